# Optimizing an MI355X kernel written in HIP

```python
import math
import jax, jax.numpy as jnp
from jax import lax
import numpy as np

D_MODEL = 1024
BATCH = 16
SEQ = 2048
DEPTH = 1

MEM_LEN = 256
EPS = 1e-6
NEG_INF = -1e30
CONV_WIDTH = 512
CONV_KERNEL = 31
NSA_HEADS = 8
HEAD_DIM = 64
NSA_WIDTH = NSA_HEADS * HEAD_DIM
NSA_KV_GROUPS = 2
HEADS_PER_GROUP = NSA_HEADS // NSA_KV_GROUPS
KV_WIDTH = NSA_KV_GROUPS * HEAD_DIM
MIX_WIDTH = CONV_WIDTH + NSA_WIDTH
ROT_DIM = HEAD_DIM // 4
ROPE_THETA = 500000.0
CMP_BLOCK = 32
CMP_STRIDE = 16
CMP_HIDDEN = 128
SEL_BLOCK = 64
N_SELECT = 16
N_LOCAL_SEL = 2
FORCED_SCORE = 1e9
WINDOW = 512
WIN_Q_BLOCK = 128
SEL_Q_CHUNK = 32
MEM_HEADS = 4
MEM_HEAD_DIM = D_MODEL // MEM_HEADS
PEER_HEADS = 8
PEER_KEYS = 128
PEER_EXPERTS = PEER_KEYS * PEER_KEYS
PEER_QDIM = 256
PEER_HALF = PEER_QDIM // 2
PEER_TOPK = 16
PEER_TOKEN_CHUNK = 128
IN_SIZES = [CONV_WIDTH, CONV_WIDTH, NSA_WIDTH,
            KV_WIDTH, KV_WIDTH, KV_WIDTH, KV_WIDTH, KV_WIDTH, KV_WIDTH,
            3 * NSA_HEADS]
IN_COLS = sum(IN_SIZES)
IN_SPLITS = [sum(IN_SIZES[:i + 1]) for i in range(len(IN_SIZES) - 1)]

kernel_name = "hybrid_conv_nsa_peer_block"


def rmsnorm(x, g):
    xf = x.astype(jnp.float32)
    y = xf * lax.rsqrt(jnp.mean(xf * xf, axis=-1, keepdims=True) + EPS)
    return (y * g.astype(jnp.float32)).astype(x.dtype)


def layernorm(x, g, b):
    xf = x.astype(jnp.float32)
    mu = jnp.mean(xf, axis=-1, keepdims=True)
    var = jnp.mean(jnp.square(xf - mu), axis=-1, keepdims=True)
    y = (xf - mu) * lax.rsqrt(var + EPS) * g.astype(jnp.float32) + b.astype(jnp.float32)
    return y.astype(x.dtype)


def masked_softmax(s, mask):
    s = jnp.where(mask, s.astype(jnp.float32), NEG_INF)
    return jax.nn.softmax(s, axis=-1) * mask


def partial_rope(x, positions):
    half = ROT_DIM // 2
    inv = ROPE_THETA ** (-(jnp.arange(half, dtype=jnp.float32) * 2.0 / ROT_DIM))
    ang = positions.astype(jnp.float32)[..., None] * inv
    cos = jnp.cos(ang)[:, :, None, :]
    sin = jnp.sin(ang)[:, :, None, :]
    xr = x[..., :ROT_DIM].astype(jnp.float32)
    x1, x2 = xr[..., :half], xr[..., half:]
    rot = jnp.concatenate([x1 * cos - x2 * sin, x2 * cos + x1 * sin], axis=-1).astype(x.dtype)
    return jnp.concatenate([rot, x[..., ROT_DIM:]], axis=-1)


def conformer_conv(a, b, w_dw, b_dw, ln_g, ln_b):
    u = a * jax.nn.sigmoid(b)
    y = lax.conv_general_dilated(
        u, w_dw[:, None, :], window_strides=(1,), padding=[(CONV_KERNEL - 1, 0)],
        dimension_numbers=('NWC', 'WIO', 'NWC'), feature_group_count=CONV_WIDTH)
    y = layernorm(y + b_dw, ln_g, ln_b)
    return jax.nn.silu(y)


def compress_tokens(kv, pos_emb, w1, b1, w2, b2):
    B, T, G, dh = kv.shape
    n_cmp = (T - CMP_BLOCK) // CMP_STRIDE + 1
    idx = jnp.arange(n_cmp)[:, None] * CMP_STRIDE + jnp.arange(CMP_BLOCK)[None, :]
    blk = kv[:, idx] + pos_emb[:, None, :]
    blk = blk.transpose(0, 1, 3, 2, 4).reshape(B, n_cmp, G, CMP_BLOCK * dh)
    hdn = jax.nn.gelu(blk @ w1 + b1)
    return hdn @ w2 + b2


def nsa_mixer(q, k_c, v_c, k_s, v_s, k_w, v_w, gate_logits, positions,
              cmp_pos, cmp_w1, cmp_b1, cmp_w2, cmp_b2):
    B, T = q.shape[:2]
    G, Hg, dh = NSA_KV_GROUPS, HEADS_PER_GROUP, HEAD_DIM
    scale = dh ** -0.5
    t_idx = jnp.arange(T)
    kvr = lambda t: t.reshape(B, T, G, dh)
    k_c, v_c, k_s, v_s, k_w, v_w = map(kvr, (k_c, v_c, k_s, v_s, k_w, v_w))

    qg = q.reshape(B, T, G, Hg, dh)
    kc = compress_tokens(k_c, cmp_pos[0], cmp_w1[0], cmp_b1[0], cmp_w2[0], cmp_b2[0])
    vc = compress_tokens(v_c, cmp_pos[1], cmp_w1[1], cmp_b1[1], cmp_w2[1], cmp_b2[1])
    n_cmp = kc.shape[1]
    c_start = jnp.arange(n_cmp) * CMP_STRIDE
    s_c = jnp.einsum('btghd,bcgd->bghtc', qg, kc) * scale
    p_c = masked_softmax(s_c, (c_start + CMP_BLOCK - 1)[None, :] <= t_idx[:, None])
    o_cmp = jnp.einsum('bghtc,bcgd->btghd', p_c.astype(vc.dtype), vc)

    n_blk = T // SEL_BLOCK
    s_start = jnp.arange(n_blk) * SEL_BLOCK
    overlap = ((c_start[:, None] <= s_start[None, :] + SEL_BLOCK - 1)
               & (c_start[:, None] + CMP_BLOCK - 1 >= s_start[None, :])).astype(jnp.float32)
    imp = jnp.einsum('bghtc,cs->bgts', p_c, overlap)
    cur = t_idx // SEL_BLOCK
    blk = jnp.arange(n_blk)
    valid = blk[None, :] <= cur[:, None]
    dist = cur[:, None] - blk[None, :]
    forced = (blk[None, :] == 0) | ((dist >= 0) & (dist < N_LOCAL_SEL))
    imp = jnp.where(forced, FORCED_SCORE, jnp.where(valid, imp, -1.0))
    n_sel = min(N_SELECT, n_blk)
    _, sel_idx = lax.top_k(imp, n_sel)

    q_r = partial_rope(q.reshape(B, T, NSA_HEADS, dh), positions).reshape(B, T, G, Hg, dh)
    k_s = partial_rope(k_s, positions)
    k_w = partial_rope(k_w, positions)

    k_blocks = k_s.reshape(B, n_blk, SEL_BLOCK, G, dh).transpose(0, 3, 1, 2, 4)
    v_blocks = v_s.reshape(B, n_blk, SEL_BLOCK, G, dh).transpose(0, 3, 1, 2, 4)
    b_ix = jnp.arange(B)[:, None, None, None]
    g_ix = jnp.arange(G)[None, :, None, None]
    n_keys_sel = n_sel * SEL_BLOCK

    def sel_chunk(ci):
        s0 = ci * SEL_Q_CHUNK
        qc = lax.dynamic_slice_in_dim(q_r, s0, SEL_Q_CHUNK, axis=1)
        ic = lax.dynamic_slice_in_dim(sel_idx, s0, SEL_Q_CHUNK, axis=2)
        kg = k_blocks[b_ix, g_ix, ic].reshape(B, G, SEL_Q_CHUNK, n_keys_sel, dh)
        vg = v_blocks[b_ix, g_ix, ic].reshape(B, G, SEL_Q_CHUNK, n_keys_sel, dh)
        kpos = (ic[..., None] * SEL_BLOCK + jnp.arange(SEL_BLOCK)).reshape(B, G, SEL_Q_CHUNK, n_keys_sel)
        qpos = s0 + jnp.arange(SEL_Q_CHUNK)
        s = jnp.einsum('bqghd,bgqkd->bghqk', qc, kg) * scale
        p = masked_softmax(s, (kpos <= qpos[None, None, :, None])[:, :, None])
        return jnp.einsum('bghqk,bgqkd->bqghd', p.astype(vg.dtype), vg)

    o_slc = lax.map(sel_chunk, jnp.arange(T // SEL_Q_CHUNK))
    o_slc = jnp.moveaxis(o_slc, 0, 1).reshape(B, T, G, Hg, dh)

    k_pad = jnp.pad(k_w, ((0, 0), (WINDOW, 0), (0, 0), (0, 0)))
    v_pad = jnp.pad(v_w, ((0, 0), (WINDOW, 0), (0, 0), (0, 0)))
    band = WINDOW + WIN_Q_BLOCK

    def win_block(bi):
        s0 = bi * WIN_Q_BLOCK
        qb = lax.dynamic_slice_in_dim(q_r, s0, WIN_Q_BLOCK, axis=1)
        kb = lax.dynamic_slice_in_dim(k_pad, s0, band, axis=1)
        vb = lax.dynamic_slice_in_dim(v_pad, s0, band, axis=1)
        kpos = s0 - WINDOW + jnp.arange(band)
        qpos = s0 + jnp.arange(WIN_Q_BLOCK)
        mask = ((kpos[None, :] <= qpos[:, None]) & (kpos[None, :] > qpos[:, None] - WINDOW)
                & (kpos[None, :] >= 0))
        s = jnp.einsum('bqghd,bkgd->bghqk', qb, kb) * scale
        p = masked_softmax(s, mask)
        return jnp.einsum('bghqk,bkgd->bqghd', p.astype(vb.dtype), vb)

    o_win = lax.map(win_block, jnp.arange(T // WIN_Q_BLOCK))
    o_win = jnp.moveaxis(o_win, 0, 1).reshape(B, T, G, Hg, dh)

    g = jax.nn.sigmoid(gate_logits).reshape(B, T, G, Hg, 3)
    out = g[..., 0:1] * o_cmp + g[..., 1:2] * o_slc + g[..., 2:3] * o_win
    return out.reshape(B, T, NSA_WIDTH)


def memory_attention(hn, mem_n, w_q, w_k, w_v, w_o):
    B, T, D = hn.shape
    M = mem_n.shape[1]
    q = (hn @ w_q).reshape(B, T, MEM_HEADS, MEM_HEAD_DIM)
    k = (mem_n @ w_k).reshape(B, M, MEM_HEADS, MEM_HEAD_DIM)
    v = (mem_n @ w_v).reshape(B, M, MEM_HEADS, MEM_HEAD_DIM)
    s = jnp.einsum('bthd,bmhd->bhtm', q, k).astype(jnp.float32) * (MEM_HEAD_DIM ** -0.5)
    p = jax.nn.softmax(s, axis=-1).astype(v.dtype)
    o = jnp.einsum('bhtm,bmhd->bthd', p, v).reshape(B, T, D)
    return o @ w_o


def peer(hn, w_q, sub_keys, u_emb, v_emb):
    B, T, D = hn.shape
    q = (hn @ w_q).reshape(B, T, PEER_HEADS, 2, PEER_HALF)
    s = jnp.einsum('bthpd,hpkd->bthpk', q, sub_keys).astype(jnp.float32)
    s_top, i_top = lax.top_k(s, PEER_TOPK)
    cand = s_top[..., 0, :, None] + s_top[..., 1, None, :]
    cand_idx = i_top[..., 0, :, None] * PEER_KEYS + i_top[..., 1, None, :]
    n_cand = PEER_TOPK * PEER_TOPK
    best, pos = lax.top_k(cand.reshape(B, T, PEER_HEADS, n_cand), PEER_TOPK)
    experts = jnp.take_along_axis(cand_idx.reshape(B, T, PEER_HEADS, n_cand), pos, axis=-1)
    gates = jax.nn.softmax(best, axis=-1).astype(hn.dtype)
    n_tok = B * T
    n_ret = PEER_HEADS * PEER_TOPK
    xs = hn.reshape(n_tok // PEER_TOKEN_CHUNK, PEER_TOKEN_CHUNK, D)
    es = experts.reshape(n_tok // PEER_TOKEN_CHUNK, PEER_TOKEN_CHUNK, n_ret)
    gs = gates.reshape(n_tok // PEER_TOKEN_CHUNK, PEER_TOKEN_CHUNK, n_ret)

    def chunk(args):
        xc, ec, gc = args
        u = u_emb[ec]
        a = jax.nn.gelu(jnp.einsum('nd,nkd->nk', xc, u))
        return jnp.einsum('nk,nkd->nd', gc * a, v_emb[ec])

    y = lax.map(chunk, (xs, es, gs))
    return y.reshape(B, T, D)


def setup_inputs(seed: int = 0) -> dict:
    key = jax.random.key(seed)
    ks = jax.random.split(key, 32)
    L, D = DEPTH, D_MODEL
    nrm = lambda k, shape, sc: jax.random.normal(k, shape, jnp.float32) * sc
    gain = lambda k, shape: 1.0 + 0.02 * jax.random.normal(k, shape, jnp.float32)
    return {
        "x": nrm(ks[0], (BATCH, SEQ, D), 1.0),
        "mem": nrm(ks[1], (BATCH, MEM_LEN, D), 1.0),
        "positions": jnp.broadcast_to(jnp.arange(SEQ, dtype=jnp.int32), (BATCH, SEQ)),
        "mix_norm_g": gain(ks[2], (L, D)),
        "w_in": nrm(ks[3], (L, D, IN_COLS), D ** -0.5),
        "conv_dw_w": nrm(ks[4], (L, CONV_KERNEL, CONV_WIDTH), CONV_KERNEL ** -0.5),
        "conv_dw_b": nrm(ks[5], (L, CONV_WIDTH), 0.02),
        "conv_ln_g": gain(ks[6], (L, CONV_WIDTH)),
        "conv_ln_b": nrm(ks[7], (L, CONV_WIDTH), 0.02),
        "cmp_pos": nrm(ks[8], (L, 2, CMP_BLOCK, HEAD_DIM), 0.02),
        "cmp_w1": nrm(ks[9], (L, 2, CMP_BLOCK * HEAD_DIM, CMP_HIDDEN), (CMP_BLOCK * HEAD_DIM) ** -0.5),
        "cmp_b1": nrm(ks[10], (L, 2, CMP_HIDDEN), 0.02),
        "cmp_w2": nrm(ks[11], (L, 2, CMP_HIDDEN, HEAD_DIM), CMP_HIDDEN ** -0.5),
        "cmp_b2": nrm(ks[12], (L, 2, HEAD_DIM), 0.02),
        "w_out": nrm(ks[13], (L, MIX_WIDTH, D), MIX_WIDTH ** -0.5),
        "mem_q_norm_g": gain(ks[14], (L, D)),
        "mem_kv_norm_g": gain(ks[15], (L, D)),
        "w_mem_q": nrm(ks[16], (L, D, D), D ** -0.5),
        "w_mem_k": nrm(ks[17], (L, D, D), D ** -0.5),
        "w_mem_v": nrm(ks[18], (L, D, D), D ** -0.5),
        "w_mem_o": nrm(ks[19], (L, D, D), D ** -0.5),
        "peer_norm_g": gain(ks[20], (L, D)),
        "peer_w_q": nrm(ks[21], (L, D, PEER_HEADS * PEER_QDIM), D ** -0.5),
        "peer_sub_keys": nrm(ks[22], (L, PEER_HEADS, 2, PEER_KEYS, PEER_HALF), PEER_HALF ** -0.5),
        "peer_u": nrm(ks[23], (L, PEER_EXPERTS, D), D ** -0.5),
        "peer_v": nrm(ks[24], (L, PEER_EXPERTS, D), D ** -0.5),
        "final_norm_g": gain(ks[25], (D,)),
    }


def reference(x, mem, positions, mix_norm_g, w_in, conv_dw_w, conv_dw_b, conv_ln_g, conv_ln_b,
              cmp_pos, cmp_w1, cmp_b1, cmp_w2, cmp_b2, w_out,
              mem_q_norm_g, mem_kv_norm_g, w_mem_q, w_mem_k, w_mem_v, w_mem_o,
              peer_norm_g, peer_w_q, peer_sub_keys, peer_u, peer_v, final_norm_g):
    h = x
    for l in range(DEPTH):
        hn = rmsnorm(h, mix_norm_g[l])
        proj = hn @ w_in[l]
        conv_a, conv_b, q, k_c, v_c, k_s, v_s, k_w, v_w, gate_logits = jnp.split(proj, IN_SPLITS, axis=-1)
        y_conv = conformer_conv(conv_a, conv_b, conv_dw_w[l], conv_dw_b[l], conv_ln_g[l], conv_ln_b[l])
        y_nsa = nsa_mixer(q, k_c, v_c, k_s, v_s, k_w, v_w, gate_logits, positions,
                          cmp_pos[l], cmp_w1[l], cmp_b1[l], cmp_w2[l], cmp_b2[l])
        h = h + jnp.concatenate([y_conv, y_nsa], axis=-1) @ w_out[l]
        h = h + memory_attention(rmsnorm(h, mem_q_norm_g[l]), rmsnorm(mem, mem_kv_norm_g[l]),
                                 w_mem_q[l], w_mem_k[l], w_mem_v[l], w_mem_o[l])
        h = h + peer(rmsnorm(h, peer_norm_g[l]), peer_w_q[l], peer_sub_keys[l], peer_u[l], peer_v[l])
    return rmsnorm(h, final_norm_g)
```

```cpp
#include <hip/hip_runtime.h>
#include <hip/hip_bf16.h>
#include <hip/hip_cooperative_groups.h>
#include <cstdio>
#include <cstdint>
namespace cg = cooperative_groups;

#ifndef COOP_MODE
#define COOP_MODE 1
#endif

typedef __attribute__((ext_vector_type(8))) short bf16x8;
typedef __attribute__((ext_vector_type(4))) short bf16x4;
typedef __attribute__((ext_vector_type(4))) float f32x4;
typedef unsigned short u16;

#define DEVI __device__ __forceinline__

constexpr int Bn = 16, T = 2048, D = 1024, NTOK = Bn * T, LDP = 2336;
constexpr int C_Q = 1024, C_KC = 1536, C_VC = 1664, C_KS = 1792, C_VS = 1920, C_KW = 2048, C_VW = 2176, C_GATE = 2304;
constexpr int SMEM_BYTES = 73728;
constexpr int NPHASE = 11;

struct Params {
  const float* x; const float* mem; const int* pos; const float* mix_g; const float* w_in;
  const float* conv_w; const float* conv_b; const float* ln_g; const float* ln_b;
  const float* cmp_pos; const float* cmp_w1; const float* cmp_b1; const float* cmp_w2; const float* cmp_b2;
  const float* w_out; const float* memq_g; const float* memkv_g; const float* w_mq; const float* w_mk;
  const float* w_mv; const float* w_mo; const float* peer_g; const float* peer_wq; const float* peer_sk;
  const float* peer_u; const float* peer_v; const float* final_g;
  float* out;
  u16* hn; u16* proj; u16* mix; float* h; u16* vts; u16* vtw; u16* memn; u16* memk; u16* memvt;
  u16* winT; u16* woutT; u16* wmqT; u16* wmkT; u16* wmvT; u16* wmoT; u16* wpqT; u16* subk; u16* w1T; u16* w2T;
  float* biasp; float* rope; u16* hdn; u16* kc; u16* vcT; float* ssq1; float* ssq2;
  int* experts; float* gates; u16* ub; u16* vb; u16* qm; u16* pq;
};

DEVI int launder(int x) { asm volatile("" : "+v"(x)); return x; }
DEVI u16 f2bf(float f) {
  unsigned u = __float_as_uint(f);
  u += 0x7fffu + ((u >> 16) & 1u);
  return (u16)(u >> 16);
}
DEVI float bf2f(u16 h) { return __uint_as_float(((unsigned)h) << 16); }
DEVI unsigned pack2(float a, float b) { return (unsigned)f2bf(a) | ((unsigned)f2bf(b) << 16); }
DEVI float wave_sum(float v) {
#pragma unroll
  for (int o = 32; o; o >>= 1) v += __shfl_xor(v, o);
  return v;
}
DEVI float sigmoidf_(float x) { return 1.f / (1.f + __expf(-x)); }
DEVI float gelu_tanh(float x) {
  float u = 0.7978845608028654f * (x + 0.044715f * x * x * x);
  return 0.5f * x * (1.f + tanhf(u));
}
DEVI f32x4 mfma16(bf16x8 a, bf16x8 b, f32x4 c) { return __builtin_amdgcn_mfma_f32_16x16x32_bf16(a, b, c, 0, 0, 0); }
DEVI float fexp2(float x) { return __builtin_amdgcn_exp2f(x); }

DEVI void tconv(const float* __restrict__ src, int K, int N, u16* __restrict__ dst, int Npad,
                const float* __restrict__ gain, int gtid, int gsz) {
  const int items = Npad * (K >> 3);
  for (int it = gtid; it < items; it += gsz) {
    const int n = it % Npad, kc = it / Npad;
    float f[8];
#pragma unroll
    for (int j = 0; j < 8; ++j) {
      float v = 0.f;
      if (n < N) {
        v = src[(size_t)(kc * 8 + j) * N + n];
        if (gain) v *= gain[kc * 8 + j];
      }
      f[j] = v;
    }
    uint4 pk;
    pk.x = pack2(f[0], f[1]); pk.y = pack2(f[2], f[3]); pk.z = pack2(f[4], f[5]); pk.w = pack2(f[6], f[7]);
    *(uint4*)(dst + (size_t)n * K + kc * 8) = pk;
  }
}

DEVI void conv_flat(const float* __restrict__ src, u16* __restrict__ dst, size_t n8, size_t gtid, size_t gsz) {
  for (size_t it = gtid; it < n8; it += gsz) {
    const float4 a = ((const float4*)src)[2 * it], b = ((const float4*)src)[2 * it + 1];
    uint4 pk;
    pk.x = pack2(a.x, a.y); pk.y = pack2(a.z, a.w); pk.z = pack2(b.x, b.y); pk.w = pack2(b.z, b.w);
    ((uint4*)dst)[it] = pk;
  }
}

DEVI void rownorm_bf16(const float* __restrict__ src, const float* __restrict__ g, u16* __restrict__ dst,
                       int rows, int gw, int nw, int lane) {
  for (int r = gw; r < rows; r += nw) {
    const float4* pr = (const float4*)(src + (size_t)r * D);
    float4 v[4];
    float ss = 0.f;
#pragma unroll
    for (int i = 0; i < 4; ++i) {
      v[i] = pr[lane + 64 * i];
      ss += v[i].x * v[i].x + v[i].y * v[i].y + v[i].z * v[i].z + v[i].w * v[i].w;
    }
    ss = wave_sum(ss);
    const float rstd = rsqrtf(ss * (1.f / D) + 1e-6f);
#pragma unroll
    for (int i = 0; i < 4; ++i) {
      const float4 gg = ((const float4*)g)[lane + 64 * i];
      uint2 pk;
      pk.x = pack2(v[i].x * rstd * gg.x, v[i].y * rstd * gg.y);
      pk.y = pack2(v[i].z * rstd * gg.z, v[i].w * rstd * gg.w);
      *(uint2*)(dst + (size_t)r * D + (size_t)(lane + 64 * i) * 4) = pk;
    }
  }
}

DEVI void phase0(const Params& p) {
  const int tid = launder(threadIdx.x), lane = tid & 63;
  const int gtid = blockIdx.x * 256 + tid, gsz = gridDim.x * 256;
  const int gw = gtid >> 6, nw = gsz >> 6;
  rownorm_bf16(p.x, p.mix_g, p.hn, NTOK, gw, nw, lane);
  rownorm_bf16(p.mem, p.memkv_g, p.memn, Bn * 256, gw, nw, lane);
  tconv(p.w_in, 1024, 2328, p.winT, 2432, nullptr, gtid, gsz);
  tconv(p.w_out, 1024, 1024, p.woutT, 1024, nullptr, gtid, gsz);
  tconv(p.w_mq, 1024, 1024, p.wmqT, 1024, p.memq_g, gtid, gsz);
  tconv(p.w_mk, 1024, 1024, p.wmkT, 1024, nullptr, gtid, gsz);
  tconv(p.w_mv, 1024, 1024, p.wmvT, 1024, nullptr, gtid, gsz);
  tconv(p.w_mo, 1024, 1024, p.wmoT, 1024, nullptr, gtid, gsz);
  tconv(p.peer_wq, 1024, 2048, p.wpqT, 2048, p.peer_g, gtid, gsz);
  tconv(p.cmp_w1, 2048, 128, p.w1T, 128, nullptr, gtid, gsz);
  tconv(p.cmp_w1 + 2048 * 128, 2048, 128, p.w1T + 128 * 2048, 128, nullptr, gtid, gsz);
  tconv(p.cmp_w2, 128, 64, p.w2T, 128, nullptr, gtid, gsz);
  tconv(p.cmp_w2 + 128 * 64, 128, 64, p.w2T + 128 * 128, 128, nullptr, gtid, gsz);
  conv_flat(p.peer_sk, p.subk, (size_t)16 * 128 * 128 / 8, gtid, gsz);
  for (int it = gtid; it < NTOK * 8; it += gsz) {
    const int tok = it >> 3, i = it & 7;
    const float inv = (float)pow(500000.0, -(double)i / 8.0);
    const float ang = (float)p.pos[tok] * inv;
    p.rope[tok * 16 + i] = (float)cos((double)ang);
    p.rope[tok * 16 + 8 + i] = (float)sin((double)ang);
  }
  for (int o = gw; o < 256; o += nw) {
    const int ty = o >> 7, n = o & 127;
    float s = 0.f;
    for (int k = lane; k < 2048; k += 64)
      s += p.cmp_pos[ty * 2048 + k] * p.cmp_w1[((size_t)ty * 2048 + k) * 128 + n];
    s = wave_sum(s);
    if (lane == 0) p.biasp[o] = s + p.cmp_b1[o];
  }
  for (int it = gtid; it < NTOK; it += gsz) { p.ssq1[it] = 0.f; p.ssq2[it] = 0.f; }
}

template <class AF>
DEVI void gemm_mainloop(int tid, u16* sA, u16* sB, AF af, const u16* __restrict__ Bt, int ldb, int m0, int n0, int nk,
                        f32x4 (&acc)[4][4]) {
  const int lane = tid & 63, w = tid >> 6;
  const int wm = w >> 1, wn = w & 1, col = lane & 15, quad = lane >> 4;
#pragma unroll
  for (int i = 0; i < 4; ++i)
#pragma unroll
    for (int j = 0; j < 4; ++j) acc[i][j] = f32x4{0.f, 0.f, 0.f, 0.f};
  uint4 ra0, ra1, ra2, ra3, rb0, rb1, rb2, rb3;
  const int lrow = tid >> 3, lkc = (tid & 7) << 3;
  const u16* bbase = Bt + (size_t)(n0 + lrow) * ldb + lkc;
#define GL_(i, kk)                                                        \
  ra##i = *(const uint4*)af(m0 + lrow + 32 * i, (kk) + lkc);              \
  rb##i = *(const uint4*)(bbase + (size_t)(32 * i) * ldb + (kk));
#define SS_(i)                                                            \
  *(uint4*)(sA + (lrow + 32 * i) * 72 + lkc) = ra##i;                     \
  *(uint4*)(sB + (lrow + 32 * i) * 72 + lkc) = rb##i;
  GL_(0, 0) GL_(1, 0) GL_(2, 0) GL_(3, 0)
  SS_(0) SS_(1) SS_(2) SS_(3)
  __syncthreads();
#pragma unroll 1
  for (int kt = 0; kt < nk; ++kt) {
    const bool more = (kt + 1 < nk);
    if (more) {
      const int kk = (kt + 1) * 64;
      GL_(0, kk) GL_(1, kk) GL_(2, kk) GL_(3, kk)
    }
#pragma unroll
    for (int ks = 0; ks < 2; ++ks) {
      bf16x8 fa[4], fb[4];
#pragma unroll
      for (int mi = 0; mi < 4; ++mi) fa[mi] = *(const bf16x8*)(sA + (wm * 64 + 16 * mi + col) * 72 + 32 * ks + 8 * quad);
#pragma unroll
      for (int ni = 0; ni < 4; ++ni) fb[ni] = *(const bf16x8*)(sB + (wn * 64 + 16 * ni + col) * 72 + 32 * ks + 8 * quad);
#pragma unroll
      for (int ni = 0; ni < 4; ++ni)
#pragma unroll
        for (int mi = 0; mi < 4; ++mi) acc[ni][mi] = mfma16(fb[ni], fa[mi], acc[ni][mi]);
    }
    __syncthreads();
    if (more) {
      SS_(0) SS_(1) SS_(2) SS_(3)
      __syncthreads();
    }
  }
#undef GL_
#undef SS_
}

struct ARow {
  const u16* base; int lda;
  DEVI const u16* operator()(int m, int k) const { return base + (size_t)m * lda + k; }
};
struct ACmp {
  const u16* proj; int colbase;
  DEVI const u16* operator()(int rr, int k) const {
    const int b = rr >> 8, g = (rr >> 7) & 1;
    int c = rr & 127; c = c > 126 ? 126 : c;
    const int l = k >> 6, d = k & 63;
    return proj + ((size_t)b * T + 16 * c + l) * LDP + colbase + g * 64 + d;
  }
};

#define GEMM_LANE_VARS                                                    \
  const int tid = launder(threadIdx.x), lane = tid & 63, w = tid >> 6;    \
  const int wm = w >> 1, wn = w & 1, col = lane & 15, quad = lane >> 4;   \
  (void)wm; (void)wn; (void)col; (void)quad;

DEVI void phase1(const Params& p, unsigned char* smem) {
  u16* sA = (u16*)smem; u16* sB = sA + 128 * 72;
  const int NT1 = 256 * 19, NT2 = 32 * 8 * 2;
#pragma unroll 1
  for (int tile = blockIdx.x; tile < NT1 + NT2; tile += gridDim.x) {
    GEMM_LANE_VARS
    f32x4 acc[4][4];
    if (tile < NT1) {
      const int mt = tile / 19, nt_ = tile % 19;
      const int m0 = mt * 128, n0 = nt_ * 128;
      gemm_mainloop(tid, sA, sB, ARow{p.hn, D}, p.winT, D, m0, n0, 16, acc);
#pragma unroll
      for (int mi = 0; mi < 4; ++mi) {
        const int m = m0 + wm * 64 + 16 * mi + col;
        const int b = m >> 11, t = m & 2047;
#pragma unroll
        for (int ni = 0; ni < 4; ++ni) {
          const int nt = n0 + wn * 64 + 16 * ni;
          const int n = nt + 4 * quad;
          f32x4 v = acc[ni][mi];
          if (nt >= LDP) continue;
          if ((nt >= C_VS && nt < C_KW) || (nt >= C_VW && nt < C_GATE)) {
            const bool isw = nt >= C_VW;
            const int off = n - (isw ? C_VW : C_VS);
            const int g = off >> 6, d = off & 63;
            u16* dst = (isw ? p.vtw : p.vts) + ((size_t)(b * 2 + g) * 64 + d) * T + t;
#pragma unroll
            for (int r = 0; r < 4; ++r) dst[(size_t)r * T] = f2bf(v[r]);
          } else {
            const bool rope_tile = ((nt >= C_KS && nt < C_VS) || (nt >= C_KW && nt < C_VW)) && ((nt & 63) == 0);
            if (rope_tile) {
#pragma unroll
              for (int r = 0; r < 4; ++r) {
                const float pr = __shfl_xor(v[r], 32);
                const int i = ((quad & 1) << 2) + r;
                const float cs = p.rope[(size_t)m * 16 + i], sn = p.rope[(size_t)m * 16 + 8 + i];
                v[r] = (quad < 2) ? (v[r] * cs - pr * sn) : (v[r] * cs + pr * sn);
              }
            }
            uint2 pk; pk.x = pack2(v[0], v[1]); pk.y = pack2(v[2], v[3]);
            *(uint2*)(p.proj + (size_t)m * LDP + n) = pk;
          }
        }
      }
    } else {
      const int t2 = tile - NT1;
      const int isv = t2 >> 8, mt = (t2 >> 3) & 31, nt_ = t2 & 7;
      const int m0 = mt * 128, n0 = nt_ * 128;
      gemm_mainloop(tid, sA, sB, ARow{p.memn, D}, isv ? p.wmvT : p.wmkT, D, m0, n0, 16, acc);
#pragma unroll
      for (int mi = 0; mi < 4; ++mi) {
        const int m = m0 + wm * 64 + 16 * mi + col;
        const int b = m >> 8, key = m & 255;
#pragma unroll
        for (int ni = 0; ni < 4; ++ni) {
          const int n = n0 + wn * 64 + 16 * ni + 4 * quad;
          const f32x4 v = acc[ni][mi];
          if (isv) {
            const int head = n >> 8, d = n & 255;
            u16* dst = p.memvt + ((size_t)(b * 4 + head) * 256 + d) * 256 + key;
#pragma unroll
            for (int r = 0; r < 4; ++r) dst[r * 256] = f2bf(v[r]);
          } else {
            uint2 pk; pk.x = pack2(v[0], v[1]); pk.y = pack2(v[2], v[3]);
            *(uint2*)(p.memk + (size_t)m * D + n) = pk;
          }
        }
      }
    }
  }
}

DEVI void conv_tile(const Params& p, unsigned char* smem, int ct) {
  u16* sU = (u16*)smem;
  float2* sRed = (float2*)(smem + 62 * 512 * 2);
  const int tid = launder(threadIdx.x), lane = tid & 63, w = tid >> 6;
  const int b = ct >> 6, t0 = (ct & 63) * 32;
  __syncthreads();
  for (int it = tid; it < 62 * 64; it += 256) {
    const int r = it >> 6, c8 = it & 63;
    const int t = t0 - 30 + r;
    uint4 pk = {0u, 0u, 0u, 0u};
    if (t >= 0) {
      const u16* src = p.proj + ((size_t)b * T + t) * LDP + c8 * 8;
      const uint4 a = *(const uint4*)src, bb = *(const uint4*)(src + 512);
      const unsigned au[4] = {a.x, a.y, a.z, a.w}, bu[4] = {bb.x, bb.y, bb.z, bb.w};
      unsigned o[4];
#pragma unroll
      for (int j = 0; j < 4; ++j) {
        const float a0 = __uint_as_float(au[j] << 16), a1 = __uint_as_float(au[j] & 0xffff0000u);
        const float b0 = __uint_as_float(bu[j] << 16), b1 = __uint_as_float(bu[j] & 0xffff0000u);
        o[j] = pack2(a0 * sigmoidf_(b0), a1 * sigmoidf_(b1));
      }
      pk.x = o[0]; pk.y = o[1]; pk.z = o[2]; pk.w = o[3];
    }
    *(uint4*)(sU + r * 512 + c8 * 8) = pk;
  }
  const int c = 2 * tid;
  float w0[31], w1[31];
#pragma unroll
  for (int j = 0; j < 31; ++j) { w0[j] = p.conv_w[j * 512 + c]; w1[j] = p.conv_w[j * 512 + c + 1]; }
  const float bd0 = p.conv_b[c], bd1 = p.conv_b[c + 1];
  __syncthreads();
  for (int tt = 0; tt < 32; ++tt) {
    float y0 = bd0, y1 = bd1;
#pragma unroll
    for (int j = 0; j < 31; ++j) {
      const unsigned uu = *(const unsigned*)(sU + (tt + j) * 512 + c);
      y0 += w0[j] * __uint_as_float(uu << 16);
      y1 += w1[j] * __uint_as_float(uu & 0xffff0000u);
    }
    float s = y0 + y1, q = y0 * y0 + y1 * y1;
    s = wave_sum(s); q = wave_sum(q);
    if (lane == 0) sRed[tt * 4 + w] = make_float2(s, q);
  }
  __syncthreads();
  const float g0 = p.ln_g[c], g1 = p.ln_g[c + 1], lb0 = p.ln_b[c], lb1 = p.ln_b[c + 1];
  for (int tt = 0; tt < 32; ++tt) {
    float y0 = bd0, y1 = bd1;
#pragma unroll
    for (int j = 0; j < 31; ++j) {
      const unsigned uu = *(const unsigned*)(sU + (tt + j) * 512 + c);
      y0 += w0[j] * __uint_as_float(uu << 16);
      y1 += w1[j] * __uint_as_float(uu & 0xffff0000u);
    }
    const float2 r0 = sRed[tt * 4 + 0], r1 = sRed[tt * 4 + 1], r2 = sRed[tt * 4 + 2], r3 = sRed[tt * 4 + 3];
    const float S = r0.x + r1.x + r2.x + r3.x, Q = r0.y + r1.y + r2.y + r3.y;
    const float mu = S * (1.f / 512.f);
    const float var = fmaxf(Q * (1.f / 512.f) - mu * mu, 0.f);
    const float rstd = rsqrtf(var + 1e-6f);
    const float z0 = (y0 - mu) * rstd * g0 + lb0, z1 = (y1 - mu) * rstd * g1 + lb1;
    const float o0 = z0 * sigmoidf_(z0), o1 = z1 * sigmoidf_(z1);
    *(unsigned*)(p.mix + ((size_t)b * T + t0 + tt) * D + c) = pack2(o0, o1);
  }
}

DEVI void phase2(const Params& p, unsigned char* smem) {
  u16* sA = (u16*)smem; u16* sB = sA + 128 * 72;
#pragma unroll 1
  for (int tile = blockIdx.x; tile < 64 + 1024; tile += gridDim.x) {
    GEMM_LANE_VARS
    if (tile < 64) {
      const int ty = tile >> 5, mt = tile & 31;
      const int m0 = mt * 128;
      f32x4 acc[4][4];
      gemm_mainloop(tid, sA, sB, ACmp{p.proj, ty ? C_VC : C_KC}, p.w1T + (size_t)ty * 128 * 2048, 2048, m0, 0, 32, acc);
#pragma unroll
      for (int mi = 0; mi < 4; ++mi) {
        const int m = m0 + wm * 64 + 16 * mi + col;
#pragma unroll
        for (int ni = 0; ni < 4; ++ni) {
          const int n = wn * 64 + 16 * ni + 4 * quad;
          const f32x4 v = acc[ni][mi];
          const float4 bb = *(const float4*)(p.biasp + ty * 128 + n);
          uint2 pk;
          pk.x = pack2(gelu_tanh(v[0] + bb.x), gelu_tanh(v[1] + bb.y));
          pk.y = pack2(gelu_tanh(v[2] + bb.z), gelu_tanh(v[3] + bb.w));
          *(uint2*)(p.hdn + ((size_t)ty * 4096 + m) * 128 + n) = pk;
        }
      }
    } else {
      conv_tile(p, smem, tile - 64);
    }
  }
}

DEVI void phase3(const Params& p, unsigned char* smem) {
  u16* sA = (u16*)smem; u16* sB = sA + 128 * 72;
#pragma unroll 1
  for (int tile = blockIdx.x; tile < 64; tile += gridDim.x) {
    GEMM_LANE_VARS
    const int ty = tile >> 5, mt = tile & 31;
    const int m0 = mt * 128;
    f32x4 acc[4][4];
    gemm_mainloop(tid, sA, sB, ARow{p.hdn + (size_t)ty * 4096 * 128, 128}, p.w2T + (size_t)ty * 128 * 128, 128, m0, 0, 2, acc);
    if (wn == 0) {
#pragma unroll
      for (int mi = 0; mi < 4; ++mi) {
        const int m = m0 + 16 * mi + wm * 64 + col;
        const int bg = m >> 7, c = m & 127;
#pragma unroll
        for (int ni = 0; ni < 4; ++ni) {
          const int n = 16 * ni + 4 * quad;
          const f32x4 v = acc[ni][mi];
          const float4 bb = *(const float4*)(p.cmp_b2 + ty * 64 + n);
          const float o0 = v[0] + bb.x, o1 = v[1] + bb.y, o2 = v[2] + bb.z, o3 = v[3] + bb.w;
          if (ty == 0) {
            uint2 pk; pk.x = pack2(o0, o1); pk.y = pack2(o2, o3);
            *(uint2*)(p.kc + (size_t)m * 64 + n) = pk;
          } else {
            u16* dst = p.vcT + ((size_t)bg * 64 + n) * 128 + c;
            dst[0] = f2bf(o0); dst[128] = f2bf(o1); dst[256] = f2bf(o2); dst[384] = f2bf(o3);
          }
        }
      }
    }
  }
}

template <int DH, int NQ, int LDK, int LDV, class MaskF>
DEVI void attn_tile(const u16* sK, const u16* sVt, const bf16x8 (&qf)[NQ][DH / 32], f32x4 (&o)[NQ][DH / 16],
                    float (&m)[NQ], float (&l)[NQ], float c2, int lane, MaskF valid) {
  const int col = lane & 15, quad = lane >> 4;
  f32x4 s[NQ][4];
#pragma unroll
  for (int kt = 0; kt < 4; ++kt) {
#pragma unroll
    for (int qt = 0; qt < NQ; ++qt) s[qt][kt] = f32x4{0.f, 0.f, 0.f, 0.f};
#pragma unroll
    for (int ks = 0; ks < DH / 32; ++ks) {
      const bf16x8 kf = *(const bf16x8*)(sK + (16 * kt + col) * LDK + 32 * ks + 8 * quad);
#pragma unroll
      for (int qt = 0; qt < NQ; ++qt) s[qt][kt] = mfma16(kf, qf[qt][ks], s[qt][kt]);
    }
  }
  bf16x8 pb[NQ][2];
#pragma unroll
  for (int qt = 0; qt < NQ; ++qt) {
    float mx = -1e30f;
#pragma unroll
    for (int kt = 0; kt < 4; ++kt)
#pragma unroll
      for (int r = 0; r < 4; ++r) {
        const bool v = valid(qt, 16 * kt + 4 * quad + r);
        const float sv = v ? s[qt][kt][r] : -1e30f;
        s[qt][kt][r] = sv;
        mx = fmaxf(mx, sv);
      }
    mx = fmaxf(mx, __shfl_xor(mx, 16));
    mx = fmaxf(mx, __shfl_xor(mx, 32));
    const float mn = fmaxf(m[qt], mx);
    const float alpha = fexp2((m[qt] - mn) * c2);
    m[qt] = mn;
    float ps = 0.f;
#pragma unroll
    for (int kt = 0; kt < 4; ++kt)
#pragma unroll
      for (int r = 0; r < 4; ++r) {
        const float sv = s[qt][kt][r];
        const float pv = (sv > -1e29f) ? fexp2((sv - mn) * c2) : 0.f;
        ps += pv;
        s[qt][kt][r] = pv;
      }
    l[qt] = l[qt] * alpha + ps;
#pragma unroll
    for (int dt = 0; dt < DH / 16; ++dt) o[qt][dt] *= alpha;
#pragma unroll
    for (int kk = 0; kk < 2; ++kk) {
      union { bf16x8 v; unsigned u[4]; } cv;
      cv.u[0] = pack2(s[qt][2 * kk][0], s[qt][2 * kk][1]);
      cv.u[1] = pack2(s[qt][2 * kk][2], s[qt][2 * kk][3]);
      cv.u[2] = pack2(s[qt][2 * kk + 1][0], s[qt][2 * kk + 1][1]);
      cv.u[3] = pack2(s[qt][2 * kk + 1][2], s[qt][2 * kk + 1][3]);
      pb[qt][kk] = cv.v;
    }
  }
#pragma unroll
  for (int dt = 0; dt < DH / 16; ++dt) {
#pragma unroll
    for (int kk = 0; kk < 2; ++kk) {
      union { bf16x8 v; uint2 h[2]; } cv;
      cv.h[0] = *(const uint2*)(sVt + (16 * dt + col) * LDV + 32 * kk + 4 * quad);
      cv.h[1] = *(const uint2*)(sVt + (16 * dt + col) * LDV + 32 * kk + 16 + 4 * quad);
#pragma unroll
      for (int qt = 0; qt < NQ; ++qt) o[qt][dt] = mfma16(cv.v, pb[qt][kk], o[qt][dt]);
    }
  }
}

DEVI void phase_nsa(const Params& p, unsigned char* smem) {
  u16* sK = (u16*)smem;
  u16* sVt = (u16*)(smem + 18432);
  float* impH = (float*)(smem + 35840);
  float* impT = (float*)(smem + 52736);
  unsigned* selm = (unsigned*)(smem + 56960);
  const float c2 = 0.125f * 1.4426950408889634f;
#pragma unroll 1
  for (int tile = blockIdx.x; tile < 2048; tile += gridDim.x) {
    const int tid = launder(threadIdx.x), lane = tid & 63, w = tid >> 6, col = lane & 15, quad = lane >> 4;
    const int qtile = 63 - (tile >> 5), bg = tile & 31, b = bg >> 1, g = bg & 1, q0 = qtile * 32;
    const int h = g * 4 + w;
    __syncthreads();
    if (tid < 32) selm[tid] = 0u;
    {
      const u16* kcp = p.kc + (size_t)bg * 128 * 64;
      const u16* vcp = p.vcT + (size_t)bg * 64 * 128;
#pragma unroll
      for (int i = 0; i < 4; ++i) {
        const int c = tid + 256 * i;
        const int row = c >> 3, ch = (c & 7) << 3;
        *(uint4*)(sK + row * 72 + ch) = *(const uint4*)(kcp + row * 64 + ch);
        const int row2 = c >> 4, ch2 = (c & 15) << 3;
        *(uint4*)(sVt + row2 * 136 + ch2) = *(const uint4*)(vcp + row2 * 128 + ch2);
      }
    }
    bf16x8 qf[2][2];
    float gate[2][3];
    int tq[2];
#pragma unroll
    for (int qt = 0; qt < 2; ++qt) {
      const int t = q0 + 16 * qt + col;
      tq[qt] = t;
      const size_t tok = (size_t)b * T + t;
      const u16* qp = p.proj + tok * LDP + C_Q + h * 64 + 8 * quad;
      qf[qt][0] = *(const bf16x8*)qp;
      qf[qt][1] = *(const bf16x8*)(qp + 32);
#pragma unroll
      for (int br = 0; br < 3; ++br) gate[qt][br] = sigmoidf_(bf2f(p.proj[tok * LDP + C_GATE + h * 3 + br]));
    }
    __syncthreads();

    f32x4 comb[2][4];
    {
      const int srcl = (lane + 48) & 63;
#pragma unroll
      for (int qt = 0; qt < 2; ++qt) {
        f32x4 s[8];
#pragma unroll
        for (int kt = 0; kt < 8; ++kt) {
          s[kt] = f32x4{0.f, 0.f, 0.f, 0.f};
#pragma unroll
          for (int ks = 0; ks < 2; ++ks) {
            const bf16x8 kf = *(const bf16x8*)(sK + (16 * kt + col) * 72 + 32 * ks + 8 * quad);
            s[kt] = mfma16(kf, qf[qt][ks], s[kt]);
          }
        }
        const int t = tq[qt];
        float mx = -1e30f;
#pragma unroll
        for (int kt = 0; kt < 8; ++kt)
#pragma unroll
          for (int r = 0; r < 4; ++r) {
            const int c = 16 * kt + 4 * quad + r;
            const bool v = (16 * c + 31) <= t;
            const float sv = v ? s[kt][r] : -1e30f;
            s[kt][r] = sv;
            mx = fmaxf(mx, sv);
          }
        mx = fmaxf(mx, __shfl_xor(mx, 16));
        mx = fmaxf(mx, __shfl_xor(mx, 32));
        float ps = 0.f;
#pragma unroll
        for (int kt = 0; kt < 8; ++kt)
#pragma unroll
          for (int r = 0; r < 4; ++r) {
            const float sv = s[kt][r];
            const float pv = (sv > -1e29f) ? fexp2((sv - mx) * c2) : 0.f;
            ps += pv;
            s[kt][r] = pv;
          }
        ps += __shfl_xor(ps, 16);
        ps += __shfl_xor(ps, 32);
        const float inv = ps > 0.f ? 1.f / ps : 0.f;
#pragma unroll
        for (int kt = 0; kt < 8; ++kt)
#pragma unroll
          for (int r = 0; r < 4; ++r) s[kt][r] *= inv;
        float prev3 = 0.f;
#pragma unroll
        for (int kt = 0; kt < 8; ++kt) {
          const float sum4 = s[kt][0] + s[kt][1] + s[kt][2] + s[kt][3];
          const float xs = __shfl(s[kt][3], srcl);
          const float extra = quad ? xs : prev3;
          prev3 = xs;
          impH[(w * 32 + 16 * qt + col) * 33 + 4 * kt + quad] = sum4 + extra;
        }
        bf16x8 pb[4];
#pragma unroll
        for (int kk = 0; kk < 4; ++kk) {
          union { bf16x8 v; unsigned u[4]; } cv;
          cv.u[0] = pack2(s[2 * kk][0], s[2 * kk][1]);
          cv.u[1] = pack2(s[2 * kk][2], s[2 * kk][3]);
          cv.u[2] = pack2(s[2 * kk + 1][0], s[2 * kk + 1][1]);
          cv.u[3] = pack2(s[2 * kk + 1][2], s[2 * kk + 1][3]);
          pb[kk] = cv.v;
        }
#pragma unroll
        for (int dt = 0; dt < 4; ++dt) {
          f32x4 oc = f32x4{0.f, 0.f, 0.f, 0.f};
#pragma unroll
          for (int kk = 0; kk < 4; ++kk) {
            union { bf16x8 v; uint2 hh[2]; } cv;
            cv.hh[0] = *(const uint2*)(sVt + (16 * dt + col) * 136 + 32 * kk + 4 * quad);
            cv.hh[1] = *(const uint2*)(sVt + (16 * dt + col) * 136 + 32 * kk + 16 + 4 * quad);
            oc = mfma16(cv.v, pb[kk], oc);
          }
          comb[qt][dt] = oc * gate[qt][0];
        }
      }
    }
#pragma unroll
    for (int qt = 0; qt < 2; ++qt) {
      const size_t tok = (size_t)b * T + tq[qt];
      union { bf16x8 v; unsigned u[4]; } own, par, res;
      own.v = qf[qt][0];
#pragma unroll
      for (int j = 0; j < 4; ++j) par.u[j] = (unsigned)__shfl_xor((int)own.u[j], 16);
      const float4 c0 = *(const float4*)(p.rope + tok * 16), c1 = *(const float4*)(p.rope + tok * 16 + 4);
      const float4 s0 = *(const float4*)(p.rope + tok * 16 + 8), s1 = *(const float4*)(p.rope + tok * 16 + 12);
      const float cs[8] = {c0.x, c0.y, c0.z, c0.w, c1.x, c1.y, c1.z, c1.w};
      const float sn[8] = {s0.x, s0.y, s0.z, s0.w, s1.x, s1.y, s1.z, s1.w};
#pragma unroll
      for (int j = 0; j < 4; ++j) {
        const float o0 = __uint_as_float(own.u[j] << 16), o1 = __uint_as_float(own.u[j] & 0xffff0000u);
        const float p0 = __uint_as_float(par.u[j] << 16), p1 = __uint_as_float(par.u[j] & 0xffff0000u);
        const float sg = (quad == 0) ? -1.f : 1.f;
        const float r0 = o0 * cs[2 * j] + sg * p0 * sn[2 * j];
        const float r1 = o1 * cs[2 * j + 1] + sg * p1 * sn[2 * j + 1];
        res.u[j] = (quad < 2) ? pack2(r0, r1) : own.u[j];
      }
      qf[qt][0] = res.v;
    }
    __syncthreads();
#pragma unroll
    for (int i = 0; i < 4; ++i) {
      const int cell = tid + 256 * i;
      const int qi = cell >> 5, s_ = cell & 31;
      const int cur = (q0 + qi) >> 6;
      float v = impH[(0 * 32 + qi) * 33 + s_] + impH[(1 * 32 + qi) * 33 + s_] + impH[(2 * 32 + qi) * 33 + s_] +
                impH[(3 * 32 + qi) * 33 + s_];
      const int dist = cur - s_;
      const bool forced = (s_ == 0) || (dist >= 0 && dist < 2);
      v = forced ? 1e9f : (s_ <= cur ? v : -1.f);
      impT[qi * 33 + s_] = v;
    }
    __syncthreads();
    {
      const int qi = tid >> 3, sub = tid & 7;
      unsigned bits = 0u;
#pragma unroll
      for (int k = 0; k < 4; ++k) {
        const int s_ = sub * 4 + k;
        const float v = impT[qi * 33 + s_];
        int rank = 0;
        for (int s2 = 0; s2 < 32; ++s2) {
          const float v2 = impT[qi * 33 + s2];
          rank += ((v2 > v) || (v2 == v && s2 < s_)) ? 1 : 0;
        }
        if (rank < 16) bits |= 1u << s_;
      }
      atomicOr(&selm[qi], bits);
    }
    __syncthreads();
    unsigned sm[2] = {selm[col], selm[16 + col]};
    unsigned uni = 0u;
#pragma unroll
    for (int i = 0; i < 32; ++i) uni |= selm[i];
    const int kbmax = (q0 + 31) >> 6;
    {
      float m[2] = {-1e30f, -1e30f}, l[2] = {0.f, 0.f};
      f32x4 o[2][4];
#pragma unroll
      for (int qt = 0; qt < 2; ++qt)
#pragma unroll
        for (int dt = 0; dt < 4; ++dt) o[qt][dt] = f32x4{0.f, 0.f, 0.f, 0.f};
#pragma unroll 1
      for (int kb = 0; kb <= kbmax; ++kb) {
        if (!((uni >> kb) & 1u)) continue;
        __syncthreads();
#pragma unroll
        for (int i = 0; i < 2; ++i) {
          const int c = tid + 256 * i, row = c >> 3, ch = (c & 7) << 3;
          *(uint4*)(sK + row * 72 + ch) = *(const uint4*)(p.proj + ((size_t)b * T + kb * 64 + row) * LDP + C_KS + g * 64 + ch);
          *(uint4*)(sVt + row * 72 + ch) = *(const uint4*)(p.vts + ((size_t)bg * 64 + row) * T + kb * 64 + ch);
        }
        __syncthreads();
        attn_tile<64, 2, 72, 72>(sK, sVt, qf, o, m, l, c2, lane, [&](int qt, int kl) {
          const int kp = kb * 64 + kl;
          return (((sm[qt] >> kb) & 1u) != 0u) && (kp <= tq[qt]);
        });
      }
#pragma unroll
      for (int qt = 0; qt < 2; ++qt) {
        float lt = l[qt];
        lt += __shfl_xor(lt, 16);
        lt += __shfl_xor(lt, 32);
        const float sc = lt > 0.f ? gate[qt][1] / lt : 0.f;
#pragma unroll
        for (int dt = 0; dt < 4; ++dt) comb[qt][dt] += o[qt][dt] * sc;
      }
    }
    {
      float m[2] = {-1e30f, -1e30f}, l[2] = {0.f, 0.f};
      f32x4 o[2][4];
#pragma unroll
      for (int qt = 0; qt < 2; ++qt)
#pragma unroll
        for (int dt = 0; dt < 4; ++dt) o[qt][dt] = f32x4{0.f, 0.f, 0.f, 0.f};
      const int kblo = (q0 >= 511) ? ((q0 - 511) >> 6) : 0;
#pragma unroll 1
      for (int kb = kblo; kb <= kbmax; ++kb) {
        __syncthreads();
#pragma unroll
        for (int i = 0; i < 2; ++i) {
          const int c = tid + 256 * i, row = c >> 3, ch = (c & 7) << 3;
          *(uint4*)(sK + row * 72 + ch) = *(const uint4*)(p.proj + ((size_t)b * T + kb * 64 + row) * LDP + C_KW + g * 64 + ch);
          *(uint4*)(sVt + row * 72 + ch) = *(const uint4*)(p.vtw + ((size_t)bg * 64 + row) * T + kb * 64 + ch);
        }
        __syncthreads();
        attn_tile<64, 2, 72, 72>(sK, sVt, qf, o, m, l, c2, lane, [&](int qt, int kl) {
          const int kp = kb * 64 + kl;
          return (kp <= tq[qt]) && (kp > tq[qt] - 512);
        });
      }
#pragma unroll
      for (int qt = 0; qt < 2; ++qt) {
        float lt = l[qt];
        lt += __shfl_xor(lt, 16);
        lt += __shfl_xor(lt, 32);
        const float sc = lt > 0.f ? gate[qt][2] / lt : 0.f;
#pragma unroll
        for (int dt = 0; dt < 4; ++dt) comb[qt][dt] += o[qt][dt] * sc;
      }
    }
#pragma unroll
    for (int qt = 0; qt < 2; ++qt) {
      const size_t tok = (size_t)b * T + tq[qt];
#pragma unroll
      for (int dt = 0; dt < 4; ++dt) {
        uint2 pk;
        pk.x = pack2(comb[qt][dt][0], comb[qt][dt][1]);
        pk.y = pack2(comb[qt][dt][2], comb[qt][dt][3]);
        *(uint2*)(p.mix + tok * D + 512 + h * 64 + 16 * dt + 4 * quad) = pk;
      }
    }
  }
}

DEVI void phase_resid(const Params& p, unsigned char* smem, const u16* A, const u16* Wt, const float* res, float* ssq) {
  u16* sA = (u16*)smem; u16* sB = sA + 128 * 72;
#pragma unroll 1
  for (int tile = blockIdx.x; tile < 256 * 8; tile += gridDim.x) {
    GEMM_LANE_VARS
    const int mt = tile >> 3, nt_ = tile & 7;
    const int m0 = mt * 128, n0 = nt_ * 128;
    f32x4 acc[4][4];
    gemm_mainloop(tid, sA, sB, ARow{A, D}, Wt, D, m0, n0, 16, acc);
#pragma unroll
    for (int mi = 0; mi < 4; ++mi) {
      const int m = m0 + wm * 64 + 16 * mi + col;
      float ss = 0.f;
#pragma unroll
      for (int ni = 0; ni < 4; ++ni) {
        const int n = n0 + wn * 64 + 16 * ni + 4 * quad;
        const f32x4 v = acc[ni][mi];
        const float4 r = *(const float4*)(res + (size_t)m * D + n);
        float4 hv;
        hv.x = r.x + v[0]; hv.y = r.y + v[1]; hv.z = r.z + v[2]; hv.w = r.w + v[3];
        ss += hv.x * hv.x + hv.y * hv.y + hv.z * hv.z + hv.w * hv.w;
        *(float4*)(p.h + (size_t)m * D + n) = hv;
        uint2 pk; pk.x = pack2(hv.x, hv.y); pk.y = pack2(hv.z, hv.w);
        *(uint2*)(p.hn + (size_t)m * D + n) = pk;
      }
      ss += __shfl_xor(ss, 16);
      ss += __shfl_xor(ss, 32);
      if (quad == 0) atomicAdd(ssq + m, ss);
    }
  }
}

DEVI void phase_scaled(const Params& p, unsigned char* smem, const u16* A, const u16* Wt, int ntn, const float* ssq, u16* outp, int ldo) {
  u16* sA = (u16*)smem; u16* sB = sA + 128 * 72;
#pragma unroll 1
  for (int tile = blockIdx.x; tile < 256 * ntn; tile += gridDim.x) {
    GEMM_LANE_VARS
    const int mt = tile / ntn, nt_ = tile % ntn;
    const int m0 = mt * 128, n0 = nt_ * 128;
    f32x4 acc[4][4];
    gemm_mainloop(tid, sA, sB, ARow{A, D}, Wt, D, m0, n0, 16, acc);
#pragma unroll
    for (int mi = 0; mi < 4; ++mi) {
      const int m = m0 + wm * 64 + 16 * mi + col;
      const float rstd = rsqrtf(ssq[m] * (1.f / D) + 1e-6f);
#pragma unroll
      for (int ni = 0; ni < 4; ++ni) {
        const int n = n0 + wn * 64 + 16 * ni + 4 * quad;
        const f32x4 v = acc[ni][mi];
        uint2 pk; pk.x = pack2(v[0] * rstd, v[1] * rstd); pk.y = pack2(v[2] * rstd, v[3] * rstd);
        *(uint2*)(outp + (size_t)m * ldo + n) = pk;
      }
    }
  }
}

DEVI void phase_memattn(const Params& p, unsigned char* smem) {
  u16* sK = (u16*)smem;
  u16* sVt = (u16*)(smem + 33792);
  const float c2 = 0.0625f * 1.4426950408889634f;
#pragma unroll 1
  for (int tile = blockIdx.x; tile < 2048; tile += gridDim.x) {
    const int tid = launder(threadIdx.x), lane = tid & 63, w = tid >> 6, col = lane & 15, quad = lane >> 4;
    const int b = tile >> 7, head = (tile >> 5) & 3, q0 = (tile & 31) * 64;
    const size_t tok = (size_t)b * T + q0 + 16 * w + col;
    bf16x8 qf[1][8];
#pragma unroll
    for (int ks = 0; ks < 8; ++ks) qf[0][ks] = *(const bf16x8*)(p.qm + tok * D + head * 256 + 32 * ks + 8 * quad);
    float m[1] = {-1e30f}, l[1] = {0.f};
    f32x4 o[1][16];
#pragma unroll
    for (int dt = 0; dt < 16; ++dt) o[0][dt] = f32x4{0.f, 0.f, 0.f, 0.f};
#pragma unroll 1
    for (int kb = 0; kb < 4; ++kb) {
      __syncthreads();
#pragma unroll
      for (int i = 0; i < 8; ++i) {
        const int c = tid + 256 * i;
        const int row = c >> 5, ch = (c & 31) << 3;
        *(uint4*)(sK + row * 264 + ch) = *(const uint4*)(p.memk + ((size_t)b * 256 + kb * 64 + row) * D + head * 256 + ch);
        const int row2 = c >> 3, ch2 = (c & 7) << 3;
        *(uint4*)(sVt + row2 * 72 + ch2) = *(const uint4*)(p.memvt + ((size_t)(b * 4 + head) * 256 + row2) * 256 + kb * 64 + ch2);
      }
      __syncthreads();
      attn_tile<256, 1, 264, 72>(sK, sVt, qf, o, m, l, c2, lane, [&](int, int) { return true; });
    }
    float lt = l[0];
    lt += __shfl_xor(lt, 16);
    lt += __shfl_xor(lt, 32);
    const float inv = 1.f / lt;
#pragma unroll
    for (int dt = 0; dt < 16; ++dt) {
      uint2 pk;
      pk.x = pack2(o[0][dt][0] * inv, o[0][dt][1] * inv);
      pk.y = pack2(o[0][dt][2] * inv, o[0][dt][3] * inv);
      *(uint2*)(p.mix + tok * D + head * 256 + 16 * dt + 4 * quad) = pk;
    }
  }
}

__constant__ unsigned char kCandI[64] = {0,0,0,0,0,0,0,0,0,0,0,0,0,0,0,0, 1,1,1,1,1,1,1,1, 2,2,2,2,2, 3,3,3,3, 4,4,4, 5,5, 6,6, 7,7,
                                          8, 9, 10, 11, 12, 13, 14, 15, 0,0,0,0,0,0,0,0,0,0,0,0,0,0};
__constant__ unsigned char kCandJ[64] = {0,1,2,3,4,5,6,7,8,9,10,11,12,13,14,15, 0,1,2,3,4,5,6,7, 0,1,2,3,4, 0,1,2,3, 0,1,2, 0,1, 0,1, 0,1,
                                          0, 0, 0, 0, 0, 0, 0, 0, 0,0,0,0,0,0,0,0,0,0,0,0,0,0};

DEVI unsigned score_key(float v, int idx) {
  unsigned u = __float_as_uint(v);
  u = (u & 0x80000000u) ? ~u : (u | 0x80000000u);
  return (u & ~127u) | (unsigned)(127 - idx);
}
DEVI float key_score(unsigned k) {
  k &= ~127u;
  const unsigned u = (k & 0x80000000u) ? (k & 0x7fffffffu) : ~k;
  return __uint_as_float(u);
}

DEVI void phase_peer_route(const Params& p, unsigned char* smem) {
  u16* sA = (u16*)smem; u16* sB = sA + 128 * 72;
  unsigned* sScore = (unsigned*)smem;
  unsigned* sTop = (unsigned*)(smem + 36864);
  {
    const size_t gtid = (size_t)blockIdx.x * 256 + launder(threadIdx.x), gsz = (size_t)gridDim.x * 256;
    conv_flat(p.peer_u, p.ub, (size_t)16384 * 1024 / 8, gtid, gsz);
    conv_flat(p.peer_v, p.vb, (size_t)16384 * 1024 / 8, gtid, gsz);
  }
#pragma unroll 1
  for (int tile = blockIdx.x; tile < 256 * 8; tile += gridDim.x) {
    GEMM_LANE_VARS
    const int mt = tile >> 3, hd = tile & 7;
    const int m0 = mt * 128;
#pragma unroll 1
    for (int ph = 0; ph < 2; ++ph) {
      const int hp = hd * 2 + ph;
      f32x4 acc[4][4];
      __syncthreads();
      gemm_mainloop(tid, sA, sB, ARow{p.pq + hp * 128, 2048}, p.subk + (size_t)hp * 128 * 128, 128, m0, 0, 2, acc);
#pragma unroll 1
      for (int hh = 0; hh < 2; ++hh) {
        if (wm == hh) {
#pragma unroll
          for (int mi = 0; mi < 4; ++mi) {
            const int row = 16 * mi + col;
#pragma unroll
            for (int ni = 0; ni < 4; ++ni) {
              const int n = wn * 64 + 16 * ni + 4 * quad;
              const f32x4 v = acc[ni][mi];
              uint4 kk;
              kk.x = score_key(v[0], n); kk.y = score_key(v[1], n + 1);
              kk.z = score_key(v[2], n + 2); kk.w = score_key(v[3], n + 3);
              *(uint4*)(sScore + row * 128 + n) = kk;
            }
          }
        }
        __syncthreads();
#pragma unroll 1
        for (int rr = 0; rr < 16; ++rr) {
          const int row = w * 16 + rr;
          const unsigned k0 = sScore[row * 128 + lane], k1 = sScore[row * 128 + 64 + lane];
          int r0 = 0, r1 = 0;
#pragma unroll 4
          for (int j = 0; j < 32; ++j) {
            const uint4 kk = *(const uint4*)(sScore + row * 128 + 4 * j);
            r0 += (kk.x > k0) + (kk.y > k0) + (kk.z > k0) + (kk.w > k0);
            r1 += (kk.x > k1) + (kk.y > k1) + (kk.z > k1) + (kk.w > k1);
          }
          if (r0 < 16) sTop[((hh * 64 + row) * 2 + ph) * 16 + r0] = k0;
          if (r1 < 16) sTop[((hh * 64 + row) * 2 + ph) * 16 + r1] = k1;
        }
        __syncthreads();
      }
    }
    const int ci = kCandI[lane], cj = kCandJ[lane];
#pragma unroll 1
    for (int tt = 0; tt < 32; ++tt) {
      const int trow = w * 32 + tt;
      const unsigned k0 = sTop[(trow * 2 + 0) * 16 + ci], k1 = sTop[(trow * 2 + 1) * 16 + cj];
      const bool act = lane < 50;
      const float v = act ? (key_score(k0) + key_score(k1)) : -3.0e38f;
      int rank = 0;
#pragma unroll
      for (int c = 0; c < 50; ++c) {
        const float v2 = __int_as_float(__builtin_amdgcn_readlane(__float_as_int(v), c));
        rank += ((v2 > v) || (v2 == v && c < lane)) ? 1 : 0;
      }
      const bool sel = act && rank < 16;
      const unsigned long long bal = __ballot(sel && rank == 0);
      const int srcl = (int)__ffsll((long long)bal) - 1;
      const float vmax = __shfl(v, srcl < 0 ? 0 : srcl);
      const float e = sel ? __expf(v - vmax) : 0.f;
      const float tot = wave_sum(e);
      if (sel) {
        const int eid = (127 - (int)(k0 & 127u)) * 128 + (127 - (int)(k1 & 127u));
        const size_t o = (size_t)(m0 + trow) * 128 + hd * 16 + rank;
        p.experts[o] = eid;
        p.gates[o] = e / tot;
      }
    }
  }
}

DEVI void phase_peer_gather(const Params& p) {
  const uint4* ub = (const uint4*)p.ub;
  const uint4* vb = (const uint4*)p.vb;
  const int w0_ = threadIdx.x >> 6;
#pragma unroll 1
  for (int tok = blockIdx.x * 4 + w0_; tok < NTOK; tok += gridDim.x * 4) {
    const int tid = launder(threadIdx.x), lane = tid & 63;
    const float4* hp4 = (const float4*)(p.h + (size_t)tok * D);
    float hv[16], xn[16], y[16];
    {
      const float4 a0 = hp4[2 * lane], a1 = hp4[2 * lane + 1], a2 = hp4[128 + 2 * lane], a3 = hp4[128 + 2 * lane + 1];
      hv[0] = a0.x; hv[1] = a0.y; hv[2] = a0.z; hv[3] = a0.w; hv[4] = a1.x; hv[5] = a1.y; hv[6] = a1.z; hv[7] = a1.w;
      hv[8] = a2.x; hv[9] = a2.y; hv[10] = a2.z; hv[11] = a2.w; hv[12] = a3.x; hv[13] = a3.y; hv[14] = a3.z; hv[15] = a3.w;
    }
    float ss = 0.f;
#pragma unroll
    for (int i = 0; i < 16; ++i) ss += hv[i] * hv[i];
    ss = wave_sum(ss);
    const float rstd = rsqrtf(ss * (1.f / D) + 1e-6f);
    {
      const float4* g4 = (const float4*)p.peer_g;
      const float4 a0 = g4[2 * lane], a1 = g4[2 * lane + 1], a2 = g4[128 + 2 * lane], a3 = g4[128 + 2 * lane + 1];
      const float gg[16] = {a0.x, a0.y, a0.z, a0.w, a1.x, a1.y, a1.z, a1.w, a2.x, a2.y, a2.z, a2.w, a3.x, a3.y, a3.z, a3.w};
#pragma unroll
      for (int i = 0; i < 16; ++i) { xn[i] = hv[i] * rstd * gg[i]; y[i] = 0.f; }
    }
    const int e0 = p.experts[(size_t)tok * 128 + lane], e1 = p.experts[(size_t)tok * 128 + 64 + lane];
    const float g0 = p.gates[(size_t)tok * 128 + lane], g1 = p.gates[(size_t)tok * 128 + 64 + lane];
    float cf0 = 0.f, cf1 = 0.f;
#pragma unroll
    for (int half = 0; half < 2; ++half) {
      const int ev = half ? e1 : e0;
      float cf = 0.f;
      for (int k = 0; k < 64; k += 4) {
        uint4 c0[4], c1[4];
#pragma unroll
        for (int u = 0; u < 4; ++u) {
          const int e = __builtin_amdgcn_readlane(ev, k + u);
          c0[u] = ub[(size_t)e * 128 + lane];
          c1[u] = ub[(size_t)e * 128 + 64 + lane];
        }
#pragma unroll
        for (int u = 0; u < 4; ++u) {
          const unsigned uu[8] = {c0[u].x, c0[u].y, c0[u].z, c0[u].w, c1[u].x, c1[u].y, c1[u].z, c1[u].w};
          float d = 0.f;
#pragma unroll
          for (int j = 0; j < 8; ++j) {
            d += xn[2 * j] * __uint_as_float(uu[j] << 16);
            d += xn[2 * j + 1] * __uint_as_float(uu[j] & 0xffff0000u);
          }
          d = wave_sum(d);
          const float a = gelu_tanh(d);
          if (lane == k + u) cf = a;
        }
      }
      if (half) cf1 = cf * g1; else cf0 = cf * g0;
    }
#pragma unroll
    for (int half = 0; half < 2; ++half) {
      const int ev = half ? e1 : e0;
      const float cfv = half ? cf1 : cf0;
      for (int k = 0; k < 64; k += 4) {
        uint4 c0[4], c1[4];
        float ck[4];
#pragma unroll
        for (int u = 0; u < 4; ++u) {
          const int e = __builtin_amdgcn_readlane(ev, k + u);
          ck[u] = __int_as_float(__builtin_amdgcn_readlane(__float_as_int(cfv), k + u));
          c0[u] = vb[(size_t)e * 128 + lane];
          c1[u] = vb[(size_t)e * 128 + 64 + lane];
        }
#pragma unroll
        for (int u = 0; u < 4; ++u) {
          const unsigned uu[8] = {c0[u].x, c0[u].y, c0[u].z, c0[u].w, c1[u].x, c1[u].y, c1[u].z, c1[u].w};
#pragma unroll
          for (int j = 0; j < 8; ++j) {
            y[2 * j] += ck[u] * __uint_as_float(uu[j] << 16);
            y[2 * j + 1] += ck[u] * __uint_as_float(uu[j] & 0xffff0000u);
          }
        }
      }
    }
    float s2 = 0.f;
#pragma unroll
    for (int i = 0; i < 16; ++i) { y[i] += hv[i]; s2 += y[i] * y[i]; }
    s2 = wave_sum(s2);
    const float rs2 = rsqrtf(s2 * (1.f / D) + 1e-6f);
    {
      const float4* g4 = (const float4*)p.final_g;
      const float4 a0 = g4[2 * lane], a1 = g4[2 * lane + 1], a2 = g4[128 + 2 * lane], a3 = g4[128 + 2 * lane + 1];
      float4* o4 = (float4*)(p.out + (size_t)tok * D);
      o4[2 * lane] = make_float4(y[0] * rs2 * a0.x, y[1] * rs2 * a0.y, y[2] * rs2 * a0.z, y[3] * rs2 * a0.w);
      o4[2 * lane + 1] = make_float4(y[4] * rs2 * a1.x, y[5] * rs2 * a1.y, y[6] * rs2 * a1.z, y[7] * rs2 * a1.w);
      o4[128 + 2 * lane] = make_float4(y[8] * rs2 * a2.x, y[9] * rs2 * a2.y, y[10] * rs2 * a2.z, y[11] * rs2 * a2.w);
      o4[128 + 2 * lane + 1] = make_float4(y[12] * rs2 * a3.x, y[13] * rs2 * a3.y, y[14] * rs2 * a3.z, y[15] * rs2 * a3.w);
    }
  }
}

template <bool COOP>
__global__ void __launch_bounds__(256, 1) mega(Params p, int ph_lo, int ph_hi) {
  __shared__ __attribute__((aligned(16))) unsigned char smem[SMEM_BYTES];
  for (int ph = ph_lo; ph <= ph_hi; ++ph) {
    switch (ph) {
      case 0: phase0(p); break;
      case 1: phase1(p, smem); break;
      case 2: phase2(p, smem); break;
      case 3: phase3(p, smem); break;
      case 4: phase_nsa(p, smem); break;
      case 5: phase_resid(p, smem, p.mix, p.woutT, p.x, p.ssq1); break;
      case 6: phase_scaled(p, smem, p.hn, p.wmqT, 8, p.ssq1, p.qm, D); break;
      case 7: phase_memattn(p, smem); break;
      case 8: phase_resid(p, smem, p.mix, p.wmoT, p.h, p.ssq2); break;
      case 9: phase_scaled(p, smem, p.hn, p.wpqT, 16, p.ssq2, p.pq, 2048); break;
      case 10: phase_peer_route(p, smem); break;
      case 11: phase_peer_gather(p); break;
    }
    if (COOP) {
      if (ph < ph_hi) cg::this_grid().sync();
    }
  }
}

extern "C" void kernel_launch(void* const* d_in, const int* in_sizes, int n_in, void* d_out, int out_size, void* d_ws,
                              size_t ws_size, hipStream_t stream) {
  (void)in_sizes; (void)n_in; (void)out_size; (void)ws_size;
  Params p{};
  p.x = (const float*)d_in[0]; p.mem = (const float*)d_in[1]; p.pos = (const int*)d_in[2];
  p.mix_g = (const float*)d_in[3]; p.w_in = (const float*)d_in[4]; p.conv_w = (const float*)d_in[5];
  p.conv_b = (const float*)d_in[6]; p.ln_g = (const float*)d_in[7]; p.ln_b = (const float*)d_in[8];
  p.cmp_pos = (const float*)d_in[9]; p.cmp_w1 = (const float*)d_in[10]; p.cmp_b1 = (const float*)d_in[11];
  p.cmp_w2 = (const float*)d_in[12]; p.cmp_b2 = (const float*)d_in[13]; p.w_out = (const float*)d_in[14];
  p.memq_g = (const float*)d_in[15]; p.memkv_g = (const float*)d_in[16]; p.w_mq = (const float*)d_in[17];
  p.w_mk = (const float*)d_in[18]; p.w_mv = (const float*)d_in[19]; p.w_mo = (const float*)d_in[20];
  p.peer_g = (const float*)d_in[21]; p.peer_wq = (const float*)d_in[22]; p.peer_sk = (const float*)d_in[23];
  p.peer_u = (const float*)d_in[24]; p.peer_v = (const float*)d_in[25]; p.final_g = (const float*)d_in[26];
  p.out = (float*)d_out;
  unsigned char* ws = (unsigned char*)d_ws;
  size_t off = 0;
  auto take = [&](size_t bytes) { unsigned char* r = ws + off; off += (bytes + 255) & ~(size_t)255; return r; };
  unsigned char* regA = take((size_t)NTOK * D * 2);
  unsigned char* regB = take((size_t)NTOK * LDP * 2);
  unsigned char* regC = take((size_t)NTOK * D * 2);
  p.hn = (u16*)regA; p.ub = (u16*)regA; p.vb = (u16*)(regA + (size_t)16384 * 1024 * 2);
  p.proj = (u16*)regB; p.qm = (u16*)regB; p.pq = (u16*)regB;
  p.mix = (u16*)regC; p.experts = (int*)regC; p.gates = (float*)(regC + (size_t)NTOK * 128 * 4);
  p.h = (float*)take((size_t)NTOK * D * 4);
  p.vts = (u16*)take((size_t)Bn * 2 * 64 * T * 2);
  p.vtw = (u16*)take((size_t)Bn * 2 * 64 * T * 2);
  p.memn = (u16*)take((size_t)Bn * 256 * D * 2);
  p.memk = (u16*)take((size_t)Bn * 256 * D * 2);
  p.memvt = (u16*)take((size_t)Bn * 256 * D * 2);
  p.winT = (u16*)take((size_t)2432 * 1024 * 2);
  p.woutT = (u16*)take((size_t)1024 * 1024 * 2);
  p.wmqT = (u16*)take((size_t)1024 * 1024 * 2);
  p.wmkT = (u16*)take((size_t)1024 * 1024 * 2);
  p.wmvT = (u16*)take((size_t)1024 * 1024 * 2);
  p.wmoT = (u16*)take((size_t)1024 * 1024 * 2);
  p.wpqT = (u16*)take((size_t)2048 * 1024 * 2);
  p.subk = (u16*)take((size_t)16 * 128 * 128 * 2);
  p.w1T = (u16*)take((size_t)2 * 128 * 2048 * 2);
  p.w2T = (u16*)take((size_t)2 * 128 * 128 * 2);
  p.biasp = (float*)take(256 * 4);
  p.rope = (float*)take((size_t)NTOK * 16 * 4);
  p.hdn = (u16*)take((size_t)2 * 4096 * 128 * 2);
  p.kc = (u16*)take((size_t)Bn * 2 * 128 * 64 * 2);
  p.vcT = (u16*)take((size_t)Bn * 2 * 64 * 128 * 2);
  p.ssq1 = (float*)take((size_t)NTOK * 4);
  p.ssq2 = (float*)take((size_t)NTOK * 4);
  if (off > ws_size) { fprintf(stderr, "workspace too small: need %zu have %zu\n", off, ws_size); return; }

#if COOP_MODE
  static int grid_blocks = 0;
  if (!grid_blocks) {
    int dev = 0, cus = 0, per_cu = 0;
    hipGetDevice(&dev);
    hipDeviceGetAttribute(&cus, hipDeviceAttributeMultiprocessorCount, dev);
    hipOccupancyMaxActiveBlocksPerMultiprocessor(&per_cu, mega<true>, 256, 0);
    if (per_cu > 2) per_cu = 2;
    if (per_cu < 1) per_cu = 1;
    grid_blocks = cus * per_cu;
  }
  int lo = 0, hi = NPHASE;
  void* args[] = {&p, &lo, &hi};
  hipError_t e = hipLaunchCooperativeKernel((void*)mega<true>, dim3(grid_blocks), dim3(256), args, 0, stream);
  if (e != hipSuccess) fprintf(stderr, "cooperative launch failed: %s (grid %d)\n", hipGetErrorString(e), grid_blocks);
#else
  for (int ph = 0; ph <= NPHASE; ++ph) mega<false><<<dim3(512), dim3(256), 0, stream>>>(p, ph, ph);
#endif
}
```

```cpp
#include <hip/hip_runtime.h>
#include <hip/hip_bf16.h>
#include <hip/hip_cooperative_groups.h>
#include <cstdio>
#include <cstdint>
namespace cg = cooperative_groups;

#ifndef COOP_MODE
#define COOP_MODE 1
#endif

typedef __attribute__((ext_vector_type(8))) short bf16x8;
typedef __attribute__((ext_vector_type(4))) short bf16x4;
typedef __attribute__((ext_vector_type(4))) float f32x4;
typedef unsigned short u16;

#define DEVI __device__ __forceinline__

constexpr int Bn = 16, T = 2048, D = 1024, NTOK = Bn * T, LDP = 2336;
constexpr int C_Q = 1024, C_KC = 1536, C_VC = 1664, C_KS = 1792, C_VS = 1920, C_KW = 2048, C_VW = 2176, C_GATE = 2304;
constexpr int SMEM_BYTES = 73728;
constexpr int NPHASE = 11;

struct Params {
  const float* x; const float* mem; const int* pos; const float* mix_g; const float* w_in;
  const float* conv_w; const float* conv_b; const float* ln_g; const float* ln_b;
  const float* cmp_pos; const float* cmp_w1; const float* cmp_b1; const float* cmp_w2; const float* cmp_b2;
  const float* w_out; const float* memq_g; const float* memkv_g; const float* w_mq; const float* w_mk;
  const float* w_mv; const float* w_mo; const float* peer_g; const float* peer_wq; const float* peer_sk;
  const float* peer_u; const float* peer_v; const float* final_g;
  float* out;
  u16* hn; u16* proj; u16* mix; float* h; u16* vts; u16* vtw; u16* memn; u16* memk; u16* memvt;
  u16* winT; u16* woutT; u16* wmqT; u16* wmkT; u16* wmvT; u16* wmoT; u16* wpqT; u16* subk; u16* w1T; u16* w2T;
  float* biasp; float* rope; u16* hdn; u16* kc; u16* vcT; float* ssq1; float* ssq2;
  int* experts; float* gates; u16* ub; u16* vb; u16* qm; u16* pq;
};

DEVI int launder(int x) { asm volatile("" : "+v"(x)); return x; }
DEVI u16 f2bf(float f) {
  unsigned u = __float_as_uint(f);
  u += 0x7fffu + ((u >> 16) & 1u);
  return (u16)(u >> 16);
}
DEVI float bf2f(u16 h) { return __uint_as_float(((unsigned)h) << 16); }
DEVI unsigned pack2(float a, float b) { return (unsigned)f2bf(a) | ((unsigned)f2bf(b) << 16); }
DEVI float wave_sum(float v) {
#pragma unroll
  for (int o = 32; o; o >>= 1) v += __shfl_xor(v, o);
  return v;
}
DEVI float sigmoidf_(float x) { return 1.f / (1.f + __expf(-x)); }
DEVI float gelu_tanh(float x) {
  float u = 0.7978845608028654f * (x + 0.044715f * x * x * x);
  return 0.5f * x * (1.f + tanhf(u));
}
DEVI f32x4 mfma16(bf16x8 a, bf16x8 b, f32x4 c) { return __builtin_amdgcn_mfma_f32_16x16x32_bf16(a, b, c, 0, 0, 0); }
DEVI float fexp2(float x) { return __builtin_amdgcn_exp2f(x); }

DEVI void tconv(const float* __restrict__ src, int K, int N, u16* __restrict__ dst, int Npad,
                const float* __restrict__ gain, int gtid, int gsz) {
  const int items = Npad * (K >> 3);
  for (int it = gtid; it < items; it += gsz) {
    const int n = it % Npad, kc = it / Npad;
    float f[8];
#pragma unroll
    for (int j = 0; j < 8; ++j) {
      float v = 0.f;
      if (n < N) {
        v = src[(size_t)(kc * 8 + j) * N + n];
        if (gain) v *= gain[kc * 8 + j];
      }
      f[j] = v;
    }
    uint4 pk;
    pk.x = pack2(f[0], f[1]); pk.y = pack2(f[2], f[3]); pk.z = pack2(f[4], f[5]); pk.w = pack2(f[6], f[7]);
    *(uint4*)(dst + (size_t)n * K + kc * 8) = pk;
  }
}

DEVI void conv_flat(const float* __restrict__ src, u16* __restrict__ dst, size_t n8, size_t gtid, size_t gsz) {
  for (size_t it = gtid; it < n8; it += gsz) {
    const float4 a = ((const float4*)src)[2 * it], b = ((const float4*)src)[2 * it + 1];
    uint4 pk;
    pk.x = pack2(a.x, a.y); pk.y = pack2(a.z, a.w); pk.z = pack2(b.x, b.y); pk.w = pack2(b.z, b.w);
    ((uint4*)dst)[it] = pk;
  }
}

DEVI void rownorm_bf16(const float* __restrict__ src, const float* __restrict__ g, u16* __restrict__ dst,
                       int rows, int gw, int nw, int lane) {
  for (int r = gw; r < rows; r += nw) {
    const float4* pr = (const float4*)(src + (size_t)r * D);
    float4 v[4];
    float ss = 0.f;
#pragma unroll
    for (int i = 0; i < 4; ++i) {
      v[i] = pr[lane + 64 * i];
      ss += v[i].x * v[i].x + v[i].y * v[i].y + v[i].z * v[i].z + v[i].w * v[i].w;
    }
    ss = wave_sum(ss);
    const float rstd = rsqrtf(ss * (1.f / D) + 1e-6f);
#pragma unroll
    for (int i = 0; i < 4; ++i) {
      const float4 gg = ((const float4*)g)[lane + 64 * i];
      uint2 pk;
      pk.x = pack2(v[i].x * rstd * gg.x, v[i].y * rstd * gg.y);
      pk.y = pack2(v[i].z * rstd * gg.z, v[i].w * rstd * gg.w);
      *(uint2*)(dst + (size_t)r * D + (size_t)(lane + 64 * i) * 4) = pk;
    }
  }
}

DEVI void phase0(const Params& p) {
  const int tid = launder(threadIdx.x), lane = tid & 63;
  const int gtid = blockIdx.x * 256 + tid, gsz = gridDim.x * 256;
  const int gw = gtid >> 6, nw = gsz >> 6;
  rownorm_bf16(p.x, p.mix_g, p.hn, NTOK, gw, nw, lane);
  rownorm_bf16(p.mem, p.memkv_g, p.memn, Bn * 256, gw, nw, lane);
  tconv(p.w_in, 1024, 2328, p.winT, 2432, nullptr, gtid, gsz);
  tconv(p.w_out, 1024, 1024, p.woutT, 1024, nullptr, gtid, gsz);
  tconv(p.w_mq, 1024, 1024, p.wmqT, 1024, p.memq_g, gtid, gsz);
  tconv(p.w_mk, 1024, 1024, p.wmkT, 1024, nullptr, gtid, gsz);
  tconv(p.w_mv, 1024, 1024, p.wmvT, 1024, nullptr, gtid, gsz);
  tconv(p.w_mo, 1024, 1024, p.wmoT, 1024, nullptr, gtid, gsz);
  tconv(p.peer_wq, 1024, 2048, p.wpqT, 2048, p.peer_g, gtid, gsz);
  tconv(p.cmp_w1, 2048, 128, p.w1T, 128, nullptr, gtid, gsz);
  tconv(p.cmp_w1 + 2048 * 128, 2048, 128, p.w1T + 128 * 2048, 128, nullptr, gtid, gsz);
  tconv(p.cmp_w2, 128, 64, p.w2T, 128, nullptr, gtid, gsz);
  tconv(p.cmp_w2 + 128 * 64, 128, 64, p.w2T + 128 * 128, 128, nullptr, gtid, gsz);
  conv_flat(p.peer_sk, p.subk, (size_t)16 * 128 * 128 / 8, gtid, gsz);
  for (int it = gtid; it < NTOK * 8; it += gsz) {
    const int tok = it >> 3, i = it & 7;
    const float inv = (i == 0) ? 1.000000000e+00f : (i == 1) ? 1.939227432e-01f : (i == 2) ? 3.760603070e-02f : (i == 3) ? 7.292664610e-03f : (i == 4) ? 1.414213562e-03f : (i == 5) ? 2.742481884e-04f : (i == 6) ? 5.318295734e-05f : 1.031338525e-05f;
    const float ang = (float)p.pos[tok] * inv;
    float sv, cv;
    sincosf(ang, &sv, &cv);
    p.rope[tok * 16 + i] = cv;
    p.rope[tok * 16 + 8 + i] = sv;
  }
  for (int o = gw; o < 256; o += nw) {
    const int ty = o >> 7, n = o & 127;
    float s = 0.f;
    for (int k = lane; k < 2048; k += 64)
      s += p.cmp_pos[ty * 2048 + k] * p.cmp_w1[((size_t)ty * 2048 + k) * 128 + n];
    s = wave_sum(s);
    if (lane == 0) p.biasp[o] = s + p.cmp_b1[o];
  }
  for (int it = gtid; it < NTOK; it += gsz) { p.ssq1[it] = 0.f; p.ssq2[it] = 0.f; }
}

template <class AF>
DEVI void gemm_mainloop(int tid, u16* sA, u16* sB, AF af, const u16* __restrict__ Bt, int ldb, int m0, int n0, int nk,
                        f32x4 (&acc)[4][4]) {
  const int lane = tid & 63, w = tid >> 6;
  const int wm = w >> 1, wn = w & 1, col = lane & 15, quad = lane >> 4;
#pragma unroll
  for (int i = 0; i < 4; ++i)
#pragma unroll
    for (int j = 0; j < 4; ++j) acc[i][j] = f32x4{0.f, 0.f, 0.f, 0.f};
  uint4 ra0, ra1, ra2, ra3, rb0, rb1, rb2, rb3;
  const int lrow = tid >> 3, lkc = (tid & 7) << 3;
  const u16* bbase = Bt + (size_t)(n0 + lrow) * ldb + lkc;
#define GL_(i, kk)                                                        \
  ra##i = *(const uint4*)af(m0 + lrow + 32 * i, (kk) + lkc);              \
  rb##i = *(const uint4*)(bbase + (size_t)(32 * i) * ldb + (kk));
#define SS_(i)                                                            \
  *(uint4*)(sA + (lrow + 32 * i) * 72 + lkc) = ra##i;                     \
  *(uint4*)(sB + (lrow + 32 * i) * 72 + lkc) = rb##i;
  GL_(0, 0) GL_(1, 0) GL_(2, 0) GL_(3, 0)
  SS_(0) SS_(1) SS_(2) SS_(3)
  __syncthreads();
#pragma unroll 1
  for (int kt = 0; kt < nk; ++kt) {
    const bool more = (kt + 1 < nk);
    if (more) {
      const int kk = (kt + 1) * 64;
      GL_(0, kk) GL_(1, kk) GL_(2, kk) GL_(3, kk)
    }
#pragma unroll
    for (int ks = 0; ks < 2; ++ks) {
      bf16x8 fa[4], fb[4];
#pragma unroll
      for (int mi = 0; mi < 4; ++mi) fa[mi] = *(const bf16x8*)(sA + (wm * 64 + 16 * mi + col) * 72 + 32 * ks + 8 * quad);
#pragma unroll
      for (int ni = 0; ni < 4; ++ni) fb[ni] = *(const bf16x8*)(sB + (wn * 64 + 16 * ni + col) * 72 + 32 * ks + 8 * quad);
#pragma unroll
      for (int ni = 0; ni < 4; ++ni)
#pragma unroll
        for (int mi = 0; mi < 4; ++mi) acc[ni][mi] = mfma16(fb[ni], fa[mi], acc[ni][mi]);
    }
    __syncthreads();
    if (more) {
      SS_(0) SS_(1) SS_(2) SS_(3)
      __syncthreads();
    }
  }
#undef GL_
#undef SS_
}

struct ARow {
  const u16* base; int lda;
  DEVI const u16* operator()(int m, int k) const { return base + (size_t)m * lda + k; }
};
struct ACmp {
  const u16* proj; int colbase;
  DEVI const u16* operator()(int rr, int k) const {
    const int b = rr >> 8, g = (rr >> 7) & 1;
    int c = rr & 127; c = c > 126 ? 126 : c;
    const int l = k >> 6, d = k & 63;
    return proj + ((size_t)b * T + 16 * c + l) * LDP + colbase + g * 64 + d;
  }
};

#define GEMM_LANE_VARS                                                    \
  const int tid = launder(threadIdx.x), lane = tid & 63, w = tid >> 6;    \
  const int wm = w >> 1, wn = w & 1, col = lane & 15, quad = lane >> 4;   \
  (void)wm; (void)wn; (void)col; (void)quad;

DEVI void phase1(const Params& p, unsigned char* smem) {
  u16* sA = (u16*)smem; u16* sB = sA + 128 * 72;
  const int NT1 = 256 * 19, NT2 = 32 * 8 * 2;
#pragma unroll 1
  for (int tile = blockIdx.x; tile < NT1 + NT2; tile += gridDim.x) {
    GEMM_LANE_VARS
    f32x4 acc[4][4];
    if (tile < NT1) {
      const int mt = tile / 19, nt_ = tile % 19;
      const int m0 = mt * 128, n0 = nt_ * 128;
      gemm_mainloop(tid, sA, sB, ARow{p.hn, D}, p.winT, D, m0, n0, 16, acc);
#pragma unroll
      for (int mi = 0; mi < 4; ++mi) {
        const int m = m0 + wm * 64 + 16 * mi + col;
        const int b = m >> 11, t = m & 2047;
#pragma unroll
        for (int ni = 0; ni < 4; ++ni) {
          const int nt = n0 + wn * 64 + 16 * ni;
          const int n = nt + 4 * quad;
          f32x4 v = acc[ni][mi];
          if (nt >= LDP) continue;
          if ((nt >= C_VS && nt < C_KW) || (nt >= C_VW && nt < C_GATE)) {
            const bool isw = nt >= C_VW;
            const int off = n - (isw ? C_VW : C_VS);
            const int g = off >> 6, d = off & 63;
            u16* dst = (isw ? p.vtw : p.vts) + ((size_t)(b * 2 + g) * 64 + d) * T + t;
#pragma unroll
            for (int r = 0; r < 4; ++r) dst[(size_t)r * T] = f2bf(v[r]);
          } else {
            const bool rope_tile = ((nt >= C_KS && nt < C_VS) || (nt >= C_KW && nt < C_VW)) && ((nt & 63) == 0);
            if (rope_tile) {
#pragma unroll
              for (int r = 0; r < 4; ++r) {
                const float pr = __shfl_xor(v[r], 32);
                const int i = ((quad & 1) << 2) + r;
                const float cs = p.rope[(size_t)m * 16 + i], sn = p.rope[(size_t)m * 16 + 8 + i];
                v[r] = (quad < 2) ? (v[r] * cs - pr * sn) : (v[r] * cs + pr * sn);
              }
            }
            uint2 pk; pk.x = pack2(v[0], v[1]); pk.y = pack2(v[2], v[3]);
            *(uint2*)(p.proj + (size_t)m * LDP + n) = pk;
          }
        }
      }
    } else {
      const int t2 = tile - NT1;
      const int isv = t2 >> 8, mt = (t2 >> 3) & 31, nt_ = t2 & 7;
      const int m0 = mt * 128, n0 = nt_ * 128;
      gemm_mainloop(tid, sA, sB, ARow{p.memn, D}, isv ? p.wmvT : p.wmkT, D, m0, n0, 16, acc);
#pragma unroll
      for (int mi = 0; mi < 4; ++mi) {
        const int m = m0 + wm * 64 + 16 * mi + col;
        const int b = m >> 8, key = m & 255;
#pragma unroll
        for (int ni = 0; ni < 4; ++ni) {
          const int n = n0 + wn * 64 + 16 * ni + 4 * quad;
          const f32x4 v = acc[ni][mi];
          if (isv) {
            const int head = n >> 8, d = n & 255;
            u16* dst = p.memvt + ((size_t)(b * 4 + head) * 256 + d) * 256 + key;
#pragma unroll
            for (int r = 0; r < 4; ++r) dst[r * 256] = f2bf(v[r]);
          } else {
            uint2 pk; pk.x = pack2(v[0], v[1]); pk.y = pack2(v[2], v[3]);
            *(uint2*)(p.memk + (size_t)m * D + n) = pk;
          }
        }
      }
    }
  }
}

DEVI void conv_tile(const Params& p, unsigned char* smem, int ct) {
  u16* sU = (u16*)smem;
  float2* sRed = (float2*)(smem + 62 * 512 * 2);
  const int tid = launder(threadIdx.x), lane = tid & 63, w = tid >> 6;
  const int b = ct >> 6, t0 = (ct & 63) * 32;
  __syncthreads();
  for (int it = tid; it < 62 * 64; it += 256) {
    const int r = it >> 6, c8 = it & 63;
    const int t = t0 - 30 + r;
    uint4 pk = {0u, 0u, 0u, 0u};
    if (t >= 0) {
      const u16* src = p.proj + ((size_t)b * T + t) * LDP + c8 * 8;
      const uint4 a = *(const uint4*)src, bb = *(const uint4*)(src + 512);
      const unsigned au[4] = {a.x, a.y, a.z, a.w}, bu[4] = {bb.x, bb.y, bb.z, bb.w};
      unsigned o[4];
#pragma unroll
      for (int j = 0; j < 4; ++j) {
        const float a0 = __uint_as_float(au[j] << 16), a1 = __uint_as_float(au[j] & 0xffff0000u);
        const float b0 = __uint_as_float(bu[j] << 16), b1 = __uint_as_float(bu[j] & 0xffff0000u);
        o[j] = pack2(a0 * sigmoidf_(b0), a1 * sigmoidf_(b1));
      }
      pk.x = o[0]; pk.y = o[1]; pk.z = o[2]; pk.w = o[3];
    }
    *(uint4*)(sU + r * 512 + c8 * 8) = pk;
  }
  const int c = 2 * tid;
  float w0[31], w1[31];
#pragma unroll
  for (int j = 0; j < 31; ++j) { w0[j] = p.conv_w[j * 512 + c]; w1[j] = p.conv_w[j * 512 + c + 1]; }
  const float bd0 = p.conv_b[c], bd1 = p.conv_b[c + 1];
  __syncthreads();
  for (int tt = 0; tt < 32; ++tt) {
    float y0 = bd0, y1 = bd1;
#pragma unroll
    for (int j = 0; j < 31; ++j) {
      const unsigned uu = *(const unsigned*)(sU + (tt + j) * 512 + c);
      y0 += w0[j] * __uint_as_float(uu << 16);
      y1 += w1[j] * __uint_as_float(uu & 0xffff0000u);
    }
    float s = y0 + y1, q = y0 * y0 + y1 * y1;
    s = wave_sum(s); q = wave_sum(q);
    if (lane == 0) sRed[tt * 4 + w] = make_float2(s, q);
  }
  __syncthreads();
  const float g0 = p.ln_g[c], g1 = p.ln_g[c + 1], lb0 = p.ln_b[c], lb1 = p.ln_b[c + 1];
  for (int tt = 0; tt < 32; ++tt) {
    float y0 = bd0, y1 = bd1;
#pragma unroll
    for (int j = 0; j < 31; ++j) {
      const unsigned uu = *(const unsigned*)(sU + (tt + j) * 512 + c);
      y0 += w0[j] * __uint_as_float(uu << 16);
      y1 += w1[j] * __uint_as_float(uu & 0xffff0000u);
    }
    const float2 r0 = sRed[tt * 4 + 0], r1 = sRed[tt * 4 + 1], r2 = sRed[tt * 4 + 2], r3 = sRed[tt * 4 + 3];
    const float S = r0.x + r1.x + r2.x + r3.x, Q = r0.y + r1.y + r2.y + r3.y;
    const float mu = S * (1.f / 512.f);
    const float var = fmaxf(Q * (1.f / 512.f) - mu * mu, 0.f);
    const float rstd = rsqrtf(var + 1e-6f);
    const float z0 = (y0 - mu) * rstd * g0 + lb0, z1 = (y1 - mu) * rstd * g1 + lb1;
    const float o0 = z0 * sigmoidf_(z0), o1 = z1 * sigmoidf_(z1);
    *(unsigned*)(p.mix + ((size_t)b * T + t0 + tt) * D + c) = pack2(o0, o1);
  }
}

DEVI void phase2(const Params& p, unsigned char* smem) {
  u16* sA = (u16*)smem; u16* sB = sA + 128 * 72;
#pragma unroll 1
  for (int tile = blockIdx.x; tile < 64 + 1024; tile += gridDim.x) {
    GEMM_LANE_VARS
    if (tile < 64) {
      const int ty = tile >> 5, mt = tile & 31;
      const int m0 = mt * 128;
      f32x4 acc[4][4];
      gemm_mainloop(tid, sA, sB, ACmp{p.proj, ty ? C_VC : C_KC}, p.w1T + (size_t)ty * 128 * 2048, 2048, m0, 0, 32, acc);
#pragma unroll
      for (int mi = 0; mi < 4; ++mi) {
        const int m = m0 + wm * 64 + 16 * mi + col;
#pragma unroll
        for (int ni = 0; ni < 4; ++ni) {
          const int n = wn * 64 + 16 * ni + 4 * quad;
          const f32x4 v = acc[ni][mi];
          const float4 bb = *(const float4*)(p.biasp + ty * 128 + n);
          uint2 pk;
          pk.x = pack2(gelu_tanh(v[0] + bb.x), gelu_tanh(v[1] + bb.y));
          pk.y = pack2(gelu_tanh(v[2] + bb.z), gelu_tanh(v[3] + bb.w));
          *(uint2*)(p.hdn + ((size_t)ty * 4096 + m) * 128 + n) = pk;
        }
      }
    } else {
      conv_tile(p, smem, tile - 64);
    }
  }
}

DEVI void phase3(const Params& p, unsigned char* smem) {
  u16* sA = (u16*)smem; u16* sB = sA + 128 * 72;
#pragma unroll 1
  for (int tile = blockIdx.x; tile < 64; tile += gridDim.x) {
    GEMM_LANE_VARS
    const int ty = tile >> 5, mt = tile & 31;
    const int m0 = mt * 128;
    f32x4 acc[4][4];
    gemm_mainloop(tid, sA, sB, ARow{p.hdn + (size_t)ty * 4096 * 128, 128}, p.w2T + (size_t)ty * 128 * 128, 128, m0, 0, 2, acc);
    if (wn == 0) {
#pragma unroll
      for (int mi = 0; mi < 4; ++mi) {
        const int m = m0 + 16 * mi + wm * 64 + col;
        const int bg = m >> 7, c = m & 127;
#pragma unroll
        for (int ni = 0; ni < 4; ++ni) {
          const int n = 16 * ni + 4 * quad;
          const f32x4 v = acc[ni][mi];
          const float4 bb = *(const float4*)(p.cmp_b2 + ty * 64 + n);
          const float o0 = v[0] + bb.x, o1 = v[1] + bb.y, o2 = v[2] + bb.z, o3 = v[3] + bb.w;
          if (ty == 0) {
            uint2 pk; pk.x = pack2(o0, o1); pk.y = pack2(o2, o3);
            *(uint2*)(p.kc + (size_t)m * 64 + n) = pk;
          } else {
            u16* dst = p.vcT + ((size_t)bg * 64 + n) * 128 + c;
            dst[0] = f2bf(o0); dst[128] = f2bf(o1); dst[256] = f2bf(o2); dst[384] = f2bf(o3);
          }
        }
      }
    }
  }
}

template <int DH, int NQ, int LDK, int LDV, class MaskF>
DEVI void attn_tile(const u16* sK, const u16* sVt, const bf16x8 (&qf)[NQ][DH / 32], f32x4 (&o)[NQ][DH / 16],
                    float (&m)[NQ], float (&l)[NQ], float c2, int lane, MaskF valid) {
  const int col = lane & 15, quad = lane >> 4;
  f32x4 s[NQ][4];
#pragma unroll
  for (int kt = 0; kt < 4; ++kt) {
#pragma unroll
    for (int qt = 0; qt < NQ; ++qt) s[qt][kt] = f32x4{0.f, 0.f, 0.f, 0.f};
#pragma unroll
    for (int ks = 0; ks < DH / 32; ++ks) {
      const bf16x8 kf = *(const bf16x8*)(sK + (16 * kt + col) * LDK + 32 * ks + 8 * quad);
#pragma unroll
      for (int qt = 0; qt < NQ; ++qt) s[qt][kt] = mfma16(kf, qf[qt][ks], s[qt][kt]);
    }
  }
  bf16x8 pb[NQ][2];
#pragma unroll
  for (int qt = 0; qt < NQ; ++qt) {
    float mx = -1e30f;
#pragma unroll
    for (int kt = 0; kt < 4; ++kt)
#pragma unroll
      for (int r = 0; r < 4; ++r) {
        const bool v = valid(qt, 16 * kt + 4 * quad + r);
        const float sv = v ? s[qt][kt][r] : -1e30f;
        s[qt][kt][r] = sv;
        mx = fmaxf(mx, sv);
      }
    mx = fmaxf(mx, __shfl_xor(mx, 16));
    mx = fmaxf(mx, __shfl_xor(mx, 32));
    const float mn = fmaxf(m[qt], mx);
    const float alpha = fexp2((m[qt] - mn) * c2);
    m[qt] = mn;
    float ps = 0.f;
#pragma unroll
    for (int kt = 0; kt < 4; ++kt)
#pragma unroll
      for (int r = 0; r < 4; ++r) {
        const float sv = s[qt][kt][r];
        const float pv = (sv > -1e29f) ? fexp2((sv - mn) * c2) : 0.f;
        ps += pv;
        s[qt][kt][r] = pv;
      }
    l[qt] = l[qt] * alpha + ps;
#pragma unroll
    for (int dt = 0; dt < DH / 16; ++dt) o[qt][dt] *= alpha;
#pragma unroll
    for (int kk = 0; kk < 2; ++kk) {
      union { bf16x8 v; unsigned u[4]; } cv;
      cv.u[0] = pack2(s[qt][2 * kk][0], s[qt][2 * kk][1]);
      cv.u[1] = pack2(s[qt][2 * kk][2], s[qt][2 * kk][3]);
      cv.u[2] = pack2(s[qt][2 * kk + 1][0], s[qt][2 * kk + 1][1]);
      cv.u[3] = pack2(s[qt][2 * kk + 1][2], s[qt][2 * kk + 1][3]);
      pb[qt][kk] = cv.v;
    }
  }
#pragma unroll
  for (int dt = 0; dt < DH / 16; ++dt) {
#pragma unroll
    for (int kk = 0; kk < 2; ++kk) {
      union { bf16x8 v; uint2 h[2]; } cv;
      cv.h[0] = *(const uint2*)(sVt + (16 * dt + col) * LDV + 32 * kk + 4 * quad);
      cv.h[1] = *(const uint2*)(sVt + (16 * dt + col) * LDV + 32 * kk + 16 + 4 * quad);
#pragma unroll
      for (int qt = 0; qt < NQ; ++qt) o[qt][dt] = mfma16(cv.v, pb[qt][kk], o[qt][dt]);
    }
  }
}

DEVI void phase_nsa(const Params& p, unsigned char* smem) {
  u16* sK = (u16*)smem;
  u16* sVt = (u16*)(smem + 18432);
  float* impH = (float*)(smem + 35840);
  float* impT = (float*)(smem + 52736);
  unsigned* selm = (unsigned*)(smem + 56960);
  const float c2 = 0.125f * 1.4426950408889634f;
#pragma unroll 1
  for (int tile = blockIdx.x; tile < 2048; tile += gridDim.x) {
    const int tid = launder(threadIdx.x), lane = tid & 63, w = tid >> 6, col = lane & 15, quad = lane >> 4;
    const int qtile = 63 - (tile >> 5), bg = tile & 31, b = bg >> 1, g = bg & 1, q0 = qtile * 32;
    const int h = g * 4 + w;
    __syncthreads();
    if (tid < 32) selm[tid] = 0u;
    {
      const u16* kcp = p.kc + (size_t)bg * 128 * 64;
      const u16* vcp = p.vcT + (size_t)bg * 64 * 128;
#pragma unroll
      for (int i = 0; i < 4; ++i) {
        const int c = tid + 256 * i;
        const int row = c >> 3, ch = (c & 7) << 3;
        *(uint4*)(sK + row * 72 + ch) = *(const uint4*)(kcp + row * 64 + ch);
        const int row2 = c >> 4, ch2 = (c & 15) << 3;
        *(uint4*)(sVt + row2 * 136 + ch2) = *(const uint4*)(vcp + row2 * 128 + ch2);
      }
    }
    bf16x8 qf[2][2];
    float gate[2][3];
    int tq[2];
#pragma unroll
    for (int qt = 0; qt < 2; ++qt) {
      const int t = q0 + 16 * qt + col;
      tq[qt] = t;
      const size_t tok = (size_t)b * T + t;
      const u16* qp = p.proj + tok * LDP + C_Q + h * 64 + 8 * quad;
      qf[qt][0] = *(const bf16x8*)qp;
      qf[qt][1] = *(const bf16x8*)(qp + 32);
#pragma unroll
      for (int br = 0; br < 3; ++br) gate[qt][br] = sigmoidf_(bf2f(p.proj[tok * LDP + C_GATE + h * 3 + br]));
    }
    __syncthreads();

    f32x4 comb[2][4];
    {
      const int srcl = (lane + 48) & 63;
#pragma unroll
      for (int qt = 0; qt < 2; ++qt) {
        f32x4 s[8];
#pragma unroll
        for (int kt = 0; kt < 8; ++kt) {
          s[kt] = f32x4{0.f, 0.f, 0.f, 0.f};
#pragma unroll
          for (int ks = 0; ks < 2; ++ks) {
            const bf16x8 kf = *(const bf16x8*)(sK + (16 * kt + col) * 72 + 32 * ks + 8 * quad);
            s[kt] = mfma16(kf, qf[qt][ks], s[kt]);
          }
        }
        const int t = tq[qt];
        float mx = -1e30f;
#pragma unroll
        for (int kt = 0; kt < 8; ++kt)
#pragma unroll
          for (int r = 0; r < 4; ++r) {
            const int c = 16 * kt + 4 * quad + r;
            const bool v = (16 * c + 31) <= t;
            const float sv = v ? s[kt][r] : -1e30f;
            s[kt][r] = sv;
            mx = fmaxf(mx, sv);
          }
        mx = fmaxf(mx, __shfl_xor(mx, 16));
        mx = fmaxf(mx, __shfl_xor(mx, 32));
        float ps = 0.f;
#pragma unroll
        for (int kt = 0; kt < 8; ++kt)
#pragma unroll
          for (int r = 0; r < 4; ++r) {
            const float sv = s[kt][r];
            const float pv = (sv > -1e29f) ? fexp2((sv - mx) * c2) : 0.f;
            ps += pv;
            s[kt][r] = pv;
          }
        ps += __shfl_xor(ps, 16);
        ps += __shfl_xor(ps, 32);
        const float inv = ps > 0.f ? 1.f / ps : 0.f;
#pragma unroll
        for (int kt = 0; kt < 8; ++kt)
#pragma unroll
          for (int r = 0; r < 4; ++r) s[kt][r] *= inv;
        float prev3 = 0.f;
#pragma unroll
        for (int kt = 0; kt < 8; ++kt) {
          const float sum4 = s[kt][0] + s[kt][1] + s[kt][2] + s[kt][3];
          const float xs = __shfl(s[kt][3], srcl);
          const float extra = quad ? xs : prev3;
          prev3 = xs;
          impH[(w * 32 + 16 * qt + col) * 33 + 4 * kt + quad] = sum4 + extra;
        }
        bf16x8 pb[4];
#pragma unroll
        for (int kk = 0; kk < 4; ++kk) {
          union { bf16x8 v; unsigned u[4]; } cv;
          cv.u[0] = pack2(s[2 * kk][0], s[2 * kk][1]);
          cv.u[1] = pack2(s[2 * kk][2], s[2 * kk][3]);
          cv.u[2] = pack2(s[2 * kk + 1][0], s[2 * kk + 1][1]);
          cv.u[3] = pack2(s[2 * kk + 1][2], s[2 * kk + 1][3]);
          pb[kk] = cv.v;
        }
#pragma unroll
        for (int dt = 0; dt < 4; ++dt) {
          f32x4 oc = f32x4{0.f, 0.f, 0.f, 0.f};
#pragma unroll
          for (int kk = 0; kk < 4; ++kk) {
            union { bf16x8 v; uint2 hh[2]; } cv;
            cv.hh[0] = *(const uint2*)(sVt + (16 * dt + col) * 136 + 32 * kk + 4 * quad);
            cv.hh[1] = *(const uint2*)(sVt + (16 * dt + col) * 136 + 32 * kk + 16 + 4 * quad);
            oc = mfma16(cv.v, pb[kk], oc);
          }
          comb[qt][dt] = oc * gate[qt][0];
        }
      }
    }
#pragma unroll
    for (int qt = 0; qt < 2; ++qt) {
      const size_t tok = (size_t)b * T + tq[qt];
      union { bf16x8 v; unsigned u[4]; } own, par, res;
      own.v = qf[qt][0];
#pragma unroll
      for (int j = 0; j < 4; ++j) par.u[j] = (unsigned)__shfl_xor((int)own.u[j], 16);
      const float4 c0 = *(const float4*)(p.rope + tok * 16), c1 = *(const float4*)(p.rope + tok * 16 + 4);
      const float4 s0 = *(const float4*)(p.rope + tok * 16 + 8), s1 = *(const float4*)(p.rope + tok * 16 + 12);
      const float cs[8] = {c0.x, c0.y, c0.z, c0.w, c1.x, c1.y, c1.z, c1.w};
      const float sn[8] = {s0.x, s0.y, s0.z, s0.w, s1.x, s1.y, s1.z, s1.w};
#pragma unroll
      for (int j = 0; j < 4; ++j) {
        const float o0 = __uint_as_float(own.u[j] << 16), o1 = __uint_as_float(own.u[j] & 0xffff0000u);
        const float p0 = __uint_as_float(par.u[j] << 16), p1 = __uint_as_float(par.u[j] & 0xffff0000u);
        const float sg = (quad == 0) ? -1.f : 1.f;
        const float r0 = o0 * cs[2 * j] + sg * p0 * sn[2 * j];
        const float r1 = o1 * cs[2 * j + 1] + sg * p1 * sn[2 * j + 1];
        res.u[j] = (quad < 2) ? pack2(r0, r1) : own.u[j];
      }
      qf[qt][0] = res.v;
    }
    __syncthreads();
#pragma unroll
    for (int i = 0; i < 4; ++i) {
      const int cell = tid + 256 * i;
      const int qi = cell >> 5, s_ = cell & 31;
      const int cur = (q0 + qi) >> 6;
      float v = impH[(0 * 32 + qi) * 33 + s_] + impH[(1 * 32 + qi) * 33 + s_] + impH[(2 * 32 + qi) * 33 + s_] +
                impH[(3 * 32 + qi) * 33 + s_];
      const int dist = cur - s_;
      const bool forced = (s_ == 0) || (dist >= 0 && dist < 2);
      v = forced ? 1e9f : (s_ <= cur ? v : -1.f);
      impT[qi * 33 + s_] = v;
    }
    __syncthreads();
    {
      const int qi = tid >> 3, sub = tid & 7;
      unsigned bits = 0u;
#pragma unroll
      for (int k = 0; k < 4; ++k) {
        const int s_ = sub * 4 + k;
        const float v = impT[qi * 33 + s_];
        int rank = 0;
        for (int s2 = 0; s2 < 32; ++s2) {
          const float v2 = impT[qi * 33 + s2];
          rank += ((v2 > v) || (v2 == v && s2 < s_)) ? 1 : 0;
        }
        if (rank < 16) bits |= 1u << s_;
      }
      atomicOr(&selm[qi], bits);
    }
    __syncthreads();
    unsigned sm[2] = {selm[col], selm[16 + col]};
    unsigned uni = 0u;
#pragma unroll
    for (int i = 0; i < 32; ++i) uni |= selm[i];
    const int kbmax = (q0 + 31) >> 6;
    {
      float m[2] = {-1e30f, -1e30f}, l[2] = {0.f, 0.f};
      f32x4 o[2][4];
#pragma unroll
      for (int qt = 0; qt < 2; ++qt)
#pragma unroll
        for (int dt = 0; dt < 4; ++dt) o[qt][dt] = f32x4{0.f, 0.f, 0.f, 0.f};
#pragma unroll 1
      for (int kb = 0; kb <= kbmax; ++kb) {
        if (!((uni >> kb) & 1u)) continue;
        __syncthreads();
#pragma unroll
        for (int i = 0; i < 2; ++i) {
          const int c = tid + 256 * i, row = c >> 3, ch = (c & 7) << 3;
          *(uint4*)(sK + row * 72 + ch) = *(const uint4*)(p.proj + ((size_t)b * T + kb * 64 + row) * LDP + C_KS + g * 64 + ch);
          *(uint4*)(sVt + row * 72 + ch) = *(const uint4*)(p.vts + ((size_t)bg * 64 + row) * T + kb * 64 + ch);
        }
        __syncthreads();
        attn_tile<64, 2, 72, 72>(sK, sVt, qf, o, m, l, c2, lane, [&](int qt, int kl) {
          const int kp = kb * 64 + kl;
          return (((sm[qt] >> kb) & 1u) != 0u) && (kp <= tq[qt]);
        });
      }
#pragma unroll
      for (int qt = 0; qt < 2; ++qt) {
        float lt = l[qt];
        lt += __shfl_xor(lt, 16);
        lt += __shfl_xor(lt, 32);
        const float sc = lt > 0.f ? gate[qt][1] / lt : 0.f;
#pragma unroll
        for (int dt = 0; dt < 4; ++dt) comb[qt][dt] += o[qt][dt] * sc;
      }
    }
    {
      float m[2] = {-1e30f, -1e30f}, l[2] = {0.f, 0.f};
      f32x4 o[2][4];
#pragma unroll
      for (int qt = 0; qt < 2; ++qt)
#pragma unroll
        for (int dt = 0; dt < 4; ++dt) o[qt][dt] = f32x4{0.f, 0.f, 0.f, 0.f};
      const int kblo = (q0 >= 511) ? ((q0 - 511) >> 6) : 0;
#pragma unroll 1
      for (int kb = kblo; kb <= kbmax; ++kb) {
        __syncthreads();
#pragma unroll
        for (int i = 0; i < 2; ++i) {
          const int c = tid + 256 * i, row = c >> 3, ch = (c & 7) << 3;
          *(uint4*)(sK + row * 72 + ch) = *(const uint4*)(p.proj + ((size_t)b * T + kb * 64 + row) * LDP + C_KW + g * 64 + ch);
          *(uint4*)(sVt + row * 72 + ch) = *(const uint4*)(p.vtw + ((size_t)bg * 64 + row) * T + kb * 64 + ch);
        }
        __syncthreads();
        attn_tile<64, 2, 72, 72>(sK, sVt, qf, o, m, l, c2, lane, [&](int qt, int kl) {
          const int kp = kb * 64 + kl;
          return (kp <= tq[qt]) && (kp > tq[qt] - 512);
        });
      }
#pragma unroll
      for (int qt = 0; qt < 2; ++qt) {
        float lt = l[qt];
        lt += __shfl_xor(lt, 16);
        lt += __shfl_xor(lt, 32);
        const float sc = lt > 0.f ? gate[qt][2] / lt : 0.f;
#pragma unroll
        for (int dt = 0; dt < 4; ++dt) comb[qt][dt] += o[qt][dt] * sc;
      }
    }
#pragma unroll
    for (int qt = 0; qt < 2; ++qt) {
      const size_t tok = (size_t)b * T + tq[qt];
#pragma unroll
      for (int dt = 0; dt < 4; ++dt) {
        uint2 pk;
        pk.x = pack2(comb[qt][dt][0], comb[qt][dt][1]);
        pk.y = pack2(comb[qt][dt][2], comb[qt][dt][3]);
        *(uint2*)(p.mix + tok * D + 512 + h * 64 + 16 * dt + 4 * quad) = pk;
      }
    }
  }
}

DEVI void phase_resid(const Params& p, unsigned char* smem, const u16* A, const u16* Wt, const float* res, float* ssq) {
  u16* sA = (u16*)smem; u16* sB = sA + 128 * 72;
#pragma unroll 1
  for (int tile = blockIdx.x; tile < 256 * 8; tile += gridDim.x) {
    GEMM_LANE_VARS
    const int mt = tile >> 3, nt_ = tile & 7;
    const int m0 = mt * 128, n0 = nt_ * 128;
    f32x4 acc[4][4];
    gemm_mainloop(tid, sA, sB, ARow{A, D}, Wt, D, m0, n0, 16, acc);
#pragma unroll
    for (int mi = 0; mi < 4; ++mi) {
      const int m = m0 + wm * 64 + 16 * mi + col;
      float ss = 0.f;
#pragma unroll
      for (int ni = 0; ni < 4; ++ni) {
        const int n = n0 + wn * 64 + 16 * ni + 4 * quad;
        const f32x4 v = acc[ni][mi];
        const float4 r = *(const float4*)(res + (size_t)m * D + n);
        float4 hv;
        hv.x = r.x + v[0]; hv.y = r.y + v[1]; hv.z = r.z + v[2]; hv.w = r.w + v[3];
        ss += hv.x * hv.x + hv.y * hv.y + hv.z * hv.z + hv.w * hv.w;
        *(float4*)(p.h + (size_t)m * D + n) = hv;
        uint2 pk; pk.x = pack2(hv.x, hv.y); pk.y = pack2(hv.z, hv.w);
        *(uint2*)(p.hn + (size_t)m * D + n) = pk;
      }
      ss += __shfl_xor(ss, 16);
      ss += __shfl_xor(ss, 32);
      if (quad == 0) atomicAdd(ssq + m, ss);
    }
  }
}

DEVI void phase_scaled(const Params& p, unsigned char* smem, const u16* A, const u16* Wt, int ntn, const float* ssq, u16* outp, int ldo) {
  u16* sA = (u16*)smem; u16* sB = sA + 128 * 72;
#pragma unroll 1
  for (int tile = blockIdx.x; tile < 256 * ntn; tile += gridDim.x) {
    GEMM_LANE_VARS
    const int mt = tile / ntn, nt_ = tile % ntn;
    const int m0 = mt * 128, n0 = nt_ * 128;
    f32x4 acc[4][4];
    gemm_mainloop(tid, sA, sB, ARow{A, D}, Wt, D, m0, n0, 16, acc);
#pragma unroll
    for (int mi = 0; mi < 4; ++mi) {
      const int m = m0 + wm * 64 + 16 * mi + col;
      const float rstd = rsqrtf(ssq[m] * (1.f / D) + 1e-6f);
#pragma unroll
      for (int ni = 0; ni < 4; ++ni) {
        const int n = n0 + wn * 64 + 16 * ni + 4 * quad;
        const f32x4 v = acc[ni][mi];
        uint2 pk; pk.x = pack2(v[0] * rstd, v[1] * rstd); pk.y = pack2(v[2] * rstd, v[3] * rstd);
        *(uint2*)(outp + (size_t)m * ldo + n) = pk;
      }
    }
  }
}

DEVI void phase_memattn(const Params& p, unsigned char* smem) {
  u16* sK = (u16*)smem;
  u16* sVt = (u16*)(smem + 33792);
  const float c2 = 0.0625f * 1.4426950408889634f;
#pragma unroll 1
  for (int tile = blockIdx.x; tile < 2048; tile += gridDim.x) {
    const int tid = launder(threadIdx.x), lane = tid & 63, w = tid >> 6, col = lane & 15, quad = lane >> 4;
    const int b = tile >> 7, head = (tile >> 5) & 3, q0 = (tile & 31) * 64;
    const size_t tok = (size_t)b * T + q0 + 16 * w + col;
    bf16x8 qf[1][8];
#pragma unroll
    for (int ks = 0; ks < 8; ++ks) qf[0][ks] = *(const bf16x8*)(p.qm + tok * D + head * 256 + 32 * ks + 8 * quad);
    float m[1] = {-1e30f}, l[1] = {0.f};
    f32x4 o[1][16];
#pragma unroll
    for (int dt = 0; dt < 16; ++dt) o[0][dt] = f32x4{0.f, 0.f, 0.f, 0.f};
#pragma unroll 1
    for (int kb = 0; kb < 4; ++kb) {
      __syncthreads();
#pragma unroll
      for (int i = 0; i < 8; ++i) {
        const int c = tid + 256 * i;
        const int row = c >> 5, ch = (c & 31) << 3;
        *(uint4*)(sK + row * 264 + ch) = *(const uint4*)(p.memk + ((size_t)b * 256 + kb * 64 + row) * D + head * 256 + ch);
      }
      __builtin_amdgcn_sched_barrier(0);
#pragma unroll
      for (int i = 0; i < 8; ++i) {
        const int c = tid + 256 * i;
        const int row2 = c >> 3, ch2 = (c & 7) << 3;
        *(uint4*)(sVt + row2 * 72 + ch2) = *(const uint4*)(p.memvt + ((size_t)(b * 4 + head) * 256 + row2) * 256 + kb * 64 + ch2);
      }
      __syncthreads();
      attn_tile<256, 1, 264, 72>(sK, sVt, qf, o, m, l, c2, lane, [&](int, int) { return true; });
    }
    float lt = l[0];
    lt += __shfl_xor(lt, 16);
    lt += __shfl_xor(lt, 32);
    const float inv = 1.f / lt;
#pragma unroll
    for (int dt = 0; dt < 16; ++dt) {
      uint2 pk;
      pk.x = pack2(o[0][dt][0] * inv, o[0][dt][1] * inv);
      pk.y = pack2(o[0][dt][2] * inv, o[0][dt][3] * inv);
      *(uint2*)(p.mix + tok * D + head * 256 + 16 * dt + 4 * quad) = pk;
    }
  }
}

__constant__ unsigned char kCandI[64] = {0,0,0,0,0,0,0,0,0,0,0,0,0,0,0,0, 1,1,1,1,1,1,1,1, 2,2,2,2,2, 3,3,3,3, 4,4,4, 5,5, 6,6, 7,7,
                                          8, 9, 10, 11, 12, 13, 14, 15, 0,0,0,0,0,0,0,0,0,0,0,0,0,0};
__constant__ unsigned char kCandJ[64] = {0,1,2,3,4,5,6,7,8,9,10,11,12,13,14,15, 0,1,2,3,4,5,6,7, 0,1,2,3,4, 0,1,2,3, 0,1,2, 0,1, 0,1, 0,1,
                                          0, 0, 0, 0, 0, 0, 0, 0, 0,0,0,0,0,0,0,0,0,0,0,0,0,0};

DEVI unsigned score_key(float v, int idx) {
  unsigned u = __float_as_uint(v);
  u = (u & 0x80000000u) ? ~u : (u | 0x80000000u);
  return (u & ~127u) | (unsigned)(127 - idx);
}
DEVI float key_score(unsigned k) {
  k &= ~127u;
  const unsigned u = (k & 0x80000000u) ? (k & 0x7fffffffu) : ~k;
  return __uint_as_float(u);
}

DEVI void phase_peer_route(const Params& p, unsigned char* smem) {
  u16* sA = (u16*)smem; u16* sB = sA + 128 * 72;
  unsigned* sScore = (unsigned*)smem;
  unsigned* sTop = (unsigned*)(smem + 36864);
  {
    const size_t gtid = (size_t)blockIdx.x * 256 + launder(threadIdx.x), gsz = (size_t)gridDim.x * 256;
    conv_flat(p.peer_u, p.ub, (size_t)16384 * 1024 / 8, gtid, gsz);
    conv_flat(p.peer_v, p.vb, (size_t)16384 * 1024 / 8, gtid, gsz);
  }
#pragma unroll 1
  for (int tile = blockIdx.x; tile < 256 * 8; tile += gridDim.x) {
    GEMM_LANE_VARS
    const int mt = tile >> 3, hd = tile & 7;
    const int m0 = mt * 128;
#pragma unroll 1
    for (int ph = 0; ph < 2; ++ph) {
      const int hp = hd * 2 + ph;
      f32x4 acc[4][4];
      __syncthreads();
      gemm_mainloop(tid, sA, sB, ARow{p.pq + hp * 128, 2048}, p.subk + (size_t)hp * 128 * 128, 128, m0, 0, 2, acc);
#pragma unroll 1
      for (int hh = 0; hh < 2; ++hh) {
        if (wm == hh) {
#pragma unroll
          for (int mi = 0; mi < 4; ++mi) {
            const int row = 16 * mi + col;
#pragma unroll
            for (int ni = 0; ni < 4; ++ni) {
              const int n = wn * 64 + 16 * ni + 4 * quad;
              const f32x4 v = acc[ni][mi];
              uint4 kk;
              kk.x = score_key(v[0], n); kk.y = score_key(v[1], n + 1);
              kk.z = score_key(v[2], n + 2); kk.w = score_key(v[3], n + 3);
              *(uint4*)(sScore + row * 128 + n) = kk;
            }
          }
        }
        __syncthreads();
#pragma unroll 1
        for (int rr = 0; rr < 16; ++rr) {
          const int row = w * 16 + rr;
          const unsigned k0 = sScore[row * 128 + lane], k1 = sScore[row * 128 + 64 + lane];
          int r0 = 0, r1 = 0;
#pragma unroll 4
          for (int j = 0; j < 32; ++j) {
            const uint4 kk = *(const uint4*)(sScore + row * 128 + 4 * j);
            r0 += (kk.x > k0) + (kk.y > k0) + (kk.z > k0) + (kk.w > k0);
            r1 += (kk.x > k1) + (kk.y > k1) + (kk.z > k1) + (kk.w > k1);
          }
          if (r0 < 16) sTop[((hh * 64 + row) * 2 + ph) * 16 + r0] = k0;
          if (r1 < 16) sTop[((hh * 64 + row) * 2 + ph) * 16 + r1] = k1;
        }
        __syncthreads();
      }
    }
    const int ci = kCandI[lane], cj = kCandJ[lane];
#pragma unroll 1
    for (int tt = 0; tt < 32; ++tt) {
      const int trow = w * 32 + tt;
      const unsigned k0 = sTop[(trow * 2 + 0) * 16 + ci], k1 = sTop[(trow * 2 + 1) * 16 + cj];
      const bool act = lane < 50;
      const float v = act ? (key_score(k0) + key_score(k1)) : -3.0e38f;
      int rank = 0;
#pragma unroll
      for (int c = 0; c < 50; ++c) {
        const float v2 = __int_as_float(__builtin_amdgcn_readlane(__float_as_int(v), c));
        rank += ((v2 > v) || (v2 == v && c < lane)) ? 1 : 0;
      }
      const bool sel = act && rank < 16;
      const unsigned long long bal = __ballot(sel && rank == 0);
      const int srcl = (int)__ffsll((long long)bal) - 1;
      const float vmax = __shfl(v, srcl < 0 ? 0 : srcl);
      const float e = sel ? __expf(v - vmax) : 0.f;
      const float tot = wave_sum(e);
      if (sel) {
        const int eid = (127 - (int)(k0 & 127u)) * 128 + (127 - (int)(k1 & 127u));
        const size_t o = (size_t)(m0 + trow) * 128 + hd * 16 + rank;
        p.experts[o] = eid;
        p.gates[o] = e / tot;
      }
    }
  }
}

DEVI void phase_peer_gather(const Params& p) {
  const uint4* ub = (const uint4*)p.ub;
  const uint4* vb = (const uint4*)p.vb;
  const int w0_ = threadIdx.x >> 6;
#pragma unroll 1
  for (int tok = blockIdx.x * 4 + w0_; tok < NTOK; tok += gridDim.x * 4) {
    const int tid = launder(threadIdx.x), lane = tid & 63;
    const float4* hp4 = (const float4*)(p.h + (size_t)tok * D);
    float hv[16], xn[16], y[16];
    {
      const float4 a0 = hp4[2 * lane], a1 = hp4[2 * lane + 1], a2 = hp4[128 + 2 * lane], a3 = hp4[128 + 2 * lane + 1];
      hv[0] = a0.x; hv[1] = a0.y; hv[2] = a0.z; hv[3] = a0.w; hv[4] = a1.x; hv[5] = a1.y; hv[6] = a1.z; hv[7] = a1.w;
      hv[8] = a2.x; hv[9] = a2.y; hv[10] = a2.z; hv[11] = a2.w; hv[12] = a3.x; hv[13] = a3.y; hv[14] = a3.z; hv[15] = a3.w;
    }
    float ss = 0.f;
#pragma unroll
    for (int i = 0; i < 16; ++i) ss += hv[i] * hv[i];
    ss = wave_sum(ss);
    const float rstd = rsqrtf(ss * (1.f / D) + 1e-6f);
    {
      const float4* g4 = (const float4*)p.peer_g;
      const float4 a0 = g4[2 * lane], a1 = g4[2 * lane + 1], a2 = g4[128 + 2 * lane], a3 = g4[128 + 2 * lane + 1];
      const float gg[16] = {a0.x, a0.y, a0.z, a0.w, a1.x, a1.y, a1.z, a1.w, a2.x, a2.y, a2.z, a2.w, a3.x, a3.y, a3.z, a3.w};
#pragma unroll
      for (int i = 0; i < 16; ++i) { xn[i] = hv[i] * rstd * gg[i]; y[i] = 0.f; }
    }
    const int e0 = p.experts[(size_t)tok * 128 + lane], e1 = p.experts[(size_t)tok * 128 + 64 + lane];
    const float g0 = p.gates[(size_t)tok * 128 + lane], g1 = p.gates[(size_t)tok * 128 + 64 + lane];
    float cf0 = 0.f, cf1 = 0.f;
#pragma unroll
    for (int half = 0; half < 2; ++half) {
      const int ev = half ? e1 : e0;
      float cf = 0.f;
      for (int k = 0; k < 64; k += 4) {
        uint4 c0[4], c1[4];
#pragma unroll
        for (int u = 0; u < 4; ++u) {
          const int e = __builtin_amdgcn_readlane(ev, k + u);
          c0[u] = ub[(size_t)e * 128 + lane];
          c1[u] = ub[(size_t)e * 128 + 64 + lane];
        }
#pragma unroll
        for (int u = 0; u < 4; ++u) {
          const unsigned uu[8] = {c0[u].x, c0[u].y, c0[u].z, c0[u].w, c1[u].x, c1[u].y, c1[u].z, c1[u].w};
          float d = 0.f;
#pragma unroll
          for (int j = 0; j < 8; ++j) {
            d += xn[2 * j] * __uint_as_float(uu[j] << 16);
            d += xn[2 * j + 1] * __uint_as_float(uu[j] & 0xffff0000u);
          }
          d = wave_sum(d);
          const float a = gelu_tanh(d);
          if (lane == k + u) cf = a;
        }
      }
      if (half) cf1 = cf * g1; else cf0 = cf * g0;
    }
#pragma unroll
    for (int half = 0; half < 2; ++half) {
      const int ev = half ? e1 : e0;
      const float cfv = half ? cf1 : cf0;
      for (int k = 0; k < 64; k += 4) {
        uint4 c0[4], c1[4];
        float ck[4];
#pragma unroll
        for (int u = 0; u < 4; ++u) {
          const int e = __builtin_amdgcn_readlane(ev, k + u);
          ck[u] = __int_as_float(__builtin_amdgcn_readlane(__float_as_int(cfv), k + u));
          c0[u] = vb[(size_t)e * 128 + lane];
          c1[u] = vb[(size_t)e * 128 + 64 + lane];
        }
#pragma unroll
        for (int u = 0; u < 4; ++u) {
          const unsigned uu[8] = {c0[u].x, c0[u].y, c0[u].z, c0[u].w, c1[u].x, c1[u].y, c1[u].z, c1[u].w};
#pragma unroll
          for (int j = 0; j < 8; ++j) {
            y[2 * j] += ck[u] * __uint_as_float(uu[j] << 16);
            y[2 * j + 1] += ck[u] * __uint_as_float(uu[j] & 0xffff0000u);
          }
        }
      }
    }
    float s2 = 0.f;
#pragma unroll
    for (int i = 0; i < 16; ++i) { y[i] += hv[i]; s2 += y[i] * y[i]; }
    s2 = wave_sum(s2);
    const float rs2 = rsqrtf(s2 * (1.f / D) + 1e-6f);
    {
      const float4* g4 = (const float4*)p.final_g;
      const float4 a0 = g4[2 * lane], a1 = g4[2 * lane + 1], a2 = g4[128 + 2 * lane], a3 = g4[128 + 2 * lane + 1];
      float4* o4 = (float4*)(p.out + (size_t)tok * D);
      o4[2 * lane] = make_float4(y[0] * rs2 * a0.x, y[1] * rs2 * a0.y, y[2] * rs2 * a0.z, y[3] * rs2 * a0.w);
      o4[2 * lane + 1] = make_float4(y[4] * rs2 * a1.x, y[5] * rs2 * a1.y, y[6] * rs2 * a1.z, y[7] * rs2 * a1.w);
      o4[128 + 2 * lane] = make_float4(y[8] * rs2 * a2.x, y[9] * rs2 * a2.y, y[10] * rs2 * a2.z, y[11] * rs2 * a2.w);
      o4[128 + 2 * lane + 1] = make_float4(y[12] * rs2 * a3.x, y[13] * rs2 * a3.y, y[14] * rs2 * a3.z, y[15] * rs2 * a3.w);
    }
  }
}

template <bool COOP>
__global__ void __launch_bounds__(256, 2) mega(Params p, int ph_lo, int ph_hi) {
  __shared__ __attribute__((aligned(16))) unsigned char smem[SMEM_BYTES];
#ifdef REPEAT_MASK
  bool rep_done = false;
#endif
  for (int ph = ph_lo; ph <= ph_hi; ++ph) {
    switch (ph) {
      case 0: phase0(p); break;
      case 1: phase1(p, smem); break;
      case 2: phase2(p, smem); break;
      case 3: phase3(p, smem); break;
      case 4: phase_nsa(p, smem); break;
      case 5: phase_resid(p, smem, p.mix, p.woutT, p.x, p.ssq1); break;
      case 6: phase_scaled(p, smem, p.hn, p.wmqT, 8, p.ssq1, p.qm, D); break;
      case 7: phase_memattn(p, smem); break;
      case 8: phase_resid(p, smem, p.mix, p.wmoT, p.h, p.ssq2); break;
      case 9: phase_scaled(p, smem, p.hn, p.wpqT, 16, p.ssq2, p.pq, 2048); break;
      case 10: phase_peer_route(p, smem); break;
      case 11: phase_peer_gather(p); break;
    }
#ifdef REPEAT_MASK
    if (COOP && ((REPEAT_MASK >> ph) & 1) && !rep_done) { rep_done = true; cg::this_grid().sync(); --ph; continue; }
    rep_done = false;
#endif
    if (COOP) {
      if (ph < ph_hi) cg::this_grid().sync();
    }
  }
}

extern "C" void kernel_launch(void* const* d_in, const int* in_sizes, int n_in, void* d_out, int out_size, void* d_ws,
                              size_t ws_size, hipStream_t stream) {
  (void)in_sizes; (void)n_in; (void)out_size; (void)ws_size;
  Params p{};
  p.x = (const float*)d_in[0]; p.mem = (const float*)d_in[1]; p.pos = (const int*)d_in[2];
  p.mix_g = (const float*)d_in[3]; p.w_in = (const float*)d_in[4]; p.conv_w = (const float*)d_in[5];
  p.conv_b = (const float*)d_in[6]; p.ln_g = (const float*)d_in[7]; p.ln_b = (const float*)d_in[8];
  p.cmp_pos = (const float*)d_in[9]; p.cmp_w1 = (const float*)d_in[10]; p.cmp_b1 = (const float*)d_in[11];
  p.cmp_w2 = (const float*)d_in[12]; p.cmp_b2 = (const float*)d_in[13]; p.w_out = (const float*)d_in[14];
  p.memq_g = (const float*)d_in[15]; p.memkv_g = (const float*)d_in[16]; p.w_mq = (const float*)d_in[17];
  p.w_mk = (const float*)d_in[18]; p.w_mv = (const float*)d_in[19]; p.w_mo = (const float*)d_in[20];
  p.peer_g = (const float*)d_in[21]; p.peer_wq = (const float*)d_in[22]; p.peer_sk = (const float*)d_in[23];
  p.peer_u = (const float*)d_in[24]; p.peer_v = (const float*)d_in[25]; p.final_g = (const float*)d_in[26];
  p.out = (float*)d_out;
  unsigned char* ws = (unsigned char*)d_ws;
  size_t off = 0;
  auto take = [&](size_t bytes) { unsigned char* r = ws + off; off += (bytes + 255) & ~(size_t)255; return r; };
  unsigned char* regA = take((size_t)NTOK * D * 2);
  unsigned char* regB = take((size_t)NTOK * LDP * 2);
  unsigned char* regC = take((size_t)NTOK * D * 2);
  p.hn = (u16*)regA; p.ub = (u16*)regA; p.vb = (u16*)(regA + (size_t)16384 * 1024 * 2);
  p.proj = (u16*)regB; p.qm = (u16*)regB; p.pq = (u16*)regB;
  p.mix = (u16*)regC; p.experts = (int*)regC; p.gates = (float*)(regC + (size_t)NTOK * 128 * 4);
  p.h = (float*)take((size_t)NTOK * D * 4);
  p.vts = (u16*)take((size_t)Bn * 2 * 64 * T * 2);
  p.vtw = (u16*)take((size_t)Bn * 2 * 64 * T * 2);
  p.memn = (u16*)take((size_t)Bn * 256 * D * 2);
  p.memk = (u16*)take((size_t)Bn * 256 * D * 2);
  p.memvt = (u16*)take((size_t)Bn * 256 * D * 2);
  p.winT = (u16*)take((size_t)2432 * 1024 * 2);
  p.woutT = (u16*)take((size_t)1024 * 1024 * 2);
  p.wmqT = (u16*)take((size_t)1024 * 1024 * 2);
  p.wmkT = (u16*)take((size_t)1024 * 1024 * 2);
  p.wmvT = (u16*)take((size_t)1024 * 1024 * 2);
  p.wmoT = (u16*)take((size_t)1024 * 1024 * 2);
  p.wpqT = (u16*)take((size_t)2048 * 1024 * 2);
  p.subk = (u16*)take((size_t)16 * 128 * 128 * 2);
  p.w1T = (u16*)take((size_t)2 * 128 * 2048 * 2);
  p.w2T = (u16*)take((size_t)2 * 128 * 128 * 2);
  p.biasp = (float*)take(256 * 4);
  p.rope = (float*)take((size_t)NTOK * 16 * 4);
  p.hdn = (u16*)take((size_t)2 * 4096 * 128 * 2);
  p.kc = (u16*)take((size_t)Bn * 2 * 128 * 64 * 2);
  p.vcT = (u16*)take((size_t)Bn * 2 * 64 * 128 * 2);
  p.ssq1 = (float*)take((size_t)NTOK * 4);
  p.ssq2 = (float*)take((size_t)NTOK * 4);
  if (off > ws_size) { fprintf(stderr, "workspace too small: need %zu have %zu\n", off, ws_size); return; }

#if COOP_MODE
  static int grid_blocks = 0;
  if (!grid_blocks) {
    int dev = 0, cus = 0, per_cu = 0;
    hipGetDevice(&dev);
    hipDeviceGetAttribute(&cus, hipDeviceAttributeMultiprocessorCount, dev);
    hipOccupancyMaxActiveBlocksPerMultiprocessor(&per_cu, mega<true>, 256, 0);
    if (per_cu > 2) per_cu = 2;
    if (per_cu < 1) per_cu = 1;
    grid_blocks = cus * per_cu;
  }
  int lo = 0, hi = NPHASE;
  void* args[] = {&p, &lo, &hi};
  hipError_t e = hipLaunchCooperativeKernel((void*)mega<true>, dim3(grid_blocks), dim3(256), args, 0, stream);
  if (e != hipSuccess) fprintf(stderr, "cooperative launch failed: %s (grid %d)\n", hipGetErrorString(e), grid_blocks);
#else
  for (int ph = 0; ph <= NPHASE; ++ph) mega<false><<<dim3(512), dim3(256), 0, stream>>>(p, ph, ph);
#endif
}
```

```cpp
#include <hip/hip_runtime.h>
#include <hip/hip_bf16.h>
#include <hip/hip_cooperative_groups.h>
#include <cstdio>
#include <cstdint>
namespace cg = cooperative_groups;

#ifndef COOP_MODE
#define COOP_MODE 1
#endif

typedef __attribute__((ext_vector_type(8))) short bf16x8;
typedef __attribute__((ext_vector_type(4))) short bf16x4;
typedef __attribute__((ext_vector_type(4))) float f32x4;
typedef unsigned short u16;

#define DEVI __device__ __forceinline__

constexpr int Bn = 16, T = 2048, D = 1024, NTOK = Bn * T, LDP = 2336;
constexpr int C_Q = 1024, C_KC = 1536, C_VC = 1664, C_KS = 1792, C_VS = 1920, C_KW = 2048, C_VW = 2176, C_GATE = 2304;
constexpr int SMEM_BYTES = 73728;
constexpr int NPHASE = 11;

struct Params {
  const float* x; const float* mem; const int* pos; const float* mix_g; const float* w_in;
  const float* conv_w; const float* conv_b; const float* ln_g; const float* ln_b;
  const float* cmp_pos; const float* cmp_w1; const float* cmp_b1; const float* cmp_w2; const float* cmp_b2;
  const float* w_out; const float* memq_g; const float* memkv_g; const float* w_mq; const float* w_mk;
  const float* w_mv; const float* w_mo; const float* peer_g; const float* peer_wq; const float* peer_sk;
  const float* peer_u; const float* peer_v; const float* final_g;
  float* out;
  u16* hn; u16* proj; u16* mix; float* h; u16* vts; u16* vtw; u16* memn; u16* memk; u16* memvt;
  u16* winT; u16* woutT; u16* wmqT; u16* wmkT; u16* wmvT; u16* wmoT; u16* wpqT; u16* subk; u16* w1T; u16* w2T;
  float* biasp; float* rope; u16* hdn; u16* kc; u16* vcT; float* ssq1; float* ssq2;
  int* experts; float* gates; unsigned char* ub8; unsigned char* vb8; float* uscale; float* vscale; u16* qm; u16* pq;
};

DEVI int launder(int x) { asm volatile("" : "+v"(x)); return x; }
DEVI u16 f2bf(float f) {
  unsigned u = __float_as_uint(f);
  u += 0x7fffu + ((u >> 16) & 1u);
  return (u16)(u >> 16);
}
DEVI float bf2f(u16 h) { return __uint_as_float(((unsigned)h) << 16); }
DEVI unsigned pack2(float a, float b) { return (unsigned)f2bf(a) | ((unsigned)f2bf(b) << 16); }
DEVI float wave_sum(float v) {
#pragma unroll
  for (int o = 32; o; o >>= 1) v += __shfl_xor(v, o);
  return v;
}
DEVI float sigmoidf_(float x) { return 1.f / (1.f + __expf(-x)); }
DEVI float gelu_tanh(float x) {
  float u = 0.7978845608028654f * (x + 0.044715f * x * x * x);
  return 0.5f * x * (1.f + tanhf(u));
}
DEVI f32x4 mfma16(bf16x8 a, bf16x8 b, f32x4 c) { return __builtin_amdgcn_mfma_f32_16x16x32_bf16(a, b, c, 0, 0, 0); }
DEVI float fexp2(float x) { return __builtin_amdgcn_exp2f(x); }

DEVI void tconv(const float* __restrict__ src, int K, int N, u16* __restrict__ dst, int Npad,
                const float* __restrict__ gain, int gtid, int gsz) {
  const int items = Npad * (K >> 3);
  for (int it = gtid; it < items; it += gsz) {
    const int n = it % Npad, kc = it / Npad;
    float f[8];
#pragma unroll
    for (int j = 0; j < 8; ++j) {
      float v = 0.f;
      if (n < N) {
        v = src[(size_t)(kc * 8 + j) * N + n];
        if (gain) v *= gain[kc * 8 + j];
      }
      f[j] = v;
    }
    uint4 pk;
    pk.x = pack2(f[0], f[1]); pk.y = pack2(f[2], f[3]); pk.z = pack2(f[4], f[5]); pk.w = pack2(f[6], f[7]);
    *(uint4*)(dst + (size_t)n * K + kc * 8) = pk;
  }
}

DEVI void conv_flat(const float* __restrict__ src, u16* __restrict__ dst, size_t n8, size_t gtid, size_t gsz) {
  for (size_t it = gtid; it < n8; it += gsz) {
    const float4 a = ((const float4*)src)[2 * it], b = ((const float4*)src)[2 * it + 1];
    uint4 pk;
    pk.x = pack2(a.x, a.y); pk.y = pack2(a.z, a.w); pk.z = pack2(b.x, b.y); pk.w = pack2(b.z, b.w);
    ((uint4*)dst)[it] = pk;
  }
}


typedef float f32x2 __attribute__((ext_vector_type(2)));
DEVI unsigned pk4_fp8(float a, float b, float c, float d) {
  int v = 0;
  v = __builtin_amdgcn_cvt_pk_fp8_f32(a, b, v, false);
  v = __builtin_amdgcn_cvt_pk_fp8_f32(c, d, v, true);
  return (unsigned)v;
}
DEVI void conv_fp8_rows(const float* __restrict__ src, unsigned char* __restrict__ dst, float* __restrict__ inv_scale,
                        int rows, int gw, int nw, int lane) {
  for (int r = gw; r < rows; r += nw) {
    const float4* p4 = (const float4*)(src + (size_t)r * 1024) + lane * 4;
    const float4 a = p4[0], b = p4[1], c = p4[2], d = p4[3];
    float mx = fmaxf(fmaxf(fmaxf(fabsf(a.x), fabsf(a.y)), fmaxf(fabsf(a.z), fabsf(a.w))),
                     fmaxf(fmaxf(fabsf(b.x), fabsf(b.y)), fmaxf(fabsf(b.z), fabsf(b.w))));
    mx = fmaxf(mx, fmaxf(fmaxf(fmaxf(fabsf(c.x), fabsf(c.y)), fmaxf(fabsf(c.z), fabsf(c.w))),
                         fmaxf(fmaxf(fabsf(d.x), fabsf(d.y)), fmaxf(fabsf(d.z), fabsf(d.w)))));
#pragma unroll
    for (int o = 32; o; o >>= 1) mx = fmaxf(mx, __shfl_xor(mx, o));
    const float sc = mx > 0.f ? 224.f / mx : 1.f;
    if (lane == 0) inv_scale[r] = mx > 0.f ? mx * (1.f / 224.f) : 1.f;
    uint4 o4;
    o4.x = pk4_fp8(a.x * sc, a.y * sc, a.z * sc, a.w * sc);
    o4.y = pk4_fp8(b.x * sc, b.y * sc, b.z * sc, b.w * sc);
    o4.z = pk4_fp8(c.x * sc, c.y * sc, c.z * sc, c.w * sc);
    o4.w = pk4_fp8(d.x * sc, d.y * sc, d.z * sc, d.w * sc);
    ((uint4*)(dst + (size_t)r * 1024))[lane] = o4;
  }
}

DEVI void rownorm_bf16(const float* __restrict__ src, const float* __restrict__ g, u16* __restrict__ dst,
                       int rows, int gw, int nw, int lane) {
  for (int r = gw; r < rows; r += nw) {
    const float4* pr = (const float4*)(src + (size_t)r * D);
    float4 v[4];
    float ss = 0.f;
#pragma unroll
    for (int i = 0; i < 4; ++i) {
      v[i] = pr[lane + 64 * i];
      ss += v[i].x * v[i].x + v[i].y * v[i].y + v[i].z * v[i].z + v[i].w * v[i].w;
    }
    ss = wave_sum(ss);
    const float rstd = rsqrtf(ss * (1.f / D) + 1e-6f);
#pragma unroll
    for (int i = 0; i < 4; ++i) {
      const float4 gg = ((const float4*)g)[lane + 64 * i];
      uint2 pk;
      pk.x = pack2(v[i].x * rstd * gg.x, v[i].y * rstd * gg.y);
      pk.y = pack2(v[i].z * rstd * gg.z, v[i].w * rstd * gg.w);
      *(uint2*)(dst + (size_t)r * D + (size_t)(lane + 64 * i) * 4) = pk;
    }
  }
}

DEVI void phase0(const Params& p) {
  const int tid = launder(threadIdx.x), lane = tid & 63;
  const int gtid = blockIdx.x * 256 + tid, gsz = gridDim.x * 256;
  const int gw = gtid >> 6, nw = gsz >> 6;
  rownorm_bf16(p.x, p.mix_g, p.hn, NTOK, gw, nw, lane);
  rownorm_bf16(p.mem, p.memkv_g, p.memn, Bn * 256, gw, nw, lane);
  tconv(p.w_in, 1024, 2328, p.winT, 2432, nullptr, gtid, gsz);
  tconv(p.w_out, 1024, 1024, p.woutT, 1024, nullptr, gtid, gsz);
  tconv(p.w_mq, 1024, 1024, p.wmqT, 1024, p.memq_g, gtid, gsz);
  tconv(p.w_mk, 1024, 1024, p.wmkT, 1024, nullptr, gtid, gsz);
  tconv(p.w_mv, 1024, 1024, p.wmvT, 1024, nullptr, gtid, gsz);
  tconv(p.w_mo, 1024, 1024, p.wmoT, 1024, nullptr, gtid, gsz);
  tconv(p.peer_wq, 1024, 2048, p.wpqT, 2048, p.peer_g, gtid, gsz);
  tconv(p.cmp_w1, 2048, 128, p.w1T, 128, nullptr, gtid, gsz);
  tconv(p.cmp_w1 + 2048 * 128, 2048, 128, p.w1T + 128 * 2048, 128, nullptr, gtid, gsz);
  tconv(p.cmp_w2, 128, 64, p.w2T, 128, nullptr, gtid, gsz);
  tconv(p.cmp_w2 + 128 * 64, 128, 64, p.w2T + 128 * 128, 128, nullptr, gtid, gsz);
  conv_flat(p.peer_sk, p.subk, (size_t)16 * 128 * 128 / 8, gtid, gsz);
  for (int it = gtid; it < NTOK * 8; it += gsz) {
    const int tok = it >> 3, i = it & 7;
    const float inv = (i == 0) ? 1.000000000e+00f : (i == 1) ? 1.939227432e-01f : (i == 2) ? 3.760603070e-02f : (i == 3) ? 7.292664610e-03f : (i == 4) ? 1.414213562e-03f : (i == 5) ? 2.742481884e-04f : (i == 6) ? 5.318295734e-05f : 1.031338525e-05f;
    const float ang = (float)p.pos[tok] * inv;
    float sv, cv;
    sincosf(ang, &sv, &cv);
    p.rope[tok * 16 + i] = cv;
    p.rope[tok * 16 + 8 + i] = sv;
  }
  for (int o = gw; o < 256; o += nw) {
    const int ty = o >> 7, n = o & 127;
    float s = 0.f;
    for (int k = lane; k < 2048; k += 64)
      s += p.cmp_pos[ty * 2048 + k] * p.cmp_w1[((size_t)ty * 2048 + k) * 128 + n];
    s = wave_sum(s);
    if (lane == 0) p.biasp[o] = s + p.cmp_b1[o];
  }
  for (int it = gtid; it < NTOK; it += gsz) { p.ssq1[it] = 0.f; p.ssq2[it] = 0.f; }
}

template <class AF>
DEVI void gemm_mainloop(int tid, u16* sA, u16* sB, AF af, const u16* __restrict__ Bt, int ldb, int m0, int n0, int nk,
                        f32x4 (&acc)[4][4]) {
  const int lane = tid & 63, w = tid >> 6;
  const int wm = w >> 1, wn = w & 1, col = lane & 15, quad = lane >> 4;
#pragma unroll
  for (int i = 0; i < 4; ++i)
#pragma unroll
    for (int j = 0; j < 4; ++j) acc[i][j] = f32x4{0.f, 0.f, 0.f, 0.f};
  uint4 ra0, ra1, ra2, ra3, rb0, rb1, rb2, rb3;
  const int lrow = tid >> 3, lkc = (tid & 7) << 3;
  const u16* bbase = Bt + (size_t)(n0 + lrow) * ldb + lkc;
#define GL_(i, kk)                                                        \
  ra##i = *(const uint4*)af(m0 + lrow + 32 * i, (kk) + lkc);              \
  rb##i = *(const uint4*)(bbase + (size_t)(32 * i) * ldb + (kk));
#define SS_(i)                                                            \
  *(uint4*)(sA + (lrow + 32 * i) * 72 + lkc) = ra##i;                     \
  *(uint4*)(sB + (lrow + 32 * i) * 72 + lkc) = rb##i;
  GL_(0, 0) GL_(1, 0) GL_(2, 0) GL_(3, 0)
  SS_(0) SS_(1) SS_(2) SS_(3)
  __syncthreads();
#pragma unroll 1
  for (int kt = 0; kt < nk; ++kt) {
    const bool more = (kt + 1 < nk);
    if (more) {
      const int kk = (kt + 1) * 64;
      GL_(0, kk) GL_(1, kk) GL_(2, kk) GL_(3, kk)
    }
#pragma unroll
    for (int ks = 0; ks < 2; ++ks) {
      bf16x8 fa[4], fb[4];
#pragma unroll
      for (int mi = 0; mi < 4; ++mi) fa[mi] = *(const bf16x8*)(sA + (wm * 64 + 16 * mi + col) * 72 + 32 * ks + 8 * quad);
#pragma unroll
      for (int ni = 0; ni < 4; ++ni) fb[ni] = *(const bf16x8*)(sB + (wn * 64 + 16 * ni + col) * 72 + 32 * ks + 8 * quad);
#pragma unroll
      for (int ni = 0; ni < 4; ++ni)
#pragma unroll
        for (int mi = 0; mi < 4; ++mi) acc[ni][mi] = mfma16(fb[ni], fa[mi], acc[ni][mi]);
    }
    __syncthreads();
    if (more) {
      SS_(0) SS_(1) SS_(2) SS_(3)
      __syncthreads();
    }
  }
#undef GL_
#undef SS_
}

struct ARow {
  const u16* base; int lda;
  DEVI const u16* operator()(int m, int k) const { return base + (size_t)m * lda + k; }
};
struct ACmp {
  const u16* proj; int colbase;
  DEVI const u16* operator()(int rr, int k) const {
    const int b = rr >> 8, g = (rr >> 7) & 1;
    int c = rr & 127; c = c > 126 ? 126 : c;
    const int l = k >> 6, d = k & 63;
    return proj + ((size_t)b * T + 16 * c + l) * LDP + colbase + g * 64 + d;
  }
};

#define GEMM_LANE_VARS                                                    \
  const int tid = launder(threadIdx.x), lane = tid & 63, w = tid >> 6;    \
  const int wm = w >> 1, wn = w & 1, col = lane & 15, quad = lane >> 4;   \
  (void)wm; (void)wn; (void)col; (void)quad;

DEVI void phase1(const Params& p, unsigned char* smem) {
  u16* sA = (u16*)smem; u16* sB = sA + 128 * 72;
  const int NT1 = 256 * 19, NT2 = 32 * 8 * 2;
#pragma unroll 1
  for (int tile = blockIdx.x; tile < NT1 + NT2; tile += gridDim.x) {
    GEMM_LANE_VARS
    f32x4 acc[4][4];
    if (tile < NT1) {
      const int mt = tile / 19, nt_ = tile % 19;
      const int m0 = mt * 128, n0 = nt_ * 128;
      gemm_mainloop(tid, sA, sB, ARow{p.hn, D}, p.winT, D, m0, n0, 16, acc);
#pragma unroll
      for (int mi = 0; mi < 4; ++mi) {
        const int m = m0 + wm * 64 + 16 * mi + col;
        const int b = m >> 11, t = m & 2047;
#pragma unroll
        for (int ni = 0; ni < 4; ++ni) {
          const int nt = n0 + wn * 64 + 16 * ni;
          const int n = nt + 4 * quad;
          f32x4 v = acc[ni][mi];
          if (nt >= LDP) continue;
          if ((nt >= C_VS && nt < C_KW) || (nt >= C_VW && nt < C_GATE)) {
            const bool isw = nt >= C_VW;
            const int off = n - (isw ? C_VW : C_VS);
            const int g = off >> 6, d = off & 63;
            u16* dst = (isw ? p.vtw : p.vts) + ((size_t)(b * 2 + g) * 64 + d) * T + t;
#pragma unroll
            for (int r = 0; r < 4; ++r) dst[(size_t)r * T] = f2bf(v[r]);
          } else {
            const bool rope_tile = ((nt >= C_KS && nt < C_VS) || (nt >= C_KW && nt < C_VW)) && ((nt & 63) == 0);
            if (rope_tile) {
#pragma unroll
              for (int r = 0; r < 4; ++r) {
                const float pr = __shfl_xor(v[r], 32);
                const int i = ((quad & 1) << 2) + r;
                const float cs = p.rope[(size_t)m * 16 + i], sn = p.rope[(size_t)m * 16 + 8 + i];
                v[r] = (quad < 2) ? (v[r] * cs - pr * sn) : (v[r] * cs + pr * sn);
              }
            }
            uint2 pk; pk.x = pack2(v[0], v[1]); pk.y = pack2(v[2], v[3]);
            *(uint2*)(p.proj + (size_t)m * LDP + n) = pk;
          }
        }
      }
    } else {
      const int t2 = tile - NT1;
      const int isv = t2 >> 8, mt = (t2 >> 3) & 31, nt_ = t2 & 7;
      const int m0 = mt * 128, n0 = nt_ * 128;
      gemm_mainloop(tid, sA, sB, ARow{p.memn, D}, isv ? p.wmvT : p.wmkT, D, m0, n0, 16, acc);
#pragma unroll
      for (int mi = 0; mi < 4; ++mi) {
        const int m = m0 + wm * 64 + 16 * mi + col;
        const int b = m >> 8, key = m & 255;
#pragma unroll
        for (int ni = 0; ni < 4; ++ni) {
          const int n = n0 + wn * 64 + 16 * ni + 4 * quad;
          const f32x4 v = acc[ni][mi];
          if (isv) {
            const int head = n >> 8, d = n & 255;
            u16* dst = p.memvt + ((size_t)(b * 4 + head) * 256 + d) * 256 + key;
#pragma unroll
            for (int r = 0; r < 4; ++r) dst[r * 256] = f2bf(v[r]);
          } else {
            uint2 pk; pk.x = pack2(v[0], v[1]); pk.y = pack2(v[2], v[3]);
            *(uint2*)(p.memk + (size_t)m * D + n) = pk;
          }
        }
      }
    }
  }
}

DEVI void conv_tile(const Params& p, unsigned char* smem, int ct) {
  u16* sU = (u16*)smem;
  float2* sRed = (float2*)(smem + 62 * 512 * 2);
  const int tid = launder(threadIdx.x), lane = tid & 63, w = tid >> 6;
  const int b = ct >> 6, t0 = (ct & 63) * 32;
  __syncthreads();
  for (int it = tid; it < 62 * 64; it += 256) {
    const int r = it >> 6, c8 = it & 63;
    const int t = t0 - 30 + r;
    uint4 pk = {0u, 0u, 0u, 0u};
    if (t >= 0) {
      const u16* src = p.proj + ((size_t)b * T + t) * LDP + c8 * 8;
      const uint4 a = *(const uint4*)src, bb = *(const uint4*)(src + 512);
      const unsigned au[4] = {a.x, a.y, a.z, a.w}, bu[4] = {bb.x, bb.y, bb.z, bb.w};
      unsigned o[4];
#pragma unroll
      for (int j = 0; j < 4; ++j) {
        const float a0 = __uint_as_float(au[j] << 16), a1 = __uint_as_float(au[j] & 0xffff0000u);
        const float b0 = __uint_as_float(bu[j] << 16), b1 = __uint_as_float(bu[j] & 0xffff0000u);
        o[j] = pack2(a0 * sigmoidf_(b0), a1 * sigmoidf_(b1));
      }
      pk.x = o[0]; pk.y = o[1]; pk.z = o[2]; pk.w = o[3];
    }
    *(uint4*)(sU + r * 512 + c8 * 8) = pk;
  }
  const int c = 2 * tid;
  float w0[31], w1[31];
#pragma unroll
  for (int j = 0; j < 31; ++j) { w0[j] = p.conv_w[j * 512 + c]; w1[j] = p.conv_w[j * 512 + c + 1]; }
  const float bd0 = p.conv_b[c], bd1 = p.conv_b[c + 1];
  __syncthreads();
  for (int tt = 0; tt < 32; ++tt) {
    float y0 = bd0, y1 = bd1;
#pragma unroll
    for (int j = 0; j < 31; ++j) {
      const unsigned uu = *(const unsigned*)(sU + (tt + j) * 512 + c);
      y0 += w0[j] * __uint_as_float(uu << 16);
      y1 += w1[j] * __uint_as_float(uu & 0xffff0000u);
    }
    float s = y0 + y1, q = y0 * y0 + y1 * y1;
    s = wave_sum(s); q = wave_sum(q);
    if (lane == 0) sRed[tt * 4 + w] = make_float2(s, q);
  }
  __syncthreads();
  const float g0 = p.ln_g[c], g1 = p.ln_g[c + 1], lb0 = p.ln_b[c], lb1 = p.ln_b[c + 1];
  for (int tt = 0; tt < 32; ++tt) {
    float y0 = bd0, y1 = bd1;
#pragma unroll
    for (int j = 0; j < 31; ++j) {
      const unsigned uu = *(const unsigned*)(sU + (tt + j) * 512 + c);
      y0 += w0[j] * __uint_as_float(uu << 16);
      y1 += w1[j] * __uint_as_float(uu & 0xffff0000u);
    }
    const float2 r0 = sRed[tt * 4 + 0], r1 = sRed[tt * 4 + 1], r2 = sRed[tt * 4 + 2], r3 = sRed[tt * 4 + 3];
    const float S = r0.x + r1.x + r2.x + r3.x, Q = r0.y + r1.y + r2.y + r3.y;
    const float mu = S * (1.f / 512.f);
    const float var = fmaxf(Q * (1.f / 512.f) - mu * mu, 0.f);
    const float rstd = rsqrtf(var + 1e-6f);
    const float z0 = (y0 - mu) * rstd * g0 + lb0, z1 = (y1 - mu) * rstd * g1 + lb1;
    const float o0 = z0 * sigmoidf_(z0), o1 = z1 * sigmoidf_(z1);
    *(unsigned*)(p.mix + ((size_t)b * T + t0 + tt) * D + c) = pack2(o0, o1);
  }
}

DEVI void phase2(const Params& p, unsigned char* smem) {
  u16* sA = (u16*)smem; u16* sB = sA + 128 * 72;
#pragma unroll 1
  for (int tile = blockIdx.x; tile < 64 + 1024; tile += gridDim.x) {
    GEMM_LANE_VARS
    if (tile < 64) {
      const int ty = tile >> 5, mt = tile & 31;
      const int m0 = mt * 128;
      f32x4 acc[4][4];
      gemm_mainloop(tid, sA, sB, ACmp{p.proj, ty ? C_VC : C_KC}, p.w1T + (size_t)ty * 128 * 2048, 2048, m0, 0, 32, acc);
#pragma unroll
      for (int mi = 0; mi < 4; ++mi) {
        const int m = m0 + wm * 64 + 16 * mi + col;
#pragma unroll
        for (int ni = 0; ni < 4; ++ni) {
          const int n = wn * 64 + 16 * ni + 4 * quad;
          const f32x4 v = acc[ni][mi];
          const float4 bb = *(const float4*)(p.biasp + ty * 128 + n);
          uint2 pk;
          pk.x = pack2(gelu_tanh(v[0] + bb.x), gelu_tanh(v[1] + bb.y));
          pk.y = pack2(gelu_tanh(v[2] + bb.z), gelu_tanh(v[3] + bb.w));
          *(uint2*)(p.hdn + ((size_t)ty * 4096 + m) * 128 + n) = pk;
        }
      }
    } else {
      conv_tile(p, smem, tile - 64);
    }
  }
}

DEVI void phase3(const Params& p, unsigned char* smem) {
  u16* sA = (u16*)smem; u16* sB = sA + 128 * 72;
#pragma unroll 1
  for (int tile = blockIdx.x; tile < 64; tile += gridDim.x) {
    GEMM_LANE_VARS
    const int ty = tile >> 5, mt = tile & 31;
    const int m0 = mt * 128;
    f32x4 acc[4][4];
    gemm_mainloop(tid, sA, sB, ARow{p.hdn + (size_t)ty * 4096 * 128, 128}, p.w2T + (size_t)ty * 128 * 128, 128, m0, 0, 2, acc);
    if (wn == 0) {
#pragma unroll
      for (int mi = 0; mi < 4; ++mi) {
        const int m = m0 + 16 * mi + wm * 64 + col;
        const int bg = m >> 7, c = m & 127;
#pragma unroll
        for (int ni = 0; ni < 4; ++ni) {
          const int n = 16 * ni + 4 * quad;
          const f32x4 v = acc[ni][mi];
          const float4 bb = *(const float4*)(p.cmp_b2 + ty * 64 + n);
          const float o0 = v[0] + bb.x, o1 = v[1] + bb.y, o2 = v[2] + bb.z, o3 = v[3] + bb.w;
          if (ty == 0) {
            uint2 pk; pk.x = pack2(o0, o1); pk.y = pack2(o2, o3);
            *(uint2*)(p.kc + (size_t)m * 64 + n) = pk;
          } else {
            u16* dst = p.vcT + ((size_t)bg * 64 + n) * 128 + c;
            dst[0] = f2bf(o0); dst[128] = f2bf(o1); dst[256] = f2bf(o2); dst[384] = f2bf(o3);
          }
        }
      }
    }
  }
}

template <int DH, int NQ, int LDK, int LDV, class MaskF>
DEVI void attn_tile(const u16* sK, const u16* sVt, const bf16x8 (&qf)[NQ][DH / 32], f32x4 (&o)[NQ][DH / 16],
                    float (&m)[NQ], float (&l)[NQ], float c2, int lane, MaskF valid) {
  const int col = lane & 15, quad = lane >> 4;
  f32x4 s[NQ][4];
#pragma unroll
  for (int kt = 0; kt < 4; ++kt) {
#pragma unroll
    for (int qt = 0; qt < NQ; ++qt) s[qt][kt] = f32x4{0.f, 0.f, 0.f, 0.f};
#pragma unroll
    for (int ks = 0; ks < DH / 32; ++ks) {
      const bf16x8 kf = *(const bf16x8*)(sK + (16 * kt + col) * LDK + 32 * ks + 8 * quad);
#pragma unroll
      for (int qt = 0; qt < NQ; ++qt) s[qt][kt] = mfma16(kf, qf[qt][ks], s[qt][kt]);
    }
  }
  bf16x8 pb[NQ][2];
#pragma unroll
  for (int qt = 0; qt < NQ; ++qt) {
    float mx = -1e30f;
#pragma unroll
    for (int kt = 0; kt < 4; ++kt)
#pragma unroll
      for (int r = 0; r < 4; ++r) {
        const bool v = valid(qt, 16 * kt + 4 * quad + r);
        const float sv = v ? s[qt][kt][r] : -1e30f;
        s[qt][kt][r] = sv;
        mx = fmaxf(mx, sv);
      }
    mx = fmaxf(mx, __shfl_xor(mx, 16));
    mx = fmaxf(mx, __shfl_xor(mx, 32));
    const float mn = fmaxf(m[qt], mx);
    const float alpha = fexp2((m[qt] - mn) * c2);
    m[qt] = mn;
    float ps = 0.f;
#pragma unroll
    for (int kt = 0; kt < 4; ++kt)
#pragma unroll
      for (int r = 0; r < 4; ++r) {
        const float sv = s[qt][kt][r];
        const float pv = (sv > -1e29f) ? fexp2((sv - mn) * c2) : 0.f;
        ps += pv;
        s[qt][kt][r] = pv;
      }
    l[qt] = l[qt] * alpha + ps;
#pragma unroll
    for (int dt = 0; dt < DH / 16; ++dt) o[qt][dt] *= alpha;
#pragma unroll
    for (int kk = 0; kk < 2; ++kk) {
      union { bf16x8 v; unsigned u[4]; } cv;
      cv.u[0] = pack2(s[qt][2 * kk][0], s[qt][2 * kk][1]);
      cv.u[1] = pack2(s[qt][2 * kk][2], s[qt][2 * kk][3]);
      cv.u[2] = pack2(s[qt][2 * kk + 1][0], s[qt][2 * kk + 1][1]);
      cv.u[3] = pack2(s[qt][2 * kk + 1][2], s[qt][2 * kk + 1][3]);
      pb[qt][kk] = cv.v;
    }
  }
#pragma unroll
  for (int dt = 0; dt < DH / 16; ++dt) {
#pragma unroll
    for (int kk = 0; kk < 2; ++kk) {
      union { bf16x8 v; uint2 h[2]; } cv;
      cv.h[0] = *(const uint2*)(sVt + (16 * dt + col) * LDV + 32 * kk + 4 * quad);
      cv.h[1] = *(const uint2*)(sVt + (16 * dt + col) * LDV + 32 * kk + 16 + 4 * quad);
#pragma unroll
      for (int qt = 0; qt < NQ; ++qt) o[qt][dt] = mfma16(cv.v, pb[qt][kk], o[qt][dt]);
    }
  }
}

DEVI void phase_nsa(const Params& p, unsigned char* smem) {
  u16* sK = (u16*)smem;
  u16* sVt = (u16*)(smem + 18432);
  float* impH = (float*)(smem + 35840);
  float* impT = (float*)(smem + 52736);
  unsigned* selm = (unsigned*)(smem + 56960);
  const float c2 = 0.125f * 1.4426950408889634f;
#pragma unroll 1
  for (int tile = blockIdx.x; tile < 2048; tile += gridDim.x) {
    const int tid = launder(threadIdx.x), lane = tid & 63, w = tid >> 6, col = lane & 15, quad = lane >> 4;
    const int qtile = 63 - (tile >> 5), bg = tile & 31, b = bg >> 1, g = bg & 1, q0 = qtile * 32;
    const int h = g * 4 + w;
    __syncthreads();
    if (tid < 32) selm[tid] = 0u;
    {
      const u16* kcp = p.kc + (size_t)bg * 128 * 64;
      const u16* vcp = p.vcT + (size_t)bg * 64 * 128;
#pragma unroll
      for (int i = 0; i < 4; ++i) {
        const int c = tid + 256 * i;
        const int row = c >> 3, ch = (c & 7) << 3;
        *(uint4*)(sK + row * 72 + ch) = *(const uint4*)(kcp + row * 64 + ch);
        const int row2 = c >> 4, ch2 = (c & 15) << 3;
        *(uint4*)(sVt + row2 * 136 + ch2) = *(const uint4*)(vcp + row2 * 128 + ch2);
      }
    }
    bf16x8 qf[2][2];
    float gate[2][3];
    int tq[2];
#pragma unroll
    for (int qt = 0; qt < 2; ++qt) {
      const int t = q0 + 16 * qt + col;
      tq[qt] = t;
      const size_t tok = (size_t)b * T + t;
      const u16* qp = p.proj + tok * LDP + C_Q + h * 64 + 8 * quad;
      qf[qt][0] = *(const bf16x8*)qp;
      qf[qt][1] = *(const bf16x8*)(qp + 32);
#pragma unroll
      for (int br = 0; br < 3; ++br) gate[qt][br] = sigmoidf_(bf2f(p.proj[tok * LDP + C_GATE + h * 3 + br]));
    }
    __syncthreads();

    f32x4 comb[2][4];
    {
      const int srcl = (lane + 48) & 63;
#pragma unroll
      for (int qt = 0; qt < 2; ++qt) {
        f32x4 s[8];
#pragma unroll
        for (int kt = 0; kt < 8; ++kt) {
          s[kt] = f32x4{0.f, 0.f, 0.f, 0.f};
#pragma unroll
          for (int ks = 0; ks < 2; ++ks) {
            const bf16x8 kf = *(const bf16x8*)(sK + (16 * kt + col) * 72 + 32 * ks + 8 * quad);
            s[kt] = mfma16(kf, qf[qt][ks], s[kt]);
          }
        }
        const int t = tq[qt];
        float mx = -1e30f;
#pragma unroll
        for (int kt = 0; kt < 8; ++kt)
#pragma unroll
          for (int r = 0; r < 4; ++r) {
            const int c = 16 * kt + 4 * quad + r;
            const bool v = (16 * c + 31) <= t;
            const float sv = v ? s[kt][r] : -1e30f;
            s[kt][r] = sv;
            mx = fmaxf(mx, sv);
          }
        mx = fmaxf(mx, __shfl_xor(mx, 16));
        mx = fmaxf(mx, __shfl_xor(mx, 32));
        float ps = 0.f;
#pragma unroll
        for (int kt = 0; kt < 8; ++kt)
#pragma unroll
          for (int r = 0; r < 4; ++r) {
            const float sv = s[kt][r];
            const float pv = (sv > -1e29f) ? fexp2((sv - mx) * c2) : 0.f;
            ps += pv;
            s[kt][r] = pv;
          }
        ps += __shfl_xor(ps, 16);
        ps += __shfl_xor(ps, 32);
        const float inv = ps > 0.f ? 1.f / ps : 0.f;
#pragma unroll
        for (int kt = 0; kt < 8; ++kt)
#pragma unroll
          for (int r = 0; r < 4; ++r) s[kt][r] *= inv;
        float prev3 = 0.f;
#pragma unroll
        for (int kt = 0; kt < 8; ++kt) {
          const float sum4 = s[kt][0] + s[kt][1] + s[kt][2] + s[kt][3];
          const float xs = __shfl(s[kt][3], srcl);
          const float extra = quad ? xs : prev3;
          prev3 = xs;
          impH[(w * 32 + 16 * qt + col) * 33 + 4 * kt + quad] = sum4 + extra;
        }
        bf16x8 pb[4];
#pragma unroll
        for (int kk = 0; kk < 4; ++kk) {
          union { bf16x8 v; unsigned u[4]; } cv;
          cv.u[0] = pack2(s[2 * kk][0], s[2 * kk][1]);
          cv.u[1] = pack2(s[2 * kk][2], s[2 * kk][3]);
          cv.u[2] = pack2(s[2 * kk + 1][0], s[2 * kk + 1][1]);
          cv.u[3] = pack2(s[2 * kk + 1][2], s[2 * kk + 1][3]);
          pb[kk] = cv.v;
        }
#pragma unroll
        for (int dt = 0; dt < 4; ++dt) {
          f32x4 oc = f32x4{0.f, 0.f, 0.f, 0.f};
#pragma unroll
          for (int kk = 0; kk < 4; ++kk) {
            union { bf16x8 v; uint2 hh[2]; } cv;
            cv.hh[0] = *(const uint2*)(sVt + (16 * dt + col) * 136 + 32 * kk + 4 * quad);
            cv.hh[1] = *(const uint2*)(sVt + (16 * dt + col) * 136 + 32 * kk + 16 + 4 * quad);
            oc = mfma16(cv.v, pb[kk], oc);
          }
          comb[qt][dt] = oc * gate[qt][0];
        }
      }
    }
#pragma unroll
    for (int qt = 0; qt < 2; ++qt) {
      const size_t tok = (size_t)b * T + tq[qt];
      union { bf16x8 v; unsigned u[4]; } own, par, res;
      own.v = qf[qt][0];
#pragma unroll
      for (int j = 0; j < 4; ++j) par.u[j] = (unsigned)__shfl_xor((int)own.u[j], 16);
      const float4 c0 = *(const float4*)(p.rope + tok * 16), c1 = *(const float4*)(p.rope + tok * 16 + 4);
      const float4 s0 = *(const float4*)(p.rope + tok * 16 + 8), s1 = *(const float4*)(p.rope + tok * 16 + 12);
      const float cs[8] = {c0.x, c0.y, c0.z, c0.w, c1.x, c1.y, c1.z, c1.w};
      const float sn[8] = {s0.x, s0.y, s0.z, s0.w, s1.x, s1.y, s1.z, s1.w};
#pragma unroll
      for (int j = 0; j < 4; ++j) {
        const float o0 = __uint_as_float(own.u[j] << 16), o1 = __uint_as_float(own.u[j] & 0xffff0000u);
        const float p0 = __uint_as_float(par.u[j] << 16), p1 = __uint_as_float(par.u[j] & 0xffff0000u);
        const float sg = (quad == 0) ? -1.f : 1.f;
        const float r0 = o0 * cs[2 * j] + sg * p0 * sn[2 * j];
        const float r1 = o1 * cs[2 * j + 1] + sg * p1 * sn[2 * j + 1];
        res.u[j] = (quad < 2) ? pack2(r0, r1) : own.u[j];
      }
      qf[qt][0] = res.v;
    }
    __syncthreads();
#pragma unroll
    for (int i = 0; i < 4; ++i) {
      const int cell = tid + 256 * i;
      const int qi = cell >> 5, s_ = cell & 31;
      const int cur = (q0 + qi) >> 6;
      float v = impH[(0 * 32 + qi) * 33 + s_] + impH[(1 * 32 + qi) * 33 + s_] + impH[(2 * 32 + qi) * 33 + s_] +
                impH[(3 * 32 + qi) * 33 + s_];
      const int dist = cur - s_;
      const bool forced = (s_ == 0) || (dist >= 0 && dist < 2);
      v = forced ? 1e9f : (s_ <= cur ? v : -1.f);
      impT[qi * 33 + s_] = v;
    }
    __syncthreads();
    {
      const int qi = tid >> 3, sub = tid & 7;
      unsigned bits = 0u;
#pragma unroll
      for (int k = 0; k < 4; ++k) {
        const int s_ = sub * 4 + k;
        const float v = impT[qi * 33 + s_];
        int rank = 0;
        for (int s2 = 0; s2 < 32; ++s2) {
          const float v2 = impT[qi * 33 + s2];
          rank += ((v2 > v) || (v2 == v && s2 < s_)) ? 1 : 0;
        }
        if (rank < 16) bits |= 1u << s_;
      }
      atomicOr(&selm[qi], bits);
    }
    __syncthreads();
    unsigned sm[2] = {selm[col], selm[16 + col]};
    unsigned uni = 0u;
#pragma unroll
    for (int i = 0; i < 32; ++i) uni |= selm[i];
    const int kbmax = (q0 + 31) >> 6;
    {
      float m[2] = {-1e30f, -1e30f}, l[2] = {0.f, 0.f};
      f32x4 o[2][4];
#pragma unroll
      for (int qt = 0; qt < 2; ++qt)
#pragma unroll
        for (int dt = 0; dt < 4; ++dt) o[qt][dt] = f32x4{0.f, 0.f, 0.f, 0.f};
#pragma unroll 1
      for (int kb = 0; kb <= kbmax; ++kb) {
        if (!((uni >> kb) & 1u)) continue;
        __syncthreads();
#pragma unroll
        for (int i = 0; i < 2; ++i) {
          const int c = tid + 256 * i, row = c >> 3, ch = (c & 7) << 3;
          *(uint4*)(sK + row * 72 + ch) = *(const uint4*)(p.proj + ((size_t)b * T + kb * 64 + row) * LDP + C_KS + g * 64 + ch);
          *(uint4*)(sVt + row * 72 + ch) = *(const uint4*)(p.vts + ((size_t)bg * 64 + row) * T + kb * 64 + ch);
        }
        __syncthreads();
        attn_tile<64, 2, 72, 72>(sK, sVt, qf, o, m, l, c2, lane, [&](int qt, int kl) {
          const int kp = kb * 64 + kl;
          return (((sm[qt] >> kb) & 1u) != 0u) && (kp <= tq[qt]);
        });
      }
#pragma unroll
      for (int qt = 0; qt < 2; ++qt) {
        float lt = l[qt];
        lt += __shfl_xor(lt, 16);
        lt += __shfl_xor(lt, 32);
        const float sc = lt > 0.f ? gate[qt][1] / lt : 0.f;
#pragma unroll
        for (int dt = 0; dt < 4; ++dt) comb[qt][dt] += o[qt][dt] * sc;
      }
    }
    {
      float m[2] = {-1e30f, -1e30f}, l[2] = {0.f, 0.f};
      f32x4 o[2][4];
#pragma unroll
      for (int qt = 0; qt < 2; ++qt)
#pragma unroll
        for (int dt = 0; dt < 4; ++dt) o[qt][dt] = f32x4{0.f, 0.f, 0.f, 0.f};
      const int kblo = (q0 >= 511) ? ((q0 - 511) >> 6) : 0;
#pragma unroll 1
      for (int kb = kblo; kb <= kbmax; ++kb) {
        __syncthreads();
#pragma unroll
        for (int i = 0; i < 2; ++i) {
          const int c = tid + 256 * i, row = c >> 3, ch = (c & 7) << 3;
          *(uint4*)(sK + row * 72 + ch) = *(const uint4*)(p.proj + ((size_t)b * T + kb * 64 + row) * LDP + C_KW + g * 64 + ch);
          *(uint4*)(sVt + row * 72 + ch) = *(const uint4*)(p.vtw + ((size_t)bg * 64 + row) * T + kb * 64 + ch);
        }
        __syncthreads();
        attn_tile<64, 2, 72, 72>(sK, sVt, qf, o, m, l, c2, lane, [&](int qt, int kl) {
          const int kp = kb * 64 + kl;
          return (kp <= tq[qt]) && (kp > tq[qt] - 512);
        });
      }
#pragma unroll
      for (int qt = 0; qt < 2; ++qt) {
        float lt = l[qt];
        lt += __shfl_xor(lt, 16);
        lt += __shfl_xor(lt, 32);
        const float sc = lt > 0.f ? gate[qt][2] / lt : 0.f;
#pragma unroll
        for (int dt = 0; dt < 4; ++dt) comb[qt][dt] += o[qt][dt] * sc;
      }
    }
#pragma unroll
    for (int qt = 0; qt < 2; ++qt) {
      const size_t tok = (size_t)b * T + tq[qt];
#pragma unroll
      for (int dt = 0; dt < 4; ++dt) {
        uint2 pk;
        pk.x = pack2(comb[qt][dt][0], comb[qt][dt][1]);
        pk.y = pack2(comb[qt][dt][2], comb[qt][dt][3]);
        *(uint2*)(p.mix + tok * D + 512 + h * 64 + 16 * dt + 4 * quad) = pk;
      }
    }
  }
}

DEVI void phase_resid(const Params& p, unsigned char* smem, const u16* A, const u16* Wt, const float* res, float* ssq) {
  u16* sA = (u16*)smem; u16* sB = sA + 128 * 72;
#pragma unroll 1
  for (int tile = blockIdx.x; tile < 256 * 8; tile += gridDim.x) {
    GEMM_LANE_VARS
    const int mt = tile >> 3, nt_ = tile & 7;
    const int m0 = mt * 128, n0 = nt_ * 128;
    f32x4 acc[4][4];
    gemm_mainloop(tid, sA, sB, ARow{A, D}, Wt, D, m0, n0, 16, acc);
#pragma unroll
    for (int mi = 0; mi < 4; ++mi) {
      const int m = m0 + wm * 64 + 16 * mi + col;
      float ss = 0.f;
#pragma unroll
      for (int ni = 0; ni < 4; ++ni) {
        const int n = n0 + wn * 64 + 16 * ni + 4 * quad;
        const f32x4 v = acc[ni][mi];
        const float4 r = *(const float4*)(res + (size_t)m * D + n);
        float4 hv;
        hv.x = r.x + v[0]; hv.y = r.y + v[1]; hv.z = r.z + v[2]; hv.w = r.w + v[3];
        ss += hv.x * hv.x + hv.y * hv.y + hv.z * hv.z + hv.w * hv.w;
        *(float4*)(p.h + (size_t)m * D + n) = hv;
        uint2 pk; pk.x = pack2(hv.x, hv.y); pk.y = pack2(hv.z, hv.w);
        *(uint2*)(p.hn + (size_t)m * D + n) = pk;
      }
      ss += __shfl_xor(ss, 16);
      ss += __shfl_xor(ss, 32);
      if (quad == 0) atomicAdd(ssq + m, ss);
    }
  }
}

DEVI void phase_scaled(const Params& p, unsigned char* smem, const u16* A, const u16* Wt, int ntn, const float* ssq, u16* outp, int ldo) {
  u16* sA = (u16*)smem; u16* sB = sA + 128 * 72;
#pragma unroll 1
  for (int tile = blockIdx.x; tile < 256 * ntn; tile += gridDim.x) {
    GEMM_LANE_VARS
    const int mt = tile / ntn, nt_ = tile % ntn;
    const int m0 = mt * 128, n0 = nt_ * 128;
    f32x4 acc[4][4];
    gemm_mainloop(tid, sA, sB, ARow{A, D}, Wt, D, m0, n0, 16, acc);
#pragma unroll
    for (int mi = 0; mi < 4; ++mi) {
      const int m = m0 + wm * 64 + 16 * mi + col;
      const float rstd = rsqrtf(ssq[m] * (1.f / D) + 1e-6f);
#pragma unroll
      for (int ni = 0; ni < 4; ++ni) {
        const int n = n0 + wn * 64 + 16 * ni + 4 * quad;
        const f32x4 v = acc[ni][mi];
        uint2 pk; pk.x = pack2(v[0] * rstd, v[1] * rstd); pk.y = pack2(v[2] * rstd, v[3] * rstd);
        *(uint2*)(outp + (size_t)m * ldo + n) = pk;
      }
    }
  }
}

DEVI void phase_memattn(const Params& p, unsigned char* smem) {
  u16* sK = (u16*)smem;
  u16* sVt = (u16*)(smem + 33792);
  const float c2 = 0.0625f * 1.4426950408889634f;
#pragma unroll 1
  for (int tile = blockIdx.x; tile < 2048; tile += gridDim.x) {
    const int tid = launder(threadIdx.x), lane = tid & 63, w = tid >> 6, col = lane & 15, quad = lane >> 4;
    const int b = tile >> 7, head = (tile >> 5) & 3, q0 = (tile & 31) * 64;
    const size_t tok = (size_t)b * T + q0 + 16 * w + col;
    bf16x8 qf[1][8];
#pragma unroll
    for (int ks = 0; ks < 8; ++ks) qf[0][ks] = *(const bf16x8*)(p.qm + tok * D + head * 256 + 32 * ks + 8 * quad);
    float m[1] = {-1e30f}, l[1] = {0.f};
    f32x4 o[1][16];
#pragma unroll
    for (int dt = 0; dt < 16; ++dt) o[0][dt] = f32x4{0.f, 0.f, 0.f, 0.f};
#pragma unroll 1
    for (int kb = 0; kb < 4; ++kb) {
      __syncthreads();
#pragma unroll
      for (int i = 0; i < 8; ++i) {
        const int c = tid + 256 * i;
        const int row = c >> 5, ch = (c & 31) << 3;
        *(uint4*)(sK + row * 264 + ch) = *(const uint4*)(p.memk + ((size_t)b * 256 + kb * 64 + row) * D + head * 256 + ch);
      }
      __builtin_amdgcn_sched_barrier(0);
#pragma unroll
      for (int i = 0; i < 8; ++i) {
        const int c = tid + 256 * i;
        const int row2 = c >> 3, ch2 = (c & 7) << 3;
        *(uint4*)(sVt + row2 * 72 + ch2) = *(const uint4*)(p.memvt + ((size_t)(b * 4 + head) * 256 + row2) * 256 + kb * 64 + ch2);
      }
      __syncthreads();
      attn_tile<256, 1, 264, 72>(sK, sVt, qf, o, m, l, c2, lane, [&](int, int) { return true; });
    }
    float lt = l[0];
    lt += __shfl_xor(lt, 16);
    lt += __shfl_xor(lt, 32);
    const float inv = 1.f / lt;
#pragma unroll
    for (int dt = 0; dt < 16; ++dt) {
      uint2 pk;
      pk.x = pack2(o[0][dt][0] * inv, o[0][dt][1] * inv);
      pk.y = pack2(o[0][dt][2] * inv, o[0][dt][3] * inv);
      *(uint2*)(p.mix + tok * D + head * 256 + 16 * dt + 4 * quad) = pk;
    }
  }
}

__constant__ unsigned char kCandI[64] = {0,0,0,0,0,0,0,0,0,0,0,0,0,0,0,0, 1,1,1,1,1,1,1,1, 2,2,2,2,2, 3,3,3,3, 4,4,4, 5,5, 6,6, 7,7,
                                          8, 9, 10, 11, 12, 13, 14, 15, 0,0,0,0,0,0,0,0,0,0,0,0,0,0};
__constant__ unsigned char kCandJ[64] = {0,1,2,3,4,5,6,7,8,9,10,11,12,13,14,15, 0,1,2,3,4,5,6,7, 0,1,2,3,4, 0,1,2,3, 0,1,2, 0,1, 0,1, 0,1,
                                          0, 0, 0, 0, 0, 0, 0, 0, 0,0,0,0,0,0,0,0,0,0,0,0,0,0};

DEVI unsigned score_key(float v, int idx) {
  unsigned u = __float_as_uint(v);
  u = (u & 0x80000000u) ? ~u : (u | 0x80000000u);
  return (u & ~127u) | (unsigned)(127 - idx);
}
DEVI float key_score(unsigned k) {
  k &= ~127u;
  const unsigned u = (k & 0x80000000u) ? (k & 0x7fffffffu) : ~k;
  return __uint_as_float(u);
}

DEVI void phase_peer_route(const Params& p, unsigned char* smem) {
  u16* sA = (u16*)smem; u16* sB = sA + 128 * 72;
  unsigned* sScore = (unsigned*)smem;
  unsigned* sTop = (unsigned*)(smem + 36864);
  unsigned* sTmp = (unsigned*)(smem + 53248);
  {
    const int t0_ = launder(threadIdx.x);
    const int gw = (blockIdx.x * 256 + t0_) >> 6, nw = (gridDim.x * 256) >> 6;
    conv_fp8_rows(p.peer_u, p.ub8, p.uscale, 16384, gw, nw, t0_ & 63);
    conv_fp8_rows(p.peer_v, p.vb8, p.vscale, 16384, gw, nw, t0_ & 63);
  }
#pragma unroll 1
  for (int tile = blockIdx.x; tile < 256 * 8; tile += gridDim.x) {
    GEMM_LANE_VARS
    const int mt = tile >> 3, hd = tile & 7;
    const int m0 = mt * 128;
#pragma unroll 1
    for (int ph = 0; ph < 2; ++ph) {
      const int hp = hd * 2 + ph;
      f32x4 acc[4][4];
      __syncthreads();
      gemm_mainloop(tid, sA, sB, ARow{p.pq + hp * 128, 2048}, p.subk + (size_t)hp * 128 * 128, 128, m0, 0, 2, acc);
#pragma unroll 1
      for (int hh = 0; hh < 2; ++hh) {
        if (wm == hh) {
#pragma unroll
          for (int mi = 0; mi < 4; ++mi) {
            const int row = 16 * mi + col;
#pragma unroll
            for (int ni = 0; ni < 4; ++ni) {
              const int n = wn * 64 + 16 * ni + 4 * quad;
              const f32x4 v = acc[ni][mi];
              uint4 kk;
              kk.x = score_key(v[0], n); kk.y = score_key(v[1], n + 1);
              kk.z = score_key(v[2], n + 2); kk.w = score_key(v[3], n + 3);
              *(uint4*)(sScore + row * 128 + n) = kk;
            }
          }
        }
        __syncthreads();
#pragma unroll 1
        for (int rr = 0; rr < 16; ++rr) {
          const int row = w * 16 + rr;
          const unsigned k0 = sScore[row * 128 + lane], k1 = sScore[row * 128 + 64 + lane];
          unsigned thr = 0u;
#pragma unroll 1
          for (int bit = 31; bit >= 0; --bit) {
            const unsigned cand = thr | (1u << bit);
            const int cnt = __popcll(__ballot(k0 >= cand)) + __popcll(__ballot(k1 >= cand));
            if (cnt >= 16) { thr = cand; if (cnt == 16) break; }
          }
          const unsigned long long m0 = __ballot(k0 >= thr), m1 = __ballot(k1 >= thr);
          const int pos0 = __builtin_amdgcn_mbcnt_hi((unsigned)(m0 >> 32), __builtin_amdgcn_mbcnt_lo((unsigned)m0, 0u));
          const int pos1 = __popcll(m0) + __builtin_amdgcn_mbcnt_hi((unsigned)(m1 >> 32), __builtin_amdgcn_mbcnt_lo((unsigned)m1, 0u));
          unsigned* tmp = sTmp + w * 16;
          if (k0 >= thr) tmp[pos0] = k0;
          if (k1 >= thr) tmp[pos1] = k1;
          __builtin_amdgcn_fence(__ATOMIC_RELEASE, "wavefront");
          __builtin_amdgcn_wave_barrier();
          __builtin_amdgcn_fence(__ATOMIC_ACQUIRE, "wavefront");
          if (lane < 16) {
            const unsigned mine = tmp[lane];
            const uint4 a = *(const uint4*)(tmp), b = *(const uint4*)(tmp + 4), c = *(const uint4*)(tmp + 8), d = *(const uint4*)(tmp + 12);
            const int rk = (a.x > mine) + (a.y > mine) + (a.z > mine) + (a.w > mine) + (b.x > mine) + (b.y > mine) + (b.z > mine) + (b.w > mine) +
                           (c.x > mine) + (c.y > mine) + (c.z > mine) + (c.w > mine) + (d.x > mine) + (d.y > mine) + (d.z > mine) + (d.w > mine);
            sTop[((hh * 64 + row) * 2 + ph) * 16 + rk] = mine;
          }
          __builtin_amdgcn_fence(__ATOMIC_RELEASE, "wavefront");
          __builtin_amdgcn_wave_barrier();
        }
        __syncthreads();
      }
    }
    const int ci = kCandI[lane], cj = kCandJ[lane];
#pragma unroll 1
    for (int tt = 0; tt < 32; ++tt) {
      const int trow = w * 32 + tt;
      const unsigned k0 = sTop[(trow * 2 + 0) * 16 + ci], k1 = sTop[(trow * 2 + 1) * 16 + cj];
      const bool act = lane < 50;
      const float v = key_score(k0) + key_score(k1);
      unsigned ku = __float_as_uint(v);
      ku = (ku & 0x80000000u) ? ~ku : (ku | 0x80000000u);
      ku = act ? ((ku & ~63u) | (unsigned)(63 - lane)) : 0u;
      unsigned thr = 0u;
#pragma unroll 1
      for (int bit = 31; bit >= 0; --bit) {
        const unsigned cand = thr | (1u << bit);
        const int cnt = __popcll(__ballot(ku >= cand));
        if (cnt >= 16) { thr = cand; if (cnt == 16) break; }
      }
      const bool sel = act && (ku >= thr);
      const unsigned long long ms = __ballot(sel);
      const int slot = __builtin_amdgcn_mbcnt_hi((unsigned)(ms >> 32), __builtin_amdgcn_mbcnt_lo((unsigned)ms, 0u));
      const float vmax = __int_as_float(__builtin_amdgcn_readlane(__float_as_int(v), 0));
      const float e = sel ? __expf(v - vmax) : 0.f;
      const float tot = wave_sum(e);
      if (sel) {
        const int eid = (127 - (int)(k0 & 127u)) * 128 + (127 - (int)(k1 & 127u));
        const size_t o = (size_t)(m0 + trow) * 128 + hd * 16 + slot;
        p.experts[o] = eid;
        p.gates[o] = e / tot;
      }
    }
  }
}

DEVI void phase_peer_gather(const Params& p) {
  const int w0_ = threadIdx.x >> 6;
#pragma unroll 1
  for (int tok = blockIdx.x * 4 + w0_; tok < NTOK; tok += gridDim.x * 4) {
    const int tid = launder(threadIdx.x), lane = tid & 63;
    const float4* hp4 = (const float4*)(p.h + (size_t)tok * D) + lane * 4;
    float hv[16], xn[16], y[16];
    {
      const float4 a0 = hp4[0], a1 = hp4[1], a2 = hp4[2], a3 = hp4[3];
      hv[0] = a0.x; hv[1] = a0.y; hv[2] = a0.z; hv[3] = a0.w; hv[4] = a1.x; hv[5] = a1.y; hv[6] = a1.z; hv[7] = a1.w;
      hv[8] = a2.x; hv[9] = a2.y; hv[10] = a2.z; hv[11] = a2.w; hv[12] = a3.x; hv[13] = a3.y; hv[14] = a3.z; hv[15] = a3.w;
    }
    float ss = 0.f;
#pragma unroll
    for (int i = 0; i < 16; ++i) ss += hv[i] * hv[i];
    ss = wave_sum(ss);
    const float rstd = rsqrtf(ss * (1.f / D) + 1e-6f);
    {
      const float4* g4 = (const float4*)p.peer_g + lane * 4;
      const float4 a0 = g4[0], a1 = g4[1], a2 = g4[2], a3 = g4[3];
      const float gg[16] = {a0.x, a0.y, a0.z, a0.w, a1.x, a1.y, a1.z, a1.w, a2.x, a2.y, a2.z, a2.w, a3.x, a3.y, a3.z, a3.w};
#pragma unroll
      for (int i = 0; i < 16; ++i) { xn[i] = hv[i] * rstd * gg[i]; y[i] = 0.f; }
    }
    const int e0 = p.experts[(size_t)tok * 128 + lane], e1 = p.experts[(size_t)tok * 128 + 64 + lane];
    const float g0 = p.gates[(size_t)tok * 128 + lane], g1 = p.gates[(size_t)tok * 128 + 64 + lane];
    const float su0 = p.uscale[e0], su1 = p.uscale[e1];
    const float sv0 = p.vscale[e0], sv1 = p.vscale[e1];
    float cf0 = 0.f, cf1 = 0.f;
#pragma unroll
    for (int half = 0; half < 2; ++half) {
      const int ev = half ? e1 : e0;
      float dsum = 0.f;
#pragma unroll 1
      for (int k = 0; k < 64; k += 8) {
        uint4 c[8];
#pragma unroll
        for (int u = 0; u < 8; ++u) {
          const int e = __builtin_amdgcn_readlane(ev, k + u);
          c[u] = ((const uint4*)(p.ub8 + (size_t)e * 1024))[lane];
        }
#pragma unroll
        for (int u = 0; u < 8; ++u) {
          const unsigned uu[4] = {c[u].x, c[u].y, c[u].z, c[u].w};
          float d = 0.f;
#pragma unroll
          for (int j = 0; j < 4; ++j) {
            const f32x2 lo = __builtin_amdgcn_cvt_pk_f32_fp8((int)uu[j], false);
            const f32x2 hi = __builtin_amdgcn_cvt_pk_f32_fp8((int)uu[j], true);
            d += xn[4 * j] * lo[0];
            d += xn[4 * j + 1] * lo[1];
            d += xn[4 * j + 2] * hi[0];
            d += xn[4 * j + 3] * hi[1];
          }
          d = wave_sum(d);
          if (lane == k + u) dsum = d;
        }
      }
      if (half) cf1 = gelu_tanh(dsum * su1) * g1 * sv1; else cf0 = gelu_tanh(dsum * su0) * g0 * sv0;
    }
#pragma unroll
    for (int half = 0; half < 2; ++half) {
      const int ev = half ? e1 : e0;
      const float cfv = half ? cf1 : cf0;
#pragma unroll 1
      for (int k = 0; k < 64; k += 8) {
        uint4 c[8];
        float ck[8];
#pragma unroll
        for (int u = 0; u < 8; ++u) {
          const int e = __builtin_amdgcn_readlane(ev, k + u);
          ck[u] = __int_as_float(__builtin_amdgcn_readlane(__float_as_int(cfv), k + u));
          c[u] = ((const uint4*)(p.vb8 + (size_t)e * 1024))[lane];
        }
#pragma unroll
        for (int u = 0; u < 8; ++u) {
          const unsigned uu[4] = {c[u].x, c[u].y, c[u].z, c[u].w};
#pragma unroll
          for (int j = 0; j < 4; ++j) {
            const f32x2 lo = __builtin_amdgcn_cvt_pk_f32_fp8((int)uu[j], false);
            const f32x2 hi = __builtin_amdgcn_cvt_pk_f32_fp8((int)uu[j], true);
            y[4 * j] += ck[u] * lo[0];
            y[4 * j + 1] += ck[u] * lo[1];
            y[4 * j + 2] += ck[u] * hi[0];
            y[4 * j + 3] += ck[u] * hi[1];
          }
        }
      }
    }
    float s2 = 0.f;
#pragma unroll
    for (int i = 0; i < 16; ++i) { y[i] += hv[i]; s2 += y[i] * y[i]; }
    s2 = wave_sum(s2);
    const float rs2 = rsqrtf(s2 * (1.f / D) + 1e-6f);
    {
      const float4* g4 = (const float4*)p.final_g + lane * 4;
      const float4 a0 = g4[0], a1 = g4[1], a2 = g4[2], a3 = g4[3];
      float4* o4 = (float4*)(p.out + (size_t)tok * D) + lane * 4;
      o4[0] = make_float4(y[0] * rs2 * a0.x, y[1] * rs2 * a0.y, y[2] * rs2 * a0.z, y[3] * rs2 * a0.w);
      o4[1] = make_float4(y[4] * rs2 * a1.x, y[5] * rs2 * a1.y, y[6] * rs2 * a1.z, y[7] * rs2 * a1.w);
      o4[2] = make_float4(y[8] * rs2 * a2.x, y[9] * rs2 * a2.y, y[10] * rs2 * a2.z, y[11] * rs2 * a2.w);
      o4[3] = make_float4(y[12] * rs2 * a3.x, y[13] * rs2 * a3.y, y[14] * rs2 * a3.z, y[15] * rs2 * a3.w);
    }
  }
}

template <bool COOP>
__global__ void __launch_bounds__(256, 2) mega(Params p, int ph_lo, int ph_hi) {
  __shared__ __attribute__((aligned(16))) unsigned char smem[SMEM_BYTES];
#ifdef REPEAT_MASK
  bool rep_done = false;
#endif
  for (int ph = ph_lo; ph <= ph_hi; ++ph) {
    switch (ph) {
      case 0: phase0(p); break;
      case 1: phase1(p, smem); break;
      case 2: phase2(p, smem); break;
      case 3: phase3(p, smem); break;
      case 4: phase_nsa(p, smem); break;
      case 5: phase_resid(p, smem, p.mix, p.woutT, p.x, p.ssq1); break;
      case 6: phase_scaled(p, smem, p.hn, p.wmqT, 8, p.ssq1, p.qm, D); break;
      case 7: phase_memattn(p, smem); break;
      case 8: phase_resid(p, smem, p.mix, p.wmoT, p.h, p.ssq2); break;
      case 9: phase_scaled(p, smem, p.hn, p.wpqT, 16, p.ssq2, p.pq, 2048); break;
      case 10: phase_peer_route(p, smem); break;
      case 11: phase_peer_gather(p); break;
    }
#ifdef REPEAT_MASK
    if (COOP && ((REPEAT_MASK >> ph) & 1) && !rep_done) { rep_done = true; cg::this_grid().sync(); --ph; continue; }
    rep_done = false;
#endif
    if (COOP) {
      if (ph < ph_hi) cg::this_grid().sync();
    }
  }
}

extern "C" void kernel_launch(void* const* d_in, const int* in_sizes, int n_in, void* d_out, int out_size, void* d_ws,
                              size_t ws_size, hipStream_t stream) {
  (void)in_sizes; (void)n_in; (void)out_size; (void)ws_size;
  Params p{};
  p.x = (const float*)d_in[0]; p.mem = (const float*)d_in[1]; p.pos = (const int*)d_in[2];
  p.mix_g = (const float*)d_in[3]; p.w_in = (const float*)d_in[4]; p.conv_w = (const float*)d_in[5];
  p.conv_b = (const float*)d_in[6]; p.ln_g = (const float*)d_in[7]; p.ln_b = (const float*)d_in[8];
  p.cmp_pos = (const float*)d_in[9]; p.cmp_w1 = (const float*)d_in[10]; p.cmp_b1 = (const float*)d_in[11];
  p.cmp_w2 = (const float*)d_in[12]; p.cmp_b2 = (const float*)d_in[13]; p.w_out = (const float*)d_in[14];
  p.memq_g = (const float*)d_in[15]; p.memkv_g = (const float*)d_in[16]; p.w_mq = (const float*)d_in[17];
  p.w_mk = (const float*)d_in[18]; p.w_mv = (const float*)d_in[19]; p.w_mo = (const float*)d_in[20];
  p.peer_g = (const float*)d_in[21]; p.peer_wq = (const float*)d_in[22]; p.peer_sk = (const float*)d_in[23];
  p.peer_u = (const float*)d_in[24]; p.peer_v = (const float*)d_in[25]; p.final_g = (const float*)d_in[26];
  p.out = (float*)d_out;
  unsigned char* ws = (unsigned char*)d_ws;
  size_t off = 0;
  auto take = [&](size_t bytes) { unsigned char* r = ws + off; off += (bytes + 255) & ~(size_t)255; return r; };
  unsigned char* regA = take((size_t)NTOK * D * 2);
  unsigned char* regB = take((size_t)NTOK * LDP * 2);
  unsigned char* regC = take((size_t)NTOK * D * 2);
  p.hn = (u16*)regA; p.ub8 = regA; p.vb8 = regA + (size_t)16384 * 1024;
  p.uscale = (float*)(regA + (size_t)2 * 16384 * 1024); p.vscale = p.uscale + 16384;
  p.proj = (u16*)regB; p.qm = (u16*)regB; p.pq = (u16*)regB;
  p.mix = (u16*)regC; p.experts = (int*)regC; p.gates = (float*)(regC + (size_t)NTOK * 128 * 4);
  p.h = (float*)take((size_t)NTOK * D * 4);
  p.vts = (u16*)take((size_t)Bn * 2 * 64 * T * 2);
  p.vtw = (u16*)take((size_t)Bn * 2 * 64 * T * 2);
  p.memn = (u16*)take((size_t)Bn * 256 * D * 2);
  p.memk = (u16*)take((size_t)Bn * 256 * D * 2);
  p.memvt = (u16*)take((size_t)Bn * 256 * D * 2);
  p.winT = (u16*)take((size_t)2432 * 1024 * 2);
  p.woutT = (u16*)take((size_t)1024 * 1024 * 2);
  p.wmqT = (u16*)take((size_t)1024 * 1024 * 2);
  p.wmkT = (u16*)take((size_t)1024 * 1024 * 2);
  p.wmvT = (u16*)take((size_t)1024 * 1024 * 2);
  p.wmoT = (u16*)take((size_t)1024 * 1024 * 2);
  p.wpqT = (u16*)take((size_t)2048 * 1024 * 2);
  p.subk = (u16*)take((size_t)16 * 128 * 128 * 2);
  p.w1T = (u16*)take((size_t)2 * 128 * 2048 * 2);
  p.w2T = (u16*)take((size_t)2 * 128 * 128 * 2);
  p.biasp = (float*)take(256 * 4);
  p.rope = (float*)take((size_t)NTOK * 16 * 4);
  p.hdn = (u16*)take((size_t)2 * 4096 * 128 * 2);
  p.kc = (u16*)take((size_t)Bn * 2 * 128 * 64 * 2);
  p.vcT = (u16*)take((size_t)Bn * 2 * 64 * 128 * 2);
  p.ssq1 = (float*)take((size_t)NTOK * 4);
  p.ssq2 = (float*)take((size_t)NTOK * 4);
  if (off > ws_size) { fprintf(stderr, "workspace too small: need %zu have %zu\n", off, ws_size); return; }

#if COOP_MODE
  static int grid_blocks = 0;
  if (!grid_blocks) {
    int dev = 0, cus = 0, per_cu = 0;
    hipGetDevice(&dev);
    hipDeviceGetAttribute(&cus, hipDeviceAttributeMultiprocessorCount, dev);
    hipOccupancyMaxActiveBlocksPerMultiprocessor(&per_cu, mega<true>, 256, 0);
    if (per_cu > 2) per_cu = 2;
    if (per_cu < 1) per_cu = 1;
    grid_blocks = cus * per_cu;
  }
  int lo = 0, hi = NPHASE;
  void* args[] = {&p, &lo, &hi};
  hipError_t e = hipLaunchCooperativeKernel((void*)mega<true>, dim3(grid_blocks), dim3(256), args, 0, stream);
  if (e != hipSuccess) fprintf(stderr, "cooperative launch failed: %s (grid %d)\n", hipGetErrorString(e), grid_blocks);
#else
  for (int ph = 0; ph <= NPHASE; ++ph) mega<false><<<dim3(512), dim3(256), 0, stream>>>(p, ph, ph);
#endif
}
```

```cpp
#include <hip/hip_runtime.h>
#include <hip/hip_bf16.h>
#include <hip/hip_cooperative_groups.h>
#include <cstdio>
#include <cstdint>
namespace cg = cooperative_groups;

#ifndef COOP_MODE
#define COOP_MODE 1
#endif

typedef __attribute__((ext_vector_type(8))) short bf16x8;
typedef __attribute__((ext_vector_type(4))) short bf16x4;
typedef __attribute__((ext_vector_type(4))) float f32x4;
typedef unsigned short u16;

#define DEVI __device__ __forceinline__

constexpr int Bn = 16, T = 2048, D = 1024, NTOK = Bn * T, LDP = 2336;
constexpr int C_Q = 1024, C_KC = 1536, C_VC = 1664, C_KS = 1792, C_VS = 1920, C_KW = 2048, C_VW = 2176, C_GATE = 2304;
constexpr int SMEM_BYTES = 73728;
constexpr int LDA = 1088;
constexpr int LDHF = 1056;
constexpr int LDPQ = 2112;
constexpr int LDW1 = 2112;
constexpr int LDT = 2112;
constexpr int NPHASE = 11;

struct Params {
  const float* x; const float* mem; const int* pos; const float* mix_g; const float* w_in;
  const float* conv_w; const float* conv_b; const float* ln_g; const float* ln_b;
  const float* cmp_pos; const float* cmp_w1; const float* cmp_b1; const float* cmp_w2; const float* cmp_b2;
  const float* w_out; const float* memq_g; const float* memkv_g; const float* w_mq; const float* w_mk;
  const float* w_mv; const float* w_mo; const float* peer_g; const float* peer_wq; const float* peer_sk;
  const float* peer_u; const float* peer_v; const float* final_g;
  float* out;
  u16* hn; u16* proj; u16* mix; float* h; u16* vts; u16* vtw; u16* memn; u16* memk; u16* memvt;
  u16* winT; u16* woutT; u16* wmqT; u16* wmkT; u16* wmvT; u16* wmoT; u16* wpqT; u16* subk; u16* w1T; u16* w2T;
  float* biasp; float* rope; u16* hdn; u16* kc; u16* vcT; float* ssq1; float* ssq2;
  int* experts; float* gates; unsigned char* ub8; unsigned char* vb8; float* uscale; float* vscale; u16* qm; u16* pq;
};

DEVI int launder(int x) { asm volatile("" : "+v"(x)); return x; }
DEVI u16 f2bf(float f) {
  unsigned u = __float_as_uint(f);
  u += 0x7fffu + ((u >> 16) & 1u);
  return (u16)(u >> 16);
}
DEVI float bf2f(u16 h) { return __uint_as_float(((unsigned)h) << 16); }
DEVI unsigned pack2(float a, float b) { return (unsigned)f2bf(a) | ((unsigned)f2bf(b) << 16); }
DEVI float wave_sum(float v) {
#pragma unroll
  for (int o = 32; o; o >>= 1) v += __shfl_xor(v, o);
  return v;
}
DEVI float sigmoidf_(float x) { return 1.f / (1.f + __expf(-x)); }
DEVI float gelu_tanh(float x) {
  float u = 0.7978845608028654f * (x + 0.044715f * x * x * x);
  return 0.5f * x * (1.f + tanhf(u));
}
DEVI f32x4 mfma16(bf16x8 a, bf16x8 b, f32x4 c) { return __builtin_amdgcn_mfma_f32_16x16x32_bf16(a, b, c, 0, 0, 0); }
DEVI float fexp2(float x) { return __builtin_amdgcn_exp2f(x); }

DEVI void tconv(const float* __restrict__ src, int K, int N, u16* __restrict__ dst, int Npad, int ldd,
                const float* __restrict__ gain, int gtid, int gsz) {
  const int items = Npad * (K >> 3);
  for (int it = gtid; it < items; it += gsz) {
    const int n = it % Npad, kc = it / Npad;
    float f[8];
#pragma unroll
    for (int j = 0; j < 8; ++j) {
      float v = 0.f;
      if (n < N) {
        v = src[(size_t)(kc * 8 + j) * N + n];
        if (gain) v *= gain[kc * 8 + j];
      }
      f[j] = v;
    }
    uint4 pk;
    pk.x = pack2(f[0], f[1]); pk.y = pack2(f[2], f[3]); pk.z = pack2(f[4], f[5]); pk.w = pack2(f[6], f[7]);
    *(uint4*)(dst + (size_t)n * ldd + kc * 8) = pk;
  }
}

DEVI void conv_flat(const float* __restrict__ src, u16* __restrict__ dst, size_t n8, size_t gtid, size_t gsz) {
  for (size_t it = gtid; it < n8; it += gsz) {
    const float4 a = ((const float4*)src)[2 * it], b = ((const float4*)src)[2 * it + 1];
    uint4 pk;
    pk.x = pack2(a.x, a.y); pk.y = pack2(a.z, a.w); pk.z = pack2(b.x, b.y); pk.w = pack2(b.z, b.w);
    ((uint4*)dst)[it] = pk;
  }
}


typedef float f32x2 __attribute__((ext_vector_type(2)));
DEVI unsigned pk4_fp8(float a, float b, float c, float d) {
  int v = 0;
  v = __builtin_amdgcn_cvt_pk_fp8_f32(a, b, v, false);
  v = __builtin_amdgcn_cvt_pk_fp8_f32(c, d, v, true);
  return (unsigned)v;
}
DEVI void conv_fp8_rows(const float* __restrict__ src, unsigned char* __restrict__ dst, float* __restrict__ inv_scale,
                        int rows, int gw, int nw, int lane) {
  for (int r = gw; r < rows; r += nw) {
    const float4* p4 = (const float4*)(src + (size_t)r * 1024) + lane * 4;
    const float4 a = p4[0], b = p4[1], c = p4[2], d = p4[3];
    float mx = fmaxf(fmaxf(fmaxf(fabsf(a.x), fabsf(a.y)), fmaxf(fabsf(a.z), fabsf(a.w))),
                     fmaxf(fmaxf(fabsf(b.x), fabsf(b.y)), fmaxf(fabsf(b.z), fabsf(b.w))));
    mx = fmaxf(mx, fmaxf(fmaxf(fmaxf(fabsf(c.x), fabsf(c.y)), fmaxf(fabsf(c.z), fabsf(c.w))),
                         fmaxf(fmaxf(fabsf(d.x), fabsf(d.y)), fmaxf(fabsf(d.z), fabsf(d.w)))));
#pragma unroll
    for (int o = 32; o; o >>= 1) mx = fmaxf(mx, __shfl_xor(mx, o));
    const float sc = mx > 0.f ? 224.f / mx : 1.f;
    if (lane == 0) inv_scale[r] = mx > 0.f ? mx * (1.f / 224.f) : 1.f;
    uint4 o4;
    o4.x = pk4_fp8(a.x * sc, a.y * sc, a.z * sc, a.w * sc);
    o4.y = pk4_fp8(b.x * sc, b.y * sc, b.z * sc, b.w * sc);
    o4.z = pk4_fp8(c.x * sc, c.y * sc, c.z * sc, c.w * sc);
    o4.w = pk4_fp8(d.x * sc, d.y * sc, d.z * sc, d.w * sc);
    ((uint4*)(dst + (size_t)r * 1024))[lane] = o4;
  }
}

DEVI void rownorm_bf16(const float* __restrict__ src, const float* __restrict__ g, u16* __restrict__ dst,
                       int rows, int gw, int nw, int lane) {
  for (int r = gw; r < rows; r += nw) {
    const float4* pr = (const float4*)(src + (size_t)r * D);
    float4 v[4];
    float ss = 0.f;
#pragma unroll
    for (int i = 0; i < 4; ++i) {
      v[i] = pr[lane + 64 * i];
      ss += v[i].x * v[i].x + v[i].y * v[i].y + v[i].z * v[i].z + v[i].w * v[i].w;
    }
    ss = wave_sum(ss);
    const float rstd = rsqrtf(ss * (1.f / D) + 1e-6f);
#pragma unroll
    for (int i = 0; i < 4; ++i) {
      const float4 gg = ((const float4*)g)[lane + 64 * i];
      uint2 pk;
      pk.x = pack2(v[i].x * rstd * gg.x, v[i].y * rstd * gg.y);
      pk.y = pack2(v[i].z * rstd * gg.z, v[i].w * rstd * gg.w);
      *(uint2*)(dst + (size_t)r * LDA + (size_t)(lane + 64 * i) * 4) = pk;
    }
  }
}

DEVI void phase0(const Params& p) {
  const int tid = launder(threadIdx.x), lane = tid & 63;
  const int gtid = blockIdx.x * 256 + tid, gsz = gridDim.x * 256;
  const int gw = gtid >> 6, nw = gsz >> 6;
  rownorm_bf16(p.x, p.mix_g, p.hn, NTOK, gw, nw, lane);
  rownorm_bf16(p.mem, p.memkv_g, p.memn, Bn * 256, gw, nw, lane);
  tconv(p.w_in, 1024, 2328, p.winT, 2432, LDA, nullptr, gtid, gsz);
  tconv(p.w_out, 1024, 1024, p.woutT, 1024, LDA, nullptr, gtid, gsz);
  tconv(p.w_mq, 1024, 1024, p.wmqT, 1024, LDA, p.memq_g, gtid, gsz);
  tconv(p.w_mk, 1024, 1024, p.wmkT, 1024, LDA, nullptr, gtid, gsz);
  tconv(p.w_mv, 1024, 1024, p.wmvT, 1024, LDA, nullptr, gtid, gsz);
  tconv(p.w_mo, 1024, 1024, p.wmoT, 1024, LDA, nullptr, gtid, gsz);
  tconv(p.peer_wq, 1024, 2048, p.wpqT, 2048, LDA, p.peer_g, gtid, gsz);
  tconv(p.cmp_w1, 2048, 128, p.w1T, 128, LDW1, nullptr, gtid, gsz);
  tconv(p.cmp_w1 + 2048 * 128, 2048, 128, p.w1T + 128 * LDW1, 128, LDW1, nullptr, gtid, gsz);
  tconv(p.cmp_w2, 128, 64, p.w2T, 128, 128, nullptr, gtid, gsz);
  tconv(p.cmp_w2 + 128 * 64, 128, 64, p.w2T + 128 * 128, 128, 128, nullptr, gtid, gsz);
  conv_flat(p.peer_sk, p.subk, (size_t)16 * 128 * 128 / 8, gtid, gsz);
  for (int it = gtid; it < NTOK * 8; it += gsz) {
    const int tok = it >> 3, i = it & 7;
    const float inv = (i == 0) ? 1.000000000e+00f : (i == 1) ? 1.939227432e-01f : (i == 2) ? 3.760603070e-02f : (i == 3) ? 7.292664610e-03f : (i == 4) ? 1.414213562e-03f : (i == 5) ? 2.742481884e-04f : (i == 6) ? 5.318295734e-05f : 1.031338525e-05f;
    const float ang = (float)p.pos[tok] * inv;
    float sv, cv;
    sincosf(ang, &sv, &cv);
    p.rope[tok * 16 + i] = cv;
    p.rope[tok * 16 + 8 + i] = sv;
  }
  for (int o = gw; o < 256; o += nw) {
    const int ty = o >> 7, n = o & 127;
    float s = 0.f;
    for (int k = lane; k < 2048; k += 64)
      s += p.cmp_pos[ty * 2048 + k] * p.cmp_w1[((size_t)ty * 2048 + k) * 128 + n];
    s = wave_sum(s);
    if (lane == 0) p.biasp[o] = s + p.cmp_b1[o];
  }
  for (int it = gtid; it < NTOK; it += gsz) { p.ssq1[it] = 0.f; p.ssq2[it] = 0.f; }
}

template <bool DB, class AF>
DEVI void gemm_mainloop(int tid, u16* sA, u16* sB, AF af, const u16* __restrict__ Bt, int ldb, int m0, int n0, int nk,
                        f32x4 (&acc)[4][4]) {
  const int lane = tid & 63, w = tid >> 6;
  const int wm = w >> 1, wn = w & 1, col = lane & 15, quad = lane >> 4;
#pragma unroll
  for (int i = 0; i < 4; ++i)
#pragma unroll
    for (int j = 0; j < 4; ++j) acc[i][j] = f32x4{0.f, 0.f, 0.f, 0.f};
  uint4 ra0, ra1, ra2, ra3, rb0, rb1, rb2, rb3;
  const int lrow = tid >> 3, lkc = (tid & 7) << 3;
  const u16* bbase = Bt + (size_t)(n0 + lrow) * ldb + lkc;
#define GL_(R, i, kk)                                                     \
  R##a##i = *(const uint4*)af(m0 + lrow + 32 * i, (kk) + lkc);            \
  R##b##i = *(const uint4*)(bbase + (size_t)(32 * i) * ldb + (kk));
#define SS_(R, i, off)                                                    \
  *(uint4*)(sA + (off) + (lrow + 32 * i) * 72 + lkc) = R##a##i;           \
  *(uint4*)(sB + (off) + (lrow + 32 * i) * 72 + lkc) = R##b##i;
#define GL4_(R, kk) GL_(R, 0, kk) GL_(R, 1, kk) GL_(R, 2, kk) GL_(R, 3, kk)
#define SS4_(R, off) SS_(R, 0, off) SS_(R, 1, off) SS_(R, 2, off) SS_(R, 3, off)
#define COMPUTE_(cur)                                                                                                   \
  _Pragma("unroll") for (int ks = 0; ks < 2; ++ks) {                                                                    \
    bf16x8 fa[4], fb[4];                                                                                                \
    _Pragma("unroll") for (int mi = 0; mi < 4; ++mi)                                                                    \
      fa[mi] = *(const bf16x8*)(sA + (cur) + (wm * 64 + 16 * mi + col) * 72 + 32 * ks + 8 * quad);                      \
    _Pragma("unroll") for (int ni = 0; ni < 4; ++ni)                                                                    \
      fb[ni] = *(const bf16x8*)(sB + (cur) + (wn * 64 + 16 * ni + col) * 72 + 32 * ks + 8 * quad);                      \
    _Pragma("unroll") for (int ni = 0; ni < 4; ++ni)                                                                    \
      _Pragma("unroll") for (int mi = 0; mi < 4; ++mi) acc[ni][mi] = mfma16(fb[ni], fa[mi], acc[ni][mi]);               \
  }
  if (DB) {
    const int srow = 8 * w + (lane >> 3);
    const int spc = lane & 7;
#define STAGE_(st, kk)                                                                                         \
    _Pragma("unroll") for (int i = 0; i < 4; ++i) {                                                            \
      const int r_ = 32 * i + srow;                                                                            \
      const int c_ = (spc ^ ((r_ >> 1) & 7)) << 3;                                                             \
      __builtin_amdgcn_global_load_lds((const unsigned*)af(m0 + r_, (kk) + c_),                                \
                                       (unsigned*)(sA + (st) * 16384 + (32 * i + 8 * w) * 64), 16, 0, 0);      \
      __builtin_amdgcn_global_load_lds((const unsigned*)(Bt + (size_t)(n0 + r_) * ldb + (kk) + c_),            \
                                       (unsigned*)(sA + (st) * 16384 + 8192 + (32 * i + 8 * w) * 64), 16, 0, 0); \
    }
#define COMPUTE_SW_(st)                                                                                                 \
  _Pragma("unroll") for (int ks = 0; ks < 2; ++ks) {                                                                    \
    bf16x8 fa[4], fb[4];                                                                                                \
    const int pc_ = ((4 * ks + quad) ^ ((col >> 1) & 7)) << 3;                                                          \
    _Pragma("unroll") for (int mi = 0; mi < 4; ++mi)                                                                    \
      fa[mi] = *(const bf16x8*)(sA + (st) * 16384 + (wm * 64 + 16 * mi + col) * 64 + pc_);                              \
    _Pragma("unroll") for (int ni = 0; ni < 4; ++ni)                                                                    \
      fb[ni] = *(const bf16x8*)(sA + (st) * 16384 + 8192 + (wn * 64 + 16 * ni + col) * 64 + pc_);                       \
    _Pragma("unroll") for (int ni = 0; ni < 4; ++ni)                                                                    \
      _Pragma("unroll") for (int mi = 0; mi < 4; ++mi) acc[ni][mi] = mfma16(fb[ni], fa[mi], acc[ni][mi]);               \
  }
    STAGE_(0, 0)
#pragma unroll 1
    for (int kt = 0; kt < nk; kt += 2) {
      asm volatile("s_waitcnt vmcnt(0)" ::: "memory");
      __syncthreads();
      { const int kk = (kt + 1) * 64; STAGE_(1, kk) }
      COMPUTE_SW_(0)
      asm volatile("s_waitcnt vmcnt(0)" ::: "memory");
      __syncthreads();
      if (kt + 2 < nk) { const int kk = (kt + 2) * 64; STAGE_(0, kk) }
      COMPUTE_SW_(1)
    }
#undef STAGE_
#undef COMPUTE_SW_
  } else {
    GL4_(r, 0)
    SS4_(r, 0)
    __syncthreads();
#pragma unroll 1
    for (int kt = 0; kt < nk; ++kt) {
      const bool more = (kt + 1 < nk);
      if (more) { const int kk = (kt + 1) * 64; GL4_(r, kk) }
      COMPUTE_(0)
      __syncthreads();
      if (more) {
        SS4_(r, 0)
        __syncthreads();
      }
    }
  }
#undef GL_
#undef SS_
#undef GL4_
#undef SS4_
#undef COMPUTE_
}

struct ARow {
  const u16* base; int lda;
  DEVI const u16* operator()(int m, int k) const { return base + (size_t)m * lda + k; }
};
struct ACmp {
  const u16* proj; int colbase;
  DEVI const u16* operator()(int rr, int k) const {
    const int b = rr >> 8, g = (rr >> 7) & 1;
    int c = rr & 127; c = c > 126 ? 126 : c;
    const int l = k >> 6, d = k & 63;
    return proj + ((size_t)b * T + 16 * c + l) * LDP + colbase + g * 64 + d;
  }
};


#define XCD_TILE_LOOP(idx, MT, NT)                                                                     \
  const bool sw_ = (gridDim.x & 7) == 0;                                                               \
  const int xcd_ = blockIdx.x & 7;                                                                     \
  const int tstart_ = sw_ ? (int)(blockIdx.x >> 3) : (int)blockIdx.x;                                  \
  const int tstep_ = sw_ ? (int)(gridDim.x >> 3) : (int)gridDim.x;                                     \
  const int ttotal_ = sw_ ? ((MT) / 8) * (NT) : (MT) * (NT);                                           \
  _Pragma("unroll 1") for (int idx = tstart_; idx < ttotal_; idx += tstep_)
#define XCD_TILE_MT(idx, NT) (sw_ ? ((idx) / (NT)) * 8 + xcd_ : (idx) / (NT))
#define XCD_TILE_NT(idx, NT) ((idx) % (NT))

#define GEMM_LANE_VARS                                                    \
  const int tid = launder(threadIdx.x), lane = tid & 63, w = tid >> 6;    \
  const int wm = w >> 1, wn = w & 1, col = lane & 15, quad = lane >> 4;   \
  (void)wm; (void)wn; (void)col; (void)quad;

DEVI void phase1(const Params& p, unsigned char* smem) {
  u16* sA = (u16*)smem; u16* sB = sA + 128 * 72;
  XCD_TILE_LOOP(idx, 256 + 32, 19) {
    GEMM_LANE_VARS
    f32x4 acc[4][4];
    const int mt = XCD_TILE_MT(idx, 19), nt_ = XCD_TILE_NT(idx, 19);
    if (mt < 256) {
      const int m0 = mt * 128, n0 = nt_ * 128;
      gemm_mainloop<true>(tid, sA, sB, ARow{p.hn, LDA}, p.winT, LDA, m0, n0, 16, acc);
#pragma unroll
      for (int mi = 0; mi < 4; ++mi) {
        const int m = m0 + wm * 64 + 16 * mi + col;
        const int b = m >> 11, t = m & 2047;
#pragma unroll
        for (int ni = 0; ni < 4; ++ni) {
          const int nt = n0 + wn * 64 + 16 * ni;
          const int n = nt + 4 * quad;
          f32x4 v = acc[ni][mi];
          if (nt >= LDP) continue;
          if ((nt >= C_VS && nt < C_KW) || (nt >= C_VW && nt < C_GATE)) {
            const bool isw = nt >= C_VW;
            const int off = n - (isw ? C_VW : C_VS);
            const int g = off >> 6, d = off & 63;
            u16* dst = (isw ? p.vtw : p.vts) + ((size_t)(b * 2 + g) * 64 + d) * LDT + t;
#pragma unroll
            for (int r = 0; r < 4; ++r) dst[(size_t)r * LDT] = f2bf(v[r]);
          } else {
            const bool rope_tile = ((nt >= C_KS && nt < C_VS) || (nt >= C_KW && nt < C_VW)) && ((nt & 63) == 0);
            if (rope_tile) {
#pragma unroll
              for (int r = 0; r < 4; ++r) {
                const float pr = __shfl_xor(v[r], 32);
                const int i = ((quad & 1) << 2) + r;
                const float cs = p.rope[(size_t)m * 16 + i], sn = p.rope[(size_t)m * 16 + 8 + i];
                v[r] = (quad < 2) ? (v[r] * cs - pr * sn) : (v[r] * cs + pr * sn);
              }
            }
            uint2 pk; pk.x = pack2(v[0], v[1]); pk.y = pack2(v[2], v[3]);
            *(uint2*)(p.proj + (size_t)m * LDP + n) = pk;
          }
        }
      }
    } else if (nt_ < 16) {
      const int isv = nt_ >> 3;
      const int m0 = (mt - 256) * 128, n0 = (nt_ & 7) * 128;
      gemm_mainloop<true>(tid, sA, sB, ARow{p.memn, LDA}, isv ? p.wmvT : p.wmkT, LDA, m0, n0, 16, acc);
#pragma unroll
      for (int mi = 0; mi < 4; ++mi) {
        const int m = m0 + wm * 64 + 16 * mi + col;
        const int b = m >> 8, key = m & 255;
#pragma unroll
        for (int ni = 0; ni < 4; ++ni) {
          const int n = n0 + wn * 64 + 16 * ni + 4 * quad;
          const f32x4 v = acc[ni][mi];
          if (isv) {
            const int head = n >> 8, d = n & 255;
            u16* dst = p.memvt + ((size_t)(b * 4 + head) * 256 + d) * 256 + key;
#pragma unroll
            for (int r = 0; r < 4; ++r) dst[r * 256] = f2bf(v[r]);
          } else {
            uint2 pk; pk.x = pack2(v[0], v[1]); pk.y = pack2(v[2], v[3]);
            *(uint2*)(p.memk + (size_t)m * LDA + n) = pk;
          }
        }
      }
    }
  }
}

DEVI void conv_tile(const Params& p, unsigned char* smem, int ct) {
  u16* sU = (u16*)smem;
  float2* sRed = (float2*)(smem + 62 * 512 * 2);
  const int tid = launder(threadIdx.x), lane = tid & 63, w = tid >> 6;
  const int b = ct >> 6, t0 = (ct & 63) * 32;
  __syncthreads();
  for (int it = tid; it < 62 * 64; it += 256) {
    const int r = it >> 6, c8 = it & 63;
    const int t = t0 - 30 + r;
    uint4 pk = {0u, 0u, 0u, 0u};
    if (t >= 0) {
      const u16* src = p.proj + ((size_t)b * T + t) * LDP + c8 * 8;
      const uint4 a = *(const uint4*)src, bb = *(const uint4*)(src + 512);
      const unsigned au[4] = {a.x, a.y, a.z, a.w}, bu[4] = {bb.x, bb.y, bb.z, bb.w};
      unsigned o[4];
#pragma unroll
      for (int j = 0; j < 4; ++j) {
        const float a0 = __uint_as_float(au[j] << 16), a1 = __uint_as_float(au[j] & 0xffff0000u);
        const float b0 = __uint_as_float(bu[j] << 16), b1 = __uint_as_float(bu[j] & 0xffff0000u);
        o[j] = pack2(a0 * sigmoidf_(b0), a1 * sigmoidf_(b1));
      }
      pk.x = o[0]; pk.y = o[1]; pk.z = o[2]; pk.w = o[3];
    }
    *(uint4*)(sU + r * 512 + c8 * 8) = pk;
  }
  const int c = 2 * tid;
  float w0[31], w1[31];
#pragma unroll
  for (int j = 0; j < 31; ++j) { w0[j] = p.conv_w[j * 512 + c]; w1[j] = p.conv_w[j * 512 + c + 1]; }
  const float bd0 = p.conv_b[c], bd1 = p.conv_b[c + 1];
  __syncthreads();
  for (int tt = 0; tt < 32; ++tt) {
    float y0 = bd0, y1 = bd1;
#pragma unroll
    for (int j = 0; j < 31; ++j) {
      const unsigned uu = *(const unsigned*)(sU + (tt + j) * 512 + c);
      y0 += w0[j] * __uint_as_float(uu << 16);
      y1 += w1[j] * __uint_as_float(uu & 0xffff0000u);
    }
    float s = y0 + y1, q = y0 * y0 + y1 * y1;
    s = wave_sum(s); q = wave_sum(q);
    if (lane == 0) sRed[tt * 4 + w] = make_float2(s, q);
  }
  __syncthreads();
  const float g0 = p.ln_g[c], g1 = p.ln_g[c + 1], lb0 = p.ln_b[c], lb1 = p.ln_b[c + 1];
  for (int tt = 0; tt < 32; ++tt) {
    float y0 = bd0, y1 = bd1;
#pragma unroll
    for (int j = 0; j < 31; ++j) {
      const unsigned uu = *(const unsigned*)(sU + (tt + j) * 512 + c);
      y0 += w0[j] * __uint_as_float(uu << 16);
      y1 += w1[j] * __uint_as_float(uu & 0xffff0000u);
    }
    const float2 r0 = sRed[tt * 4 + 0], r1 = sRed[tt * 4 + 1], r2 = sRed[tt * 4 + 2], r3 = sRed[tt * 4 + 3];
    const float S = r0.x + r1.x + r2.x + r3.x, Q = r0.y + r1.y + r2.y + r3.y;
    const float mu = S * (1.f / 512.f);
    const float var = fmaxf(Q * (1.f / 512.f) - mu * mu, 0.f);
    const float rstd = rsqrtf(var + 1e-6f);
    const float z0 = (y0 - mu) * rstd * g0 + lb0, z1 = (y1 - mu) * rstd * g1 + lb1;
    const float o0 = z0 * sigmoidf_(z0), o1 = z1 * sigmoidf_(z1);
    *(unsigned*)(p.mix + ((size_t)b * T + t0 + tt) * LDA + c) = pack2(o0, o1);
  }
}

DEVI void phase2(const Params& p, unsigned char* smem) {
  u16* sA = (u16*)smem; u16* sB = sA + 128 * 72;
#pragma unroll 1
  for (int tile = blockIdx.x; tile < 64 + 1024; tile += gridDim.x) {
    GEMM_LANE_VARS
    if (tile < 64) {
      const int ty = tile >> 5, mt = tile & 31;
      const int m0 = mt * 128;
      f32x4 acc[4][4];
      gemm_mainloop<true>(tid, sA, sB, ACmp{p.proj, ty ? C_VC : C_KC}, p.w1T + (size_t)ty * 128 * LDW1, LDW1, m0, 0, 32, acc);
#pragma unroll
      for (int mi = 0; mi < 4; ++mi) {
        const int m = m0 + wm * 64 + 16 * mi + col;
#pragma unroll
        for (int ni = 0; ni < 4; ++ni) {
          const int n = wn * 64 + 16 * ni + 4 * quad;
          const f32x4 v = acc[ni][mi];
          const float4 bb = *(const float4*)(p.biasp + ty * 128 + n);
          uint2 pk;
          pk.x = pack2(gelu_tanh(v[0] + bb.x), gelu_tanh(v[1] + bb.y));
          pk.y = pack2(gelu_tanh(v[2] + bb.z), gelu_tanh(v[3] + bb.w));
          *(uint2*)(p.hdn + ((size_t)ty * 4096 + m) * 128 + n) = pk;
        }
      }
    } else {
      conv_tile(p, smem, tile - 64);
    }
  }
}

DEVI void phase3(const Params& p, unsigned char* smem) {
  u16* sA = (u16*)smem; u16* sB = sA + 128 * 72;
#pragma unroll 1
  for (int tile = blockIdx.x; tile < 64; tile += gridDim.x) {
    GEMM_LANE_VARS
    const int ty = tile >> 5, mt = tile & 31;
    const int m0 = mt * 128;
    f32x4 acc[4][4];
    gemm_mainloop<true>(tid, sA, sB, ARow{p.hdn + (size_t)ty * 4096 * 128, 128}, p.w2T + (size_t)ty * 128 * 128, 128, m0, 0, 2, acc);
    if (wn == 0) {
#pragma unroll
      for (int mi = 0; mi < 4; ++mi) {
        const int m = m0 + 16 * mi + wm * 64 + col;
        const int bg = m >> 7, c = m & 127;
#pragma unroll
        for (int ni = 0; ni < 4; ++ni) {
          const int n = 16 * ni + 4 * quad;
          const f32x4 v = acc[ni][mi];
          const float4 bb = *(const float4*)(p.cmp_b2 + ty * 64 + n);
          const float o0 = v[0] + bb.x, o1 = v[1] + bb.y, o2 = v[2] + bb.z, o3 = v[3] + bb.w;
          if (ty == 0) {
            uint2 pk; pk.x = pack2(o0, o1); pk.y = pack2(o2, o3);
            *(uint2*)(p.kc + (size_t)m * 64 + n) = pk;
          } else {
            u16* dst = p.vcT + ((size_t)bg * 64 + n) * 128 + c;
            dst[0] = f2bf(o0); dst[128] = f2bf(o1); dst[256] = f2bf(o2); dst[384] = f2bf(o3);
          }
        }
      }
    }
  }
}

template <int DH, int NQ, int LDK, int LDV, class MaskF>
DEVI void attn_tile(const u16* sK, const u16* sVt, const bf16x8 (&qf)[NQ][DH / 32], f32x4 (&o)[NQ][DH / 16],
                    float (&m)[NQ], float (&l)[NQ], float c2, int lane, MaskF valid) {
  const int col = lane & 15, quad = lane >> 4;
  f32x4 s[NQ][4];
#pragma unroll
  for (int kt = 0; kt < 4; ++kt) {
#pragma unroll
    for (int qt = 0; qt < NQ; ++qt) s[qt][kt] = f32x4{0.f, 0.f, 0.f, 0.f};
#pragma unroll
    for (int ks = 0; ks < DH / 32; ++ks) {
      const bf16x8 kf = *(const bf16x8*)(sK + (16 * kt + col) * LDK + 32 * ks + 8 * quad);
#pragma unroll
      for (int qt = 0; qt < NQ; ++qt) s[qt][kt] = mfma16(kf, qf[qt][ks], s[qt][kt]);
    }
  }
  bf16x8 pb[NQ][2];
#pragma unroll
  for (int qt = 0; qt < NQ; ++qt) {
    float mx = -1e30f;
#pragma unroll
    for (int kt = 0; kt < 4; ++kt)
#pragma unroll
      for (int r = 0; r < 4; ++r) {
        const bool v = valid(qt, 16 * kt + 4 * quad + r);
        const float sv = v ? s[qt][kt][r] : -1e30f;
        s[qt][kt][r] = sv;
        mx = fmaxf(mx, sv);
      }
    mx = fmaxf(mx, __shfl_xor(mx, 16));
    mx = fmaxf(mx, __shfl_xor(mx, 32));
    const float mn = fmaxf(m[qt], mx);
    const float alpha = fexp2((m[qt] - mn) * c2);
    m[qt] = mn;
    float ps = 0.f;
#pragma unroll
    for (int kt = 0; kt < 4; ++kt)
#pragma unroll
      for (int r = 0; r < 4; ++r) {
        const float sv = s[qt][kt][r];
        const float pv = (sv > -1e29f) ? fexp2((sv - mn) * c2) : 0.f;
        ps += pv;
        s[qt][kt][r] = pv;
      }
    l[qt] = l[qt] * alpha + ps;
#pragma unroll
    for (int dt = 0; dt < DH / 16; ++dt) o[qt][dt] *= alpha;
#pragma unroll
    for (int kk = 0; kk < 2; ++kk) {
      union { bf16x8 v; unsigned u[4]; } cv;
      cv.u[0] = pack2(s[qt][2 * kk][0], s[qt][2 * kk][1]);
      cv.u[1] = pack2(s[qt][2 * kk][2], s[qt][2 * kk][3]);
      cv.u[2] = pack2(s[qt][2 * kk + 1][0], s[qt][2 * kk + 1][1]);
      cv.u[3] = pack2(s[qt][2 * kk + 1][2], s[qt][2 * kk + 1][3]);
      pb[qt][kk] = cv.v;
    }
  }
#pragma unroll
  for (int dt = 0; dt < DH / 16; ++dt) {
#pragma unroll
    for (int kk = 0; kk < 2; ++kk) {
      union { bf16x8 v; uint2 h[2]; } cv;
      cv.h[0] = *(const uint2*)(sVt + (16 * dt + col) * LDV + 32 * kk + 4 * quad);
      cv.h[1] = *(const uint2*)(sVt + (16 * dt + col) * LDV + 32 * kk + 16 + 4 * quad);
#pragma unroll
      for (int qt = 0; qt < NQ; ++qt) o[qt][dt] = mfma16(cv.v, pb[qt][kk], o[qt][dt]);
    }
  }
}

DEVI void phase_nsa(const Params& p, unsigned char* smem) {
  u16* sK = (u16*)smem;
  u16* sVt = (u16*)(smem + 18432);
  float* impH = (float*)(smem + 35840);
  float* impT = (float*)(smem + 52736);
  unsigned* selm = (unsigned*)(smem + 56960);
  const float c2 = 0.125f * 1.4426950408889634f;
#pragma unroll 1
  for (int tile = blockIdx.x; tile < 2048; tile += gridDim.x) {
    const int tid = launder(threadIdx.x), lane = tid & 63, w = tid >> 6, col = lane & 15, quad = lane >> 4;
    const int qtile = 63 - (tile >> 5), bg = tile & 31, b = bg >> 1, g = bg & 1, q0 = qtile * 32;
    const int h = g * 4 + w;
    __syncthreads();
    if (tid < 32) selm[tid] = 0u;
    {
      const u16* kcp = p.kc + (size_t)bg * 128 * 64;
      const u16* vcp = p.vcT + (size_t)bg * 64 * 128;
#pragma unroll
      for (int i = 0; i < 4; ++i) {
        const int c = tid + 256 * i;
        const int row = c >> 3, ch = (c & 7) << 3;
        *(uint4*)(sK + row * 72 + ch) = *(const uint4*)(kcp + row * 64 + ch);
        const int row2 = c >> 4, ch2 = (c & 15) << 3;
        *(uint4*)(sVt + row2 * 136 + ch2) = *(const uint4*)(vcp + row2 * 128 + ch2);
      }
    }
    bf16x8 qf[2][2];
    float gate[2][3];
    int tq[2];
#pragma unroll
    for (int qt = 0; qt < 2; ++qt) {
      const int t = q0 + 16 * qt + col;
      tq[qt] = t;
      const size_t tok = (size_t)b * T + t;
      const u16* qp = p.proj + tok * LDP + C_Q + h * 64 + 8 * quad;
      qf[qt][0] = *(const bf16x8*)qp;
      qf[qt][1] = *(const bf16x8*)(qp + 32);
#pragma unroll
      for (int br = 0; br < 3; ++br) gate[qt][br] = sigmoidf_(bf2f(p.proj[tok * LDP + C_GATE + h * 3 + br]));
    }
    __syncthreads();

    f32x4 comb[2][4];
    {
      const int srcl = (lane + 48) & 63;
#pragma unroll
      for (int qt = 0; qt < 2; ++qt) {
        f32x4 s[8];
#pragma unroll
        for (int kt = 0; kt < 8; ++kt) {
          s[kt] = f32x4{0.f, 0.f, 0.f, 0.f};
#pragma unroll
          for (int ks = 0; ks < 2; ++ks) {
            const bf16x8 kf = *(const bf16x8*)(sK + (16 * kt + col) * 72 + 32 * ks + 8 * quad);
            s[kt] = mfma16(kf, qf[qt][ks], s[kt]);
          }
        }
        const int t = tq[qt];
        float mx = -1e30f;
#pragma unroll
        for (int kt = 0; kt < 8; ++kt)
#pragma unroll
          for (int r = 0; r < 4; ++r) {
            const int c = 16 * kt + 4 * quad + r;
            const bool v = (16 * c + 31) <= t;
            const float sv = v ? s[kt][r] : -1e30f;
            s[kt][r] = sv;
            mx = fmaxf(mx, sv);
          }
        mx = fmaxf(mx, __shfl_xor(mx, 16));
        mx = fmaxf(mx, __shfl_xor(mx, 32));
        float ps = 0.f;
#pragma unroll
        for (int kt = 0; kt < 8; ++kt)
#pragma unroll
          for (int r = 0; r < 4; ++r) {
            const float sv = s[kt][r];
            const float pv = (sv > -1e29f) ? fexp2((sv - mx) * c2) : 0.f;
            ps += pv;
            s[kt][r] = pv;
          }
        ps += __shfl_xor(ps, 16);
        ps += __shfl_xor(ps, 32);
        const float inv = ps > 0.f ? 1.f / ps : 0.f;
#pragma unroll
        for (int kt = 0; kt < 8; ++kt)
#pragma unroll
          for (int r = 0; r < 4; ++r) s[kt][r] *= inv;
        float prev3 = 0.f;
#pragma unroll
        for (int kt = 0; kt < 8; ++kt) {
          const float sum4 = s[kt][0] + s[kt][1] + s[kt][2] + s[kt][3];
          const float xs = __shfl(s[kt][3], srcl);
          const float extra = quad ? xs : prev3;
          prev3 = xs;
          impH[(w * 32 + 16 * qt + col) * 33 + 4 * kt + quad] = sum4 + extra;
        }
        bf16x8 pb[4];
#pragma unroll
        for (int kk = 0; kk < 4; ++kk) {
          union { bf16x8 v; unsigned u[4]; } cv;
          cv.u[0] = pack2(s[2 * kk][0], s[2 * kk][1]);
          cv.u[1] = pack2(s[2 * kk][2], s[2 * kk][3]);
          cv.u[2] = pack2(s[2 * kk + 1][0], s[2 * kk + 1][1]);
          cv.u[3] = pack2(s[2 * kk + 1][2], s[2 * kk + 1][3]);
          pb[kk] = cv.v;
        }
#pragma unroll
        for (int dt = 0; dt < 4; ++dt) {
          f32x4 oc = f32x4{0.f, 0.f, 0.f, 0.f};
#pragma unroll
          for (int kk = 0; kk < 4; ++kk) {
            union { bf16x8 v; uint2 hh[2]; } cv;
            cv.hh[0] = *(const uint2*)(sVt + (16 * dt + col) * 136 + 32 * kk + 4 * quad);
            cv.hh[1] = *(const uint2*)(sVt + (16 * dt + col) * 136 + 32 * kk + 16 + 4 * quad);
            oc = mfma16(cv.v, pb[kk], oc);
          }
          comb[qt][dt] = oc * gate[qt][0];
        }
      }
    }
#pragma unroll
    for (int qt = 0; qt < 2; ++qt) {
      const size_t tok = (size_t)b * T + tq[qt];
      union { bf16x8 v; unsigned u[4]; } own, par, res;
      own.v = qf[qt][0];
#pragma unroll
      for (int j = 0; j < 4; ++j) par.u[j] = (unsigned)__shfl_xor((int)own.u[j], 16);
      const float4 c0 = *(const float4*)(p.rope + tok * 16), c1 = *(const float4*)(p.rope + tok * 16 + 4);
      const float4 s0 = *(const float4*)(p.rope + tok * 16 + 8), s1 = *(const float4*)(p.rope + tok * 16 + 12);
      const float cs[8] = {c0.x, c0.y, c0.z, c0.w, c1.x, c1.y, c1.z, c1.w};
      const float sn[8] = {s0.x, s0.y, s0.z, s0.w, s1.x, s1.y, s1.z, s1.w};
#pragma unroll
      for (int j = 0; j < 4; ++j) {
        const float o0 = __uint_as_float(own.u[j] << 16), o1 = __uint_as_float(own.u[j] & 0xffff0000u);
        const float p0 = __uint_as_float(par.u[j] << 16), p1 = __uint_as_float(par.u[j] & 0xffff0000u);
        const float sg = (quad == 0) ? -1.f : 1.f;
        const float r0 = o0 * cs[2 * j] + sg * p0 * sn[2 * j];
        const float r1 = o1 * cs[2 * j + 1] + sg * p1 * sn[2 * j + 1];
        res.u[j] = (quad < 2) ? pack2(r0, r1) : own.u[j];
      }
      qf[qt][0] = res.v;
    }
    __syncthreads();
#pragma unroll
    for (int i = 0; i < 4; ++i) {
      const int cell = tid + 256 * i;
      const int qi = cell >> 5, s_ = cell & 31;
      const int cur = (q0 + qi) >> 6;
      float v = impH[(0 * 32 + qi) * 33 + s_] + impH[(1 * 32 + qi) * 33 + s_] + impH[(2 * 32 + qi) * 33 + s_] +
                impH[(3 * 32 + qi) * 33 + s_];
      const int dist = cur - s_;
      const bool forced = (s_ == 0) || (dist >= 0 && dist < 2);
      v = forced ? 1e9f : (s_ <= cur ? v : -1.f);
      impT[qi * 33 + s_] = v;
    }
    __syncthreads();
    {
      const int qi = tid >> 3, sub = tid & 7;
      unsigned bits = 0u;
#pragma unroll
      for (int k = 0; k < 4; ++k) {
        const int s_ = sub * 4 + k;
        const float v = impT[qi * 33 + s_];
        int rank = 0;
        for (int s2 = 0; s2 < 32; ++s2) {
          const float v2 = impT[qi * 33 + s2];
          rank += ((v2 > v) || (v2 == v && s2 < s_)) ? 1 : 0;
        }
        if (rank < 16) bits |= 1u << s_;
      }
      atomicOr(&selm[qi], bits);
    }
    __syncthreads();
    unsigned sm[2] = {selm[col], selm[16 + col]};
    unsigned uni = 0u;
#pragma unroll
    for (int i = 0; i < 32; ++i) uni |= selm[i];
    const int kbmax = (q0 + 31) >> 6;
    {
      float m[2] = {-1e30f, -1e30f}, l[2] = {0.f, 0.f};
      f32x4 o[2][4];
#pragma unroll
      for (int qt = 0; qt < 2; ++qt)
#pragma unroll
        for (int dt = 0; dt < 4; ++dt) o[qt][dt] = f32x4{0.f, 0.f, 0.f, 0.f};
#pragma unroll 1
      for (int kb = 0; kb <= kbmax; ++kb) {
        if (!((uni >> kb) & 1u)) continue;
        __syncthreads();
#pragma unroll
        for (int i = 0; i < 2; ++i) {
          const int c = tid + 256 * i, row = c >> 3, ch = (c & 7) << 3;
          *(uint4*)(sK + row * 72 + ch) = *(const uint4*)(p.proj + ((size_t)b * T + kb * 64 + row) * LDP + C_KS + g * 64 + ch);
          *(uint4*)(sVt + row * 72 + ch) = *(const uint4*)(p.vts + ((size_t)bg * 64 + row) * LDT + kb * 64 + ch);
        }
        __syncthreads();
        attn_tile<64, 2, 72, 72>(sK, sVt, qf, o, m, l, c2, lane, [&](int qt, int kl) {
          const int kp = kb * 64 + kl;
          return (((sm[qt] >> kb) & 1u) != 0u) && (kp <= tq[qt]);
        });
      }
#pragma unroll
      for (int qt = 0; qt < 2; ++qt) {
        float lt = l[qt];
        lt += __shfl_xor(lt, 16);
        lt += __shfl_xor(lt, 32);
        const float sc = lt > 0.f ? gate[qt][1] / lt : 0.f;
#pragma unroll
        for (int dt = 0; dt < 4; ++dt) comb[qt][dt] += o[qt][dt] * sc;
      }
    }
    {
      float m[2] = {-1e30f, -1e30f}, l[2] = {0.f, 0.f};
      f32x4 o[2][4];
#pragma unroll
      for (int qt = 0; qt < 2; ++qt)
#pragma unroll
        for (int dt = 0; dt < 4; ++dt) o[qt][dt] = f32x4{0.f, 0.f, 0.f, 0.f};
      const int kblo = (q0 >= 511) ? ((q0 - 511) >> 6) : 0;
#pragma unroll 1
      for (int kb = kblo; kb <= kbmax; ++kb) {
        __syncthreads();
#pragma unroll
        for (int i = 0; i < 2; ++i) {
          const int c = tid + 256 * i, row = c >> 3, ch = (c & 7) << 3;
          *(uint4*)(sK + row * 72 + ch) = *(const uint4*)(p.proj + ((size_t)b * T + kb * 64 + row) * LDP + C_KW + g * 64 + ch);
          *(uint4*)(sVt + row * 72 + ch) = *(const uint4*)(p.vtw + ((size_t)bg * 64 + row) * LDT + kb * 64 + ch);
        }
        __syncthreads();
        attn_tile<64, 2, 72, 72>(sK, sVt, qf, o, m, l, c2, lane, [&](int qt, int kl) {
          const int kp = kb * 64 + kl;
          return (kp <= tq[qt]) && (kp > tq[qt] - 512);
        });
      }
#pragma unroll
      for (int qt = 0; qt < 2; ++qt) {
        float lt = l[qt];
        lt += __shfl_xor(lt, 16);
        lt += __shfl_xor(lt, 32);
        const float sc = lt > 0.f ? gate[qt][2] / lt : 0.f;
#pragma unroll
        for (int dt = 0; dt < 4; ++dt) comb[qt][dt] += o[qt][dt] * sc;
      }
    }
#pragma unroll
    for (int qt = 0; qt < 2; ++qt) {
      const size_t tok = (size_t)b * T + tq[qt];
#pragma unroll
      for (int dt = 0; dt < 4; ++dt) {
        uint2 pk;
        pk.x = pack2(comb[qt][dt][0], comb[qt][dt][1]);
        pk.y = pack2(comb[qt][dt][2], comb[qt][dt][3]);
        *(uint2*)(p.mix + tok * LDA + 512 + h * 64 + 16 * dt + 4 * quad) = pk;
      }
    }
  }
}

DEVI void phase_resid(const Params& p, unsigned char* smem, const u16* A, const u16* Wt, const float* res, int ldres, float* ssq) {
  u16* sA = (u16*)smem; u16* sB = sA + 128 * 72;
  XCD_TILE_LOOP(idx, 256, 8) {
    GEMM_LANE_VARS
    const int mt = XCD_TILE_MT(idx, 8), nt_ = XCD_TILE_NT(idx, 8);
    const int m0 = mt * 128, n0 = nt_ * 128;
    f32x4 acc[4][4];
    gemm_mainloop<true>(tid, sA, sB, ARow{A, LDA}, Wt, LDA, m0, n0, 16, acc);
#pragma unroll
    for (int mi = 0; mi < 4; ++mi) {
      const int m = m0 + wm * 64 + 16 * mi + col;
      float ss = 0.f;
#pragma unroll
      for (int ni = 0; ni < 4; ++ni) {
        const int n = n0 + wn * 64 + 16 * ni + 4 * quad;
        const f32x4 v = acc[ni][mi];
        const float4 r = *(const float4*)(res + (size_t)m * ldres + n);
        float4 hv;
        hv.x = r.x + v[0]; hv.y = r.y + v[1]; hv.z = r.z + v[2]; hv.w = r.w + v[3];
        ss += hv.x * hv.x + hv.y * hv.y + hv.z * hv.z + hv.w * hv.w;
        *(float4*)(p.h + (size_t)m * LDHF + n) = hv;
        uint2 pk; pk.x = pack2(hv.x, hv.y); pk.y = pack2(hv.z, hv.w);
        *(uint2*)(p.hn + (size_t)m * LDA + n) = pk;
      }
      ss += __shfl_xor(ss, 16);
      ss += __shfl_xor(ss, 32);
      if (quad == 0) atomicAdd(ssq + m, ss);
    }
  }
}

DEVI void phase_scaled(const Params& p, unsigned char* smem, const u16* A, const u16* Wt, int ntn, const float* ssq, u16* outp, int ldo) {
  u16* sA = (u16*)smem; u16* sB = sA + 128 * 72;
  XCD_TILE_LOOP(idx, 256, ntn) {
    GEMM_LANE_VARS
    const int mt = XCD_TILE_MT(idx, ntn), nt_ = XCD_TILE_NT(idx, ntn);
    const int m0 = mt * 128, n0 = nt_ * 128;
    f32x4 acc[4][4];
    gemm_mainloop<true>(tid, sA, sB, ARow{A, LDA}, Wt, LDA, m0, n0, 16, acc);
#pragma unroll
    for (int mi = 0; mi < 4; ++mi) {
      const int m = m0 + wm * 64 + 16 * mi + col;
      const float rstd = rsqrtf(ssq[m] * (1.f / D) + 1e-6f);
#pragma unroll
      for (int ni = 0; ni < 4; ++ni) {
        const int n = n0 + wn * 64 + 16 * ni + 4 * quad;
        const f32x4 v = acc[ni][mi];
        uint2 pk; pk.x = pack2(v[0] * rstd, v[1] * rstd); pk.y = pack2(v[2] * rstd, v[3] * rstd);
        *(uint2*)(outp + (size_t)m * ldo + n) = pk;
      }
    }
  }
}

DEVI void phase_memattn(const Params& p, unsigned char* smem) {
  u16* sK = (u16*)smem;
  u16* sVt = (u16*)(smem + 33792);
  const float c2 = 0.0625f * 1.4426950408889634f;
#pragma unroll 1
  for (int tile = blockIdx.x; tile < 2048; tile += gridDim.x) {
    const int tid = launder(threadIdx.x), lane = tid & 63, w = tid >> 6, col = lane & 15, quad = lane >> 4;
    const int b = tile >> 7, head = (tile >> 5) & 3, q0 = (tile & 31) * 64;
    const size_t tok = (size_t)b * T + q0 + 16 * w + col;
    bf16x8 qf[1][8];
#pragma unroll
    for (int ks = 0; ks < 8; ++ks) qf[0][ks] = *(const bf16x8*)(p.qm + tok * LDA + head * 256 + 32 * ks + 8 * quad);
    float m[1] = {-1e30f}, l[1] = {0.f};
    f32x4 o[1][16];
#pragma unroll
    for (int dt = 0; dt < 16; ++dt) o[0][dt] = f32x4{0.f, 0.f, 0.f, 0.f};
#pragma unroll 1
    for (int kb = 0; kb < 4; ++kb) {
      __syncthreads();
#pragma unroll
      for (int i = 0; i < 8; ++i) {
        const int c = tid + 256 * i;
        const int row = c >> 5, ch = (c & 31) << 3;
        *(uint4*)(sK + row * 264 + ch) = *(const uint4*)(p.memk + ((size_t)b * 256 + kb * 64 + row) * LDA + head * 256 + ch);
      }
      __builtin_amdgcn_sched_barrier(0);
#pragma unroll
      for (int i = 0; i < 8; ++i) {
        const int c = tid + 256 * i;
        const int row2 = c >> 3, ch2 = (c & 7) << 3;
        *(uint4*)(sVt + row2 * 72 + ch2) = *(const uint4*)(p.memvt + ((size_t)(b * 4 + head) * 256 + row2) * 256 + kb * 64 + ch2);
      }
      __syncthreads();
      attn_tile<256, 1, 264, 72>(sK, sVt, qf, o, m, l, c2, lane, [&](int, int) { return true; });
    }
    float lt = l[0];
    lt += __shfl_xor(lt, 16);
    lt += __shfl_xor(lt, 32);
    const float inv = 1.f / lt;
#pragma unroll
    for (int dt = 0; dt < 16; ++dt) {
      uint2 pk;
      pk.x = pack2(o[0][dt][0] * inv, o[0][dt][1] * inv);
      pk.y = pack2(o[0][dt][2] * inv, o[0][dt][3] * inv);
      *(uint2*)(p.mix + tok * LDA + head * 256 + 16 * dt + 4 * quad) = pk;
    }
  }
}

__constant__ unsigned char kCandI[64] = {0,0,0,0,0,0,0,0,0,0,0,0,0,0,0,0, 1,1,1,1,1,1,1,1, 2,2,2,2,2, 3,3,3,3, 4,4,4, 5,5, 6,6, 7,7,
                                          8, 9, 10, 11, 12, 13, 14, 15, 0,0,0,0,0,0,0,0,0,0,0,0,0,0};
__constant__ unsigned char kCandJ[64] = {0,1,2,3,4,5,6,7,8,9,10,11,12,13,14,15, 0,1,2,3,4,5,6,7, 0,1,2,3,4, 0,1,2,3, 0,1,2, 0,1, 0,1, 0,1,
                                          0, 0, 0, 0, 0, 0, 0, 0, 0,0,0,0,0,0,0,0,0,0,0,0,0,0};

DEVI unsigned score_key(float v, int idx) {
  unsigned u = __float_as_uint(v);
  u = (u & 0x80000000u) ? ~u : (u | 0x80000000u);
  return (u & ~127u) | (unsigned)(127 - idx);
}
DEVI float key_score(unsigned k) {
  k &= ~127u;
  const unsigned u = (k & 0x80000000u) ? (k & 0x7fffffffu) : ~k;
  return __uint_as_float(u);
}

DEVI void phase_peer_route(const Params& p, unsigned char* smem) {
  u16* sA = (u16*)smem; u16* sB = sA + 128 * 72;
  unsigned* sScore = (unsigned*)smem;
  unsigned* sTop = (unsigned*)(smem + 36864);
  unsigned* sTmp = (unsigned*)(smem + 53248);
  {
    const int t0_ = launder(threadIdx.x);
    const int gw = (blockIdx.x * 256 + t0_) >> 6, nw = (gridDim.x * 256) >> 6;
    conv_fp8_rows(p.peer_u, p.ub8, p.uscale, 16384, gw, nw, t0_ & 63);
    conv_fp8_rows(p.peer_v, p.vb8, p.vscale, 16384, gw, nw, t0_ & 63);
  }
#pragma unroll 1
  for (int tile = blockIdx.x; tile < 256 * 8; tile += gridDim.x) {
    GEMM_LANE_VARS
    const int mt = tile >> 3, hd = tile & 7;
    const int m0 = mt * 128;
#pragma unroll 1
    for (int ph = 0; ph < 2; ++ph) {
      const int hp = hd * 2 + ph;
      f32x4 acc[4][4];
      __syncthreads();
      gemm_mainloop<false>(tid, sA, sB, ARow{p.pq + hp * 128, LDPQ}, p.subk + (size_t)hp * 128 * 128, 128, m0, 0, 2, acc);
#pragma unroll 1
      for (int hh = 0; hh < 2; ++hh) {
        if (wm == hh) {
#pragma unroll
          for (int mi = 0; mi < 4; ++mi) {
            const int row = 16 * mi + col;
#pragma unroll
            for (int ni = 0; ni < 4; ++ni) {
              const int n = wn * 64 + 16 * ni + 4 * quad;
              const f32x4 v = acc[ni][mi];
              uint4 kk;
              kk.x = score_key(v[0], n); kk.y = score_key(v[1], n + 1);
              kk.z = score_key(v[2], n + 2); kk.w = score_key(v[3], n + 3);
              *(uint4*)(sScore + row * 128 + n) = kk;
            }
          }
        }
        __syncthreads();
#pragma unroll 1
        for (int rg = 0; rg < 4; ++rg) {
          const int rbase = w * 16 + rg * 4;
          unsigned k0[4], k1[4], thr[4];
#pragma unroll
          for (int r = 0; r < 4; ++r) {
            k0[r] = sScore[(rbase + r) * 128 + lane];
            k1[r] = sScore[(rbase + r) * 128 + 64 + lane];
            thr[r] = 0u;
          }
#pragma unroll
          for (int bit = 31; bit >= 0; --bit) {
#pragma unroll
            for (int r = 0; r < 4; ++r) {
              const unsigned cand = thr[r] | (1u << bit);
              const int cnt = __popcll(__ballot(k0[r] >= cand)) + __popcll(__ballot(k1[r] >= cand));
              thr[r] = (cnt >= 16) ? cand : thr[r];
            }
          }
          unsigned* tmp = sTmp + w * 64;
#pragma unroll
          for (int r = 0; r < 4; ++r) {
            const unsigned long long b0 = __ballot(k0[r] >= thr[r]), b1 = __ballot(k1[r] >= thr[r]);
            const int pos0 = __builtin_amdgcn_mbcnt_hi((unsigned)(b0 >> 32), __builtin_amdgcn_mbcnt_lo((unsigned)b0, 0u));
            const int pos1 = __popcll(b0) + __builtin_amdgcn_mbcnt_hi((unsigned)(b1 >> 32), __builtin_amdgcn_mbcnt_lo((unsigned)b1, 0u));
            if (k0[r] >= thr[r]) tmp[r * 16 + pos0] = k0[r];
            if (k1[r] >= thr[r]) tmp[r * 16 + pos1] = k1[r];
          }
          __builtin_amdgcn_fence(__ATOMIC_RELEASE, "wavefront");
          __builtin_amdgcn_wave_barrier();
          __builtin_amdgcn_fence(__ATOMIC_ACQUIRE, "wavefront");
          {
            const int r = lane >> 4, ix = lane & 15;
            const unsigned mine = tmp[r * 16 + ix];
            const uint4 a = *(const uint4*)(tmp + r * 16), b = *(const uint4*)(tmp + r * 16 + 4), c = *(const uint4*)(tmp + r * 16 + 8),
                        d = *(const uint4*)(tmp + r * 16 + 12);
            const int rk = (a.x > mine) + (a.y > mine) + (a.z > mine) + (a.w > mine) + (b.x > mine) + (b.y > mine) + (b.z > mine) + (b.w > mine) +
                           (c.x > mine) + (c.y > mine) + (c.z > mine) + (c.w > mine) + (d.x > mine) + (d.y > mine) + (d.z > mine) + (d.w > mine);
            sTop[((hh * 64 + rbase + r) * 2 + ph) * 16 + rk] = mine;
          }
          __builtin_amdgcn_fence(__ATOMIC_RELEASE, "wavefront");
          __builtin_amdgcn_wave_barrier();
        }
        __syncthreads();
      }
    }
    const int ci = kCandI[lane], cj = kCandJ[lane];
    const bool act = lane < 50;
#pragma unroll 1
    for (int tg = 0; tg < 8; ++tg) {
      const int tb = w * 32 + tg * 4;
      unsigned k0[4], k1[4], ku[4], thr[4];
      float v[4];
#pragma unroll
      for (int r = 0; r < 4; ++r) {
        k0[r] = sTop[((tb + r) * 2 + 0) * 16 + ci];
        k1[r] = sTop[((tb + r) * 2 + 1) * 16 + cj];
        v[r] = key_score(k0[r]) + key_score(k1[r]);
        unsigned u = __float_as_uint(v[r]);
        u = (u & 0x80000000u) ? ~u : (u | 0x80000000u);
        ku[r] = act ? ((u & ~63u) | (unsigned)(63 - lane)) : 0u;
        thr[r] = 0u;
      }
#pragma unroll
      for (int bit = 31; bit >= 0; --bit) {
#pragma unroll
        for (int r = 0; r < 4; ++r) {
          const unsigned cand = thr[r] | (1u << bit);
          const int cnt = __popcll(__ballot(ku[r] >= cand));
          thr[r] = (cnt >= 16) ? cand : thr[r];
        }
      }
#pragma unroll
      for (int r = 0; r < 4; ++r) {
        const bool sel = act && (ku[r] >= thr[r]);
        const unsigned long long ms = __ballot(sel);
        const int slot = __builtin_amdgcn_mbcnt_hi((unsigned)(ms >> 32), __builtin_amdgcn_mbcnt_lo((unsigned)ms, 0u));
        const float vmax = __int_as_float(__builtin_amdgcn_readlane(__float_as_int(v[r]), 0));
        const float e = sel ? __expf(v[r] - vmax) : 0.f;
        const float tot = wave_sum(e);
        if (sel) {
          const int eid = (127 - (int)(k0[r] & 127u)) * 128 + (127 - (int)(k1[r] & 127u));
          const size_t o = (size_t)(m0 + tb + r) * 128 + hd * 16 + slot;
          p.experts[o] = eid;
          p.gates[o] = e / tot;
        }
      }
    }
  }
}

DEVI void phase_peer_gather(const Params& p) {
  const int w0_ = threadIdx.x >> 6;
#pragma unroll 1
  for (int tok = blockIdx.x * 4 + w0_; tok < NTOK; tok += gridDim.x * 4) {
    const int tid = launder(threadIdx.x), lane = tid & 63;
    const float4* hp4 = (const float4*)(p.h + (size_t)tok * LDHF) + lane * 4;
    float hv[16], xn[16], y[16];
    {
      const float4 a0 = hp4[0], a1 = hp4[1], a2 = hp4[2], a3 = hp4[3];
      hv[0] = a0.x; hv[1] = a0.y; hv[2] = a0.z; hv[3] = a0.w; hv[4] = a1.x; hv[5] = a1.y; hv[6] = a1.z; hv[7] = a1.w;
      hv[8] = a2.x; hv[9] = a2.y; hv[10] = a2.z; hv[11] = a2.w; hv[12] = a3.x; hv[13] = a3.y; hv[14] = a3.z; hv[15] = a3.w;
    }
    float ss = 0.f;
#pragma unroll
    for (int i = 0; i < 16; ++i) ss += hv[i] * hv[i];
    ss = wave_sum(ss);
    const float rstd = rsqrtf(ss * (1.f / D) + 1e-6f);
    {
      const float4* g4 = (const float4*)p.peer_g + lane * 4;
      const float4 a0 = g4[0], a1 = g4[1], a2 = g4[2], a3 = g4[3];
      const float gg[16] = {a0.x, a0.y, a0.z, a0.w, a1.x, a1.y, a1.z, a1.w, a2.x, a2.y, a2.z, a2.w, a3.x, a3.y, a3.z, a3.w};
#pragma unroll
      for (int i = 0; i < 16; ++i) { xn[i] = hv[i] * rstd * gg[i]; y[i] = 0.f; }
    }
    const int e0 = p.experts[(size_t)tok * 128 + lane], e1 = p.experts[(size_t)tok * 128 + 64 + lane];
    const float g0 = p.gates[(size_t)tok * 128 + lane], g1 = p.gates[(size_t)tok * 128 + 64 + lane];
    const float su0 = p.uscale[e0], su1 = p.uscale[e1];
    const float sv0 = p.vscale[e0], sv1 = p.vscale[e1];
    float cf0 = 0.f, cf1 = 0.f;
#pragma unroll
    for (int half = 0; half < 2; ++half) {
      const int ev = half ? e1 : e0;
      float dsum = 0.f;
#pragma unroll 1
      for (int k = 0; k < 64; k += 8) {
        uint4 c[8];
#pragma unroll
        for (int u = 0; u < 8; ++u) {
          const int e = __builtin_amdgcn_readlane(ev, k + u);
          c[u] = ((const uint4*)(p.ub8 + (size_t)e * 1024))[lane];
        }
#pragma unroll
        for (int u = 0; u < 8; ++u) {
          const unsigned uu[4] = {c[u].x, c[u].y, c[u].z, c[u].w};
          float d = 0.f;
#pragma unroll
          for (int j = 0; j < 4; ++j) {
            const f32x2 lo = __builtin_amdgcn_cvt_pk_f32_fp8((int)uu[j], false);
            const f32x2 hi = __builtin_amdgcn_cvt_pk_f32_fp8((int)uu[j], true);
            d += xn[4 * j] * lo[0];
            d += xn[4 * j + 1] * lo[1];
            d += xn[4 * j + 2] * hi[0];
            d += xn[4 * j + 3] * hi[1];
          }
          d = wave_sum(d);
          if (lane == k + u) dsum = d;
        }
      }
      if (half) cf1 = gelu_tanh(dsum * su1) * g1 * sv1; else cf0 = gelu_tanh(dsum * su0) * g0 * sv0;
    }
#pragma unroll
    for (int half = 0; half < 2; ++half) {
      const int ev = half ? e1 : e0;
      const float cfv = half ? cf1 : cf0;
#pragma unroll 1
      for (int k = 0; k < 64; k += 8) {
        uint4 c[8];
        float ck[8];
#pragma unroll
        for (int u = 0; u < 8; ++u) {
          const int e = __builtin_amdgcn_readlane(ev, k + u);
          ck[u] = __int_as_float(__builtin_amdgcn_readlane(__float_as_int(cfv), k + u));
          c[u] = ((const uint4*)(p.vb8 + (size_t)e * 1024))[lane];
        }
#pragma unroll
        for (int u = 0; u < 8; ++u) {
          const unsigned uu[4] = {c[u].x, c[u].y, c[u].z, c[u].w};
#pragma unroll
          for (int j = 0; j < 4; ++j) {
            const f32x2 lo = __builtin_amdgcn_cvt_pk_f32_fp8((int)uu[j], false);
            const f32x2 hi = __builtin_amdgcn_cvt_pk_f32_fp8((int)uu[j], true);
            y[4 * j] += ck[u] * lo[0];
            y[4 * j + 1] += ck[u] * lo[1];
            y[4 * j + 2] += ck[u] * hi[0];
            y[4 * j + 3] += ck[u] * hi[1];
          }
        }
      }
    }
    float s2 = 0.f;
#pragma unroll
    for (int i = 0; i < 16; ++i) { y[i] += hv[i]; s2 += y[i] * y[i]; }
    s2 = wave_sum(s2);
    const float rs2 = rsqrtf(s2 * (1.f / D) + 1e-6f);
    {
      const float4* g4 = (const float4*)p.final_g + lane * 4;
      const float4 a0 = g4[0], a1 = g4[1], a2 = g4[2], a3 = g4[3];
      float4* o4 = (float4*)(p.out + (size_t)tok * D) + lane * 4;
      o4[0] = make_float4(y[0] * rs2 * a0.x, y[1] * rs2 * a0.y, y[2] * rs2 * a0.z, y[3] * rs2 * a0.w);
      o4[1] = make_float4(y[4] * rs2 * a1.x, y[5] * rs2 * a1.y, y[6] * rs2 * a1.z, y[7] * rs2 * a1.w);
      o4[2] = make_float4(y[8] * rs2 * a2.x, y[9] * rs2 * a2.y, y[10] * rs2 * a2.z, y[11] * rs2 * a2.w);
      o4[3] = make_float4(y[12] * rs2 * a3.x, y[13] * rs2 * a3.y, y[14] * rs2 * a3.z, y[15] * rs2 * a3.w);
    }
  }
}

template <bool COOP>
__global__ void __launch_bounds__(256, 2) mega(Params p, int ph_lo, int ph_hi) {
  __shared__ __attribute__((aligned(16))) unsigned char smem[SMEM_BYTES];
#ifdef REPEAT_MASK
  bool rep_done = false;
#endif
  for (int ph = ph_lo; ph <= ph_hi; ++ph) {
    switch (ph) {
      case 0: phase0(p); break;
      case 1: phase1(p, smem); break;
      case 2: phase2(p, smem); break;
      case 3: phase3(p, smem); break;
      case 4: phase_nsa(p, smem); break;
      case 5: phase_resid(p, smem, p.mix, p.woutT, p.x, D, p.ssq1); break;
      case 6: phase_scaled(p, smem, p.hn, p.wmqT, 8, p.ssq1, p.qm, LDA); break;
      case 7: phase_memattn(p, smem); break;
      case 8: phase_resid(p, smem, p.mix, p.wmoT, p.h, LDHF, p.ssq2); break;
      case 9: phase_scaled(p, smem, p.hn, p.wpqT, 16, p.ssq2, p.pq, LDPQ); break;
      case 10: phase_peer_route(p, smem); break;
      case 11: phase_peer_gather(p); break;
    }
#ifdef REPEAT_MASK
    if (COOP && ((REPEAT_MASK >> ph) & 1) && !rep_done) { rep_done = true; cg::this_grid().sync(); --ph; continue; }
    rep_done = false;
#endif
    if (COOP) {
      if (ph < ph_hi) cg::this_grid().sync();
    }
  }
}

extern "C" void kernel_launch(void* const* d_in, const int* in_sizes, int n_in, void* d_out, int out_size, void* d_ws,
                              size_t ws_size, hipStream_t stream) {
  (void)in_sizes; (void)n_in; (void)out_size; (void)ws_size;
  Params p{};
  p.x = (const float*)d_in[0]; p.mem = (const float*)d_in[1]; p.pos = (const int*)d_in[2];
  p.mix_g = (const float*)d_in[3]; p.w_in = (const float*)d_in[4]; p.conv_w = (const float*)d_in[5];
  p.conv_b = (const float*)d_in[6]; p.ln_g = (const float*)d_in[7]; p.ln_b = (const float*)d_in[8];
  p.cmp_pos = (const float*)d_in[9]; p.cmp_w1 = (const float*)d_in[10]; p.cmp_b1 = (const float*)d_in[11];
  p.cmp_w2 = (const float*)d_in[12]; p.cmp_b2 = (const float*)d_in[13]; p.w_out = (const float*)d_in[14];
  p.memq_g = (const float*)d_in[15]; p.memkv_g = (const float*)d_in[16]; p.w_mq = (const float*)d_in[17];
  p.w_mk = (const float*)d_in[18]; p.w_mv = (const float*)d_in[19]; p.w_mo = (const float*)d_in[20];
  p.peer_g = (const float*)d_in[21]; p.peer_wq = (const float*)d_in[22]; p.peer_sk = (const float*)d_in[23];
  p.peer_u = (const float*)d_in[24]; p.peer_v = (const float*)d_in[25]; p.final_g = (const float*)d_in[26];
  p.out = (float*)d_out;
  unsigned char* ws = (unsigned char*)d_ws;
  size_t off = 0;
  auto take = [&](size_t bytes) { unsigned char* r = ws + off; off += (bytes + 255) & ~(size_t)255; return r; };
  unsigned char* regA = take((size_t)NTOK * LDA * 2);
  unsigned char* regB = take((size_t)NTOK * LDP * 2);
  unsigned char* regC = take((size_t)NTOK * LDA * 2);
  p.hn = (u16*)regA; p.ub8 = regA; p.vb8 = regA + (size_t)16384 * 1024;
  p.uscale = (float*)(regA + (size_t)2 * 16384 * 1024); p.vscale = p.uscale + 16384;
  p.proj = (u16*)regB; p.qm = (u16*)regB; p.pq = (u16*)regB;
  p.mix = (u16*)regC; p.experts = (int*)regC; p.gates = (float*)(regC + (size_t)NTOK * 128 * 4);
  p.h = (float*)take((size_t)NTOK * LDHF * 4);
  p.vts = (u16*)take((size_t)Bn * 2 * 64 * LDT * 2);
  p.vtw = (u16*)take((size_t)Bn * 2 * 64 * LDT * 2);
  p.memn = (u16*)take((size_t)Bn * 256 * LDA * 2);
  p.memk = (u16*)take((size_t)Bn * 256 * LDA * 2);
  p.memvt = (u16*)take((size_t)Bn * 256 * D * 2);
  p.winT = (u16*)take((size_t)2432 * LDA * 2);
  p.woutT = (u16*)take((size_t)1024 * LDA * 2);
  p.wmqT = (u16*)take((size_t)1024 * LDA * 2);
  p.wmkT = (u16*)take((size_t)1024 * LDA * 2);
  p.wmvT = (u16*)take((size_t)1024 * LDA * 2);
  p.wmoT = (u16*)take((size_t)1024 * LDA * 2);
  p.wpqT = (u16*)take((size_t)2048 * LDA * 2);
  p.subk = (u16*)take((size_t)16 * 128 * 128 * 2);
  p.w1T = (u16*)take((size_t)2 * 128 * LDW1 * 2);
  p.w2T = (u16*)take((size_t)2 * 128 * 128 * 2);
  p.biasp = (float*)take(256 * 4);
  p.rope = (float*)take((size_t)NTOK * 16 * 4);
  p.hdn = (u16*)take((size_t)2 * 4096 * 128 * 2);
  p.kc = (u16*)take((size_t)Bn * 2 * 128 * 64 * 2);
  p.vcT = (u16*)take((size_t)Bn * 2 * 64 * 128 * 2);
  p.ssq1 = (float*)take((size_t)NTOK * 4);
  p.ssq2 = (float*)take((size_t)NTOK * 4);
  if (off > ws_size) { fprintf(stderr, "workspace too small: need %zu have %zu\n", off, ws_size); return; }

#if COOP_MODE
  static int grid_blocks = 0;
  if (!grid_blocks) {
    int dev = 0, cus = 0, per_cu = 0;
    hipGetDevice(&dev);
    hipDeviceGetAttribute(&cus, hipDeviceAttributeMultiprocessorCount, dev);
    hipOccupancyMaxActiveBlocksPerMultiprocessor(&per_cu, mega<true>, 256, 0);
    if (per_cu > 2) per_cu = 2;
    if (per_cu < 1) per_cu = 1;
    grid_blocks = cus * per_cu;
  }
  int lo = 0, hi = NPHASE;
  void* args[] = {&p, &lo, &hi};
  hipError_t e = hipLaunchCooperativeKernel((void*)mega<true>, dim3(grid_blocks), dim3(256), args, 0, stream);
  if (e != hipSuccess) fprintf(stderr, "cooperative launch failed: %s (grid %d)\n", hipGetErrorString(e), grid_blocks);
#else
  for (int ph = 0; ph <= NPHASE; ++ph) mega<false><<<dim3(512), dim3(256), 0, stream>>>(p, ph, ph);
#endif
}
```

```cpp
#include <hip/hip_runtime.h>
#include <hip/hip_bf16.h>
#include <hip/hip_cooperative_groups.h>
#include <cstdio>
#include <cstdint>
namespace cg = cooperative_groups;

#ifndef COOP_MODE
#define COOP_MODE 1
#endif

typedef __attribute__((ext_vector_type(8))) short bf16x8;
typedef __attribute__((ext_vector_type(4))) short bf16x4;
typedef __attribute__((ext_vector_type(4))) float f32x4;
typedef unsigned short u16;

#define DEVI __device__ __forceinline__

constexpr int Bn = 16, T = 2048, D = 1024, NTOK = Bn * T, LDP = 2336;
constexpr int C_Q = 1024, C_KC = 1536, C_VC = 1664, C_KS = 1792, C_VS = 1920, C_KW = 2048, C_VW = 2176, C_GATE = 2304;
constexpr int SMEM_BYTES = 73728;
constexpr int LDA = 1088;
constexpr int LDHF = 1056;
constexpr int LDPQ = 2112;
constexpr int LDW1 = 2112;
constexpr int LDT = 2112;
constexpr int NPHASE = 11;

struct Params {
  const float* x; const float* mem; const int* pos; const float* mix_g; const float* w_in;
  const float* conv_w; const float* conv_b; const float* ln_g; const float* ln_b;
  const float* cmp_pos; const float* cmp_w1; const float* cmp_b1; const float* cmp_w2; const float* cmp_b2;
  const float* w_out; const float* memq_g; const float* memkv_g; const float* w_mq; const float* w_mk;
  const float* w_mv; const float* w_mo; const float* peer_g; const float* peer_wq; const float* peer_sk;
  const float* peer_u; const float* peer_v; const float* final_g;
  float* out;
  u16* hn; u16* proj; u16* mix; float* h; u16* vts; u16* vtw; u16* memn; u16* memk; u16* memvt;
  u16* winT; u16* woutT; u16* wmqT; u16* wmkT; u16* wmvT; u16* wmoT; u16* wpqT; u16* subk; u16* w1T; u16* w2T;
  float* biasp; float* rope; u16* hdn; u16* kc; u16* vcT; float* ssq1; float* ssq2;
  int* experts; float* gates; unsigned char* ub8; unsigned char* vb8; float* uscale; float* vscale; u16* qm; u16* pq;
};

DEVI int launder(int x) { asm volatile("" : "+v"(x)); return x; }
DEVI u16 f2bf(float f) {
  unsigned u = __float_as_uint(f);
  u += 0x7fffu + ((u >> 16) & 1u);
  return (u16)(u >> 16);
}
DEVI float bf2f(u16 h) { return __uint_as_float(((unsigned)h) << 16); }
DEVI unsigned pack2(float a, float b) { return (unsigned)f2bf(a) | ((unsigned)f2bf(b) << 16); }
DEVI float wave_sum(float v) {
#pragma unroll
  for (int o = 32; o; o >>= 1) v += __shfl_xor(v, o);
  return v;
}
DEVI float sigmoidf_(float x) { return 1.f / (1.f + __expf(-x)); }
DEVI float gelu_tanh(float x) {
  float u = 0.7978845608028654f * (x + 0.044715f * x * x * x);
  return 0.5f * x * (1.f + tanhf(u));
}
DEVI f32x4 mfma16(bf16x8 a, bf16x8 b, f32x4 c) { return __builtin_amdgcn_mfma_f32_16x16x32_bf16(a, b, c, 0, 0, 0); }
DEVI float fexp2(float x) { return __builtin_amdgcn_exp2f(x); }

DEVI void tconv(const float* __restrict__ src, int K, int N, u16* __restrict__ dst, int Npad, int ldd,
                const float* __restrict__ gain, int gtid, int gsz) {
  const int items = Npad * (K >> 3);
  for (int it = gtid; it < items; it += gsz) {
    const int n = it % Npad, kc = it / Npad;
    float f[8];
#pragma unroll
    for (int j = 0; j < 8; ++j) {
      float v = 0.f;
      if (n < N) {
        v = src[(size_t)(kc * 8 + j) * N + n];
        if (gain) v *= gain[kc * 8 + j];
      }
      f[j] = v;
    }
    uint4 pk;
    pk.x = pack2(f[0], f[1]); pk.y = pack2(f[2], f[3]); pk.z = pack2(f[4], f[5]); pk.w = pack2(f[6], f[7]);
    *(uint4*)(dst + (size_t)n * ldd + kc * 8) = pk;
  }
}

DEVI void conv_flat(const float* __restrict__ src, u16* __restrict__ dst, size_t n8, size_t gtid, size_t gsz) {
  for (size_t it = gtid; it < n8; it += gsz) {
    const float4 a = ((const float4*)src)[2 * it], b = ((const float4*)src)[2 * it + 1];
    uint4 pk;
    pk.x = pack2(a.x, a.y); pk.y = pack2(a.z, a.w); pk.z = pack2(b.x, b.y); pk.w = pack2(b.z, b.w);
    ((uint4*)dst)[it] = pk;
  }
}


typedef float f32x2 __attribute__((ext_vector_type(2)));
DEVI unsigned pk4_fp8(float a, float b, float c, float d) {
  int v = 0;
  v = __builtin_amdgcn_cvt_pk_fp8_f32(a, b, v, false);
  v = __builtin_amdgcn_cvt_pk_fp8_f32(c, d, v, true);
  return (unsigned)v;
}
DEVI void conv_fp8_rows(const float* __restrict__ src, unsigned char* __restrict__ dst, float* __restrict__ inv_scale,
                        int rows, int gw, int nw, int lane) {
  for (int r = gw; r < rows; r += nw) {
    const float4* p4 = (const float4*)(src + (size_t)r * 1024) + lane * 4;
    const float4 a = p4[0], b = p4[1], c = p4[2], d = p4[3];
    float mx = fmaxf(fmaxf(fmaxf(fabsf(a.x), fabsf(a.y)), fmaxf(fabsf(a.z), fabsf(a.w))),
                     fmaxf(fmaxf(fabsf(b.x), fabsf(b.y)), fmaxf(fabsf(b.z), fabsf(b.w))));
    mx = fmaxf(mx, fmaxf(fmaxf(fmaxf(fabsf(c.x), fabsf(c.y)), fmaxf(fabsf(c.z), fabsf(c.w))),
                         fmaxf(fmaxf(fabsf(d.x), fabsf(d.y)), fmaxf(fabsf(d.z), fabsf(d.w)))));
#pragma unroll
    for (int o = 32; o; o >>= 1) mx = fmaxf(mx, __shfl_xor(mx, o));
    const float sc = mx > 0.f ? 224.f / mx : 1.f;
    if (lane == 0) inv_scale[r] = mx > 0.f ? mx * (1.f / 224.f) : 1.f;
    uint4 o4;
    o4.x = pk4_fp8(a.x * sc, a.y * sc, a.z * sc, a.w * sc);
    o4.y = pk4_fp8(b.x * sc, b.y * sc, b.z * sc, b.w * sc);
    o4.z = pk4_fp8(c.x * sc, c.y * sc, c.z * sc, c.w * sc);
    o4.w = pk4_fp8(d.x * sc, d.y * sc, d.z * sc, d.w * sc);
    ((uint4*)(dst + (size_t)r * 1024))[lane] = o4;
  }
}

DEVI void rownorm_bf16(const float* __restrict__ src, const float* __restrict__ g, u16* __restrict__ dst,
                       int rows, int gw, int nw, int lane) {
  for (int r = gw; r < rows; r += nw) {
    const float4* pr = (const float4*)(src + (size_t)r * D);
    float4 v[4];
    float ss = 0.f;
#pragma unroll
    for (int i = 0; i < 4; ++i) {
      v[i] = pr[lane + 64 * i];
      ss += v[i].x * v[i].x + v[i].y * v[i].y + v[i].z * v[i].z + v[i].w * v[i].w;
    }
    ss = wave_sum(ss);
    const float rstd = rsqrtf(ss * (1.f / D) + 1e-6f);
#pragma unroll
    for (int i = 0; i < 4; ++i) {
      const float4 gg = ((const float4*)g)[lane + 64 * i];
      uint2 pk;
      pk.x = pack2(v[i].x * rstd * gg.x, v[i].y * rstd * gg.y);
      pk.y = pack2(v[i].z * rstd * gg.z, v[i].w * rstd * gg.w);
      *(uint2*)(dst + (size_t)r * LDA + (size_t)(lane + 64 * i) * 4) = pk;
    }
  }
}

DEVI void phase0(const Params& p) {
  const int tid = launder(threadIdx.x), lane = tid & 63;
  const int gtid = blockIdx.x * 256 + tid, gsz = gridDim.x * 256;
  const int gw = gtid >> 6, nw = gsz >> 6;
  rownorm_bf16(p.x, p.mix_g, p.hn, NTOK, gw, nw, lane);
  rownorm_bf16(p.mem, p.memkv_g, p.memn, Bn * 256, gw, nw, lane);
  tconv(p.w_in, 1024, 2328, p.winT, 2432, LDA, nullptr, gtid, gsz);
  tconv(p.w_out, 1024, 1024, p.woutT, 1024, LDA, nullptr, gtid, gsz);
  tconv(p.w_mq, 1024, 1024, p.wmqT, 1024, LDA, p.memq_g, gtid, gsz);
  tconv(p.w_mk, 1024, 1024, p.wmkT, 1024, LDA, nullptr, gtid, gsz);
  tconv(p.w_mv, 1024, 1024, p.wmvT, 1024, LDA, nullptr, gtid, gsz);
  tconv(p.w_mo, 1024, 1024, p.wmoT, 1024, LDA, nullptr, gtid, gsz);
  tconv(p.peer_wq, 1024, 2048, p.wpqT, 2048, LDA, p.peer_g, gtid, gsz);
  tconv(p.cmp_w1, 2048, 128, p.w1T, 128, LDW1, nullptr, gtid, gsz);
  tconv(p.cmp_w1 + 2048 * 128, 2048, 128, p.w1T + 128 * LDW1, 128, LDW1, nullptr, gtid, gsz);
  tconv(p.cmp_w2, 128, 64, p.w2T, 128, 128, nullptr, gtid, gsz);
  tconv(p.cmp_w2 + 128 * 64, 128, 64, p.w2T + 128 * 128, 128, 128, nullptr, gtid, gsz);
  conv_flat(p.peer_sk, p.subk, (size_t)16 * 128 * 128 / 8, gtid, gsz);
  for (int it = gtid; it < NTOK * 8; it += gsz) {
    const int tok = it >> 3, i = it & 7;
    const float inv = (i == 0) ? 1.000000000e+00f : (i == 1) ? 1.939227432e-01f : (i == 2) ? 3.760603070e-02f : (i == 3) ? 7.292664610e-03f : (i == 4) ? 1.414213562e-03f : (i == 5) ? 2.742481884e-04f : (i == 6) ? 5.318295734e-05f : 1.031338525e-05f;
    const float ang = (float)p.pos[tok] * inv;
    float sv, cv;
    sincosf(ang, &sv, &cv);
    p.rope[tok * 16 + i] = cv;
    p.rope[tok * 16 + 8 + i] = sv;
  }
  for (int o = gw; o < 256; o += nw) {
    const int ty = o >> 7, n = o & 127;
    float s = 0.f;
    for (int k = lane; k < 2048; k += 64)
      s += p.cmp_pos[ty * 2048 + k] * p.cmp_w1[((size_t)ty * 2048 + k) * 128 + n];
    s = wave_sum(s);
    if (lane == 0) p.biasp[o] = s + p.cmp_b1[o];
  }
  for (int it = gtid; it < NTOK; it += gsz) { p.ssq1[it] = 0.f; p.ssq2[it] = 0.f; }
}

template <bool DB, class AF>
DEVI void gemm_mainloop(int tid, u16* sA, u16* sB, AF af, const u16* __restrict__ Bt, int ldb, int m0, int n0, int nk,
                        f32x4 (&acc)[4][4]) {
  const int lane = tid & 63, w = tid >> 6;
  const int wm = w >> 1, wn = w & 1, col = lane & 15, quad = lane >> 4;
#pragma unroll
  for (int i = 0; i < 4; ++i)
#pragma unroll
    for (int j = 0; j < 4; ++j) acc[i][j] = f32x4{0.f, 0.f, 0.f, 0.f};
  uint4 ra0, ra1, ra2, ra3, rb0, rb1, rb2, rb3;
  const int lrow = tid >> 3, lkc = (tid & 7) << 3;
  const u16* bbase = Bt + (size_t)(n0 + lrow) * ldb + lkc;
#define GL_(R, i, kk)                                                     \
  R##a##i = *(const uint4*)af(m0 + lrow + 32 * i, (kk) + lkc);            \
  R##b##i = *(const uint4*)(bbase + (size_t)(32 * i) * ldb + (kk));
#define SS_(R, i, off)                                                    \
  *(uint4*)(sA + (off) + (lrow + 32 * i) * 72 + lkc) = R##a##i;           \
  *(uint4*)(sB + (off) + (lrow + 32 * i) * 72 + lkc) = R##b##i;
#define GL4_(R, kk) GL_(R, 0, kk) GL_(R, 1, kk) GL_(R, 2, kk) GL_(R, 3, kk)
#define SS4_(R, off) SS_(R, 0, off) SS_(R, 1, off) SS_(R, 2, off) SS_(R, 3, off)
#define COMPUTE_(cur)                                                                                                   \
  _Pragma("unroll") for (int ks = 0; ks < 2; ++ks) {                                                                    \
    bf16x8 fa[4], fb[4];                                                                                                \
    _Pragma("unroll") for (int mi = 0; mi < 4; ++mi)                                                                    \
      fa[mi] = *(const bf16x8*)(sA + (cur) + (wm * 64 + 16 * mi + col) * 72 + 32 * ks + 8 * quad);                      \
    _Pragma("unroll") for (int ni = 0; ni < 4; ++ni)                                                                    \
      fb[ni] = *(const bf16x8*)(sB + (cur) + (wn * 64 + 16 * ni + col) * 72 + 32 * ks + 8 * quad);                      \
    _Pragma("unroll") for (int ni = 0; ni < 4; ++ni)                                                                    \
      _Pragma("unroll") for (int mi = 0; mi < 4; ++mi) acc[ni][mi] = mfma16(fb[ni], fa[mi], acc[ni][mi]);               \
  }
  if (DB) {
    const int srow = 8 * w + (lane >> 3);
    const int spc = lane & 7;
#define STAGE_(st, kk)                                                                                         \
    _Pragma("unroll") for (int i = 0; i < 4; ++i) {                                                            \
      const int r_ = 32 * i + srow;                                                                            \
      const int c_ = (spc ^ ((r_ >> 1) & 7)) << 3;                                                             \
      __builtin_amdgcn_global_load_lds((const unsigned*)af(m0 + r_, (kk) + c_),                                \
                                       (unsigned*)(sA + (st) * 16384 + (32 * i + 8 * w) * 64), 16, 0, 0);      \
      __builtin_amdgcn_global_load_lds((const unsigned*)(Bt + (size_t)(n0 + r_) * ldb + (kk) + c_),            \
                                       (unsigned*)(sA + (st) * 16384 + 8192 + (32 * i + 8 * w) * 64), 16, 0, 0); \
    }
#define COMPUTE_SW_(st)                                                                                                 \
  _Pragma("unroll") for (int ks = 0; ks < 2; ++ks) {                                                                    \
    bf16x8 fa[4], fb[4];                                                                                                \
    const int pc_ = ((4 * ks + quad) ^ ((col >> 1) & 7)) << 3;                                                          \
    _Pragma("unroll") for (int mi = 0; mi < 4; ++mi)                                                                    \
      fa[mi] = *(const bf16x8*)(sA + (st) * 16384 + (wm * 64 + 16 * mi + col) * 64 + pc_);                              \
    _Pragma("unroll") for (int ni = 0; ni < 4; ++ni)                                                                    \
      fb[ni] = *(const bf16x8*)(sA + (st) * 16384 + 8192 + (wn * 64 + 16 * ni + col) * 64 + pc_);                       \
    _Pragma("unroll") for (int ni = 0; ni < 4; ++ni)                                                                    \
      _Pragma("unroll") for (int mi = 0; mi < 4; ++mi) acc[ni][mi] = mfma16(fb[ni], fa[mi], acc[ni][mi]);               \
  }
    STAGE_(0, 0)
#pragma unroll 1
    for (int kt = 0; kt < nk; kt += 2) {
      asm volatile("s_waitcnt vmcnt(0)" ::: "memory");
      __syncthreads();
      { const int kk = (kt + 1) * 64; STAGE_(1, kk) }
      COMPUTE_SW_(0)
      asm volatile("s_waitcnt vmcnt(0)" ::: "memory");
      __syncthreads();
      if (kt + 2 < nk) { const int kk = (kt + 2) * 64; STAGE_(0, kk) }
      COMPUTE_SW_(1)
    }
#undef STAGE_
#undef COMPUTE_SW_
  } else {
    GL4_(r, 0)
    SS4_(r, 0)
    __syncthreads();
#pragma unroll 1
    for (int kt = 0; kt < nk; ++kt) {
      const bool more = (kt + 1 < nk);
      if (more) { const int kk = (kt + 1) * 64; GL4_(r, kk) }
      COMPUTE_(0)
      __syncthreads();
      if (more) {
        SS4_(r, 0)
        __syncthreads();
      }
    }
  }
#undef GL_
#undef SS_
#undef GL4_
#undef SS4_
#undef COMPUTE_
}

struct ARow {
  const u16* base; int lda;
  DEVI const u16* operator()(int m, int k) const { return base + (size_t)m * lda + k; }
};
struct ACmp {
  const u16* proj; int colbase;
  DEVI const u16* operator()(int rr, int k) const {
    const int b = rr >> 8, g = (rr >> 7) & 1;
    int c = rr & 127; c = c > 126 ? 126 : c;
    const int l = k >> 6, d = k & 63;
    return proj + ((size_t)b * T + 16 * c + l) * LDP + colbase + g * 64 + d;
  }
};


#define XCD_TILE_LOOP(idx, MT, NT)                                                                     \
  const bool sw_ = (gridDim.x & 7) == 0;                                                               \
  const int xcd_ = blockIdx.x & 7;                                                                     \
  const int tstart_ = sw_ ? (int)(blockIdx.x >> 3) : (int)blockIdx.x;                                  \
  const int tstep_ = sw_ ? (int)(gridDim.x >> 3) : (int)gridDim.x;                                     \
  const int ttotal_ = sw_ ? ((MT) / 8) * (NT) : (MT) * (NT);                                           \
  _Pragma("unroll 1") for (int idx = tstart_; idx < ttotal_; idx += tstep_)
#define XCD_TILE_MT(idx, NT) (sw_ ? ((idx) / (NT)) * 8 + xcd_ : (idx) / (NT))
#define XCD_TILE_NT(idx, NT) ((idx) % (NT))

#define GEMM_LANE_VARS                                                    \
  const int tid = launder(threadIdx.x), lane = tid & 63, w = tid >> 6;    \
  const int wm = w >> 1, wn = w & 1, col = lane & 15, quad = lane >> 4;   \
  (void)wm; (void)wn; (void)col; (void)quad;

DEVI void phase1(const Params& p, unsigned char* smem) {
  u16* sA = (u16*)smem; u16* sB = sA + 128 * 72;
  XCD_TILE_LOOP(idx, 256 + 32, 19) {
    GEMM_LANE_VARS
    f32x4 acc[4][4];
    const int mt = XCD_TILE_MT(idx, 19), nt_ = XCD_TILE_NT(idx, 19);
    if (mt < 256) {
      const int m0 = mt * 128, n0 = nt_ * 128;
      gemm_mainloop<true>(tid, sA, sB, ARow{p.hn, LDA}, p.winT, LDA, m0, n0, 16, acc);
#pragma unroll
      for (int mi = 0; mi < 4; ++mi) {
        const int m = m0 + wm * 64 + 16 * mi + col;
        const int b = m >> 11, t = m & 2047;
#pragma unroll
        for (int ni = 0; ni < 4; ++ni) {
          const int nt = n0 + wn * 64 + 16 * ni;
          const int n = nt + 4 * quad;
          f32x4 v = acc[ni][mi];
          if (nt >= LDP) continue;
          if ((nt >= C_VS && nt < C_KW) || (nt >= C_VW && nt < C_GATE)) {
            const bool isw = nt >= C_VW;
            const int off = n - (isw ? C_VW : C_VS);
            const int g = off >> 6, d = off & 63;
            u16* dst = (isw ? p.vtw : p.vts) + ((size_t)(b * 2 + g) * 64 + d) * LDT + t;
#pragma unroll
            for (int r = 0; r < 4; ++r) dst[(size_t)r * LDT] = f2bf(v[r]);
          } else {
            const bool rope_tile = ((nt >= C_KS && nt < C_VS) || (nt >= C_KW && nt < C_VW)) && ((nt & 63) == 0);
            if (rope_tile) {
#pragma unroll
              for (int r = 0; r < 4; ++r) {
                const float pr = __shfl_xor(v[r], 32);
                const int i = ((quad & 1) << 2) + r;
                const float cs = p.rope[(size_t)m * 16 + i], sn = p.rope[(size_t)m * 16 + 8 + i];
                v[r] = (quad < 2) ? (v[r] * cs - pr * sn) : (v[r] * cs + pr * sn);
              }
            }
            uint2 pk; pk.x = pack2(v[0], v[1]); pk.y = pack2(v[2], v[3]);
            *(uint2*)(p.proj + (size_t)m * LDP + n) = pk;
          }
        }
      }
    } else if (nt_ < 16) {
      const int isv = nt_ >> 3;
      const int m0 = (mt - 256) * 128, n0 = (nt_ & 7) * 128;
      gemm_mainloop<true>(tid, sA, sB, ARow{p.memn, LDA}, isv ? p.wmvT : p.wmkT, LDA, m0, n0, 16, acc);
#pragma unroll
      for (int mi = 0; mi < 4; ++mi) {
        const int m = m0 + wm * 64 + 16 * mi + col;
        const int b = m >> 8, key = m & 255;
#pragma unroll
        for (int ni = 0; ni < 4; ++ni) {
          const int n = n0 + wn * 64 + 16 * ni + 4 * quad;
          const f32x4 v = acc[ni][mi];
          if (isv) {
            const int head = n >> 8, d = n & 255;
            u16* dst = p.memvt + ((size_t)(b * 4 + head) * 256 + d) * 256 + key;
#pragma unroll
            for (int r = 0; r < 4; ++r) dst[r * 256] = f2bf(v[r]);
          } else {
            uint2 pk; pk.x = pack2(v[0], v[1]); pk.y = pack2(v[2], v[3]);
            *(uint2*)(p.memk + (size_t)m * LDA + n) = pk;
          }
        }
      }
    }
  }
}

DEVI void conv_tile(const Params& p, unsigned char* smem, int ct) {
  u16* sU = (u16*)smem;
  float2* sRed = (float2*)(smem + 62 * 512 * 2);
  const int tid = launder(threadIdx.x), lane = tid & 63, w = tid >> 6;
  const int b = ct >> 6, t0 = (ct & 63) * 32;
  __syncthreads();
  for (int it = tid; it < 62 * 64; it += 256) {
    const int r = it >> 6, c8 = it & 63;
    const int t = t0 - 30 + r;
    uint4 pk = {0u, 0u, 0u, 0u};
    if (t >= 0) {
      const u16* src = p.proj + ((size_t)b * T + t) * LDP + c8 * 8;
      const uint4 a = *(const uint4*)src, bb = *(const uint4*)(src + 512);
      const unsigned au[4] = {a.x, a.y, a.z, a.w}, bu[4] = {bb.x, bb.y, bb.z, bb.w};
      unsigned o[4];
#pragma unroll
      for (int j = 0; j < 4; ++j) {
        const float a0 = __uint_as_float(au[j] << 16), a1 = __uint_as_float(au[j] & 0xffff0000u);
        const float b0 = __uint_as_float(bu[j] << 16), b1 = __uint_as_float(bu[j] & 0xffff0000u);
        o[j] = pack2(a0 * sigmoidf_(b0), a1 * sigmoidf_(b1));
      }
      pk.x = o[0]; pk.y = o[1]; pk.z = o[2]; pk.w = o[3];
    }
    *(uint4*)(sU + r * 512 + c8 * 8) = pk;
  }
  const int c = 2 * tid;
  float w0[31], w1[31];
#pragma unroll
  for (int j = 0; j < 31; ++j) { w0[j] = p.conv_w[j * 512 + c]; w1[j] = p.conv_w[j * 512 + c + 1]; }
  const float bd0 = p.conv_b[c], bd1 = p.conv_b[c + 1];
  __syncthreads();
  for (int tt = 0; tt < 32; ++tt) {
    float y0 = bd0, y1 = bd1;
#pragma unroll
    for (int j = 0; j < 31; ++j) {
      const unsigned uu = *(const unsigned*)(sU + (tt + j) * 512 + c);
      y0 += w0[j] * __uint_as_float(uu << 16);
      y1 += w1[j] * __uint_as_float(uu & 0xffff0000u);
    }
    float s = y0 + y1, q = y0 * y0 + y1 * y1;
    s = wave_sum(s); q = wave_sum(q);
    if (lane == 0) sRed[tt * 4 + w] = make_float2(s, q);
  }
  __syncthreads();
  const float g0 = p.ln_g[c], g1 = p.ln_g[c + 1], lb0 = p.ln_b[c], lb1 = p.ln_b[c + 1];
  for (int tt = 0; tt < 32; ++tt) {
    float y0 = bd0, y1 = bd1;
#pragma unroll
    for (int j = 0; j < 31; ++j) {
      const unsigned uu = *(const unsigned*)(sU + (tt + j) * 512 + c);
      y0 += w0[j] * __uint_as_float(uu << 16);
      y1 += w1[j] * __uint_as_float(uu & 0xffff0000u);
    }
    const float2 r0 = sRed[tt * 4 + 0], r1 = sRed[tt * 4 + 1], r2 = sRed[tt * 4 + 2], r3 = sRed[tt * 4 + 3];
    const float S = r0.x + r1.x + r2.x + r3.x, Q = r0.y + r1.y + r2.y + r3.y;
    const float mu = S * (1.f / 512.f);
    const float var = fmaxf(Q * (1.f / 512.f) - mu * mu, 0.f);
    const float rstd = rsqrtf(var + 1e-6f);
    const float z0 = (y0 - mu) * rstd * g0 + lb0, z1 = (y1 - mu) * rstd * g1 + lb1;
    const float o0 = z0 * sigmoidf_(z0), o1 = z1 * sigmoidf_(z1);
    *(unsigned*)(p.mix + ((size_t)b * T + t0 + tt) * LDA + c) = pack2(o0, o1);
  }
}

DEVI void phase2(const Params& p, unsigned char* smem) {
  u16* sA = (u16*)smem; u16* sB = sA + 128 * 72;
#pragma unroll 1
  for (int tile = blockIdx.x; tile < 64 + 1024; tile += gridDim.x) {
    GEMM_LANE_VARS
    if (tile < 64) {
      const int ty = tile >> 5, mt = tile & 31;
      const int m0 = mt * 128;
      f32x4 acc[4][4];
      gemm_mainloop<true>(tid, sA, sB, ACmp{p.proj, ty ? C_VC : C_KC}, p.w1T + (size_t)ty * 128 * LDW1, LDW1, m0, 0, 32, acc);
#pragma unroll
      for (int mi = 0; mi < 4; ++mi) {
        const int m = m0 + wm * 64 + 16 * mi + col;
#pragma unroll
        for (int ni = 0; ni < 4; ++ni) {
          const int n = wn * 64 + 16 * ni + 4 * quad;
          const f32x4 v = acc[ni][mi];
          const float4 bb = *(const float4*)(p.biasp + ty * 128 + n);
          uint2 pk;
          pk.x = pack2(gelu_tanh(v[0] + bb.x), gelu_tanh(v[1] + bb.y));
          pk.y = pack2(gelu_tanh(v[2] + bb.z), gelu_tanh(v[3] + bb.w));
          *(uint2*)(p.hdn + ((size_t)ty * 4096 + m) * 128 + n) = pk;
        }
      }
    } else {
      conv_tile(p, smem, tile - 64);
    }
  }
}

DEVI void phase3(const Params& p, unsigned char* smem) {
  u16* sA = (u16*)smem; u16* sB = sA + 128 * 72;
#pragma unroll 1
  for (int tile = blockIdx.x; tile < 64; tile += gridDim.x) {
    GEMM_LANE_VARS
    const int ty = tile >> 5, mt = tile & 31;
    const int m0 = mt * 128;
    f32x4 acc[4][4];
    gemm_mainloop<true>(tid, sA, sB, ARow{p.hdn + (size_t)ty * 4096 * 128, 128}, p.w2T + (size_t)ty * 128 * 128, 128, m0, 0, 2, acc);
    if (wn == 0) {
#pragma unroll
      for (int mi = 0; mi < 4; ++mi) {
        const int m = m0 + 16 * mi + wm * 64 + col;
        const int bg = m >> 7, c = m & 127;
#pragma unroll
        for (int ni = 0; ni < 4; ++ni) {
          const int n = 16 * ni + 4 * quad;
          const f32x4 v = acc[ni][mi];
          const float4 bb = *(const float4*)(p.cmp_b2 + ty * 64 + n);
          const float o0 = v[0] + bb.x, o1 = v[1] + bb.y, o2 = v[2] + bb.z, o3 = v[3] + bb.w;
          if (ty == 0) {
            uint2 pk; pk.x = pack2(o0, o1); pk.y = pack2(o2, o3);
            *(uint2*)(p.kc + (size_t)m * 64 + n) = pk;
          } else {
            u16* dst = p.vcT + ((size_t)bg * 64 + n) * 128 + c;
            dst[0] = f2bf(o0); dst[128] = f2bf(o1); dst[256] = f2bf(o2); dst[384] = f2bf(o3);
          }
        }
      }
    }
  }
}

template <int DH, int NQ, int LDK, int LDV, class MaskF>
DEVI void attn_tile(const u16* sK, const u16* sVt, const bf16x8 (&qf)[NQ][DH / 32], f32x4 (&o)[NQ][DH / 16],
                    float (&m)[NQ], float (&l)[NQ], float c2, int lane, MaskF valid) {
  const int col = lane & 15, quad = lane >> 4;
  f32x4 s[NQ][4];
#pragma unroll
  for (int kt = 0; kt < 4; ++kt) {
#pragma unroll
    for (int qt = 0; qt < NQ; ++qt) s[qt][kt] = f32x4{0.f, 0.f, 0.f, 0.f};
#pragma unroll
    for (int ks = 0; ks < DH / 32; ++ks) {
      const bf16x8 kf = *(const bf16x8*)(sK + (16 * kt + col) * LDK + 32 * ks + 8 * quad);
#pragma unroll
      for (int qt = 0; qt < NQ; ++qt) s[qt][kt] = mfma16(kf, qf[qt][ks], s[qt][kt]);
    }
  }
  bf16x8 pb[NQ][2];
#pragma unroll
  for (int qt = 0; qt < NQ; ++qt) {
    float mx = -1e30f;
#pragma unroll
    for (int kt = 0; kt < 4; ++kt)
#pragma unroll
      for (int r = 0; r < 4; ++r) {
        const bool v = valid(qt, 16 * kt + 4 * quad + r);
        const float sv = v ? s[qt][kt][r] : -1e30f;
        s[qt][kt][r] = sv;
        mx = fmaxf(mx, sv);
      }
    mx = fmaxf(mx, __shfl_xor(mx, 16));
    mx = fmaxf(mx, __shfl_xor(mx, 32));
    const float mn = fmaxf(m[qt], mx);
    const float alpha = fexp2((m[qt] - mn) * c2);
    m[qt] = mn;
    float ps = 0.f;
#pragma unroll
    for (int kt = 0; kt < 4; ++kt)
#pragma unroll
      for (int r = 0; r < 4; ++r) {
        const float sv = s[qt][kt][r];
        const float pv = (sv > -1e29f) ? fexp2((sv - mn) * c2) : 0.f;
        ps += pv;
        s[qt][kt][r] = pv;
      }
    l[qt] = l[qt] * alpha + ps;
#pragma unroll
    for (int dt = 0; dt < DH / 16; ++dt) o[qt][dt] *= alpha;
#pragma unroll
    for (int kk = 0; kk < 2; ++kk) {
      union { bf16x8 v; unsigned u[4]; } cv;
      cv.u[0] = pack2(s[qt][2 * kk][0], s[qt][2 * kk][1]);
      cv.u[1] = pack2(s[qt][2 * kk][2], s[qt][2 * kk][3]);
      cv.u[2] = pack2(s[qt][2 * kk + 1][0], s[qt][2 * kk + 1][1]);
      cv.u[3] = pack2(s[qt][2 * kk + 1][2], s[qt][2 * kk + 1][3]);
      pb[qt][kk] = cv.v;
    }
  }
#pragma unroll
  for (int dt = 0; dt < DH / 16; ++dt) {
#pragma unroll
    for (int kk = 0; kk < 2; ++kk) {
      union { bf16x8 v; uint2 h[2]; } cv;
      cv.h[0] = *(const uint2*)(sVt + (16 * dt + col) * LDV + 32 * kk + 4 * quad);
      cv.h[1] = *(const uint2*)(sVt + (16 * dt + col) * LDV + 32 * kk + 16 + 4 * quad);
#pragma unroll
      for (int qt = 0; qt < NQ; ++qt) o[qt][dt] = mfma16(cv.v, pb[qt][kk], o[qt][dt]);
    }
  }
}

DEVI void phase_nsa(const Params& p, unsigned char* smem) {
  u16* sK = (u16*)smem;
  u16* sVt = (u16*)(smem + 18432);
  float* impH = (float*)(smem + 35840);
  float* impT = (float*)(smem + 52736);
  unsigned* selm = (unsigned*)(smem + 56960);
  const float c2 = 0.125f * 1.4426950408889634f;
#pragma unroll 1
  for (int tile = blockIdx.x; tile < 2048; tile += gridDim.x) {
    const int tid = launder(threadIdx.x), lane = tid & 63, w = tid >> 6, col = lane & 15, quad = lane >> 4;
    const int qtile = 63 - (tile >> 5), bg = tile & 31, b = bg >> 1, g = bg & 1, q0 = qtile * 32;
    const int h = g * 4 + w;
    __syncthreads();
    if (tid < 32) selm[tid] = 0u;
    {
      const u16* kcp = p.kc + (size_t)bg * 128 * 64;
      const u16* vcp = p.vcT + (size_t)bg * 64 * 128;
#pragma unroll
      for (int i = 0; i < 4; ++i) {
        const int c = tid + 256 * i;
        const int row = c >> 3, ch = (c & 7) << 3;
        *(uint4*)(sK + row * 72 + ch) = *(const uint4*)(kcp + row * 64 + ch);
        const int row2 = c >> 4, ch2 = (c & 15) << 3;
        *(uint4*)(sVt + row2 * 136 + ch2) = *(const uint4*)(vcp + row2 * 128 + ch2);
      }
    }
    bf16x8 qf[2][2];
    float gate[2][3];
    int tq[2];
#pragma unroll
    for (int qt = 0; qt < 2; ++qt) {
      const int t = q0 + 16 * qt + col;
      tq[qt] = t;
      const size_t tok = (size_t)b * T + t;
      const u16* qp = p.proj + tok * LDP + C_Q + h * 64 + 8 * quad;
      qf[qt][0] = *(const bf16x8*)qp;
      qf[qt][1] = *(const bf16x8*)(qp + 32);
#pragma unroll
      for (int br = 0; br < 3; ++br) gate[qt][br] = sigmoidf_(bf2f(p.proj[tok * LDP + C_GATE + h * 3 + br]));
    }
    __syncthreads();

    f32x4 comb[2][4];
    {
      const int srcl = (lane + 48) & 63;
#pragma unroll
      for (int qt = 0; qt < 2; ++qt) {
        f32x4 s[8];
#pragma unroll
        for (int kt = 0; kt < 8; ++kt) {
          s[kt] = f32x4{0.f, 0.f, 0.f, 0.f};
#pragma unroll
          for (int ks = 0; ks < 2; ++ks) {
            const bf16x8 kf = *(const bf16x8*)(sK + (16 * kt + col) * 72 + 32 * ks + 8 * quad);
            s[kt] = mfma16(kf, qf[qt][ks], s[kt]);
          }
        }
        const int t = tq[qt];
        float mx = -1e30f;
#pragma unroll
        for (int kt = 0; kt < 8; ++kt)
#pragma unroll
          for (int r = 0; r < 4; ++r) {
            const int c = 16 * kt + 4 * quad + r;
            const bool v = (16 * c + 31) <= t;
            const float sv = v ? s[kt][r] : -1e30f;
            s[kt][r] = sv;
            mx = fmaxf(mx, sv);
          }
        mx = fmaxf(mx, __shfl_xor(mx, 16));
        mx = fmaxf(mx, __shfl_xor(mx, 32));
        float ps = 0.f;
#pragma unroll
        for (int kt = 0; kt < 8; ++kt)
#pragma unroll
          for (int r = 0; r < 4; ++r) {
            const float sv = s[kt][r];
            const float pv = (sv > -1e29f) ? fexp2((sv - mx) * c2) : 0.f;
            ps += pv;
            s[kt][r] = pv;
          }
        ps += __shfl_xor(ps, 16);
        ps += __shfl_xor(ps, 32);
        const float inv = ps > 0.f ? 1.f / ps : 0.f;
#pragma unroll
        for (int kt = 0; kt < 8; ++kt)
#pragma unroll
          for (int r = 0; r < 4; ++r) s[kt][r] *= inv;
        float prev3 = 0.f;
#pragma unroll
        for (int kt = 0; kt < 8; ++kt) {
          const float sum4 = s[kt][0] + s[kt][1] + s[kt][2] + s[kt][3];
          const float xs = __shfl(s[kt][3], srcl);
          const float extra = quad ? xs : prev3;
          prev3 = xs;
          impH[(w * 32 + 16 * qt + col) * 33 + 4 * kt + quad] = sum4 + extra;
        }
        bf16x8 pb[4];
#pragma unroll
        for (int kk = 0; kk < 4; ++kk) {
          union { bf16x8 v; unsigned u[4]; } cv;
          cv.u[0] = pack2(s[2 * kk][0], s[2 * kk][1]);
          cv.u[1] = pack2(s[2 * kk][2], s[2 * kk][3]);
          cv.u[2] = pack2(s[2 * kk + 1][0], s[2 * kk + 1][1]);
          cv.u[3] = pack2(s[2 * kk + 1][2], s[2 * kk + 1][3]);
          pb[kk] = cv.v;
        }
#pragma unroll
        for (int dt = 0; dt < 4; ++dt) {
          f32x4 oc = f32x4{0.f, 0.f, 0.f, 0.f};
#pragma unroll
          for (int kk = 0; kk < 4; ++kk) {
            union { bf16x8 v; uint2 hh[2]; } cv;
            cv.hh[0] = *(const uint2*)(sVt + (16 * dt + col) * 136 + 32 * kk + 4 * quad);
            cv.hh[1] = *(const uint2*)(sVt + (16 * dt + col) * 136 + 32 * kk + 16 + 4 * quad);
            oc = mfma16(cv.v, pb[kk], oc);
          }
          comb[qt][dt] = oc * gate[qt][0];
        }
      }
    }
#pragma unroll
    for (int qt = 0; qt < 2; ++qt) {
      const size_t tok = (size_t)b * T + tq[qt];
      union { bf16x8 v; unsigned u[4]; } own, par, res;
      own.v = qf[qt][0];
#pragma unroll
      for (int j = 0; j < 4; ++j) par.u[j] = (unsigned)__shfl_xor((int)own.u[j], 16);
      const float4 c0 = *(const float4*)(p.rope + tok * 16), c1 = *(const float4*)(p.rope + tok * 16 + 4);
      const float4 s0 = *(const float4*)(p.rope + tok * 16 + 8), s1 = *(const float4*)(p.rope + tok * 16 + 12);
      const float cs[8] = {c0.x, c0.y, c0.z, c0.w, c1.x, c1.y, c1.z, c1.w};
      const float sn[8] = {s0.x, s0.y, s0.z, s0.w, s1.x, s1.y, s1.z, s1.w};
#pragma unroll
      for (int j = 0; j < 4; ++j) {
        const float o0 = __uint_as_float(own.u[j] << 16), o1 = __uint_as_float(own.u[j] & 0xffff0000u);
        const float p0 = __uint_as_float(par.u[j] << 16), p1 = __uint_as_float(par.u[j] & 0xffff0000u);
        const float sg = (quad == 0) ? -1.f : 1.f;
        const float r0 = o0 * cs[2 * j] + sg * p0 * sn[2 * j];
        const float r1 = o1 * cs[2 * j + 1] + sg * p1 * sn[2 * j + 1];
        res.u[j] = (quad < 2) ? pack2(r0, r1) : own.u[j];
      }
      qf[qt][0] = res.v;
    }
    __syncthreads();
#pragma unroll
    for (int i = 0; i < 4; ++i) {
      const int cell = tid + 256 * i;
      const int qi = cell >> 5, s_ = cell & 31;
      const int cur = (q0 + qi) >> 6;
      float v = impH[(0 * 32 + qi) * 33 + s_] + impH[(1 * 32 + qi) * 33 + s_] + impH[(2 * 32 + qi) * 33 + s_] +
                impH[(3 * 32 + qi) * 33 + s_];
      const int dist = cur - s_;
      const bool forced = (s_ == 0) || (dist >= 0 && dist < 2);
      v = forced ? 1e9f : (s_ <= cur ? v : -1.f);
      impT[qi * 33 + s_] = v;
    }
    __syncthreads();
    {
      const int qi = tid >> 3, sub = tid & 7;
      unsigned bits = 0u;
#pragma unroll
      for (int k = 0; k < 4; ++k) {
        const int s_ = sub * 4 + k;
        const float v = impT[qi * 33 + s_];
        int rank = 0;
        for (int s2 = 0; s2 < 32; ++s2) {
          const float v2 = impT[qi * 33 + s2];
          rank += ((v2 > v) || (v2 == v && s2 < s_)) ? 1 : 0;
        }
        if (rank < 16) bits |= 1u << s_;
      }
      atomicOr(&selm[qi], bits);
    }
    __syncthreads();
    unsigned sm[2] = {selm[col], selm[16 + col]};
    unsigned uni = 0u;
#pragma unroll
    for (int i = 0; i < 32; ++i) uni |= selm[i];
    const int kbmax = (q0 + 31) >> 6;
    {
      float m[2] = {-1e30f, -1e30f}, l[2] = {0.f, 0.f};
      f32x4 o[2][4];
#pragma unroll
      for (int qt = 0; qt < 2; ++qt)
#pragma unroll
        for (int dt = 0; dt < 4; ++dt) o[qt][dt] = f32x4{0.f, 0.f, 0.f, 0.f};
#pragma unroll 1
      for (int kb = 0; kb <= kbmax; ++kb) {
        if (!((uni >> kb) & 1u)) continue;
        __syncthreads();
#pragma unroll
        for (int i = 0; i < 2; ++i) {
          const int c = tid + 256 * i, row = c >> 3, ch = (c & 7) << 3;
          *(uint4*)(sK + row * 72 + ch) = *(const uint4*)(p.proj + ((size_t)b * T + kb * 64 + row) * LDP + C_KS + g * 64 + ch);
          *(uint4*)(sVt + row * 72 + ch) = *(const uint4*)(p.vts + ((size_t)bg * 64 + row) * LDT + kb * 64 + ch);
        }
        __syncthreads();
        attn_tile<64, 2, 72, 72>(sK, sVt, qf, o, m, l, c2, lane, [&](int qt, int kl) {
          const int kp = kb * 64 + kl;
          return (((sm[qt] >> kb) & 1u) != 0u) && (kp <= tq[qt]);
        });
      }
#pragma unroll
      for (int qt = 0; qt < 2; ++qt) {
        float lt = l[qt];
        lt += __shfl_xor(lt, 16);
        lt += __shfl_xor(lt, 32);
        const float sc = lt > 0.f ? gate[qt][1] / lt : 0.f;
#pragma unroll
        for (int dt = 0; dt < 4; ++dt) comb[qt][dt] += o[qt][dt] * sc;
      }
    }
    {
      float m[2] = {-1e30f, -1e30f}, l[2] = {0.f, 0.f};
      f32x4 o[2][4];
#pragma unroll
      for (int qt = 0; qt < 2; ++qt)
#pragma unroll
        for (int dt = 0; dt < 4; ++dt) o[qt][dt] = f32x4{0.f, 0.f, 0.f, 0.f};
      const int kblo = (q0 >= 511) ? ((q0 - 511) >> 6) : 0;
#pragma unroll 1
      for (int kb = kblo; kb <= kbmax; ++kb) {
        __syncthreads();
#pragma unroll
        for (int i = 0; i < 2; ++i) {
          const int c = tid + 256 * i, row = c >> 3, ch = (c & 7) << 3;
          *(uint4*)(sK + row * 72 + ch) = *(const uint4*)(p.proj + ((size_t)b * T + kb * 64 + row) * LDP + C_KW + g * 64 + ch);
          *(uint4*)(sVt + row * 72 + ch) = *(const uint4*)(p.vtw + ((size_t)bg * 64 + row) * LDT + kb * 64 + ch);
        }
        __syncthreads();
        attn_tile<64, 2, 72, 72>(sK, sVt, qf, o, m, l, c2, lane, [&](int qt, int kl) {
          const int kp = kb * 64 + kl;
          return (kp <= tq[qt]) && (kp > tq[qt] - 512);
        });
      }
#pragma unroll
      for (int qt = 0; qt < 2; ++qt) {
        float lt = l[qt];
        lt += __shfl_xor(lt, 16);
        lt += __shfl_xor(lt, 32);
        const float sc = lt > 0.f ? gate[qt][2] / lt : 0.f;
#pragma unroll
        for (int dt = 0; dt < 4; ++dt) comb[qt][dt] += o[qt][dt] * sc;
      }
    }
#pragma unroll
    for (int qt = 0; qt < 2; ++qt) {
      const size_t tok = (size_t)b * T + tq[qt];
#pragma unroll
      for (int dt = 0; dt < 4; ++dt) {
        uint2 pk;
        pk.x = pack2(comb[qt][dt][0], comb[qt][dt][1]);
        pk.y = pack2(comb[qt][dt][2], comb[qt][dt][3]);
        *(uint2*)(p.mix + tok * LDA + 512 + h * 64 + 16 * dt + 4 * quad) = pk;
      }
    }
  }
}

DEVI void phase_resid(const Params& p, unsigned char* smem, const u16* A, const u16* Wt, const float* res, int ldres, float* ssq) {
  u16* sA = (u16*)smem; u16* sB = sA + 128 * 72;
  XCD_TILE_LOOP(idx, 256, 8) {
    GEMM_LANE_VARS
    const int mt = XCD_TILE_MT(idx, 8), nt_ = XCD_TILE_NT(idx, 8);
    const int m0 = mt * 128, n0 = nt_ * 128;
    f32x4 acc[4][4];
    gemm_mainloop<true>(tid, sA, sB, ARow{A, LDA}, Wt, LDA, m0, n0, 16, acc);
#pragma unroll
    for (int mi = 0; mi < 4; ++mi) {
      const int m = m0 + wm * 64 + 16 * mi + col;
      float ss = 0.f;
#pragma unroll
      for (int ni = 0; ni < 4; ++ni) {
        const int n = n0 + wn * 64 + 16 * ni + 4 * quad;
        const f32x4 v = acc[ni][mi];
        const float4 r = *(const float4*)(res + (size_t)m * ldres + n);
        float4 hv;
        hv.x = r.x + v[0]; hv.y = r.y + v[1]; hv.z = r.z + v[2]; hv.w = r.w + v[3];
        ss += hv.x * hv.x + hv.y * hv.y + hv.z * hv.z + hv.w * hv.w;
        *(float4*)(p.h + (size_t)m * LDHF + n) = hv;
        uint2 pk; pk.x = pack2(hv.x, hv.y); pk.y = pack2(hv.z, hv.w);
        *(uint2*)(p.hn + (size_t)m * LDA + n) = pk;
      }
      ss += __shfl_xor(ss, 16);
      ss += __shfl_xor(ss, 32);
      if (quad == 0) atomicAdd(ssq + m, ss);
    }
  }
}

DEVI void phase_scaled(const Params& p, unsigned char* smem, const u16* A, const u16* Wt, int ntn, const float* ssq, u16* outp, int ldo) {
  u16* sA = (u16*)smem; u16* sB = sA + 128 * 72;
  XCD_TILE_LOOP(idx, 256, ntn) {
    GEMM_LANE_VARS
    const int mt = XCD_TILE_MT(idx, ntn), nt_ = XCD_TILE_NT(idx, ntn);
    const int m0 = mt * 128, n0 = nt_ * 128;
    f32x4 acc[4][4];
    gemm_mainloop<true>(tid, sA, sB, ARow{A, LDA}, Wt, LDA, m0, n0, 16, acc);
#pragma unroll
    for (int mi = 0; mi < 4; ++mi) {
      const int m = m0 + wm * 64 + 16 * mi + col;
      const float rstd = rsqrtf(ssq[m] * (1.f / D) + 1e-6f);
#pragma unroll
      for (int ni = 0; ni < 4; ++ni) {
        const int n = n0 + wn * 64 + 16 * ni + 4 * quad;
        const f32x4 v = acc[ni][mi];
        uint2 pk; pk.x = pack2(v[0] * rstd, v[1] * rstd); pk.y = pack2(v[2] * rstd, v[3] * rstd);
        *(uint2*)(outp + (size_t)m * ldo + n) = pk;
      }
    }
  }
}

DEVI void phase_memattn(const Params& p, unsigned char* smem) {
  u16* sK = (u16*)smem;
  u16* sVt = (u16*)(smem + 33792);
  const float c2 = 0.0625f * 1.4426950408889634f;
#pragma unroll 1
  for (int tile = blockIdx.x; tile < 2048; tile += gridDim.x) {
    const int tid = launder(threadIdx.x), lane = tid & 63, w = tid >> 6, col = lane & 15, quad = lane >> 4;
    const int b = tile >> 7, head = (tile >> 5) & 3, q0 = (tile & 31) * 64;
    const size_t tok = (size_t)b * T + q0 + 16 * w + col;
    bf16x8 qf[1][8];
#pragma unroll
    for (int ks = 0; ks < 8; ++ks) qf[0][ks] = *(const bf16x8*)(p.qm + tok * LDA + head * 256 + 32 * ks + 8 * quad);
    float m[1] = {-1e30f}, l[1] = {0.f};
    f32x4 o[1][16];
#pragma unroll
    for (int dt = 0; dt < 16; ++dt) o[0][dt] = f32x4{0.f, 0.f, 0.f, 0.f};
#pragma unroll 1
    for (int kb = 0; kb < 4; ++kb) {
      __syncthreads();
#pragma unroll
      for (int i = 0; i < 8; ++i) {
        const int c = tid + 256 * i;
        const int row = c >> 5, ch = (c & 31) << 3;
        *(uint4*)(sK + row * 264 + ch) = *(const uint4*)(p.memk + ((size_t)b * 256 + kb * 64 + row) * LDA + head * 256 + ch);
      }
      __builtin_amdgcn_sched_barrier(0);
#pragma unroll
      for (int i = 0; i < 8; ++i) {
        const int c = tid + 256 * i;
        const int row2 = c >> 3, ch2 = (c & 7) << 3;
        *(uint4*)(sVt + row2 * 72 + ch2) = *(const uint4*)(p.memvt + ((size_t)(b * 4 + head) * 256 + row2) * 256 + kb * 64 + ch2);
      }
      __syncthreads();
      attn_tile<256, 1, 264, 72>(sK, sVt, qf, o, m, l, c2, lane, [&](int, int) { return true; });
    }
    float lt = l[0];
    lt += __shfl_xor(lt, 16);
    lt += __shfl_xor(lt, 32);
    const float inv = 1.f / lt;
#pragma unroll
    for (int dt = 0; dt < 16; ++dt) {
      uint2 pk;
      pk.x = pack2(o[0][dt][0] * inv, o[0][dt][1] * inv);
      pk.y = pack2(o[0][dt][2] * inv, o[0][dt][3] * inv);
      *(uint2*)(p.mix + tok * LDA + head * 256 + 16 * dt + 4 * quad) = pk;
    }
  }
}

__constant__ unsigned char kCandI[64] = {0,0,0,0,0,0,0,0,0,0,0,0,0,0,0,0, 1,1,1,1,1,1,1,1, 2,2,2,2,2, 3,3,3,3, 4,4,4, 5,5, 6,6, 7,7,
                                          8, 9, 10, 11, 12, 13, 14, 15, 0,0,0,0,0,0,0,0,0,0,0,0,0,0};
__constant__ unsigned char kCandJ[64] = {0,1,2,3,4,5,6,7,8,9,10,11,12,13,14,15, 0,1,2,3,4,5,6,7, 0,1,2,3,4, 0,1,2,3, 0,1,2, 0,1, 0,1, 0,1,
                                          0, 0, 0, 0, 0, 0, 0, 0, 0,0,0,0,0,0,0,0,0,0,0,0,0,0};

DEVI unsigned score_key(float v, int idx) {
  unsigned u = __float_as_uint(v);
  u = (u & 0x80000000u) ? ~u : (u | 0x80000000u);
  return (u & ~127u) | (unsigned)(127 - idx);
}
DEVI float key_score(unsigned k) {
  k &= ~127u;
  const unsigned u = (k & 0x80000000u) ? (k & 0x7fffffffu) : ~k;
  return __uint_as_float(u);
}

DEVI void phase_peer_route(const Params& p, unsigned char* smem) {
  u16* sA = (u16*)smem; u16* sB = sA + 128 * 72;
  unsigned* sScore = (unsigned*)smem;
  unsigned* sTop = (unsigned*)(smem + 36864);
  unsigned* sTmp = (unsigned*)(smem + 53248);
  {
    const int t0_ = launder(threadIdx.x);
    const int gw = (blockIdx.x * 256 + t0_) >> 6, nw = (gridDim.x * 256) >> 6;
    conv_fp8_rows(p.peer_u, p.ub8, p.uscale, 16384, gw, nw, t0_ & 63);
    conv_fp8_rows(p.peer_v, p.vb8, p.vscale, 16384, gw, nw, t0_ & 63);
  }
#pragma unroll 1
  for (int tile = blockIdx.x; tile < 256 * 8; tile += gridDim.x) {
    GEMM_LANE_VARS
    const int mt = tile >> 3, hd = tile & 7;
    const int m0 = mt * 128;
#pragma unroll 1
    for (int ph = 0; ph < 2; ++ph) {
      const int hp = hd * 2 + ph;
      f32x4 acc[4][4];
      __syncthreads();
      gemm_mainloop<false>(tid, sA, sB, ARow{p.pq + hp * 128, LDPQ}, p.subk + (size_t)hp * 128 * 128, 128, m0, 0, 2, acc);
#pragma unroll 1
      for (int hh = 0; hh < 2; ++hh) {
        if (wm == hh) {
#pragma unroll
          for (int mi = 0; mi < 4; ++mi) {
            const int row = 16 * mi + col;
#pragma unroll
            for (int ni = 0; ni < 4; ++ni) {
              const int n = wn * 64 + 16 * ni + 4 * quad;
              const f32x4 v = acc[ni][mi];
              uint4 kk;
              kk.x = score_key(v[0], n); kk.y = score_key(v[1], n + 1);
              kk.z = score_key(v[2], n + 2); kk.w = score_key(v[3], n + 3);
              *(uint4*)(sScore + row * 128 + n) = kk;
            }
          }
        }
        __syncthreads();
#pragma unroll 1
        for (int rg = 0; rg < 4; ++rg) {
          const int rbase = w * 16 + rg * 4;
          unsigned k0[4], k1[4], thr[4];
#pragma unroll
          for (int r = 0; r < 4; ++r) {
            k0[r] = sScore[(rbase + r) * 128 + lane];
            k1[r] = sScore[(rbase + r) * 128 + 64 + lane];
            thr[r] = 0u;
          }
#pragma unroll
          for (int bit = 31; bit >= 0; --bit) {
#pragma unroll
            for (int r = 0; r < 4; ++r) {
              const unsigned cand = thr[r] | (1u << bit);
              const int cnt = __popcll(__ballot(k0[r] >= cand)) + __popcll(__ballot(k1[r] >= cand));
              thr[r] = (cnt >= 16) ? cand : thr[r];
            }
          }
          unsigned* tmp = sTmp + w * 64;
#pragma unroll
          for (int r = 0; r < 4; ++r) {
            const unsigned long long b0 = __ballot(k0[r] >= thr[r]), b1 = __ballot(k1[r] >= thr[r]);
            const int pos0 = __builtin_amdgcn_mbcnt_hi((unsigned)(b0 >> 32), __builtin_amdgcn_mbcnt_lo((unsigned)b0, 0u));
            const int pos1 = __popcll(b0) + __builtin_amdgcn_mbcnt_hi((unsigned)(b1 >> 32), __builtin_amdgcn_mbcnt_lo((unsigned)b1, 0u));
            if (k0[r] >= thr[r]) tmp[r * 16 + pos0] = k0[r];
            if (k1[r] >= thr[r]) tmp[r * 16 + pos1] = k1[r];
          }
          __builtin_amdgcn_fence(__ATOMIC_RELEASE, "wavefront");
          __builtin_amdgcn_wave_barrier();
          __builtin_amdgcn_fence(__ATOMIC_ACQUIRE, "wavefront");
          {
            const int r = lane >> 4, ix = lane & 15;
            const unsigned mine = tmp[r * 16 + ix];
            const uint4 a = *(const uint4*)(tmp + r * 16), b = *(const uint4*)(tmp + r * 16 + 4), c = *(const uint4*)(tmp + r * 16 + 8),
                        d = *(const uint4*)(tmp + r * 16 + 12);
            const int rk = (a.x > mine) + (a.y > mine) + (a.z > mine) + (a.w > mine) + (b.x > mine) + (b.y > mine) + (b.z > mine) + (b.w > mine) +
                           (c.x > mine) + (c.y > mine) + (c.z > mine) + (c.w > mine) + (d.x > mine) + (d.y > mine) + (d.z > mine) + (d.w > mine);
            sTop[((hh * 64 + rbase + r) * 2 + ph) * 16 + rk] = mine;
          }
          __builtin_amdgcn_fence(__ATOMIC_RELEASE, "wavefront");
          __builtin_amdgcn_wave_barrier();
        }
        __syncthreads();
      }
    }
    const int ci = kCandI[lane], cj = kCandJ[lane];
    const bool act = lane < 50;
#pragma unroll 1
    for (int tg = 0; tg < 8; ++tg) {
      const int tb = w * 32 + tg * 4;
      unsigned k0[4], k1[4], ku[4], thr[4];
      float v[4];
#pragma unroll
      for (int r = 0; r < 4; ++r) {
        k0[r] = sTop[((tb + r) * 2 + 0) * 16 + ci];
        k1[r] = sTop[((tb + r) * 2 + 1) * 16 + cj];
        v[r] = key_score(k0[r]) + key_score(k1[r]);
        unsigned u = __float_as_uint(v[r]);
        u = (u & 0x80000000u) ? ~u : (u | 0x80000000u);
        ku[r] = act ? ((u & ~63u) | (unsigned)(63 - lane)) : 0u;
        thr[r] = 0u;
      }
#pragma unroll
      for (int bit = 31; bit >= 0; --bit) {
#pragma unroll
        for (int r = 0; r < 4; ++r) {
          const unsigned cand = thr[r] | (1u << bit);
          const int cnt = __popcll(__ballot(ku[r] >= cand));
          thr[r] = (cnt >= 16) ? cand : thr[r];
        }
      }
#pragma unroll
      for (int r = 0; r < 4; ++r) {
        const bool sel = act && (ku[r] >= thr[r]);
        const unsigned long long ms = __ballot(sel);
        const int slot = __builtin_amdgcn_mbcnt_hi((unsigned)(ms >> 32), __builtin_amdgcn_mbcnt_lo((unsigned)ms, 0u));
        const float vmax = __int_as_float(__builtin_amdgcn_readlane(__float_as_int(v[r]), 0));
        const float e = sel ? __expf(v[r] - vmax) : 0.f;
        const float tot = wave_sum(e);
        if (sel) {
          const int eid = (127 - (int)(k0[r] & 127u)) * 128 + (127 - (int)(k1[r] & 127u));
          const size_t o = (size_t)(m0 + tb + r) * 128 + hd * 16 + slot;
          p.experts[o] = eid;
          p.gates[o] = e / tot;
        }
      }
    }
  }
}

DEVI void phase_peer_gather(const Params& p) {
  const int w0_ = threadIdx.x >> 6;
#pragma unroll 1
  for (int tok = blockIdx.x * 4 + w0_; tok < NTOK; tok += gridDim.x * 4) {
    const int tid = launder(threadIdx.x), lane = tid & 63;
    const float4* hp4 = (const float4*)(p.h + (size_t)tok * LDHF) + lane * 4;
    float hv[16], xn[16], y[16];
    {
      const float4 a0 = hp4[0], a1 = hp4[1], a2 = hp4[2], a3 = hp4[3];
      hv[0] = a0.x; hv[1] = a0.y; hv[2] = a0.z; hv[3] = a0.w; hv[4] = a1.x; hv[5] = a1.y; hv[6] = a1.z; hv[7] = a1.w;
      hv[8] = a2.x; hv[9] = a2.y; hv[10] = a2.z; hv[11] = a2.w; hv[12] = a3.x; hv[13] = a3.y; hv[14] = a3.z; hv[15] = a3.w;
    }
    float ss = 0.f;
#pragma unroll
    for (int i = 0; i < 16; ++i) ss += hv[i] * hv[i];
    ss = wave_sum(ss);
    const float rstd = rsqrtf(ss * (1.f / D) + 1e-6f);
    {
      const float4* g4 = (const float4*)p.peer_g + lane * 4;
      const float4 a0 = g4[0], a1 = g4[1], a2 = g4[2], a3 = g4[3];
      const float gg[16] = {a0.x, a0.y, a0.z, a0.w, a1.x, a1.y, a1.z, a1.w, a2.x, a2.y, a2.z, a2.w, a3.x, a3.y, a3.z, a3.w};
#pragma unroll
      for (int i = 0; i < 16; ++i) { xn[i] = hv[i] * rstd * gg[i]; y[i] = 0.f; }
    }
    const int e0 = p.experts[(size_t)tok * 128 + lane], e1 = p.experts[(size_t)tok * 128 + 64 + lane];
    const float g0 = p.gates[(size_t)tok * 128 + lane], g1 = p.gates[(size_t)tok * 128 + 64 + lane];
    const float su0 = p.uscale[e0], su1 = p.uscale[e1];
    const float sv0 = p.vscale[e0], sv1 = p.vscale[e1];
    float cf0 = 0.f, cf1 = 0.f, dsum = 0.f;
    uint4 ca[8], cb[8];
#define LOADB_(R, bi)                                                                                   \
    _Pragma("unroll") for (int u = 0; u < 8; ++u) {                                                       \
      const int kk_ = (((bi) & 7) << 3) + u;                                                             \
      const int e_ = __builtin_amdgcn_readlane((((bi) >> 3) & 1) ? e1 : e0, kk_);                        \
      R[u] = ((const uint4*)((((bi) >> 4) ? p.vb8 : p.ub8) + (size_t)e_ * 1024))[lane];                  \
    }
#define COMPU_(R, bi)                                                                                   \
    _Pragma("unroll") for (int u = 0; u < 8; ++u) {                                                       \
      const unsigned uu[4] = {R[u].x, R[u].y, R[u].z, R[u].w};                                           \
      float d = 0.f;                                                                                     \
      _Pragma("unroll") for (int j = 0; j < 4; ++j) {                                                     \
        const f32x2 lo = __builtin_amdgcn_cvt_pk_f32_fp8((int)uu[j], false);                             \
        const f32x2 hi = __builtin_amdgcn_cvt_pk_f32_fp8((int)uu[j], true);                              \
        d += xn[4 * j] * lo[0]; d += xn[4 * j + 1] * lo[1]; d += xn[4 * j + 2] * hi[0]; d += xn[4 * j + 3] * hi[1]; \
      }                                                                                                  \
      d = wave_sum(d);                                                                                   \
      if (lane == (((bi) & 7) << 3) + u) dsum = d;                                                       \
    }                                                                                                    \
    if (((bi) & 7) == 7) {                                                                               \
      if (((bi) >> 3) & 1) cf1 = gelu_tanh(dsum * su1) * g1 * sv1; else cf0 = gelu_tanh(dsum * su0) * g0 * sv0; \
    }
#define COMPV_(R, bi)                                                                                   \
    _Pragma("unroll") for (int u = 0; u < 8; ++u) {                                                       \
      const int kk_ = (((bi) & 7) << 3) + u;                                                             \
      const float ck_ = __int_as_float(__builtin_amdgcn_readlane(__float_as_int((((bi) >> 3) & 1) ? cf1 : cf0), kk_)); \
      const unsigned uu[4] = {R[u].x, R[u].y, R[u].z, R[u].w};                                           \
      _Pragma("unroll") for (int j = 0; j < 4; ++j) {                                                     \
        const f32x2 lo = __builtin_amdgcn_cvt_pk_f32_fp8((int)uu[j], false);                             \
        const f32x2 hi = __builtin_amdgcn_cvt_pk_f32_fp8((int)uu[j], true);                              \
        y[4 * j] += ck_ * lo[0]; y[4 * j + 1] += ck_ * lo[1]; y[4 * j + 2] += ck_ * hi[0]; y[4 * j + 3] += ck_ * hi[1]; \
      }                                                                                                  \
    }
    LOADB_(ca, 0)
#pragma unroll 1
    for (int bi = 0; bi < 16; bi += 2) {
      LOADB_(cb, bi + 1)
      COMPU_(ca, bi)
      LOADB_(ca, bi + 2)
      COMPU_(cb, bi + 1)
    }
#pragma unroll 1
    for (int bi = 16; bi < 32; bi += 2) {
      LOADB_(cb, bi + 1)
      COMPV_(ca, bi)
      if (bi + 2 < 32) { LOADB_(ca, bi + 2) }
      COMPV_(cb, bi + 1)
    }
#undef LOADB_
#undef COMPU_
#undef COMPV_
    float s2 = 0.f;
    {
      const float4 a0 = hp4[0], a1 = hp4[1], a2 = hp4[2], a3 = hp4[3];
      const float hr[16] = {a0.x, a0.y, a0.z, a0.w, a1.x, a1.y, a1.z, a1.w, a2.x, a2.y, a2.z, a2.w, a3.x, a3.y, a3.z, a3.w};
#pragma unroll
      for (int i = 0; i < 16; ++i) { y[i] += hr[i]; s2 += y[i] * y[i]; }
    }
    s2 = wave_sum(s2);
    const float rs2 = rsqrtf(s2 * (1.f / D) + 1e-6f);
    {
      const float4* g4 = (const float4*)p.final_g + lane * 4;
      const float4 a0 = g4[0], a1 = g4[1], a2 = g4[2], a3 = g4[3];
      float4* o4 = (float4*)(p.out + (size_t)tok * D) + lane * 4;
      o4[0] = make_float4(y[0] * rs2 * a0.x, y[1] * rs2 * a0.y, y[2] * rs2 * a0.z, y[3] * rs2 * a0.w);
      o4[1] = make_float4(y[4] * rs2 * a1.x, y[5] * rs2 * a1.y, y[6] * rs2 * a1.z, y[7] * rs2 * a1.w);
      o4[2] = make_float4(y[8] * rs2 * a2.x, y[9] * rs2 * a2.y, y[10] * rs2 * a2.z, y[11] * rs2 * a2.w);
      o4[3] = make_float4(y[12] * rs2 * a3.x, y[13] * rs2 * a3.y, y[14] * rs2 * a3.z, y[15] * rs2 * a3.w);
    }
  }
}

template <bool COOP>
__global__ void __launch_bounds__(256, 2) mega(Params p, int ph_lo, int ph_hi) {
  __shared__ __attribute__((aligned(16))) unsigned char smem[SMEM_BYTES];
#ifdef REPEAT_MASK
#define RUN_PHASE(i, call)                                                                   \
  if (ph_lo <= (i) && (i) <= ph_hi) {                                                        \
    call;                                                                                    \
    if (COOP && ((REPEAT_MASK >> (i)) & 1)) { cg::this_grid().sync(); call; }                \
    if (COOP && (i) < ph_hi) cg::this_grid().sync();                                         \
  }
#else
#define RUN_PHASE(i, call)                                                                   \
  if (ph_lo <= (i) && (i) <= ph_hi) {                                                        \
    call;                                                                                    \
    if (COOP && (i) < ph_hi) cg::this_grid().sync();                                         \
  }
#endif
  RUN_PHASE(0, phase0(p))
  RUN_PHASE(1, phase1(p, smem))
  RUN_PHASE(2, phase2(p, smem))
  RUN_PHASE(3, phase3(p, smem))
  RUN_PHASE(4, phase_nsa(p, smem))
  RUN_PHASE(5, phase_resid(p, smem, p.mix, p.woutT, p.x, D, p.ssq1))
  RUN_PHASE(6, phase_scaled(p, smem, p.hn, p.wmqT, 8, p.ssq1, p.qm, LDA))
  RUN_PHASE(7, phase_memattn(p, smem))
  RUN_PHASE(8, phase_resid(p, smem, p.mix, p.wmoT, p.h, LDHF, p.ssq2))
  RUN_PHASE(9, phase_scaled(p, smem, p.hn, p.wpqT, 16, p.ssq2, p.pq, LDPQ))
  RUN_PHASE(10, phase_peer_route(p, smem))
  RUN_PHASE(11, phase_peer_gather(p))
#undef RUN_PHASE
}

extern "C" void kernel_launch(void* const* d_in, const int* in_sizes, int n_in, void* d_out, int out_size, void* d_ws,
                              size_t ws_size, hipStream_t stream) {
  (void)in_sizes; (void)n_in; (void)out_size; (void)ws_size;
  Params p{};
  p.x = (const float*)d_in[0]; p.mem = (const float*)d_in[1]; p.pos = (const int*)d_in[2];
  p.mix_g = (const float*)d_in[3]; p.w_in = (const float*)d_in[4]; p.conv_w = (const float*)d_in[5];
  p.conv_b = (const float*)d_in[6]; p.ln_g = (const float*)d_in[7]; p.ln_b = (const float*)d_in[8];
  p.cmp_pos = (const float*)d_in[9]; p.cmp_w1 = (const float*)d_in[10]; p.cmp_b1 = (const float*)d_in[11];
  p.cmp_w2 = (const float*)d_in[12]; p.cmp_b2 = (const float*)d_in[13]; p.w_out = (const float*)d_in[14];
  p.memq_g = (const float*)d_in[15]; p.memkv_g = (const float*)d_in[16]; p.w_mq = (const float*)d_in[17];
  p.w_mk = (const float*)d_in[18]; p.w_mv = (const float*)d_in[19]; p.w_mo = (const float*)d_in[20];
  p.peer_g = (const float*)d_in[21]; p.peer_wq = (const float*)d_in[22]; p.peer_sk = (const float*)d_in[23];
  p.peer_u = (const float*)d_in[24]; p.peer_v = (const float*)d_in[25]; p.final_g = (const float*)d_in[26];
  p.out = (float*)d_out;
  unsigned char* ws = (unsigned char*)d_ws;
  size_t off = 0;
  auto take = [&](size_t bytes) { unsigned char* r = ws + off; off += (bytes + 255) & ~(size_t)255; return r; };
  unsigned char* regA = take((size_t)NTOK * LDA * 2);
  unsigned char* regB = take((size_t)NTOK * LDP * 2);
  unsigned char* regC = take((size_t)NTOK * LDA * 2);
  p.hn = (u16*)regA; p.ub8 = regA; p.vb8 = regA + (size_t)16384 * 1024;
  p.uscale = (float*)(regA + (size_t)2 * 16384 * 1024); p.vscale = p.uscale + 16384;
  p.proj = (u16*)regB; p.qm = (u16*)regB; p.pq = (u16*)regB;
  p.mix = (u16*)regC; p.experts = (int*)regC; p.gates = (float*)(regC + (size_t)NTOK * 128 * 4);
  p.h = (float*)take((size_t)NTOK * LDHF * 4);
  p.vts = (u16*)take((size_t)Bn * 2 * 64 * LDT * 2);
  p.vtw = (u16*)take((size_t)Bn * 2 * 64 * LDT * 2);
  p.memn = (u16*)take((size_t)Bn * 256 * LDA * 2);
  p.memk = (u16*)take((size_t)Bn * 256 * LDA * 2);
  p.memvt = (u16*)take((size_t)Bn * 256 * D * 2);
  p.winT = (u16*)take((size_t)2432 * LDA * 2);
  p.woutT = (u16*)take((size_t)1024 * LDA * 2);
  p.wmqT = (u16*)take((size_t)1024 * LDA * 2);
  p.wmkT = (u16*)take((size_t)1024 * LDA * 2);
  p.wmvT = (u16*)take((size_t)1024 * LDA * 2);
  p.wmoT = (u16*)take((size_t)1024 * LDA * 2);
  p.wpqT = (u16*)take((size_t)2048 * LDA * 2);
  p.subk = (u16*)take((size_t)16 * 128 * 128 * 2);
  p.w1T = (u16*)take((size_t)2 * 128 * LDW1 * 2);
  p.w2T = (u16*)take((size_t)2 * 128 * 128 * 2);
  p.biasp = (float*)take(256 * 4);
  p.rope = (float*)take((size_t)NTOK * 16 * 4);
  p.hdn = (u16*)take((size_t)2 * 4096 * 128 * 2);
  p.kc = (u16*)take((size_t)Bn * 2 * 128 * 64 * 2);
  p.vcT = (u16*)take((size_t)Bn * 2 * 64 * 128 * 2);
  p.ssq1 = (float*)take((size_t)NTOK * 4);
  p.ssq2 = (float*)take((size_t)NTOK * 4);
  if (off > ws_size) { fprintf(stderr, "workspace too small: need %zu have %zu\n", off, ws_size); return; }

#if COOP_MODE
  static int grid_blocks = 0;
  if (!grid_blocks) {
    int dev = 0, cus = 0, per_cu = 0;
    hipGetDevice(&dev);
    hipDeviceGetAttribute(&cus, hipDeviceAttributeMultiprocessorCount, dev);
    hipOccupancyMaxActiveBlocksPerMultiprocessor(&per_cu, mega<true>, 256, 0);
    if (per_cu > 2) per_cu = 2;
    if (per_cu < 1) per_cu = 1;
    grid_blocks = cus * per_cu;
  }
  int lo = 0, hi = NPHASE;
  void* args[] = {&p, &lo, &hi};
  hipError_t e = hipLaunchCooperativeKernel((void*)mega<true>, dim3(grid_blocks), dim3(256), args, 0, stream);
  if (e != hipSuccess) fprintf(stderr, "cooperative launch failed: %s (grid %d)\n", hipGetErrorString(e), grid_blocks);
#else
  for (int ph = 0; ph <= NPHASE; ++ph) mega<false><<<dim3(512), dim3(256), 0, stream>>>(p, ph, ph);
#endif
}
```

```cpp
#include <hip/hip_runtime.h>
#include <hip/hip_bf16.h>
#include <hip/hip_cooperative_groups.h>
#include <cstdio>
#include <cstdint>
namespace cg = cooperative_groups;

#ifndef COOP_MODE
#define COOP_MODE 1
#endif

typedef __attribute__((ext_vector_type(8))) short bf16x8;
typedef __attribute__((ext_vector_type(4))) short bf16x4;
typedef __attribute__((ext_vector_type(4))) float f32x4;
typedef unsigned short u16;

#define DEVI __device__ __forceinline__

constexpr int Bn = 16, T = 2048, D = 1024, NTOK = Bn * T, LDP = 2336;
constexpr int C_Q = 1024, C_KC = 1536, C_VC = 1664, C_KS = 1792, C_VS = 1920, C_KW = 2048, C_VW = 2176, C_GATE = 2304;
constexpr int SMEM_BYTES = 73728;
constexpr int LDA = 1088;
constexpr int LDHF = 1056;
constexpr int LDPQ = 2112;
constexpr int LDW1 = 2112;
constexpr int LDT = 2112;
constexpr int NPHASE = 11;

struct Params {
  const float* x; const float* mem; const int* pos; const float* mix_g; const float* w_in;
  const float* conv_w; const float* conv_b; const float* ln_g; const float* ln_b;
  const float* cmp_pos; const float* cmp_w1; const float* cmp_b1; const float* cmp_w2; const float* cmp_b2;
  const float* w_out; const float* memq_g; const float* memkv_g; const float* w_mq; const float* w_mk;
  const float* w_mv; const float* w_mo; const float* peer_g; const float* peer_wq; const float* peer_sk;
  const float* peer_u; const float* peer_v; const float* final_g;
  float* out;
  u16* hn; u16* proj; u16* mix; float* h; u16* vts; u16* vtw; u16* memn; u16* memk; u16* memvt;
  u16* winT; u16* woutT; u16* wmqT; u16* wmkT; u16* wmvT; u16* wmoT; u16* wpqT; u16* subk; u16* w1T; u16* w2T;
  float* biasp; float* rope; u16* hdn; u16* kc; u16* vcT; float* ssq1; float* ssq2;
  int* experts; float* gates; unsigned char* ub8; unsigned char* vb8; float* uscale; float* vscale; u16* qm; u16* pq;
  unsigned* bar;
};

DEVI int launder(int x) { asm volatile("" : "+v"(x)); return x; }
DEVI u16 f2bf(float f) {
  unsigned u = __float_as_uint(f);
  u += 0x7fffu + ((u >> 16) & 1u);
  return (u16)(u >> 16);
}
DEVI float bf2f(u16 h) { return __uint_as_float(((unsigned)h) << 16); }
DEVI unsigned pack2(float a, float b) { return (unsigned)f2bf(a) | ((unsigned)f2bf(b) << 16); }
DEVI float wave_sum(float v) {
#pragma unroll
  for (int o = 32; o; o >>= 1) v += __shfl_xor(v, o);
  return v;
}
DEVI float sigmoidf_(float x) { return 1.f / (1.f + __expf(-x)); }
DEVI float gelu_tanh(float x) {
  float u = 0.7978845608028654f * (x + 0.044715f * x * x * x);
  return 0.5f * x * (1.f + tanhf(u));
}
DEVI f32x4 mfma16(bf16x8 a, bf16x8 b, f32x4 c) { return __builtin_amdgcn_mfma_f32_16x16x32_bf16(a, b, c, 0, 0, 0); }
DEVI float fexp2(float x) { return __builtin_amdgcn_exp2f(x); }

DEVI void tconv(const float* __restrict__ src, int K, int N, u16* __restrict__ dst, int Npad, int ldd,
                const float* __restrict__ gain, int gtid, int gsz) {
  const int items = Npad * (K >> 3);
  for (int it = gtid; it < items; it += gsz) {
    const int n = it % Npad, kc = it / Npad;
    float f[8];
#pragma unroll
    for (int j = 0; j < 8; ++j) {
      float v = 0.f;
      if (n < N) {
        v = src[(size_t)(kc * 8 + j) * N + n];
        if (gain) v *= gain[kc * 8 + j];
      }
      f[j] = v;
    }
    uint4 pk;
    pk.x = pack2(f[0], f[1]); pk.y = pack2(f[2], f[3]); pk.z = pack2(f[4], f[5]); pk.w = pack2(f[6], f[7]);
    *(uint4*)(dst + (size_t)n * ldd + kc * 8) = pk;
  }
}

DEVI void conv_flat(const float* __restrict__ src, u16* __restrict__ dst, size_t n8, size_t gtid, size_t gsz) {
  for (size_t it = gtid; it < n8; it += gsz) {
    const float4 a = ((const float4*)src)[2 * it], b = ((const float4*)src)[2 * it + 1];
    uint4 pk;
    pk.x = pack2(a.x, a.y); pk.y = pack2(a.z, a.w); pk.z = pack2(b.x, b.y); pk.w = pack2(b.z, b.w);
    ((uint4*)dst)[it] = pk;
  }
}


typedef float f32x2 __attribute__((ext_vector_type(2)));
DEVI unsigned pk4_fp8(float a, float b, float c, float d) {
  int v = 0;
  v = __builtin_amdgcn_cvt_pk_fp8_f32(a, b, v, false);
  v = __builtin_amdgcn_cvt_pk_fp8_f32(c, d, v, true);
  return (unsigned)v;
}
DEVI void conv_fp8_rows(const float* __restrict__ src, unsigned char* __restrict__ dst, float* __restrict__ inv_scale,
                        int rows, int gw, int nw, int lane) {
  for (int r = gw; r < rows; r += nw) {
    const float4* p4 = (const float4*)(src + (size_t)r * 1024) + lane * 4;
    const float4 a = p4[0], b = p4[1], c = p4[2], d = p4[3];
    float mx = fmaxf(fmaxf(fmaxf(fabsf(a.x), fabsf(a.y)), fmaxf(fabsf(a.z), fabsf(a.w))),
                     fmaxf(fmaxf(fabsf(b.x), fabsf(b.y)), fmaxf(fabsf(b.z), fabsf(b.w))));
    mx = fmaxf(mx, fmaxf(fmaxf(fmaxf(fabsf(c.x), fabsf(c.y)), fmaxf(fabsf(c.z), fabsf(c.w))),
                         fmaxf(fmaxf(fabsf(d.x), fabsf(d.y)), fmaxf(fabsf(d.z), fabsf(d.w)))));
#pragma unroll
    for (int o = 32; o; o >>= 1) mx = fmaxf(mx, __shfl_xor(mx, o));
    const float sc = mx > 0.f ? 224.f / mx : 1.f;
    if (lane == 0) inv_scale[r] = mx > 0.f ? mx * (1.f / 224.f) : 1.f;
    uint4 o4;
    o4.x = pk4_fp8(a.x * sc, a.y * sc, a.z * sc, a.w * sc);
    o4.y = pk4_fp8(b.x * sc, b.y * sc, b.z * sc, b.w * sc);
    o4.z = pk4_fp8(c.x * sc, c.y * sc, c.z * sc, c.w * sc);
    o4.w = pk4_fp8(d.x * sc, d.y * sc, d.z * sc, d.w * sc);
    ((uint4*)(dst + (size_t)r * 1024))[lane] = o4;
  }
}

DEVI void rownorm_bf16(const float* __restrict__ src, const float* __restrict__ g, u16* __restrict__ dst,
                       int rows, int gw, int nw, int lane) {
  for (int r = gw; r < rows; r += nw) {
    const float4* pr = (const float4*)(src + (size_t)r * D);
    float4 v[4];
    float ss = 0.f;
#pragma unroll
    for (int i = 0; i < 4; ++i) {
      v[i] = pr[lane + 64 * i];
      ss += v[i].x * v[i].x + v[i].y * v[i].y + v[i].z * v[i].z + v[i].w * v[i].w;
    }
    ss = wave_sum(ss);
    const float rstd = rsqrtf(ss * (1.f / D) + 1e-6f);
#pragma unroll
    for (int i = 0; i < 4; ++i) {
      const float4 gg = ((const float4*)g)[lane + 64 * i];
      uint2 pk;
      pk.x = pack2(v[i].x * rstd * gg.x, v[i].y * rstd * gg.y);
      pk.y = pack2(v[i].z * rstd * gg.z, v[i].w * rstd * gg.w);
      *(uint2*)(dst + (size_t)r * LDA + (size_t)(lane + 64 * i) * 4) = pk;
    }
  }
}

DEVI void phase0(const Params& p) {
  const int tid = launder(threadIdx.x), lane = tid & 63;
  const int gtid = blockIdx.x * 256 + tid, gsz = gridDim.x * 256;
  const int gw = gtid >> 6, nw = gsz >> 6;
  rownorm_bf16(p.x, p.mix_g, p.hn, NTOK, gw, nw, lane);
  rownorm_bf16(p.mem, p.memkv_g, p.memn, Bn * 256, gw, nw, lane);
  tconv(p.w_in, 1024, 2328, p.winT, 2432, LDA, nullptr, gtid, gsz);
  tconv(p.w_out, 1024, 1024, p.woutT, 1024, LDA, nullptr, gtid, gsz);
  tconv(p.w_mq, 1024, 1024, p.wmqT, 1024, LDA, p.memq_g, gtid, gsz);
  tconv(p.w_mk, 1024, 1024, p.wmkT, 1024, LDA, nullptr, gtid, gsz);
  tconv(p.w_mv, 1024, 1024, p.wmvT, 1024, LDA, nullptr, gtid, gsz);
  tconv(p.w_mo, 1024, 1024, p.wmoT, 1024, LDA, nullptr, gtid, gsz);
  tconv(p.peer_wq, 1024, 2048, p.wpqT, 2048, LDA, p.peer_g, gtid, gsz);
  tconv(p.cmp_w1, 2048, 128, p.w1T, 128, LDW1, nullptr, gtid, gsz);
  tconv(p.cmp_w1 + 2048 * 128, 2048, 128, p.w1T + 128 * LDW1, 128, LDW1, nullptr, gtid, gsz);
  tconv(p.cmp_w2, 128, 64, p.w2T, 128, 128, nullptr, gtid, gsz);
  tconv(p.cmp_w2 + 128 * 64, 128, 64, p.w2T + 128 * 128, 128, 128, nullptr, gtid, gsz);
  conv_flat(p.peer_sk, p.subk, (size_t)16 * 128 * 128 / 8, gtid, gsz);
  for (int it = gtid; it < NTOK * 8; it += gsz) {
    const int tok = it >> 3, i = it & 7;
    const float inv = (i == 0) ? 1.000000000e+00f : (i == 1) ? 1.939227432e-01f : (i == 2) ? 3.760603070e-02f : (i == 3) ? 7.292664610e-03f : (i == 4) ? 1.414213562e-03f : (i == 5) ? 2.742481884e-04f : (i == 6) ? 5.318295734e-05f : 1.031338525e-05f;
    const float ang = (float)p.pos[tok] * inv;
    float sv, cv;
    sincosf(ang, &sv, &cv);
    p.rope[tok * 16 + i] = cv;
    p.rope[tok * 16 + 8 + i] = sv;
  }
  for (int o = gw; o < 256; o += nw) {
    const int ty = o >> 7, n = o & 127;
    float s = 0.f;
    for (int k = lane; k < 2048; k += 64)
      s += p.cmp_pos[ty * 2048 + k] * p.cmp_w1[((size_t)ty * 2048 + k) * 128 + n];
    s = wave_sum(s);
    if (lane == 0) p.biasp[o] = s + p.cmp_b1[o];
  }
  for (int it = gtid; it < NTOK; it += gsz) { p.ssq1[it] = 0.f; p.ssq2[it] = 0.f; }
}

template <bool DB, class AF>
DEVI void gemm_mainloop(int tid, u16* sA, u16* sB, AF af, const u16* __restrict__ Bt, int ldb, int m0, int n0, int nk,
                        f32x4 (&acc)[4][4]) {
  const int lane = tid & 63, w = tid >> 6;
  const int wm = w >> 1, wn = w & 1, col = lane & 15, quad = lane >> 4;
#pragma unroll
  for (int i = 0; i < 4; ++i)
#pragma unroll
    for (int j = 0; j < 4; ++j) acc[i][j] = f32x4{0.f, 0.f, 0.f, 0.f};
  uint4 ra0, ra1, ra2, ra3, rb0, rb1, rb2, rb3;
  const int lrow = tid >> 3, lkc = (tid & 7) << 3;
  const u16* bbase = Bt + (size_t)(n0 + lrow) * ldb + lkc;
#define GL_(R, i, kk)                                                     \
  R##a##i = *(const uint4*)af(m0 + lrow + 32 * i, (kk) + lkc);            \
  R##b##i = *(const uint4*)(bbase + (size_t)(32 * i) * ldb + (kk));
#define SS_(R, i, off)                                                    \
  *(uint4*)(sA + (off) + (lrow + 32 * i) * 72 + lkc) = R##a##i;           \
  *(uint4*)(sB + (off) + (lrow + 32 * i) * 72 + lkc) = R##b##i;
#define GL4_(R, kk) GL_(R, 0, kk) GL_(R, 1, kk) GL_(R, 2, kk) GL_(R, 3, kk)
#define SS4_(R, off) SS_(R, 0, off) SS_(R, 1, off) SS_(R, 2, off) SS_(R, 3, off)
#define COMPUTE_(cur)                                                                                                   \
  _Pragma("unroll") for (int ks = 0; ks < 2; ++ks) {                                                                    \
    bf16x8 fa[4], fb[4];                                                                                                \
    _Pragma("unroll") for (int mi = 0; mi < 4; ++mi)                                                                    \
      fa[mi] = *(const bf16x8*)(sA + (cur) + (wm * 64 + 16 * mi + col) * 72 + 32 * ks + 8 * quad);                      \
    _Pragma("unroll") for (int ni = 0; ni < 4; ++ni)                                                                    \
      fb[ni] = *(const bf16x8*)(sB + (cur) + (wn * 64 + 16 * ni + col) * 72 + 32 * ks + 8 * quad);                      \
    _Pragma("unroll") for (int ni = 0; ni < 4; ++ni)                                                                    \
      _Pragma("unroll") for (int mi = 0; mi < 4; ++mi) acc[ni][mi] = mfma16(fb[ni], fa[mi], acc[ni][mi]);               \
  }
  if (DB) {
    const int srow = 8 * w + (lane >> 3);
    const int spc = lane & 7;
#define STAGE_(st, kk)                                                                                         \
    _Pragma("unroll") for (int i = 0; i < 4; ++i) {                                                            \
      const int r_ = 32 * i + srow;                                                                            \
      const int c_ = (spc ^ ((r_ >> 1) & 7)) << 3;                                                             \
      __builtin_amdgcn_global_load_lds((const unsigned*)af(m0 + r_, (kk) + c_),                                \
                                       (unsigned*)(sA + (st) * 16384 + (32 * i + 8 * w) * 64), 16, 0, 0);      \
      __builtin_amdgcn_global_load_lds((const unsigned*)(Bt + (size_t)(n0 + r_) * ldb + (kk) + c_),            \
                                       (unsigned*)(sA + (st) * 16384 + 8192 + (32 * i + 8 * w) * 64), 16, 0, 0); \
    }
#define COMPUTE_SW_(st)                                                                                                 \
  _Pragma("unroll") for (int ks = 0; ks < 2; ++ks) {                                                                    \
    bf16x8 fa[4], fb[4];                                                                                                \
    const int pc_ = ((4 * ks + quad) ^ ((col >> 1) & 7)) << 3;                                                          \
    _Pragma("unroll") for (int mi = 0; mi < 4; ++mi)                                                                    \
      fa[mi] = *(const bf16x8*)(sA + (st) * 16384 + (wm * 64 + 16 * mi + col) * 64 + pc_);                              \
    _Pragma("unroll") for (int ni = 0; ni < 4; ++ni)                                                                    \
      fb[ni] = *(const bf16x8*)(sA + (st) * 16384 + 8192 + (wn * 64 + 16 * ni + col) * 64 + pc_);                       \
    _Pragma("unroll") for (int ni = 0; ni < 4; ++ni)                                                                    \
      _Pragma("unroll") for (int mi = 0; mi < 4; ++mi) acc[ni][mi] = mfma16(fb[ni], fa[mi], acc[ni][mi]);               \
  }
    STAGE_(0, 0)
#pragma unroll 1
    for (int kt = 0; kt < nk; kt += 2) {
      asm volatile("s_waitcnt vmcnt(0)" ::: "memory");
      __syncthreads();
      { const int kk = (kt + 1) * 64; STAGE_(1, kk) }
      COMPUTE_SW_(0)
      asm volatile("s_waitcnt vmcnt(0)" ::: "memory");
      __syncthreads();
      if (kt + 2 < nk) { const int kk = (kt + 2) * 64; STAGE_(0, kk) }
      COMPUTE_SW_(1)
    }
#undef STAGE_
#undef COMPUTE_SW_
  } else {
    GL4_(r, 0)
    SS4_(r, 0)
    __syncthreads();
#pragma unroll 1
    for (int kt = 0; kt < nk; ++kt) {
      const bool more = (kt + 1 < nk);
      if (more) { const int kk = (kt + 1) * 64; GL4_(r, kk) }
      COMPUTE_(0)
      __syncthreads();
      if (more) {
        SS4_(r, 0)
        __syncthreads();
      }
    }
  }
#undef GL_
#undef SS_
#undef GL4_
#undef SS4_
#undef COMPUTE_
}

struct ARow {
  const u16* base; int lda;
  DEVI const u16* operator()(int m, int k) const { return base + (size_t)m * lda + k; }
};
struct ACmp {
  const u16* proj; int colbase;
  DEVI const u16* operator()(int rr, int k) const {
    const int b = rr >> 8, g = (rr >> 7) & 1;
    int c = rr & 127; c = c > 126 ? 126 : c;
    const int l = k >> 6, d = k & 63;
    return proj + ((size_t)b * T + 16 * c + l) * LDP + colbase + g * 64 + d;
  }
};


#define XCD_TILE_LOOP(idx, MT, NT)                                                                     \
  const bool sw_ = (gridDim.x & 7) == 0;                                                               \
  const int xcd_ = blockIdx.x & 7;                                                                     \
  const int tstart_ = sw_ ? (int)(blockIdx.x >> 3) : (int)blockIdx.x;                                  \
  const int tstep_ = sw_ ? (int)(gridDim.x >> 3) : (int)gridDim.x;                                     \
  const int ttotal_ = sw_ ? ((MT) / 8) * (NT) : (MT) * (NT);                                           \
  _Pragma("unroll 1") for (int idx = tstart_; idx < ttotal_; idx += tstep_)
#define XCD_TILE_MT(idx, NT) (sw_ ? ((idx) / (NT)) * 8 + xcd_ : (idx) / (NT))
#define XCD_TILE_NT(idx, NT) ((idx) % (NT))

#define GEMM_LANE_VARS                                                    \
  const int tid = launder(threadIdx.x), lane = tid & 63, w = tid >> 6;    \
  const int wm = w >> 1, wn = w & 1, col = lane & 15, quad = lane >> 4;   \
  (void)wm; (void)wn; (void)col; (void)quad;

DEVI void phase1(const Params& p, unsigned char* smem) {
  u16* sA = (u16*)smem; u16* sB = sA + 128 * 72;
  XCD_TILE_LOOP(idx, 256 + 32, 19) {
    GEMM_LANE_VARS
    f32x4 acc[4][4];
    const int mt = XCD_TILE_MT(idx, 19), nt_ = XCD_TILE_NT(idx, 19);
    if (mt < 256) {
      const int m0 = mt * 128, n0 = nt_ * 128;
      gemm_mainloop<true>(tid, sA, sB, ARow{p.hn, LDA}, p.winT, LDA, m0, n0, 16, acc);
#pragma unroll
      for (int mi = 0; mi < 4; ++mi) {
        const int m = m0 + wm * 64 + 16 * mi + col;
        const int b = m >> 11, t = m & 2047;
#pragma unroll
        for (int ni = 0; ni < 4; ++ni) {
          const int nt = n0 + wn * 64 + 16 * ni;
          const int n = nt + 4 * quad;
          f32x4 v = acc[ni][mi];
          if (nt >= LDP) continue;
          if ((nt >= C_VS && nt < C_KW) || (nt >= C_VW && nt < C_GATE)) {
            const bool isw = nt >= C_VW;
            const int off = n - (isw ? C_VW : C_VS);
            const int g = off >> 6, d = off & 63;
            u16* dst = (isw ? p.vtw : p.vts) + ((size_t)(b * 2 + g) * 64 + d) * LDT + t;
#pragma unroll
            for (int r = 0; r < 4; ++r) dst[(size_t)r * LDT] = f2bf(v[r]);
          } else {
            const bool rope_tile = ((nt >= C_KS && nt < C_VS) || (nt >= C_KW && nt < C_VW)) && ((nt & 63) == 0);
            if (rope_tile) {
#pragma unroll
              for (int r = 0; r < 4; ++r) {
                const float pr = __shfl_xor(v[r], 32);
                const int i = ((quad & 1) << 2) + r;
                const float cs = p.rope[(size_t)m * 16 + i], sn = p.rope[(size_t)m * 16 + 8 + i];
                v[r] = (quad < 2) ? (v[r] * cs - pr * sn) : (v[r] * cs + pr * sn);
              }
            }
            uint2 pk; pk.x = pack2(v[0], v[1]); pk.y = pack2(v[2], v[3]);
            *(uint2*)(p.proj + (size_t)m * LDP + n) = pk;
          }
        }
      }
    } else if (nt_ < 16) {
      const int isv = nt_ >> 3;
      const int m0 = (mt - 256) * 128, n0 = (nt_ & 7) * 128;
      gemm_mainloop<true>(tid, sA, sB, ARow{p.memn, LDA}, isv ? p.wmvT : p.wmkT, LDA, m0, n0, 16, acc);
#pragma unroll
      for (int mi = 0; mi < 4; ++mi) {
        const int m = m0 + wm * 64 + 16 * mi + col;
        const int b = m >> 8, key = m & 255;
#pragma unroll
        for (int ni = 0; ni < 4; ++ni) {
          const int n = n0 + wn * 64 + 16 * ni + 4 * quad;
          const f32x4 v = acc[ni][mi];
          if (isv) {
            const int head = n >> 8, d = n & 255;
            u16* dst = p.memvt + ((size_t)(b * 4 + head) * 256 + d) * 256 + key;
#pragma unroll
            for (int r = 0; r < 4; ++r) dst[r * 256] = f2bf(v[r]);
          } else {
            uint2 pk; pk.x = pack2(v[0], v[1]); pk.y = pack2(v[2], v[3]);
            *(uint2*)(p.memk + (size_t)m * LDA + n) = pk;
          }
        }
      }
    }
  }
}

DEVI void conv_tile(const Params& p, unsigned char* smem, int ct) {
  u16* sU = (u16*)smem;
  float2* sRed = (float2*)(smem + 62 * 512 * 2);
  const int tid = launder(threadIdx.x), lane = tid & 63, w = tid >> 6;
  const int b = ct >> 6, t0 = (ct & 63) * 32;
  __syncthreads();
  for (int it = tid; it < 62 * 64; it += 256) {
    const int r = it >> 6, c8 = it & 63;
    const int t = t0 - 30 + r;
    uint4 pk = {0u, 0u, 0u, 0u};
    if (t >= 0) {
      const u16* src = p.proj + ((size_t)b * T + t) * LDP + c8 * 8;
      const uint4 a = *(const uint4*)src, bb = *(const uint4*)(src + 512);
      const unsigned au[4] = {a.x, a.y, a.z, a.w}, bu[4] = {bb.x, bb.y, bb.z, bb.w};
      unsigned o[4];
#pragma unroll
      for (int j = 0; j < 4; ++j) {
        const float a0 = __uint_as_float(au[j] << 16), a1 = __uint_as_float(au[j] & 0xffff0000u);
        const float b0 = __uint_as_float(bu[j] << 16), b1 = __uint_as_float(bu[j] & 0xffff0000u);
        o[j] = pack2(a0 * sigmoidf_(b0), a1 * sigmoidf_(b1));
      }
      pk.x = o[0]; pk.y = o[1]; pk.z = o[2]; pk.w = o[3];
    }
    *(uint4*)(sU + r * 512 + c8 * 8) = pk;
  }
  const int c = 2 * tid;
  float w0[31], w1[31];
#pragma unroll
  for (int j = 0; j < 31; ++j) { w0[j] = p.conv_w[j * 512 + c]; w1[j] = p.conv_w[j * 512 + c + 1]; }
  const float bd0 = p.conv_b[c], bd1 = p.conv_b[c + 1];
  __syncthreads();
  for (int tt = 0; tt < 32; ++tt) {
    float y0 = bd0, y1 = bd1;
#pragma unroll
    for (int j = 0; j < 31; ++j) {
      const unsigned uu = *(const unsigned*)(sU + (tt + j) * 512 + c);
      y0 += w0[j] * __uint_as_float(uu << 16);
      y1 += w1[j] * __uint_as_float(uu & 0xffff0000u);
    }
    float s = y0 + y1, q = y0 * y0 + y1 * y1;
    s = wave_sum(s); q = wave_sum(q);
    if (lane == 0) sRed[tt * 4 + w] = make_float2(s, q);
  }
  __syncthreads();
  const float g0 = p.ln_g[c], g1 = p.ln_g[c + 1], lb0 = p.ln_b[c], lb1 = p.ln_b[c + 1];
  for (int tt = 0; tt < 32; ++tt) {
    float y0 = bd0, y1 = bd1;
#pragma unroll
    for (int j = 0; j < 31; ++j) {
      const unsigned uu = *(const unsigned*)(sU + (tt + j) * 512 + c);
      y0 += w0[j] * __uint_as_float(uu << 16);
      y1 += w1[j] * __uint_as_float(uu & 0xffff0000u);
    }
    const float2 r0 = sRed[tt * 4 + 0], r1 = sRed[tt * 4 + 1], r2 = sRed[tt * 4 + 2], r3 = sRed[tt * 4 + 3];
    const float S = r0.x + r1.x + r2.x + r3.x, Q = r0.y + r1.y + r2.y + r3.y;
    const float mu = S * (1.f / 512.f);
    const float var = fmaxf(Q * (1.f / 512.f) - mu * mu, 0.f);
    const float rstd = rsqrtf(var + 1e-6f);
    const float z0 = (y0 - mu) * rstd * g0 + lb0, z1 = (y1 - mu) * rstd * g1 + lb1;
    const float o0 = z0 * sigmoidf_(z0), o1 = z1 * sigmoidf_(z1);
    *(unsigned*)(p.mix + ((size_t)b * T + t0 + tt) * LDA + c) = pack2(o0, o1);
  }
}

DEVI void phase2(const Params& p, unsigned char* smem) {
  u16* sA = (u16*)smem; u16* sB = sA + 128 * 72;
#pragma unroll 1
  for (int tile = blockIdx.x; tile < 64 + 1024; tile += gridDim.x) {
    GEMM_LANE_VARS
    if (tile < 64) {
      const int ty = tile >> 5, mt = tile & 31;
      const int m0 = mt * 128;
      f32x4 acc[4][4];
      gemm_mainloop<true>(tid, sA, sB, ACmp{p.proj, ty ? C_VC : C_KC}, p.w1T + (size_t)ty * 128 * LDW1, LDW1, m0, 0, 32, acc);
#pragma unroll
      for (int mi = 0; mi < 4; ++mi) {
        const int m = m0 + wm * 64 + 16 * mi + col;
#pragma unroll
        for (int ni = 0; ni < 4; ++ni) {
          const int n = wn * 64 + 16 * ni + 4 * quad;
          const f32x4 v = acc[ni][mi];
          const float4 bb = *(const float4*)(p.biasp + ty * 128 + n);
          uint2 pk;
          pk.x = pack2(gelu_tanh(v[0] + bb.x), gelu_tanh(v[1] + bb.y));
          pk.y = pack2(gelu_tanh(v[2] + bb.z), gelu_tanh(v[3] + bb.w));
          *(uint2*)(p.hdn + ((size_t)ty * 4096 + m) * 128 + n) = pk;
        }
      }
    } else {
      conv_tile(p, smem, tile - 64);
    }
  }
}

DEVI void phase3(const Params& p, unsigned char* smem) {
  u16* sA = (u16*)smem; u16* sB = sA + 128 * 72;
#pragma unroll 1
  for (int tile = blockIdx.x; tile < 64; tile += gridDim.x) {
    GEMM_LANE_VARS
    const int ty = tile >> 5, mt = tile & 31;
    const int m0 = mt * 128;
    f32x4 acc[4][4];
    gemm_mainloop<true>(tid, sA, sB, ARow{p.hdn + (size_t)ty * 4096 * 128, 128}, p.w2T + (size_t)ty * 128 * 128, 128, m0, 0, 2, acc);
    if (wn == 0) {
#pragma unroll
      for (int mi = 0; mi < 4; ++mi) {
        const int m = m0 + 16 * mi + wm * 64 + col;
        const int bg = m >> 7, c = m & 127;
#pragma unroll
        for (int ni = 0; ni < 4; ++ni) {
          const int n = 16 * ni + 4 * quad;
          const f32x4 v = acc[ni][mi];
          const float4 bb = *(const float4*)(p.cmp_b2 + ty * 64 + n);
          const float o0 = v[0] + bb.x, o1 = v[1] + bb.y, o2 = v[2] + bb.z, o3 = v[3] + bb.w;
          if (ty == 0) {
            uint2 pk; pk.x = pack2(o0, o1); pk.y = pack2(o2, o3);
            *(uint2*)(p.kc + (size_t)m * 64 + n) = pk;
          } else {
            u16* dst = p.vcT + ((size_t)bg * 64 + n) * 128 + c;
            dst[0] = f2bf(o0); dst[128] = f2bf(o1); dst[256] = f2bf(o2); dst[384] = f2bf(o3);
          }
        }
      }
    }
  }
}

template <int DH, int NQ, int LDK, int LDV, class MaskF>
DEVI void attn_tile(const u16* sK, const u16* sVt, const bf16x8 (&qf)[NQ][DH / 32], f32x4 (&o)[NQ][DH / 16],
                    float (&m)[NQ], float (&l)[NQ], float c2, int lane, MaskF valid) {
  const int col = lane & 15, quad = lane >> 4;
  f32x4 s[NQ][4];
#pragma unroll
  for (int kt = 0; kt < 4; ++kt) {
#pragma unroll
    for (int qt = 0; qt < NQ; ++qt) s[qt][kt] = f32x4{0.f, 0.f, 0.f, 0.f};
#pragma unroll
    for (int ks = 0; ks < DH / 32; ++ks) {
      const bf16x8 kf = *(const bf16x8*)(sK + (16 * kt + col) * LDK + 32 * ks + 8 * quad);
#pragma unroll
      for (int qt = 0; qt < NQ; ++qt) s[qt][kt] = mfma16(kf, qf[qt][ks], s[qt][kt]);
    }
  }
  bf16x8 pb[NQ][2];
#pragma unroll
  for (int qt = 0; qt < NQ; ++qt) {
    float mx = -1e30f;
#pragma unroll
    for (int kt = 0; kt < 4; ++kt)
#pragma unroll
      for (int r = 0; r < 4; ++r) {
        const bool v = valid(qt, 16 * kt + 4 * quad + r);
        const float sv = v ? s[qt][kt][r] : -1e30f;
        s[qt][kt][r] = sv;
        mx = fmaxf(mx, sv);
      }
    mx = fmaxf(mx, __shfl_xor(mx, 16));
    mx = fmaxf(mx, __shfl_xor(mx, 32));
    const float mn = fmaxf(m[qt], mx);
    const float alpha = fexp2((m[qt] - mn) * c2);
    m[qt] = mn;
    float ps = 0.f;
#pragma unroll
    for (int kt = 0; kt < 4; ++kt)
#pragma unroll
      for (int r = 0; r < 4; ++r) {
        const float sv = s[qt][kt][r];
        const float pv = (sv > -1e29f) ? fexp2((sv - mn) * c2) : 0.f;
        ps += pv;
        s[qt][kt][r] = pv;
      }
    l[qt] = l[qt] * alpha + ps;
#pragma unroll
    for (int dt = 0; dt < DH / 16; ++dt) o[qt][dt] *= alpha;
#pragma unroll
    for (int kk = 0; kk < 2; ++kk) {
      union { bf16x8 v; unsigned u[4]; } cv;
      cv.u[0] = pack2(s[qt][2 * kk][0], s[qt][2 * kk][1]);
      cv.u[1] = pack2(s[qt][2 * kk][2], s[qt][2 * kk][3]);
      cv.u[2] = pack2(s[qt][2 * kk + 1][0], s[qt][2 * kk + 1][1]);
      cv.u[3] = pack2(s[qt][2 * kk + 1][2], s[qt][2 * kk + 1][3]);
      pb[qt][kk] = cv.v;
    }
  }
#pragma unroll
  for (int dt = 0; dt < DH / 16; ++dt) {
#pragma unroll
    for (int kk = 0; kk < 2; ++kk) {
      union { bf16x8 v; uint2 h[2]; } cv;
      cv.h[0] = *(const uint2*)(sVt + (16 * dt + col) * LDV + 32 * kk + 4 * quad);
      cv.h[1] = *(const uint2*)(sVt + (16 * dt + col) * LDV + 32 * kk + 16 + 4 * quad);
#pragma unroll
      for (int qt = 0; qt < NQ; ++qt) o[qt][dt] = mfma16(cv.v, pb[qt][kk], o[qt][dt]);
    }
  }
}

DEVI void phase_nsa(const Params& p, unsigned char* smem) {
  u16* sK = (u16*)smem;
  u16* sVt = (u16*)(smem + 18432);
  float* impH = (float*)(smem + 35840);
  float* impT = (float*)(smem + 52736);
  unsigned* selm = (unsigned*)(smem + 56960);
  const float c2 = 0.125f * 1.4426950408889634f;
#pragma unroll 1
  for (int tile = blockIdx.x; tile < 2048; tile += gridDim.x) {
    const int tid = launder(threadIdx.x), lane = tid & 63, w = tid >> 6, col = lane & 15, quad = lane >> 4;
    const int qtile = 63 - (tile >> 5), bg = tile & 31, b = bg >> 1, g = bg & 1, q0 = qtile * 32;
    const int h = g * 4 + w;
    __syncthreads();
    if (tid < 32) selm[tid] = 0u;
    {
      const u16* kcp = p.kc + (size_t)bg * 128 * 64;
      const u16* vcp = p.vcT + (size_t)bg * 64 * 128;
#pragma unroll
      for (int i = 0; i < 4; ++i) {
        const int c = tid + 256 * i;
        const int row = c >> 3, ch = (c & 7) << 3;
        *(uint4*)(sK + row * 72 + ch) = *(const uint4*)(kcp + row * 64 + ch);
        const int row2 = c >> 4, ch2 = (c & 15) << 3;
        *(uint4*)(sVt + row2 * 136 + ch2) = *(const uint4*)(vcp + row2 * 128 + ch2);
      }
    }
    bf16x8 qf[2][2];
    float gate[2][3];
    int tq[2];
#pragma unroll
    for (int qt = 0; qt < 2; ++qt) {
      const int t = q0 + 16 * qt + col;
      tq[qt] = t;
      const size_t tok = (size_t)b * T + t;
      const u16* qp = p.proj + tok * LDP + C_Q + h * 64 + 8 * quad;
      qf[qt][0] = *(const bf16x8*)qp;
      qf[qt][1] = *(const bf16x8*)(qp + 32);
#pragma unroll
      for (int br = 0; br < 3; ++br) gate[qt][br] = sigmoidf_(bf2f(p.proj[tok * LDP + C_GATE + h * 3 + br]));
    }
    __syncthreads();

    f32x4 comb[2][4];
    {
      const int srcl = (lane + 48) & 63;
#pragma unroll
      for (int qt = 0; qt < 2; ++qt) {
        f32x4 s[8];
#pragma unroll
        for (int kt = 0; kt < 8; ++kt) {
          s[kt] = f32x4{0.f, 0.f, 0.f, 0.f};
#pragma unroll
          for (int ks = 0; ks < 2; ++ks) {
            const bf16x8 kf = *(const bf16x8*)(sK + (16 * kt + col) * 72 + 32 * ks + 8 * quad);
            s[kt] = mfma16(kf, qf[qt][ks], s[kt]);
          }
        }
        const int t = tq[qt];
        float mx = -1e30f;
#pragma unroll
        for (int kt = 0; kt < 8; ++kt)
#pragma unroll
          for (int r = 0; r < 4; ++r) {
            const int c = 16 * kt + 4 * quad + r;
            const bool v = (16 * c + 31) <= t;
            const float sv = v ? s[kt][r] : -1e30f;
            s[kt][r] = sv;
            mx = fmaxf(mx, sv);
          }
        mx = fmaxf(mx, __shfl_xor(mx, 16));
        mx = fmaxf(mx, __shfl_xor(mx, 32));
        float ps = 0.f;
#pragma unroll
        for (int kt = 0; kt < 8; ++kt)
#pragma unroll
          for (int r = 0; r < 4; ++r) {
            const float sv = s[kt][r];
            const float pv = (sv > -1e29f) ? fexp2((sv - mx) * c2) : 0.f;
            ps += pv;
            s[kt][r] = pv;
          }
        ps += __shfl_xor(ps, 16);
        ps += __shfl_xor(ps, 32);
        const float inv = ps > 0.f ? 1.f / ps : 0.f;
#pragma unroll
        for (int kt = 0; kt < 8; ++kt)
#pragma unroll
          for (int r = 0; r < 4; ++r) s[kt][r] *= inv;
        float prev3 = 0.f;
#pragma unroll
        for (int kt = 0; kt < 8; ++kt) {
          const float sum4 = s[kt][0] + s[kt][1] + s[kt][2] + s[kt][3];
          const float xs = __shfl(s[kt][3], srcl);
          const float extra = quad ? xs : prev3;
          prev3 = xs;
          impH[(w * 32 + 16 * qt + col) * 33 + 4 * kt + quad] = sum4 + extra;
        }
        bf16x8 pb[4];
#pragma unroll
        for (int kk = 0; kk < 4; ++kk) {
          union { bf16x8 v; unsigned u[4]; } cv;
          cv.u[0] = pack2(s[2 * kk][0], s[2 * kk][1]);
          cv.u[1] = pack2(s[2 * kk][2], s[2 * kk][3]);
          cv.u[2] = pack2(s[2 * kk + 1][0], s[2 * kk + 1][1]);
          cv.u[3] = pack2(s[2 * kk + 1][2], s[2 * kk + 1][3]);
          pb[kk] = cv.v;
        }
#pragma unroll
        for (int dt = 0; dt < 4; ++dt) {
          f32x4 oc = f32x4{0.f, 0.f, 0.f, 0.f};
#pragma unroll
          for (int kk = 0; kk < 4; ++kk) {
            union { bf16x8 v; uint2 hh[2]; } cv;
            cv.hh[0] = *(const uint2*)(sVt + (16 * dt + col) * 136 + 32 * kk + 4 * quad);
            cv.hh[1] = *(const uint2*)(sVt + (16 * dt + col) * 136 + 32 * kk + 16 + 4 * quad);
            oc = mfma16(cv.v, pb[kk], oc);
          }
          comb[qt][dt] = oc * gate[qt][0];
        }
      }
    }
#pragma unroll
    for (int qt = 0; qt < 2; ++qt) {
      const size_t tok = (size_t)b * T + tq[qt];
      union { bf16x8 v; unsigned u[4]; } own, par, res;
      own.v = qf[qt][0];
#pragma unroll
      for (int j = 0; j < 4; ++j) par.u[j] = (unsigned)__shfl_xor((int)own.u[j], 16);
      const float4 c0 = *(const float4*)(p.rope + tok * 16), c1 = *(const float4*)(p.rope + tok * 16 + 4);
      const float4 s0 = *(const float4*)(p.rope + tok * 16 + 8), s1 = *(const float4*)(p.rope + tok * 16 + 12);
      const float cs[8] = {c0.x, c0.y, c0.z, c0.w, c1.x, c1.y, c1.z, c1.w};
      const float sn[8] = {s0.x, s0.y, s0.z, s0.w, s1.x, s1.y, s1.z, s1.w};
#pragma unroll
      for (int j = 0; j < 4; ++j) {
        const float o0 = __uint_as_float(own.u[j] << 16), o1 = __uint_as_float(own.u[j] & 0xffff0000u);
        const float p0 = __uint_as_float(par.u[j] << 16), p1 = __uint_as_float(par.u[j] & 0xffff0000u);
        const float sg = (quad == 0) ? -1.f : 1.f;
        const float r0 = o0 * cs[2 * j] + sg * p0 * sn[2 * j];
        const float r1 = o1 * cs[2 * j + 1] + sg * p1 * sn[2 * j + 1];
        res.u[j] = (quad < 2) ? pack2(r0, r1) : own.u[j];
      }
      qf[qt][0] = res.v;
    }
    __syncthreads();
#pragma unroll
    for (int i = 0; i < 4; ++i) {
      const int cell = tid + 256 * i;
      const int qi = cell >> 5, s_ = cell & 31;
      const int cur = (q0 + qi) >> 6;
      float v = impH[(0 * 32 + qi) * 33 + s_] + impH[(1 * 32 + qi) * 33 + s_] + impH[(2 * 32 + qi) * 33 + s_] +
                impH[(3 * 32 + qi) * 33 + s_];
      const int dist = cur - s_;
      const bool forced = (s_ == 0) || (dist >= 0 && dist < 2);
      v = forced ? 1e9f : (s_ <= cur ? v : -1.f);
      impT[qi * 33 + s_] = v;
    }
    __syncthreads();
    {
      const int qi = tid >> 3, sub = tid & 7;
      unsigned bits = 0u;
#pragma unroll
      for (int k = 0; k < 4; ++k) {
        const int s_ = sub * 4 + k;
        const float v = impT[qi * 33 + s_];
        int rank = 0;
        for (int s2 = 0; s2 < 32; ++s2) {
          const float v2 = impT[qi * 33 + s2];
          rank += ((v2 > v) || (v2 == v && s2 < s_)) ? 1 : 0;
        }
        if (rank < 16) bits |= 1u << s_;
      }
      atomicOr(&selm[qi], bits);
    }
    __syncthreads();
    unsigned sm[2] = {selm[col], selm[16 + col]};
    unsigned uni = 0u;
#pragma unroll
    for (int i = 0; i < 32; ++i) uni |= selm[i];
    const int kbmax = (q0 + 31) >> 6;
    {
      float m[2] = {-1e30f, -1e30f}, l[2] = {0.f, 0.f};
      f32x4 o[2][4];
#pragma unroll
      for (int qt = 0; qt < 2; ++qt)
#pragma unroll
        for (int dt = 0; dt < 4; ++dt) o[qt][dt] = f32x4{0.f, 0.f, 0.f, 0.f};
      unsigned rem = (kbmax >= 31) ? uni : (uni & ((1u << (kbmax + 1)) - 1u));
      int kb = rem ? (__ffs((int)rem) - 1) : -1;
      uint4 rk0, rk1, rv0, rv1;
      const int lr0 = tid >> 3, lch = (tid & 7) << 3;
#define LOADKV_(kbx, CK, VT)                                                                                         \
      rk0 = *(const uint4*)(p.proj + ((size_t)b * T + (kbx) * 64 + lr0) * LDP + (CK) + g * 64 + lch);                 \
      rk1 = *(const uint4*)(p.proj + ((size_t)b * T + (kbx) * 64 + lr0 + 32) * LDP + (CK) + g * 64 + lch);            \
      rv0 = *(const uint4*)((VT) + ((size_t)bg * 64 + lr0) * LDT + (kbx) * 64 + lch);                                 \
      rv1 = *(const uint4*)((VT) + ((size_t)bg * 64 + lr0 + 32) * LDT + (kbx) * 64 + lch);
#define STOREKV_()                                                                                                   \
      *(uint4*)(sK + lr0 * 72 + lch) = rk0; *(uint4*)(sK + (lr0 + 32) * 72 + lch) = rk1;                              \
      *(uint4*)(sVt + lr0 * 72 + lch) = rv0; *(uint4*)(sVt + (lr0 + 32) * 72 + lch) = rv1;
      if (kb >= 0) { LOADKV_(kb, C_KS, p.vts) }
#pragma unroll 1
      while (kb >= 0) {
        rem &= rem - 1u;
        const int nkb = rem ? (__ffs((int)rem) - 1) : -1;
        __syncthreads();
        STOREKV_()
        if (nkb >= 0) { LOADKV_(nkb, C_KS, p.vts) }
        __syncthreads();
        attn_tile<64, 2, 72, 72>(sK, sVt, qf, o, m, l, c2, lane, [&](int qt, int kl) {
          const int kp = kb * 64 + kl;
          return (((sm[qt] >> kb) & 1u) != 0u) && (kp <= tq[qt]);
        });
        kb = nkb;
      }
#pragma unroll
      for (int qt = 0; qt < 2; ++qt) {
        float lt = l[qt];
        lt += __shfl_xor(lt, 16);
        lt += __shfl_xor(lt, 32);
        const float sc = lt > 0.f ? gate[qt][1] / lt : 0.f;
#pragma unroll
        for (int dt = 0; dt < 4; ++dt) comb[qt][dt] += o[qt][dt] * sc;
      }
    }
    {
      float m[2] = {-1e30f, -1e30f}, l[2] = {0.f, 0.f};
      f32x4 o[2][4];
#pragma unroll
      for (int qt = 0; qt < 2; ++qt)
#pragma unroll
        for (int dt = 0; dt < 4; ++dt) o[qt][dt] = f32x4{0.f, 0.f, 0.f, 0.f};
      const int kblo = (q0 >= 511) ? ((q0 - 511) >> 6) : 0;
      uint4 rk0, rk1, rv0, rv1;
      const int lr0 = tid >> 3, lch = (tid & 7) << 3;
      int kb = kblo;
      LOADKV_(kb, C_KW, p.vtw)
#pragma unroll 1
      while (kb >= 0) {
        const int nkb = (kb < kbmax) ? kb + 1 : -1;
        __syncthreads();
        STOREKV_()
        if (nkb >= 0) { LOADKV_(nkb, C_KW, p.vtw) }
        __syncthreads();
        attn_tile<64, 2, 72, 72>(sK, sVt, qf, o, m, l, c2, lane, [&](int qt, int kl) {
          const int kp = kb * 64 + kl;
          return (kp <= tq[qt]) && (kp > tq[qt] - 512);
        });
        kb = nkb;
      }
#undef LOADKV_
#undef STOREKV_
#pragma unroll
      for (int qt = 0; qt < 2; ++qt) {
        float lt = l[qt];
        lt += __shfl_xor(lt, 16);
        lt += __shfl_xor(lt, 32);
        const float sc = lt > 0.f ? gate[qt][2] / lt : 0.f;
#pragma unroll
        for (int dt = 0; dt < 4; ++dt) comb[qt][dt] += o[qt][dt] * sc;
      }
    }
#pragma unroll
    for (int qt = 0; qt < 2; ++qt) {
      const size_t tok = (size_t)b * T + tq[qt];
#pragma unroll
      for (int dt = 0; dt < 4; ++dt) {
        uint2 pk;
        pk.x = pack2(comb[qt][dt][0], comb[qt][dt][1]);
        pk.y = pack2(comb[qt][dt][2], comb[qt][dt][3]);
        *(uint2*)(p.mix + tok * LDA + 512 + h * 64 + 16 * dt + 4 * quad) = pk;
      }
    }
  }
}

DEVI void phase_resid(const Params& p, unsigned char* smem, const u16* A, const u16* Wt, const float* res, int ldres, float* ssq) {
  u16* sA = (u16*)smem; u16* sB = sA + 128 * 72;
  XCD_TILE_LOOP(idx, 256, 8) {
    GEMM_LANE_VARS
    const int mt = XCD_TILE_MT(idx, 8), nt_ = XCD_TILE_NT(idx, 8);
    const int m0 = mt * 128, n0 = nt_ * 128;
    f32x4 acc[4][4];
    gemm_mainloop<true>(tid, sA, sB, ARow{A, LDA}, Wt, LDA, m0, n0, 16, acc);
#pragma unroll
    for (int mi = 0; mi < 4; ++mi) {
      const int m = m0 + wm * 64 + 16 * mi + col;
      float ss = 0.f;
#pragma unroll
      for (int ni = 0; ni < 4; ++ni) {
        const int n = n0 + wn * 64 + 16 * ni + 4 * quad;
        const f32x4 v = acc[ni][mi];
        const float4 r = *(const float4*)(res + (size_t)m * ldres + n);
        float4 hv;
        hv.x = r.x + v[0]; hv.y = r.y + v[1]; hv.z = r.z + v[2]; hv.w = r.w + v[3];
        ss += hv.x * hv.x + hv.y * hv.y + hv.z * hv.z + hv.w * hv.w;
        *(float4*)(p.h + (size_t)m * LDHF + n) = hv;
        uint2 pk; pk.x = pack2(hv.x, hv.y); pk.y = pack2(hv.z, hv.w);
        *(uint2*)(p.hn + (size_t)m * LDA + n) = pk;
      }
      ss += __shfl_xor(ss, 16);
      ss += __shfl_xor(ss, 32);
      if (quad == 0) atomicAdd(ssq + m, ss);
    }
  }
}

DEVI void phase_scaled(const Params& p, unsigned char* smem, const u16* A, const u16* Wt, int ntn, const float* ssq, u16* outp, int ldo) {
  u16* sA = (u16*)smem; u16* sB = sA + 128 * 72;
  XCD_TILE_LOOP(idx, 256, ntn) {
    GEMM_LANE_VARS
    const int mt = XCD_TILE_MT(idx, ntn), nt_ = XCD_TILE_NT(idx, ntn);
    const int m0 = mt * 128, n0 = nt_ * 128;
    f32x4 acc[4][4];
    gemm_mainloop<true>(tid, sA, sB, ARow{A, LDA}, Wt, LDA, m0, n0, 16, acc);
#pragma unroll
    for (int mi = 0; mi < 4; ++mi) {
      const int m = m0 + wm * 64 + 16 * mi + col;
      const float rstd = rsqrtf(ssq[m] * (1.f / D) + 1e-6f);
#pragma unroll
      for (int ni = 0; ni < 4; ++ni) {
        const int n = n0 + wn * 64 + 16 * ni + 4 * quad;
        const f32x4 v = acc[ni][mi];
        uint2 pk; pk.x = pack2(v[0] * rstd, v[1] * rstd); pk.y = pack2(v[2] * rstd, v[3] * rstd);
        *(uint2*)(outp + (size_t)m * ldo + n) = pk;
      }
    }
  }
}

DEVI void phase_memattn(const Params& p, unsigned char* smem) {
  u16* sK = (u16*)smem;
  u16* sVt = (u16*)(smem + 33792);
  const float c2 = 0.0625f * 1.4426950408889634f;
#pragma unroll 1
  for (int tile = blockIdx.x; tile < 2048; tile += gridDim.x) {
    const int tid = launder(threadIdx.x), lane = tid & 63, w = tid >> 6, col = lane & 15, quad = lane >> 4;
    const int b = tile >> 7, head = (tile >> 5) & 3, q0 = (tile & 31) * 64;
    const size_t tok = (size_t)b * T + q0 + 16 * w + col;
    bf16x8 qf[1][8];
#pragma unroll
    for (int ks = 0; ks < 8; ++ks) qf[0][ks] = *(const bf16x8*)(p.qm + tok * LDA + head * 256 + 32 * ks + 8 * quad);
    float m[1] = {-1e30f}, l[1] = {0.f};
    f32x4 o[1][16];
#pragma unroll
    for (int dt = 0; dt < 16; ++dt) o[0][dt] = f32x4{0.f, 0.f, 0.f, 0.f};
#pragma unroll 1
    for (int kb = 0; kb < 4; ++kb) {
      __syncthreads();
#pragma unroll
      for (int i = 0; i < 8; ++i) {
        const int c = tid + 256 * i;
        const int row = c >> 5, ch = (c & 31) << 3;
        *(uint4*)(sK + row * 264 + ch) = *(const uint4*)(p.memk + ((size_t)b * 256 + kb * 64 + row) * LDA + head * 256 + ch);
      }
      __builtin_amdgcn_sched_barrier(0);
#pragma unroll
      for (int i = 0; i < 8; ++i) {
        const int c = tid + 256 * i;
        const int row2 = c >> 3, ch2 = (c & 7) << 3;
        *(uint4*)(sVt + row2 * 72 + ch2) = *(const uint4*)(p.memvt + ((size_t)(b * 4 + head) * 256 + row2) * 256 + kb * 64 + ch2);
      }
      __syncthreads();
      attn_tile<256, 1, 264, 72>(sK, sVt, qf, o, m, l, c2, lane, [&](int, int) { return true; });
    }
    float lt = l[0];
    lt += __shfl_xor(lt, 16);
    lt += __shfl_xor(lt, 32);
    const float inv = 1.f / lt;
#pragma unroll
    for (int dt = 0; dt < 16; ++dt) {
      uint2 pk;
      pk.x = pack2(o[0][dt][0] * inv, o[0][dt][1] * inv);
      pk.y = pack2(o[0][dt][2] * inv, o[0][dt][3] * inv);
      *(uint2*)(p.mix + tok * LDA + head * 256 + 16 * dt + 4 * quad) = pk;
    }
  }
}

__constant__ unsigned char kCandI[64] = {0,0,0,0,0,0,0,0,0,0,0,0,0,0,0,0, 1,1,1,1,1,1,1,1, 2,2,2,2,2, 3,3,3,3, 4,4,4, 5,5, 6,6, 7,7,
                                          8, 9, 10, 11, 12, 13, 14, 15, 0,0,0,0,0,0,0,0,0,0,0,0,0,0};
__constant__ unsigned char kCandJ[64] = {0,1,2,3,4,5,6,7,8,9,10,11,12,13,14,15, 0,1,2,3,4,5,6,7, 0,1,2,3,4, 0,1,2,3, 0,1,2, 0,1, 0,1, 0,1,
                                          0, 0, 0, 0, 0, 0, 0, 0, 0,0,0,0,0,0,0,0,0,0,0,0,0,0};

DEVI unsigned score_key(float v, int idx) {
  unsigned u = __float_as_uint(v);
  u = (u & 0x80000000u) ? ~u : (u | 0x80000000u);
  return (u & ~127u) | (unsigned)(127 - idx);
}
DEVI float key_score(unsigned k) {
  k &= ~127u;
  const unsigned u = (k & 0x80000000u) ? (k & 0x7fffffffu) : ~k;
  return __uint_as_float(u);
}

DEVI void phase_peer_route(const Params& p, unsigned char* smem) {
  u16* sA = (u16*)smem; u16* sB = sA + 128 * 72;
  unsigned* sScore = (unsigned*)smem;
  unsigned* sTop = (unsigned*)(smem + 36864);
  unsigned* sTmp = (unsigned*)(smem + 53248);
  {
    const int t0_ = launder(threadIdx.x);
    const int gw = (blockIdx.x * 256 + t0_) >> 6, nw = (gridDim.x * 256) >> 6;
    conv_fp8_rows(p.peer_u, p.ub8, p.uscale, 16384, gw, nw, t0_ & 63);
    conv_fp8_rows(p.peer_v, p.vb8, p.vscale, 16384, gw, nw, t0_ & 63);
  }
#pragma unroll 1
  for (int tile = blockIdx.x; tile < 256 * 8; tile += gridDim.x) {
    GEMM_LANE_VARS
    const int mt = tile >> 3, hd = tile & 7;
    const int m0 = mt * 128;
#pragma unroll 1
    for (int ph = 0; ph < 2; ++ph) {
      const int hp = hd * 2 + ph;
      f32x4 acc[4][4];
      __syncthreads();
      gemm_mainloop<false>(tid, sA, sB, ARow{p.pq + hp * 128, LDPQ}, p.subk + (size_t)hp * 128 * 128, 128, m0, 0, 2, acc);
#pragma unroll 1
      for (int hh = 0; hh < 2; ++hh) {
        if (wm == hh) {
#pragma unroll
          for (int mi = 0; mi < 4; ++mi) {
            const int row = 16 * mi + col;
#pragma unroll
            for (int ni = 0; ni < 4; ++ni) {
              const int n = wn * 64 + 16 * ni + 4 * quad;
              const f32x4 v = acc[ni][mi];
              uint4 kk;
              kk.x = score_key(v[0], n); kk.y = score_key(v[1], n + 1);
              kk.z = score_key(v[2], n + 2); kk.w = score_key(v[3], n + 3);
              *(uint4*)(sScore + row * 128 + n) = kk;
            }
          }
        }
        __syncthreads();
#pragma unroll 1
        for (int rg = 0; rg < 4; ++rg) {
          const int rbase = w * 16 + rg * 4;
          unsigned k0[4], k1[4], thr[4];
#pragma unroll
          for (int r = 0; r < 4; ++r) {
            k0[r] = sScore[(rbase + r) * 128 + lane];
            k1[r] = sScore[(rbase + r) * 128 + 64 + lane];
            thr[r] = 0u;
          }
#pragma unroll
          for (int bit = 31; bit >= 0; --bit) {
#pragma unroll
            for (int r = 0; r < 4; ++r) {
              const unsigned cand = thr[r] | (1u << bit);
              const int cnt = __popcll(__ballot(k0[r] >= cand)) + __popcll(__ballot(k1[r] >= cand));
              thr[r] = (cnt >= 16) ? cand : thr[r];
            }
          }
          unsigned* tmp = sTmp + w * 64;
#pragma unroll
          for (int r = 0; r < 4; ++r) {
            const unsigned long long b0 = __ballot(k0[r] >= thr[r]), b1 = __ballot(k1[r] >= thr[r]);
            const int pos0 = __builtin_amdgcn_mbcnt_hi((unsigned)(b0 >> 32), __builtin_amdgcn_mbcnt_lo((unsigned)b0, 0u));
            const int pos1 = __popcll(b0) + __builtin_amdgcn_mbcnt_hi((unsigned)(b1 >> 32), __builtin_amdgcn_mbcnt_lo((unsigned)b1, 0u));
            if (k0[r] >= thr[r]) tmp[r * 16 + pos0] = k0[r];
            if (k1[r] >= thr[r]) tmp[r * 16 + pos1] = k1[r];
          }
          __builtin_amdgcn_fence(__ATOMIC_RELEASE, "wavefront");
          __builtin_amdgcn_wave_barrier();
          __builtin_amdgcn_fence(__ATOMIC_ACQUIRE, "wavefront");
          {
            const int r = lane >> 4, ix = lane & 15;
            const unsigned mine = tmp[r * 16 + ix];
            const uint4 a = *(const uint4*)(tmp + r * 16), b = *(const uint4*)(tmp + r * 16 + 4), c = *(const uint4*)(tmp + r * 16 + 8),
                        d = *(const uint4*)(tmp + r * 16 + 12);
            const int rk = (a.x > mine) + (a.y > mine) + (a.z > mine) + (a.w > mine) + (b.x > mine) + (b.y > mine) + (b.z > mine) + (b.w > mine) +
                           (c.x > mine) + (c.y > mine) + (c.z > mine) + (c.w > mine) + (d.x > mine) + (d.y > mine) + (d.z > mine) + (d.w > mine);
            sTop[((hh * 64 + rbase + r) * 2 + ph) * 16 + rk] = mine;
          }
          __builtin_amdgcn_fence(__ATOMIC_RELEASE, "wavefront");
          __builtin_amdgcn_wave_barrier();
        }
        __syncthreads();
      }
    }
    const int ci = kCandI[lane], cj = kCandJ[lane];
    const bool act = lane < 50;
#pragma unroll 1
    for (int tg = 0; tg < 8; ++tg) {
      const int tb = w * 32 + tg * 4;
      unsigned k0[4], k1[4], ku[4], thr[4];
      float v[4];
#pragma unroll
      for (int r = 0; r < 4; ++r) {
        k0[r] = sTop[((tb + r) * 2 + 0) * 16 + ci];
        k1[r] = sTop[((tb + r) * 2 + 1) * 16 + cj];
        v[r] = key_score(k0[r]) + key_score(k1[r]);
        unsigned u = __float_as_uint(v[r]);
        u = (u & 0x80000000u) ? ~u : (u | 0x80000000u);
        ku[r] = act ? ((u & ~63u) | (unsigned)(63 - lane)) : 0u;
        thr[r] = 0u;
      }
#pragma unroll
      for (int bit = 31; bit >= 0; --bit) {
#pragma unroll
        for (int r = 0; r < 4; ++r) {
          const unsigned cand = thr[r] | (1u << bit);
          const int cnt = __popcll(__ballot(ku[r] >= cand));
          thr[r] = (cnt >= 16) ? cand : thr[r];
        }
      }
#pragma unroll
      for (int r = 0; r < 4; ++r) {
        const bool sel = act && (ku[r] >= thr[r]);
        const unsigned long long ms = __ballot(sel);
        const int slot = __builtin_amdgcn_mbcnt_hi((unsigned)(ms >> 32), __builtin_amdgcn_mbcnt_lo((unsigned)ms, 0u));
        const float vmax = __int_as_float(__builtin_amdgcn_readlane(__float_as_int(v[r]), 0));
        const float e = sel ? __expf(v[r] - vmax) : 0.f;
        const float tot = wave_sum(e);
        if (sel) {
          const int eid = (127 - (int)(k0[r] & 127u)) * 128 + (127 - (int)(k1[r] & 127u));
          const size_t o = (size_t)(m0 + tb + r) * 128 + hd * 16 + slot;
          p.experts[o] = eid;
          p.gates[o] = e / tot;
        }
      }
    }
  }
}

DEVI void phase_peer_gather(const Params& p) {
  const int w0_ = threadIdx.x >> 6;
#pragma unroll 1
  for (int tok = blockIdx.x * 4 + w0_; tok < NTOK; tok += gridDim.x * 4) {
    const int tid = launder(threadIdx.x), lane = tid & 63;
    const float4* hp4 = (const float4*)(p.h + (size_t)tok * LDHF) + lane * 4;
    float hv[16], xn[16], y[16];
    {
      const float4 a0 = hp4[0], a1 = hp4[1], a2 = hp4[2], a3 = hp4[3];
      hv[0] = a0.x; hv[1] = a0.y; hv[2] = a0.z; hv[3] = a0.w; hv[4] = a1.x; hv[5] = a1.y; hv[6] = a1.z; hv[7] = a1.w;
      hv[8] = a2.x; hv[9] = a2.y; hv[10] = a2.z; hv[11] = a2.w; hv[12] = a3.x; hv[13] = a3.y; hv[14] = a3.z; hv[15] = a3.w;
    }
    float ss = 0.f;
#pragma unroll
    for (int i = 0; i < 16; ++i) ss += hv[i] * hv[i];
    ss = wave_sum(ss);
    const float rstd = rsqrtf(ss * (1.f / D) + 1e-6f);
    {
      const float4* g4 = (const float4*)p.peer_g + lane * 4;
      const float4 a0 = g4[0], a1 = g4[1], a2 = g4[2], a3 = g4[3];
      const float gg[16] = {a0.x, a0.y, a0.z, a0.w, a1.x, a1.y, a1.z, a1.w, a2.x, a2.y, a2.z, a2.w, a3.x, a3.y, a3.z, a3.w};
#pragma unroll
      for (int i = 0; i < 16; ++i) { xn[i] = hv[i] * rstd * gg[i]; y[i] = 0.f; }
    }
    const int e0 = p.experts[(size_t)tok * 128 + lane], e1 = p.experts[(size_t)tok * 128 + 64 + lane];
    const float g0 = p.gates[(size_t)tok * 128 + lane], g1 = p.gates[(size_t)tok * 128 + 64 + lane];
    const float su0 = p.uscale[e0], su1 = p.uscale[e1];
    const float sv0 = p.vscale[e0], sv1 = p.vscale[e1];
    float cf0 = 0.f, cf1 = 0.f, dsum = 0.f;
    uint4 ca[8], cb[8];
#define LOADB_(R, bi)                                                                                   \
    _Pragma("unroll") for (int u = 0; u < 8; ++u) {                                                       \
      const int kk_ = (((bi) & 7) << 3) + u;                                                             \
      const int e_ = __builtin_amdgcn_readlane((((bi) >> 3) & 1) ? e1 : e0, kk_);                        \
      R[u] = ((const uint4*)((((bi) >> 4) ? p.vb8 : p.ub8) + (size_t)e_ * 1024))[lane];                  \
    }
#define COMPU_(R, bi)                                                                                   \
    {                                                                                                    \
      float d8[8];                                                                                       \
      _Pragma("unroll") for (int u = 0; u < 8; ++u) {                                                     \
        const unsigned uu[4] = {R[u].x, R[u].y, R[u].z, R[u].w};                                         \
        f32x2 a2 = {0.f, 0.f};                                                                           \
        _Pragma("unroll") for (int j = 0; j < 4; ++j) {                                                   \
          const f32x2 lo = __builtin_amdgcn_cvt_pk_f32_fp8((int)uu[j], false);                           \
          const f32x2 hi = __builtin_amdgcn_cvt_pk_f32_fp8((int)uu[j], true);                            \
          a2 = xn2[2 * j] * lo + a2;                                                                     \
          a2 = xn2[2 * j + 1] * hi + a2;                                                                 \
        }                                                                                                \
        d8[u] = a2[0] + a2[1];                                                                           \
      }                                                                                                  \
          \
      float v4[4], v2[2];                                                                                \
      _Pragma("unroll") for (int i = 0; i < 4; ++i) {                                                     \
        const float snd = b5 ? d8[i] : d8[4 + i], kp = b5 ? d8[4 + i] : d8[i];                           \
        v4[i] = kp + __shfl_xor(snd, 32);                                                                \
      }                                                                                                  \
      _Pragma("unroll") for (int i = 0; i < 2; ++i) {                                                     \
        const float snd = b4 ? v4[i] : v4[2 + i], kp = b4 ? v4[2 + i] : v4[i];                           \
        v2[i] = kp + __shfl_xor(snd, 16);                                                                \
      }                                                                                                  \
      float v1;                                                                                          \
      { const float snd = b3 ? v2[0] : v2[1], kp = b3 ? v2[1] : v2[0]; v1 = kp + __shfl_xor(snd, 8); }   \
      v1 += __shfl_xor(v1, 4);                                                                           \
      v1 += __shfl_xor(v1, 2);                                                                           \
      v1 += __shfl_xor(v1, 1);                                                                           \
                \
      const float got = __shfl(v1, fsrc);                                                                \
      if ((lane >> 3) == ((bi) & 7)) dsum = got;                                                         \
    }                                                                                                    \
    if (((bi) & 7) == 7) {                                                                               \
      if (((bi) >> 3) & 1) cf1 = gelu_tanh(dsum * su1) * g1 * sv1; else cf0 = gelu_tanh(dsum * su0) * g0 * sv0; \
    }
#define COMPV_(R, bi)                                                                                   \
    _Pragma("unroll") for (int u = 0; u < 8; ++u) {                                                       \
      const int kk_ = (((bi) & 7) << 3) + u;                                                             \
      const float ck_ = __int_as_float(__builtin_amdgcn_readlane(__float_as_int((((bi) >> 3) & 1) ? cf1 : cf0), kk_)); \
      const f32x2 ck2 = {ck_, ck_};                                                                      \
      const unsigned uu[4] = {R[u].x, R[u].y, R[u].z, R[u].w};                                           \
      _Pragma("unroll") for (int j = 0; j < 4; ++j) {                                                     \
        const f32x2 lo = __builtin_amdgcn_cvt_pk_f32_fp8((int)uu[j], false);                             \
        const f32x2 hi = __builtin_amdgcn_cvt_pk_f32_fp8((int)uu[j], true);                              \
        y2[2 * j] = ck2 * lo + y2[2 * j];                                                                \
        y2[2 * j + 1] = ck2 * hi + y2[2 * j + 1];                                                        \
      }                                                                                                  \
    }
    const bool b5 = (lane & 32) != 0, b4 = (lane & 16) != 0, b3 = (lane & 8) != 0;
    const int fsrc = ((lane & 4) << 3) | ((lane & 2) << 3) | ((lane & 1) << 3);
    f32x2 xn2[8], y2[8];
#pragma unroll
    for (int i = 0; i < 8; ++i) { xn2[i] = f32x2{xn[2 * i], xn[2 * i + 1]}; y2[i] = f32x2{0.f, 0.f}; }
    LOADB_(ca, 0)
#pragma unroll 1
    for (int bi = 0; bi < 16; bi += 2) {
      LOADB_(cb, bi + 1)
      COMPU_(ca, bi)
      LOADB_(ca, bi + 2)
      COMPU_(cb, bi + 1)
    }
#pragma unroll 1
    for (int bi = 16; bi < 32; bi += 2) {
      LOADB_(cb, bi + 1)
      COMPV_(ca, bi)
      if (bi + 2 < 32) { LOADB_(ca, bi + 2) }
      COMPV_(cb, bi + 1)
    }
#undef LOADB_
#undef COMPU_
#undef COMPV_
#pragma unroll
    for (int i = 0; i < 8; ++i) { y[2 * i] = y2[i][0]; y[2 * i + 1] = y2[i][1]; }
    float s2 = 0.f;
    {
      const float4 a0 = hp4[0], a1 = hp4[1], a2 = hp4[2], a3 = hp4[3];
      const float hr[16] = {a0.x, a0.y, a0.z, a0.w, a1.x, a1.y, a1.z, a1.w, a2.x, a2.y, a2.z, a2.w, a3.x, a3.y, a3.z, a3.w};
#pragma unroll
      for (int i = 0; i < 16; ++i) { y[i] += hr[i]; s2 += y[i] * y[i]; }
    }
    s2 = wave_sum(s2);
    const float rs2 = rsqrtf(s2 * (1.f / D) + 1e-6f);
    {
      const float4* g4 = (const float4*)p.final_g + lane * 4;
      const float4 a0 = g4[0], a1 = g4[1], a2 = g4[2], a3 = g4[3];
      float4* o4 = (float4*)(p.out + (size_t)tok * D) + lane * 4;
      o4[0] = make_float4(y[0] * rs2 * a0.x, y[1] * rs2 * a0.y, y[2] * rs2 * a0.z, y[3] * rs2 * a0.w);
      o4[1] = make_float4(y[4] * rs2 * a1.x, y[5] * rs2 * a1.y, y[6] * rs2 * a1.z, y[7] * rs2 * a1.w);
      o4[2] = make_float4(y[8] * rs2 * a2.x, y[9] * rs2 * a2.y, y[10] * rs2 * a2.z, y[11] * rs2 * a2.w);
      o4[3] = make_float4(y[12] * rs2 * a3.x, y[13] * rs2 * a3.y, y[14] * rs2 * a3.z, y[15] * rs2 * a3.w);
    }
  }
}

#define XB_TMO      128
#define XB_XCNT(j)  (256  + 64 * (j))
#define XB_XSUB(j)  (1280 + 64 * (j))
#define XB_XGEN(j)  (2304 + 64 * (j))
#define XB_TOP      3328
#define XB_TOPGEN   3392
#define XCD_BAR_WORDS 3456
#define XB_SPIN_CAP (1u << 20)
#define LAS __attribute__((address_space(3)))
DEVI unsigned xb_ld(unsigned* q) { return __hip_atomic_load(q, __ATOMIC_RELAXED, __HIP_MEMORY_SCOPE_AGENT); }
DEVI unsigned xb_add(unsigned* q, unsigned v) { return __hip_atomic_fetch_add(q, v, __ATOMIC_RELAXED, __HIP_MEMORY_SCOPE_AGENT); }
DEVI unsigned xb_xcc_id() { return (unsigned)__builtin_amdgcn_s_getreg((3 << 11) | 20) & 0xFu; }
#define XB_SPIN(cond, bar) do { unsigned _sp = 0; while (cond) { __builtin_amdgcn_s_sleep(1); \
    if ((++_sp & 255u) == 0u) { if (xb_ld(&(bar)[XB_TMO])) break; if (_sp > XB_SPIN_CAP) { atomicAdd(&(bar)[XB_TMO], 1u); break; } } } } while (0)
struct XcdBarrier { unsigned* bar; unsigned x; volatile LAS unsigned* st; };
DEVI XcdBarrier xcd_barrier_post(unsigned* bar, volatile LAS unsigned* st) {
  XcdBarrier b; b.bar = bar; b.x = xb_xcc_id(); b.st = st;
  if (threadIdx.x == 0) (void)xb_add(&bar[XB_XCNT(b.x)], 1u);
  return b;
}
DEVI void xcd_barrier_complete(unsigned* bar, unsigned x, unsigned& nloc, unsigned& nx) {
  const unsigned G = gridDim.x * gridDim.y * gridDim.z;
  unsigned sum, cnt, mine, sp = 0u;
  for (;;) {
    sum = 0u; cnt = 0u; mine = 0u;
#pragma unroll
    for (unsigned j = 0; j < 16; ++j) { const unsigned c = xb_ld(&bar[XB_XCNT(j)]); sum += c; cnt += (c > 0u) ? 1u : 0u; mine = (j == x) ? c : mine; }
    if (sum == G) break;
    __builtin_amdgcn_s_sleep(1);
    if ((++sp & 255u) == 0u) { if (xb_ld(&bar[XB_TMO])) break; if (sp > XB_SPIN_CAP) { atomicAdd(&bar[XB_TMO], 1u); break; } }
  }
  nloc = mine > 0u ? mine : 1u; nx = cnt > 0u ? cnt : 1u;
}
DEVI void xcd_barrier(const XcdBarrier& b) {
  asm volatile("s_waitcnt vmcnt(0)" ::: "memory");
  __syncthreads();
  if (threadIdx.x == 0) {
    unsigned* bar = b.bar;
    __builtin_amdgcn_s_waitcnt(0);
    unsigned nloc = b.st[0], nx = b.st[1];
    if (nloc == 0u) { xcd_barrier_complete(bar, b.x, nloc, nx); b.st[0] = nloc; b.st[1] = nx; }
    const unsigned old = xb_add(&bar[XB_XSUB(b.x)], 1u);
    const unsigned gen = old / nloc;
    if (old + 1u == (gen + 1u) * nloc) {
      __builtin_amdgcn_fence(__ATOMIC_RELEASE, "agent");
      asm volatile("s_waitcnt vmcnt(0)" ::: "memory");
      const unsigned og = xb_add(&bar[XB_TOP], 1u);
      const unsigned tg = og / nx;
      if (og + 1u == (tg + 1u) * nx) xb_add(&bar[XB_TOPGEN], 1u);
      else XB_SPIN(xb_ld(&bar[XB_TOPGEN]) == tg, bar);
      __builtin_amdgcn_fence(__ATOMIC_ACQUIRE, "agent");
      xb_add(&bar[XB_XGEN(b.x)], 1u);
      asm volatile("s_waitcnt vmcnt(0)" ::: "memory");
    } else {
      XB_SPIN(xb_ld(&bar[XB_XGEN(b.x)]) == gen, bar);
      __builtin_amdgcn_fence(__ATOMIC_ACQUIRE, "agent");
      asm volatile("s_waitcnt vmcnt(0)" ::: "memory");
    }
  }
  __syncthreads();
}

template <bool COOP>
__global__ void __launch_bounds__(256, 2) mega(Params p, int ph_lo, int ph_hi) {
  __shared__ __attribute__((aligned(16))) unsigned char smem[SMEM_BYTES];
  __shared__ uint4 xb_words;
  if (threadIdx.x == 0) xb_words = make_uint4(0u, 0u, 0u, 0u);
  __syncthreads();
  XcdBarrier xb = xcd_barrier_post(p.bar, (volatile LAS unsigned*)&xb_words);
  (void)xb;
  if (COOP && ph_hi > 1000) cg::this_grid().sync();
#ifdef REPEAT_MASK
#define RUN_PHASE(i, call)                                                                   \
  if (ph_lo <= (i) && (i) <= ph_hi) {                                                        \
    call;                                                                                    \
    if (COOP && ((REPEAT_MASK >> (i)) & 1)) { cg::this_grid().sync(); call; }                \
    if (COOP && (i) < ph_hi) cg::this_grid().sync();                                         \
  }
#else
#define RUN_PHASE(i, call)                                                                   \
  if (ph_lo <= (i) && (i) <= ph_hi) {                                                        \
    call;                                                                                    \
    if (COOP && (i) < ph_hi) {                                                               \
      xcd_barrier(xb);                                                                       \
    }                                                                                        \
  }
#endif
  RUN_PHASE(0, phase0(p))
  RUN_PHASE(1, phase1(p, smem))
  RUN_PHASE(2, phase2(p, smem))
  RUN_PHASE(3, phase3(p, smem))
  RUN_PHASE(4, phase_nsa(p, smem))
  RUN_PHASE(5, phase_resid(p, smem, p.mix, p.woutT, p.x, D, p.ssq1))
  RUN_PHASE(6, phase_scaled(p, smem, p.hn, p.wmqT, 8, p.ssq1, p.qm, LDA))
  RUN_PHASE(7, phase_memattn(p, smem))
  RUN_PHASE(8, phase_resid(p, smem, p.mix, p.wmoT, p.h, LDHF, p.ssq2))
  RUN_PHASE(9, phase_scaled(p, smem, p.hn, p.wpqT, 16, p.ssq2, p.pq, LDPQ))
  RUN_PHASE(10, phase_peer_route(p, smem))
  RUN_PHASE(11, phase_peer_gather(p))
#undef RUN_PHASE
}

extern "C" void kernel_launch(void* const* d_in, const int* in_sizes, int n_in, void* d_out, int out_size, void* d_ws,
                              size_t ws_size, hipStream_t stream) {
  (void)in_sizes; (void)n_in; (void)out_size; (void)ws_size;
  Params p{};
  p.x = (const float*)d_in[0]; p.mem = (const float*)d_in[1]; p.pos = (const int*)d_in[2];
  p.mix_g = (const float*)d_in[3]; p.w_in = (const float*)d_in[4]; p.conv_w = (const float*)d_in[5];
  p.conv_b = (const float*)d_in[6]; p.ln_g = (const float*)d_in[7]; p.ln_b = (const float*)d_in[8];
  p.cmp_pos = (const float*)d_in[9]; p.cmp_w1 = (const float*)d_in[10]; p.cmp_b1 = (const float*)d_in[11];
  p.cmp_w2 = (const float*)d_in[12]; p.cmp_b2 = (const float*)d_in[13]; p.w_out = (const float*)d_in[14];
  p.memq_g = (const float*)d_in[15]; p.memkv_g = (const float*)d_in[16]; p.w_mq = (const float*)d_in[17];
  p.w_mk = (const float*)d_in[18]; p.w_mv = (const float*)d_in[19]; p.w_mo = (const float*)d_in[20];
  p.peer_g = (const float*)d_in[21]; p.peer_wq = (const float*)d_in[22]; p.peer_sk = (const float*)d_in[23];
  p.peer_u = (const float*)d_in[24]; p.peer_v = (const float*)d_in[25]; p.final_g = (const float*)d_in[26];
  p.out = (float*)d_out;
  unsigned char* ws = (unsigned char*)d_ws;
  size_t off = 0;
  auto take = [&](size_t bytes) { unsigned char* r = ws + off; off += (bytes + 255) & ~(size_t)255; return r; };
  unsigned char* regA = take((size_t)NTOK * LDA * 2);
  unsigned char* regB = take((size_t)NTOK * LDP * 2);
  unsigned char* regC = take((size_t)NTOK * LDA * 2);
  p.hn = (u16*)regA; p.ub8 = regA; p.vb8 = regA + (size_t)16384 * 1024;
  p.uscale = (float*)(regA + (size_t)2 * 16384 * 1024); p.vscale = p.uscale + 16384;
  p.proj = (u16*)regB; p.qm = (u16*)regB; p.pq = (u16*)regB;
  p.mix = (u16*)regC; p.experts = (int*)regC; p.gates = (float*)(regC + (size_t)NTOK * 128 * 4);
  p.h = (float*)take((size_t)NTOK * LDHF * 4);
  p.vts = (u16*)take((size_t)Bn * 2 * 64 * LDT * 2);
  p.vtw = (u16*)take((size_t)Bn * 2 * 64 * LDT * 2);
  p.memn = (u16*)take((size_t)Bn * 256 * LDA * 2);
  p.memk = (u16*)take((size_t)Bn * 256 * LDA * 2);
  p.memvt = (u16*)take((size_t)Bn * 256 * D * 2);
  p.winT = (u16*)take((size_t)2432 * LDA * 2);
  p.woutT = (u16*)take((size_t)1024 * LDA * 2);
  p.wmqT = (u16*)take((size_t)1024 * LDA * 2);
  p.wmkT = (u16*)take((size_t)1024 * LDA * 2);
  p.wmvT = (u16*)take((size_t)1024 * LDA * 2);
  p.wmoT = (u16*)take((size_t)1024 * LDA * 2);
  p.wpqT = (u16*)take((size_t)2048 * LDA * 2);
  p.subk = (u16*)take((size_t)16 * 128 * 128 * 2);
  p.w1T = (u16*)take((size_t)2 * 128 * LDW1 * 2);
  p.w2T = (u16*)take((size_t)2 * 128 * 128 * 2);
  p.biasp = (float*)take(256 * 4);
  p.rope = (float*)take((size_t)NTOK * 16 * 4);
  p.hdn = (u16*)take((size_t)2 * 4096 * 128 * 2);
  p.kc = (u16*)take((size_t)Bn * 2 * 128 * 64 * 2);
  p.vcT = (u16*)take((size_t)Bn * 2 * 64 * 128 * 2);
  p.ssq1 = (float*)take((size_t)NTOK * 4);
  p.ssq2 = (float*)take((size_t)NTOK * 4);
  p.bar = (unsigned*)take(16384);
  if (off > ws_size) { fprintf(stderr, "workspace too small: need %zu have %zu\n", off, ws_size); return; }

#if COOP_MODE
  static int grid_blocks = 0;
  if (!grid_blocks) {
    int dev = 0, cus = 0, per_cu = 0;
    hipGetDevice(&dev);
    hipDeviceGetAttribute(&cus, hipDeviceAttributeMultiprocessorCount, dev);
    hipOccupancyMaxActiveBlocksPerMultiprocessor(&per_cu, mega<true>, 256, 0);
    if (per_cu > 2) per_cu = 2;
    if (per_cu < 1) per_cu = 1;
    grid_blocks = cus * per_cu;
  }
  int lo = 0, hi = NPHASE;
  void* args[] = {&p, &lo, &hi};
  (void)hipMemsetAsync(p.bar, 0, 16384, stream);
  hipError_t e = hipLaunchCooperativeKernel((void*)mega<true>, dim3(grid_blocks), dim3(256), args, 0, stream);
  if (e != hipSuccess) fprintf(stderr, "cooperative launch failed: %s (grid %d)\n", hipGetErrorString(e), grid_blocks);
#else
  for (int ph = 0; ph <= NPHASE; ++ph) mega<false><<<dim3(512), dim3(256), 0, stream>>>(p, ph, ph);
#endif
}
```

```cpp
#include <hip/hip_runtime.h>
#include <hip/hip_bf16.h>
#include <hip/hip_cooperative_groups.h>
#include <cstdio>
#include <cstdint>
namespace cg = cooperative_groups;

#ifndef COOP_MODE
#define COOP_MODE 1
#endif

typedef __attribute__((ext_vector_type(8))) short bf16x8;
typedef __attribute__((ext_vector_type(4))) short bf16x4;
typedef __attribute__((ext_vector_type(4))) float f32x4;
typedef unsigned short u16;

#define DEVI __device__ __forceinline__

constexpr int Bn = 16, T = 2048, D = 1024, NTOK = Bn * T, LDP = 2336;
constexpr int C_Q = 1024, C_KC = 1536, C_VC = 1664, C_KS = 1792, C_VS = 1920, C_KW = 2048, C_VW = 2176, C_GATE = 2304;
constexpr int SMEM_BYTES = 73728;
constexpr int LDA = 1088;
constexpr int LDHF = 1056;
constexpr int LDPQ = 2112;
constexpr int LDW1 = 2112;
constexpr int LDT = 2112;
constexpr int NPHASE = 11;

struct Params {
  const float* x; const float* mem; const int* pos; const float* mix_g; const float* w_in;
  const float* conv_w; const float* conv_b; const float* ln_g; const float* ln_b;
  const float* cmp_pos; const float* cmp_w1; const float* cmp_b1; const float* cmp_w2; const float* cmp_b2;
  const float* w_out; const float* memq_g; const float* memkv_g; const float* w_mq; const float* w_mk;
  const float* w_mv; const float* w_mo; const float* peer_g; const float* peer_wq; const float* peer_sk;
  const float* peer_u; const float* peer_v; const float* final_g;
  float* out;
  u16* hn; u16* proj; u16* mix; float* h; u16* vts; u16* vtw; u16* memn; u16* memk; u16* memvt;
  u16* winT; u16* woutT; u16* wmqT; u16* wmkT; u16* wmvT; u16* wmoT; u16* wpqT; u16* subk; u16* w1T; u16* w2T;
  float* biasp; float* rope; u16* hdn; u16* kc; u16* vcT; float* ssq1; float* ssq2;
  int* experts; float* gates; unsigned char* ub8; unsigned char* vb8; float* uscale; float* vscale; u16* qm; u16* pq;
  unsigned* bar;
};

DEVI int launder(int x) { asm volatile("" : "+v"(x)); return x; }
DEVI u16 f2bf(float f) {
  unsigned u = __float_as_uint(f);
  u += 0x7fffu + ((u >> 16) & 1u);
  return (u16)(u >> 16);
}
DEVI float bf2f(u16 h) { return __uint_as_float(((unsigned)h) << 16); }
DEVI unsigned pack2(float a, float b) { return (unsigned)f2bf(a) | ((unsigned)f2bf(b) << 16); }
DEVI float wave_sum(float v) {
#pragma unroll
  for (int o = 32; o; o >>= 1) v += __shfl_xor(v, o);
  return v;
}
DEVI float sigmoidf_(float x) { return 1.f / (1.f + __expf(-x)); }
DEVI float gelu_tanh(float x) {
  float u = 0.7978845608028654f * (x + 0.044715f * x * x * x);
  return 0.5f * x * (1.f + tanhf(u));
}
DEVI f32x4 mfma16(bf16x8 a, bf16x8 b, f32x4 c) { return __builtin_amdgcn_mfma_f32_16x16x32_bf16(a, b, c, 0, 0, 0); }
DEVI float fexp2(float x) { return __builtin_amdgcn_exp2f(x); }

DEVI void tconv(const float* __restrict__ src, int K, int N, u16* __restrict__ dst, int Npad, int ldd,
                const float* __restrict__ gain, int gtid, int gsz) {
  const int items = Npad * (K >> 3);
  for (int it = gtid; it < items; it += gsz) {
    const int n = it % Npad, kc = it / Npad;
    float f[8];
#pragma unroll
    for (int j = 0; j < 8; ++j) {
      float v = 0.f;
      if (n < N) {
        v = src[(size_t)(kc * 8 + j) * N + n];
        if (gain) v *= gain[kc * 8 + j];
      }
      f[j] = v;
    }
    uint4 pk;
    pk.x = pack2(f[0], f[1]); pk.y = pack2(f[2], f[3]); pk.z = pack2(f[4], f[5]); pk.w = pack2(f[6], f[7]);
    *(uint4*)(dst + (size_t)n * ldd + kc * 8) = pk;
  }
}

DEVI void conv_flat(const float* __restrict__ src, u16* __restrict__ dst, size_t n8, size_t gtid, size_t gsz) {
  for (size_t it = gtid; it < n8; it += gsz) {
    const float4 a = ((const float4*)src)[2 * it], b = ((const float4*)src)[2 * it + 1];
    uint4 pk;
    pk.x = pack2(a.x, a.y); pk.y = pack2(a.z, a.w); pk.z = pack2(b.x, b.y); pk.w = pack2(b.z, b.w);
    ((uint4*)dst)[it] = pk;
  }
}


typedef float f32x2 __attribute__((ext_vector_type(2)));
DEVI unsigned pk4_fp8(float a, float b, float c, float d) {
  int v = 0;
  v = __builtin_amdgcn_cvt_pk_fp8_f32(a, b, v, false);
  v = __builtin_amdgcn_cvt_pk_fp8_f32(c, d, v, true);
  return (unsigned)v;
}
DEVI void conv_fp8_rows(const float* __restrict__ src, unsigned char* __restrict__ dst, float* __restrict__ inv_scale,
                        int rows, int gw, int nw, int lane) {
  for (int r0 = gw; r0 < rows; r0 += 2 * nw) {
    const int r1 = r0 + nw;
    const bool has1 = r1 < rows;
    const float4* p0 = (const float4*)(src + (size_t)r0 * 1024) + lane * 4;
    const float4* p1 = (const float4*)(src + (size_t)(has1 ? r1 : r0) * 1024) + lane * 4;
    float4 v[2][4];
#pragma unroll
    for (int i = 0; i < 4; ++i) { v[0][i] = p0[i]; v[1][i] = p1[i]; }
    float mx[2];
#pragma unroll
    for (int q = 0; q < 2; ++q) {
      float m = 0.f;
#pragma unroll
      for (int i = 0; i < 4; ++i)
        m = fmaxf(m, fmaxf(fmaxf(fabsf(v[q][i].x), fabsf(v[q][i].y)), fmaxf(fabsf(v[q][i].z), fabsf(v[q][i].w))));
      mx[q] = m;
    }
#pragma unroll
    for (int o = 32; o; o >>= 1) { mx[0] = fmaxf(mx[0], __shfl_xor(mx[0], o)); mx[1] = fmaxf(mx[1], __shfl_xor(mx[1], o)); }
#pragma unroll
    for (int q = 0; q < 2; ++q) {
      if (q == 1 && !has1) break;
      const int r = q ? r1 : r0;
      const float sc = mx[q] > 0.f ? 224.f / mx[q] : 1.f;
      if (lane == 0) inv_scale[r] = mx[q] > 0.f ? mx[q] * (1.f / 224.f) : 1.f;
      uint4 o4;
      o4.x = pk4_fp8(v[q][0].x * sc, v[q][0].y * sc, v[q][0].z * sc, v[q][0].w * sc);
      o4.y = pk4_fp8(v[q][1].x * sc, v[q][1].y * sc, v[q][1].z * sc, v[q][1].w * sc);
      o4.z = pk4_fp8(v[q][2].x * sc, v[q][2].y * sc, v[q][2].z * sc, v[q][2].w * sc);
      o4.w = pk4_fp8(v[q][3].x * sc, v[q][3].y * sc, v[q][3].z * sc, v[q][3].w * sc);
      ((uint4*)(dst + (size_t)r * 1024))[lane] = o4;
    }
  }
}

DEVI void rownorm_bf16(const float* __restrict__ src, const float* __restrict__ g, u16* __restrict__ dst,
                       int rows, int gw, int nw, int lane) {
  for (int r = gw; r < rows; r += nw) {
    const float4* pr = (const float4*)(src + (size_t)r * D);
    float4 v[4];
    float ss = 0.f;
#pragma unroll
    for (int i = 0; i < 4; ++i) {
      v[i] = pr[lane + 64 * i];
      ss += v[i].x * v[i].x + v[i].y * v[i].y + v[i].z * v[i].z + v[i].w * v[i].w;
    }
    ss = wave_sum(ss);
    const float rstd = rsqrtf(ss * (1.f / D) + 1e-6f);
#pragma unroll
    for (int i = 0; i < 4; ++i) {
      const float4 gg = ((const float4*)g)[lane + 64 * i];
      uint2 pk;
      pk.x = pack2(v[i].x * rstd * gg.x, v[i].y * rstd * gg.y);
      pk.y = pack2(v[i].z * rstd * gg.z, v[i].w * rstd * gg.w);
      *(uint2*)(dst + (size_t)r * LDA + (size_t)(lane + 64 * i) * 4) = pk;
    }
  }
}

DEVI void phase0(const Params& p) {
  const int tid = launder(threadIdx.x), lane = tid & 63;
  const int gtid = blockIdx.x * 256 + tid, gsz = gridDim.x * 256;
  const int gw = gtid >> 6, nw = gsz >> 6;
  rownorm_bf16(p.x, p.mix_g, p.hn, NTOK, gw, nw, lane);
  rownorm_bf16(p.mem, p.memkv_g, p.memn, Bn * 256, gw, nw, lane);
  tconv(p.w_in, 1024, 2328, p.winT, 2432, LDA, nullptr, gtid, gsz);
  tconv(p.w_out, 1024, 1024, p.woutT, 1024, LDA, nullptr, gtid, gsz);
  tconv(p.w_mq, 1024, 1024, p.wmqT, 1024, LDA, p.memq_g, gtid, gsz);
  tconv(p.w_mk, 1024, 1024, p.wmkT, 1024, LDA, nullptr, gtid, gsz);
  tconv(p.w_mv, 1024, 1024, p.wmvT, 1024, LDA, nullptr, gtid, gsz);
  tconv(p.w_mo, 1024, 1024, p.wmoT, 1024, LDA, nullptr, gtid, gsz);
  tconv(p.peer_wq, 1024, 2048, p.wpqT, 2048, LDA, p.peer_g, gtid, gsz);
  tconv(p.cmp_w1, 2048, 128, p.w1T, 128, LDW1, nullptr, gtid, gsz);
  tconv(p.cmp_w1 + 2048 * 128, 2048, 128, p.w1T + 128 * LDW1, 128, LDW1, nullptr, gtid, gsz);
  tconv(p.cmp_w2, 128, 64, p.w2T, 128, 128, nullptr, gtid, gsz);
  tconv(p.cmp_w2 + 128 * 64, 128, 64, p.w2T + 128 * 128, 128, 128, nullptr, gtid, gsz);
  conv_flat(p.peer_sk, p.subk, (size_t)16 * 128 * 128 / 8, gtid, gsz);
  for (int it = gtid; it < NTOK * 8; it += gsz) {
    const int tok = it >> 3, i = it & 7;
    const float inv = (i == 0) ? 1.000000000e+00f : (i == 1) ? 1.939227432e-01f : (i == 2) ? 3.760603070e-02f : (i == 3) ? 7.292664610e-03f : (i == 4) ? 1.414213562e-03f : (i == 5) ? 2.742481884e-04f : (i == 6) ? 5.318295734e-05f : 1.031338525e-05f;
    const float ang = (float)p.pos[tok] * inv;
    float sv, cv;
    sincosf(ang, &sv, &cv);
    p.rope[tok * 16 + i] = cv;
    p.rope[tok * 16 + 8 + i] = sv;
  }
  for (int o = gw; o < 256; o += nw) {
    const int ty = o >> 7, n = o & 127;
    float s = 0.f;
    for (int k = lane; k < 2048; k += 64)
      s += p.cmp_pos[ty * 2048 + k] * p.cmp_w1[((size_t)ty * 2048 + k) * 128 + n];
    s = wave_sum(s);
    if (lane == 0) p.biasp[o] = s + p.cmp_b1[o];
  }
  for (int it = gtid; it < NTOK; it += gsz) { p.ssq1[it] = 0.f; p.ssq2[it] = 0.f; }
}

template <bool DB, class AF>
DEVI void gemm_mainloop(int tid, u16* sA, u16* sB, AF af, const u16* __restrict__ Bt, int ldb, int m0, int n0, int nk,
                        f32x4 (&acc)[4][4]) {
  const int lane = tid & 63, w = tid >> 6;
  const int wm = w >> 1, wn = w & 1, col = lane & 15, quad = lane >> 4;
#pragma unroll
  for (int i = 0; i < 4; ++i)
#pragma unroll
    for (int j = 0; j < 4; ++j) acc[i][j] = f32x4{0.f, 0.f, 0.f, 0.f};
  uint4 ra0, ra1, ra2, ra3, rb0, rb1, rb2, rb3;
  const int lrow = tid >> 3, lkc = (tid & 7) << 3;
  const u16* bbase = Bt + (size_t)(n0 + lrow) * ldb + lkc;
#define GL_(R, i, kk)                                                     \
  R##a##i = *(const uint4*)af(m0 + lrow + 32 * i, (kk) + lkc);            \
  R##b##i = *(const uint4*)(bbase + (size_t)(32 * i) * ldb + (kk));
#define SS_(R, i, off)                                                    \
  *(uint4*)(sA + (off) + (lrow + 32 * i) * 72 + lkc) = R##a##i;           \
  *(uint4*)(sB + (off) + (lrow + 32 * i) * 72 + lkc) = R##b##i;
#define GL4_(R, kk) GL_(R, 0, kk) GL_(R, 1, kk) GL_(R, 2, kk) GL_(R, 3, kk)
#define SS4_(R, off) SS_(R, 0, off) SS_(R, 1, off) SS_(R, 2, off) SS_(R, 3, off)
#define COMPUTE_(cur)                                                                                                   \
  _Pragma("unroll") for (int ks = 0; ks < 2; ++ks) {                                                                    \
    bf16x8 fa[4], fb[4];                                                                                                \
    _Pragma("unroll") for (int mi = 0; mi < 4; ++mi)                                                                    \
      fa[mi] = *(const bf16x8*)(sA + (cur) + (wm * 64 + 16 * mi + col) * 72 + 32 * ks + 8 * quad);                      \
    _Pragma("unroll") for (int ni = 0; ni < 4; ++ni)                                                                    \
      fb[ni] = *(const bf16x8*)(sB + (cur) + (wn * 64 + 16 * ni + col) * 72 + 32 * ks + 8 * quad);                      \
    _Pragma("unroll") for (int ni = 0; ni < 4; ++ni)                                                                    \
      _Pragma("unroll") for (int mi = 0; mi < 4; ++mi) acc[ni][mi] = mfma16(fb[ni], fa[mi], acc[ni][mi]);               \
  }
  if (DB) {
    const int srow = 8 * w + (lane >> 3);
    const int spc = lane & 7;
#define STAGE_(st, kk)                                                                                         \
    _Pragma("unroll") for (int i = 0; i < 4; ++i) {                                                            \
      const int r_ = 32 * i + srow;                                                                            \
      const int c_ = (spc ^ ((r_ >> 1) & 7)) << 3;                                                             \
      __builtin_amdgcn_global_load_lds((const unsigned*)af(m0 + r_, (kk) + c_),                                \
                                       (unsigned*)(sA + (st) * 16384 + (32 * i + 8 * w) * 64), 16, 0, 0);      \
      __builtin_amdgcn_global_load_lds((const unsigned*)(Bt + (size_t)(n0 + r_) * ldb + (kk) + c_),            \
                                       (unsigned*)(sA + (st) * 16384 + 8192 + (32 * i + 8 * w) * 64), 16, 0, 0); \
    }
#define COMPUTE_SW_(st)                                                                                                 \
  _Pragma("unroll") for (int ks = 0; ks < 2; ++ks) {                                                                    \
    bf16x8 fa[4], fb[4];                                                                                                \
    const int pc_ = ((4 * ks + quad) ^ ((col >> 1) & 7)) << 3;                                                          \
    _Pragma("unroll") for (int mi = 0; mi < 4; ++mi)                                                                    \
      fa[mi] = *(const bf16x8*)(sA + (st) * 16384 + (wm * 64 + 16 * mi + col) * 64 + pc_);                              \
    _Pragma("unroll") for (int ni = 0; ni < 4; ++ni)                                                                    \
      fb[ni] = *(const bf16x8*)(sA + (st) * 16384 + 8192 + (wn * 64 + 16 * ni + col) * 64 + pc_);                       \
    _Pragma("unroll") for (int ni = 0; ni < 4; ++ni)                                                                    \
      _Pragma("unroll") for (int mi = 0; mi < 4; ++mi) acc[ni][mi] = mfma16(fb[ni], fa[mi], acc[ni][mi]);               \
  }
    STAGE_(0, 0)
#pragma unroll 1
    for (int kt = 0; kt < nk; kt += 2) {
      asm volatile("s_waitcnt vmcnt(0)" ::: "memory");
      __syncthreads();
      { const int kk = (kt + 1) * 64; STAGE_(1, kk) }
      COMPUTE_SW_(0)
      asm volatile("s_waitcnt vmcnt(0)" ::: "memory");
      __syncthreads();
      if (kt + 2 < nk) { const int kk = (kt + 2) * 64; STAGE_(0, kk) }
      COMPUTE_SW_(1)
    }
#undef STAGE_
#undef COMPUTE_SW_
  } else {
    GL4_(r, 0)
    SS4_(r, 0)
    __syncthreads();
#pragma unroll 1
    for (int kt = 0; kt < nk; ++kt) {
      const bool more = (kt + 1 < nk);
      if (more) { const int kk = (kt + 1) * 64; GL4_(r, kk) }
      COMPUTE_(0)
      __syncthreads();
      if (more) {
        SS4_(r, 0)
        __syncthreads();
      }
    }
  }
#undef GL_
#undef SS_
#undef GL4_
#undef SS4_
#undef COMPUTE_
}

struct ARow {
  const u16* base; int lda;
  DEVI const u16* operator()(int m, int k) const { return base + (size_t)m * lda + k; }
};
struct ACmp {
  const u16* proj; int colbase;
  DEVI const u16* operator()(int rr, int k) const {
    const int b = rr >> 8, g = (rr >> 7) & 1;
    int c = rr & 127; c = c > 126 ? 126 : c;
    const int l = k >> 6, d = k & 63;
    return proj + ((size_t)b * T + 16 * c + l) * LDP + colbase + g * 64 + d;
  }
};


#define XCD_TILE_LOOP(idx, MT, NT)                                                                     \
  const bool sw_ = (gridDim.x & 7) == 0;                                                               \
  const int xcd_ = blockIdx.x & 7;                                                                     \
  const int tstart_ = sw_ ? (int)(blockIdx.x >> 3) : (int)blockIdx.x;                                  \
  const int tstep_ = sw_ ? (int)(gridDim.x >> 3) : (int)gridDim.x;                                     \
  const int ttotal_ = sw_ ? ((MT) / 8) * (NT) : (MT) * (NT);                                           \
  _Pragma("unroll 1") for (int idx = tstart_; idx < ttotal_; idx += tstep_)
#define XCD_TILE_MT(idx, NT) (sw_ ? ((idx) / (NT)) * 8 + xcd_ : (idx) / (NT))
#define XCD_TILE_NT(idx, NT) ((idx) % (NT))

#define GEMM_LANE_VARS                                                    \
  const int tid = launder(threadIdx.x), lane = tid & 63, w = tid >> 6;    \
  const int wm = w >> 1, wn = w & 1, col = lane & 15, quad = lane >> 4;   \
  (void)wm; (void)wn; (void)col; (void)quad;

DEVI void phase1(const Params& p, unsigned char* smem) {
  u16* sA = (u16*)smem; u16* sB = sA + 128 * 72;
  XCD_TILE_LOOP(idx, 256 + 32, 19) {
    GEMM_LANE_VARS
    f32x4 acc[4][4];
    const int mt = XCD_TILE_MT(idx, 19), nt_ = XCD_TILE_NT(idx, 19);
    if (mt < 256) {
      const int m0 = mt * 128, n0 = nt_ * 128;
      gemm_mainloop<true>(tid, sA, sB, ARow{p.hn, LDA}, p.winT, LDA, m0, n0, 16, acc);
#pragma unroll
      for (int mi = 0; mi < 4; ++mi) {
        const int m = m0 + wm * 64 + 16 * mi + col;
        const int b = m >> 11, t = m & 2047;
#pragma unroll
        for (int ni = 0; ni < 4; ++ni) {
          const int nt = n0 + wn * 64 + 16 * ni;
          const int n = nt + 4 * quad;
          f32x4 v = acc[ni][mi];
          if (nt >= LDP) continue;
          if ((nt >= C_VS && nt < C_KW) || (nt >= C_VW && nt < C_GATE)) {
            const bool isw = nt >= C_VW;
            const int off = n - (isw ? C_VW : C_VS);
            const int g = off >> 6, d = off & 63;
            u16* dst = (isw ? p.vtw : p.vts) + ((size_t)(b * 2 + g) * 64 + d) * LDT + t;
#pragma unroll
            for (int r = 0; r < 4; ++r) dst[(size_t)r * LDT] = f2bf(v[r]);
          } else {
            const bool rope_tile = ((nt >= C_KS && nt < C_VS) || (nt >= C_KW && nt < C_VW)) && ((nt & 63) == 0);
            if (rope_tile) {
#pragma unroll
              for (int r = 0; r < 4; ++r) {
                const float pr = __shfl_xor(v[r], 32);
                const int i = ((quad & 1) << 2) + r;
                const float cs = p.rope[(size_t)m * 16 + i], sn = p.rope[(size_t)m * 16 + 8 + i];
                v[r] = (quad < 2) ? (v[r] * cs - pr * sn) : (v[r] * cs + pr * sn);
              }
            }
            uint2 pk; pk.x = pack2(v[0], v[1]); pk.y = pack2(v[2], v[3]);
            *(uint2*)(p.proj + (size_t)m * LDP + n) = pk;
          }
        }
      }
    } else if (nt_ < 16) {
      const int isv = nt_ >> 3;
      const int m0 = (mt - 256) * 128, n0 = (nt_ & 7) * 128;
      gemm_mainloop<true>(tid, sA, sB, ARow{p.memn, LDA}, isv ? p.wmvT : p.wmkT, LDA, m0, n0, 16, acc);
#pragma unroll
      for (int mi = 0; mi < 4; ++mi) {
        const int m = m0 + wm * 64 + 16 * mi + col;
        const int b = m >> 8, key = m & 255;
#pragma unroll
        for (int ni = 0; ni < 4; ++ni) {
          const int n = n0 + wn * 64 + 16 * ni + 4 * quad;
          const f32x4 v = acc[ni][mi];
          if (isv) {
            const int head = n >> 8, d = n & 255;
            u16* dst = p.memvt + ((size_t)(b * 4 + head) * 256 + d) * 256 + key;
#pragma unroll
            for (int r = 0; r < 4; ++r) dst[r * 256] = f2bf(v[r]);
          } else {
            uint2 pk; pk.x = pack2(v[0], v[1]); pk.y = pack2(v[2], v[3]);
            *(uint2*)(p.memk + (size_t)m * LDA + n) = pk;
          }
        }
      }
    }
  }
}

DEVI void conv_tile(const Params& p, unsigned char* smem, int ct) {
  u16* sU = (u16*)smem;
  float2* sRed = (float2*)(smem + 62 * 512 * 2);
  const int tid = launder(threadIdx.x), lane = tid & 63, w = tid >> 6;
  const int b = ct >> 6, t0 = (ct & 63) * 32;
  __syncthreads();
  for (int it = tid; it < 62 * 64; it += 256) {
    const int r = it >> 6, c8 = it & 63;
    const int t = t0 - 30 + r;
    uint4 pk = {0u, 0u, 0u, 0u};
    if (t >= 0) {
      const u16* src = p.proj + ((size_t)b * T + t) * LDP + c8 * 8;
      const uint4 a = *(const uint4*)src, bb = *(const uint4*)(src + 512);
      const unsigned au[4] = {a.x, a.y, a.z, a.w}, bu[4] = {bb.x, bb.y, bb.z, bb.w};
      unsigned o[4];
#pragma unroll
      for (int j = 0; j < 4; ++j) {
        const float a0 = __uint_as_float(au[j] << 16), a1 = __uint_as_float(au[j] & 0xffff0000u);
        const float b0 = __uint_as_float(bu[j] << 16), b1 = __uint_as_float(bu[j] & 0xffff0000u);
        o[j] = pack2(a0 * sigmoidf_(b0), a1 * sigmoidf_(b1));
      }
      pk.x = o[0]; pk.y = o[1]; pk.z = o[2]; pk.w = o[3];
    }
    *(uint4*)(sU + r * 512 + c8 * 8) = pk;
  }
  const int c = 2 * tid;
  float w0[31], w1[31];
#pragma unroll
  for (int j = 0; j < 31; ++j) { w0[j] = p.conv_w[j * 512 + c]; w1[j] = p.conv_w[j * 512 + c + 1]; }
  const float bd0 = p.conv_b[c], bd1 = p.conv_b[c + 1];
  __syncthreads();
  for (int tt = 0; tt < 32; ++tt) {
    float y0 = bd0, y1 = bd1;
#pragma unroll
    for (int j = 0; j < 31; ++j) {
      const unsigned uu = *(const unsigned*)(sU + (tt + j) * 512 + c);
      y0 += w0[j] * __uint_as_float(uu << 16);
      y1 += w1[j] * __uint_as_float(uu & 0xffff0000u);
    }
    float s = y0 + y1, q = y0 * y0 + y1 * y1;
    s = wave_sum(s); q = wave_sum(q);
    if (lane == 0) sRed[tt * 4 + w] = make_float2(s, q);
  }
  __syncthreads();
  const float g0 = p.ln_g[c], g1 = p.ln_g[c + 1], lb0 = p.ln_b[c], lb1 = p.ln_b[c + 1];
  for (int tt = 0; tt < 32; ++tt) {
    float y0 = bd0, y1 = bd1;
#pragma unroll
    for (int j = 0; j < 31; ++j) {
      const unsigned uu = *(const unsigned*)(sU + (tt + j) * 512 + c);
      y0 += w0[j] * __uint_as_float(uu << 16);
      y1 += w1[j] * __uint_as_float(uu & 0xffff0000u);
    }
    const float2 r0 = sRed[tt * 4 + 0], r1 = sRed[tt * 4 + 1], r2 = sRed[tt * 4 + 2], r3 = sRed[tt * 4 + 3];
    const float S = r0.x + r1.x + r2.x + r3.x, Q = r0.y + r1.y + r2.y + r3.y;
    const float mu = S * (1.f / 512.f);
    const float var = fmaxf(Q * (1.f / 512.f) - mu * mu, 0.f);
    const float rstd = rsqrtf(var + 1e-6f);
    const float z0 = (y0 - mu) * rstd * g0 + lb0, z1 = (y1 - mu) * rstd * g1 + lb1;
    const float o0 = z0 * sigmoidf_(z0), o1 = z1 * sigmoidf_(z1);
    *(unsigned*)(p.mix + ((size_t)b * T + t0 + tt) * LDA + c) = pack2(o0, o1);
  }
}

DEVI void phase2(const Params& p, unsigned char* smem) {
  u16* sA = (u16*)smem; u16* sB = sA + 128 * 72;
#pragma unroll 1
  for (int tile = blockIdx.x; tile < 64 + 1024; tile += gridDim.x) {
    GEMM_LANE_VARS
    if (tile < 64) {
      const int ty = tile >> 5, mt = tile & 31;
      const int m0 = mt * 128;
      f32x4 acc[4][4];
      gemm_mainloop<true>(tid, sA, sB, ACmp{p.proj, ty ? C_VC : C_KC}, p.w1T + (size_t)ty * 128 * LDW1, LDW1, m0, 0, 32, acc);
#pragma unroll
      for (int mi = 0; mi < 4; ++mi) {
        const int m = m0 + wm * 64 + 16 * mi + col;
#pragma unroll
        for (int ni = 0; ni < 4; ++ni) {
          const int n = wn * 64 + 16 * ni + 4 * quad;
          const f32x4 v = acc[ni][mi];
          const float4 bb = *(const float4*)(p.biasp + ty * 128 + n);
          uint2 pk;
          pk.x = pack2(gelu_tanh(v[0] + bb.x), gelu_tanh(v[1] + bb.y));
          pk.y = pack2(gelu_tanh(v[2] + bb.z), gelu_tanh(v[3] + bb.w));
          *(uint2*)(p.hdn + ((size_t)ty * 4096 + m) * 128 + n) = pk;
        }
      }
    } else {
      conv_tile(p, smem, tile - 64);
    }
  }
}

DEVI void phase3(const Params& p, unsigned char* smem) {
  u16* sA = (u16*)smem; u16* sB = sA + 128 * 72;
#pragma unroll 1
  for (int tile = blockIdx.x; tile < 64; tile += gridDim.x) {
    GEMM_LANE_VARS
    const int ty = tile >> 5, mt = tile & 31;
    const int m0 = mt * 128;
    f32x4 acc[4][4];
    gemm_mainloop<true>(tid, sA, sB, ARow{p.hdn + (size_t)ty * 4096 * 128, 128}, p.w2T + (size_t)ty * 128 * 128, 128, m0, 0, 2, acc);
    if (wn == 0) {
#pragma unroll
      for (int mi = 0; mi < 4; ++mi) {
        const int m = m0 + 16 * mi + wm * 64 + col;
        const int bg = m >> 7, c = m & 127;
#pragma unroll
        for (int ni = 0; ni < 4; ++ni) {
          const int n = 16 * ni + 4 * quad;
          const f32x4 v = acc[ni][mi];
          const float4 bb = *(const float4*)(p.cmp_b2 + ty * 64 + n);
          const float o0 = v[0] + bb.x, o1 = v[1] + bb.y, o2 = v[2] + bb.z, o3 = v[3] + bb.w;
          if (ty == 0) {
            uint2 pk; pk.x = pack2(o0, o1); pk.y = pack2(o2, o3);
            *(uint2*)(p.kc + (size_t)m * 64 + n) = pk;
          } else {
            u16* dst = p.vcT + ((size_t)bg * 64 + n) * 128 + c;
            dst[0] = f2bf(o0); dst[128] = f2bf(o1); dst[256] = f2bf(o2); dst[384] = f2bf(o3);
          }
        }
      }
    }
  }
}

template <int DH, int NQ, int LDK, int LDV, class MaskF>
DEVI void attn_tile(const u16* sK, const u16* sVt, const bf16x8 (&qf)[NQ][DH / 32], f32x4 (&o)[NQ][DH / 16],
                    float (&m)[NQ], float (&l)[NQ], float c2, int lane, MaskF valid) {
  const int col = lane & 15, quad = lane >> 4;
  f32x4 s[NQ][4];
#pragma unroll
  for (int kt = 0; kt < 4; ++kt) {
#pragma unroll
    for (int qt = 0; qt < NQ; ++qt) s[qt][kt] = f32x4{0.f, 0.f, 0.f, 0.f};
#pragma unroll
    for (int ks = 0; ks < DH / 32; ++ks) {
      const bf16x8 kf = *(const bf16x8*)(sK + (16 * kt + col) * LDK + 32 * ks + 8 * quad);
#pragma unroll
      for (int qt = 0; qt < NQ; ++qt) s[qt][kt] = mfma16(kf, qf[qt][ks], s[qt][kt]);
    }
  }
  bf16x8 pb[NQ][2];
#pragma unroll
  for (int qt = 0; qt < NQ; ++qt) {
    float mx = -1e30f;
#pragma unroll
    for (int kt = 0; kt < 4; ++kt)
#pragma unroll
      for (int r = 0; r < 4; ++r) {
        const bool v = valid(qt, 16 * kt + 4 * quad + r);
        const float sv = v ? s[qt][kt][r] : -1e30f;
        s[qt][kt][r] = sv;
        mx = fmaxf(mx, sv);
      }
    mx = fmaxf(mx, __shfl_xor(mx, 16));
    mx = fmaxf(mx, __shfl_xor(mx, 32));
    const float mn = fmaxf(m[qt], mx);
    const float alpha = fexp2((m[qt] - mn) * c2);
    m[qt] = mn;
    float ps = 0.f;
#pragma unroll
    for (int kt = 0; kt < 4; ++kt)
#pragma unroll
      for (int r = 0; r < 4; ++r) {
        const float sv = s[qt][kt][r];
        const float pv = (sv > -1e29f) ? fexp2((sv - mn) * c2) : 0.f;
        ps += pv;
        s[qt][kt][r] = pv;
      }
    l[qt] = l[qt] * alpha + ps;
#pragma unroll
    for (int dt = 0; dt < DH / 16; ++dt) o[qt][dt] *= alpha;
#pragma unroll
    for (int kk = 0; kk < 2; ++kk) {
      union { bf16x8 v; unsigned u[4]; } cv;
      cv.u[0] = pack2(s[qt][2 * kk][0], s[qt][2 * kk][1]);
      cv.u[1] = pack2(s[qt][2 * kk][2], s[qt][2 * kk][3]);
      cv.u[2] = pack2(s[qt][2 * kk + 1][0], s[qt][2 * kk + 1][1]);
      cv.u[3] = pack2(s[qt][2 * kk + 1][2], s[qt][2 * kk + 1][3]);
      pb[qt][kk] = cv.v;
    }
  }
#pragma unroll
  for (int dt = 0; dt < DH / 16; ++dt) {
#pragma unroll
    for (int kk = 0; kk < 2; ++kk) {
      union { bf16x8 v; uint2 h[2]; } cv;
      cv.h[0] = *(const uint2*)(sVt + (16 * dt + col) * LDV + 32 * kk + 4 * quad);
      cv.h[1] = *(const uint2*)(sVt + (16 * dt + col) * LDV + 32 * kk + 16 + 4 * quad);
#pragma unroll
      for (int qt = 0; qt < NQ; ++qt) o[qt][dt] = mfma16(cv.v, pb[qt][kk], o[qt][dt]);
    }
  }
}

DEVI void phase_nsa(const Params& p, unsigned char* smem) {
  u16* sK = (u16*)smem;
  u16* sVt = (u16*)(smem + 18432);
  float* impH = (float*)(smem + 35840);
  float* impT = (float*)(smem + 52736);
  unsigned* selm = (unsigned*)(smem + 56960);
  const float c2 = 0.125f * 1.4426950408889634f;
#pragma unroll 1
  for (int tile = blockIdx.x; tile < 2048; tile += gridDim.x) {
    const int tid = launder(threadIdx.x), lane = tid & 63, w = tid >> 6, col = lane & 15, quad = lane >> 4;
    const int qtile = 63 - (tile >> 5), bg = tile & 31, b = bg >> 1, g = bg & 1, q0 = qtile * 32;
    const int h = g * 4 + w;
    __syncthreads();
    if (tid < 32) selm[tid] = 0u;
    {
      const u16* kcp = p.kc + (size_t)bg * 128 * 64;
      const u16* vcp = p.vcT + (size_t)bg * 64 * 128;
#pragma unroll
      for (int i = 0; i < 4; ++i) {
        const int c = tid + 256 * i;
        const int row = c >> 3, ch = (c & 7) << 3;
        *(uint4*)(sK + row * 72 + ch) = *(const uint4*)(kcp + row * 64 + ch);
        const int row2 = c >> 4, ch2 = (c & 15) << 3;
        *(uint4*)(sVt + row2 * 136 + ch2) = *(const uint4*)(vcp + row2 * 128 + ch2);
      }
    }
    bf16x8 qf[2][2];
    float gate[2][3];
    int tq[2];
#pragma unroll
    for (int qt = 0; qt < 2; ++qt) {
      const int t = q0 + 16 * qt + col;
      tq[qt] = t;
      const size_t tok = (size_t)b * T + t;
      const u16* qp = p.proj + tok * LDP + C_Q + h * 64 + 8 * quad;
      qf[qt][0] = *(const bf16x8*)qp;
      qf[qt][1] = *(const bf16x8*)(qp + 32);
#pragma unroll
      for (int br = 0; br < 3; ++br) gate[qt][br] = sigmoidf_(bf2f(p.proj[tok * LDP + C_GATE + h * 3 + br]));
    }
    __syncthreads();

    f32x4 comb[2][4];
    {
      const int srcl = (lane + 48) & 63;
#pragma unroll
      for (int qt = 0; qt < 2; ++qt) {
        f32x4 s[8];
#pragma unroll
        for (int kt = 0; kt < 8; ++kt) {
          s[kt] = f32x4{0.f, 0.f, 0.f, 0.f};
#pragma unroll
          for (int ks = 0; ks < 2; ++ks) {
            const bf16x8 kf = *(const bf16x8*)(sK + (16 * kt + col) * 72 + 32 * ks + 8 * quad);
            s[kt] = mfma16(kf, qf[qt][ks], s[kt]);
          }
        }
        const int t = tq[qt];
        float mx = -1e30f;
#pragma unroll
        for (int kt = 0; kt < 8; ++kt)
#pragma unroll
          for (int r = 0; r < 4; ++r) {
            const int c = 16 * kt + 4 * quad + r;
            const bool v = (16 * c + 31) <= t;
            const float sv = v ? s[kt][r] : -1e30f;
            s[kt][r] = sv;
            mx = fmaxf(mx, sv);
          }
        mx = fmaxf(mx, __shfl_xor(mx, 16));
        mx = fmaxf(mx, __shfl_xor(mx, 32));
        float ps = 0.f;
#pragma unroll
        for (int kt = 0; kt < 8; ++kt)
#pragma unroll
          for (int r = 0; r < 4; ++r) {
            const float sv = s[kt][r];
            const float pv = (sv > -1e29f) ? fexp2((sv - mx) * c2) : 0.f;
            ps += pv;
            s[kt][r] = pv;
          }
        ps += __shfl_xor(ps, 16);
        ps += __shfl_xor(ps, 32);
        const float inv = ps > 0.f ? 1.f / ps : 0.f;
#pragma unroll
        for (int kt = 0; kt < 8; ++kt)
#pragma unroll
          for (int r = 0; r < 4; ++r) s[kt][r] *= inv;
        float prev3 = 0.f;
#pragma unroll
        for (int kt = 0; kt < 8; ++kt) {
          const float sum4 = s[kt][0] + s[kt][1] + s[kt][2] + s[kt][3];
          const float xs = __shfl(s[kt][3], srcl);
          const float extra = quad ? xs : prev3;
          prev3 = xs;
          impH[(w * 32 + 16 * qt + col) * 33 + 4 * kt + quad] = sum4 + extra;
        }
        bf16x8 pb[4];
#pragma unroll
        for (int kk = 0; kk < 4; ++kk) {
          union { bf16x8 v; unsigned u[4]; } cv;
          cv.u[0] = pack2(s[2 * kk][0], s[2 * kk][1]);
          cv.u[1] = pack2(s[2 * kk][2], s[2 * kk][3]);
          cv.u[2] = pack2(s[2 * kk + 1][0], s[2 * kk + 1][1]);
          cv.u[3] = pack2(s[2 * kk + 1][2], s[2 * kk + 1][3]);
          pb[kk] = cv.v;
        }
#pragma unroll
        for (int dt = 0; dt < 4; ++dt) {
          f32x4 oc = f32x4{0.f, 0.f, 0.f, 0.f};
#pragma unroll
          for (int kk = 0; kk < 4; ++kk) {
            union { bf16x8 v; uint2 hh[2]; } cv;
            cv.hh[0] = *(const uint2*)(sVt + (16 * dt + col) * 136 + 32 * kk + 4 * quad);
            cv.hh[1] = *(const uint2*)(sVt + (16 * dt + col) * 136 + 32 * kk + 16 + 4 * quad);
            oc = mfma16(cv.v, pb[kk], oc);
          }
          comb[qt][dt] = oc * gate[qt][0];
        }
      }
    }
#pragma unroll
    for (int qt = 0; qt < 2; ++qt) {
      const size_t tok = (size_t)b * T + tq[qt];
      union { bf16x8 v; unsigned u[4]; } own, par, res;
      own.v = qf[qt][0];
#pragma unroll
      for (int j = 0; j < 4; ++j) par.u[j] = (unsigned)__shfl_xor((int)own.u[j], 16);
      const float4 c0 = *(const float4*)(p.rope + tok * 16), c1 = *(const float4*)(p.rope + tok * 16 + 4);
      const float4 s0 = *(const float4*)(p.rope + tok * 16 + 8), s1 = *(const float4*)(p.rope + tok * 16 + 12);
      const float cs[8] = {c0.x, c0.y, c0.z, c0.w, c1.x, c1.y, c1.z, c1.w};
      const float sn[8] = {s0.x, s0.y, s0.z, s0.w, s1.x, s1.y, s1.z, s1.w};
#pragma unroll
      for (int j = 0; j < 4; ++j) {
        const float o0 = __uint_as_float(own.u[j] << 16), o1 = __uint_as_float(own.u[j] & 0xffff0000u);
        const float p0 = __uint_as_float(par.u[j] << 16), p1 = __uint_as_float(par.u[j] & 0xffff0000u);
        const float sg = (quad == 0) ? -1.f : 1.f;
        const float r0 = o0 * cs[2 * j] + sg * p0 * sn[2 * j];
        const float r1 = o1 * cs[2 * j + 1] + sg * p1 * sn[2 * j + 1];
        res.u[j] = (quad < 2) ? pack2(r0, r1) : own.u[j];
      }
      qf[qt][0] = res.v;
    }
    __syncthreads();
#pragma unroll
    for (int i = 0; i < 4; ++i) {
      const int cell = tid + 256 * i;
      const int qi = cell >> 5, s_ = cell & 31;
      const int cur = (q0 + qi) >> 6;
      float v = impH[(0 * 32 + qi) * 33 + s_] + impH[(1 * 32 + qi) * 33 + s_] + impH[(2 * 32 + qi) * 33 + s_] +
                impH[(3 * 32 + qi) * 33 + s_];
      const int dist = cur - s_;
      const bool forced = (s_ == 0) || (dist >= 0 && dist < 2);
      v = forced ? 1e9f : (s_ <= cur ? v : -1.f);
      impT[qi * 33 + s_] = v;
    }
    __syncthreads();
    {
      const int qi = tid >> 3, sub = tid & 7;
      unsigned bits = 0u;
#pragma unroll
      for (int k = 0; k < 4; ++k) {
        const int s_ = sub * 4 + k;
        const float v = impT[qi * 33 + s_];
        int rank = 0;
        for (int s2 = 0; s2 < 32; ++s2) {
          const float v2 = impT[qi * 33 + s2];
          rank += ((v2 > v) || (v2 == v && s2 < s_)) ? 1 : 0;
        }
        if (rank < 16) bits |= 1u << s_;
      }
      atomicOr(&selm[qi], bits);
    }
    __syncthreads();
    unsigned sm[2] = {selm[col], selm[16 + col]};
    unsigned uni = 0u;
#pragma unroll
    for (int i = 0; i < 32; ++i) uni |= selm[i];
    const int kbmax = (q0 + 31) >> 6;
    {
      float m[2] = {-1e30f, -1e30f}, l[2] = {0.f, 0.f};
      f32x4 o[2][4];
#pragma unroll
      for (int qt = 0; qt < 2; ++qt)
#pragma unroll
        for (int dt = 0; dt < 4; ++dt) o[qt][dt] = f32x4{0.f, 0.f, 0.f, 0.f};
      unsigned rem = (kbmax >= 31) ? uni : (uni & ((1u << (kbmax + 1)) - 1u));
      int kb = rem ? (__ffs((int)rem) - 1) : -1;
      uint4 rk0, rk1, rv0, rv1;
      const int lr0 = tid >> 3, lch = (tid & 7) << 3;
#define LOADKV_(kbx, CK, VT)                                                                                         \
      rk0 = *(const uint4*)(p.proj + ((size_t)b * T + (kbx) * 64 + lr0) * LDP + (CK) + g * 64 + lch);                 \
      rk1 = *(const uint4*)(p.proj + ((size_t)b * T + (kbx) * 64 + lr0 + 32) * LDP + (CK) + g * 64 + lch);            \
      rv0 = *(const uint4*)((VT) + ((size_t)bg * 64 + lr0) * LDT + (kbx) * 64 + lch);                                 \
      rv1 = *(const uint4*)((VT) + ((size_t)bg * 64 + lr0 + 32) * LDT + (kbx) * 64 + lch);
#define STOREKV_()                                                                                                   \
      *(uint4*)(sK + lr0 * 72 + lch) = rk0; *(uint4*)(sK + (lr0 + 32) * 72 + lch) = rk1;                              \
      *(uint4*)(sVt + lr0 * 72 + lch) = rv0; *(uint4*)(sVt + (lr0 + 32) * 72 + lch) = rv1;
      if (kb >= 0) { LOADKV_(kb, C_KS, p.vts) }
#pragma unroll 1
      while (kb >= 0) {
        rem &= rem - 1u;
        const int nkb = rem ? (__ffs((int)rem) - 1) : -1;
        __syncthreads();
        STOREKV_()
        if (nkb >= 0) { LOADKV_(nkb, C_KS, p.vts) }
        __syncthreads();
        attn_tile<64, 2, 72, 72>(sK, sVt, qf, o, m, l, c2, lane, [&](int qt, int kl) {
          const int kp = kb * 64 + kl;
          return (((sm[qt] >> kb) & 1u) != 0u) && (kp <= tq[qt]);
        });
        kb = nkb;
      }
#pragma unroll
      for (int qt = 0; qt < 2; ++qt) {
        float lt = l[qt];
        lt += __shfl_xor(lt, 16);
        lt += __shfl_xor(lt, 32);
        const float sc = lt > 0.f ? gate[qt][1] / lt : 0.f;
#pragma unroll
        for (int dt = 0; dt < 4; ++dt) comb[qt][dt] += o[qt][dt] * sc;
      }
    }
    {
      float m[2] = {-1e30f, -1e30f}, l[2] = {0.f, 0.f};
      f32x4 o[2][4];
#pragma unroll
      for (int qt = 0; qt < 2; ++qt)
#pragma unroll
        for (int dt = 0; dt < 4; ++dt) o[qt][dt] = f32x4{0.f, 0.f, 0.f, 0.f};
      const int kblo = (q0 >= 511) ? ((q0 - 511) >> 6) : 0;
      uint4 rk0, rk1, rv0, rv1;
      const int lr0 = tid >> 3, lch = (tid & 7) << 3;
      int kb = kblo;
      LOADKV_(kb, C_KW, p.vtw)
#pragma unroll 1
      while (kb >= 0) {
        const int nkb = (kb < kbmax) ? kb + 1 : -1;
        __syncthreads();
        STOREKV_()
        if (nkb >= 0) { LOADKV_(nkb, C_KW, p.vtw) }
        __syncthreads();
        attn_tile<64, 2, 72, 72>(sK, sVt, qf, o, m, l, c2, lane, [&](int qt, int kl) {
          const int kp = kb * 64 + kl;
          return (kp <= tq[qt]) && (kp > tq[qt] - 512);
        });
        kb = nkb;
      }
#undef LOADKV_
#undef STOREKV_
#pragma unroll
      for (int qt = 0; qt < 2; ++qt) {
        float lt = l[qt];
        lt += __shfl_xor(lt, 16);
        lt += __shfl_xor(lt, 32);
        const float sc = lt > 0.f ? gate[qt][2] / lt : 0.f;
#pragma unroll
        for (int dt = 0; dt < 4; ++dt) comb[qt][dt] += o[qt][dt] * sc;
      }
    }
#pragma unroll
    for (int qt = 0; qt < 2; ++qt) {
      const size_t tok = (size_t)b * T + tq[qt];
#pragma unroll
      for (int dt = 0; dt < 4; ++dt) {
        uint2 pk;
        pk.x = pack2(comb[qt][dt][0], comb[qt][dt][1]);
        pk.y = pack2(comb[qt][dt][2], comb[qt][dt][3]);
        *(uint2*)(p.mix + tok * LDA + 512 + h * 64 + 16 * dt + 4 * quad) = pk;
      }
    }
  }
}

DEVI void phase_resid(const Params& p, unsigned char* smem, const u16* A, const u16* Wt, const float* res, int ldres, float* ssq) {
  u16* sA = (u16*)smem; u16* sB = sA + 128 * 72;
  XCD_TILE_LOOP(idx, 256, 8) {
    GEMM_LANE_VARS
    const int mt = XCD_TILE_MT(idx, 8), nt_ = XCD_TILE_NT(idx, 8);
    const int m0 = mt * 128, n0 = nt_ * 128;
    f32x4 acc[4][4];
    gemm_mainloop<true>(tid, sA, sB, ARow{A, LDA}, Wt, LDA, m0, n0, 16, acc);
#pragma unroll
    for (int mi = 0; mi < 4; ++mi) {
      const int m = m0 + wm * 64 + 16 * mi + col;
      float ss = 0.f;
#pragma unroll
      for (int ni = 0; ni < 4; ++ni) {
        const int n = n0 + wn * 64 + 16 * ni + 4 * quad;
        const f32x4 v = acc[ni][mi];
        const float4 r = *(const float4*)(res + (size_t)m * ldres + n);
        float4 hv;
        hv.x = r.x + v[0]; hv.y = r.y + v[1]; hv.z = r.z + v[2]; hv.w = r.w + v[3];
        ss += hv.x * hv.x + hv.y * hv.y + hv.z * hv.z + hv.w * hv.w;
        *(float4*)(p.h + (size_t)m * LDHF + n) = hv;
        uint2 pk; pk.x = pack2(hv.x, hv.y); pk.y = pack2(hv.z, hv.w);
        *(uint2*)(p.hn + (size_t)m * LDA + n) = pk;
      }
      ss += __shfl_xor(ss, 16);
      ss += __shfl_xor(ss, 32);
      if (quad == 0) atomicAdd(ssq + m, ss);
    }
  }
}

DEVI void phase_scaled(const Params& p, unsigned char* smem, const u16* A, const u16* Wt, int ntn, const float* ssq, u16* outp, int ldo) {
  u16* sA = (u16*)smem; u16* sB = sA + 128 * 72;
  XCD_TILE_LOOP(idx, 256, ntn) {
    GEMM_LANE_VARS
    const int mt = XCD_TILE_MT(idx, ntn), nt_ = XCD_TILE_NT(idx, ntn);
    const int m0 = mt * 128, n0 = nt_ * 128;
    f32x4 acc[4][4];
    gemm_mainloop<true>(tid, sA, sB, ARow{A, LDA}, Wt, LDA, m0, n0, 16, acc);
#pragma unroll
    for (int mi = 0; mi < 4; ++mi) {
      const int m = m0 + wm * 64 + 16 * mi + col;
      const float rstd = rsqrtf(ssq[m] * (1.f / D) + 1e-6f);
#pragma unroll
      for (int ni = 0; ni < 4; ++ni) {
        const int n = n0 + wn * 64 + 16 * ni + 4 * quad;
        const f32x4 v = acc[ni][mi];
        uint2 pk; pk.x = pack2(v[0] * rstd, v[1] * rstd); pk.y = pack2(v[2] * rstd, v[3] * rstd);
        *(uint2*)(outp + (size_t)m * ldo + n) = pk;
      }
    }
  }
}

DEVI void phase_memattn(const Params& p, unsigned char* smem) {
  u16* sK = (u16*)smem;
  u16* sVt = (u16*)(smem + 33792);
  const float c2 = 0.0625f * 1.4426950408889634f;
#pragma unroll 1
  for (int tile = blockIdx.x; tile < 2048; tile += gridDim.x) {
    const int tid = launder(threadIdx.x), lane = tid & 63, w = tid >> 6, col = lane & 15, quad = lane >> 4;
    const int b = tile >> 7, head = (tile >> 5) & 3, q0 = (tile & 31) * 64;
    const size_t tok = (size_t)b * T + q0 + 16 * w + col;
    bf16x8 qf[1][8];
#pragma unroll
    for (int ks = 0; ks < 8; ++ks) qf[0][ks] = *(const bf16x8*)(p.qm + tok * LDA + head * 256 + 32 * ks + 8 * quad);
    float m[1] = {-1e30f}, l[1] = {0.f};
    f32x4 o[1][16];
#pragma unroll
    for (int dt = 0; dt < 16; ++dt) o[0][dt] = f32x4{0.f, 0.f, 0.f, 0.f};
#pragma unroll 1
    for (int kb = 0; kb < 4; ++kb) {
      __syncthreads();
#pragma unroll
      for (int i = 0; i < 8; ++i) {
        const int c = tid + 256 * i;
        const int row = c >> 5, ch = (c & 31) << 3;
        *(uint4*)(sK + row * 264 + ch) = *(const uint4*)(p.memk + ((size_t)b * 256 + kb * 64 + row) * LDA + head * 256 + ch);
      }
      __builtin_amdgcn_sched_barrier(0);
#pragma unroll
      for (int i = 0; i < 8; ++i) {
        const int c = tid + 256 * i;
        const int row2 = c >> 3, ch2 = (c & 7) << 3;
        *(uint4*)(sVt + row2 * 72 + ch2) = *(const uint4*)(p.memvt + ((size_t)(b * 4 + head) * 256 + row2) * 256 + kb * 64 + ch2);
      }
      __syncthreads();
      attn_tile<256, 1, 264, 72>(sK, sVt, qf, o, m, l, c2, lane, [&](int, int) { return true; });
    }
    float lt = l[0];
    lt += __shfl_xor(lt, 16);
    lt += __shfl_xor(lt, 32);
    const float inv = 1.f / lt;
#pragma unroll
    for (int dt = 0; dt < 16; ++dt) {
      uint2 pk;
      pk.x = pack2(o[0][dt][0] * inv, o[0][dt][1] * inv);
      pk.y = pack2(o[0][dt][2] * inv, o[0][dt][3] * inv);
      *(uint2*)(p.mix + tok * LDA + head * 256 + 16 * dt + 4 * quad) = pk;
    }
  }
}

__constant__ unsigned char kCandI[64] = {0,0,0,0,0,0,0,0,0,0,0,0,0,0,0,0, 1,1,1,1,1,1,1,1, 2,2,2,2,2, 3,3,3,3, 4,4,4, 5,5, 6,6, 7,7,
                                          8, 9, 10, 11, 12, 13, 14, 15, 0,0,0,0,0,0,0,0,0,0,0,0,0,0};
__constant__ unsigned char kCandJ[64] = {0,1,2,3,4,5,6,7,8,9,10,11,12,13,14,15, 0,1,2,3,4,5,6,7, 0,1,2,3,4, 0,1,2,3, 0,1,2, 0,1, 0,1, 0,1,
                                          0, 0, 0, 0, 0, 0, 0, 0, 0,0,0,0,0,0,0,0,0,0,0,0,0,0};

DEVI unsigned score_key(float v, int idx) {
  unsigned u = __float_as_uint(v);
  u = (u & 0x80000000u) ? ~u : (u | 0x80000000u);
  return (u & ~127u) | (unsigned)(127 - idx);
}
DEVI float key_score(unsigned k) {
  k &= ~127u;
  const unsigned u = (k & 0x80000000u) ? (k & 0x7fffffffu) : ~k;
  return __uint_as_float(u);
}

DEVI void phase_peer_route(const Params& p, unsigned char* smem) {
  u16* sA = (u16*)smem; u16* sB = sA + 128 * 72;
  unsigned* sScore = (unsigned*)smem;
  unsigned* sTop = (unsigned*)(smem + 36864);
  unsigned* sTmp = (unsigned*)(smem + 53248);
  {
    const int t0_ = launder(threadIdx.x);
    const int gw = (blockIdx.x * 256 + t0_) >> 6, nw = (gridDim.x * 256) >> 6;
    conv_fp8_rows(p.peer_u, p.ub8, p.uscale, 16384, gw, nw, t0_ & 63);
    conv_fp8_rows(p.peer_v, p.vb8, p.vscale, 16384, gw, nw, t0_ & 63);
  }
#pragma unroll 1
  for (int tile = blockIdx.x; tile < 256 * 8; tile += gridDim.x) {
    GEMM_LANE_VARS
    const int mt = tile >> 3, hd = tile & 7;
    const int m0 = mt * 128;
#pragma unroll 1
    for (int ph = 0; ph < 2; ++ph) {
      const int hp = hd * 2 + ph;
      f32x4 acc[4][4];
      __syncthreads();
      gemm_mainloop<false>(tid, sA, sB, ARow{p.pq + hp * 128, LDPQ}, p.subk + (size_t)hp * 128 * 128, 128, m0, 0, 2, acc);
#pragma unroll 1
      for (int hh = 0; hh < 2; ++hh) {
        if (wm == hh) {
#pragma unroll
          for (int mi = 0; mi < 4; ++mi) {
            const int row = 16 * mi + col;
#pragma unroll
            for (int ni = 0; ni < 4; ++ni) {
              const int n = wn * 64 + 16 * ni + 4 * quad;
              const f32x4 v = acc[ni][mi];
              uint4 kk;
              kk.x = score_key(v[0], n); kk.y = score_key(v[1], n + 1);
              kk.z = score_key(v[2], n + 2); kk.w = score_key(v[3], n + 3);
              *(uint4*)(sScore + row * 128 + n) = kk;
            }
          }
        }
        __syncthreads();
#pragma unroll 1
        for (int rg = 0; rg < 4; ++rg) {
          const int rbase = w * 16 + rg * 4;
          unsigned k0[4], k1[4], t0[4], t1[4], thr[4];
#pragma unroll
          for (int r = 0; r < 4; ++r) {
            k0[r] = sScore[(rbase + r) * 128 + lane];
            k1[r] = sScore[(rbase + r) * 128 + 64 + lane];
            t0[r] = ((k0[r] >> 16) << 7) | (k0[r] & 127u);
            t1[r] = ((k1[r] >> 16) << 7) | (k1[r] & 127u);
            thr[r] = 0u;
          }
#pragma unroll
          for (int bit = 22; bit >= 0; --bit) {
#pragma unroll
            for (int r = 0; r < 4; ++r) {
              const unsigned cand = thr[r] | (1u << bit);
              const int cnt = __popcll(__ballot(t0[r] >= cand)) + __popcll(__ballot(t1[r] >= cand));
              thr[r] = (cnt >= 16) ? cand : thr[r];
            }
          }
          unsigned* tmp = sTmp + w * 64;
#pragma unroll
          for (int r = 0; r < 4; ++r) {
            const unsigned long long b0 = __ballot(t0[r] >= thr[r]), b1 = __ballot(t1[r] >= thr[r]);
            const int pos0 = __builtin_amdgcn_mbcnt_hi((unsigned)(b0 >> 32), __builtin_amdgcn_mbcnt_lo((unsigned)b0, 0u));
            const int pos1 = __popcll(b0) + __builtin_amdgcn_mbcnt_hi((unsigned)(b1 >> 32), __builtin_amdgcn_mbcnt_lo((unsigned)b1, 0u));
            if (t0[r] >= thr[r]) tmp[r * 16 + pos0] = k0[r];
            if (t1[r] >= thr[r]) tmp[r * 16 + pos1] = k1[r];
          }
          __builtin_amdgcn_fence(__ATOMIC_RELEASE, "wavefront");
          __builtin_amdgcn_wave_barrier();
          __builtin_amdgcn_fence(__ATOMIC_ACQUIRE, "wavefront");
          {
            const int r = lane >> 4, ix = lane & 15;
            const unsigned mine = tmp[r * 16 + ix];
            const uint4 a = *(const uint4*)(tmp + r * 16), b = *(const uint4*)(tmp + r * 16 + 4), c = *(const uint4*)(tmp + r * 16 + 8),
                        d = *(const uint4*)(tmp + r * 16 + 12);
            const int rk = (a.x > mine) + (a.y > mine) + (a.z > mine) + (a.w > mine) + (b.x > mine) + (b.y > mine) + (b.z > mine) + (b.w > mine) +
                           (c.x > mine) + (c.y > mine) + (c.z > mine) + (c.w > mine) + (d.x > mine) + (d.y > mine) + (d.z > mine) + (d.w > mine);
            sTop[((hh * 64 + rbase + r) * 2 + ph) * 16 + rk] = mine;
          }
          __builtin_amdgcn_fence(__ATOMIC_RELEASE, "wavefront");
          __builtin_amdgcn_wave_barrier();
        }
        __syncthreads();
      }
    }
    const int ci = kCandI[lane], cj = kCandJ[lane];
    const bool act = lane < 50;
#pragma unroll 1
    for (int tg = 0; tg < 8; ++tg) {
      const int tb = w * 32 + tg * 4;
      unsigned k0[4], k1[4], ku[4], thr[4];
      float v[4];
#pragma unroll
      for (int r = 0; r < 4; ++r) {
        k0[r] = sTop[((tb + r) * 2 + 0) * 16 + ci];
        k1[r] = sTop[((tb + r) * 2 + 1) * 16 + cj];
        v[r] = key_score(k0[r]) + key_score(k1[r]);
        unsigned u = __float_as_uint(v[r]);
        u = (u & 0x80000000u) ? ~u : (u | 0x80000000u);
        ku[r] = act ? (((u >> 16) << 6) | (unsigned)(63 - lane)) : 0u;
        thr[r] = 0u;
      }
#pragma unroll
      for (int bit = 21; bit >= 0; --bit) {
#pragma unroll
        for (int r = 0; r < 4; ++r) {
          const unsigned cand = thr[r] | (1u << bit);
          const int cnt = __popcll(__ballot(ku[r] >= cand));
          thr[r] = (cnt >= 16) ? cand : thr[r];
        }
      }
#pragma unroll
      for (int r = 0; r < 4; ++r) {
        const bool sel = act && (ku[r] >= thr[r]);
        const unsigned long long ms = __ballot(sel);
        const int slot = __builtin_amdgcn_mbcnt_hi((unsigned)(ms >> 32), __builtin_amdgcn_mbcnt_lo((unsigned)ms, 0u));
        const float vmax = __int_as_float(__builtin_amdgcn_readlane(__float_as_int(v[r]), 0));
        const float e = sel ? __expf(v[r] - vmax) : 0.f;
        const float tot = wave_sum(e);
        if (sel) {
          const int eid = (127 - (int)(k0[r] & 127u)) * 128 + (127 - (int)(k1[r] & 127u));
          const size_t o = (size_t)(m0 + tb + r) * 128 + hd * 16 + slot;
          p.experts[o] = eid;
          p.gates[o] = e / tot;
        }
      }
    }
  }
}

DEVI void phase_peer_gather(const Params& p) {
  const int w0_ = threadIdx.x >> 6;
#pragma unroll 1
  for (int tok = blockIdx.x * 4 + w0_; tok < NTOK; tok += gridDim.x * 4) {
    const int tid = launder(threadIdx.x), lane = tid & 63;
    const float4* hp4 = (const float4*)(p.h + (size_t)tok * LDHF) + lane * 4;
    float hv[16], xn[16], y[16];
    {
      const float4 a0 = hp4[0], a1 = hp4[1], a2 = hp4[2], a3 = hp4[3];
      hv[0] = a0.x; hv[1] = a0.y; hv[2] = a0.z; hv[3] = a0.w; hv[4] = a1.x; hv[5] = a1.y; hv[6] = a1.z; hv[7] = a1.w;
      hv[8] = a2.x; hv[9] = a2.y; hv[10] = a2.z; hv[11] = a2.w; hv[12] = a3.x; hv[13] = a3.y; hv[14] = a3.z; hv[15] = a3.w;
    }
    float ss = 0.f;
#pragma unroll
    for (int i = 0; i < 16; ++i) ss += hv[i] * hv[i];
    ss = wave_sum(ss);
    const float rstd = rsqrtf(ss * (1.f / D) + 1e-6f);
    {
      const float4* g4 = (const float4*)p.peer_g + lane * 4;
      const float4 a0 = g4[0], a1 = g4[1], a2 = g4[2], a3 = g4[3];
      const float gg[16] = {a0.x, a0.y, a0.z, a0.w, a1.x, a1.y, a1.z, a1.w, a2.x, a2.y, a2.z, a2.w, a3.x, a3.y, a3.z, a3.w};
#pragma unroll
      for (int i = 0; i < 16; ++i) { xn[i] = hv[i] * rstd * gg[i]; y[i] = 0.f; }
    }
    const int e0 = p.experts[(size_t)tok * 128 + lane], e1 = p.experts[(size_t)tok * 128 + 64 + lane];
    const float g0 = p.gates[(size_t)tok * 128 + lane], g1 = p.gates[(size_t)tok * 128 + 64 + lane];
    const float su0 = p.uscale[e0], su1 = p.uscale[e1];
    const float sv0 = p.vscale[e0], sv1 = p.vscale[e1];
    float cf0 = 0.f, cf1 = 0.f, dsum = 0.f;
    uint4 ca[8], cb[8];
#define LOADB_(R, bi)                                                                                   \
    _Pragma("unroll") for (int u = 0; u < 8; ++u) {                                                       \
      const int kk_ = (((bi) & 7) << 3) + u;                                                             \
      const int e_ = __builtin_amdgcn_readlane((((bi) >> 3) & 1) ? e1 : e0, kk_);                        \
      R[u] = ((const uint4*)((((bi) >> 4) ? p.vb8 : p.ub8) + (size_t)e_ * 1024))[lane];                  \
    }
#define COMPU_(R, bi)                                                                                   \
    {                                                                                                    \
      float d8[8];                                                                                       \
      _Pragma("unroll") for (int u = 0; u < 8; ++u) {                                                     \
        const unsigned uu[4] = {R[u].x, R[u].y, R[u].z, R[u].w};                                         \
        f32x2 a2 = {0.f, 0.f};                                                                           \
        _Pragma("unroll") for (int j = 0; j < 4; ++j) {                                                   \
          const f32x2 lo = __builtin_amdgcn_cvt_pk_f32_fp8((int)uu[j], false);                           \
          const f32x2 hi = __builtin_amdgcn_cvt_pk_f32_fp8((int)uu[j], true);                            \
          a2 = xn2[2 * j] * lo + a2;                                                                     \
          a2 = xn2[2 * j + 1] * hi + a2;                                                                 \
        }                                                                                                \
        d8[u] = a2[0] + a2[1];                                                                           \
      }                                                                                                  \
          \
      float v4[4], v2[2];                                                                                \
      _Pragma("unroll") for (int i = 0; i < 4; ++i) {                                                     \
        const float snd = b5 ? d8[i] : d8[4 + i], kp = b5 ? d8[4 + i] : d8[i];                           \
        v4[i] = kp + __shfl_xor(snd, 32);                                                                \
      }                                                                                                  \
      _Pragma("unroll") for (int i = 0; i < 2; ++i) {                                                     \
        const float snd = b4 ? v4[i] : v4[2 + i], kp = b4 ? v4[2 + i] : v4[i];                           \
        v2[i] = kp + __shfl_xor(snd, 16);                                                                \
      }                                                                                                  \
      float v1;                                                                                          \
      { const float snd = b3 ? v2[0] : v2[1], kp = b3 ? v2[1] : v2[0]; v1 = kp + __shfl_xor(snd, 8); }   \
      v1 += __shfl_xor(v1, 4);                                                                           \
      v1 += __shfl_xor(v1, 2);                                                                           \
      v1 += __shfl_xor(v1, 1);                                                                           \
                \
      const float got = __shfl(v1, fsrc);                                                                \
      if ((lane >> 3) == ((bi) & 7)) dsum = got;                                                         \
    }                                                                                                    \
    if (((bi) & 7) == 7) {                                                                               \
      if (((bi) >> 3) & 1) cf1 = gelu_tanh(dsum * su1) * g1 * sv1; else cf0 = gelu_tanh(dsum * su0) * g0 * sv0; \
    }
#define COMPV_(R, bi)                                                                                   \
    _Pragma("unroll") for (int u = 0; u < 8; ++u) {                                                       \
      const int kk_ = (((bi) & 7) << 3) + u;                                                             \
      const float ck_ = __int_as_float(__builtin_amdgcn_readlane(__float_as_int((((bi) >> 3) & 1) ? cf1 : cf0), kk_)); \
      const f32x2 ck2 = {ck_, ck_};                                                                      \
      const unsigned uu[4] = {R[u].x, R[u].y, R[u].z, R[u].w};                                           \
      _Pragma("unroll") for (int j = 0; j < 4; ++j) {                                                     \
        const f32x2 lo = __builtin_amdgcn_cvt_pk_f32_fp8((int)uu[j], false);                             \
        const f32x2 hi = __builtin_amdgcn_cvt_pk_f32_fp8((int)uu[j], true);                              \
        y2[2 * j] = ck2 * lo + y2[2 * j];                                                                \
        y2[2 * j + 1] = ck2 * hi + y2[2 * j + 1];                                                        \
      }                                                                                                  \
    }
    const bool b5 = (lane & 32) != 0, b4 = (lane & 16) != 0, b3 = (lane & 8) != 0;
    const int fsrc = ((lane & 4) << 3) | ((lane & 2) << 3) | ((lane & 1) << 3);
    f32x2 xn2[8], y2[8];
#pragma unroll
    for (int i = 0; i < 8; ++i) { xn2[i] = f32x2{xn[2 * i], xn[2 * i + 1]}; y2[i] = f32x2{0.f, 0.f}; }
    LOADB_(ca, 0)
#pragma unroll 1
    for (int bi = 0; bi < 16; bi += 2) {
      LOADB_(cb, bi + 1)
      COMPU_(ca, bi)
      LOADB_(ca, bi + 2)
      COMPU_(cb, bi + 1)
    }
#pragma unroll 1
    for (int bi = 16; bi < 32; bi += 2) {
      LOADB_(cb, bi + 1)
      COMPV_(ca, bi)
      if (bi + 2 < 32) { LOADB_(ca, bi + 2) }
      COMPV_(cb, bi + 1)
    }
#undef LOADB_
#undef COMPU_
#undef COMPV_
#pragma unroll
    for (int i = 0; i < 8; ++i) { y[2 * i] = y2[i][0]; y[2 * i + 1] = y2[i][1]; }
    float s2 = 0.f;
    {
      const float4 a0 = hp4[0], a1 = hp4[1], a2 = hp4[2], a3 = hp4[3];
      const float hr[16] = {a0.x, a0.y, a0.z, a0.w, a1.x, a1.y, a1.z, a1.w, a2.x, a2.y, a2.z, a2.w, a3.x, a3.y, a3.z, a3.w};
#pragma unroll
      for (int i = 0; i < 16; ++i) { y[i] += hr[i]; s2 += y[i] * y[i]; }
    }
    s2 = wave_sum(s2);
    const float rs2 = rsqrtf(s2 * (1.f / D) + 1e-6f);
    {
      const float4* g4 = (const float4*)p.final_g + lane * 4;
      const float4 a0 = g4[0], a1 = g4[1], a2 = g4[2], a3 = g4[3];
      float4* o4 = (float4*)(p.out + (size_t)tok * D) + lane * 4;
      o4[0] = make_float4(y[0] * rs2 * a0.x, y[1] * rs2 * a0.y, y[2] * rs2 * a0.z, y[3] * rs2 * a0.w);
      o4[1] = make_float4(y[4] * rs2 * a1.x, y[5] * rs2 * a1.y, y[6] * rs2 * a1.z, y[7] * rs2 * a1.w);
      o4[2] = make_float4(y[8] * rs2 * a2.x, y[9] * rs2 * a2.y, y[10] * rs2 * a2.z, y[11] * rs2 * a2.w);
      o4[3] = make_float4(y[12] * rs2 * a3.x, y[13] * rs2 * a3.y, y[14] * rs2 * a3.z, y[15] * rs2 * a3.w);
    }
  }
}

#define XB_TMO      128
#define XB_XCNT(j)  (256  + 64 * (j))
#define XB_XSUB(j)  (1280 + 64 * (j))
#define XB_XGEN(j)  (2304 + 64 * (j))
#define XB_TOP      3328
#define XB_TOPGEN   3392
#define XCD_BAR_WORDS 3456
#define XB_SPIN_CAP (1u << 20)
#define LAS __attribute__((address_space(3)))
DEVI unsigned xb_ld(unsigned* q) { return __hip_atomic_load(q, __ATOMIC_RELAXED, __HIP_MEMORY_SCOPE_AGENT); }
DEVI unsigned xb_add(unsigned* q, unsigned v) { return __hip_atomic_fetch_add(q, v, __ATOMIC_RELAXED, __HIP_MEMORY_SCOPE_AGENT); }
DEVI unsigned xb_xcc_id() { return (unsigned)__builtin_amdgcn_s_getreg((3 << 11) | 20) & 0xFu; }
#define XB_SPIN(cond, bar) do { unsigned _sp = 0; while (cond) { __builtin_amdgcn_s_sleep(1); \
    if ((++_sp & 255u) == 0u) { if (xb_ld(&(bar)[XB_TMO])) break; if (_sp > XB_SPIN_CAP) { atomicAdd(&(bar)[XB_TMO], 1u); break; } } } } while (0)
struct XcdBarrier { unsigned* bar; unsigned x; volatile LAS unsigned* st; };
DEVI XcdBarrier xcd_barrier_post(unsigned* bar, volatile LAS unsigned* st) {
  XcdBarrier b; b.bar = bar; b.x = xb_xcc_id(); b.st = st;
  if (threadIdx.x == 0) (void)xb_add(&bar[XB_XCNT(b.x)], 1u);
  return b;
}
DEVI void xcd_barrier_complete(unsigned* bar, unsigned x, unsigned& nloc, unsigned& nx) {
  const unsigned G = gridDim.x * gridDim.y * gridDim.z;
  unsigned sum, cnt, mine, sp = 0u;
  for (;;) {
    sum = 0u; cnt = 0u; mine = 0u;
#pragma unroll
    for (unsigned j = 0; j < 16; ++j) { const unsigned c = xb_ld(&bar[XB_XCNT(j)]); sum += c; cnt += (c > 0u) ? 1u : 0u; mine = (j == x) ? c : mine; }
    if (sum == G) break;
    __builtin_amdgcn_s_sleep(1);
    if ((++sp & 255u) == 0u) { if (xb_ld(&bar[XB_TMO])) break; if (sp > XB_SPIN_CAP) { atomicAdd(&bar[XB_TMO], 1u); break; } }
  }
  nloc = mine > 0u ? mine : 1u; nx = cnt > 0u ? cnt : 1u;
}
DEVI void xcd_barrier(const XcdBarrier& b) {
  asm volatile("s_waitcnt vmcnt(0)" ::: "memory");
  __syncthreads();
  if (threadIdx.x == 0) {
    unsigned* bar = b.bar;
    __builtin_amdgcn_s_waitcnt(0);
    unsigned nloc = b.st[0], nx = b.st[1];
    if (nloc == 0u) { xcd_barrier_complete(bar, b.x, nloc, nx); b.st[0] = nloc; b.st[1] = nx; }
    const unsigned old = xb_add(&bar[XB_XSUB(b.x)], 1u);
    const unsigned gen = old / nloc;
    if (old + 1u == (gen + 1u) * nloc) {
      __builtin_amdgcn_fence(__ATOMIC_RELEASE, "agent");
      asm volatile("s_waitcnt vmcnt(0)" ::: "memory");
      const unsigned og = xb_add(&bar[XB_TOP], 1u);
      const unsigned tg = og / nx;
      if (og + 1u == (tg + 1u) * nx) xb_add(&bar[XB_TOPGEN], 1u);
      else XB_SPIN(xb_ld(&bar[XB_TOPGEN]) == tg, bar);
      __builtin_amdgcn_fence(__ATOMIC_ACQUIRE, "agent");
      xb_add(&bar[XB_XGEN(b.x)], 1u);
      asm volatile("s_waitcnt vmcnt(0)" ::: "memory");
    } else {
      XB_SPIN(xb_ld(&bar[XB_XGEN(b.x)]) == gen, bar);
      __builtin_amdgcn_fence(__ATOMIC_ACQUIRE, "agent");
      asm volatile("s_waitcnt vmcnt(0)" ::: "memory");
    }
  }
  __syncthreads();
}

template <bool COOP>
__global__ void __launch_bounds__(256, 2) mega(Params p, int ph_lo, int ph_hi) {
  __shared__ __attribute__((aligned(16))) unsigned char smem[SMEM_BYTES];
  __shared__ uint4 xb_words;
  if (threadIdx.x == 0) xb_words = make_uint4(0u, 0u, 0u, 0u);
  __syncthreads();
  XcdBarrier xb = xcd_barrier_post(p.bar, (volatile LAS unsigned*)&xb_words);
  (void)xb;
  if (COOP && ph_hi > 1000) cg::this_grid().sync();
#ifdef REPEAT_MASK
#define RUN_PHASE(i, call)                                                                   \
  if (ph_lo <= (i) && (i) <= ph_hi) {                                                        \
    call;                                                                                    \
    if (COOP && ((REPEAT_MASK >> (i)) & 1)) { cg::this_grid().sync(); call; }                \
    if (COOP && (i) < ph_hi) cg::this_grid().sync();                                         \
  }
#else
#define RUN_PHASE(i, call)                                                                   \
  if (ph_lo <= (i) && (i) <= ph_hi) {                                                        \
    call;                                                                                    \
    if (COOP && (i) < ph_hi) {                                                               \
      xcd_barrier(xb);                                                                       \
    }                                                                                        \
  }
#endif
  RUN_PHASE(0, phase0(p))
  RUN_PHASE(1, phase1(p, smem))
  RUN_PHASE(2, phase2(p, smem))
  RUN_PHASE(3, phase3(p, smem))
  RUN_PHASE(4, phase_nsa(p, smem))
  RUN_PHASE(5, phase_resid(p, smem, p.mix, p.woutT, p.x, D, p.ssq1))
  RUN_PHASE(6, phase_scaled(p, smem, p.hn, p.wmqT, 8, p.ssq1, p.qm, LDA))
  RUN_PHASE(7, phase_memattn(p, smem))
  RUN_PHASE(8, phase_resid(p, smem, p.mix, p.wmoT, p.h, LDHF, p.ssq2))
  RUN_PHASE(9, phase_scaled(p, smem, p.hn, p.wpqT, 16, p.ssq2, p.pq, LDPQ))
  RUN_PHASE(10, phase_peer_route(p, smem))
  RUN_PHASE(11, phase_peer_gather(p))
#undef RUN_PHASE
}

extern "C" void kernel_launch(void* const* d_in, const int* in_sizes, int n_in, void* d_out, int out_size, void* d_ws,
                              size_t ws_size, hipStream_t stream) {
  (void)in_sizes; (void)n_in; (void)out_size; (void)ws_size;
  Params p{};
  p.x = (const float*)d_in[0]; p.mem = (const float*)d_in[1]; p.pos = (const int*)d_in[2];
  p.mix_g = (const float*)d_in[3]; p.w_in = (const float*)d_in[4]; p.conv_w = (const float*)d_in[5];
  p.conv_b = (const float*)d_in[6]; p.ln_g = (const float*)d_in[7]; p.ln_b = (const float*)d_in[8];
  p.cmp_pos = (const float*)d_in[9]; p.cmp_w1 = (const float*)d_in[10]; p.cmp_b1 = (const float*)d_in[11];
  p.cmp_w2 = (const float*)d_in[12]; p.cmp_b2 = (const float*)d_in[13]; p.w_out = (const float*)d_in[14];
  p.memq_g = (const float*)d_in[15]; p.memkv_g = (const float*)d_in[16]; p.w_mq = (const float*)d_in[17];
  p.w_mk = (const float*)d_in[18]; p.w_mv = (const float*)d_in[19]; p.w_mo = (const float*)d_in[20];
  p.peer_g = (const float*)d_in[21]; p.peer_wq = (const float*)d_in[22]; p.peer_sk = (const float*)d_in[23];
  p.peer_u = (const float*)d_in[24]; p.peer_v = (const float*)d_in[25]; p.final_g = (const float*)d_in[26];
  p.out = (float*)d_out;
  unsigned char* ws = (unsigned char*)d_ws;
  size_t off = 0;
  auto take = [&](size_t bytes) { unsigned char* r = ws + off; off += (bytes + 255) & ~(size_t)255; return r; };
  unsigned char* regA = take((size_t)NTOK * LDA * 2);
  unsigned char* regB = take((size_t)NTOK * LDP * 2);
  unsigned char* regC = take((size_t)NTOK * LDA * 2);
  p.hn = (u16*)regA; p.ub8 = regA; p.vb8 = regA + (size_t)16384 * 1024;
  p.uscale = (float*)(regA + (size_t)2 * 16384 * 1024); p.vscale = p.uscale + 16384;
  p.proj = (u16*)regB; p.qm = (u16*)regB; p.pq = (u16*)regB;
  p.mix = (u16*)regC; p.experts = (int*)regC; p.gates = (float*)(regC + (size_t)NTOK * 128 * 4);
  p.h = (float*)take((size_t)NTOK * LDHF * 4);
  p.vts = (u16*)take((size_t)Bn * 2 * 64 * LDT * 2);
  p.vtw = (u16*)take((size_t)Bn * 2 * 64 * LDT * 2);
  p.memn = (u16*)take((size_t)Bn * 256 * LDA * 2);
  p.memk = (u16*)take((size_t)Bn * 256 * LDA * 2);
  p.memvt = (u16*)take((size_t)Bn * 256 * D * 2);
  p.winT = (u16*)take((size_t)2432 * LDA * 2);
  p.woutT = (u16*)take((size_t)1024 * LDA * 2);
  p.wmqT = (u16*)take((size_t)1024 * LDA * 2);
  p.wmkT = (u16*)take((size_t)1024 * LDA * 2);
  p.wmvT = (u16*)take((size_t)1024 * LDA * 2);
  p.wmoT = (u16*)take((size_t)1024 * LDA * 2);
  p.wpqT = (u16*)take((size_t)2048 * LDA * 2);
  p.subk = (u16*)take((size_t)16 * 128 * 128 * 2);
  p.w1T = (u16*)take((size_t)2 * 128 * LDW1 * 2);
  p.w2T = (u16*)take((size_t)2 * 128 * 128 * 2);
  p.biasp = (float*)take(256 * 4);
  p.rope = (float*)take((size_t)NTOK * 16 * 4);
  p.hdn = (u16*)take((size_t)2 * 4096 * 128 * 2);
  p.kc = (u16*)take((size_t)Bn * 2 * 128 * 64 * 2);
  p.vcT = (u16*)take((size_t)Bn * 2 * 64 * 128 * 2);
  p.ssq1 = (float*)take((size_t)NTOK * 4);
  p.ssq2 = (float*)take((size_t)NTOK * 4);
  p.bar = (unsigned*)take(16384);
  if (off > ws_size) { fprintf(stderr, "workspace too small: need %zu have %zu\n", off, ws_size); return; }

#if COOP_MODE
  static int grid_blocks = 0;
  if (!grid_blocks) {
    int dev = 0, cus = 0, per_cu = 0;
    hipGetDevice(&dev);
    hipDeviceGetAttribute(&cus, hipDeviceAttributeMultiprocessorCount, dev);
    hipOccupancyMaxActiveBlocksPerMultiprocessor(&per_cu, mega<true>, 256, 0);
    if (per_cu > 2) per_cu = 2;
    if (per_cu < 1) per_cu = 1;
    grid_blocks = cus * per_cu;
  }
  int lo = 0, hi = NPHASE;
  void* args[] = {&p, &lo, &hi};
  (void)hipMemsetAsync(p.bar, 0, 16384, stream);
  hipError_t e = hipLaunchCooperativeKernel((void*)mega<true>, dim3(grid_blocks), dim3(256), args, 0, stream);
  if (e != hipSuccess) fprintf(stderr, "cooperative launch failed: %s (grid %d)\n", hipGetErrorString(e), grid_blocks);
#else
  for (int ph = 0; ph <= NPHASE; ++ph) mega<false><<<dim3(512), dim3(256), 0, stream>>>(p, ph, ph);
#endif
}
```

```cpp
#include <hip/hip_runtime.h>
#include <hip/hip_bf16.h>
#include <hip/hip_cooperative_groups.h>
#include <cstdio>
#include <cstdint>
namespace cg = cooperative_groups;

#ifndef COOP_MODE
#define COOP_MODE 1
#endif

typedef __attribute__((ext_vector_type(8))) short bf16x8;
typedef __attribute__((ext_vector_type(4))) short bf16x4;
typedef __attribute__((ext_vector_type(4))) float f32x4;
typedef unsigned short u16;

#define DEVI __device__ __forceinline__

constexpr int Bn = 16, T = 2048, D = 1024, NTOK = Bn * T, LDP = 2336;
constexpr int C_Q = 1024, C_KC = 1536, C_VC = 1664, C_KS = 1792, C_VS = 1920, C_KW = 2048, C_VW = 2176, C_GATE = 2304;
constexpr int SMEM_BYTES = 73728;
constexpr int LDA = 1088;
constexpr int LDHF = 1056;
constexpr int LDPQ = 2112;
constexpr int LDW1 = 2112;
constexpr int LDT = 2112;
constexpr int NPHASE = 11;

struct Params {
  const float* x; const float* mem; const int* pos; const float* mix_g; const float* w_in;
  const float* conv_w; const float* conv_b; const float* ln_g; const float* ln_b;
  const float* cmp_pos; const float* cmp_w1; const float* cmp_b1; const float* cmp_w2; const float* cmp_b2;
  const float* w_out; const float* memq_g; const float* memkv_g; const float* w_mq; const float* w_mk;
  const float* w_mv; const float* w_mo; const float* peer_g; const float* peer_wq; const float* peer_sk;
  const float* peer_u; const float* peer_v; const float* final_g;
  float* out;
  u16* hn; u16* proj; u16* mix; float* h; u16* vts; u16* vtw; u16* memn; u16* memk; u16* memvt;
  u16* winT; u16* woutT; u16* wmqT; u16* wmkT; u16* wmvT; u16* wmoT; u16* wpqT; u16* subk; u16* w1T; u16* w2T;
  float* biasp; float* rope; u16* hdn; u16* kc; u16* vcT; float* ssq1; float* ssq2;
  int* experts; float* gates; unsigned char* ub8; unsigned char* vb8; float* uscale; float* vscale; u16* qm; u16* pq;
  unsigned* bar;
};

DEVI int launder(int x) { asm volatile("" : "+v"(x)); return x; }
DEVI u16 f2bf(float f) {
  unsigned u = __float_as_uint(f);
  u += 0x7fffu + ((u >> 16) & 1u);
  return (u16)(u >> 16);
}
DEVI float bf2f(u16 h) { return __uint_as_float(((unsigned)h) << 16); }
DEVI unsigned pack2(float a, float b) { return (unsigned)f2bf(a) | ((unsigned)f2bf(b) << 16); }
DEVI float wave_sum(float v) {
#pragma unroll
  for (int o = 32; o; o >>= 1) v += __shfl_xor(v, o);
  return v;
}
DEVI float sigmoidf_(float x) { return 1.f / (1.f + __expf(-x)); }
DEVI float gelu_tanh(float x) {
  float u = 0.7978845608028654f * (x + 0.044715f * x * x * x);
  return 0.5f * x * (1.f + tanhf(u));
}
DEVI f32x4 mfma16(bf16x8 a, bf16x8 b, f32x4 c) { return __builtin_amdgcn_mfma_f32_16x16x32_bf16(a, b, c, 0, 0, 0); }
DEVI float fexp2(float x) { return __builtin_amdgcn_exp2f(x); }

DEVI void tconv(const float* __restrict__ src, int K, int N, u16* __restrict__ dst, int Npad, int ldd,
                const float* __restrict__ gain, int gtid, int gsz) {
  const int items = Npad * (K >> 3);
  for (int it = gtid; it < items; it += gsz) {
    const int n = it % Npad, kc = it / Npad;
    float f[8];
#pragma unroll
    for (int j = 0; j < 8; ++j) {
      float v = 0.f;
      if (n < N) {
        v = src[(size_t)(kc * 8 + j) * N + n];
        if (gain) v *= gain[kc * 8 + j];
      }
      f[j] = v;
    }
    uint4 pk;
    pk.x = pack2(f[0], f[1]); pk.y = pack2(f[2], f[3]); pk.z = pack2(f[4], f[5]); pk.w = pack2(f[6], f[7]);
    *(uint4*)(dst + (size_t)n * ldd + kc * 8) = pk;
  }
}

DEVI void conv_flat(const float* __restrict__ src, u16* __restrict__ dst, size_t n8, size_t gtid, size_t gsz) {
  for (size_t it = gtid; it < n8; it += gsz) {
    const float4 a = ((const float4*)src)[2 * it], b = ((const float4*)src)[2 * it + 1];
    uint4 pk;
    pk.x = pack2(a.x, a.y); pk.y = pack2(a.z, a.w); pk.z = pack2(b.x, b.y); pk.w = pack2(b.z, b.w);
    ((uint4*)dst)[it] = pk;
  }
}


typedef float f32x2 __attribute__((ext_vector_type(2)));
DEVI unsigned pk4_fp8(float a, float b, float c, float d) {
  int v = 0;
  v = __builtin_amdgcn_cvt_pk_fp8_f32(a, b, v, false);
  v = __builtin_amdgcn_cvt_pk_fp8_f32(c, d, v, true);
  return (unsigned)v;
}
DEVI void conv_fp8_rows(const float* __restrict__ src, unsigned char* __restrict__ dst, float* __restrict__ inv_scale,
                        int rows, int gw, int nw, int lane) {
  for (int r0 = gw; r0 < rows; r0 += 2 * nw) {
    const int r1 = r0 + nw;
    const bool has1 = r1 < rows;
    const float4* p0 = (const float4*)(src + (size_t)r0 * 1024) + lane * 4;
    const float4* p1 = (const float4*)(src + (size_t)(has1 ? r1 : r0) * 1024) + lane * 4;
    float4 v[2][4];
#pragma unroll
    for (int i = 0; i < 4; ++i) { v[0][i] = p0[i]; v[1][i] = p1[i]; }
    float mx[2];
#pragma unroll
    for (int q = 0; q < 2; ++q) {
      float m = 0.f;
#pragma unroll
      for (int i = 0; i < 4; ++i)
        m = fmaxf(m, fmaxf(fmaxf(fabsf(v[q][i].x), fabsf(v[q][i].y)), fmaxf(fabsf(v[q][i].z), fabsf(v[q][i].w))));
      mx[q] = m;
    }
#pragma unroll
    for (int o = 32; o; o >>= 1) { mx[0] = fmaxf(mx[0], __shfl_xor(mx[0], o)); mx[1] = fmaxf(mx[1], __shfl_xor(mx[1], o)); }
#pragma unroll
    for (int q = 0; q < 2; ++q) {
      if (q == 1 && !has1) break;
      const int r = q ? r1 : r0;
      const float sc = mx[q] > 0.f ? 224.f / mx[q] : 1.f;
      if (lane == 0) inv_scale[r] = mx[q] > 0.f ? mx[q] * (1.f / 224.f) : 1.f;
      uint4 o4;
      o4.x = pk4_fp8(v[q][0].x * sc, v[q][0].y * sc, v[q][0].z * sc, v[q][0].w * sc);
      o4.y = pk4_fp8(v[q][1].x * sc, v[q][1].y * sc, v[q][1].z * sc, v[q][1].w * sc);
      o4.z = pk4_fp8(v[q][2].x * sc, v[q][2].y * sc, v[q][2].z * sc, v[q][2].w * sc);
      o4.w = pk4_fp8(v[q][3].x * sc, v[q][3].y * sc, v[q][3].z * sc, v[q][3].w * sc);
      ((uint4*)(dst + (size_t)r * 1024))[lane] = o4;
    }
  }
}

DEVI void rownorm_bf16(const float* __restrict__ src, const float* __restrict__ g, u16* __restrict__ dst,
                       int rows, int gw, int nw, int lane) {
  for (int r = gw; r < rows; r += nw) {
    const float4* pr = (const float4*)(src + (size_t)r * D);
    float4 v[4];
    float ss = 0.f;
#pragma unroll
    for (int i = 0; i < 4; ++i) {
      v[i] = pr[lane + 64 * i];
      ss += v[i].x * v[i].x + v[i].y * v[i].y + v[i].z * v[i].z + v[i].w * v[i].w;
    }
    ss = wave_sum(ss);
    const float rstd = rsqrtf(ss * (1.f / D) + 1e-6f);
#pragma unroll
    for (int i = 0; i < 4; ++i) {
      const float4 gg = ((const float4*)g)[lane + 64 * i];
      uint2 pk;
      pk.x = pack2(v[i].x * rstd * gg.x, v[i].y * rstd * gg.y);
      pk.y = pack2(v[i].z * rstd * gg.z, v[i].w * rstd * gg.w);
      *(uint2*)(dst + (size_t)r * LDA + (size_t)(lane + 64 * i) * 4) = pk;
    }
  }
}

DEVI void phase0(const Params& p) {
  const int tid = launder(threadIdx.x), lane = tid & 63;
  const int gtid = blockIdx.x * 256 + tid, gsz = gridDim.x * 256;
  const int gw = gtid >> 6, nw = gsz >> 6;
  rownorm_bf16(p.x, p.mix_g, p.hn, NTOK, gw, nw, lane);
  rownorm_bf16(p.mem, p.memkv_g, p.memn, Bn * 256, gw, nw, lane);
  tconv(p.w_in, 1024, 2328, p.winT, 2432, LDA, nullptr, gtid, gsz);
  tconv(p.w_out, 1024, 1024, p.woutT, 1024, LDA, nullptr, gtid, gsz);
  tconv(p.w_mq, 1024, 1024, p.wmqT, 1024, LDA, p.memq_g, gtid, gsz);
  tconv(p.w_mk, 1024, 1024, p.wmkT, 1024, LDA, nullptr, gtid, gsz);
  tconv(p.w_mv, 1024, 1024, p.wmvT, 1024, LDA, nullptr, gtid, gsz);
  tconv(p.w_mo, 1024, 1024, p.wmoT, 1024, LDA, nullptr, gtid, gsz);
  tconv(p.peer_wq, 1024, 2048, p.wpqT, 2048, LDA, p.peer_g, gtid, gsz);
  tconv(p.cmp_w1, 2048, 128, p.w1T, 128, LDW1, nullptr, gtid, gsz);
  tconv(p.cmp_w1 + 2048 * 128, 2048, 128, p.w1T + 128 * LDW1, 128, LDW1, nullptr, gtid, gsz);
  tconv(p.cmp_w2, 128, 64, p.w2T, 128, 128, nullptr, gtid, gsz);
  tconv(p.cmp_w2 + 128 * 64, 128, 64, p.w2T + 128 * 128, 128, 128, nullptr, gtid, gsz);
  conv_flat(p.peer_sk, p.subk, (size_t)16 * 128 * 128 / 8, gtid, gsz);
  for (int it = gtid; it < NTOK * 8; it += gsz) {
    const int tok = it >> 3, i = it & 7;
    const float inv = (i == 0) ? 1.000000000e+00f : (i == 1) ? 1.939227432e-01f : (i == 2) ? 3.760603070e-02f : (i == 3) ? 7.292664610e-03f : (i == 4) ? 1.414213562e-03f : (i == 5) ? 2.742481884e-04f : (i == 6) ? 5.318295734e-05f : 1.031338525e-05f;
    const float ang = (float)p.pos[tok] * inv;
    float sv, cv;
    sincosf(ang, &sv, &cv);
    p.rope[tok * 16 + i] = cv;
    p.rope[tok * 16 + 8 + i] = sv;
  }
  for (int o = gw; o < 256; o += nw) {
    const int ty = o >> 7, n = o & 127;
    float s = 0.f;
    for (int k = lane; k < 2048; k += 64)
      s += p.cmp_pos[ty * 2048 + k] * p.cmp_w1[((size_t)ty * 2048 + k) * 128 + n];
    s = wave_sum(s);
    if (lane == 0) p.biasp[o] = s + p.cmp_b1[o];
  }
  for (int it = gtid; it < NTOK; it += gsz) { p.ssq1[it] = 0.f; p.ssq2[it] = 0.f; }
}

template <bool DB, class AF>
DEVI void gemm_mainloop(int tid, u16* sA, u16* sB, AF af, const u16* __restrict__ Bt, int ldb, int m0, int n0, int nk,
                        f32x4 (&acc)[4][4]) {
  const int lane = tid & 63, w = tid >> 6;
  const int wm = w >> 1, wn = w & 1, col = lane & 15, quad = lane >> 4;
#pragma unroll
  for (int i = 0; i < 4; ++i)
#pragma unroll
    for (int j = 0; j < 4; ++j) acc[i][j] = f32x4{0.f, 0.f, 0.f, 0.f};
  uint4 ra0, ra1, ra2, ra3, rb0, rb1, rb2, rb3;
  const int lrow = tid >> 3, lkc = (tid & 7) << 3;
  const u16* bbase = Bt + (size_t)(n0 + lrow) * ldb + lkc;
#define GL_(R, i, kk)                                                     \
  R##a##i = *(const uint4*)af(m0 + lrow + 32 * i, (kk) + lkc);            \
  R##b##i = *(const uint4*)(bbase + (size_t)(32 * i) * ldb + (kk));
#define SS_(R, i, off)                                                    \
  *(uint4*)(sA + (off) + (lrow + 32 * i) * 72 + lkc) = R##a##i;           \
  *(uint4*)(sB + (off) + (lrow + 32 * i) * 72 + lkc) = R##b##i;
#define GL4_(R, kk) GL_(R, 0, kk) GL_(R, 1, kk) GL_(R, 2, kk) GL_(R, 3, kk)
#define SS4_(R, off) SS_(R, 0, off) SS_(R, 1, off) SS_(R, 2, off) SS_(R, 3, off)
#define COMPUTE_(cur)                                                                                                   \
  _Pragma("unroll") for (int ks = 0; ks < 2; ++ks) {                                                                    \
    bf16x8 fa[4], fb[4];                                                                                                \
    _Pragma("unroll") for (int mi = 0; mi < 4; ++mi)                                                                    \
      fa[mi] = *(const bf16x8*)(sA + (cur) + (wm * 64 + 16 * mi + col) * 72 + 32 * ks + 8 * quad);                      \
    _Pragma("unroll") for (int ni = 0; ni < 4; ++ni)                                                                    \
      fb[ni] = *(const bf16x8*)(sB + (cur) + (wn * 64 + 16 * ni + col) * 72 + 32 * ks + 8 * quad);                      \
    _Pragma("unroll") for (int ni = 0; ni < 4; ++ni)                                                                    \
      _Pragma("unroll") for (int mi = 0; mi < 4; ++mi) acc[ni][mi] = mfma16(fb[ni], fa[mi], acc[ni][mi]);               \
  }
  if (DB) {
    const int srow = 8 * w + (lane >> 3);
    const int spc = lane & 7;
#define STAGE_(st, kk)                                                                                         \
    _Pragma("unroll") for (int i = 0; i < 4; ++i) {                                                            \
      const int r_ = 32 * i + srow;                                                                            \
      const int c_ = (spc ^ ((r_ >> 1) & 7)) << 3;                                                             \
      __builtin_amdgcn_global_load_lds((const unsigned*)af(m0 + r_, (kk) + c_),                                \
                                       (unsigned*)(sA + (st) * 16384 + (32 * i + 8 * w) * 64), 16, 0, 0);      \
      __builtin_amdgcn_global_load_lds((const unsigned*)(Bt + (size_t)(n0 + r_) * ldb + (kk) + c_),            \
                                       (unsigned*)(sA + (st) * 16384 + 8192 + (32 * i + 8 * w) * 64), 16, 0, 0); \
    }
#define COMPUTE_SW_(st)                                                                                                 \
  _Pragma("unroll") for (int ks = 0; ks < 2; ++ks) {                                                                    \
    bf16x8 fa[4], fb[4];                                                                                                \
    const int pc_ = ((4 * ks + quad) ^ ((col >> 1) & 7)) << 3;                                                          \
    _Pragma("unroll") for (int mi = 0; mi < 4; ++mi)                                                                    \
      fa[mi] = *(const bf16x8*)(sA + (st) * 16384 + (wm * 64 + 16 * mi + col) * 64 + pc_);                              \
    _Pragma("unroll") for (int ni = 0; ni < 4; ++ni)                                                                    \
      fb[ni] = *(const bf16x8*)(sA + (st) * 16384 + 8192 + (wn * 64 + 16 * ni + col) * 64 + pc_);                       \
    _Pragma("unroll") for (int ni = 0; ni < 4; ++ni)                                                                    \
      _Pragma("unroll") for (int mi = 0; mi < 4; ++mi) acc[ni][mi] = mfma16(fb[ni], fa[mi], acc[ni][mi]);               \
  }
    STAGE_(0, 0)
#pragma unroll 1
    for (int kt = 0; kt < nk; kt += 2) {
      asm volatile("s_waitcnt vmcnt(0)" ::: "memory");
      __syncthreads();
      { const int kk = (kt + 1) * 64; STAGE_(1, kk) }
      COMPUTE_SW_(0)
      asm volatile("s_waitcnt vmcnt(0)" ::: "memory");
      __syncthreads();
      if (kt + 2 < nk) { const int kk = (kt + 2) * 64; STAGE_(0, kk) }
      COMPUTE_SW_(1)
    }
#undef STAGE_
#undef COMPUTE_SW_
  } else {
    GL4_(r, 0)
    SS4_(r, 0)
    __syncthreads();
#pragma unroll 1
    for (int kt = 0; kt < nk; ++kt) {
      const bool more = (kt + 1 < nk);
      if (more) { const int kk = (kt + 1) * 64; GL4_(r, kk) }
      COMPUTE_(0)
      __syncthreads();
      if (more) {
        SS4_(r, 0)
        __syncthreads();
      }
    }
  }
#undef GL_
#undef SS_
#undef GL4_
#undef SS4_
#undef COMPUTE_
}

struct ARow {
  const u16* base; int lda;
  DEVI const u16* operator()(int m, int k) const { return base + (size_t)m * lda + k; }
};
struct ACmp {
  const u16* proj; int colbase;
  DEVI const u16* operator()(int rr, int k) const {
    const int b = rr >> 8, g = (rr >> 7) & 1;
    int c = rr & 127; c = c > 126 ? 126 : c;
    const int l = k >> 6, d = k & 63;
    return proj + ((size_t)b * T + 16 * c + l) * LDP + colbase + g * 64 + d;
  }
};


#define XCD_TILE_LOOP(idx, MT, NT)                                                                     \
  const bool sw_ = (gridDim.x & 7) == 0;                                                               \
  const int xcd_ = blockIdx.x & 7;                                                                     \
  const int tstart_ = sw_ ? (int)(blockIdx.x >> 3) : (int)blockIdx.x;                                  \
  const int tstep_ = sw_ ? (int)(gridDim.x >> 3) : (int)gridDim.x;                                     \
  const int ttotal_ = sw_ ? ((MT) / 8) * (NT) : (MT) * (NT);                                           \
  _Pragma("unroll 1") for (int idx = tstart_; idx < ttotal_; idx += tstep_)
#define XCD_TILE_MT(idx, NT) (sw_ ? ((idx) / (NT)) * 8 + xcd_ : (idx) / (NT))
#define XCD_TILE_NT(idx, NT) ((idx) % (NT))

#define GEMM_LANE_VARS                                                    \
  const int tid = launder(threadIdx.x), lane = tid & 63, w = tid >> 6;    \
  const int wm = w >> 1, wn = w & 1, col = lane & 15, quad = lane >> 4;   \
  (void)wm; (void)wn; (void)col; (void)quad;

DEVI void phase1(const Params& p, unsigned char* smem) {
  u16* sA = (u16*)smem; u16* sB = sA + 128 * 72;
  XCD_TILE_LOOP(idx, 256 + 32, 19) {
    GEMM_LANE_VARS
    f32x4 acc[4][4];
    const int mt = XCD_TILE_MT(idx, 19), nt_ = XCD_TILE_NT(idx, 19);
    if (mt < 256) {
      const int m0 = mt * 128, n0 = nt_ * 128;
      gemm_mainloop<true>(tid, sA, sB, ARow{p.hn, LDA}, p.winT, LDA, m0, n0, 16, acc);
#pragma unroll
      for (int mi = 0; mi < 4; ++mi) {
        const int m = m0 + wm * 64 + 16 * mi + col;
        const int b = m >> 11, t = m & 2047;
#pragma unroll
        for (int ni = 0; ni < 4; ++ni) {
          const int nt = n0 + wn * 64 + 16 * ni;
          const int n = nt + 4 * quad;
          f32x4 v = acc[ni][mi];
          if (nt >= LDP) continue;
          if ((nt >= C_VS && nt < C_KW) || (nt >= C_VW && nt < C_GATE)) {
            const bool isw = nt >= C_VW;
            const int off = n - (isw ? C_VW : C_VS);
            const int g = off >> 6, d = off & 63;
            u16* dst = (isw ? p.vtw : p.vts) + ((size_t)(b * 2 + g) * 64 + d) * LDT + t;
#pragma unroll
            for (int r = 0; r < 4; ++r) dst[(size_t)r * LDT] = f2bf(v[r]);
          } else {
            const bool rope_tile = ((nt >= C_KS && nt < C_VS) || (nt >= C_KW && nt < C_VW)) && ((nt & 63) == 0);
            if (rope_tile) {
#pragma unroll
              for (int r = 0; r < 4; ++r) {
                const float pr = __shfl_xor(v[r], 32);
                const int i = ((quad & 1) << 2) + r;
                const float cs = p.rope[(size_t)m * 16 + i], sn = p.rope[(size_t)m * 16 + 8 + i];
                v[r] = (quad < 2) ? (v[r] * cs - pr * sn) : (v[r] * cs + pr * sn);
              }
            }
            uint2 pk; pk.x = pack2(v[0], v[1]); pk.y = pack2(v[2], v[3]);
            *(uint2*)(p.proj + (size_t)m * LDP + n) = pk;
          }
        }
      }
    } else if (nt_ < 16) {
      const int isv = nt_ >> 3;
      const int m0 = (mt - 256) * 128, n0 = (nt_ & 7) * 128;
      gemm_mainloop<true>(tid, sA, sB, ARow{p.memn, LDA}, isv ? p.wmvT : p.wmkT, LDA, m0, n0, 16, acc);
#pragma unroll
      for (int mi = 0; mi < 4; ++mi) {
        const int m = m0 + wm * 64 + 16 * mi + col;
        const int b = m >> 8, key = m & 255;
#pragma unroll
        for (int ni = 0; ni < 4; ++ni) {
          const int n = n0 + wn * 64 + 16 * ni + 4 * quad;
          const f32x4 v = acc[ni][mi];
          if (isv) {
            const int head = n >> 8, d = n & 255;
            u16* dst = p.memvt + ((size_t)(b * 4 + head) * 256 + d) * 256 + key;
#pragma unroll
            for (int r = 0; r < 4; ++r) dst[r * 256] = f2bf(v[r]);
          } else {
            uint2 pk; pk.x = pack2(v[0], v[1]); pk.y = pack2(v[2], v[3]);
            *(uint2*)(p.memk + (size_t)m * LDA + n) = pk;
          }
        }
      }
    }
  }
}

DEVI void conv_tile(const Params& p, unsigned char* smem, int ct) {
  u16* sU = (u16*)smem;
  float2* sRed = (float2*)(smem + 62 * 512 * 2);
  const int tid = launder(threadIdx.x), lane = tid & 63, w = tid >> 6;
  const int b = ct >> 6, t0 = (ct & 63) * 32;
  __syncthreads();
  for (int it = tid; it < 62 * 64; it += 256) {
    const int r = it >> 6, c8 = it & 63;
    const int t = t0 - 30 + r;
    uint4 pk = {0u, 0u, 0u, 0u};
    if (t >= 0) {
      const u16* src = p.proj + ((size_t)b * T + t) * LDP + c8 * 8;
      const uint4 a = *(const uint4*)src, bb = *(const uint4*)(src + 512);
      const unsigned au[4] = {a.x, a.y, a.z, a.w}, bu[4] = {bb.x, bb.y, bb.z, bb.w};
      unsigned o[4];
#pragma unroll
      for (int j = 0; j < 4; ++j) {
        const float a0 = __uint_as_float(au[j] << 16), a1 = __uint_as_float(au[j] & 0xffff0000u);
        const float b0 = __uint_as_float(bu[j] << 16), b1 = __uint_as_float(bu[j] & 0xffff0000u);
        o[j] = pack2(a0 * sigmoidf_(b0), a1 * sigmoidf_(b1));
      }
      pk.x = o[0]; pk.y = o[1]; pk.z = o[2]; pk.w = o[3];
    }
    *(uint4*)(sU + r * 512 + c8 * 8) = pk;
  }
  const int c = 2 * tid;
  float w0[31], w1[31];
#pragma unroll
  for (int j = 0; j < 31; ++j) { w0[j] = p.conv_w[j * 512 + c]; w1[j] = p.conv_w[j * 512 + c + 1]; }
  const float bd0 = p.conv_b[c], bd1 = p.conv_b[c + 1];
  __syncthreads();
  for (int tt = 0; tt < 32; ++tt) {
    float y0 = bd0, y1 = bd1;
#pragma unroll
    for (int j = 0; j < 31; ++j) {
      const unsigned uu = *(const unsigned*)(sU + (tt + j) * 512 + c);
      y0 += w0[j] * __uint_as_float(uu << 16);
      y1 += w1[j] * __uint_as_float(uu & 0xffff0000u);
    }
    float s = y0 + y1, q = y0 * y0 + y1 * y1;
    s = wave_sum(s); q = wave_sum(q);
    if (lane == 0) sRed[tt * 4 + w] = make_float2(s, q);
  }
  __syncthreads();
  const float g0 = p.ln_g[c], g1 = p.ln_g[c + 1], lb0 = p.ln_b[c], lb1 = p.ln_b[c + 1];
  for (int tt = 0; tt < 32; ++tt) {
    float y0 = bd0, y1 = bd1;
#pragma unroll
    for (int j = 0; j < 31; ++j) {
      const unsigned uu = *(const unsigned*)(sU + (tt + j) * 512 + c);
      y0 += w0[j] * __uint_as_float(uu << 16);
      y1 += w1[j] * __uint_as_float(uu & 0xffff0000u);
    }
    const float2 r0 = sRed[tt * 4 + 0], r1 = sRed[tt * 4 + 1], r2 = sRed[tt * 4 + 2], r3 = sRed[tt * 4 + 3];
    const float S = r0.x + r1.x + r2.x + r3.x, Q = r0.y + r1.y + r2.y + r3.y;
    const float mu = S * (1.f / 512.f);
    const float var = fmaxf(Q * (1.f / 512.f) - mu * mu, 0.f);
    const float rstd = rsqrtf(var + 1e-6f);
    const float z0 = (y0 - mu) * rstd * g0 + lb0, z1 = (y1 - mu) * rstd * g1 + lb1;
    const float o0 = z0 * sigmoidf_(z0), o1 = z1 * sigmoidf_(z1);
    *(unsigned*)(p.mix + ((size_t)b * T + t0 + tt) * LDA + c) = pack2(o0, o1);
  }
}

DEVI void phase2(const Params& p, unsigned char* smem) {
  u16* sA = (u16*)smem; u16* sB = sA + 128 * 72;
#pragma unroll 1
  for (int tile = blockIdx.x; tile < 64 + 1024; tile += gridDim.x) {
    GEMM_LANE_VARS
    if (tile < 64) {
      const int ty = tile >> 5, mt = tile & 31;
      const int m0 = mt * 128;
      f32x4 acc[4][4];
      gemm_mainloop<true>(tid, sA, sB, ACmp{p.proj, ty ? C_VC : C_KC}, p.w1T + (size_t)ty * 128 * LDW1, LDW1, m0, 0, 32, acc);
#pragma unroll
      for (int mi = 0; mi < 4; ++mi) {
        const int m = m0 + wm * 64 + 16 * mi + col;
#pragma unroll
        for (int ni = 0; ni < 4; ++ni) {
          const int n = wn * 64 + 16 * ni + 4 * quad;
          const f32x4 v = acc[ni][mi];
          const float4 bb = *(const float4*)(p.biasp + ty * 128 + n);
          uint2 pk;
          pk.x = pack2(gelu_tanh(v[0] + bb.x), gelu_tanh(v[1] + bb.y));
          pk.y = pack2(gelu_tanh(v[2] + bb.z), gelu_tanh(v[3] + bb.w));
          *(uint2*)(p.hdn + ((size_t)ty * 4096 + m) * 128 + n) = pk;
        }
      }
    } else {
      conv_tile(p, smem, tile - 64);
    }
  }
}

DEVI void phase3(const Params& p, unsigned char* smem) {
  u16* sA = (u16*)smem; u16* sB = sA + 128 * 72;
#pragma unroll 1
  for (int tile = blockIdx.x; tile < 64; tile += gridDim.x) {
    GEMM_LANE_VARS
    const int ty = tile >> 5, mt = tile & 31;
    const int m0 = mt * 128;
    f32x4 acc[4][4];
    gemm_mainloop<true>(tid, sA, sB, ARow{p.hdn + (size_t)ty * 4096 * 128, 128}, p.w2T + (size_t)ty * 128 * 128, 128, m0, 0, 2, acc);
    if (wn == 0) {
#pragma unroll
      for (int mi = 0; mi < 4; ++mi) {
        const int m = m0 + 16 * mi + wm * 64 + col;
        const int bg = m >> 7, c = m & 127;
#pragma unroll
        for (int ni = 0; ni < 4; ++ni) {
          const int n = 16 * ni + 4 * quad;
          const f32x4 v = acc[ni][mi];
          const float4 bb = *(const float4*)(p.cmp_b2 + ty * 64 + n);
          const float o0 = v[0] + bb.x, o1 = v[1] + bb.y, o2 = v[2] + bb.z, o3 = v[3] + bb.w;
          if (ty == 0) {
            uint2 pk; pk.x = pack2(o0, o1); pk.y = pack2(o2, o3);
            *(uint2*)(p.kc + (size_t)m * 64 + n) = pk;
          } else {
            u16* dst = p.vcT + ((size_t)bg * 64 + n) * 128 + c;
            dst[0] = f2bf(o0); dst[128] = f2bf(o1); dst[256] = f2bf(o2); dst[384] = f2bf(o3);
          }
        }
      }
    }
  }
}

template <int DH, int NQ, int LDK, int LDV, class MaskF>
DEVI void attn_tile(const u16* sK, const u16* sVt, const bf16x8 (&qf)[NQ][DH / 32], f32x4 (&o)[NQ][DH / 16],
                    float (&m)[NQ], float (&l)[NQ], float c2, int lane, MaskF valid) {
  const int col = lane & 15, quad = lane >> 4;
  f32x4 s[NQ][4];
#pragma unroll
  for (int kt = 0; kt < 4; ++kt) {
#pragma unroll
    for (int qt = 0; qt < NQ; ++qt) s[qt][kt] = f32x4{0.f, 0.f, 0.f, 0.f};
#pragma unroll
    for (int ks = 0; ks < DH / 32; ++ks) {
      const bf16x8 kf = *(const bf16x8*)(sK + (16 * kt + col) * LDK + 32 * ks + 8 * quad);
#pragma unroll
      for (int qt = 0; qt < NQ; ++qt) s[qt][kt] = mfma16(kf, qf[qt][ks], s[qt][kt]);
    }
  }
  bf16x8 pb[NQ][2];
#pragma unroll
  for (int qt = 0; qt < NQ; ++qt) {
    float mx = -1e30f;
#pragma unroll
    for (int kt = 0; kt < 4; ++kt)
#pragma unroll
      for (int r = 0; r < 4; ++r) {
        const bool v = valid(qt, 16 * kt + 4 * quad + r);
        const float sv = v ? s[qt][kt][r] : -1e30f;
        s[qt][kt][r] = sv;
        mx = fmaxf(mx, sv);
      }
    mx = fmaxf(mx, __shfl_xor(mx, 16));
    mx = fmaxf(mx, __shfl_xor(mx, 32));
    const float mn = fmaxf(m[qt], mx);
    const float alpha = fexp2((m[qt] - mn) * c2);
    m[qt] = mn;
    float ps = 0.f;
#pragma unroll
    for (int kt = 0; kt < 4; ++kt)
#pragma unroll
      for (int r = 0; r < 4; ++r) {
        const float sv = s[qt][kt][r];
        const float pv = (sv > -1e29f) ? fexp2((sv - mn) * c2) : 0.f;
        ps += pv;
        s[qt][kt][r] = pv;
      }
    l[qt] = l[qt] * alpha + ps;
#pragma unroll
    for (int dt = 0; dt < DH / 16; ++dt) o[qt][dt] *= alpha;
#pragma unroll
    for (int kk = 0; kk < 2; ++kk) {
      union { bf16x8 v; unsigned u[4]; } cv;
      cv.u[0] = pack2(s[qt][2 * kk][0], s[qt][2 * kk][1]);
      cv.u[1] = pack2(s[qt][2 * kk][2], s[qt][2 * kk][3]);
      cv.u[2] = pack2(s[qt][2 * kk + 1][0], s[qt][2 * kk + 1][1]);
      cv.u[3] = pack2(s[qt][2 * kk + 1][2], s[qt][2 * kk + 1][3]);
      pb[qt][kk] = cv.v;
    }
  }
#pragma unroll
  for (int dt = 0; dt < DH / 16; ++dt) {
#pragma unroll
    for (int kk = 0; kk < 2; ++kk) {
      union { bf16x8 v; uint2 h[2]; } cv;
      cv.h[0] = *(const uint2*)(sVt + (16 * dt + col) * LDV + 32 * kk + 4 * quad);
      cv.h[1] = *(const uint2*)(sVt + (16 * dt + col) * LDV + 32 * kk + 16 + 4 * quad);
#pragma unroll
      for (int qt = 0; qt < NQ; ++qt) o[qt][dt] = mfma16(cv.v, pb[qt][kk], o[qt][dt]);
    }
  }
}

DEVI void phase_nsa(const Params& p, unsigned char* smem) {
  u16* sK = (u16*)smem;
  u16* sVt = (u16*)(smem + 18432);
  float* impH = (float*)(smem + 35840);
  float* impT = (float*)(smem + 52736);
  unsigned* selm = (unsigned*)(smem + 56960);
  const float c2 = 0.125f * 1.4426950408889634f;
#pragma unroll 1
  for (int tile = blockIdx.x; tile < 2048; tile += gridDim.x) {
    const int tid = launder(threadIdx.x), lane = tid & 63, w = tid >> 6, col = lane & 15, quad = lane >> 4;
    const int qtile = 63 - (tile >> 5), bg = tile & 31, b = bg >> 1, g = bg & 1, q0 = qtile * 32;
    const int h = g * 4 + w;
    __syncthreads();
    if (tid < 32) selm[tid] = 0u;
    {
      const u16* kcp = p.kc + (size_t)bg * 128 * 64;
      const u16* vcp = p.vcT + (size_t)bg * 64 * 128;
#pragma unroll
      for (int i = 0; i < 4; ++i) {
        const int c = tid + 256 * i;
        const int row = c >> 3, ch = (c & 7) << 3;
        *(uint4*)(sK + row * 72 + ch) = *(const uint4*)(kcp + row * 64 + ch);
        const int row2 = c >> 4, ch2 = (c & 15) << 3;
        *(uint4*)(sVt + row2 * 136 + ch2) = *(const uint4*)(vcp + row2 * 128 + ch2);
      }
    }
    bf16x8 qf[2][2];
    float gate[2][3];
    int tq[2];
#pragma unroll
    for (int qt = 0; qt < 2; ++qt) {
      const int t = q0 + 16 * qt + col;
      tq[qt] = t;
      const size_t tok = (size_t)b * T + t;
      const u16* qp = p.proj + tok * LDP + C_Q + h * 64 + 8 * quad;
      qf[qt][0] = *(const bf16x8*)qp;
      qf[qt][1] = *(const bf16x8*)(qp + 32);
#pragma unroll
      for (int br = 0; br < 3; ++br) gate[qt][br] = sigmoidf_(bf2f(p.proj[tok * LDP + C_GATE + h * 3 + br]));
    }
    __syncthreads();

    f32x4 comb[2][4];
    {
      const int srcl = (lane + 48) & 63;
#pragma unroll
      for (int qt = 0; qt < 2; ++qt) {
        f32x4 s[8];
#pragma unroll
        for (int kt = 0; kt < 8; ++kt) {
          s[kt] = f32x4{0.f, 0.f, 0.f, 0.f};
#pragma unroll
          for (int ks = 0; ks < 2; ++ks) {
            const bf16x8 kf = *(const bf16x8*)(sK + (16 * kt + col) * 72 + 32 * ks + 8 * quad);
            s[kt] = mfma16(kf, qf[qt][ks], s[kt]);
          }
        }
        const int t = tq[qt];
        float mx = -1e30f;
#pragma unroll
        for (int kt = 0; kt < 8; ++kt)
#pragma unroll
          for (int r = 0; r < 4; ++r) {
            const int c = 16 * kt + 4 * quad + r;
            const bool v = (16 * c + 31) <= t;
            const float sv = v ? s[kt][r] : -1e30f;
            s[kt][r] = sv;
            mx = fmaxf(mx, sv);
          }
        mx = fmaxf(mx, __shfl_xor(mx, 16));
        mx = fmaxf(mx, __shfl_xor(mx, 32));
        float ps = 0.f;
#pragma unroll
        for (int kt = 0; kt < 8; ++kt)
#pragma unroll
          for (int r = 0; r < 4; ++r) {
            const float sv = s[kt][r];
            const float pv = (sv > -1e29f) ? fexp2((sv - mx) * c2) : 0.f;
            ps += pv;
            s[kt][r] = pv;
          }
        ps += __shfl_xor(ps, 16);
        ps += __shfl_xor(ps, 32);
        const float inv = ps > 0.f ? 1.f / ps : 0.f;
#pragma unroll
        for (int kt = 0; kt < 8; ++kt)
#pragma unroll
          for (int r = 0; r < 4; ++r) s[kt][r] *= inv;
        float prev3 = 0.f;
#pragma unroll
        for (int kt = 0; kt < 8; ++kt) {
          const float sum4 = s[kt][0] + s[kt][1] + s[kt][2] + s[kt][3];
          const float xs = __shfl(s[kt][3], srcl);
          const float extra = quad ? xs : prev3;
          prev3 = xs;
          impH[(w * 32 + 16 * qt + col) * 33 + 4 * kt + quad] = sum4 + extra;
        }
        bf16x8 pb[4];
#pragma unroll
        for (int kk = 0; kk < 4; ++kk) {
          union { bf16x8 v; unsigned u[4]; } cv;
          cv.u[0] = pack2(s[2 * kk][0], s[2 * kk][1]);
          cv.u[1] = pack2(s[2 * kk][2], s[2 * kk][3]);
          cv.u[2] = pack2(s[2 * kk + 1][0], s[2 * kk + 1][1]);
          cv.u[3] = pack2(s[2 * kk + 1][2], s[2 * kk + 1][3]);
          pb[kk] = cv.v;
        }
#pragma unroll
        for (int dt = 0; dt < 4; ++dt) {
          f32x4 oc = f32x4{0.f, 0.f, 0.f, 0.f};
#pragma unroll
          for (int kk = 0; kk < 4; ++kk) {
            union { bf16x8 v; uint2 hh[2]; } cv;
            cv.hh[0] = *(const uint2*)(sVt + (16 * dt + col) * 136 + 32 * kk + 4 * quad);
            cv.hh[1] = *(const uint2*)(sVt + (16 * dt + col) * 136 + 32 * kk + 16 + 4 * quad);
            oc = mfma16(cv.v, pb[kk], oc);
          }
          comb[qt][dt] = oc * gate[qt][0];
        }
      }
    }
#pragma unroll
    for (int qt = 0; qt < 2; ++qt) {
      const size_t tok = (size_t)b * T + tq[qt];
      union { bf16x8 v; unsigned u[4]; } own, par, res;
      own.v = qf[qt][0];
#pragma unroll
      for (int j = 0; j < 4; ++j) par.u[j] = (unsigned)__shfl_xor((int)own.u[j], 16);
      const float4 c0 = *(const float4*)(p.rope + tok * 16), c1 = *(const float4*)(p.rope + tok * 16 + 4);
      const float4 s0 = *(const float4*)(p.rope + tok * 16 + 8), s1 = *(const float4*)(p.rope + tok * 16 + 12);
      const float cs[8] = {c0.x, c0.y, c0.z, c0.w, c1.x, c1.y, c1.z, c1.w};
      const float sn[8] = {s0.x, s0.y, s0.z, s0.w, s1.x, s1.y, s1.z, s1.w};
#pragma unroll
      for (int j = 0; j < 4; ++j) {
        const float o0 = __uint_as_float(own.u[j] << 16), o1 = __uint_as_float(own.u[j] & 0xffff0000u);
        const float p0 = __uint_as_float(par.u[j] << 16), p1 = __uint_as_float(par.u[j] & 0xffff0000u);
        const float sg = (quad == 0) ? -1.f : 1.f;
        const float r0 = o0 * cs[2 * j] + sg * p0 * sn[2 * j];
        const float r1 = o1 * cs[2 * j + 1] + sg * p1 * sn[2 * j + 1];
        res.u[j] = (quad < 2) ? pack2(r0, r1) : own.u[j];
      }
      qf[qt][0] = res.v;
    }
    __syncthreads();
#pragma unroll
    for (int i = 0; i < 4; ++i) {
      const int cell = tid + 256 * i;
      const int qi = cell >> 5, s_ = cell & 31;
      const int cur = (q0 + qi) >> 6;
      float v = impH[(0 * 32 + qi) * 33 + s_] + impH[(1 * 32 + qi) * 33 + s_] + impH[(2 * 32 + qi) * 33 + s_] +
                impH[(3 * 32 + qi) * 33 + s_];
      const int dist = cur - s_;
      const bool forced = (s_ == 0) || (dist >= 0 && dist < 2);
      v = forced ? 1e9f : (s_ <= cur ? v : -1.f);
      impT[qi * 33 + s_] = v;
    }
    __syncthreads();
    {
      const int qi = tid >> 3, sub = tid & 7;
      unsigned bits = 0u;
#pragma unroll
      for (int k = 0; k < 4; ++k) {
        const int s_ = sub * 4 + k;
        const float v = impT[qi * 33 + s_];
        int rank = 0;
        for (int s2 = 0; s2 < 32; ++s2) {
          const float v2 = impT[qi * 33 + s2];
          rank += ((v2 > v) || (v2 == v && s2 < s_)) ? 1 : 0;
        }
        if (rank < 16) bits |= 1u << s_;
      }
      atomicOr(&selm[qi], bits);
    }
    __syncthreads();
    unsigned sm[2] = {selm[col], selm[16 + col]};
    unsigned uni = 0u;
#pragma unroll
    for (int i = 0; i < 32; ++i) uni |= selm[i];
    const int kbmax = (q0 + 31) >> 6;
    {
      float m[2] = {-1e30f, -1e30f}, l[2] = {0.f, 0.f};
      f32x4 o[2][4];
#pragma unroll
      for (int qt = 0; qt < 2; ++qt)
#pragma unroll
        for (int dt = 0; dt < 4; ++dt) o[qt][dt] = f32x4{0.f, 0.f, 0.f, 0.f};
      unsigned rem = (kbmax >= 31) ? uni : (uni & ((1u << (kbmax + 1)) - 1u));
      int kb = rem ? (__ffs((int)rem) - 1) : -1;
      uint4 rk0, rk1, rv0, rv1;
      const int lr0 = tid >> 3, lch = (tid & 7) << 3;
#define LOADKV_(kbx, CK, VT)                                                                                         \
      rk0 = *(const uint4*)(p.proj + ((size_t)b * T + (kbx) * 64 + lr0) * LDP + (CK) + g * 64 + lch);                 \
      rk1 = *(const uint4*)(p.proj + ((size_t)b * T + (kbx) * 64 + lr0 + 32) * LDP + (CK) + g * 64 + lch);            \
      rv0 = *(const uint4*)((VT) + ((size_t)bg * 64 + lr0) * LDT + (kbx) * 64 + lch);                                 \
      rv1 = *(const uint4*)((VT) + ((size_t)bg * 64 + lr0 + 32) * LDT + (kbx) * 64 + lch);
#define STOREKV_()                                                                                                   \
      *(uint4*)(sK + lr0 * 72 + lch) = rk0; *(uint4*)(sK + (lr0 + 32) * 72 + lch) = rk1;                              \
      *(uint4*)(sVt + lr0 * 72 + lch) = rv0; *(uint4*)(sVt + (lr0 + 32) * 72 + lch) = rv1;
      if (kb >= 0) { LOADKV_(kb, C_KS, p.vts) }
#pragma unroll 1
      while (kb >= 0) {
        rem &= rem - 1u;
        const int nkb = rem ? (__ffs((int)rem) - 1) : -1;
        __syncthreads();
        STOREKV_()
        if (nkb >= 0) { LOADKV_(nkb, C_KS, p.vts) }
        __syncthreads();
        attn_tile<64, 2, 72, 72>(sK, sVt, qf, o, m, l, c2, lane, [&](int qt, int kl) {
          const int kp = kb * 64 + kl;
          return (((sm[qt] >> kb) & 1u) != 0u) && (kp <= tq[qt]);
        });
        kb = nkb;
      }
#pragma unroll
      for (int qt = 0; qt < 2; ++qt) {
        float lt = l[qt];
        lt += __shfl_xor(lt, 16);
        lt += __shfl_xor(lt, 32);
        const float sc = lt > 0.f ? gate[qt][1] / lt : 0.f;
#pragma unroll
        for (int dt = 0; dt < 4; ++dt) comb[qt][dt] += o[qt][dt] * sc;
      }
    }
    {
      float m[2] = {-1e30f, -1e30f}, l[2] = {0.f, 0.f};
      f32x4 o[2][4];
#pragma unroll
      for (int qt = 0; qt < 2; ++qt)
#pragma unroll
        for (int dt = 0; dt < 4; ++dt) o[qt][dt] = f32x4{0.f, 0.f, 0.f, 0.f};
      const int kblo = (q0 >= 511) ? ((q0 - 511) >> 6) : 0;
      uint4 rk0, rk1, rv0, rv1;
      const int lr0 = tid >> 3, lch = (tid & 7) << 3;
      int kb = kblo;
      LOADKV_(kb, C_KW, p.vtw)
#pragma unroll 1
      while (kb >= 0) {
        const int nkb = (kb < kbmax) ? kb + 1 : -1;
        __syncthreads();
        STOREKV_()
        if (nkb >= 0) { LOADKV_(nkb, C_KW, p.vtw) }
        __syncthreads();
        attn_tile<64, 2, 72, 72>(sK, sVt, qf, o, m, l, c2, lane, [&](int qt, int kl) {
          const int kp = kb * 64 + kl;
          return (kp <= tq[qt]) && (kp > tq[qt] - 512);
        });
        kb = nkb;
      }
#undef LOADKV_
#undef STOREKV_
#pragma unroll
      for (int qt = 0; qt < 2; ++qt) {
        float lt = l[qt];
        lt += __shfl_xor(lt, 16);
        lt += __shfl_xor(lt, 32);
        const float sc = lt > 0.f ? gate[qt][2] / lt : 0.f;
#pragma unroll
        for (int dt = 0; dt < 4; ++dt) comb[qt][dt] += o[qt][dt] * sc;
      }
    }
#pragma unroll
    for (int qt = 0; qt < 2; ++qt) {
      const size_t tok = (size_t)b * T + tq[qt];
#pragma unroll
      for (int dt = 0; dt < 4; ++dt) {
        uint2 pk;
        pk.x = pack2(comb[qt][dt][0], comb[qt][dt][1]);
        pk.y = pack2(comb[qt][dt][2], comb[qt][dt][3]);
        *(uint2*)(p.mix + tok * LDA + 512 + h * 64 + 16 * dt + 4 * quad) = pk;
      }
    }
  }
}

template <bool RESB>
DEVI void phase_resid(const Params& p, unsigned char* smem, const u16* A, const u16* Wt, const float* res, float* ssq) {
  u16* sA = (u16*)smem; u16* sB = sA + 128 * 72;
  XCD_TILE_LOOP(idx, 256, 8) {
    GEMM_LANE_VARS
    const int mt = XCD_TILE_MT(idx, 8), nt_ = XCD_TILE_NT(idx, 8);
    const int m0 = mt * 128, n0 = nt_ * 128;
    f32x4 acc[4][4];
    gemm_mainloop<true>(tid, sA, sB, ARow{A, LDA}, Wt, LDA, m0, n0, 16, acc);
#pragma unroll
    for (int mi = 0; mi < 4; ++mi) {
      const int m = m0 + wm * 64 + 16 * mi + col;
      float ss = 0.f;
#pragma unroll
      for (int ni = 0; ni < 4; ++ni) {
        const int n = n0 + wn * 64 + 16 * ni + 4 * quad;
        const f32x4 v = acc[ni][mi];
        float4 r;
        if (RESB) {
          const uint2 rb = *(const uint2*)(p.hn + (size_t)m * LDA + n);
          r.x = __uint_as_float(rb.x << 16); r.y = __uint_as_float(rb.x & 0xffff0000u);
          r.z = __uint_as_float(rb.y << 16); r.w = __uint_as_float(rb.y & 0xffff0000u);
        } else {
          r = *(const float4*)(res + (size_t)m * D + n);
        }
        float4 hv;
        hv.x = r.x + v[0]; hv.y = r.y + v[1]; hv.z = r.z + v[2]; hv.w = r.w + v[3];
        ss += hv.x * hv.x + hv.y * hv.y + hv.z * hv.z + hv.w * hv.w;
        uint2 pk; pk.x = pack2(hv.x, hv.y); pk.y = pack2(hv.z, hv.w);
        *(uint2*)(p.hn + (size_t)m * LDA + n) = pk;
      }
      ss += __shfl_xor(ss, 16);
      ss += __shfl_xor(ss, 32);
      if (quad == 0) atomicAdd(ssq + m, ss);
    }
  }
}

DEVI void phase_scaled(const Params& p, unsigned char* smem, const u16* A, const u16* Wt, int ntn, const float* ssq, u16* outp, int ldo) {
  u16* sA = (u16*)smem; u16* sB = sA + 128 * 72;
  XCD_TILE_LOOP(idx, 256, ntn) {
    GEMM_LANE_VARS
    const int mt = XCD_TILE_MT(idx, ntn), nt_ = XCD_TILE_NT(idx, ntn);
    const int m0 = mt * 128, n0 = nt_ * 128;
    f32x4 acc[4][4];
    gemm_mainloop<true>(tid, sA, sB, ARow{A, LDA}, Wt, LDA, m0, n0, 16, acc);
#pragma unroll
    for (int mi = 0; mi < 4; ++mi) {
      const int m = m0 + wm * 64 + 16 * mi + col;
      const float rstd = rsqrtf(ssq[m] * (1.f / D) + 1e-6f);
#pragma unroll
      for (int ni = 0; ni < 4; ++ni) {
        const int n = n0 + wn * 64 + 16 * ni + 4 * quad;
        const f32x4 v = acc[ni][mi];
        uint2 pk; pk.x = pack2(v[0] * rstd, v[1] * rstd); pk.y = pack2(v[2] * rstd, v[3] * rstd);
        *(uint2*)(outp + (size_t)m * ldo + n) = pk;
      }
    }
  }
}

DEVI void phase_memattn(const Params& p, unsigned char* smem) {
  u16* sK = (u16*)smem;
  u16* sVt = (u16*)(smem + 33792);
  const float c2 = 0.0625f * 1.4426950408889634f;
#pragma unroll 1
  for (int tile = blockIdx.x; tile < 2048; tile += gridDim.x) {
    const int tid = launder(threadIdx.x), lane = tid & 63, w = tid >> 6, col = lane & 15, quad = lane >> 4;
    const int b = tile >> 7, head = (tile >> 5) & 3, q0 = (tile & 31) * 64;
    const size_t tok = (size_t)b * T + q0 + 16 * w + col;
    bf16x8 qf[1][8];
#pragma unroll
    for (int ks = 0; ks < 8; ++ks) qf[0][ks] = *(const bf16x8*)(p.qm + tok * LDA + head * 256 + 32 * ks + 8 * quad);
    float m[1] = {-1e30f}, l[1] = {0.f};
    f32x4 o[1][16];
#pragma unroll
    for (int dt = 0; dt < 16; ++dt) o[0][dt] = f32x4{0.f, 0.f, 0.f, 0.f};
#pragma unroll 1
    for (int kb = 0; kb < 4; ++kb) {
      __syncthreads();
#pragma unroll
      for (int i = 0; i < 8; ++i) {
        const int c = tid + 256 * i;
        const int row = c >> 5, ch = (c & 31) << 3;
        *(uint4*)(sK + row * 264 + ch) = *(const uint4*)(p.memk + ((size_t)b * 256 + kb * 64 + row) * LDA + head * 256 + ch);
      }
      __builtin_amdgcn_sched_barrier(0);
#pragma unroll
      for (int i = 0; i < 8; ++i) {
        const int c = tid + 256 * i;
        const int row2 = c >> 3, ch2 = (c & 7) << 3;
        *(uint4*)(sVt + row2 * 72 + ch2) = *(const uint4*)(p.memvt + ((size_t)(b * 4 + head) * 256 + row2) * 256 + kb * 64 + ch2);
      }
      __syncthreads();
      attn_tile<256, 1, 264, 72>(sK, sVt, qf, o, m, l, c2, lane, [&](int, int) { return true; });
    }
    float lt = l[0];
    lt += __shfl_xor(lt, 16);
    lt += __shfl_xor(lt, 32);
    const float inv = 1.f / lt;
#pragma unroll
    for (int dt = 0; dt < 16; ++dt) {
      uint2 pk;
      pk.x = pack2(o[0][dt][0] * inv, o[0][dt][1] * inv);
      pk.y = pack2(o[0][dt][2] * inv, o[0][dt][3] * inv);
      *(uint2*)(p.mix + tok * LDA + head * 256 + 16 * dt + 4 * quad) = pk;
    }
  }
}

__constant__ unsigned char kCandI[64] = {0,0,0,0,0,0,0,0,0,0,0,0,0,0,0,0, 1,1,1,1,1,1,1,1, 2,2,2,2,2, 3,3,3,3, 4,4,4, 5,5, 6,6, 7,7,
                                          8, 9, 10, 11, 12, 13, 14, 15, 0,0,0,0,0,0,0,0,0,0,0,0,0,0};
__constant__ unsigned char kCandJ[64] = {0,1,2,3,4,5,6,7,8,9,10,11,12,13,14,15, 0,1,2,3,4,5,6,7, 0,1,2,3,4, 0,1,2,3, 0,1,2, 0,1, 0,1, 0,1,
                                          0, 0, 0, 0, 0, 0, 0, 0, 0,0,0,0,0,0,0,0,0,0,0,0,0,0};

DEVI unsigned score_key(float v, int idx) {
  unsigned u = __float_as_uint(v);
  u = (u & 0x80000000u) ? ~u : (u | 0x80000000u);
  return (u & ~127u) | (unsigned)(127 - idx);
}
DEVI float key_score(unsigned k) {
  k &= ~127u;
  const unsigned u = (k & 0x80000000u) ? (k & 0x7fffffffu) : ~k;
  return __uint_as_float(u);
}

DEVI void phase_peer_route(const Params& p, unsigned char* smem) {
  u16* sA = (u16*)smem; u16* sB = sA + 128 * 72;
  unsigned* sScore = (unsigned*)smem;
  unsigned* sTop = (unsigned*)(smem + 36864);
  unsigned* sTmp = (unsigned*)(smem + 53248);
  {
    const int t0_ = launder(threadIdx.x);
    const int gw = (blockIdx.x * 256 + t0_) >> 6, nw = (gridDim.x * 256) >> 6;
    conv_fp8_rows(p.peer_u, p.ub8, p.uscale, 16384, gw, nw, t0_ & 63);
    conv_fp8_rows(p.peer_v, p.vb8, p.vscale, 16384, gw, nw, t0_ & 63);
  }
#pragma unroll 1
  for (int tile = blockIdx.x; tile < 256 * 8; tile += gridDim.x) {
    GEMM_LANE_VARS
    const int mt = tile >> 3, hd = tile & 7;
    const int m0 = mt * 128;
#pragma unroll 1
    for (int ph = 0; ph < 2; ++ph) {
      const int hp = hd * 2 + ph;
      f32x4 acc[4][4];
      __syncthreads();
      gemm_mainloop<false>(tid, sA, sB, ARow{p.pq + hp * 128, LDPQ}, p.subk + (size_t)hp * 128 * 128, 128, m0, 0, 2, acc);
#pragma unroll 1
      for (int hh = 0; hh < 2; ++hh) {
        if (wm == hh) {
#pragma unroll
          for (int mi = 0; mi < 4; ++mi) {
            const int row = 16 * mi + col;
#pragma unroll
            for (int ni = 0; ni < 4; ++ni) {
              const int n = wn * 64 + 16 * ni + 4 * quad;
              const f32x4 v = acc[ni][mi];
              uint4 kk;
              kk.x = score_key(v[0], n); kk.y = score_key(v[1], n + 1);
              kk.z = score_key(v[2], n + 2); kk.w = score_key(v[3], n + 3);
              *(uint4*)(sScore + row * 128 + n) = kk;
            }
          }
        }
        __syncthreads();
#pragma unroll 1
        for (int rg = 0; rg < 4; ++rg) {
          const int rbase = w * 16 + rg * 4;
          unsigned k0[4], k1[4], t0[4], t1[4], thr[4];
#pragma unroll
          for (int r = 0; r < 4; ++r) {
            k0[r] = sScore[(rbase + r) * 128 + lane];
            k1[r] = sScore[(rbase + r) * 128 + 64 + lane];
            t0[r] = ((k0[r] >> 16) << 7) | (k0[r] & 127u);
            t1[r] = ((k1[r] >> 16) << 7) | (k1[r] & 127u);
            thr[r] = 0u;
          }
#pragma unroll
          for (int bit = 22; bit >= 0; --bit) {
#pragma unroll
            for (int r = 0; r < 4; ++r) {
              const unsigned cand = thr[r] | (1u << bit);
              const int cnt = __popcll(__ballot(t0[r] >= cand)) + __popcll(__ballot(t1[r] >= cand));
              thr[r] = (cnt >= 16) ? cand : thr[r];
            }
          }
          unsigned* tmp = sTmp + w * 64;
#pragma unroll
          for (int r = 0; r < 4; ++r) {
            const unsigned long long b0 = __ballot(t0[r] >= thr[r]), b1 = __ballot(t1[r] >= thr[r]);
            const int pos0 = __builtin_amdgcn_mbcnt_hi((unsigned)(b0 >> 32), __builtin_amdgcn_mbcnt_lo((unsigned)b0, 0u));
            const int pos1 = __popcll(b0) + __builtin_amdgcn_mbcnt_hi((unsigned)(b1 >> 32), __builtin_amdgcn_mbcnt_lo((unsigned)b1, 0u));
            if (t0[r] >= thr[r]) tmp[r * 16 + pos0] = k0[r];
            if (t1[r] >= thr[r]) tmp[r * 16 + pos1] = k1[r];
          }
          __builtin_amdgcn_fence(__ATOMIC_RELEASE, "wavefront");
          __builtin_amdgcn_wave_barrier();
          __builtin_amdgcn_fence(__ATOMIC_ACQUIRE, "wavefront");
          {
            const int r = lane >> 4, ix = lane & 15;
            const unsigned mine = tmp[r * 16 + ix];
            const uint4 a = *(const uint4*)(tmp + r * 16), b = *(const uint4*)(tmp + r * 16 + 4), c = *(const uint4*)(tmp + r * 16 + 8),
                        d = *(const uint4*)(tmp + r * 16 + 12);
            const int rk = (a.x > mine) + (a.y > mine) + (a.z > mine) + (a.w > mine) + (b.x > mine) + (b.y > mine) + (b.z > mine) + (b.w > mine) +
                           (c.x > mine) + (c.y > mine) + (c.z > mine) + (c.w > mine) + (d.x > mine) + (d.y > mine) + (d.z > mine) + (d.w > mine);
            sTop[((hh * 64 + rbase + r) * 2 + ph) * 16 + rk] = mine;
          }
          __builtin_amdgcn_fence(__ATOMIC_RELEASE, "wavefront");
          __builtin_amdgcn_wave_barrier();
        }
        __syncthreads();
      }
    }
    const int ci = kCandI[lane], cj = kCandJ[lane];
    const bool act = lane < 50;
#pragma unroll 1
    for (int tg = 0; tg < 8; ++tg) {
      const int tb = w * 32 + tg * 4;
      unsigned k0[4], k1[4], ku[4], thr[4];
      float v[4];
#pragma unroll
      for (int r = 0; r < 4; ++r) {
        k0[r] = sTop[((tb + r) * 2 + 0) * 16 + ci];
        k1[r] = sTop[((tb + r) * 2 + 1) * 16 + cj];
        v[r] = key_score(k0[r]) + key_score(k1[r]);
        unsigned u = __float_as_uint(v[r]);
        u = (u & 0x80000000u) ? ~u : (u | 0x80000000u);
        ku[r] = act ? (((u >> 16) << 6) | (unsigned)(63 - lane)) : 0u;
        thr[r] = 0u;
      }
#pragma unroll
      for (int bit = 21; bit >= 0; --bit) {
#pragma unroll
        for (int r = 0; r < 4; ++r) {
          const unsigned cand = thr[r] | (1u << bit);
          const int cnt = __popcll(__ballot(ku[r] >= cand));
          thr[r] = (cnt >= 16) ? cand : thr[r];
        }
      }
#pragma unroll
      for (int r = 0; r < 4; ++r) {
        const bool sel = act && (ku[r] >= thr[r]);
        const unsigned long long ms = __ballot(sel);
        const int slot = __builtin_amdgcn_mbcnt_hi((unsigned)(ms >> 32), __builtin_amdgcn_mbcnt_lo((unsigned)ms, 0u));
        const float vmax = __int_as_float(__builtin_amdgcn_readlane(__float_as_int(v[r]), 0));
        const float e = sel ? __expf(v[r] - vmax) : 0.f;
        const float tot = wave_sum(e);
        if (sel) {
          const int eid = (127 - (int)(k0[r] & 127u)) * 128 + (127 - (int)(k1[r] & 127u));
          const size_t o = (size_t)(m0 + tb + r) * 128 + hd * 16 + slot;
          p.experts[o] = eid;
          p.gates[o] = e / tot;
        }
      }
    }
  }
}

DEVI void phase_peer_gather(const Params& p) {
  const int w0_ = threadIdx.x >> 6;
#pragma unroll 1
  for (int tok = blockIdx.x * 4 + w0_; tok < NTOK; tok += gridDim.x * 4) {
    const int tid = launder(threadIdx.x), lane = tid & 63;
    const uint4* hp4 = (const uint4*)(p.hn + (size_t)tok * LDA + lane * 16);
    float hv[16], xn[16], y[16];
    {
      const uint4 a0 = hp4[0], a1 = hp4[1];
      const unsigned hu[8] = {a0.x, a0.y, a0.z, a0.w, a1.x, a1.y, a1.z, a1.w};
#pragma unroll
      for (int i = 0; i < 8; ++i) { hv[2 * i] = __uint_as_float(hu[i] << 16); hv[2 * i + 1] = __uint_as_float(hu[i] & 0xffff0000u); }
    }
    float ss = 0.f;
#pragma unroll
    for (int i = 0; i < 16; ++i) ss += hv[i] * hv[i];
    ss = wave_sum(ss);
    const float rstd = rsqrtf(ss * (1.f / D) + 1e-6f);
    {
      const float4* g4 = (const float4*)p.peer_g + lane * 4;
      const float4 a0 = g4[0], a1 = g4[1], a2 = g4[2], a3 = g4[3];
      const float gg[16] = {a0.x, a0.y, a0.z, a0.w, a1.x, a1.y, a1.z, a1.w, a2.x, a2.y, a2.z, a2.w, a3.x, a3.y, a3.z, a3.w};
#pragma unroll
      for (int i = 0; i < 16; ++i) { xn[i] = hv[i] * rstd * gg[i]; y[i] = 0.f; }
    }
    const int e0 = p.experts[(size_t)tok * 128 + lane], e1 = p.experts[(size_t)tok * 128 + 64 + lane];
    const float g0 = p.gates[(size_t)tok * 128 + lane], g1 = p.gates[(size_t)tok * 128 + 64 + lane];
    const float su0 = p.uscale[e0], su1 = p.uscale[e1];
    const float sv0 = p.vscale[e0], sv1 = p.vscale[e1];
    float cf0 = 0.f, cf1 = 0.f, dsum = 0.f;
    uint4 ca[8], cb[8];
#define LOADB_(R, bi)                                                                                   \
    _Pragma("unroll") for (int u = 0; u < 8; ++u) {                                                       \
      const int kk_ = (((bi) & 7) << 3) + u;                                                             \
      const int e_ = __builtin_amdgcn_readlane((((bi) >> 3) & 1) ? e1 : e0, kk_);                        \
      R[u] = ((const uint4*)((((bi) >> 4) ? p.vb8 : p.ub8) + (size_t)e_ * 1024))[lane];                  \
    }
#define COMPU_(R, bi)                                                                                   \
    {                                                                                                    \
      float d8[8];                                                                                       \
      _Pragma("unroll") for (int u = 0; u < 8; ++u) {                                                     \
        const unsigned uu[4] = {R[u].x, R[u].y, R[u].z, R[u].w};                                         \
        f32x2 a2 = {0.f, 0.f};                                                                           \
        _Pragma("unroll") for (int j = 0; j < 4; ++j) {                                                   \
          const f32x2 lo = __builtin_amdgcn_cvt_pk_f32_fp8((int)uu[j], false);                           \
          const f32x2 hi = __builtin_amdgcn_cvt_pk_f32_fp8((int)uu[j], true);                            \
          a2 = xn2[2 * j] * lo + a2;                                                                     \
          a2 = xn2[2 * j + 1] * hi + a2;                                                                 \
        }                                                                                                \
        d8[u] = a2[0] + a2[1];                                                                           \
      }                                                                                                  \
          \
      float v4[4], v2[2];                                                                                \
      _Pragma("unroll") for (int i = 0; i < 4; ++i) {                                                     \
        const float snd = b5 ? d8[i] : d8[4 + i], kp = b5 ? d8[4 + i] : d8[i];                           \
        v4[i] = kp + __shfl_xor(snd, 32);                                                                \
      }                                                                                                  \
      _Pragma("unroll") for (int i = 0; i < 2; ++i) {                                                     \
        const float snd = b4 ? v4[i] : v4[2 + i], kp = b4 ? v4[2 + i] : v4[i];                           \
        v2[i] = kp + __shfl_xor(snd, 16);                                                                \
      }                                                                                                  \
      float v1;                                                                                          \
      { const float snd = b3 ? v2[0] : v2[1], kp = b3 ? v2[1] : v2[0]; v1 = kp + __shfl_xor(snd, 8); }   \
      v1 += __shfl_xor(v1, 4);                                                                           \
      v1 += __shfl_xor(v1, 2);                                                                           \
      v1 += __shfl_xor(v1, 1);                                                                           \
                \
      const float got = __shfl(v1, fsrc);                                                                \
      if ((lane >> 3) == ((bi) & 7)) dsum = got;                                                         \
    }                                                                                                    \
    if (((bi) & 7) == 7) {                                                                               \
      if (((bi) >> 3) & 1) cf1 = gelu_tanh(dsum * su1) * g1 * sv1; else cf0 = gelu_tanh(dsum * su0) * g0 * sv0; \
    }
#define COMPV_(R, bi)                                                                                   \
    _Pragma("unroll") for (int u = 0; u < 8; ++u) {                                                       \
      const int kk_ = (((bi) & 7) << 3) + u;                                                             \
      const float ck_ = __int_as_float(__builtin_amdgcn_readlane(__float_as_int((((bi) >> 3) & 1) ? cf1 : cf0), kk_)); \
      const f32x2 ck2 = {ck_, ck_};                                                                      \
      const unsigned uu[4] = {R[u].x, R[u].y, R[u].z, R[u].w};                                           \
      _Pragma("unroll") for (int j = 0; j < 4; ++j) {                                                     \
        const f32x2 lo = __builtin_amdgcn_cvt_pk_f32_fp8((int)uu[j], false);                             \
        const f32x2 hi = __builtin_amdgcn_cvt_pk_f32_fp8((int)uu[j], true);                              \
        y2[2 * j] = ck2 * lo + y2[2 * j];                                                                \
        y2[2 * j + 1] = ck2 * hi + y2[2 * j + 1];                                                        \
      }                                                                                                  \
    }
    const bool b5 = (lane & 32) != 0, b4 = (lane & 16) != 0, b3 = (lane & 8) != 0;
    const int fsrc = ((lane & 4) << 3) | ((lane & 2) << 3) | ((lane & 1) << 3);
    f32x2 xn2[8], y2[8];
#pragma unroll
    for (int i = 0; i < 8; ++i) { xn2[i] = f32x2{xn[2 * i], xn[2 * i + 1]}; y2[i] = f32x2{0.f, 0.f}; }
    LOADB_(ca, 0)
#pragma unroll 1
    for (int bi = 0; bi < 16; bi += 2) {
      LOADB_(cb, bi + 1)
      COMPU_(ca, bi)
      LOADB_(ca, bi + 2)
      COMPU_(cb, bi + 1)
    }
#pragma unroll 1
    for (int bi = 16; bi < 32; bi += 2) {
      LOADB_(cb, bi + 1)
      COMPV_(ca, bi)
      if (bi + 2 < 32) { LOADB_(ca, bi + 2) }
      COMPV_(cb, bi + 1)
    }
#undef LOADB_
#undef COMPU_
#undef COMPV_
#pragma unroll
    for (int i = 0; i < 8; ++i) { y[2 * i] = y2[i][0]; y[2 * i + 1] = y2[i][1]; }
    float s2 = 0.f;
    {
      const uint4 a0 = hp4[0], a1 = hp4[1];
      const unsigned hu[8] = {a0.x, a0.y, a0.z, a0.w, a1.x, a1.y, a1.z, a1.w};
#pragma unroll
      for (int i = 0; i < 8; ++i) {
        y[2 * i] += __uint_as_float(hu[i] << 16);
        y[2 * i + 1] += __uint_as_float(hu[i] & 0xffff0000u);
        s2 += y[2 * i] * y[2 * i] + y[2 * i + 1] * y[2 * i + 1];
      }
    }
    s2 = wave_sum(s2);
    const float rs2 = rsqrtf(s2 * (1.f / D) + 1e-6f);
    {
      const float4* g4 = (const float4*)p.final_g + lane * 4;
      const float4 a0 = g4[0], a1 = g4[1], a2 = g4[2], a3 = g4[3];
      float4* o4 = (float4*)(p.out + (size_t)tok * D) + lane * 4;
      o4[0] = make_float4(y[0] * rs2 * a0.x, y[1] * rs2 * a0.y, y[2] * rs2 * a0.z, y[3] * rs2 * a0.w);
      o4[1] = make_float4(y[4] * rs2 * a1.x, y[5] * rs2 * a1.y, y[6] * rs2 * a1.z, y[7] * rs2 * a1.w);
      o4[2] = make_float4(y[8] * rs2 * a2.x, y[9] * rs2 * a2.y, y[10] * rs2 * a2.z, y[11] * rs2 * a2.w);
      o4[3] = make_float4(y[12] * rs2 * a3.x, y[13] * rs2 * a3.y, y[14] * rs2 * a3.z, y[15] * rs2 * a3.w);
    }
  }
}

#define XB_TMO      128
#define XB_XCNT(j)  (256  + 64 * (j))
#define XB_XSUB(j)  (1280 + 64 * (j))
#define XB_XGEN(j)  (2304 + 64 * (j))
#define XB_TOP      3328
#define XB_TOPGEN   3392
#define XCD_BAR_WORDS 3456
#define XB_SPIN_CAP (1u << 20)
#define LAS __attribute__((address_space(3)))
DEVI unsigned xb_ld(unsigned* q) { return __hip_atomic_load(q, __ATOMIC_RELAXED, __HIP_MEMORY_SCOPE_AGENT); }
DEVI unsigned xb_add(unsigned* q, unsigned v) { return __hip_atomic_fetch_add(q, v, __ATOMIC_RELAXED, __HIP_MEMORY_SCOPE_AGENT); }
DEVI unsigned xb_xcc_id() { return (unsigned)__builtin_amdgcn_s_getreg((3 << 11) | 20) & 0xFu; }
#define XB_SPIN(cond, bar) do { unsigned _sp = 0; while (cond) { __builtin_amdgcn_s_sleep(1); \
    if ((++_sp & 255u) == 0u) { if (xb_ld(&(bar)[XB_TMO])) break; if (_sp > XB_SPIN_CAP) { atomicAdd(&(bar)[XB_TMO], 1u); break; } } } } while (0)
struct XcdBarrier { unsigned* bar; unsigned x; volatile LAS unsigned* st; };
DEVI XcdBarrier xcd_barrier_post(unsigned* bar, volatile LAS unsigned* st) {
  XcdBarrier b; b.bar = bar; b.x = xb_xcc_id(); b.st = st;
  if (threadIdx.x == 0) (void)xb_add(&bar[XB_XCNT(b.x)], 1u);
  return b;
}
DEVI void xcd_barrier_complete(unsigned* bar, unsigned x, unsigned& nloc, unsigned& nx) {
  const unsigned G = gridDim.x * gridDim.y * gridDim.z;
  unsigned sum, cnt, mine, sp = 0u;
  for (;;) {
    sum = 0u; cnt = 0u; mine = 0u;
#pragma unroll
    for (unsigned j = 0; j < 16; ++j) { const unsigned c = xb_ld(&bar[XB_XCNT(j)]); sum += c; cnt += (c > 0u) ? 1u : 0u; mine = (j == x) ? c : mine; }
    if (sum == G) break;
    __builtin_amdgcn_s_sleep(1);
    if ((++sp & 255u) == 0u) { if (xb_ld(&bar[XB_TMO])) break; if (sp > XB_SPIN_CAP) { atomicAdd(&bar[XB_TMO], 1u); break; } }
  }
  nloc = mine > 0u ? mine : 1u; nx = cnt > 0u ? cnt : 1u;
}
DEVI void xcd_barrier(const XcdBarrier& b) {
  asm volatile("s_waitcnt vmcnt(0)" ::: "memory");
  __syncthreads();
  if (threadIdx.x == 0) {
    unsigned* bar = b.bar;
    __builtin_amdgcn_s_waitcnt(0);
    unsigned nloc = b.st[0], nx = b.st[1];
    if (nloc == 0u) { xcd_barrier_complete(bar, b.x, nloc, nx); b.st[0] = nloc; b.st[1] = nx; }
    const unsigned old = xb_add(&bar[XB_XSUB(b.x)], 1u);
    const unsigned gen = old / nloc;
    if (old + 1u == (gen + 1u) * nloc) {
      __builtin_amdgcn_fence(__ATOMIC_RELEASE, "agent");
      asm volatile("s_waitcnt vmcnt(0)" ::: "memory");
      const unsigned og = xb_add(&bar[XB_TOP], 1u);
      const unsigned tg = og / nx;
      if (og + 1u == (tg + 1u) * nx) xb_add(&bar[XB_TOPGEN], 1u);
      else XB_SPIN(xb_ld(&bar[XB_TOPGEN]) == tg, bar);
      __builtin_amdgcn_fence(__ATOMIC_ACQUIRE, "agent");
      xb_add(&bar[XB_XGEN(b.x)], 1u);
      asm volatile("s_waitcnt vmcnt(0)" ::: "memory");
    } else {
      XB_SPIN(xb_ld(&bar[XB_XGEN(b.x)]) == gen, bar);
      __builtin_amdgcn_fence(__ATOMIC_ACQUIRE, "agent");
      asm volatile("s_waitcnt vmcnt(0)" ::: "memory");
    }
  }
  __syncthreads();
}

template <bool COOP>
__global__ void __launch_bounds__(256, 2) mega(Params p, int ph_lo, int ph_hi) {
  __shared__ __attribute__((aligned(16))) unsigned char smem[SMEM_BYTES];
  __shared__ uint4 xb_words;
  if (threadIdx.x == 0) xb_words = make_uint4(0u, 0u, 0u, 0u);
  __syncthreads();
  XcdBarrier xb = xcd_barrier_post(p.bar, (volatile LAS unsigned*)&xb_words);
  (void)xb;
  if (COOP && ph_hi > 1000) cg::this_grid().sync();
#ifdef REPEAT_MASK
#define RUN_PHASE(i, call)                                                                   \
  if (ph_lo <= (i) && (i) <= ph_hi) {                                                        \
    call;                                                                                    \
    if (COOP && ((REPEAT_MASK >> (i)) & 1)) { cg::this_grid().sync(); call; }                \
    if (COOP && (i) < ph_hi) cg::this_grid().sync();                                         \
  }
#else
#define RUN_PHASE(i, call)                                                                   \
  if (ph_lo <= (i) && (i) <= ph_hi) {                                                        \
    call;                                                                                    \
    if (COOP && (i) < ph_hi) {                                                               \
      xcd_barrier(xb);                                                                       \
    }                                                                                        \
  }
#endif
  RUN_PHASE(0, phase0(p))
  RUN_PHASE(1, phase1(p, smem))
  RUN_PHASE(2, phase2(p, smem))
  RUN_PHASE(3, phase3(p, smem))
  RUN_PHASE(4, phase_nsa(p, smem))
  RUN_PHASE(5, phase_resid<false>(p, smem, p.mix, p.woutT, p.x, p.ssq1))
  RUN_PHASE(6, phase_scaled(p, smem, p.hn, p.wmqT, 8, p.ssq1, p.qm, LDA))
  RUN_PHASE(7, phase_memattn(p, smem))
  RUN_PHASE(8, phase_resid<true>(p, smem, p.mix, p.wmoT, nullptr, p.ssq2))
  RUN_PHASE(9, phase_scaled(p, smem, p.hn, p.wpqT, 16, p.ssq2, p.pq, LDPQ))
  RUN_PHASE(10, phase_peer_route(p, smem))
  RUN_PHASE(11, phase_peer_gather(p))
#undef RUN_PHASE
}

extern "C" void kernel_launch(void* const* d_in, const int* in_sizes, int n_in, void* d_out, int out_size, void* d_ws,
                              size_t ws_size, hipStream_t stream) {
  (void)in_sizes; (void)n_in; (void)out_size; (void)ws_size;
  Params p{};
  p.x = (const float*)d_in[0]; p.mem = (const float*)d_in[1]; p.pos = (const int*)d_in[2];
  p.mix_g = (const float*)d_in[3]; p.w_in = (const float*)d_in[4]; p.conv_w = (const float*)d_in[5];
  p.conv_b = (const float*)d_in[6]; p.ln_g = (const float*)d_in[7]; p.ln_b = (const float*)d_in[8];
  p.cmp_pos = (const float*)d_in[9]; p.cmp_w1 = (const float*)d_in[10]; p.cmp_b1 = (const float*)d_in[11];
  p.cmp_w2 = (const float*)d_in[12]; p.cmp_b2 = (const float*)d_in[13]; p.w_out = (const float*)d_in[14];
  p.memq_g = (const float*)d_in[15]; p.memkv_g = (const float*)d_in[16]; p.w_mq = (const float*)d_in[17];
  p.w_mk = (const float*)d_in[18]; p.w_mv = (const float*)d_in[19]; p.w_mo = (const float*)d_in[20];
  p.peer_g = (const float*)d_in[21]; p.peer_wq = (const float*)d_in[22]; p.peer_sk = (const float*)d_in[23];
  p.peer_u = (const float*)d_in[24]; p.peer_v = (const float*)d_in[25]; p.final_g = (const float*)d_in[26];
  p.out = (float*)d_out;
  unsigned char* ws = (unsigned char*)d_ws;
  size_t off = 0;
  auto take = [&](size_t bytes) { unsigned char* r = ws + off; off += (bytes + 255) & ~(size_t)255; return r; };
  unsigned char* regA = take((size_t)NTOK * LDA * 2);
  unsigned char* regB = take((size_t)NTOK * LDP * 2);
  unsigned char* regC = take((size_t)NTOK * LDA * 2);
  p.hn = (u16*)regA;
  p.proj = (u16*)regB; p.qm = (u16*)regB; p.pq = (u16*)regB;
  p.mix = (u16*)regC; p.experts = (int*)regC; p.gates = (float*)(regC + (size_t)NTOK * 128 * 4);
  {
    unsigned char* tb = regC + (size_t)2 * NTOK * 128 * 4;
    p.ub8 = tb; p.vb8 = tb + (size_t)16384 * 1024;
    p.uscale = (float*)(tb + (size_t)2 * 16384 * 1024); p.vscale = p.uscale + 16384;
  }
  p.h = nullptr;
  p.vts = (u16*)take((size_t)Bn * 2 * 64 * LDT * 2);
  p.vtw = (u16*)take((size_t)Bn * 2 * 64 * LDT * 2);
  p.memn = (u16*)take((size_t)Bn * 256 * LDA * 2);
  p.memk = (u16*)take((size_t)Bn * 256 * LDA * 2);
  p.memvt = (u16*)take((size_t)Bn * 256 * D * 2);
  p.winT = (u16*)take((size_t)2432 * LDA * 2);
  p.woutT = (u16*)take((size_t)1024 * LDA * 2);
  p.wmqT = (u16*)take((size_t)1024 * LDA * 2);
  p.wmkT = (u16*)take((size_t)1024 * LDA * 2);
  p.wmvT = (u16*)take((size_t)1024 * LDA * 2);
  p.wmoT = (u16*)take((size_t)1024 * LDA * 2);
  p.wpqT = (u16*)take((size_t)2048 * LDA * 2);
  p.subk = (u16*)take((size_t)16 * 128 * 128 * 2);
  p.w1T = (u16*)take((size_t)2 * 128 * LDW1 * 2);
  p.w2T = (u16*)take((size_t)2 * 128 * 128 * 2);
  p.biasp = (float*)take(256 * 4);
  p.rope = (float*)take((size_t)NTOK * 16 * 4);
  p.hdn = (u16*)take((size_t)2 * 4096 * 128 * 2);
  p.kc = (u16*)take((size_t)Bn * 2 * 128 * 64 * 2);
  p.vcT = (u16*)take((size_t)Bn * 2 * 64 * 128 * 2);
  p.ssq1 = (float*)take((size_t)NTOK * 4);
  p.ssq2 = (float*)take((size_t)NTOK * 4);
  p.bar = (unsigned*)take(16384);
  if (off > ws_size) { fprintf(stderr, "workspace too small: need %zu have %zu\n", off, ws_size); return; }

#if COOP_MODE
  static int grid_blocks = 0;
  if (!grid_blocks) {
    int dev = 0, cus = 0, per_cu = 0;
    hipGetDevice(&dev);
    hipDeviceGetAttribute(&cus, hipDeviceAttributeMultiprocessorCount, dev);
    hipOccupancyMaxActiveBlocksPerMultiprocessor(&per_cu, mega<true>, 256, 0);
    if (per_cu > 2) per_cu = 2;
    if (per_cu < 1) per_cu = 1;
    grid_blocks = cus * per_cu;
  }
  int lo = 0, hi = NPHASE;
  void* args[] = {&p, &lo, &hi};
  (void)hipMemsetAsync(p.bar, 0, 16384, stream);
  hipError_t e = hipLaunchCooperativeKernel((void*)mega<true>, dim3(grid_blocks), dim3(256), args, 0, stream);
  if (e != hipSuccess) fprintf(stderr, "cooperative launch failed: %s (grid %d)\n", hipGetErrorString(e), grid_blocks);
#else
  for (int ph = 0; ph <= NPHASE; ++ph) mega<false><<<dim3(512), dim3(256), 0, stream>>>(p, ph, ph);
#endif
}
```

```cpp
#include <hip/hip_runtime.h>
#include <hip/hip_bf16.h>
#include <hip/hip_cooperative_groups.h>
#include <cstdio>
#include <cstdint>
namespace cg = cooperative_groups;

#ifndef COOP_MODE
#define COOP_MODE 1
#endif

typedef __attribute__((ext_vector_type(8))) short bf16x8;
typedef __attribute__((ext_vector_type(4))) short bf16x4;
typedef __attribute__((ext_vector_type(4))) float f32x4;
typedef unsigned short u16;

#define DEVI __device__ __forceinline__

constexpr int Bn = 16, T = 2048, D = 1024, NTOK = Bn * T, LDP = 2336;
constexpr int C_Q = 1024, C_KC = 1536, C_VC = 1664, C_KS = 1792, C_VS = 1920, C_KW = 2048, C_VW = 2176, C_GATE = 2304;
constexpr int SMEM_BYTES = 73728;
constexpr int LDA = 1088;
constexpr int LDHF = 1056;
constexpr int LDPQ = 2112;
constexpr int LDW1 = 2112;
constexpr int LDT = 2112;
constexpr int NPHASE = 12;

struct Params {
  const float* x; const float* mem; const int* pos; const float* mix_g; const float* w_in;
  const float* conv_w; const float* conv_b; const float* ln_g; const float* ln_b;
  const float* cmp_pos; const float* cmp_w1; const float* cmp_b1; const float* cmp_w2; const float* cmp_b2;
  const float* w_out; const float* memq_g; const float* memkv_g; const float* w_mq; const float* w_mk;
  const float* w_mv; const float* w_mo; const float* peer_g; const float* peer_wq; const float* peer_sk;
  const float* peer_u; const float* peer_v; const float* final_g;
  float* out;
  u16* hn; u16* proj; u16* mix; float* h; u16* vts; u16* vtw; u16* memn; u16* memk; u16* memvt;
  u16* winT; u16* woutT; u16* wmqT; u16* wmkT; u16* wmvT; u16* wmoT; u16* wpqT; u16* subk; u16* w1T; u16* w2T;
  float* biasp; float* rope; u16* hdn; u16* kc; u16* vcT; float* ssq1; float* ssq2;
  int* experts; float* gates; unsigned char* ub8; unsigned char* vb8; float* uscale; float* vscale; u16* qm; u16* pq;
  unsigned* bar;
};

DEVI int launder(int x) { asm volatile("" : "+v"(x)); return x; }
DEVI u16 f2bf(float f) {
  unsigned u = __float_as_uint(f);
  u += 0x7fffu + ((u >> 16) & 1u);
  return (u16)(u >> 16);
}
DEVI float bf2f(u16 h) { return __uint_as_float(((unsigned)h) << 16); }
DEVI unsigned pack2(float a, float b) { return (unsigned)f2bf(a) | ((unsigned)f2bf(b) << 16); }
DEVI float wave_sum(float v) {
#pragma unroll
  for (int o = 32; o; o >>= 1) v += __shfl_xor(v, o);
  return v;
}
DEVI float sigmoidf_(float x) { return 1.f / (1.f + __expf(-x)); }
DEVI float gelu_tanh(float x) {
  float u = 0.7978845608028654f * (x + 0.044715f * x * x * x);
  return 0.5f * x * (1.f + tanhf(u));
}
DEVI f32x4 mfma16(bf16x8 a, bf16x8 b, f32x4 c) { return __builtin_amdgcn_mfma_f32_16x16x32_bf16(a, b, c, 0, 0, 0); }
DEVI float fexp2(float x) { return __builtin_amdgcn_exp2f(x); }

DEVI void tconv(const float* __restrict__ src, int K, int N, u16* __restrict__ dst, int Npad, int ldd,
                const float* __restrict__ gain, int gtid, int gsz) {
  const int items = Npad * (K >> 3);
  for (int it = gtid; it < items; it += gsz) {
    const int n = it % Npad, kc = it / Npad;
    float f[8];
#pragma unroll
    for (int j = 0; j < 8; ++j) {
      float v = 0.f;
      if (n < N) {
        v = src[(size_t)(kc * 8 + j) * N + n];
        if (gain) v *= gain[kc * 8 + j];
      }
      f[j] = v;
    }
    uint4 pk;
    pk.x = pack2(f[0], f[1]); pk.y = pack2(f[2], f[3]); pk.z = pack2(f[4], f[5]); pk.w = pack2(f[6], f[7]);
    *(uint4*)(dst + (size_t)n * ldd + kc * 8) = pk;
  }
}

DEVI void conv_flat(const float* __restrict__ src, u16* __restrict__ dst, size_t n8, size_t gtid, size_t gsz) {
  for (size_t it = gtid; it < n8; it += gsz) {
    const float4 a = ((const float4*)src)[2 * it], b = ((const float4*)src)[2 * it + 1];
    uint4 pk;
    pk.x = pack2(a.x, a.y); pk.y = pack2(a.z, a.w); pk.z = pack2(b.x, b.y); pk.w = pack2(b.z, b.w);
    ((uint4*)dst)[it] = pk;
  }
}


typedef float f32x2 __attribute__((ext_vector_type(2)));
DEVI unsigned pk4_fp8(float a, float b, float c, float d) {
  int v = 0;
  v = __builtin_amdgcn_cvt_pk_fp8_f32(a, b, v, false);
  v = __builtin_amdgcn_cvt_pk_fp8_f32(c, d, v, true);
  return (unsigned)v;
}
DEVI void conv_fp8_rows(const float* __restrict__ src, unsigned char* __restrict__ dst, float* __restrict__ inv_scale,
                        int rows, int gw, int nw, int lane) {
  for (int r0 = gw; r0 < rows; r0 += 2 * nw) {
    const int r1 = r0 + nw;
    const bool has1 = r1 < rows;
    const float4* p0 = (const float4*)(src + (size_t)r0 * 1024) + lane * 4;
    const float4* p1 = (const float4*)(src + (size_t)(has1 ? r1 : r0) * 1024) + lane * 4;
    float4 v[2][4];
#pragma unroll
    for (int i = 0; i < 4; ++i) { v[0][i] = p0[i]; v[1][i] = p1[i]; }
    float mx[2];
#pragma unroll
    for (int q = 0; q < 2; ++q) {
      float m = 0.f;
#pragma unroll
      for (int i = 0; i < 4; ++i)
        m = fmaxf(m, fmaxf(fmaxf(fabsf(v[q][i].x), fabsf(v[q][i].y)), fmaxf(fabsf(v[q][i].z), fabsf(v[q][i].w))));
      mx[q] = m;
    }
#pragma unroll
    for (int o = 32; o; o >>= 1) { mx[0] = fmaxf(mx[0], __shfl_xor(mx[0], o)); mx[1] = fmaxf(mx[1], __shfl_xor(mx[1], o)); }
#pragma unroll
    for (int q = 0; q < 2; ++q) {
      if (q == 1 && !has1) break;
      const int r = q ? r1 : r0;
      const float sc = mx[q] > 0.f ? 224.f / mx[q] : 1.f;
      if (lane == 0) inv_scale[r] = mx[q] > 0.f ? mx[q] * (1.f / 224.f) : 1.f;
      uint4 o4;
      o4.x = pk4_fp8(v[q][0].x * sc, v[q][0].y * sc, v[q][0].z * sc, v[q][0].w * sc);
      o4.y = pk4_fp8(v[q][1].x * sc, v[q][1].y * sc, v[q][1].z * sc, v[q][1].w * sc);
      o4.z = pk4_fp8(v[q][2].x * sc, v[q][2].y * sc, v[q][2].z * sc, v[q][2].w * sc);
      o4.w = pk4_fp8(v[q][3].x * sc, v[q][3].y * sc, v[q][3].z * sc, v[q][3].w * sc);
      ((uint4*)(dst + (size_t)r * 1024))[lane] = o4;
    }
  }
}

DEVI void rownorm_bf16(const float* __restrict__ src, const float* __restrict__ g, u16* __restrict__ dst,
                       int rows, int gw, int nw, int lane) {
  for (int r0 = gw; r0 < rows; r0 += 2 * nw) {
    const int r1 = r0 + nw;
    const bool has1 = r1 < rows;
    const float4* pa = (const float4*)(src + (size_t)r0 * D);
    const float4* pb = (const float4*)(src + (size_t)(has1 ? r1 : r0) * D);
    float4 va[4], vb[4];
    float sa = 0.f, sb = 0.f;
#pragma unroll
    for (int i = 0; i < 4; ++i) { va[i] = pa[lane + 64 * i]; vb[i] = pb[lane + 64 * i]; }
#pragma unroll
    for (int i = 0; i < 4; ++i) {
      sa += va[i].x * va[i].x + va[i].y * va[i].y + va[i].z * va[i].z + va[i].w * va[i].w;
      sb += vb[i].x * vb[i].x + vb[i].y * vb[i].y + vb[i].z * vb[i].z + vb[i].w * vb[i].w;
    }
#pragma unroll
    for (int o = 32; o; o >>= 1) { sa += __shfl_xor(sa, o); sb += __shfl_xor(sb, o); }
    const float ra = rsqrtf(sa * (1.f / D) + 1e-6f), rb = rsqrtf(sb * (1.f / D) + 1e-6f);
#pragma unroll
    for (int i = 0; i < 4; ++i) {
      const float4 gg = ((const float4*)g)[lane + 64 * i];
      uint2 pk;
      pk.x = pack2(va[i].x * ra * gg.x, va[i].y * ra * gg.y);
      pk.y = pack2(va[i].z * ra * gg.z, va[i].w * ra * gg.w);
      *(uint2*)(dst + (size_t)r0 * LDA + (size_t)(lane + 64 * i) * 4) = pk;
      if (has1) {
        pk.x = pack2(vb[i].x * rb * gg.x, vb[i].y * rb * gg.y);
        pk.y = pack2(vb[i].z * rb * gg.z, vb[i].w * rb * gg.w);
        *(uint2*)(dst + (size_t)r1 * LDA + (size_t)(lane + 64 * i) * 4) = pk;
      }
    }
  }
}

DEVI void phase0(const Params& p) {
  const int tid = launder(threadIdx.x), lane = tid & 63;
  const int gtid = blockIdx.x * 256 + tid, gsz = gridDim.x * 256;
  const int gw = gtid >> 6, nw = gsz >> 6;
  rownorm_bf16(p.x, p.mix_g, p.hn, NTOK, gw, nw, lane);
  rownorm_bf16(p.mem, p.memkv_g, p.memn, Bn * 256, gw, nw, lane);
  tconv(p.w_in, 1024, 2328, p.winT, 2432, LDA, nullptr, gtid, gsz);
  tconv(p.w_out, 1024, 1024, p.woutT, 1024, LDA, nullptr, gtid, gsz);
  tconv(p.w_mq, 1024, 1024, p.wmqT, 1024, LDA, p.memq_g, gtid, gsz);
  tconv(p.w_mk, 1024, 1024, p.wmkT, 1024, LDA, nullptr, gtid, gsz);
  tconv(p.w_mv, 1024, 1024, p.wmvT, 1024, LDA, nullptr, gtid, gsz);
  tconv(p.w_mo, 1024, 1024, p.wmoT, 1024, LDA, nullptr, gtid, gsz);
  tconv(p.peer_wq, 1024, 2048, p.wpqT, 2048, LDA, p.peer_g, gtid, gsz);
  tconv(p.cmp_w1, 2048, 128, p.w1T, 128, LDW1, nullptr, gtid, gsz);
  tconv(p.cmp_w1 + 2048 * 128, 2048, 128, p.w1T + 128 * LDW1, 128, LDW1, nullptr, gtid, gsz);
  tconv(p.cmp_w2, 128, 64, p.w2T, 128, 128, nullptr, gtid, gsz);
  tconv(p.cmp_w2 + 128 * 64, 128, 64, p.w2T + 128 * 128, 128, 128, nullptr, gtid, gsz);
  conv_flat(p.peer_sk, p.subk, (size_t)16 * 128 * 128 / 8, gtid, gsz);
  for (int it = gtid; it < NTOK * 8; it += gsz) {
    const int tok = it >> 3, i = it & 7;
    const float inv = (i == 0) ? 1.000000000e+00f : (i == 1) ? 1.939227432e-01f : (i == 2) ? 3.760603070e-02f : (i == 3) ? 7.292664610e-03f : (i == 4) ? 1.414213562e-03f : (i == 5) ? 2.742481884e-04f : (i == 6) ? 5.318295734e-05f : 1.031338525e-05f;
    const float ang = (float)p.pos[tok] * inv;
    float sv, cv;
    sincosf(ang, &sv, &cv);
    p.rope[tok * 16 + i] = cv;
    p.rope[tok * 16 + 8 + i] = sv;
  }
  for (int o = gw; o < 256; o += nw) {
    const int ty = o >> 7, n = o & 127;
    float s = 0.f;
#pragma unroll 8
    for (int k = lane; k < 2048; k += 64)
      s += p.cmp_pos[ty * 2048 + k] * p.cmp_w1[((size_t)ty * 2048 + k) * 128 + n];
    s = wave_sum(s);
    if (lane == 0) p.biasp[o] = s + p.cmp_b1[o];
  }
  for (int it = gtid; it < NTOK; it += gsz) { p.ssq1[it] = 0.f; p.ssq2[it] = 0.f; }
}

template <bool DB, class AF>
DEVI void gemm_mainloop(int tid, u16* sA, u16* sB, AF af, const u16* __restrict__ Bt, int ldb, int m0, int n0, int nk,
                        f32x4 (&acc)[4][4]) {
  const int lane = tid & 63, w = tid >> 6;
  const int wm = w >> 1, wn = w & 1, col = lane & 15, quad = lane >> 4;
#pragma unroll
  for (int i = 0; i < 4; ++i)
#pragma unroll
    for (int j = 0; j < 4; ++j) acc[i][j] = f32x4{0.f, 0.f, 0.f, 0.f};
  uint4 ra0, ra1, ra2, ra3, rb0, rb1, rb2, rb3;
  const int lrow = tid >> 3, lkc = (tid & 7) << 3;
  const u16* bbase = Bt + (size_t)(n0 + lrow) * ldb + lkc;
#define GL_(R, i, kk)                                                     \
  R##a##i = *(const uint4*)af(m0 + lrow + 32 * i, (kk) + lkc);            \
  R##b##i = *(const uint4*)(bbase + (size_t)(32 * i) * ldb + (kk));
#define SS_(R, i, off)                                                    \
  *(uint4*)(sA + (off) + (lrow + 32 * i) * 72 + lkc) = R##a##i;           \
  *(uint4*)(sB + (off) + (lrow + 32 * i) * 72 + lkc) = R##b##i;
#define GL4_(R, kk) GL_(R, 0, kk) GL_(R, 1, kk) GL_(R, 2, kk) GL_(R, 3, kk)
#define SS4_(R, off) SS_(R, 0, off) SS_(R, 1, off) SS_(R, 2, off) SS_(R, 3, off)
#define COMPUTE_(cur)                                                                                                   \
  _Pragma("unroll") for (int ks = 0; ks < 2; ++ks) {                                                                    \
    bf16x8 fa[4], fb[4];                                                                                                \
    _Pragma("unroll") for (int mi = 0; mi < 4; ++mi)                                                                    \
      fa[mi] = *(const bf16x8*)(sA + (cur) + (wm * 64 + 16 * mi + col) * 72 + 32 * ks + 8 * quad);                      \
    _Pragma("unroll") for (int ni = 0; ni < 4; ++ni)                                                                    \
      fb[ni] = *(const bf16x8*)(sB + (cur) + (wn * 64 + 16 * ni + col) * 72 + 32 * ks + 8 * quad);                      \
    _Pragma("unroll") for (int ni = 0; ni < 4; ++ni)                                                                    \
      _Pragma("unroll") for (int mi = 0; mi < 4; ++mi) acc[ni][mi] = mfma16(fb[ni], fa[mi], acc[ni][mi]);               \
  }
  if (DB) {
    const int srow = 8 * w + (lane >> 3);
    const int spc = lane & 7;
#define STAGE_(st, kk)                                                                                         \
    _Pragma("unroll") for (int i = 0; i < 4; ++i) {                                                            \
      const int r_ = 32 * i + srow;                                                                            \
      const int c_ = (spc ^ ((r_ >> 1) & 7)) << 3;                                                             \
      __builtin_amdgcn_global_load_lds((const unsigned*)af(m0 + r_, (kk) + c_),                                \
                                       (unsigned*)(sA + (st) * 16384 + (32 * i + 8 * w) * 64), 16, 0, 0);      \
      __builtin_amdgcn_global_load_lds((const unsigned*)(Bt + (size_t)(n0 + r_) * ldb + (kk) + c_),            \
                                       (unsigned*)(sA + (st) * 16384 + 8192 + (32 * i + 8 * w) * 64), 16, 0, 0); \
    }
#define COMPUTE_SW_(st)                                                                                                 \
  _Pragma("unroll") for (int ks = 0; ks < 2; ++ks) {                                                                    \
    bf16x8 fa[4], fb[4];                                                                                                \
    const int pc_ = ((4 * ks + quad) ^ ((col >> 1) & 7)) << 3;                                                          \
    _Pragma("unroll") for (int mi = 0; mi < 4; ++mi)                                                                    \
      fa[mi] = *(const bf16x8*)(sA + (st) * 16384 + (wm * 64 + 16 * mi + col) * 64 + pc_);                              \
    _Pragma("unroll") for (int ni = 0; ni < 4; ++ni)                                                                    \
      fb[ni] = *(const bf16x8*)(sA + (st) * 16384 + 8192 + (wn * 64 + 16 * ni + col) * 64 + pc_);                       \
    _Pragma("unroll") for (int ni = 0; ni < 4; ++ni)                                                                    \
      _Pragma("unroll") for (int mi = 0; mi < 4; ++mi) acc[ni][mi] = mfma16(fb[ni], fa[mi], acc[ni][mi]);               \
  }
    STAGE_(0, 0)
#pragma unroll 1
    for (int kt = 0; kt < nk; kt += 2) {
      asm volatile("s_waitcnt vmcnt(0)" ::: "memory");
      __syncthreads();
      { const int kk = (kt + 1) * 64; STAGE_(1, kk) }
      COMPUTE_SW_(0)
      asm volatile("s_waitcnt vmcnt(0)" ::: "memory");
      __syncthreads();
      if (kt + 2 < nk) { const int kk = (kt + 2) * 64; STAGE_(0, kk) }
      COMPUTE_SW_(1)
    }
#undef STAGE_
#undef COMPUTE_SW_
  } else {
    GL4_(r, 0)
    SS4_(r, 0)
    __syncthreads();
#pragma unroll 1
    for (int kt = 0; kt < nk; ++kt) {
      const bool more = (kt + 1 < nk);
      if (more) { const int kk = (kt + 1) * 64; GL4_(r, kk) }
      COMPUTE_(0)
      __syncthreads();
      if (more) {
        SS4_(r, 0)
        __syncthreads();
      }
    }
  }
#undef GL_
#undef SS_
#undef GL4_
#undef SS4_
#undef COMPUTE_
}

struct ARow {
  const u16* base; int lda;
  DEVI const u16* operator()(int m, int k) const { return base + (size_t)m * lda + k; }
};
struct ACmp {
  const u16* proj; int colbase;
  DEVI const u16* operator()(int rr, int k) const {
    const int b = rr >> 8, g = (rr >> 7) & 1;
    int c = rr & 127; c = c > 126 ? 126 : c;
    const int l = k >> 6, d = k & 63;
    return proj + ((size_t)b * T + 16 * c + l) * LDP + colbase + g * 64 + d;
  }
};


#define XCD_TILE_LOOP(idx, MT, NT)                                                                     \
  const bool sw_ = (gridDim.x & 7) == 0;                                                               \
  const int xcd_ = blockIdx.x & 7;                                                                     \
  const int tstart_ = sw_ ? (int)(blockIdx.x >> 3) : (int)blockIdx.x;                                  \
  const int tstep_ = sw_ ? (int)(gridDim.x >> 3) : (int)gridDim.x;                                     \
  const int ttotal_ = sw_ ? ((MT) / 8) * (NT) : (MT) * (NT);                                           \
  _Pragma("unroll 1") for (int idx = tstart_; idx < ttotal_; idx += tstep_)
#define XCD_TILE_MT(idx, NT) (sw_ ? ((idx) / (NT)) * 8 + xcd_ : (idx) / (NT))
#define XCD_TILE_NT(idx, NT) ((idx) % (NT))

#define GEMM_LANE_VARS                                                    \
  const int tid = launder(threadIdx.x), lane = tid & 63, w = tid >> 6;    \
  const int wm = w >> 1, wn = w & 1, col = lane & 15, quad = lane >> 4;   \
  (void)wm; (void)wn; (void)col; (void)quad;

DEVI void phase1(const Params& p, unsigned char* smem) {
  u16* sA = (u16*)smem; u16* sB = sA + 128 * 72;
  XCD_TILE_LOOP(idx, 256 + 32, 19) {
    GEMM_LANE_VARS
    f32x4 acc[4][4];
    const int mt = XCD_TILE_MT(idx, 19), nt_ = XCD_TILE_NT(idx, 19);
    if (mt < 256) {
      const int m0 = mt * 128, n0 = nt_ * 128;
      gemm_mainloop<true>(tid, sA, sB, ARow{p.hn, LDA}, p.winT, LDA, m0, n0, 16, acc);
#pragma unroll
      for (int mi = 0; mi < 4; ++mi) {
        const int m = m0 + wm * 64 + 16 * mi + col;
        const int b = m >> 11, t = m & 2047;
#pragma unroll
        for (int ni = 0; ni < 4; ++ni) {
          const int nt = n0 + wn * 64 + 16 * ni;
          const int n = nt + 4 * quad;
          f32x4 v = acc[ni][mi];
          if (nt >= LDP) continue;
          if ((nt >= C_VS && nt < C_KW) || (nt >= C_VW && nt < C_GATE)) {
            const bool isw = nt >= C_VW;
            const int off = n - (isw ? C_VW : C_VS);
            const int g = off >> 6, d = off & 63;
            u16* dst = (isw ? p.vtw : p.vts) + ((size_t)(b * 2 + g) * 64 + d) * LDT + t;
#pragma unroll
            for (int r = 0; r < 4; ++r) dst[(size_t)r * LDT] = f2bf(v[r]);
          } else {
            const bool rope_tile = ((nt >= C_KS && nt < C_VS) || (nt >= C_KW && nt < C_VW)) && ((nt & 63) == 0);
            if (rope_tile) {
#pragma unroll
              for (int r = 0; r < 4; ++r) {
                const float pr = __shfl_xor(v[r], 32);
                const int i = ((quad & 1) << 2) + r;
                const float cs = p.rope[(size_t)m * 16 + i], sn = p.rope[(size_t)m * 16 + 8 + i];
                v[r] = (quad < 2) ? (v[r] * cs - pr * sn) : (v[r] * cs + pr * sn);
              }
            }
            uint2 pk; pk.x = pack2(v[0], v[1]); pk.y = pack2(v[2], v[3]);
            *(uint2*)(p.proj + (size_t)m * LDP + n) = pk;
          }
        }
      }
    } else if (nt_ < 16) {
      const int isv = nt_ >> 3;
      const int m0 = (mt - 256) * 128, n0 = (nt_ & 7) * 128;
      gemm_mainloop<true>(tid, sA, sB, ARow{p.memn, LDA}, isv ? p.wmvT : p.wmkT, LDA, m0, n0, 16, acc);
#pragma unroll
      for (int mi = 0; mi < 4; ++mi) {
        const int m = m0 + wm * 64 + 16 * mi + col;
        const int b = m >> 8, key = m & 255;
#pragma unroll
        for (int ni = 0; ni < 4; ++ni) {
          const int n = n0 + wn * 64 + 16 * ni + 4 * quad;
          const f32x4 v = acc[ni][mi];
          if (isv) {
            const int head = n >> 8, d = n & 255;
            u16* dst = p.memvt + ((size_t)(b * 4 + head) * 256 + d) * 256 + key;
#pragma unroll
            for (int r = 0; r < 4; ++r) dst[r * 256] = f2bf(v[r]);
          } else {
            uint2 pk; pk.x = pack2(v[0], v[1]); pk.y = pack2(v[2], v[3]);
            *(uint2*)(p.memk + (size_t)m * LDA + n) = pk;
          }
        }
      }
    }
  }
}

DEVI void conv_tile(const Params& p, unsigned char* smem, int ct) {
  u16* sU = (u16*)smem;
  float2* sRed = (float2*)(smem + 62 * 512 * 2);
  const int tid = launder(threadIdx.x), lane = tid & 63, w = tid >> 6;
  const int b = ct >> 6, t0 = (ct & 63) * 32;
  __syncthreads();
  for (int it = tid; it < 62 * 64; it += 256) {
    const int r = it >> 6, c8 = it & 63;
    const int t = t0 - 30 + r;
    uint4 pk = {0u, 0u, 0u, 0u};
    if (t >= 0) {
      const u16* src = p.proj + ((size_t)b * T + t) * LDP + c8 * 8;
      const uint4 a = *(const uint4*)src, bb = *(const uint4*)(src + 512);
      const unsigned au[4] = {a.x, a.y, a.z, a.w}, bu[4] = {bb.x, bb.y, bb.z, bb.w};
      unsigned o[4];
#pragma unroll
      for (int j = 0; j < 4; ++j) {
        const float a0 = __uint_as_float(au[j] << 16), a1 = __uint_as_float(au[j] & 0xffff0000u);
        const float b0 = __uint_as_float(bu[j] << 16), b1 = __uint_as_float(bu[j] & 0xffff0000u);
        o[j] = pack2(a0 * sigmoidf_(b0), a1 * sigmoidf_(b1));
      }
      pk.x = o[0]; pk.y = o[1]; pk.z = o[2]; pk.w = o[3];
    }
    *(uint4*)(sU + r * 512 + c8 * 8) = pk;
  }
  const int c = 2 * tid;
  float w0[31], w1[31];
#pragma unroll
  for (int j = 0; j < 31; ++j) { w0[j] = p.conv_w[j * 512 + c]; w1[j] = p.conv_w[j * 512 + c + 1]; }
  const float bd0 = p.conv_b[c], bd1 = p.conv_b[c + 1];
  __syncthreads();
  for (int tt = 0; tt < 32; ++tt) {
    float y0 = bd0, y1 = bd1;
#pragma unroll
    for (int j = 0; j < 31; ++j) {
      const unsigned uu = *(const unsigned*)(sU + (tt + j) * 512 + c);
      y0 += w0[j] * __uint_as_float(uu << 16);
      y1 += w1[j] * __uint_as_float(uu & 0xffff0000u);
    }
    float s = y0 + y1, q = y0 * y0 + y1 * y1;
    s = wave_sum(s); q = wave_sum(q);
    if (lane == 0) sRed[tt * 4 + w] = make_float2(s, q);
  }
  __syncthreads();
  const float g0 = p.ln_g[c], g1 = p.ln_g[c + 1], lb0 = p.ln_b[c], lb1 = p.ln_b[c + 1];
  for (int tt = 0; tt < 32; ++tt) {
    float y0 = bd0, y1 = bd1;
#pragma unroll
    for (int j = 0; j < 31; ++j) {
      const unsigned uu = *(const unsigned*)(sU + (tt + j) * 512 + c);
      y0 += w0[j] * __uint_as_float(uu << 16);
      y1 += w1[j] * __uint_as_float(uu & 0xffff0000u);
    }
    const float2 r0 = sRed[tt * 4 + 0], r1 = sRed[tt * 4 + 1], r2 = sRed[tt * 4 + 2], r3 = sRed[tt * 4 + 3];
    const float S = r0.x + r1.x + r2.x + r3.x, Q = r0.y + r1.y + r2.y + r3.y;
    const float mu = S * (1.f / 512.f);
    const float var = fmaxf(Q * (1.f / 512.f) - mu * mu, 0.f);
    const float rstd = rsqrtf(var + 1e-6f);
    const float z0 = (y0 - mu) * rstd * g0 + lb0, z1 = (y1 - mu) * rstd * g1 + lb1;
    const float o0 = z0 * sigmoidf_(z0), o1 = z1 * sigmoidf_(z1);
    *(unsigned*)(p.mix + ((size_t)b * T + t0 + tt) * LDA + c) = pack2(o0, o1);
  }
}

DEVI void phase2(const Params& p, unsigned char* smem) {
  u16* sA = (u16*)smem; u16* sB = sA + 128 * 72;
#pragma unroll 1
  for (int tile = blockIdx.x; tile < 64 + 1024; tile += gridDim.x) {
    GEMM_LANE_VARS
    if (tile < 64) {
      const int ty = tile >> 5, mt = tile & 31;
      const int m0 = mt * 128;
      f32x4 acc[4][4];
      gemm_mainloop<true>(tid, sA, sB, ACmp{p.proj, ty ? C_VC : C_KC}, p.w1T + (size_t)ty * 128 * LDW1, LDW1, m0, 0, 32, acc);
#pragma unroll
      for (int mi = 0; mi < 4; ++mi) {
        const int m = m0 + wm * 64 + 16 * mi + col;
#pragma unroll
        for (int ni = 0; ni < 4; ++ni) {
          const int n = wn * 64 + 16 * ni + 4 * quad;
          const f32x4 v = acc[ni][mi];
          const float4 bb = *(const float4*)(p.biasp + ty * 128 + n);
          uint2 pk;
          pk.x = pack2(gelu_tanh(v[0] + bb.x), gelu_tanh(v[1] + bb.y));
          pk.y = pack2(gelu_tanh(v[2] + bb.z), gelu_tanh(v[3] + bb.w));
          *(uint2*)(p.hdn + ((size_t)ty * 4096 + m) * 128 + n) = pk;
        }
      }
    } else {
      conv_tile(p, smem, tile - 64);
    }
  }
}

DEVI void phase3(const Params& p, unsigned char* smem) {
  u16* sA = (u16*)smem; u16* sB = sA + 128 * 72;
#pragma unroll 1
  for (int tile = blockIdx.x; tile < 64; tile += gridDim.x) {
    GEMM_LANE_VARS
    const int ty = tile >> 5, mt = tile & 31;
    const int m0 = mt * 128;
    f32x4 acc[4][4];
    gemm_mainloop<true>(tid, sA, sB, ARow{p.hdn + (size_t)ty * 4096 * 128, 128}, p.w2T + (size_t)ty * 128 * 128, 128, m0, 0, 2, acc);
    if (wn == 0) {
#pragma unroll
      for (int mi = 0; mi < 4; ++mi) {
        const int m = m0 + 16 * mi + wm * 64 + col;
        const int bg = m >> 7, c = m & 127;
#pragma unroll
        for (int ni = 0; ni < 4; ++ni) {
          const int n = 16 * ni + 4 * quad;
          const f32x4 v = acc[ni][mi];
          const float4 bb = *(const float4*)(p.cmp_b2 + ty * 64 + n);
          const float o0 = v[0] + bb.x, o1 = v[1] + bb.y, o2 = v[2] + bb.z, o3 = v[3] + bb.w;
          if (ty == 0) {
            uint2 pk; pk.x = pack2(o0, o1); pk.y = pack2(o2, o3);
            *(uint2*)(p.kc + (size_t)m * 64 + n) = pk;
          } else {
            u16* dst = p.vcT + ((size_t)bg * 64 + n) * 128 + c;
            dst[0] = f2bf(o0); dst[128] = f2bf(o1); dst[256] = f2bf(o2); dst[384] = f2bf(o3);
          }
        }
      }
    }
  }
}

template <int DH, int NQ, int LDK, class MaskF>
DEVI void attn_qk(const u16* sK, const bf16x8 (&qf)[NQ][DH / 32], f32x4 (&o)[NQ][DH / 16], float (&m)[NQ], float (&l)[NQ],
                  float c2, int lane, MaskF valid, bf16x8 (&pb)[NQ][2]) {
  const int col = lane & 15, quad = lane >> 4;
  f32x4 s[NQ][4];
#pragma unroll
  for (int kt = 0; kt < 4; ++kt) {
#pragma unroll
    for (int qt = 0; qt < NQ; ++qt) s[qt][kt] = f32x4{0.f, 0.f, 0.f, 0.f};
#pragma unroll
    for (int ks = 0; ks < DH / 32; ++ks) {
      const bf16x8 kf = *(const bf16x8*)(sK + (16 * kt + col) * LDK + 32 * ks + 8 * quad);
#pragma unroll
      for (int qt = 0; qt < NQ; ++qt) s[qt][kt] = mfma16(kf, qf[qt][ks], s[qt][kt]);
    }
  }
#pragma unroll
  for (int qt = 0; qt < NQ; ++qt) {
    float mx = -1e30f;
#pragma unroll
    for (int kt = 0; kt < 4; ++kt)
#pragma unroll
      for (int r = 0; r < 4; ++r) {
        const bool v = valid(qt, 16 * kt + 4 * quad + r);
        const float sv = v ? s[qt][kt][r] : -1e30f;
        s[qt][kt][r] = sv;
        mx = fmaxf(mx, sv);
      }
    mx = fmaxf(mx, __shfl_xor(mx, 16));
    mx = fmaxf(mx, __shfl_xor(mx, 32));
    const float mn = fmaxf(m[qt], mx);
    const float alpha = fexp2((m[qt] - mn) * c2);
    m[qt] = mn;
    float ps = 0.f;
#pragma unroll
    for (int kt = 0; kt < 4; ++kt)
#pragma unroll
      for (int r = 0; r < 4; ++r) {
        const float sv = s[qt][kt][r];
        const float pv = (sv > -1e29f) ? fexp2((sv - mn) * c2) : 0.f;
        ps += pv;
        s[qt][kt][r] = pv;
      }
    l[qt] = l[qt] * alpha + ps;
#pragma unroll
    for (int dt = 0; dt < DH / 16; ++dt) o[qt][dt] *= alpha;
#pragma unroll
    for (int kk = 0; kk < 2; ++kk) {
      union { bf16x8 v; unsigned u[4]; } cv;
      cv.u[0] = pack2(s[qt][2 * kk][0], s[qt][2 * kk][1]);
      cv.u[1] = pack2(s[qt][2 * kk][2], s[qt][2 * kk][3]);
      cv.u[2] = pack2(s[qt][2 * kk + 1][0], s[qt][2 * kk + 1][1]);
      cv.u[3] = pack2(s[qt][2 * kk + 1][2], s[qt][2 * kk + 1][3]);
      pb[qt][kk] = cv.v;
    }
  }
}
template <int DH, int NQ, int LDV>
DEVI void attn_pv(const u16* sVt, const bf16x8 (&pb)[NQ][2], f32x4 (&o)[NQ][DH / 16], int lane) {
  const int col = lane & 15, quad = lane >> 4;
#pragma unroll
  for (int dt = 0; dt < DH / 16; ++dt) {
#pragma unroll
    for (int kk = 0; kk < 2; ++kk) {
      union { bf16x8 v; uint2 h[2]; } cv;
      cv.h[0] = *(const uint2*)(sVt + (16 * dt + col) * LDV + 32 * kk + 4 * quad);
      cv.h[1] = *(const uint2*)(sVt + (16 * dt + col) * LDV + 32 * kk + 16 + 4 * quad);
#pragma unroll
      for (int qt = 0; qt < NQ; ++qt) o[qt][dt] = mfma16(cv.v, pb[qt][kk], o[qt][dt]);
    }
  }
}
template <int DH, int NQ, int LDK, int LDV, class MaskF>
DEVI void attn_tile(const u16* sK, const u16* sVt, const bf16x8 (&qf)[NQ][DH / 32], f32x4 (&o)[NQ][DH / 16],
                    float (&m)[NQ], float (&l)[NQ], float c2, int lane, MaskF valid) {
  bf16x8 pb[NQ][2];
  attn_qk<DH, NQ, LDK>(sK, qf, o, m, l, c2, lane, valid, pb);
  attn_pv<DH, NQ, LDV>(sVt, pb, o, lane);
}

DEVI void phase_nsa(const Params& p, unsigned char* smem) {
  u16* sK = (u16*)smem;
  u16* sVt = (u16*)(smem + 18432);
  float* impH = (float*)(smem + 35840);
  float* impT = (float*)(smem + 52736);
  unsigned* selm = (unsigned*)(smem + 56960);
  const float c2 = 0.125f * 1.4426950408889634f;
#pragma unroll 1
  for (int tile = blockIdx.x; tile < 2048; tile += gridDim.x) {
    const int tid = launder(threadIdx.x), lane = tid & 63, w = tid >> 6, col = lane & 15, quad = lane >> 4;
    const int qtile = 63 - (tile >> 5), bg = tile & 31, b = bg >> 1, g = bg & 1, q0 = qtile * 32;
    const int h = g * 4 + w;
    __syncthreads();
    if (tid < 32) selm[tid] = 0u;
    {
      const u16* kcp = p.kc + (size_t)bg * 128 * 64;
      const u16* vcp = p.vcT + (size_t)bg * 64 * 128;
#pragma unroll
      for (int i = 0; i < 4; ++i) {
        const int c = tid + 256 * i;
        const int row = c >> 3, ch = (c & 7) << 3;
        *(uint4*)(sK + row * 72 + ch) = *(const uint4*)(kcp + row * 64 + ch);
        const int row2 = c >> 4, ch2 = (c & 15) << 3;
        *(uint4*)(sVt + row2 * 136 + ch2) = *(const uint4*)(vcp + row2 * 128 + ch2);
      }
    }
    bf16x8 qf[2][2];
    float gate[2][3];
    int tq[2];
#pragma unroll
    for (int qt = 0; qt < 2; ++qt) {
      const int t = q0 + 16 * qt + col;
      tq[qt] = t;
      const size_t tok = (size_t)b * T + t;
      const u16* qp = p.proj + tok * LDP + C_Q + h * 64 + 8 * quad;
      qf[qt][0] = *(const bf16x8*)qp;
      qf[qt][1] = *(const bf16x8*)(qp + 32);
#pragma unroll
      for (int br = 0; br < 3; ++br) gate[qt][br] = sigmoidf_(bf2f(p.proj[tok * LDP + C_GATE + h * 3 + br]));
    }
    __syncthreads();

    f32x4 comb[2][4];
    {
      const int srcl = (lane + 48) & 63;
#pragma unroll
      for (int qt = 0; qt < 2; ++qt) {
        f32x4 s[8];
#pragma unroll
        for (int kt = 0; kt < 8; ++kt) {
          s[kt] = f32x4{0.f, 0.f, 0.f, 0.f};
#pragma unroll
          for (int ks = 0; ks < 2; ++ks) {
            const bf16x8 kf = *(const bf16x8*)(sK + (16 * kt + col) * 72 + 32 * ks + 8 * quad);
            s[kt] = mfma16(kf, qf[qt][ks], s[kt]);
          }
        }
        const int t = tq[qt];
        float mx = -1e30f;
#pragma unroll
        for (int kt = 0; kt < 8; ++kt)
#pragma unroll
          for (int r = 0; r < 4; ++r) {
            const int c = 16 * kt + 4 * quad + r;
            const bool v = (16 * c + 31) <= t;
            const float sv = v ? s[kt][r] : -1e30f;
            s[kt][r] = sv;
            mx = fmaxf(mx, sv);
          }
        mx = fmaxf(mx, __shfl_xor(mx, 16));
        mx = fmaxf(mx, __shfl_xor(mx, 32));
        float ps = 0.f;
#pragma unroll
        for (int kt = 0; kt < 8; ++kt)
#pragma unroll
          for (int r = 0; r < 4; ++r) {
            const float sv = s[kt][r];
            const float pv = (sv > -1e29f) ? fexp2((sv - mx) * c2) : 0.f;
            ps += pv;
            s[kt][r] = pv;
          }
        ps += __shfl_xor(ps, 16);
        ps += __shfl_xor(ps, 32);
        const float inv = ps > 0.f ? 1.f / ps : 0.f;
#pragma unroll
        for (int kt = 0; kt < 8; ++kt)
#pragma unroll
          for (int r = 0; r < 4; ++r) s[kt][r] *= inv;
        float prev3 = 0.f;
#pragma unroll
        for (int kt = 0; kt < 8; ++kt) {
          const float sum4 = s[kt][0] + s[kt][1] + s[kt][2] + s[kt][3];
          const float xs = __shfl(s[kt][3], srcl);
          const float extra = quad ? xs : prev3;
          prev3 = xs;
          impH[(w * 32 + 16 * qt + col) * 33 + 4 * kt + quad] = sum4 + extra;
        }
        bf16x8 pb[4];
#pragma unroll
        for (int kk = 0; kk < 4; ++kk) {
          union { bf16x8 v; unsigned u[4]; } cv;
          cv.u[0] = pack2(s[2 * kk][0], s[2 * kk][1]);
          cv.u[1] = pack2(s[2 * kk][2], s[2 * kk][3]);
          cv.u[2] = pack2(s[2 * kk + 1][0], s[2 * kk + 1][1]);
          cv.u[3] = pack2(s[2 * kk + 1][2], s[2 * kk + 1][3]);
          pb[kk] = cv.v;
        }
#pragma unroll
        for (int dt = 0; dt < 4; ++dt) {
          f32x4 oc = f32x4{0.f, 0.f, 0.f, 0.f};
#pragma unroll
          for (int kk = 0; kk < 4; ++kk) {
            union { bf16x8 v; uint2 hh[2]; } cv;
            cv.hh[0] = *(const uint2*)(sVt + (16 * dt + col) * 136 + 32 * kk + 4 * quad);
            cv.hh[1] = *(const uint2*)(sVt + (16 * dt + col) * 136 + 32 * kk + 16 + 4 * quad);
            oc = mfma16(cv.v, pb[kk], oc);
          }
          comb[qt][dt] = oc * gate[qt][0];
        }
      }
    }
#pragma unroll
    for (int qt = 0; qt < 2; ++qt) {
      const size_t tok = (size_t)b * T + tq[qt];
      union { bf16x8 v; unsigned u[4]; } own, par, res;
      own.v = qf[qt][0];
#pragma unroll
      for (int j = 0; j < 4; ++j) par.u[j] = (unsigned)__shfl_xor((int)own.u[j], 16);
      const float4 c0 = *(const float4*)(p.rope + tok * 16), c1 = *(const float4*)(p.rope + tok * 16 + 4);
      const float4 s0 = *(const float4*)(p.rope + tok * 16 + 8), s1 = *(const float4*)(p.rope + tok * 16 + 12);
      const float cs[8] = {c0.x, c0.y, c0.z, c0.w, c1.x, c1.y, c1.z, c1.w};
      const float sn[8] = {s0.x, s0.y, s0.z, s0.w, s1.x, s1.y, s1.z, s1.w};
#pragma unroll
      for (int j = 0; j < 4; ++j) {
        const float o0 = __uint_as_float(own.u[j] << 16), o1 = __uint_as_float(own.u[j] & 0xffff0000u);
        const float p0 = __uint_as_float(par.u[j] << 16), p1 = __uint_as_float(par.u[j] & 0xffff0000u);
        const float sg = (quad == 0) ? -1.f : 1.f;
        const float r0 = o0 * cs[2 * j] + sg * p0 * sn[2 * j];
        const float r1 = o1 * cs[2 * j + 1] + sg * p1 * sn[2 * j + 1];
        res.u[j] = (quad < 2) ? pack2(r0, r1) : own.u[j];
      }
      qf[qt][0] = res.v;
    }
    __syncthreads();
#pragma unroll
    for (int i = 0; i < 4; ++i) {
      const int cell = tid + 256 * i;
      const int qi = cell >> 5, s_ = cell & 31;
      const int cur = (q0 + qi) >> 6;
      float v = impH[(0 * 32 + qi) * 33 + s_] + impH[(1 * 32 + qi) * 33 + s_] + impH[(2 * 32 + qi) * 33 + s_] +
                impH[(3 * 32 + qi) * 33 + s_];
      const int dist = cur - s_;
      const bool forced = (s_ == 0) || (dist >= 0 && dist < 2);
      v = forced ? 1e9f : (s_ <= cur ? v : -1.f);
      impT[qi * 33 + s_] = v;
    }
    __syncthreads();
    {
      const int qi = tid >> 3, sub = tid & 7;
      unsigned bits = 0u;
#pragma unroll
      for (int k = 0; k < 4; ++k) {
        const int s_ = sub * 4 + k;
        const float v = impT[qi * 33 + s_];
        int rank = 0;
        for (int s2 = 0; s2 < 32; ++s2) {
          const float v2 = impT[qi * 33 + s2];
          rank += ((v2 > v) || (v2 == v && s2 < s_)) ? 1 : 0;
        }
        if (rank < 16) bits |= 1u << s_;
      }
      atomicOr(&selm[qi], bits);
    }
    __syncthreads();
    unsigned sm[2] = {selm[col], selm[16 + col]};
    unsigned uni = 0u;
#pragma unroll
    for (int i = 0; i < 32; ++i) uni |= selm[i];
    const int kbmax = (q0 + 31) >> 6;
    {
      float m[2] = {-1e30f, -1e30f}, l[2] = {0.f, 0.f};
      f32x4 o[2][4];
#pragma unroll
      for (int qt = 0; qt < 2; ++qt)
#pragma unroll
        for (int dt = 0; dt < 4; ++dt) o[qt][dt] = f32x4{0.f, 0.f, 0.f, 0.f};
      unsigned rem = (kbmax >= 31) ? uni : (uni & ((1u << (kbmax + 1)) - 1u));
      int kb = rem ? (__ffs((int)rem) - 1) : -1;
      uint4 rk0, rk1, rv0, rv1;
      const int lr0 = tid >> 3, lch = (tid & 7) << 3;
#define LOADKV_(kbx, CK, VT)                                                                                         \
      rk0 = *(const uint4*)(p.proj + ((size_t)b * T + (kbx) * 64 + lr0) * LDP + (CK) + g * 64 + lch);                 \
      rk1 = *(const uint4*)(p.proj + ((size_t)b * T + (kbx) * 64 + lr0 + 32) * LDP + (CK) + g * 64 + lch);            \
      rv0 = *(const uint4*)((VT) + ((size_t)bg * 64 + lr0) * LDT + (kbx) * 64 + lch);                                 \
      rv1 = *(const uint4*)((VT) + ((size_t)bg * 64 + lr0 + 32) * LDT + (kbx) * 64 + lch);
#define STOREKV_()                                                                                                   \
      *(uint4*)(sK + lr0 * 72 + lch) = rk0; *(uint4*)(sK + (lr0 + 32) * 72 + lch) = rk1;                              \
      *(uint4*)(sVt + lr0 * 72 + lch) = rv0; *(uint4*)(sVt + (lr0 + 32) * 72 + lch) = rv1;
      if (kb >= 0) { LOADKV_(kb, C_KS, p.vts) }
#pragma unroll 1
      while (kb >= 0) {
        rem &= rem - 1u;
        const int nkb = rem ? (__ffs((int)rem) - 1) : -1;
        __syncthreads();
        STOREKV_()
        if (nkb >= 0) { LOADKV_(nkb, C_KS, p.vts) }
        __syncthreads();
        attn_tile<64, 2, 72, 72>(sK, sVt, qf, o, m, l, c2, lane, [&](int qt, int kl) {
          const int kp = kb * 64 + kl;
          return (((sm[qt] >> kb) & 1u) != 0u) && (kp <= tq[qt]);
        });
        kb = nkb;
      }
#pragma unroll
      for (int qt = 0; qt < 2; ++qt) {
        float lt = l[qt];
        lt += __shfl_xor(lt, 16);
        lt += __shfl_xor(lt, 32);
        const float sc = lt > 0.f ? gate[qt][1] / lt : 0.f;
#pragma unroll
        for (int dt = 0; dt < 4; ++dt) comb[qt][dt] += o[qt][dt] * sc;
      }
    }
    {
      float m[2] = {-1e30f, -1e30f}, l[2] = {0.f, 0.f};
      f32x4 o[2][4];
#pragma unroll
      for (int qt = 0; qt < 2; ++qt)
#pragma unroll
        for (int dt = 0; dt < 4; ++dt) o[qt][dt] = f32x4{0.f, 0.f, 0.f, 0.f};
      const int kblo = (q0 >= 511) ? ((q0 - 511) >> 6) : 0;
      uint4 rk0, rk1, rv0, rv1;
      const int lr0 = tid >> 3, lch = (tid & 7) << 3;
      int kb = kblo;
      LOADKV_(kb, C_KW, p.vtw)
#pragma unroll 1
      while (kb >= 0) {
        const int nkb = (kb < kbmax) ? kb + 1 : -1;
        __syncthreads();
        STOREKV_()
        if (nkb >= 0) { LOADKV_(nkb, C_KW, p.vtw) }
        __syncthreads();
        attn_tile<64, 2, 72, 72>(sK, sVt, qf, o, m, l, c2, lane, [&](int qt, int kl) {
          const int kp = kb * 64 + kl;
          return (kp <= tq[qt]) && (kp > tq[qt] - 512);
        });
        kb = nkb;
      }
#undef LOADKV_
#undef STOREKV_
#pragma unroll
      for (int qt = 0; qt < 2; ++qt) {
        float lt = l[qt];
        lt += __shfl_xor(lt, 16);
        lt += __shfl_xor(lt, 32);
        const float sc = lt > 0.f ? gate[qt][2] / lt : 0.f;
#pragma unroll
        for (int dt = 0; dt < 4; ++dt) comb[qt][dt] += o[qt][dt] * sc;
      }
    }
#pragma unroll
    for (int qt = 0; qt < 2; ++qt) {
      const size_t tok = (size_t)b * T + tq[qt];
#pragma unroll
      for (int dt = 0; dt < 4; ++dt) {
        uint2 pk;
        pk.x = pack2(comb[qt][dt][0], comb[qt][dt][1]);
        pk.y = pack2(comb[qt][dt][2], comb[qt][dt][3]);
        *(uint2*)(p.mix + tok * LDA + 512 + h * 64 + 16 * dt + 4 * quad) = pk;
      }
    }
  }
}

template <bool RESB>
DEVI void phase_resid(const Params& p, unsigned char* smem, const u16* A, const u16* Wt, const float* res, float* ssq) {
  u16* sA = (u16*)smem; u16* sB = sA + 128 * 72;
  XCD_TILE_LOOP(idx, 256, 8) {
    GEMM_LANE_VARS
    const int mt = XCD_TILE_MT(idx, 8), nt_ = XCD_TILE_NT(idx, 8);
    const int m0 = mt * 128, n0 = nt_ * 128;
    f32x4 acc[4][4];
    gemm_mainloop<true>(tid, sA, sB, ARow{A, LDA}, Wt, LDA, m0, n0, 16, acc);
#pragma unroll
    for (int mi = 0; mi < 4; ++mi) {
      const int m = m0 + wm * 64 + 16 * mi + col;
      float ss = 0.f;
#pragma unroll
      for (int ni = 0; ni < 4; ++ni) {
        const int n = n0 + wn * 64 + 16 * ni + 4 * quad;
        const f32x4 v = acc[ni][mi];
        float4 r;
        if (RESB) {
          const uint2 rb = *(const uint2*)(p.hn + (size_t)m * LDA + n);
          r.x = __uint_as_float(rb.x << 16); r.y = __uint_as_float(rb.x & 0xffff0000u);
          r.z = __uint_as_float(rb.y << 16); r.w = __uint_as_float(rb.y & 0xffff0000u);
        } else {
          r = *(const float4*)(res + (size_t)m * D + n);
        }
        float4 hv;
        hv.x = r.x + v[0]; hv.y = r.y + v[1]; hv.z = r.z + v[2]; hv.w = r.w + v[3];
        ss += hv.x * hv.x + hv.y * hv.y + hv.z * hv.z + hv.w * hv.w;
        uint2 pk; pk.x = pack2(hv.x, hv.y); pk.y = pack2(hv.z, hv.w);
        *(uint2*)(p.hn + (size_t)m * LDA + n) = pk;
      }
      ss += __shfl_xor(ss, 16);
      ss += __shfl_xor(ss, 32);
      if (quad == 0) atomicAdd(ssq + m, ss);
    }
  }
}

DEVI void phase_scaled(const Params& p, unsigned char* smem, const u16* A, const u16* Wt, int ntn, const float* ssq, u16* outp, int ldo) {
  u16* sA = (u16*)smem; u16* sB = sA + 128 * 72;
  XCD_TILE_LOOP(idx, 256, ntn) {
    GEMM_LANE_VARS
    const int mt = XCD_TILE_MT(idx, ntn), nt_ = XCD_TILE_NT(idx, ntn);
    const int m0 = mt * 128, n0 = nt_ * 128;
    f32x4 acc[4][4];
    gemm_mainloop<true>(tid, sA, sB, ARow{A, LDA}, Wt, LDA, m0, n0, 16, acc);
#pragma unroll
    for (int mi = 0; mi < 4; ++mi) {
      const int m = m0 + wm * 64 + 16 * mi + col;
      const float rstd = rsqrtf(ssq[m] * (1.f / D) + 1e-6f);
#pragma unroll
      for (int ni = 0; ni < 4; ++ni) {
        const int n = n0 + wn * 64 + 16 * ni + 4 * quad;
        const f32x4 v = acc[ni][mi];
        uint2 pk; pk.x = pack2(v[0] * rstd, v[1] * rstd); pk.y = pack2(v[2] * rstd, v[3] * rstd);
        *(uint2*)(outp + (size_t)m * ldo + n) = pk;
      }
    }
  }
}

DEVI void phase_memattn(const Params& p, unsigned char* smem) {
  u16* sK = (u16*)smem;
  u16* sVt = (u16*)(smem + 33792);
  const float c2 = 0.0625f * 1.4426950408889634f;
#pragma unroll 1
  for (int tile = blockIdx.x; tile < 2048; tile += gridDim.x) {
    const int tid = launder(threadIdx.x), lane = tid & 63, w = tid >> 6, col = lane & 15, quad = lane >> 4;
    const int b = tile >> 7, head = (tile >> 5) & 3, q0 = (tile & 31) * 64;
    const size_t tok = (size_t)b * T + q0 + 16 * w + col;
    bf16x8 qf[1][8];
#pragma unroll
    for (int ks = 0; ks < 8; ++ks) qf[0][ks] = *(const bf16x8*)(p.qm + tok * LDA + head * 256 + 32 * ks + 8 * quad);
    float m[1] = {-1e30f}, l[1] = {0.f};
    f32x4 o[1][16];
#pragma unroll
    for (int dt = 0; dt < 16; ++dt) o[0][dt] = f32x4{0.f, 0.f, 0.f, 0.f};
    uint4 rg0, rg1, rg2, rg3, rg4, rg5, rg6, rg7;
    const int krow = tid >> 5, kch = (tid & 31) << 3;
    const int vrow = tid >> 3, vch = (tid & 7) << 3;
#define LK1_(i, kbx) rg##i = *(const uint4*)(p.memk + ((size_t)b * 256 + (kbx) * 64 + krow + 8 * i) * LDA + head * 256 + kch);
#define SK1_(i) *(uint4*)(sK + (krow + 8 * i) * 264 + kch) = rg##i;
#define LV1_(i, kbx) rg##i = *(const uint4*)(p.memvt + ((size_t)(b * 4 + head) * 256 + vrow + 32 * i) * 256 + (kbx) * 64 + vch);
#define SV1_(i) *(uint4*)(sVt + (vrow + 32 * i) * 72 + vch) = rg##i;
#define LOADK_(kbx) LK1_(0, kbx) LK1_(1, kbx) LK1_(2, kbx) LK1_(3, kbx) LK1_(4, kbx) LK1_(5, kbx) LK1_(6, kbx) LK1_(7, kbx)
#define STOREK_() SK1_(0) SK1_(1) SK1_(2) SK1_(3) SK1_(4) SK1_(5) SK1_(6) SK1_(7)
#define LOADV_(kbx) LV1_(0, kbx) LV1_(1, kbx) LV1_(2, kbx) LV1_(3, kbx) LV1_(4, kbx) LV1_(5, kbx) LV1_(6, kbx) LV1_(7, kbx)
#define STOREV_() SV1_(0) SV1_(1) SV1_(2) SV1_(3) SV1_(4) SV1_(5) SV1_(6) SV1_(7)
    __syncthreads();
    LOADK_(0)
    STOREK_()
    LOADV_(0)
    __syncthreads();
#pragma unroll 1
    for (int kb = 0; kb < 4; ++kb) {
      bf16x8 pb[1][2];
      attn_qk<256, 1, 264>(sK, qf, o, m, l, c2, lane, [&](int, int) { return true; }, pb);
      STOREV_()
      if (kb < 3) { LOADK_(kb + 1) }
      __syncthreads();
      attn_pv<256, 1, 72>(sVt, pb, o, lane);
      if (kb < 3) {
        STOREK_()
        LOADV_(kb + 1)
      }
      __syncthreads();
    }
#undef LOADK_
#undef STOREK_
#undef LOADV_
#undef STOREV_
#undef LK1_
#undef SK1_
#undef LV1_
#undef SV1_
    float lt = l[0];
    lt += __shfl_xor(lt, 16);
    lt += __shfl_xor(lt, 32);
    const float inv = 1.f / lt;
#pragma unroll
    for (int dt = 0; dt < 16; ++dt) {
      uint2 pk;
      pk.x = pack2(o[0][dt][0] * inv, o[0][dt][1] * inv);
      pk.y = pack2(o[0][dt][2] * inv, o[0][dt][3] * inv);
      *(uint2*)(p.mix + tok * LDA + head * 256 + 16 * dt + 4 * quad) = pk;
    }
  }
}

__constant__ unsigned char kCandI[64] = {0,0,0,0,0,0,0,0,0,0,0,0,0,0,0,0, 1,1,1,1,1,1,1,1, 2,2,2,2,2, 3,3,3,3, 4,4,4, 5,5, 6,6, 7,7,
                                          8, 9, 10, 11, 12, 13, 14, 15, 0,0,0,0,0,0,0,0,0,0,0,0,0,0};
__constant__ unsigned char kCandJ[64] = {0,1,2,3,4,5,6,7,8,9,10,11,12,13,14,15, 0,1,2,3,4,5,6,7, 0,1,2,3,4, 0,1,2,3, 0,1,2, 0,1, 0,1, 0,1,
                                          0, 0, 0, 0, 0, 0, 0, 0, 0,0,0,0,0,0,0,0,0,0,0,0,0,0};

DEVI unsigned score_key(float v, int idx) {
  unsigned u = __float_as_uint(v);
  u = (u & 0x80000000u) ? ~u : (u | 0x80000000u);
  return (u & ~127u) | (unsigned)(127 - idx);
}
DEVI float key_score(unsigned k) {
  k &= ~127u;
  const unsigned u = (k & 0x80000000u) ? (k & 0x7fffffffu) : ~k;
  return __uint_as_float(u);
}

DEVI void phase_peer_route(const Params& p, unsigned char* smem) {
  u16* sA = (u16*)smem; u16* sB = sA + 128 * 72;
  unsigned* sScore = (unsigned*)smem;
  unsigned* sTop = (unsigned*)(smem + 36864);
  unsigned* sTmp = (unsigned*)(smem + 53248);
  {
    const int t0_ = launder(threadIdx.x);
    const int gw = (blockIdx.x * 256 + t0_) >> 6, nw = (gridDim.x * 256) >> 6;
    conv_fp8_rows(p.peer_u, p.ub8, p.uscale, 16384, gw, nw, t0_ & 63);
    conv_fp8_rows(p.peer_v, p.vb8, p.vscale, 16384, gw, nw, t0_ & 63);
  }
#pragma unroll 1
  for (int tile = blockIdx.x; tile < 256 * 8; tile += gridDim.x) {
    GEMM_LANE_VARS
    const int mt = tile >> 3, hd = tile & 7;
    const int m0 = mt * 128;
#pragma unroll 1
    for (int ph = 0; ph < 2; ++ph) {
      const int hp = hd * 2 + ph;
      f32x4 acc[4][4];
      __syncthreads();
      gemm_mainloop<false>(tid, sA, sB, ARow{p.pq + hp * 128, LDPQ}, p.subk + (size_t)hp * 128 * 128, 128, m0, 0, 2, acc);
#pragma unroll 1
      for (int hh = 0; hh < 2; ++hh) {
        if (wm == hh) {
#pragma unroll
          for (int mi = 0; mi < 4; ++mi) {
            const int row = 16 * mi + col;
#pragma unroll
            for (int ni = 0; ni < 4; ++ni) {
              const int n = wn * 64 + 16 * ni + 4 * quad;
              const f32x4 v = acc[ni][mi];
              uint4 kk;
              kk.x = score_key(v[0], n); kk.y = score_key(v[1], n + 1);
              kk.z = score_key(v[2], n + 2); kk.w = score_key(v[3], n + 3);
              *(uint4*)(sScore + row * 128 + n) = kk;
            }
          }
        }
        __syncthreads();
#pragma unroll 1
        for (int rg = 0; rg < 4; ++rg) {
          const int rbase = w * 16 + rg * 4;
          unsigned k0[4], k1[4], t0[4], t1[4], thr[4];
#pragma unroll
          for (int r = 0; r < 4; ++r) {
            k0[r] = sScore[(rbase + r) * 128 + lane];
            k1[r] = sScore[(rbase + r) * 128 + 64 + lane];
            t0[r] = ((k0[r] >> 16) << 7) | (k0[r] & 127u);
            t1[r] = ((k1[r] >> 16) << 7) | (k1[r] & 127u);
            thr[r] = 0u;
          }
#pragma unroll
          for (int bit = 22; bit >= 0; --bit) {
#pragma unroll
            for (int r = 0; r < 4; ++r) {
              const unsigned cand = thr[r] | (1u << bit);
              const int cnt = __popcll(__ballot(t0[r] >= cand)) + __popcll(__ballot(t1[r] >= cand));
              thr[r] = (cnt >= 16) ? cand : thr[r];
            }
          }
          unsigned* tmp = sTmp + w * 64;
#pragma unroll
          for (int r = 0; r < 4; ++r) {
            const unsigned long long b0 = __ballot(t0[r] >= thr[r]), b1 = __ballot(t1[r] >= thr[r]);
            const int pos0 = __builtin_amdgcn_mbcnt_hi((unsigned)(b0 >> 32), __builtin_amdgcn_mbcnt_lo((unsigned)b0, 0u));
            const int pos1 = __popcll(b0) + __builtin_amdgcn_mbcnt_hi((unsigned)(b1 >> 32), __builtin_amdgcn_mbcnt_lo((unsigned)b1, 0u));
            if (t0[r] >= thr[r]) tmp[r * 16 + pos0] = k0[r];
            if (t1[r] >= thr[r]) tmp[r * 16 + pos1] = k1[r];
          }
          __builtin_amdgcn_fence(__ATOMIC_RELEASE, "wavefront");
          __builtin_amdgcn_wave_barrier();
          __builtin_amdgcn_fence(__ATOMIC_ACQUIRE, "wavefront");
          {
            const int r = lane >> 4, ix = lane & 15;
            const unsigned mine = tmp[r * 16 + ix];
            const uint4 a = *(const uint4*)(tmp + r * 16), b = *(const uint4*)(tmp + r * 16 + 4), c = *(const uint4*)(tmp + r * 16 + 8),
                        d = *(const uint4*)(tmp + r * 16 + 12);
            const int rk = (a.x > mine) + (a.y > mine) + (a.z > mine) + (a.w > mine) + (b.x > mine) + (b.y > mine) + (b.z > mine) + (b.w > mine) +
                           (c.x > mine) + (c.y > mine) + (c.z > mine) + (c.w > mine) + (d.x > mine) + (d.y > mine) + (d.z > mine) + (d.w > mine);
            sTop[((hh * 64 + rbase + r) * 2 + ph) * 16 + rk] = mine;
          }
          __builtin_amdgcn_fence(__ATOMIC_RELEASE, "wavefront");
          __builtin_amdgcn_wave_barrier();
        }
        __syncthreads();
      }
    }
    const int ci = kCandI[lane], cj = kCandJ[lane];
    const bool act = lane < 50;
#pragma unroll 1
    for (int tg = 0; tg < 8; ++tg) {
      const int tb = w * 32 + tg * 4;
      unsigned k0[4], k1[4], ku[4], thr[4];
      float v[4];
#pragma unroll
      for (int r = 0; r < 4; ++r) {
        k0[r] = sTop[((tb + r) * 2 + 0) * 16 + ci];
        k1[r] = sTop[((tb + r) * 2 + 1) * 16 + cj];
        v[r] = key_score(k0[r]) + key_score(k1[r]);
        unsigned u = __float_as_uint(v[r]);
        u = (u & 0x80000000u) ? ~u : (u | 0x80000000u);
        ku[r] = act ? (((u >> 16) << 6) | (unsigned)(63 - lane)) : 0u;
        thr[r] = 0u;
      }
#pragma unroll
      for (int bit = 21; bit >= 0; --bit) {
#pragma unroll
        for (int r = 0; r < 4; ++r) {
          const unsigned cand = thr[r] | (1u << bit);
          const int cnt = __popcll(__ballot(ku[r] >= cand));
          thr[r] = (cnt >= 16) ? cand : thr[r];
        }
      }
#pragma unroll
      for (int r = 0; r < 4; ++r) {
        const bool sel = act && (ku[r] >= thr[r]);
        const unsigned long long ms = __ballot(sel);
        const int slot = __builtin_amdgcn_mbcnt_hi((unsigned)(ms >> 32), __builtin_amdgcn_mbcnt_lo((unsigned)ms, 0u));
        const float vmax = __int_as_float(__builtin_amdgcn_readlane(__float_as_int(v[r]), 0));
        const float e = sel ? __expf(v[r] - vmax) : 0.f;
        const float tot = wave_sum(e);
        if (sel) {
          const int eid = (127 - (int)(k0[r] & 127u)) * 128 + (127 - (int)(k1[r] & 127u));
          const size_t o = (size_t)(m0 + tb + r) * 128 + hd * 16 + slot;
          p.experts[o] = eid;
          p.gates[o] = e / tot;
        }
      }
    }
  }
}

template <int PART>
DEVI void phase_peer_gather(const Params& p) {
  const int w0_ = threadIdx.x >> 6;
#pragma unroll 1
  for (int tok = blockIdx.x * 4 + w0_; tok < NTOK; tok += gridDim.x * 4) {
    const int tid = launder(threadIdx.x), lane = tid & 63;
    const uint4* hp4 = (const uint4*)(p.hn + (size_t)tok * LDA + lane * 16);
    float hv[16], xn[16], y[16];
    {
      const uint4 a0 = hp4[0], a1 = hp4[1];
      const unsigned hu[8] = {a0.x, a0.y, a0.z, a0.w, a1.x, a1.y, a1.z, a1.w};
#pragma unroll
      for (int i = 0; i < 8; ++i) { hv[2 * i] = __uint_as_float(hu[i] << 16); hv[2 * i + 1] = __uint_as_float(hu[i] & 0xffff0000u); }
    }
    float ss = 0.f;
#pragma unroll
    for (int i = 0; i < 16; ++i) ss += hv[i] * hv[i];
    ss = wave_sum(ss);
    const float rstd = rsqrtf(ss * (1.f / D) + 1e-6f);
    {
      const float4* g4 = (const float4*)p.peer_g + lane * 4;
      const float4 a0 = g4[0], a1 = g4[1], a2 = g4[2], a3 = g4[3];
      const float gg[16] = {a0.x, a0.y, a0.z, a0.w, a1.x, a1.y, a1.z, a1.w, a2.x, a2.y, a2.z, a2.w, a3.x, a3.y, a3.z, a3.w};
#pragma unroll
      for (int i = 0; i < 16; ++i) { xn[i] = hv[i] * rstd * gg[i]; y[i] = 0.f; }
    }
    const int e0 = p.experts[(size_t)tok * 128 + lane], e1 = p.experts[(size_t)tok * 128 + 64 + lane];
    const float g0 = p.gates[(size_t)tok * 128 + lane], g1 = p.gates[(size_t)tok * 128 + 64 + lane];
    const float su0 = p.uscale[e0], su1 = p.uscale[e1];
    const float sv0 = p.vscale[e0], sv1 = p.vscale[e1];
    float cf0 = 0.f, cf1 = 0.f, dsum = 0.f;
    uint4 ca[8], cb[8];
#define LOADB_(R, bi)                                                                                   \
    _Pragma("unroll") for (int u = 0; u < 8; ++u) {                                                       \
      const int kk_ = (((bi) & 7) << 3) + u;                                                             \
      const int e_ = __builtin_amdgcn_readlane((((bi) >> 3) & 1) ? e1 : e0, kk_);                        \
      R[u] = ((const uint4*)((((bi) >> 4) ? p.vb8 : p.ub8) + (size_t)e_ * 1024))[lane];                  \
    }
#define COMPU_(R, bi)                                                                                   \
    {                                                                                                    \
      float d8[8];                                                                                       \
      _Pragma("unroll") for (int u = 0; u < 8; ++u) {                                                     \
        const unsigned uu[4] = {R[u].x, R[u].y, R[u].z, R[u].w};                                         \
        f32x2 a2 = {0.f, 0.f};                                                                           \
        _Pragma("unroll") for (int j = 0; j < 4; ++j) {                                                   \
          const f32x2 lo = __builtin_amdgcn_cvt_pk_f32_fp8((int)uu[j], false);                           \
          const f32x2 hi = __builtin_amdgcn_cvt_pk_f32_fp8((int)uu[j], true);                            \
          a2 = xn2[2 * j] * lo + a2;                                                                     \
          a2 = xn2[2 * j + 1] * hi + a2;                                                                 \
        }                                                                                                \
        d8[u] = a2[0] + a2[1];                                                                           \
      }                                                                                                  \
          \
      float v4[4], v2[2];                                                                                \
      _Pragma("unroll") for (int i = 0; i < 4; ++i) {                                                     \
        const float snd = b5 ? d8[i] : d8[4 + i], kp = b5 ? d8[4 + i] : d8[i];                           \
        v4[i] = kp + __shfl_xor(snd, 32);                                                                \
      }                                                                                                  \
      _Pragma("unroll") for (int i = 0; i < 2; ++i) {                                                     \
        const float snd = b4 ? v4[i] : v4[2 + i], kp = b4 ? v4[2 + i] : v4[i];                           \
        v2[i] = kp + __shfl_xor(snd, 16);                                                                \
      }                                                                                                  \
      float v1;                                                                                          \
      { const float snd = b3 ? v2[0] : v2[1], kp = b3 ? v2[1] : v2[0]; v1 = kp + __shfl_xor(snd, 8); }   \
      v1 += __shfl_xor(v1, 4);                                                                           \
      v1 += __shfl_xor(v1, 2);                                                                           \
      v1 += __shfl_xor(v1, 1);                                                                           \
                \
      const float got = __shfl(v1, fsrc);                                                                \
      if ((lane >> 3) == ((bi) & 7)) dsum = got;                                                         \
    }                                                                                                    \
    if (((bi) & 7) == 7) {                                                                               \
      if (((bi) >> 3) & 1) cf1 = gelu_tanh(dsum * su1) * g1 * sv1; else cf0 = gelu_tanh(dsum * su0) * g0 * sv0; \
    }
#define COMPV_(R, bi)                                                                                   \
    _Pragma("unroll") for (int u = 0; u < 8; ++u) {                                                       \
      const int kk_ = (((bi) & 7) << 3) + u;                                                             \
      const float ck_ = __int_as_float(__builtin_amdgcn_readlane(__float_as_int((((bi) >> 3) & 1) ? cf1 : cf0), kk_)); \
      const f32x2 ck2 = {ck_, ck_};                                                                      \
      const unsigned uu[4] = {R[u].x, R[u].y, R[u].z, R[u].w};                                           \
      _Pragma("unroll") for (int j = 0; j < 4; ++j) {                                                     \
        const f32x2 lo = __builtin_amdgcn_cvt_pk_f32_fp8((int)uu[j], false);                             \
        const f32x2 hi = __builtin_amdgcn_cvt_pk_f32_fp8((int)uu[j], true);                              \
        y2[2 * j] = ck2 * lo + y2[2 * j];                                                                \
        y2[2 * j + 1] = ck2 * hi + y2[2 * j + 1];                                                        \
      }                                                                                                  \
    }
    const bool b5 = (lane & 32) != 0, b4 = (lane & 16) != 0, b3 = (lane & 8) != 0;
    const int fsrc = ((lane & 4) << 3) | ((lane & 2) << 3) | ((lane & 1) << 3);
    f32x2 xn2[8], y2[8];
#pragma unroll
    for (int i = 0; i < 8; ++i) { xn2[i] = f32x2{xn[2 * i], xn[2 * i + 1]}; y2[i] = f32x2{0.f, 0.f}; }
    if (PART == 0) {
      LOADB_(ca, 0)
#pragma unroll 1
      for (int bi = 0; bi < 16; bi += 2) {
        LOADB_(cb, bi + 1)
        COMPU_(ca, bi)
        if (bi + 2 < 16) { LOADB_(ca, bi + 2) }
        COMPU_(cb, bi + 1)
      }
      p.gates[(size_t)tok * 128 + lane] = cf0;
      p.gates[(size_t)tok * 128 + 64 + lane] = cf1;
      continue;
    }
    cf0 = g0; cf1 = g1;
    LOADB_(ca, 16)
#pragma unroll 1
    for (int bi = 16; bi < 32; bi += 2) {
      LOADB_(cb, bi + 1)
      COMPV_(ca, bi)
      if (bi + 2 < 32) { LOADB_(ca, bi + 2) }
      COMPV_(cb, bi + 1)
    }
#undef LOADB_
#undef COMPU_
#undef COMPV_
#pragma unroll
    for (int i = 0; i < 8; ++i) { y[2 * i] = y2[i][0]; y[2 * i + 1] = y2[i][1]; }
    float s2 = 0.f;
    {
      const uint4 a0 = hp4[0], a1 = hp4[1];
      const unsigned hu[8] = {a0.x, a0.y, a0.z, a0.w, a1.x, a1.y, a1.z, a1.w};
#pragma unroll
      for (int i = 0; i < 8; ++i) {
        y[2 * i] += __uint_as_float(hu[i] << 16);
        y[2 * i + 1] += __uint_as_float(hu[i] & 0xffff0000u);
        s2 += y[2 * i] * y[2 * i] + y[2 * i + 1] * y[2 * i + 1];
      }
    }
    s2 = wave_sum(s2);
    const float rs2 = rsqrtf(s2 * (1.f / D) + 1e-6f);
    {
      const float4* g4 = (const float4*)p.final_g + lane * 4;
      const float4 a0 = g4[0], a1 = g4[1], a2 = g4[2], a3 = g4[3];
      float4* o4 = (float4*)(p.out + (size_t)tok * D) + lane * 4;
      o4[0] = make_float4(y[0] * rs2 * a0.x, y[1] * rs2 * a0.y, y[2] * rs2 * a0.z, y[3] * rs2 * a0.w);
      o4[1] = make_float4(y[4] * rs2 * a1.x, y[5] * rs2 * a1.y, y[6] * rs2 * a1.z, y[7] * rs2 * a1.w);
      o4[2] = make_float4(y[8] * rs2 * a2.x, y[9] * rs2 * a2.y, y[10] * rs2 * a2.z, y[11] * rs2 * a2.w);
      o4[3] = make_float4(y[12] * rs2 * a3.x, y[13] * rs2 * a3.y, y[14] * rs2 * a3.z, y[15] * rs2 * a3.w);
    }
  }
}

#define XB_TMO      128
#define XB_XCNT(j)  (256  + 64 * (j))
#define XB_XSUB(j)  (1280 + 64 * (j))
#define XB_XGEN(j)  (2304 + 64 * (j))
#define XB_TOP      3328
#define XB_TOPGEN   3392
#define XCD_BAR_WORDS 3456
#define XB_SPIN_CAP (1u << 20)
#define LAS __attribute__((address_space(3)))
DEVI unsigned xb_ld(unsigned* q) { return __hip_atomic_load(q, __ATOMIC_RELAXED, __HIP_MEMORY_SCOPE_AGENT); }
DEVI unsigned xb_add(unsigned* q, unsigned v) { return __hip_atomic_fetch_add(q, v, __ATOMIC_RELAXED, __HIP_MEMORY_SCOPE_AGENT); }
DEVI unsigned xb_xcc_id() { return (unsigned)__builtin_amdgcn_s_getreg((3 << 11) | 20) & 0xFu; }
#define XB_SPIN(cond, bar) do { unsigned _sp = 0; while (cond) { __builtin_amdgcn_s_sleep(1); \
    if ((++_sp & 255u) == 0u) { if (xb_ld(&(bar)[XB_TMO])) break; if (_sp > XB_SPIN_CAP) { atomicAdd(&(bar)[XB_TMO], 1u); break; } } } } while (0)
struct XcdBarrier { unsigned* bar; unsigned x; volatile LAS unsigned* st; };
DEVI XcdBarrier xcd_barrier_post(unsigned* bar, volatile LAS unsigned* st) {
  XcdBarrier b; b.bar = bar; b.x = xb_xcc_id(); b.st = st;
  if (threadIdx.x == 0) (void)xb_add(&bar[XB_XCNT(b.x)], 1u);
  return b;
}
DEVI void xcd_barrier_complete(unsigned* bar, unsigned x, unsigned& nloc, unsigned& nx) {
  const unsigned G = gridDim.x * gridDim.y * gridDim.z;
  unsigned sum, cnt, mine, sp = 0u;
  for (;;) {
    sum = 0u; cnt = 0u; mine = 0u;
#pragma unroll
    for (unsigned j = 0; j < 16; ++j) { const unsigned c = xb_ld(&bar[XB_XCNT(j)]); sum += c; cnt += (c > 0u) ? 1u : 0u; mine = (j == x) ? c : mine; }
    if (sum == G) break;
    __builtin_amdgcn_s_sleep(1);
    if ((++sp & 255u) == 0u) { if (xb_ld(&bar[XB_TMO])) break; if (sp > XB_SPIN_CAP) { atomicAdd(&bar[XB_TMO], 1u); break; } }
  }
  nloc = mine > 0u ? mine : 1u; nx = cnt > 0u ? cnt : 1u;
}
DEVI void xcd_barrier(const XcdBarrier& b) {
  asm volatile("s_waitcnt vmcnt(0)" ::: "memory");
  __syncthreads();
  if (threadIdx.x == 0) {
    unsigned* bar = b.bar;
    __builtin_amdgcn_s_waitcnt(0);
    unsigned nloc = b.st[0], nx = b.st[1];
    if (nloc == 0u) { xcd_barrier_complete(bar, b.x, nloc, nx); b.st[0] = nloc; b.st[1] = nx; }
    const unsigned old = xb_add(&bar[XB_XSUB(b.x)], 1u);
    const unsigned gen = old / nloc;
    if (old + 1u == (gen + 1u) * nloc) {
      __builtin_amdgcn_fence(__ATOMIC_RELEASE, "agent");
      asm volatile("s_waitcnt vmcnt(0)" ::: "memory");
      const unsigned og = xb_add(&bar[XB_TOP], 1u);
      const unsigned tg = og / nx;
      if (og + 1u == (tg + 1u) * nx) xb_add(&bar[XB_TOPGEN], 1u);
      else XB_SPIN(xb_ld(&bar[XB_TOPGEN]) == tg, bar);
      __builtin_amdgcn_fence(__ATOMIC_ACQUIRE, "agent");
      xb_add(&bar[XB_XGEN(b.x)], 1u);
      asm volatile("s_waitcnt vmcnt(0)" ::: "memory");
    } else {
      XB_SPIN(xb_ld(&bar[XB_XGEN(b.x)]) == gen, bar);
      __builtin_amdgcn_fence(__ATOMIC_ACQUIRE, "agent");
      asm volatile("s_waitcnt vmcnt(0)" ::: "memory");
    }
  }
  __syncthreads();
}

template <bool COOP>
__global__ void __launch_bounds__(256, 2) mega(Params p, int ph_lo, int ph_hi) {
  __shared__ __attribute__((aligned(16))) unsigned char smem[SMEM_BYTES];
  __shared__ uint4 xb_words;
  if (threadIdx.x == 0) xb_words = make_uint4(0u, 0u, 0u, 0u);
  __syncthreads();
  XcdBarrier xb = xcd_barrier_post(p.bar, (volatile LAS unsigned*)&xb_words);
  (void)xb;
  if (COOP && ph_hi > 1000) cg::this_grid().sync();
#ifdef REPEAT_MASK
#define RUN_PHASE(i, call)                                                                   \
  if (ph_lo <= (i) && (i) <= ph_hi) {                                                        \
    call;                                                                                    \
    if (COOP && ((REPEAT_MASK >> (i)) & 1)) { xcd_barrier(xb); call; }                       \
    if (COOP && (i) < ph_hi) xcd_barrier(xb);                                                \
  }
#else
#define RUN_PHASE(i, call)                                                                   \
  if (ph_lo <= (i) && (i) <= ph_hi) {                                                        \
    call;                                                                                    \
    if (COOP && (i) < ph_hi) {                                                               \
      xcd_barrier(xb);                                                                       \
    }                                                                                        \
  }
#endif
  RUN_PHASE(0, phase0(p))
  RUN_PHASE(1, phase1(p, smem))
  RUN_PHASE(2, phase2(p, smem))
  RUN_PHASE(3, phase3(p, smem))
  RUN_PHASE(4, phase_nsa(p, smem))
  RUN_PHASE(5, phase_resid<false>(p, smem, p.mix, p.woutT, p.x, p.ssq1))
  RUN_PHASE(6, phase_scaled(p, smem, p.hn, p.wmqT, 8, p.ssq1, p.qm, LDA))
  RUN_PHASE(7, phase_memattn(p, smem))
  RUN_PHASE(8, phase_resid<true>(p, smem, p.mix, p.wmoT, nullptr, p.ssq2))
  RUN_PHASE(9, phase_scaled(p, smem, p.hn, p.wpqT, 16, p.ssq2, p.pq, LDPQ))
  RUN_PHASE(10, phase_peer_route(p, smem))
  RUN_PHASE(11, phase_peer_gather<0>(p))
  RUN_PHASE(12, phase_peer_gather<1>(p))
#undef RUN_PHASE
}

extern "C" void kernel_launch(void* const* d_in, const int* in_sizes, int n_in, void* d_out, int out_size, void* d_ws,
                              size_t ws_size, hipStream_t stream) {
  (void)in_sizes; (void)n_in; (void)out_size; (void)ws_size;
  Params p{};
  p.x = (const float*)d_in[0]; p.mem = (const float*)d_in[1]; p.pos = (const int*)d_in[2];
  p.mix_g = (const float*)d_in[3]; p.w_in = (const float*)d_in[4]; p.conv_w = (const float*)d_in[5];
  p.conv_b = (const float*)d_in[6]; p.ln_g = (const float*)d_in[7]; p.ln_b = (const float*)d_in[8];
  p.cmp_pos = (const float*)d_in[9]; p.cmp_w1 = (const float*)d_in[10]; p.cmp_b1 = (const float*)d_in[11];
  p.cmp_w2 = (const float*)d_in[12]; p.cmp_b2 = (const float*)d_in[13]; p.w_out = (const float*)d_in[14];
  p.memq_g = (const float*)d_in[15]; p.memkv_g = (const float*)d_in[16]; p.w_mq = (const float*)d_in[17];
  p.w_mk = (const float*)d_in[18]; p.w_mv = (const float*)d_in[19]; p.w_mo = (const float*)d_in[20];
  p.peer_g = (const float*)d_in[21]; p.peer_wq = (const float*)d_in[22]; p.peer_sk = (const float*)d_in[23];
  p.peer_u = (const float*)d_in[24]; p.peer_v = (const float*)d_in[25]; p.final_g = (const float*)d_in[26];
  p.out = (float*)d_out;
  unsigned char* ws = (unsigned char*)d_ws;
  size_t off = 0;
  auto take = [&](size_t bytes) { unsigned char* r = ws + off; off += (bytes + 255) & ~(size_t)255; return r; };
  unsigned char* regA = take((size_t)NTOK * LDA * 2);
  unsigned char* regB = take((size_t)NTOK * LDP * 2);
  unsigned char* regC = take((size_t)NTOK * LDA * 2);
  p.hn = (u16*)regA;
  p.proj = (u16*)regB; p.qm = (u16*)regB; p.pq = (u16*)regB;
  p.mix = (u16*)regC; p.experts = (int*)regC; p.gates = (float*)(regC + (size_t)NTOK * 128 * 4);
  {
    unsigned char* tb = regC + (size_t)2 * NTOK * 128 * 4;
    p.ub8 = tb; p.vb8 = tb + (size_t)16384 * 1024;
    p.uscale = (float*)(tb + (size_t)2 * 16384 * 1024); p.vscale = p.uscale + 16384;
  }
  p.h = nullptr;
  p.vts = (u16*)take((size_t)Bn * 2 * 64 * LDT * 2);
  p.vtw = (u16*)take((size_t)Bn * 2 * 64 * LDT * 2);
  p.memn = (u16*)take((size_t)Bn * 256 * LDA * 2);
  p.memk = (u16*)take((size_t)Bn * 256 * LDA * 2);
  p.memvt = (u16*)take((size_t)Bn * 256 * D * 2);
  p.winT = (u16*)take((size_t)2432 * LDA * 2);
  p.woutT = (u16*)take((size_t)1024 * LDA * 2);
  p.wmqT = (u16*)take((size_t)1024 * LDA * 2);
  p.wmkT = (u16*)take((size_t)1024 * LDA * 2);
  p.wmvT = (u16*)take((size_t)1024 * LDA * 2);
  p.wmoT = (u16*)take((size_t)1024 * LDA * 2);
  p.wpqT = (u16*)take((size_t)2048 * LDA * 2);
  p.subk = (u16*)take((size_t)16 * 128 * 128 * 2);
  p.w1T = (u16*)take((size_t)2 * 128 * LDW1 * 2);
  p.w2T = (u16*)take((size_t)2 * 128 * 128 * 2);
  p.biasp = (float*)take(256 * 4);
  p.rope = (float*)take((size_t)NTOK * 16 * 4);
  p.hdn = (u16*)take((size_t)2 * 4096 * 128 * 2);
  p.kc = (u16*)take((size_t)Bn * 2 * 128 * 64 * 2);
  p.vcT = (u16*)take((size_t)Bn * 2 * 64 * 128 * 2);
  p.ssq1 = (float*)take((size_t)NTOK * 4);
  p.ssq2 = (float*)take((size_t)NTOK * 4);
  p.bar = (unsigned*)take(16384);
  if (off > ws_size) { fprintf(stderr, "workspace too small: need %zu have %zu\n", off, ws_size); return; }

#if COOP_MODE
  static int grid_blocks = 0;
  if (!grid_blocks) {
    int dev = 0, cus = 0, per_cu = 0;
    hipGetDevice(&dev);
    hipDeviceGetAttribute(&cus, hipDeviceAttributeMultiprocessorCount, dev);
    hipOccupancyMaxActiveBlocksPerMultiprocessor(&per_cu, mega<true>, 256, 0);
    if (per_cu > 2) per_cu = 2;
    if (per_cu < 1) per_cu = 1;
    grid_blocks = cus * per_cu;
  }
  int lo = 0, hi = NPHASE;
  void* args[] = {&p, &lo, &hi};
  (void)hipMemsetAsync(p.bar, 0, 16384, stream);
  hipError_t e = hipLaunchCooperativeKernel((void*)mega<true>, dim3(grid_blocks), dim3(256), args, 0, stream);
  if (e != hipSuccess) fprintf(stderr, "cooperative launch failed: %s (grid %d)\n", hipGetErrorString(e), grid_blocks);
#else
  for (int ph = 0; ph <= NPHASE; ++ph) mega<false><<<dim3(512), dim3(256), 0, stream>>>(p, ph, ph);
#endif
}
```

```cpp
#include <hip/hip_runtime.h>
#include <hip/hip_bf16.h>
#include <hip/hip_cooperative_groups.h>
#include <cstdio>
#include <cstdint>
namespace cg = cooperative_groups;

#ifndef COOP_MODE
#define COOP_MODE 1
#endif

typedef __attribute__((ext_vector_type(8))) short bf16x8;
typedef __attribute__((ext_vector_type(4))) short bf16x4;
typedef __attribute__((ext_vector_type(4))) float f32x4;
typedef unsigned short u16;

#define DEVI __device__ __forceinline__

constexpr int Bn = 16, T = 2048, D = 1024, NTOK = Bn * T, LDP = 2336;
constexpr int C_Q = 1024, C_KC = 1536, C_VC = 1664, C_KS = 1792, C_VS = 1920, C_KW = 2048, C_VW = 2176, C_GATE = 2304;
constexpr int SMEM_BYTES = 73728;
constexpr int LDA = 1088;
constexpr int LDHF = 1056;
constexpr int LDPQ = 2112;
constexpr int LDW1 = 2112;
constexpr int LDT = 2112;
constexpr int NPHASE = 12;

struct Params {
  const float* x; const float* mem; const int* pos; const float* mix_g; const float* w_in;
  const float* conv_w; const float* conv_b; const float* ln_g; const float* ln_b;
  const float* cmp_pos; const float* cmp_w1; const float* cmp_b1; const float* cmp_w2; const float* cmp_b2;
  const float* w_out; const float* memq_g; const float* memkv_g; const float* w_mq; const float* w_mk;
  const float* w_mv; const float* w_mo; const float* peer_g; const float* peer_wq; const float* peer_sk;
  const float* peer_u; const float* peer_v; const float* final_g;
  float* out;
  u16* hn; u16* proj; u16* mix; float* h; u16* vts; u16* vtw; u16* memn; u16* memk; u16* memvt;
  u16* winT; u16* woutT; u16* wmqT; u16* wmkT; u16* wmvT; u16* wmoT; u16* wpqT; u16* subk; u16* w1T; u16* w2T;
  float* biasp; float* rope; u16* hdn; u16* kc; u16* vcT; float* ssq1; float* ssq2;
  int* experts; float* gates; unsigned char* ub8; unsigned char* vb8; float* uscale; float* vscale; u16* qm; u16* pq;
  unsigned* bar;
};

DEVI int launder(int x) { asm volatile("" : "+v"(x)); return x; }
DEVI u16 f2bf(float f) {
  unsigned u = __float_as_uint(f);
  u += 0x7fffu + ((u >> 16) & 1u);
  return (u16)(u >> 16);
}
DEVI float bf2f(u16 h) { return __uint_as_float(((unsigned)h) << 16); }
DEVI unsigned pack2(float a, float b) { return (unsigned)f2bf(a) | ((unsigned)f2bf(b) << 16); }
DEVI float wave_sum(float v) {
#pragma unroll
  for (int o = 32; o; o >>= 1) v += __shfl_xor(v, o);
  return v;
}
DEVI float sigmoidf_(float x) { return 1.f / (1.f + __expf(-x)); }
DEVI float gelu_tanh(float x) {
  float u = 0.7978845608028654f * (x + 0.044715f * x * x * x);
  return 0.5f * x * (1.f + tanhf(u));
}
DEVI f32x4 mfma16(bf16x8 a, bf16x8 b, f32x4 c) { return __builtin_amdgcn_mfma_f32_16x16x32_bf16(a, b, c, 0, 0, 0); }
DEVI float fexp2(float x) { return __builtin_amdgcn_exp2f(x); }

DEVI void tconv(const float* __restrict__ src, int K, int N, u16* __restrict__ dst, int Npad, int ldd,
                const float* __restrict__ gain, int gtid, int gsz) {
  const int items = Npad * (K >> 3);
  for (int it = gtid; it < items; it += gsz) {
    const int n = it % Npad, kc = it / Npad;
    float f[8];
#pragma unroll
    for (int j = 0; j < 8; ++j) {
      float v = 0.f;
      if (n < N) {
        v = src[(size_t)(kc * 8 + j) * N + n];
        if (gain) v *= gain[kc * 8 + j];
      }
      f[j] = v;
    }
    uint4 pk;
    pk.x = pack2(f[0], f[1]); pk.y = pack2(f[2], f[3]); pk.z = pack2(f[4], f[5]); pk.w = pack2(f[6], f[7]);
    *(uint4*)(dst + (size_t)n * ldd + kc * 8) = pk;
  }
}

DEVI void conv_flat(const float* __restrict__ src, u16* __restrict__ dst, size_t n8, size_t gtid, size_t gsz) {
  for (size_t it = gtid; it < n8; it += gsz) {
    const float4 a = ((const float4*)src)[2 * it], b = ((const float4*)src)[2 * it + 1];
    uint4 pk;
    pk.x = pack2(a.x, a.y); pk.y = pack2(a.z, a.w); pk.z = pack2(b.x, b.y); pk.w = pack2(b.z, b.w);
    ((uint4*)dst)[it] = pk;
  }
}


typedef float f32x2 __attribute__((ext_vector_type(2)));
DEVI unsigned pk4_fp8(float a, float b, float c, float d) {
  int v = 0;
  v = __builtin_amdgcn_cvt_pk_fp8_f32(a, b, v, false);
  v = __builtin_amdgcn_cvt_pk_fp8_f32(c, d, v, true);
  return (unsigned)v;
}
DEVI void conv_fp8_rows(const float* __restrict__ src, unsigned char* __restrict__ dst, float* __restrict__ inv_scale,
                        int rows, int gw, int nw, int lane) {
  for (int r0 = gw; r0 < rows; r0 += 2 * nw) {
    const int r1 = r0 + nw;
    const bool has1 = r1 < rows;
    const float4* p0 = (const float4*)(src + (size_t)r0 * 1024) + lane * 4;
    const float4* p1 = (const float4*)(src + (size_t)(has1 ? r1 : r0) * 1024) + lane * 4;
    float4 v[2][4];
#pragma unroll
    for (int i = 0; i < 4; ++i) { v[0][i] = p0[i]; v[1][i] = p1[i]; }
    float mx[2];
#pragma unroll
    for (int q = 0; q < 2; ++q) {
      float m = 0.f;
#pragma unroll
      for (int i = 0; i < 4; ++i)
        m = fmaxf(m, fmaxf(fmaxf(fabsf(v[q][i].x), fabsf(v[q][i].y)), fmaxf(fabsf(v[q][i].z), fabsf(v[q][i].w))));
      mx[q] = m;
    }
#pragma unroll
    for (int o = 32; o; o >>= 1) { mx[0] = fmaxf(mx[0], __shfl_xor(mx[0], o)); mx[1] = fmaxf(mx[1], __shfl_xor(mx[1], o)); }
#pragma unroll
    for (int q = 0; q < 2; ++q) {
      if (q == 1 && !has1) break;
      const int r = q ? r1 : r0;
      const float sc = mx[q] > 0.f ? 224.f / mx[q] : 1.f;
      if (lane == 0) inv_scale[r] = mx[q] > 0.f ? mx[q] * (1.f / 224.f) : 1.f;
      uint4 o4;
      o4.x = pk4_fp8(v[q][0].x * sc, v[q][0].y * sc, v[q][0].z * sc, v[q][0].w * sc);
      o4.y = pk4_fp8(v[q][1].x * sc, v[q][1].y * sc, v[q][1].z * sc, v[q][1].w * sc);
      o4.z = pk4_fp8(v[q][2].x * sc, v[q][2].y * sc, v[q][2].z * sc, v[q][2].w * sc);
      o4.w = pk4_fp8(v[q][3].x * sc, v[q][3].y * sc, v[q][3].z * sc, v[q][3].w * sc);
      ((uint4*)(dst + (size_t)r * 1024))[lane] = o4;
    }
  }
}

DEVI void rownorm_bf16(const float* __restrict__ src, const float* __restrict__ g, u16* __restrict__ dst,
                       int rows, int gw, int nw, int lane) {
  for (int r0 = gw; r0 < rows; r0 += 2 * nw) {
    const int r1 = r0 + nw;
    const bool has1 = r1 < rows;
    const float4* pa = (const float4*)(src + (size_t)r0 * D);
    const float4* pb = (const float4*)(src + (size_t)(has1 ? r1 : r0) * D);
    float4 va[4], vb[4];
    float sa = 0.f, sb = 0.f;
#pragma unroll
    for (int i = 0; i < 4; ++i) { va[i] = pa[lane + 64 * i]; vb[i] = pb[lane + 64 * i]; }
#pragma unroll
    for (int i = 0; i < 4; ++i) {
      sa += va[i].x * va[i].x + va[i].y * va[i].y + va[i].z * va[i].z + va[i].w * va[i].w;
      sb += vb[i].x * vb[i].x + vb[i].y * vb[i].y + vb[i].z * vb[i].z + vb[i].w * vb[i].w;
    }
#pragma unroll
    for (int o = 32; o; o >>= 1) { sa += __shfl_xor(sa, o); sb += __shfl_xor(sb, o); }
    const float ra = rsqrtf(sa * (1.f / D) + 1e-6f), rb = rsqrtf(sb * (1.f / D) + 1e-6f);
#pragma unroll
    for (int i = 0; i < 4; ++i) {
      const float4 gg = ((const float4*)g)[lane + 64 * i];
      uint2 pk;
      pk.x = pack2(va[i].x * ra * gg.x, va[i].y * ra * gg.y);
      pk.y = pack2(va[i].z * ra * gg.z, va[i].w * ra * gg.w);
      *(uint2*)(dst + (size_t)r0 * LDA + (size_t)(lane + 64 * i) * 4) = pk;
      if (has1) {
        pk.x = pack2(vb[i].x * rb * gg.x, vb[i].y * rb * gg.y);
        pk.y = pack2(vb[i].z * rb * gg.z, vb[i].w * rb * gg.w);
        *(uint2*)(dst + (size_t)r1 * LDA + (size_t)(lane + 64 * i) * 4) = pk;
      }
    }
  }
}

DEVI void phase0(const Params& p) {
  const int tid = launder(threadIdx.x), lane = tid & 63;
  const int gtid = blockIdx.x * 256 + tid, gsz = gridDim.x * 256;
  const int gw = gtid >> 6, nw = gsz >> 6;
  rownorm_bf16(p.x, p.mix_g, p.hn, NTOK, gw, nw, lane);
  rownorm_bf16(p.mem, p.memkv_g, p.memn, Bn * 256, gw, nw, lane);
  tconv(p.w_in, 1024, 2328, p.winT, 2432, LDA, nullptr, gtid, gsz);
  tconv(p.w_out, 1024, 1024, p.woutT, 1024, LDA, nullptr, gtid, gsz);
  tconv(p.w_mq, 1024, 1024, p.wmqT, 1024, LDA, p.memq_g, gtid, gsz);
  tconv(p.w_mk, 1024, 1024, p.wmkT, 1024, LDA, nullptr, gtid, gsz);
  tconv(p.w_mv, 1024, 1024, p.wmvT, 1024, LDA, nullptr, gtid, gsz);
  tconv(p.w_mo, 1024, 1024, p.wmoT, 1024, LDA, nullptr, gtid, gsz);
  tconv(p.peer_wq, 1024, 2048, p.wpqT, 2048, LDA, p.peer_g, gtid, gsz);
  tconv(p.cmp_w1, 2048, 128, p.w1T, 128, LDW1, nullptr, gtid, gsz);
  tconv(p.cmp_w1 + 2048 * 128, 2048, 128, p.w1T + 128 * LDW1, 128, LDW1, nullptr, gtid, gsz);
  tconv(p.cmp_w2, 128, 64, p.w2T, 128, 128, nullptr, gtid, gsz);
  tconv(p.cmp_w2 + 128 * 64, 128, 64, p.w2T + 128 * 128, 128, 128, nullptr, gtid, gsz);
  conv_flat(p.peer_sk, p.subk, (size_t)16 * 128 * 128 / 8, gtid, gsz);
  for (int it = gtid; it < NTOK * 8; it += gsz) {
    const int tok = it >> 3, i = it & 7;
    const float inv = (i == 0) ? 1.000000000e+00f : (i == 1) ? 1.939227432e-01f : (i == 2) ? 3.760603070e-02f : (i == 3) ? 7.292664610e-03f : (i == 4) ? 1.414213562e-03f : (i == 5) ? 2.742481884e-04f : (i == 6) ? 5.318295734e-05f : 1.031338525e-05f;
    const float ang = (float)p.pos[tok] * inv;
    float sv, cv;
    sincosf(ang, &sv, &cv);
    p.rope[tok * 16 + i] = cv;
    p.rope[tok * 16 + 8 + i] = sv;
  }
  for (int o = gw; o < 256; o += nw) {
    const int ty = o >> 7, n = o & 127;
    float s = 0.f;
#pragma unroll 8
    for (int k = lane; k < 2048; k += 64)
      s += p.cmp_pos[ty * 2048 + k] * p.cmp_w1[((size_t)ty * 2048 + k) * 128 + n];
    s = wave_sum(s);
    if (lane == 0) p.biasp[o] = s + p.cmp_b1[o];
  }
  for (int it = gtid; it < NTOK; it += gsz) { p.ssq1[it] = 0.f; p.ssq2[it] = 0.f; }
}

template <bool DB, class AF>
DEVI void gemm_mainloop(int tid, u16* sA, u16* sB, AF af, const u16* __restrict__ Bt, int ldb, int m0, int n0, int nk,
                        f32x4 (&acc)[4][4]) {
  const int lane = tid & 63, w = tid >> 6;
  const int wm = w >> 1, wn = w & 1, col = lane & 15, quad = lane >> 4;
#pragma unroll
  for (int i = 0; i < 4; ++i)
#pragma unroll
    for (int j = 0; j < 4; ++j) acc[i][j] = f32x4{0.f, 0.f, 0.f, 0.f};
  uint4 ra0, ra1, ra2, ra3, rb0, rb1, rb2, rb3;
  const int lrow = tid >> 3, lkc = (tid & 7) << 3;
  const u16* bbase = Bt + (size_t)(n0 + lrow) * ldb + lkc;
#define GL_(R, i, kk)                                                     \
  R##a##i = *(const uint4*)af(m0 + lrow + 32 * i, (kk) + lkc);            \
  R##b##i = *(const uint4*)(bbase + (size_t)(32 * i) * ldb + (kk));
#define SS_(R, i, off)                                                    \
  *(uint4*)(sA + (off) + (lrow + 32 * i) * 72 + lkc) = R##a##i;           \
  *(uint4*)(sB + (off) + (lrow + 32 * i) * 72 + lkc) = R##b##i;
#define GL4_(R, kk) GL_(R, 0, kk) GL_(R, 1, kk) GL_(R, 2, kk) GL_(R, 3, kk)
#define SS4_(R, off) SS_(R, 0, off) SS_(R, 1, off) SS_(R, 2, off) SS_(R, 3, off)
#define COMPUTE_(cur)                                                                                                   \
  _Pragma("unroll") for (int ks = 0; ks < 2; ++ks) {                                                                    \
    bf16x8 fa[4], fb[4];                                                                                                \
    _Pragma("unroll") for (int mi = 0; mi < 4; ++mi)                                                                    \
      fa[mi] = *(const bf16x8*)(sA + (cur) + (wm * 64 + 16 * mi + col) * 72 + 32 * ks + 8 * quad);                      \
    _Pragma("unroll") for (int ni = 0; ni < 4; ++ni)                                                                    \
      fb[ni] = *(const bf16x8*)(sB + (cur) + (wn * 64 + 16 * ni + col) * 72 + 32 * ks + 8 * quad);                      \
    _Pragma("unroll") for (int ni = 0; ni < 4; ++ni)                                                                    \
      _Pragma("unroll") for (int mi = 0; mi < 4; ++mi) acc[ni][mi] = mfma16(fb[ni], fa[mi], acc[ni][mi]);               \
  }
  if (DB) {
    const int srow = 8 * w + (lane >> 3);
    const int spc = lane & 7;
#define STAGE_(st, kk)                                                                                         \
    _Pragma("unroll") for (int i = 0; i < 4; ++i) {                                                            \
      const int r_ = 32 * i + srow;                                                                            \
      const int c_ = (spc ^ ((r_ >> 1) & 7)) << 3;                                                             \
      __builtin_amdgcn_global_load_lds((const unsigned*)af(m0 + r_, (kk) + c_),                                \
                                       (unsigned*)(sA + (st) * 16384 + (32 * i + 8 * w) * 64), 16, 0, 0);      \
      __builtin_amdgcn_global_load_lds((const unsigned*)(Bt + (size_t)(n0 + r_) * ldb + (kk) + c_),            \
                                       (unsigned*)(sA + (st) * 16384 + 8192 + (32 * i + 8 * w) * 64), 16, 0, 0); \
    }
#define COMPUTE_SW_(st)                                                                                                 \
  _Pragma("unroll") for (int ks = 0; ks < 2; ++ks) {                                                                    \
    bf16x8 fa[4], fb[4];                                                                                                \
    const int pc_ = ((4 * ks + quad) ^ ((col >> 1) & 7)) << 3;                                                          \
    _Pragma("unroll") for (int mi = 0; mi < 4; ++mi)                                                                    \
      fa[mi] = *(const bf16x8*)(sA + (st) * 16384 + (wm * 64 + 16 * mi + col) * 64 + pc_);                              \
    _Pragma("unroll") for (int ni = 0; ni < 4; ++ni)                                                                    \
      fb[ni] = *(const bf16x8*)(sA + (st) * 16384 + 8192 + (wn * 64 + 16 * ni + col) * 64 + pc_);                       \
    _Pragma("unroll") for (int ni = 0; ni < 4; ++ni)                                                                    \
      _Pragma("unroll") for (int mi = 0; mi < 4; ++mi) acc[ni][mi] = mfma16(fb[ni], fa[mi], acc[ni][mi]);               \
  }
    STAGE_(0, 0)
#pragma unroll 1
    for (int kt = 0; kt < nk; kt += 2) {
      asm volatile("s_waitcnt vmcnt(0)" ::: "memory");
      __syncthreads();
      { const int kk = (kt + 1) * 64; STAGE_(1, kk) }
      COMPUTE_SW_(0)
      asm volatile("s_waitcnt vmcnt(0)" ::: "memory");
      __syncthreads();
      if (kt + 2 < nk) { const int kk = (kt + 2) * 64; STAGE_(0, kk) }
      COMPUTE_SW_(1)
    }
#undef STAGE_
#undef COMPUTE_SW_
  } else {
    GL4_(r, 0)
    SS4_(r, 0)
    __syncthreads();
#pragma unroll 1
    for (int kt = 0; kt < nk; ++kt) {
      const bool more = (kt + 1 < nk);
      if (more) { const int kk = (kt + 1) * 64; GL4_(r, kk) }
      COMPUTE_(0)
      __syncthreads();
      if (more) {
        SS4_(r, 0)
        __syncthreads();
      }
    }
  }
#undef GL_
#undef SS_
#undef GL4_
#undef SS4_
#undef COMPUTE_
}

struct ARow {
  const u16* base; int lda;
  DEVI const u16* operator()(int m, int k) const { return base + (size_t)m * lda + k; }
};
struct ACmp {
  const u16* proj; int colbase;
  DEVI const u16* operator()(int rr, int k) const {
    const int b = rr >> 8, g = (rr >> 7) & 1;
    int c = rr & 127; c = c > 126 ? 126 : c;
    const int l = k >> 6, d = k & 63;
    return proj + ((size_t)b * T + 16 * c + l) * LDP + colbase + g * 64 + d;
  }
};


#define XCD_TILE_LOOP(idx, MT, NT)                                                                     \
  const bool sw_ = (gridDim.x & 7) == 0;                                                               \
  const int xcd_ = blockIdx.x & 7;                                                                     \
  const int tstart_ = sw_ ? (int)(blockIdx.x >> 3) : (int)blockIdx.x;                                  \
  const int tstep_ = sw_ ? (int)(gridDim.x >> 3) : (int)gridDim.x;                                     \
  const int ttotal_ = sw_ ? ((MT) / 8) * (NT) : (MT) * (NT);                                           \
  _Pragma("unroll 1") for (int idx = tstart_; idx < ttotal_; idx += tstep_)
#define XCD_TILE_MT(idx, NT) (sw_ ? ((idx) / (NT)) * 8 + xcd_ : (idx) / (NT))
#define XCD_TILE_NT(idx, NT) ((idx) % (NT))

#define GEMM_LANE_VARS                                                    \
  const int tid = launder(threadIdx.x), lane = tid & 63, w = tid >> 6;    \
  const int wm = w >> 1, wn = w & 1, col = lane & 15, quad = lane >> 4;   \
  (void)wm; (void)wn; (void)col; (void)quad;

DEVI void phase1(const Params& p, unsigned char* smem) {
  u16* sA = (u16*)smem; u16* sB = sA + 128 * 72;
  XCD_TILE_LOOP(idx, 256 + 32, 19) {
    GEMM_LANE_VARS
    f32x4 acc[4][4];
    const int mt = XCD_TILE_MT(idx, 19), nt_ = XCD_TILE_NT(idx, 19);
    if (mt < 256) {
      const int m0 = mt * 128, n0 = nt_ * 128;
      gemm_mainloop<true>(tid, sA, sB, ARow{p.hn, LDA}, p.winT, LDA, m0, n0, 16, acc);
#pragma unroll
      for (int mi = 0; mi < 4; ++mi) {
        const int m = m0 + wm * 64 + 16 * mi + col;
        const int b = m >> 11, t = m & 2047;
#pragma unroll
        for (int ni = 0; ni < 4; ++ni) {
          const int nt = n0 + wn * 64 + 16 * ni;
          const int n = nt + 4 * quad;
          f32x4 v = acc[ni][mi];
          if (nt >= LDP) continue;
          if ((nt >= C_VS && nt < C_KW) || (nt >= C_VW && nt < C_GATE)) {
            const bool isw = nt >= C_VW;
            const int off = n - (isw ? C_VW : C_VS);
            const int g = off >> 6, d = off & 63;
            u16* dst = (isw ? p.vtw : p.vts) + ((size_t)(b * 2 + g) * 64 + d) * LDT + t;
#pragma unroll
            for (int r = 0; r < 4; ++r) dst[(size_t)r * LDT] = f2bf(v[r]);
          } else {
            const bool rope_tile = ((nt >= C_KS && nt < C_VS) || (nt >= C_KW && nt < C_VW)) && ((nt & 63) == 0);
            if (rope_tile) {
#pragma unroll
              for (int r = 0; r < 4; ++r) {
                const float pr = __shfl_xor(v[r], 32);
                const int i = ((quad & 1) << 2) + r;
                const float cs = p.rope[(size_t)m * 16 + i], sn = p.rope[(size_t)m * 16 + 8 + i];
                v[r] = (quad < 2) ? (v[r] * cs - pr * sn) : (v[r] * cs + pr * sn);
              }
            }
            uint2 pk; pk.x = pack2(v[0], v[1]); pk.y = pack2(v[2], v[3]);
            *(uint2*)(p.proj + (size_t)m * LDP + n) = pk;
          }
        }
      }
    } else if (nt_ < 16) {
      const int isv = nt_ >> 3;
      const int m0 = (mt - 256) * 128, n0 = (nt_ & 7) * 128;
      gemm_mainloop<true>(tid, sA, sB, ARow{p.memn, LDA}, isv ? p.wmvT : p.wmkT, LDA, m0, n0, 16, acc);
#pragma unroll
      for (int mi = 0; mi < 4; ++mi) {
        const int m = m0 + wm * 64 + 16 * mi + col;
        const int b = m >> 8, key = m & 255;
#pragma unroll
        for (int ni = 0; ni < 4; ++ni) {
          const int n = n0 + wn * 64 + 16 * ni + 4 * quad;
          const f32x4 v = acc[ni][mi];
          if (isv) {
            const int head = n >> 8, d = n & 255;
            u16* dst = p.memvt + ((size_t)(b * 4 + head) * 256 + d) * 256 + key;
#pragma unroll
            for (int r = 0; r < 4; ++r) dst[r * 256] = f2bf(v[r]);
          } else {
            uint2 pk; pk.x = pack2(v[0], v[1]); pk.y = pack2(v[2], v[3]);
            *(uint2*)(p.memk + (size_t)m * LDA + n) = pk;
          }
        }
      }
    }
  }
}

DEVI void conv_tile(const Params& p, unsigned char* smem, int ct) {
  u16* sU = (u16*)smem;
  float2* sRed = (float2*)(smem + 62 * 512 * 2);
  const int tid = launder(threadIdx.x), lane = tid & 63, w = tid >> 6;
  const int b = ct >> 6, t0 = (ct & 63) * 32;
  __syncthreads();
  for (int it = tid; it < 62 * 64; it += 256) {
    const int r = it >> 6, c8 = it & 63;
    const int t = t0 - 30 + r;
    uint4 pk = {0u, 0u, 0u, 0u};
    if (t >= 0) {
      const u16* src = p.proj + ((size_t)b * T + t) * LDP + c8 * 8;
      const uint4 a = *(const uint4*)src, bb = *(const uint4*)(src + 512);
      const unsigned au[4] = {a.x, a.y, a.z, a.w}, bu[4] = {bb.x, bb.y, bb.z, bb.w};
      unsigned o[4];
#pragma unroll
      for (int j = 0; j < 4; ++j) {
        const float a0 = __uint_as_float(au[j] << 16), a1 = __uint_as_float(au[j] & 0xffff0000u);
        const float b0 = __uint_as_float(bu[j] << 16), b1 = __uint_as_float(bu[j] & 0xffff0000u);
        o[j] = pack2(a0 * sigmoidf_(b0), a1 * sigmoidf_(b1));
      }
      pk.x = o[0]; pk.y = o[1]; pk.z = o[2]; pk.w = o[3];
    }
    *(uint4*)(sU + r * 512 + c8 * 8) = pk;
  }
  const int c = 2 * tid;
  float w0[31], w1[31];
#pragma unroll
  for (int j = 0; j < 31; ++j) { w0[j] = p.conv_w[j * 512 + c]; w1[j] = p.conv_w[j * 512 + c + 1]; }
  const float bd0 = p.conv_b[c], bd1 = p.conv_b[c + 1];
  __syncthreads();
  for (int tt = 0; tt < 32; ++tt) {
    float y0 = bd0, y1 = bd1;
#pragma unroll
    for (int j = 0; j < 31; ++j) {
      const unsigned uu = *(const unsigned*)(sU + (tt + j) * 512 + c);
      y0 += w0[j] * __uint_as_float(uu << 16);
      y1 += w1[j] * __uint_as_float(uu & 0xffff0000u);
    }
    float s = y0 + y1, q = y0 * y0 + y1 * y1;
    s = wave_sum(s); q = wave_sum(q);
    if (lane == 0) sRed[tt * 4 + w] = make_float2(s, q);
  }
  __syncthreads();
  const float g0 = p.ln_g[c], g1 = p.ln_g[c + 1], lb0 = p.ln_b[c], lb1 = p.ln_b[c + 1];
  for (int tt = 0; tt < 32; ++tt) {
    float y0 = bd0, y1 = bd1;
#pragma unroll
    for (int j = 0; j < 31; ++j) {
      const unsigned uu = *(const unsigned*)(sU + (tt + j) * 512 + c);
      y0 += w0[j] * __uint_as_float(uu << 16);
      y1 += w1[j] * __uint_as_float(uu & 0xffff0000u);
    }
    const float2 r0 = sRed[tt * 4 + 0], r1 = sRed[tt * 4 + 1], r2 = sRed[tt * 4 + 2], r3 = sRed[tt * 4 + 3];
    const float S = r0.x + r1.x + r2.x + r3.x, Q = r0.y + r1.y + r2.y + r3.y;
    const float mu = S * (1.f / 512.f);
    const float var = fmaxf(Q * (1.f / 512.f) - mu * mu, 0.f);
    const float rstd = rsqrtf(var + 1e-6f);
    const float z0 = (y0 - mu) * rstd * g0 + lb0, z1 = (y1 - mu) * rstd * g1 + lb1;
    const float o0 = z0 * sigmoidf_(z0), o1 = z1 * sigmoidf_(z1);
    *(unsigned*)(p.mix + ((size_t)b * T + t0 + tt) * LDA + c) = pack2(o0, o1);
  }
}

DEVI void phase2(const Params& p, unsigned char* smem) {
  u16* sA = (u16*)smem; u16* sB = sA + 128 * 72;
#pragma unroll 1
  for (int tile = blockIdx.x; tile < 64 + 1024; tile += gridDim.x) {
    GEMM_LANE_VARS
    if (tile < 64) {
      const int ty = tile >> 5, mt = tile & 31;
      const int m0 = mt * 128;
      f32x4 acc[4][4];
      gemm_mainloop<true>(tid, sA, sB, ACmp{p.proj, ty ? C_VC : C_KC}, p.w1T + (size_t)ty * 128 * LDW1, LDW1, m0, 0, 32, acc);
#pragma unroll
      for (int mi = 0; mi < 4; ++mi) {
        const int m = m0 + wm * 64 + 16 * mi + col;
#pragma unroll
        for (int ni = 0; ni < 4; ++ni) {
          const int n = wn * 64 + 16 * ni + 4 * quad;
          const f32x4 v = acc[ni][mi];
          const float4 bb = *(const float4*)(p.biasp + ty * 128 + n);
          uint2 pk;
          pk.x = pack2(gelu_tanh(v[0] + bb.x), gelu_tanh(v[1] + bb.y));
          pk.y = pack2(gelu_tanh(v[2] + bb.z), gelu_tanh(v[3] + bb.w));
          *(uint2*)(p.hdn + ((size_t)ty * 4096 + m) * 128 + n) = pk;
        }
      }
    } else {
      conv_tile(p, smem, tile - 64);
    }
  }
}

DEVI void phase3(const Params& p, unsigned char* smem) {
  u16* sA = (u16*)smem; u16* sB = sA + 128 * 72;
#pragma unroll 1
  for (int tile = blockIdx.x; tile < 64; tile += gridDim.x) {
    GEMM_LANE_VARS
    const int ty = tile >> 5, mt = tile & 31;
    const int m0 = mt * 128;
    f32x4 acc[4][4];
    gemm_mainloop<true>(tid, sA, sB, ARow{p.hdn + (size_t)ty * 4096 * 128, 128}, p.w2T + (size_t)ty * 128 * 128, 128, m0, 0, 2, acc);
    if (wn == 0) {
#pragma unroll
      for (int mi = 0; mi < 4; ++mi) {
        const int m = m0 + 16 * mi + wm * 64 + col;
        const int bg = m >> 7, c = m & 127;
#pragma unroll
        for (int ni = 0; ni < 4; ++ni) {
          const int n = 16 * ni + 4 * quad;
          const f32x4 v = acc[ni][mi];
          const float4 bb = *(const float4*)(p.cmp_b2 + ty * 64 + n);
          const float o0 = v[0] + bb.x, o1 = v[1] + bb.y, o2 = v[2] + bb.z, o3 = v[3] + bb.w;
          if (ty == 0) {
            uint2 pk; pk.x = pack2(o0, o1); pk.y = pack2(o2, o3);
            *(uint2*)(p.kc + (size_t)m * 64 + n) = pk;
          } else {
            u16* dst = p.vcT + ((size_t)bg * 64 + n) * 128 + c;
            dst[0] = f2bf(o0); dst[128] = f2bf(o1); dst[256] = f2bf(o2); dst[384] = f2bf(o3);
          }
        }
      }
    }
  }
}

template <int DH, int NQ, int LDK, class MaskF>
DEVI void attn_qk(const u16* sK, const bf16x8 (&qf)[NQ][DH / 32], f32x4 (&o)[NQ][DH / 16], float (&m)[NQ], float (&l)[NQ],
                  float c2, int lane, MaskF valid, bf16x8 (&pb)[NQ][2]) {
  const int col = lane & 15, quad = lane >> 4;
  f32x4 s[NQ][4];
#pragma unroll
  for (int kt = 0; kt < 4; ++kt) {
#pragma unroll
    for (int qt = 0; qt < NQ; ++qt) s[qt][kt] = f32x4{0.f, 0.f, 0.f, 0.f};
#pragma unroll
    for (int ks = 0; ks < DH / 32; ++ks) {
      const bf16x8 kf = *(const bf16x8*)(sK + (16 * kt + col) * LDK + 32 * ks + 8 * quad);
#pragma unroll
      for (int qt = 0; qt < NQ; ++qt) s[qt][kt] = mfma16(kf, qf[qt][ks], s[qt][kt]);
    }
  }
#pragma unroll
  for (int qt = 0; qt < NQ; ++qt) {
    float mx = -1e30f;
#pragma unroll
    for (int kt = 0; kt < 4; ++kt)
#pragma unroll
      for (int r = 0; r < 4; ++r) {
        const bool v = valid(qt, 16 * kt + 4 * quad + r);
        const float sv = v ? s[qt][kt][r] : -1e30f;
        s[qt][kt][r] = sv;
        mx = fmaxf(mx, sv);
      }
    mx = fmaxf(mx, __shfl_xor(mx, 16));
    mx = fmaxf(mx, __shfl_xor(mx, 32));
    const float mn = fmaxf(m[qt], mx);
    const float alpha = fexp2((m[qt] - mn) * c2);
    m[qt] = mn;
    const float mc = fmaxf(mn, -1e20f) * c2;
    float ps = 0.f;
#pragma unroll
    for (int kt = 0; kt < 4; ++kt)
#pragma unroll
      for (int r = 0; r < 4; ++r) {
        const float pv = fexp2(__builtin_fmaf(s[qt][kt][r], c2, -mc));
        ps += pv;
        s[qt][kt][r] = pv;
      }
    l[qt] = l[qt] * alpha + ps;
#pragma unroll
    for (int dt = 0; dt < DH / 16; ++dt) o[qt][dt] *= alpha;
#pragma unroll
    for (int kk = 0; kk < 2; ++kk) {
      union { bf16x8 v; unsigned u[4]; } cv;
      cv.u[0] = pack2(s[qt][2 * kk][0], s[qt][2 * kk][1]);
      cv.u[1] = pack2(s[qt][2 * kk][2], s[qt][2 * kk][3]);
      cv.u[2] = pack2(s[qt][2 * kk + 1][0], s[qt][2 * kk + 1][1]);
      cv.u[3] = pack2(s[qt][2 * kk + 1][2], s[qt][2 * kk + 1][3]);
      pb[qt][kk] = cv.v;
    }
  }
}
template <int DH, int NQ, int LDV>
DEVI void attn_pv(const u16* sVt, const bf16x8 (&pb)[NQ][2], f32x4 (&o)[NQ][DH / 16], int lane) {
  const int col = lane & 15, quad = lane >> 4;
#pragma unroll
  for (int dt = 0; dt < DH / 16; ++dt) {
#pragma unroll
    for (int kk = 0; kk < 2; ++kk) {
      union { bf16x8 v; uint2 h[2]; } cv;
      cv.h[0] = *(const uint2*)(sVt + (16 * dt + col) * LDV + 32 * kk + 4 * quad);
      cv.h[1] = *(const uint2*)(sVt + (16 * dt + col) * LDV + 32 * kk + 16 + 4 * quad);
#pragma unroll
      for (int qt = 0; qt < NQ; ++qt) o[qt][dt] = mfma16(cv.v, pb[qt][kk], o[qt][dt]);
    }
  }
}
template <int DH, int NQ, int LDK, int LDV, class MaskF>
DEVI void attn_tile(const u16* sK, const u16* sVt, const bf16x8 (&qf)[NQ][DH / 32], f32x4 (&o)[NQ][DH / 16],
                    float (&m)[NQ], float (&l)[NQ], float c2, int lane, MaskF valid) {
  bf16x8 pb[NQ][2];
  attn_qk<DH, NQ, LDK>(sK, qf, o, m, l, c2, lane, valid, pb);
  attn_pv<DH, NQ, LDV>(sVt, pb, o, lane);
}

DEVI void phase_nsa(const Params& p, unsigned char* smem) {
  u16* sK = (u16*)smem;
  u16* sVt = (u16*)(smem + 18432);
  float* impH = (float*)(smem + 35840);
  float* impT = (float*)(smem + 52736);
  unsigned* selm = (unsigned*)(smem + 56960);
  const float c2 = 0.125f * 1.4426950408889634f;
#pragma unroll 1
  for (int tile = blockIdx.x; tile < 2048; tile += gridDim.x) {
    const int tid = launder(threadIdx.x), lane = tid & 63, w = tid >> 6, col = lane & 15, quad = lane >> 4;
    const int qtile = 63 - (tile >> 5), bg = tile & 31, b = bg >> 1, g = bg & 1, q0 = qtile * 32;
    const int h = g * 4 + w;
    __syncthreads();
    if (tid < 32) selm[tid] = 0u;
    {
      const u16* kcp = p.kc + (size_t)bg * 128 * 64;
      const u16* vcp = p.vcT + (size_t)bg * 64 * 128;
#pragma unroll
      for (int i = 0; i < 4; ++i) {
        const int c = tid + 256 * i;
        const int row = c >> 3, ch = (c & 7) << 3;
        *(uint4*)(sK + row * 72 + ch) = *(const uint4*)(kcp + row * 64 + ch);
        const int row2 = c >> 4, ch2 = (c & 15) << 3;
        *(uint4*)(sVt + row2 * 136 + ch2) = *(const uint4*)(vcp + row2 * 128 + ch2);
      }
    }
    bf16x8 qf[2][2];
    float gate[2][3];
    int tq[2];
#pragma unroll
    for (int qt = 0; qt < 2; ++qt) {
      const int t = q0 + 16 * qt + col;
      tq[qt] = t;
      const size_t tok = (size_t)b * T + t;
      const u16* qp = p.proj + tok * LDP + C_Q + h * 64 + 8 * quad;
      qf[qt][0] = *(const bf16x8*)qp;
      qf[qt][1] = *(const bf16x8*)(qp + 32);
#pragma unroll
      for (int br = 0; br < 3; ++br) gate[qt][br] = sigmoidf_(bf2f(p.proj[tok * LDP + C_GATE + h * 3 + br]));
    }
    __syncthreads();

    f32x4 comb[2][4];
    {
      const int srcl = (lane + 48) & 63;
#pragma unroll
      for (int qt = 0; qt < 2; ++qt) {
        f32x4 s[8];
#pragma unroll
        for (int kt = 0; kt < 8; ++kt) {
          s[kt] = f32x4{0.f, 0.f, 0.f, 0.f};
#pragma unroll
          for (int ks = 0; ks < 2; ++ks) {
            const bf16x8 kf = *(const bf16x8*)(sK + (16 * kt + col) * 72 + 32 * ks + 8 * quad);
            s[kt] = mfma16(kf, qf[qt][ks], s[kt]);
          }
        }
        const int t = tq[qt];
        float mx = -1e30f;
#pragma unroll
        for (int kt = 0; kt < 8; ++kt)
#pragma unroll
          for (int r = 0; r < 4; ++r) {
            const int c = 16 * kt + 4 * quad + r;
            const bool v = (16 * c + 31) <= t;
            const float sv = v ? s[kt][r] : -1e30f;
            s[kt][r] = sv;
            mx = fmaxf(mx, sv);
          }
        mx = fmaxf(mx, __shfl_xor(mx, 16));
        mx = fmaxf(mx, __shfl_xor(mx, 32));
        float ps = 0.f;
#pragma unroll
        for (int kt = 0; kt < 8; ++kt)
#pragma unroll
          for (int r = 0; r < 4; ++r) {
            const float sv = s[kt][r];
            const float pv = (sv > -1e29f) ? fexp2((sv - mx) * c2) : 0.f;
            ps += pv;
            s[kt][r] = pv;
          }
        ps += __shfl_xor(ps, 16);
        ps += __shfl_xor(ps, 32);
        const float inv = ps > 0.f ? 1.f / ps : 0.f;
#pragma unroll
        for (int kt = 0; kt < 8; ++kt)
#pragma unroll
          for (int r = 0; r < 4; ++r) s[kt][r] *= inv;
        float prev3 = 0.f;
#pragma unroll
        for (int kt = 0; kt < 8; ++kt) {
          const float sum4 = s[kt][0] + s[kt][1] + s[kt][2] + s[kt][3];
          const float xs = __shfl(s[kt][3], srcl);
          const float extra = quad ? xs : prev3;
          prev3 = xs;
          impH[(w * 32 + 16 * qt + col) * 33 + 4 * kt + quad] = sum4 + extra;
        }
        bf16x8 pb[4];
#pragma unroll
        for (int kk = 0; kk < 4; ++kk) {
          union { bf16x8 v; unsigned u[4]; } cv;
          cv.u[0] = pack2(s[2 * kk][0], s[2 * kk][1]);
          cv.u[1] = pack2(s[2 * kk][2], s[2 * kk][3]);
          cv.u[2] = pack2(s[2 * kk + 1][0], s[2 * kk + 1][1]);
          cv.u[3] = pack2(s[2 * kk + 1][2], s[2 * kk + 1][3]);
          pb[kk] = cv.v;
        }
#pragma unroll
        for (int dt = 0; dt < 4; ++dt) {
          f32x4 oc = f32x4{0.f, 0.f, 0.f, 0.f};
#pragma unroll
          for (int kk = 0; kk < 4; ++kk) {
            union { bf16x8 v; uint2 hh[2]; } cv;
            cv.hh[0] = *(const uint2*)(sVt + (16 * dt + col) * 136 + 32 * kk + 4 * quad);
            cv.hh[1] = *(const uint2*)(sVt + (16 * dt + col) * 136 + 32 * kk + 16 + 4 * quad);
            oc = mfma16(cv.v, pb[kk], oc);
          }
          comb[qt][dt] = oc * gate[qt][0];
        }
      }
    }
#pragma unroll
    for (int qt = 0; qt < 2; ++qt) {
      const size_t tok = (size_t)b * T + tq[qt];
      union { bf16x8 v; unsigned u[4]; } own, par, res;
      own.v = qf[qt][0];
#pragma unroll
      for (int j = 0; j < 4; ++j) par.u[j] = (unsigned)__shfl_xor((int)own.u[j], 16);
      const float4 c0 = *(const float4*)(p.rope + tok * 16), c1 = *(const float4*)(p.rope + tok * 16 + 4);
      const float4 s0 = *(const float4*)(p.rope + tok * 16 + 8), s1 = *(const float4*)(p.rope + tok * 16 + 12);
      const float cs[8] = {c0.x, c0.y, c0.z, c0.w, c1.x, c1.y, c1.z, c1.w};
      const float sn[8] = {s0.x, s0.y, s0.z, s0.w, s1.x, s1.y, s1.z, s1.w};
#pragma unroll
      for (int j = 0; j < 4; ++j) {
        const float o0 = __uint_as_float(own.u[j] << 16), o1 = __uint_as_float(own.u[j] & 0xffff0000u);
        const float p0 = __uint_as_float(par.u[j] << 16), p1 = __uint_as_float(par.u[j] & 0xffff0000u);
        const float sg = (quad == 0) ? -1.f : 1.f;
        const float r0 = o0 * cs[2 * j] + sg * p0 * sn[2 * j];
        const float r1 = o1 * cs[2 * j + 1] + sg * p1 * sn[2 * j + 1];
        res.u[j] = (quad < 2) ? pack2(r0, r1) : own.u[j];
      }
      qf[qt][0] = res.v;
    }
    __syncthreads();
#pragma unroll
    for (int i = 0; i < 4; ++i) {
      const int cell = tid + 256 * i;
      const int qi = cell >> 5, s_ = cell & 31;
      const int cur = (q0 + qi) >> 6;
      float v = impH[(0 * 32 + qi) * 33 + s_] + impH[(1 * 32 + qi) * 33 + s_] + impH[(2 * 32 + qi) * 33 + s_] +
                impH[(3 * 32 + qi) * 33 + s_];
      const int dist = cur - s_;
      const bool forced = (s_ == 0) || (dist >= 0 && dist < 2);
      v = forced ? 1e9f : (s_ <= cur ? v : -1.f);
      impT[qi * 33 + s_] = v;
    }
    __syncthreads();
    {
      const int qi = tid >> 3, sub = tid & 7;
      unsigned bits = 0u;
#pragma unroll
      for (int k = 0; k < 4; ++k) {
        const int s_ = sub * 4 + k;
        const float v = impT[qi * 33 + s_];
        int rank = 0;
        for (int s2 = 0; s2 < 32; ++s2) {
          const float v2 = impT[qi * 33 + s2];
          rank += ((v2 > v) || (v2 == v && s2 < s_)) ? 1 : 0;
        }
        if (rank < 16) bits |= 1u << s_;
      }
      atomicOr(&selm[qi], bits);
    }
    __syncthreads();
    unsigned sm[2] = {selm[col], selm[16 + col]};
    unsigned uni = 0u;
#pragma unroll
    for (int i = 0; i < 32; ++i) uni |= selm[i];
    const int kbmax = (q0 + 31) >> 6;
    {
      float m[2] = {-1e30f, -1e30f}, l[2] = {0.f, 0.f};
      f32x4 o[2][4];
#pragma unroll
      for (int qt = 0; qt < 2; ++qt)
#pragma unroll
        for (int dt = 0; dt < 4; ++dt) o[qt][dt] = f32x4{0.f, 0.f, 0.f, 0.f};
      unsigned rem = (kbmax >= 31) ? uni : (uni & ((1u << (kbmax + 1)) - 1u));
      int kb = rem ? (__ffs((int)rem) - 1) : -1;
      uint4 rk0, rk1, rv0, rv1;
      const int lr0 = tid >> 3, lch = (tid & 7) << 3;
#define LOADKV_(kbx, CK, VT)                                                                                         \
      rk0 = *(const uint4*)(p.proj + ((size_t)b * T + (kbx) * 64 + lr0) * LDP + (CK) + g * 64 + lch);                 \
      rk1 = *(const uint4*)(p.proj + ((size_t)b * T + (kbx) * 64 + lr0 + 32) * LDP + (CK) + g * 64 + lch);            \
      rv0 = *(const uint4*)((VT) + ((size_t)bg * 64 + lr0) * LDT + (kbx) * 64 + lch);                                 \
      rv1 = *(const uint4*)((VT) + ((size_t)bg * 64 + lr0 + 32) * LDT + (kbx) * 64 + lch);
#define STOREKV_()                                                                                                   \
      *(uint4*)(sK + lr0 * 72 + lch) = rk0; *(uint4*)(sK + (lr0 + 32) * 72 + lch) = rk1;                              \
      *(uint4*)(sVt + lr0 * 72 + lch) = rv0; *(uint4*)(sVt + (lr0 + 32) * 72 + lch) = rv1;
      if (kb >= 0) { LOADKV_(kb, C_KS, p.vts) }
#pragma unroll 1
      while (kb >= 0) {
        rem &= rem - 1u;
        const int nkb = rem ? (__ffs((int)rem) - 1) : -1;
        __syncthreads();
        STOREKV_()
        if (nkb >= 0) { LOADKV_(nkb, C_KS, p.vts) }
        __syncthreads();
        const int lim0 = ((sm[0] >> kb) & 1u) ? tq[0] : -1, lim1 = ((sm[1] >> kb) & 1u) ? tq[1] : -1;
        attn_tile<64, 2, 72, 72>(sK, sVt, qf, o, m, l, c2, lane, [&](int qt, int kl) {
          return (kb * 64 + kl) <= (qt ? lim1 : lim0);
        });
        kb = nkb;
      }
#pragma unroll
      for (int qt = 0; qt < 2; ++qt) {
        float lt = l[qt];
        lt += __shfl_xor(lt, 16);
        lt += __shfl_xor(lt, 32);
        const float sc = lt > 0.f ? gate[qt][1] / lt : 0.f;
#pragma unroll
        for (int dt = 0; dt < 4; ++dt) comb[qt][dt] += o[qt][dt] * sc;
      }
    }
    {
      float m[2] = {-1e30f, -1e30f}, l[2] = {0.f, 0.f};
      f32x4 o[2][4];
#pragma unroll
      for (int qt = 0; qt < 2; ++qt)
#pragma unroll
        for (int dt = 0; dt < 4; ++dt) o[qt][dt] = f32x4{0.f, 0.f, 0.f, 0.f};
      const int kblo = (q0 >= 511) ? ((q0 - 511) >> 6) : 0;
      uint4 rk0, rk1, rv0, rv1;
      const int lr0 = tid >> 3, lch = (tid & 7) << 3;
      int kb = kblo;
      LOADKV_(kb, C_KW, p.vtw)
#pragma unroll 1
      while (kb >= 0) {
        const int nkb = (kb < kbmax) ? kb + 1 : -1;
        __syncthreads();
        STOREKV_()
        if (nkb >= 0) { LOADKV_(nkb, C_KW, p.vtw) }
        __syncthreads();
        attn_tile<64, 2, 72, 72>(sK, sVt, qf, o, m, l, c2, lane, [&](int qt, int kl) {
          return (unsigned)(tq[qt] - (kb * 64 + kl)) < 512u;
        });
        kb = nkb;
      }
#undef LOADKV_
#undef STOREKV_
#pragma unroll
      for (int qt = 0; qt < 2; ++qt) {
        float lt = l[qt];
        lt += __shfl_xor(lt, 16);
        lt += __shfl_xor(lt, 32);
        const float sc = lt > 0.f ? gate[qt][2] / lt : 0.f;
#pragma unroll
        for (int dt = 0; dt < 4; ++dt) comb[qt][dt] += o[qt][dt] * sc;
      }
    }
#pragma unroll
    for (int qt = 0; qt < 2; ++qt) {
      const size_t tok = (size_t)b * T + tq[qt];
#pragma unroll
      for (int dt = 0; dt < 4; ++dt) {
        uint2 pk;
        pk.x = pack2(comb[qt][dt][0], comb[qt][dt][1]);
        pk.y = pack2(comb[qt][dt][2], comb[qt][dt][3]);
        *(uint2*)(p.mix + tok * LDA + 512 + h * 64 + 16 * dt + 4 * quad) = pk;
      }
    }
  }
}

template <bool RESB>
DEVI void phase_resid(const Params& p, unsigned char* smem, const u16* A, const u16* Wt, const float* res, float* ssq) {
  u16* sA = (u16*)smem; u16* sB = sA + 128 * 72;
  XCD_TILE_LOOP(idx, 256, 8) {
    GEMM_LANE_VARS
    const int mt = XCD_TILE_MT(idx, 8), nt_ = XCD_TILE_NT(idx, 8);
    const int m0 = mt * 128, n0 = nt_ * 128;
    f32x4 acc[4][4];
    gemm_mainloop<true>(tid, sA, sB, ARow{A, LDA}, Wt, LDA, m0, n0, 16, acc);
#pragma unroll
    for (int mi = 0; mi < 4; ++mi) {
      const int m = m0 + wm * 64 + 16 * mi + col;
      float ss = 0.f;
#pragma unroll
      for (int ni = 0; ni < 4; ++ni) {
        const int n = n0 + wn * 64 + 16 * ni + 4 * quad;
        const f32x4 v = acc[ni][mi];
        float4 r;
        if (RESB) {
          const uint2 rb = *(const uint2*)(p.hn + (size_t)m * LDA + n);
          r.x = __uint_as_float(rb.x << 16); r.y = __uint_as_float(rb.x & 0xffff0000u);
          r.z = __uint_as_float(rb.y << 16); r.w = __uint_as_float(rb.y & 0xffff0000u);
        } else {
          r = *(const float4*)(res + (size_t)m * D + n);
        }
        float4 hv;
        hv.x = r.x + v[0]; hv.y = r.y + v[1]; hv.z = r.z + v[2]; hv.w = r.w + v[3];
        ss += hv.x * hv.x + hv.y * hv.y + hv.z * hv.z + hv.w * hv.w;
        uint2 pk; pk.x = pack2(hv.x, hv.y); pk.y = pack2(hv.z, hv.w);
        *(uint2*)(p.hn + (size_t)m * LDA + n) = pk;
      }
      ss += __shfl_xor(ss, 16);
      ss += __shfl_xor(ss, 32);
      if (quad == 0) atomicAdd(ssq + m, ss);
    }
  }
}

DEVI void phase_scaled(const Params& p, unsigned char* smem, const u16* A, const u16* Wt, int ntn, const float* ssq, u16* outp, int ldo) {
  u16* sA = (u16*)smem; u16* sB = sA + 128 * 72;
  XCD_TILE_LOOP(idx, 256, ntn) {
    GEMM_LANE_VARS
    const int mt = XCD_TILE_MT(idx, ntn), nt_ = XCD_TILE_NT(idx, ntn);
    const int m0 = mt * 128, n0 = nt_ * 128;
    f32x4 acc[4][4];
    gemm_mainloop<true>(tid, sA, sB, ARow{A, LDA}, Wt, LDA, m0, n0, 16, acc);
#pragma unroll
    for (int mi = 0; mi < 4; ++mi) {
      const int m = m0 + wm * 64 + 16 * mi + col;
      const float rstd = rsqrtf(ssq[m] * (1.f / D) + 1e-6f);
#pragma unroll
      for (int ni = 0; ni < 4; ++ni) {
        const int n = n0 + wn * 64 + 16 * ni + 4 * quad;
        const f32x4 v = acc[ni][mi];
        uint2 pk; pk.x = pack2(v[0] * rstd, v[1] * rstd); pk.y = pack2(v[2] * rstd, v[3] * rstd);
        *(uint2*)(outp + (size_t)m * ldo + n) = pk;
      }
    }
  }
}

DEVI void phase_memattn(const Params& p, unsigned char* smem) {
  u16* sK = (u16*)smem;
  u16* sVt = (u16*)(smem + 33792);
  const float c2 = 0.0625f * 1.4426950408889634f;
#pragma unroll 1
  for (int tile = blockIdx.x; tile < 2048; tile += gridDim.x) {
    const int tid = launder(threadIdx.x), lane = tid & 63, w = tid >> 6, col = lane & 15, quad = lane >> 4;
    const int b = tile >> 7, head = (tile >> 5) & 3, q0 = (tile & 31) * 64;
    const size_t tok = (size_t)b * T + q0 + 16 * w + col;
    bf16x8 qf[1][8];
#pragma unroll
    for (int ks = 0; ks < 8; ++ks) qf[0][ks] = *(const bf16x8*)(p.qm + tok * LDA + head * 256 + 32 * ks + 8 * quad);
    float m[1] = {-1e30f}, l[1] = {0.f};
    f32x4 o[1][16];
#pragma unroll
    for (int dt = 0; dt < 16; ++dt) o[0][dt] = f32x4{0.f, 0.f, 0.f, 0.f};
    uint4 rg0, rg1, rg2, rg3, rg4, rg5, rg6, rg7;
    const int krow = tid >> 5, kch = (tid & 31) << 3;
    const int vrow = tid >> 3, vch = (tid & 7) << 3;
#define LK1_(i, kbx) rg##i = *(const uint4*)(p.memk + ((size_t)b * 256 + (kbx) * 64 + krow + 8 * i) * LDA + head * 256 + kch);
#define SK1_(i) *(uint4*)(sK + (krow + 8 * i) * 264 + kch) = rg##i;
#define LV1_(i, kbx) rg##i = *(const uint4*)(p.memvt + ((size_t)(b * 4 + head) * 256 + vrow + 32 * i) * 256 + (kbx) * 64 + vch);
#define SV1_(i) *(uint4*)(sVt + (vrow + 32 * i) * 72 + vch) = rg##i;
#define LOADK_(kbx) LK1_(0, kbx) LK1_(1, kbx) LK1_(2, kbx) LK1_(3, kbx) LK1_(4, kbx) LK1_(5, kbx) LK1_(6, kbx) LK1_(7, kbx)
#define STOREK_() SK1_(0) SK1_(1) SK1_(2) SK1_(3) SK1_(4) SK1_(5) SK1_(6) SK1_(7)
#define LOADV_(kbx) LV1_(0, kbx) LV1_(1, kbx) LV1_(2, kbx) LV1_(3, kbx) LV1_(4, kbx) LV1_(5, kbx) LV1_(6, kbx) LV1_(7, kbx)
#define STOREV_() SV1_(0) SV1_(1) SV1_(2) SV1_(3) SV1_(4) SV1_(5) SV1_(6) SV1_(7)
    __syncthreads();
    LOADK_(0)
    STOREK_()
    LOADV_(0)
    __syncthreads();
#pragma unroll 1
    for (int kb = 0; kb < 4; ++kb) {
      bf16x8 pb[1][2];
      attn_qk<256, 1, 264>(sK, qf, o, m, l, c2, lane, [&](int, int) { return true; }, pb);
      STOREV_()
      if (kb < 3) { LOADK_(kb + 1) }
      __syncthreads();
      attn_pv<256, 1, 72>(sVt, pb, o, lane);
      if (kb < 3) {
        STOREK_()
        LOADV_(kb + 1)
      }
      __syncthreads();
    }
#undef LOADK_
#undef STOREK_
#undef LOADV_
#undef STOREV_
#undef LK1_
#undef SK1_
#undef LV1_
#undef SV1_
    float lt = l[0];
    lt += __shfl_xor(lt, 16);
    lt += __shfl_xor(lt, 32);
    const float inv = 1.f / lt;
#pragma unroll
    for (int dt = 0; dt < 16; ++dt) {
      uint2 pk;
      pk.x = pack2(o[0][dt][0] * inv, o[0][dt][1] * inv);
      pk.y = pack2(o[0][dt][2] * inv, o[0][dt][3] * inv);
      *(uint2*)(p.mix + tok * LDA + head * 256 + 16 * dt + 4 * quad) = pk;
    }
  }
}

__constant__ unsigned char kCandI[64] = {0,0,0,0,0,0,0,0,0,0,0,0,0,0,0,0, 1,1,1,1,1,1,1,1, 2,2,2,2,2, 3,3,3,3, 4,4,4, 5,5, 6,6, 7,7,
                                          8, 9, 10, 11, 12, 13, 14, 15, 0,0,0,0,0,0,0,0,0,0,0,0,0,0};
__constant__ unsigned char kCandJ[64] = {0,1,2,3,4,5,6,7,8,9,10,11,12,13,14,15, 0,1,2,3,4,5,6,7, 0,1,2,3,4, 0,1,2,3, 0,1,2, 0,1, 0,1, 0,1,
                                          0, 0, 0, 0, 0, 0, 0, 0, 0,0,0,0,0,0,0,0,0,0,0,0,0,0};

DEVI unsigned score_key(float v, int idx) {
  unsigned u = __float_as_uint(v);
  u = (u & 0x80000000u) ? ~u : (u | 0x80000000u);
  return (u & ~127u) | (unsigned)(127 - idx);
}
DEVI float key_score(unsigned k) {
  k &= ~127u;
  const unsigned u = (k & 0x80000000u) ? (k & 0x7fffffffu) : ~k;
  return __uint_as_float(u);
}

DEVI void phase_peer_route(const Params& p, unsigned char* smem) {
  u16* sA = (u16*)smem; u16* sB = sA + 128 * 72;
  unsigned* sScore = (unsigned*)smem;
  unsigned* sTop = (unsigned*)(smem + 36864);
  unsigned* sTmp = (unsigned*)(smem + 53248);
  {
    const int t0_ = launder(threadIdx.x);
    const int gw = (blockIdx.x * 256 + t0_) >> 6, nw = (gridDim.x * 256) >> 6;
    conv_fp8_rows(p.peer_u, p.ub8, p.uscale, 16384, gw, nw, t0_ & 63);
    conv_fp8_rows(p.peer_v, p.vb8, p.vscale, 16384, gw, nw, t0_ & 63);
  }
#pragma unroll 1
  for (int tile = blockIdx.x; tile < 256 * 8; tile += gridDim.x) {
    GEMM_LANE_VARS
    const int mt = tile >> 3, hd = tile & 7;
    const int m0 = mt * 128;
#pragma unroll 1
    for (int ph = 0; ph < 2; ++ph) {
      const int hp = hd * 2 + ph;
      f32x4 acc[4][4];
      __syncthreads();
      gemm_mainloop<false>(tid, sA, sB, ARow{p.pq + hp * 128, LDPQ}, p.subk + (size_t)hp * 128 * 128, 128, m0, 0, 2, acc);
#pragma unroll 1
      for (int hh = 0; hh < 2; ++hh) {
        if (wm == hh) {
#pragma unroll
          for (int mi = 0; mi < 4; ++mi) {
            const int row = 16 * mi + col;
#pragma unroll
            for (int ni = 0; ni < 4; ++ni) {
              const int n = wn * 64 + 16 * ni + 4 * quad;
              const f32x4 v = acc[ni][mi];
              uint4 kk;
              kk.x = score_key(v[0], n); kk.y = score_key(v[1], n + 1);
              kk.z = score_key(v[2], n + 2); kk.w = score_key(v[3], n + 3);
              *(uint4*)(sScore + row * 128 + n) = kk;
            }
          }
        }
        __syncthreads();
#pragma unroll 1
        for (int rg = 0; rg < 4; ++rg) {
          const int rbase = w * 16 + rg * 4;
          unsigned k0[4], k1[4], t0[4], t1[4], thr[4];
#pragma unroll
          for (int r = 0; r < 4; ++r) {
            k0[r] = sScore[(rbase + r) * 128 + lane];
            k1[r] = sScore[(rbase + r) * 128 + 64 + lane];
            t0[r] = ((k0[r] >> 16) << 7) | (k0[r] & 127u);
            t1[r] = ((k1[r] >> 16) << 7) | (k1[r] & 127u);
            thr[r] = 0u;
          }
#pragma unroll
          for (int bit = 22; bit >= 0; --bit) {
#pragma unroll
            for (int r = 0; r < 4; ++r) {
              const unsigned cand = thr[r] | (1u << bit);
              const int cnt = __popcll(__ballot(t0[r] >= cand)) + __popcll(__ballot(t1[r] >= cand));
              thr[r] = (cnt >= 16) ? cand : thr[r];
            }
          }
          unsigned* tmp = sTmp + w * 64;
#pragma unroll
          for (int r = 0; r < 4; ++r) {
            const unsigned long long b0 = __ballot(t0[r] >= thr[r]), b1 = __ballot(t1[r] >= thr[r]);
            const int pos0 = __builtin_amdgcn_mbcnt_hi((unsigned)(b0 >> 32), __builtin_amdgcn_mbcnt_lo((unsigned)b0, 0u));
            const int pos1 = __popcll(b0) + __builtin_amdgcn_mbcnt_hi((unsigned)(b1 >> 32), __builtin_amdgcn_mbcnt_lo((unsigned)b1, 0u));
            if (t0[r] >= thr[r]) tmp[r * 16 + pos0] = k0[r];
            if (t1[r] >= thr[r]) tmp[r * 16 + pos1] = k1[r];
          }
          __builtin_amdgcn_fence(__ATOMIC_RELEASE, "wavefront");
          __builtin_amdgcn_wave_barrier();
          __builtin_amdgcn_fence(__ATOMIC_ACQUIRE, "wavefront");
          {
            const int r = lane >> 4, ix = lane & 15;
            const unsigned mine = tmp[r * 16 + ix];
            const uint4 a = *(const uint4*)(tmp + r * 16), b = *(const uint4*)(tmp + r * 16 + 4), c = *(const uint4*)(tmp + r * 16 + 8),
                        d = *(const uint4*)(tmp + r * 16 + 12);
            const int rk = (a.x > mine) + (a.y > mine) + (a.z > mine) + (a.w > mine) + (b.x > mine) + (b.y > mine) + (b.z > mine) + (b.w > mine) +
                           (c.x > mine) + (c.y > mine) + (c.z > mine) + (c.w > mine) + (d.x > mine) + (d.y > mine) + (d.z > mine) + (d.w > mine);
            sTop[((hh * 64 + rbase + r) * 2 + ph) * 16 + rk] = mine;
          }
          __builtin_amdgcn_fence(__ATOMIC_RELEASE, "wavefront");
          __builtin_amdgcn_wave_barrier();
        }
        __syncthreads();
      }
    }
    const int ci = kCandI[lane], cj = kCandJ[lane];
    const bool act = lane < 50;
#pragma unroll 1
    for (int tg = 0; tg < 8; ++tg) {
      const int tb = w * 32 + tg * 4;
      unsigned k0[4], k1[4], ku[4], thr[4];
      float v[4];
#pragma unroll
      for (int r = 0; r < 4; ++r) {
        k0[r] = sTop[((tb + r) * 2 + 0) * 16 + ci];
        k1[r] = sTop[((tb + r) * 2 + 1) * 16 + cj];
        v[r] = key_score(k0[r]) + key_score(k1[r]);
        unsigned u = __float_as_uint(v[r]);
        u = (u & 0x80000000u) ? ~u : (u | 0x80000000u);
        ku[r] = act ? (((u >> 16) << 6) | (unsigned)(63 - lane)) : 0u;
        thr[r] = 0u;
      }
#pragma unroll
      for (int bit = 21; bit >= 0; --bit) {
#pragma unroll
        for (int r = 0; r < 4; ++r) {
          const unsigned cand = thr[r] | (1u << bit);
          const int cnt = __popcll(__ballot(ku[r] >= cand));
          thr[r] = (cnt >= 16) ? cand : thr[r];
        }
      }
#pragma unroll
      for (int r = 0; r < 4; ++r) {
        const bool sel = act && (ku[r] >= thr[r]);
        const unsigned long long ms = __ballot(sel);
        const int slot = __builtin_amdgcn_mbcnt_hi((unsigned)(ms >> 32), __builtin_amdgcn_mbcnt_lo((unsigned)ms, 0u));
        const float vmax = __int_as_float(__builtin_amdgcn_readlane(__float_as_int(v[r]), 0));
        const float e = sel ? __expf(v[r] - vmax) : 0.f;
        const float tot = wave_sum(e);
        if (sel) {
          const int eid = (127 - (int)(k0[r] & 127u)) * 128 + (127 - (int)(k1[r] & 127u));
          const size_t o = (size_t)(m0 + tb + r) * 128 + hd * 16 + slot;
          p.experts[o] = eid;
          p.gates[o] = e / tot;
        }
      }
    }
  }
}

template <int PART>
DEVI void phase_peer_gather(const Params& p) {
  const int w0_ = threadIdx.x >> 6;
#pragma unroll 1
  for (int tok = blockIdx.x * 4 + w0_; tok < NTOK; tok += gridDim.x * 4) {
    const int tid = launder(threadIdx.x), lane = tid & 63;
    const uint4* hp4 = (const uint4*)(p.hn + (size_t)tok * LDA + lane * 16);
    float hv[16], xn[16], y[16];
    {
      const uint4 a0 = hp4[0], a1 = hp4[1];
      const unsigned hu[8] = {a0.x, a0.y, a0.z, a0.w, a1.x, a1.y, a1.z, a1.w};
#pragma unroll
      for (int i = 0; i < 8; ++i) { hv[2 * i] = __uint_as_float(hu[i] << 16); hv[2 * i + 1] = __uint_as_float(hu[i] & 0xffff0000u); }
    }
    float ss = 0.f;
#pragma unroll
    for (int i = 0; i < 16; ++i) ss += hv[i] * hv[i];
    ss = wave_sum(ss);
    const float rstd = rsqrtf(ss * (1.f / D) + 1e-6f);
    {
      const float4* g4 = (const float4*)p.peer_g + lane * 4;
      const float4 a0 = g4[0], a1 = g4[1], a2 = g4[2], a3 = g4[3];
      const float gg[16] = {a0.x, a0.y, a0.z, a0.w, a1.x, a1.y, a1.z, a1.w, a2.x, a2.y, a2.z, a2.w, a3.x, a3.y, a3.z, a3.w};
#pragma unroll
      for (int i = 0; i < 16; ++i) { xn[i] = hv[i] * rstd * gg[i]; y[i] = 0.f; }
    }
    const int e0 = p.experts[(size_t)tok * 128 + lane], e1 = p.experts[(size_t)tok * 128 + 64 + lane];
    const float g0 = p.gates[(size_t)tok * 128 + lane], g1 = p.gates[(size_t)tok * 128 + 64 + lane];
    const float su0 = p.uscale[e0], su1 = p.uscale[e1];
    const float sv0 = p.vscale[e0], sv1 = p.vscale[e1];
    float cf0 = 0.f, cf1 = 0.f, dsum = 0.f;
    uint4 ca[8], cb[8];
#define LOADB_(R, bi)                                                                                   \
    _Pragma("unroll") for (int u = 0; u < 8; ++u) {                                                       \
      const int kk_ = (((bi) & 7) << 3) + u;                                                             \
      const int e_ = __builtin_amdgcn_readlane((((bi) >> 3) & 1) ? e1 : e0, kk_);                        \
      R[u] = ((const uint4*)((((bi) >> 4) ? p.vb8 : p.ub8) + (size_t)e_ * 1024))[lane];                  \
    }
#define COMPU_(R, bi)                                                                                   \
    {                                                                                                    \
      float d8[8];                                                                                       \
      _Pragma("unroll") for (int u = 0; u < 8; ++u) {                                                     \
        const unsigned uu[4] = {R[u].x, R[u].y, R[u].z, R[u].w};                                         \
        f32x2 a2 = {0.f, 0.f};                                                                           \
        _Pragma("unroll") for (int j = 0; j < 4; ++j) {                                                   \
          const f32x2 lo = __builtin_amdgcn_cvt_pk_f32_fp8((int)uu[j], false);                           \
          const f32x2 hi = __builtin_amdgcn_cvt_pk_f32_fp8((int)uu[j], true);                            \
          a2 = xn2[2 * j] * lo + a2;                                                                     \
          a2 = xn2[2 * j + 1] * hi + a2;                                                                 \
        }                                                                                                \
        d8[u] = a2[0] + a2[1];                                                                           \
      }                                                                                                  \
          \
      float v4[4], v2[2];                                                                                \
      _Pragma("unroll") for (int i = 0; i < 4; ++i) {                                                     \
        const float snd = b5 ? d8[i] : d8[4 + i], kp = b5 ? d8[4 + i] : d8[i];                           \
        v4[i] = kp + __shfl_xor(snd, 32);                                                                \
      }                                                                                                  \
      _Pragma("unroll") for (int i = 0; i < 2; ++i) {                                                     \
        const float snd = b4 ? v4[i] : v4[2 + i], kp = b4 ? v4[2 + i] : v4[i];                           \
        v2[i] = kp + __shfl_xor(snd, 16);                                                                \
      }                                                                                                  \
      float v1;                                                                                          \
      { const float snd = b3 ? v2[0] : v2[1], kp = b3 ? v2[1] : v2[0]; v1 = kp + __shfl_xor(snd, 8); }   \
      v1 += __shfl_xor(v1, 4);                                                                           \
      v1 += __shfl_xor(v1, 2);                                                                           \
      v1 += __shfl_xor(v1, 1);                                                                           \
                \
      const float got = __shfl(v1, fsrc);                                                                \
      if ((lane >> 3) == ((bi) & 7)) dsum = got;                                                         \
    }                                                                                                    \
    if (((bi) & 7) == 7) {                                                                               \
      if (((bi) >> 3) & 1) cf1 = gelu_tanh(dsum * su1) * g1 * sv1; else cf0 = gelu_tanh(dsum * su0) * g0 * sv0; \
    }
#define COMPV_(R, bi)                                                                                   \
    _Pragma("unroll") for (int u = 0; u < 8; ++u) {                                                       \
      const int kk_ = (((bi) & 7) << 3) + u;                                                             \
      const float ck_ = __int_as_float(__builtin_amdgcn_readlane(__float_as_int((((bi) >> 3) & 1) ? cf1 : cf0), kk_)); \
      const f32x2 ck2 = {ck_, ck_};                                                                      \
      const unsigned uu[4] = {R[u].x, R[u].y, R[u].z, R[u].w};                                           \
      _Pragma("unroll") for (int j = 0; j < 4; ++j) {                                                     \
        const f32x2 lo = __builtin_amdgcn_cvt_pk_f32_fp8((int)uu[j], false);                             \
        const f32x2 hi = __builtin_amdgcn_cvt_pk_f32_fp8((int)uu[j], true);                              \
        y2[2 * j] = ck2 * lo + y2[2 * j];                                                                \
        y2[2 * j + 1] = ck2 * hi + y2[2 * j + 1];                                                        \
      }                                                                                                  \
    }
    const bool b5 = (lane & 32) != 0, b4 = (lane & 16) != 0, b3 = (lane & 8) != 0;
    const int fsrc = ((lane & 4) << 3) | ((lane & 2) << 3) | ((lane & 1) << 3);
    f32x2 xn2[8], y2[8];
#pragma unroll
    for (int i = 0; i < 8; ++i) { xn2[i] = f32x2{xn[2 * i], xn[2 * i + 1]}; y2[i] = f32x2{0.f, 0.f}; }
    if (PART == 0) {
      LOADB_(ca, 0)
#pragma unroll 1
      for (int bi = 0; bi < 16; bi += 2) {
        LOADB_(cb, bi + 1)
        COMPU_(ca, bi)
        if (bi + 2 < 16) { LOADB_(ca, bi + 2) }
        COMPU_(cb, bi + 1)
      }
      p.gates[(size_t)tok * 128 + lane] = cf0;
      p.gates[(size_t)tok * 128 + 64 + lane] = cf1;
      continue;
    }
    cf0 = g0; cf1 = g1;
    LOADB_(ca, 16)
#pragma unroll 1
    for (int bi = 16; bi < 32; bi += 2) {
      LOADB_(cb, bi + 1)
      COMPV_(ca, bi)
      if (bi + 2 < 32) { LOADB_(ca, bi + 2) }
      COMPV_(cb, bi + 1)
    }
#undef LOADB_
#undef COMPU_
#undef COMPV_
#pragma unroll
    for (int i = 0; i < 8; ++i) { y[2 * i] = y2[i][0]; y[2 * i + 1] = y2[i][1]; }
    float s2 = 0.f;
    {
      const uint4 a0 = hp4[0], a1 = hp4[1];
      const unsigned hu[8] = {a0.x, a0.y, a0.z, a0.w, a1.x, a1.y, a1.z, a1.w};
#pragma unroll
      for (int i = 0; i < 8; ++i) {
        y[2 * i] += __uint_as_float(hu[i] << 16);
        y[2 * i + 1] += __uint_as_float(hu[i] & 0xffff0000u);
        s2 += y[2 * i] * y[2 * i] + y[2 * i + 1] * y[2 * i + 1];
      }
    }
    s2 = wave_sum(s2);
    const float rs2 = rsqrtf(s2 * (1.f / D) + 1e-6f);
    {
      const float4* g4 = (const float4*)p.final_g + lane * 4;
      const float4 a0 = g4[0], a1 = g4[1], a2 = g4[2], a3 = g4[3];
      float4* o4 = (float4*)(p.out + (size_t)tok * D) + lane * 4;
      o4[0] = make_float4(y[0] * rs2 * a0.x, y[1] * rs2 * a0.y, y[2] * rs2 * a0.z, y[3] * rs2 * a0.w);
      o4[1] = make_float4(y[4] * rs2 * a1.x, y[5] * rs2 * a1.y, y[6] * rs2 * a1.z, y[7] * rs2 * a1.w);
      o4[2] = make_float4(y[8] * rs2 * a2.x, y[9] * rs2 * a2.y, y[10] * rs2 * a2.z, y[11] * rs2 * a2.w);
      o4[3] = make_float4(y[12] * rs2 * a3.x, y[13] * rs2 * a3.y, y[14] * rs2 * a3.z, y[15] * rs2 * a3.w);
    }
  }
}

#define XB_TMO      128
#define XB_XCNT(j)  (256  + 64 * (j))
#define XB_XSUB(j)  (1280 + 64 * (j))
#define XB_XGEN(j)  (2304 + 64 * (j))
#define XB_TOP      3328
#define XB_TOPGEN   3392
#define XCD_BAR_WORDS 3456
#define XB_SPIN_CAP (1u << 20)
#define LAS __attribute__((address_space(3)))
DEVI unsigned xb_ld(unsigned* q) { return __hip_atomic_load(q, __ATOMIC_RELAXED, __HIP_MEMORY_SCOPE_AGENT); }
DEVI unsigned xb_add(unsigned* q, unsigned v) { return __hip_atomic_fetch_add(q, v, __ATOMIC_RELAXED, __HIP_MEMORY_SCOPE_AGENT); }
DEVI unsigned xb_xcc_id() { return (unsigned)__builtin_amdgcn_s_getreg((3 << 11) | 20) & 0xFu; }
#define XB_SPIN(cond, bar) do { unsigned _sp = 0; while (cond) { __builtin_amdgcn_s_sleep(1); \
    if ((++_sp & 255u) == 0u) { if (xb_ld(&(bar)[XB_TMO])) break; if (_sp > XB_SPIN_CAP) { atomicAdd(&(bar)[XB_TMO], 1u); break; } } } } while (0)
struct XcdBarrier { unsigned* bar; unsigned x; volatile LAS unsigned* st; };
DEVI XcdBarrier xcd_barrier_post(unsigned* bar, volatile LAS unsigned* st) {
  XcdBarrier b; b.bar = bar; b.x = xb_xcc_id(); b.st = st;
  if (threadIdx.x == 0) (void)xb_add(&bar[XB_XCNT(b.x)], 1u);
  return b;
}
DEVI void xcd_barrier_complete(unsigned* bar, unsigned x, unsigned& nloc, unsigned& nx) {
  const unsigned G = gridDim.x * gridDim.y * gridDim.z;
  unsigned sum, cnt, mine, sp = 0u;
  for (;;) {
    sum = 0u; cnt = 0u; mine = 0u;
#pragma unroll
    for (unsigned j = 0; j < 16; ++j) { const unsigned c = xb_ld(&bar[XB_XCNT(j)]); sum += c; cnt += (c > 0u) ? 1u : 0u; mine = (j == x) ? c : mine; }
    if (sum == G) break;
    __builtin_amdgcn_s_sleep(1);
    if ((++sp & 255u) == 0u) { if (xb_ld(&bar[XB_TMO])) break; if (sp > XB_SPIN_CAP) { atomicAdd(&bar[XB_TMO], 1u); break; } }
  }
  nloc = mine > 0u ? mine : 1u; nx = cnt > 0u ? cnt : 1u;
}
DEVI void xcd_barrier(const XcdBarrier& b) {
  asm volatile("s_waitcnt vmcnt(0)" ::: "memory");
  __syncthreads();
  if (threadIdx.x == 0) {
    unsigned* bar = b.bar;
    __builtin_amdgcn_s_waitcnt(0);
    unsigned nloc = b.st[0], nx = b.st[1];
    if (nloc == 0u) { xcd_barrier_complete(bar, b.x, nloc, nx); b.st[0] = nloc; b.st[1] = nx; }
    const unsigned old = xb_add(&bar[XB_XSUB(b.x)], 1u);
    const unsigned gen = old / nloc;
    if (old + 1u == (gen + 1u) * nloc) {
      __builtin_amdgcn_fence(__ATOMIC_RELEASE, "agent");
      asm volatile("s_waitcnt vmcnt(0)" ::: "memory");
      const unsigned og = xb_add(&bar[XB_TOP], 1u);
      const unsigned tg = og / nx;
      if (og + 1u == (tg + 1u) * nx) xb_add(&bar[XB_TOPGEN], 1u);
      else XB_SPIN(xb_ld(&bar[XB_TOPGEN]) == tg, bar);
      __builtin_amdgcn_fence(__ATOMIC_ACQUIRE, "agent");
      xb_add(&bar[XB_XGEN(b.x)], 1u);
      asm volatile("s_waitcnt vmcnt(0)" ::: "memory");
    } else {
      XB_SPIN(xb_ld(&bar[XB_XGEN(b.x)]) == gen, bar);
      __builtin_amdgcn_fence(__ATOMIC_ACQUIRE, "agent");
      asm volatile("s_waitcnt vmcnt(0)" ::: "memory");
    }
  }
  __syncthreads();
}

template <bool COOP>
__global__ void __launch_bounds__(256, 2) mega(Params p, int ph_lo, int ph_hi) {
  __shared__ __attribute__((aligned(16))) unsigned char smem[SMEM_BYTES];
  __shared__ uint4 xb_words;
  if (threadIdx.x == 0) xb_words = make_uint4(0u, 0u, 0u, 0u);
  __syncthreads();
  XcdBarrier xb = xcd_barrier_post(p.bar, (volatile LAS unsigned*)&xb_words);
  (void)xb;
  if (COOP && ph_hi > 1000) cg::this_grid().sync();
#ifdef REPEAT_MASK
#define RUN_PHASE(i, call)                                                                   \
  if (ph_lo <= (i) && (i) <= ph_hi) {                                                        \
    call;                                                                                    \
    if (COOP && ((REPEAT_MASK >> (i)) & 1)) { xcd_barrier(xb); call; }                       \
    if (COOP && (i) < ph_hi) xcd_barrier(xb);                                                \
  }
#else
#define RUN_PHASE(i, call)                                                                   \
  if (ph_lo <= (i) && (i) <= ph_hi) {                                                        \
    call;                                                                                    \
    if (COOP && (i) < ph_hi) {                                                               \
      xcd_barrier(xb);                                                                       \
    }                                                                                        \
  }
#endif
  RUN_PHASE(0, phase0(p))
  RUN_PHASE(1, phase1(p, smem))
  RUN_PHASE(2, phase2(p, smem))
  RUN_PHASE(3, phase3(p, smem))
  RUN_PHASE(4, phase_nsa(p, smem))
  RUN_PHASE(5, phase_resid<false>(p, smem, p.mix, p.woutT, p.x, p.ssq1))
  RUN_PHASE(6, phase_scaled(p, smem, p.hn, p.wmqT, 8, p.ssq1, p.qm, LDA))
  RUN_PHASE(7, phase_memattn(p, smem))
  RUN_PHASE(8, phase_resid<true>(p, smem, p.mix, p.wmoT, nullptr, p.ssq2))
  RUN_PHASE(9, phase_scaled(p, smem, p.hn, p.wpqT, 16, p.ssq2, p.pq, LDPQ))
  RUN_PHASE(10, phase_peer_route(p, smem))
  RUN_PHASE(11, phase_peer_gather<0>(p))
  RUN_PHASE(12, phase_peer_gather<1>(p))
#undef RUN_PHASE
}

extern "C" void kernel_launch(void* const* d_in, const int* in_sizes, int n_in, void* d_out, int out_size, void* d_ws,
                              size_t ws_size, hipStream_t stream) {
  (void)in_sizes; (void)n_in; (void)out_size; (void)ws_size;
  Params p{};
  p.x = (const float*)d_in[0]; p.mem = (const float*)d_in[1]; p.pos = (const int*)d_in[2];
  p.mix_g = (const float*)d_in[3]; p.w_in = (const float*)d_in[4]; p.conv_w = (const float*)d_in[5];
  p.conv_b = (const float*)d_in[6]; p.ln_g = (const float*)d_in[7]; p.ln_b = (const float*)d_in[8];
  p.cmp_pos = (const float*)d_in[9]; p.cmp_w1 = (const float*)d_in[10]; p.cmp_b1 = (const float*)d_in[11];
  p.cmp_w2 = (const float*)d_in[12]; p.cmp_b2 = (const float*)d_in[13]; p.w_out = (const float*)d_in[14];
  p.memq_g = (const float*)d_in[15]; p.memkv_g = (const float*)d_in[16]; p.w_mq = (const float*)d_in[17];
  p.w_mk = (const float*)d_in[18]; p.w_mv = (const float*)d_in[19]; p.w_mo = (const float*)d_in[20];
  p.peer_g = (const float*)d_in[21]; p.peer_wq = (const float*)d_in[22]; p.peer_sk = (const float*)d_in[23];
  p.peer_u = (const float*)d_in[24]; p.peer_v = (const float*)d_in[25]; p.final_g = (const float*)d_in[26];
  p.out = (float*)d_out;
  unsigned char* ws = (unsigned char*)d_ws;
  size_t off = 0;
  auto take = [&](size_t bytes) { unsigned char* r = ws + off; off += (bytes + 255) & ~(size_t)255; return r; };
  unsigned char* regA = take((size_t)NTOK * LDA * 2);
  unsigned char* regB = take((size_t)NTOK * LDP * 2);
  unsigned char* regC = take((size_t)NTOK * LDA * 2);
  p.hn = (u16*)regA;
  p.proj = (u16*)regB; p.qm = (u16*)regB; p.pq = (u16*)regB;
  p.mix = (u16*)regC; p.experts = (int*)regC; p.gates = (float*)(regC + (size_t)NTOK * 128 * 4);
  {
    unsigned char* tb = regC + (size_t)2 * NTOK * 128 * 4;
    p.ub8 = tb; p.vb8 = tb + (size_t)16384 * 1024;
    p.uscale = (float*)(tb + (size_t)2 * 16384 * 1024); p.vscale = p.uscale + 16384;
  }
  p.h = nullptr;
  p.vts = (u16*)take((size_t)Bn * 2 * 64 * LDT * 2);
  p.vtw = (u16*)take((size_t)Bn * 2 * 64 * LDT * 2);
  p.memn = (u16*)take((size_t)Bn * 256 * LDA * 2);
  p.memk = (u16*)take((size_t)Bn * 256 * LDA * 2);
  p.memvt = (u16*)take((size_t)Bn * 256 * D * 2);
  p.winT = (u16*)take((size_t)2432 * LDA * 2);
  p.woutT = (u16*)take((size_t)1024 * LDA * 2);
  p.wmqT = (u16*)take((size_t)1024 * LDA * 2);
  p.wmkT = (u16*)take((size_t)1024 * LDA * 2);
  p.wmvT = (u16*)take((size_t)1024 * LDA * 2);
  p.wmoT = (u16*)take((size_t)1024 * LDA * 2);
  p.wpqT = (u16*)take((size_t)2048 * LDA * 2);
  p.subk = (u16*)take((size_t)16 * 128 * 128 * 2);
  p.w1T = (u16*)take((size_t)2 * 128 * LDW1 * 2);
  p.w2T = (u16*)take((size_t)2 * 128 * 128 * 2);
  p.biasp = (float*)take(256 * 4);
  p.rope = (float*)take((size_t)NTOK * 16 * 4);
  p.hdn = (u16*)take((size_t)2 * 4096 * 128 * 2);
  p.kc = (u16*)take((size_t)Bn * 2 * 128 * 64 * 2);
  p.vcT = (u16*)take((size_t)Bn * 2 * 64 * 128 * 2);
  p.ssq1 = (float*)take((size_t)NTOK * 4);
  p.ssq2 = (float*)take((size_t)NTOK * 4);
  p.bar = (unsigned*)take(16384);
  if (off > ws_size) { fprintf(stderr, "workspace too small: need %zu have %zu\n", off, ws_size); return; }

#if COOP_MODE
  static int grid_blocks = 0;
  if (!grid_blocks) {
    int dev = 0, cus = 0, per_cu = 0;
    hipGetDevice(&dev);
    hipDeviceGetAttribute(&cus, hipDeviceAttributeMultiprocessorCount, dev);
    hipOccupancyMaxActiveBlocksPerMultiprocessor(&per_cu, mega<true>, 256, 0);
    if (per_cu > 2) per_cu = 2;
    if (per_cu < 1) per_cu = 1;
    grid_blocks = cus * per_cu;
  }
  int lo = 0, hi = NPHASE;
  void* args[] = {&p, &lo, &hi};
  (void)hipMemsetAsync(p.bar, 0, 16384, stream);
  hipError_t e = hipLaunchCooperativeKernel((void*)mega<true>, dim3(grid_blocks), dim3(256), args, 0, stream);
  if (e != hipSuccess) fprintf(stderr, "cooperative launch failed: %s (grid %d)\n", hipGetErrorString(e), grid_blocks);
#else
  for (int ph = 0; ph <= NPHASE; ++ph) mega<false><<<dim3(512), dim3(256), 0, stream>>>(p, ph, ph);
#endif
}
```

```cpp
#include <hip/hip_runtime.h>
#include <hip/hip_bf16.h>
#include <hip/hip_cooperative_groups.h>
#include <cstdio>
#include <cstdint>
namespace cg = cooperative_groups;

#ifndef COOP_MODE
#define COOP_MODE 1
#endif

typedef __attribute__((ext_vector_type(8))) short bf16x8;
typedef __attribute__((ext_vector_type(4))) short bf16x4;
typedef __attribute__((ext_vector_type(4))) float f32x4;
typedef unsigned short u16;

#define DEVI __device__ __forceinline__

constexpr int Bn = 16, T = 2048, D = 1024, NTOK = Bn * T, LDP = 2336;
constexpr int C_Q = 1024, C_KC = 1536, C_VC = 1664, C_KS = 1792, C_VS = 1920, C_KW = 2048, C_VW = 2176, C_GATE = 2304;
constexpr int SMEM_BYTES = 73728;
constexpr int LDA = 1088;
constexpr int LDHF = 1056;
constexpr int LDPQ = 2112;
constexpr int LDW1 = 2112;
constexpr int LDT = 2112;
constexpr int NPHASE = 12;

struct Params {
  const float* x; const float* mem; const int* pos; const float* mix_g; const float* w_in;
  const float* conv_w; const float* conv_b; const float* ln_g; const float* ln_b;
  const float* cmp_pos; const float* cmp_w1; const float* cmp_b1; const float* cmp_w2; const float* cmp_b2;
  const float* w_out; const float* memq_g; const float* memkv_g; const float* w_mq; const float* w_mk;
  const float* w_mv; const float* w_mo; const float* peer_g; const float* peer_wq; const float* peer_sk;
  const float* peer_u; const float* peer_v; const float* final_g;
  float* out;
  u16* hn; u16* proj; u16* mix; float* h; u16* vts; u16* vtw; u16* memn; u16* memk; u16* memvt;
  u16* winT; u16* woutT; u16* wmqT; u16* wmkT; u16* wmvT; u16* wmoT; u16* wpqT; u16* subk; u16* w1T; u16* w2T;
  float* biasp; float* rope; u16* hdn; u16* kc; u16* vcT; float* ssq1; float* ssq2;
  int* experts; float* gates; unsigned char* ub8; unsigned char* vb8; float* uscale; float* vscale; u16* qm; u16* pq;
  unsigned* bar;
};

DEVI int launder(int x) { asm volatile("" : "+v"(x)); return x; }
DEVI u16 f2bf(float f) {
  unsigned u = __float_as_uint(f);
  u += 0x7fffu + ((u >> 16) & 1u);
  return (u16)(u >> 16);
}
DEVI float bf2f(u16 h) { return __uint_as_float(((unsigned)h) << 16); }
DEVI unsigned pack2(float a, float b) { return (unsigned)f2bf(a) | ((unsigned)f2bf(b) << 16); }
DEVI float wave_sum(float v) {
#pragma unroll
  for (int o = 32; o; o >>= 1) v += __shfl_xor(v, o);
  return v;
}
DEVI float sigmoidf_(float x) { return 1.f / (1.f + __expf(-x)); }
DEVI float gelu_tanh(float x) {
  float u = 0.7978845608028654f * (x + 0.044715f * x * x * x);
  return 0.5f * x * (1.f + tanhf(u));
}
DEVI f32x4 mfma16(bf16x8 a, bf16x8 b, f32x4 c) { return __builtin_amdgcn_mfma_f32_16x16x32_bf16(a, b, c, 0, 0, 0); }
DEVI float fexp2(float x) { return __builtin_amdgcn_exp2f(x); }

DEVI void tconv(const float* __restrict__ src, int K, int N, u16* __restrict__ dst, int Npad, int ldd,
                const float* __restrict__ gain, int gtid, int gsz) {
  const int items = Npad * (K >> 3);
  for (int it = gtid; it < items; it += gsz) {
    const int n = it % Npad, kc = it / Npad;
    float f[8];
#pragma unroll
    for (int j = 0; j < 8; ++j) {
      float v = 0.f;
      if (n < N) {
        v = src[(size_t)(kc * 8 + j) * N + n];
        if (gain) v *= gain[kc * 8 + j];
      }
      f[j] = v;
    }
    uint4 pk;
    pk.x = pack2(f[0], f[1]); pk.y = pack2(f[2], f[3]); pk.z = pack2(f[4], f[5]); pk.w = pack2(f[6], f[7]);
    *(uint4*)(dst + (size_t)n * ldd + kc * 8) = pk;
  }
}

DEVI void conv_flat(const float* __restrict__ src, u16* __restrict__ dst, size_t n8, size_t gtid, size_t gsz) {
  for (size_t it = gtid; it < n8; it += gsz) {
    const float4 a = ((const float4*)src)[2 * it], b = ((const float4*)src)[2 * it + 1];
    uint4 pk;
    pk.x = pack2(a.x, a.y); pk.y = pack2(a.z, a.w); pk.z = pack2(b.x, b.y); pk.w = pack2(b.z, b.w);
    ((uint4*)dst)[it] = pk;
  }
}


typedef float f32x2 __attribute__((ext_vector_type(2)));
DEVI unsigned pk4_fp8(float a, float b, float c, float d) {
  int v = 0;
  v = __builtin_amdgcn_cvt_pk_fp8_f32(a, b, v, false);
  v = __builtin_amdgcn_cvt_pk_fp8_f32(c, d, v, true);
  return (unsigned)v;
}
DEVI void conv_fp8_rows(const float* __restrict__ src, unsigned char* __restrict__ dst, float* __restrict__ inv_scale,
                        int rows, int gw, int nw, int lane) {
  for (int r0 = gw; r0 < rows; r0 += 2 * nw) {
    const int r1 = r0 + nw;
    const bool has1 = r1 < rows;
    const float4* p0 = (const float4*)(src + (size_t)r0 * 1024) + lane * 4;
    const float4* p1 = (const float4*)(src + (size_t)(has1 ? r1 : r0) * 1024) + lane * 4;
    float4 v[2][4];
#pragma unroll
    for (int i = 0; i < 4; ++i) { v[0][i] = p0[i]; v[1][i] = p1[i]; }
    float mx[2];
#pragma unroll
    for (int q = 0; q < 2; ++q) {
      float m = 0.f;
#pragma unroll
      for (int i = 0; i < 4; ++i)
        m = fmaxf(m, fmaxf(fmaxf(fabsf(v[q][i].x), fabsf(v[q][i].y)), fmaxf(fabsf(v[q][i].z), fabsf(v[q][i].w))));
      mx[q] = m;
    }
#pragma unroll
    for (int o = 32; o; o >>= 1) { mx[0] = fmaxf(mx[0], __shfl_xor(mx[0], o)); mx[1] = fmaxf(mx[1], __shfl_xor(mx[1], o)); }
#pragma unroll
    for (int q = 0; q < 2; ++q) {
      if (q == 1 && !has1) break;
      const int r = q ? r1 : r0;
      const float sc = mx[q] > 0.f ? 224.f / mx[q] : 1.f;
      if (lane == 0) inv_scale[r] = mx[q] > 0.f ? mx[q] * (1.f / 224.f) : 1.f;
      uint4 o4;
      o4.x = pk4_fp8(v[q][0].x * sc, v[q][0].y * sc, v[q][0].z * sc, v[q][0].w * sc);
      o4.y = pk4_fp8(v[q][1].x * sc, v[q][1].y * sc, v[q][1].z * sc, v[q][1].w * sc);
      o4.z = pk4_fp8(v[q][2].x * sc, v[q][2].y * sc, v[q][2].z * sc, v[q][2].w * sc);
      o4.w = pk4_fp8(v[q][3].x * sc, v[q][3].y * sc, v[q][3].z * sc, v[q][3].w * sc);
      ((uint4*)(dst + (size_t)r * 1024))[lane] = o4;
    }
  }
}

DEVI void rownorm_bf16(const float* __restrict__ src, const float* __restrict__ g, u16* __restrict__ dst,
                       int rows, int gw, int nw, int lane) {
  for (int r0 = gw; r0 < rows; r0 += 2 * nw) {
    const int r1 = r0 + nw;
    const bool has1 = r1 < rows;
    const float4* pa = (const float4*)(src + (size_t)r0 * D);
    const float4* pb = (const float4*)(src + (size_t)(has1 ? r1 : r0) * D);
    float4 va[4], vb[4];
    float sa = 0.f, sb = 0.f;
#pragma unroll
    for (int i = 0; i < 4; ++i) { va[i] = pa[lane + 64 * i]; vb[i] = pb[lane + 64 * i]; }
#pragma unroll
    for (int i = 0; i < 4; ++i) {
      sa += va[i].x * va[i].x + va[i].y * va[i].y + va[i].z * va[i].z + va[i].w * va[i].w;
      sb += vb[i].x * vb[i].x + vb[i].y * vb[i].y + vb[i].z * vb[i].z + vb[i].w * vb[i].w;
    }
#pragma unroll
    for (int o = 32; o; o >>= 1) { sa += __shfl_xor(sa, o); sb += __shfl_xor(sb, o); }
    const float ra = rsqrtf(sa * (1.f / D) + 1e-6f), rb = rsqrtf(sb * (1.f / D) + 1e-6f);
#pragma unroll
    for (int i = 0; i < 4; ++i) {
      const float4 gg = ((const float4*)g)[lane + 64 * i];
      uint2 pk;
      pk.x = pack2(va[i].x * ra * gg.x, va[i].y * ra * gg.y);
      pk.y = pack2(va[i].z * ra * gg.z, va[i].w * ra * gg.w);
      *(uint2*)(dst + (size_t)r0 * LDA + (size_t)(lane + 64 * i) * 4) = pk;
      if (has1) {
        pk.x = pack2(vb[i].x * rb * gg.x, vb[i].y * rb * gg.y);
        pk.y = pack2(vb[i].z * rb * gg.z, vb[i].w * rb * gg.w);
        *(uint2*)(dst + (size_t)r1 * LDA + (size_t)(lane + 64 * i) * 4) = pk;
      }
    }
  }
}

DEVI void phase0(const Params& p) {
  const int tid = launder(threadIdx.x), lane = tid & 63;
  const int gtid = blockIdx.x * 256 + tid, gsz = gridDim.x * 256;
  const int gw = gtid >> 6, nw = gsz >> 6;
  rownorm_bf16(p.x, p.mix_g, p.hn, NTOK, gw, nw, lane);
  rownorm_bf16(p.mem, p.memkv_g, p.memn, Bn * 256, gw, nw, lane);
  tconv(p.w_in, 1024, 2328, p.winT, 2432, LDA, nullptr, gtid, gsz);
  tconv(p.w_out, 1024, 1024, p.woutT, 1024, LDA, nullptr, gtid, gsz);
  tconv(p.w_mq, 1024, 1024, p.wmqT, 1024, LDA, p.memq_g, gtid, gsz);
  tconv(p.w_mk, 1024, 1024, p.wmkT, 1024, LDA, nullptr, gtid, gsz);
  tconv(p.w_mv, 1024, 1024, p.wmvT, 1024, LDA, nullptr, gtid, gsz);
  tconv(p.w_mo, 1024, 1024, p.wmoT, 1024, LDA, nullptr, gtid, gsz);
  tconv(p.peer_wq, 1024, 2048, p.wpqT, 2048, LDA, p.peer_g, gtid, gsz);
  tconv(p.cmp_w1, 2048, 128, p.w1T, 128, LDW1, nullptr, gtid, gsz);
  tconv(p.cmp_w1 + 2048 * 128, 2048, 128, p.w1T + 128 * LDW1, 128, LDW1, nullptr, gtid, gsz);
  tconv(p.cmp_w2, 128, 64, p.w2T, 128, 128, nullptr, gtid, gsz);
  tconv(p.cmp_w2 + 128 * 64, 128, 64, p.w2T + 128 * 128, 128, 128, nullptr, gtid, gsz);
  conv_flat(p.peer_sk, p.subk, (size_t)16 * 128 * 128 / 8, gtid, gsz);
  for (int it = gtid; it < NTOK * 8; it += gsz) {
    const int tok = it >> 3, i = it & 7;
    const float inv = (i == 0) ? 1.000000000e+00f : (i == 1) ? 1.939227432e-01f : (i == 2) ? 3.760603070e-02f : (i == 3) ? 7.292664610e-03f : (i == 4) ? 1.414213562e-03f : (i == 5) ? 2.742481884e-04f : (i == 6) ? 5.318295734e-05f : 1.031338525e-05f;
    const float ang = (float)p.pos[tok] * inv;
    float sv, cv;
    sincosf(ang, &sv, &cv);
    p.rope[tok * 16 + i] = cv;
    p.rope[tok * 16 + 8 + i] = sv;
  }
  for (int o = gw; o < 256; o += nw) {
    const int ty = o >> 7, n = o & 127;
    float s = 0.f;
#pragma unroll 8
    for (int k = lane; k < 2048; k += 64)
      s += p.cmp_pos[ty * 2048 + k] * p.cmp_w1[((size_t)ty * 2048 + k) * 128 + n];
    s = wave_sum(s);
    if (lane == 0) p.biasp[o] = s + p.cmp_b1[o];
  }
  for (int it = gtid; it < NTOK; it += gsz) { p.ssq1[it] = 0.f; p.ssq2[it] = 0.f; }
}

template <bool DB, class AF>
DEVI void gemm_mainloop(int tid, u16* sA, u16* sB, AF af, const u16* __restrict__ Bt, int ldb, int m0, int n0, int nk,
                        f32x4 (&acc)[4][4]) {
  const int lane = tid & 63, w = tid >> 6;
  const int wm = w >> 1, wn = w & 1, col = lane & 15, quad = lane >> 4;
#pragma unroll
  for (int i = 0; i < 4; ++i)
#pragma unroll
    for (int j = 0; j < 4; ++j) acc[i][j] = f32x4{0.f, 0.f, 0.f, 0.f};
  uint4 ra0, ra1, ra2, ra3, rb0, rb1, rb2, rb3;
  const int lrow = tid >> 3, lkc = (tid & 7) << 3;
  const u16* bbase = Bt + (size_t)(n0 + lrow) * ldb + lkc;
#define GL_(R, i, kk)                                                     \
  R##a##i = *(const uint4*)af(m0 + lrow + 32 * i, (kk) + lkc);            \
  R##b##i = *(const uint4*)(bbase + (size_t)(32 * i) * ldb + (kk));
#define SS_(R, i, off)                                                    \
  *(uint4*)(sA + (off) + (lrow + 32 * i) * 72 + lkc) = R##a##i;           \
  *(uint4*)(sB + (off) + (lrow + 32 * i) * 72 + lkc) = R##b##i;
#define GL4_(R, kk) GL_(R, 0, kk) GL_(R, 1, kk) GL_(R, 2, kk) GL_(R, 3, kk)
#define SS4_(R, off) SS_(R, 0, off) SS_(R, 1, off) SS_(R, 2, off) SS_(R, 3, off)
#define COMPUTE_(cur)                                                                                                   \
  _Pragma("unroll") for (int ks = 0; ks < 2; ++ks) {                                                                    \
    bf16x8 fa[4], fb[4];                                                                                                \
    _Pragma("unroll") for (int mi = 0; mi < 4; ++mi)                                                                    \
      fa[mi] = *(const bf16x8*)(sA + (cur) + (wm * 64 + 16 * mi + col) * 72 + 32 * ks + 8 * quad);                      \
    _Pragma("unroll") for (int ni = 0; ni < 4; ++ni)                                                                    \
      fb[ni] = *(const bf16x8*)(sB + (cur) + (wn * 64 + 16 * ni + col) * 72 + 32 * ks + 8 * quad);                      \
    _Pragma("unroll") for (int ni = 0; ni < 4; ++ni)                                                                    \
      _Pragma("unroll") for (int mi = 0; mi < 4; ++mi) acc[ni][mi] = mfma16(fb[ni], fa[mi], acc[ni][mi]);               \
  }
  if (DB) {
    const int srow = 8 * w + (lane >> 3);
    const int spc = lane & 7;
#define STAGE_(st, kk)                                                                                         \
    _Pragma("unroll") for (int i = 0; i < 4; ++i) {                                                            \
      const int r_ = 32 * i + srow;                                                                            \
      const int c_ = (spc ^ ((r_ >> 1) & 7)) << 3;                                                             \
      __builtin_amdgcn_global_load_lds((const unsigned*)af(m0 + r_, (kk) + c_),                                \
                                       (unsigned*)(sA + (st) * 16384 + (32 * i + 8 * w) * 64), 16, 0, 0);      \
      __builtin_amdgcn_global_load_lds((const unsigned*)(Bt + (size_t)(n0 + r_) * ldb + (kk) + c_),            \
                                       (unsigned*)(sA + (st) * 16384 + 8192 + (32 * i + 8 * w) * 64), 16, 0, 0); \
    }
#define COMPUTE_SW_(st)                                                                                                 \
  _Pragma("unroll") for (int ks = 0; ks < 2; ++ks) {                                                                    \
    bf16x8 fa[4], fb[4];                                                                                                \
    const int pc_ = ((4 * ks + quad) ^ ((col >> 1) & 7)) << 3;                                                          \
    _Pragma("unroll") for (int mi = 0; mi < 4; ++mi)                                                                    \
      fa[mi] = *(const bf16x8*)(sA + (st) * 16384 + (wm * 64 + 16 * mi + col) * 64 + pc_);                              \
    _Pragma("unroll") for (int ni = 0; ni < 4; ++ni)                                                                    \
      fb[ni] = *(const bf16x8*)(sA + (st) * 16384 + 8192 + (wn * 64 + 16 * ni + col) * 64 + pc_);                       \
    _Pragma("unroll") for (int ni = 0; ni < 4; ++ni)                                                                    \
      _Pragma("unroll") for (int mi = 0; mi < 4; ++mi) acc[ni][mi] = mfma16(fb[ni], fa[mi], acc[ni][mi]);               \
  }
    STAGE_(0, 0)
#pragma unroll 1
    for (int kt = 0; kt < nk; kt += 2) {
      asm volatile("s_waitcnt vmcnt(0)" ::: "memory");
      __syncthreads();
      { const int kk = (kt + 1) * 64; STAGE_(1, kk) }
      COMPUTE_SW_(0)
      asm volatile("s_waitcnt vmcnt(0)" ::: "memory");
      __syncthreads();
      if (kt + 2 < nk) { const int kk = (kt + 2) * 64; STAGE_(0, kk) }
      COMPUTE_SW_(1)
    }
#undef STAGE_
#undef COMPUTE_SW_
  } else {
    GL4_(r, 0)
    SS4_(r, 0)
    __syncthreads();
#pragma unroll 1
    for (int kt = 0; kt < nk; ++kt) {
      const bool more = (kt + 1 < nk);
      if (more) { const int kk = (kt + 1) * 64; GL4_(r, kk) }
      COMPUTE_(0)
      __syncthreads();
      if (more) {
        SS4_(r, 0)
        __syncthreads();
      }
    }
  }
#undef GL_
#undef SS_
#undef GL4_
#undef SS4_
#undef COMPUTE_
}

struct ARow {
  const u16* base; int lda;
  DEVI const u16* operator()(int m, int k) const { return base + (size_t)m * lda + k; }
};
struct ACmp {
  const u16* proj; int colbase;
  DEVI const u16* operator()(int rr, int k) const {
    const int b = rr >> 8, g = (rr >> 7) & 1;
    int c = rr & 127; c = c > 126 ? 126 : c;
    const int l = k >> 6, d = k & 63;
    return proj + ((size_t)b * T + 16 * c + l) * LDP + colbase + g * 64 + d;
  }
};


#define XCD_TILE_LOOP(idx, MT, NT)                                                                     \
  const bool sw_ = (gridDim.x & 7) == 0;                                                               \
  const int xcd_ = blockIdx.x & 7;                                                                     \
  const int tstart_ = sw_ ? (int)(blockIdx.x >> 3) : (int)blockIdx.x;                                  \
  const int tstep_ = sw_ ? (int)(gridDim.x >> 3) : (int)gridDim.x;                                     \
  const int ttotal_ = sw_ ? ((MT) / 8) * (NT) : (MT) * (NT);                                           \
  _Pragma("unroll 1") for (int idx = tstart_; idx < ttotal_; idx += tstep_)
#define XCD_TILE_MT(idx, NT) (sw_ ? ((idx) / (NT)) * 8 + xcd_ : (idx) / (NT))
#define XCD_TILE_NT(idx, NT) ((idx) % (NT))

#define GEMM_LANE_VARS                                                    \
  const int tid = launder(threadIdx.x), lane = tid & 63, w = tid >> 6;    \
  const int wm = w >> 1, wn = w & 1, col = lane & 15, quad = lane >> 4;   \
  (void)wm; (void)wn; (void)col; (void)quad;

DEVI void phase1(const Params& p, unsigned char* smem) {
  u16* sA = (u16*)smem; u16* sB = sA + 128 * 72;
  XCD_TILE_LOOP(idx, 256 + 32, 19) {
    GEMM_LANE_VARS
    f32x4 acc[4][4];
    const int mt = XCD_TILE_MT(idx, 19), nt_ = XCD_TILE_NT(idx, 19);
    if (mt < 256) {
      const int m0 = mt * 128, n0 = nt_ * 128;
      gemm_mainloop<true>(tid, sA, sB, ARow{p.hn, LDA}, p.winT, LDA, m0, n0, 16, acc);
#pragma unroll
      for (int mi = 0; mi < 4; ++mi) {
        const int m = m0 + wm * 64 + 16 * mi + col;
        const int b = m >> 11, t = m & 2047;
#pragma unroll
        for (int ni = 0; ni < 4; ++ni) {
          const int nt = n0 + wn * 64 + 16 * ni;
          const int n = nt + 4 * quad;
          f32x4 v = acc[ni][mi];
          if (nt >= LDP) continue;
          if ((nt >= C_VS && nt < C_KW) || (nt >= C_VW && nt < C_GATE)) {
            const bool isw = nt >= C_VW;
            const int off = n - (isw ? C_VW : C_VS);
            const int g = off >> 6, d = off & 63;
            u16* dst = (isw ? p.vtw : p.vts) + ((size_t)(b * 2 + g) * 64 + d) * LDT + t;
#pragma unroll
            for (int r = 0; r < 4; ++r) dst[(size_t)r * LDT] = f2bf(v[r]);
          } else {
            const bool rope_tile = ((nt >= C_KS && nt < C_VS) || (nt >= C_KW && nt < C_VW)) && ((nt & 63) == 0);
            if (rope_tile) {
#pragma unroll
              for (int r = 0; r < 4; ++r) {
                const float pr = __shfl_xor(v[r], 32);
                const int i = ((quad & 1) << 2) + r;
                const float cs = p.rope[(size_t)m * 16 + i], sn = p.rope[(size_t)m * 16 + 8 + i];
                v[r] = (quad < 2) ? (v[r] * cs - pr * sn) : (v[r] * cs + pr * sn);
              }
            }
            uint2 pk; pk.x = pack2(v[0], v[1]); pk.y = pack2(v[2], v[3]);
            *(uint2*)(p.proj + (size_t)m * LDP + n) = pk;
          }
        }
      }
    } else if (nt_ < 16) {
      const int isv = nt_ >> 3;
      const int m0 = (mt - 256) * 128, n0 = (nt_ & 7) * 128;
      gemm_mainloop<true>(tid, sA, sB, ARow{p.memn, LDA}, isv ? p.wmvT : p.wmkT, LDA, m0, n0, 16, acc);
#pragma unroll
      for (int mi = 0; mi < 4; ++mi) {
        const int m = m0 + wm * 64 + 16 * mi + col;
        const int b = m >> 8, key = m & 255;
#pragma unroll
        for (int ni = 0; ni < 4; ++ni) {
          const int n = n0 + wn * 64 + 16 * ni + 4 * quad;
          const f32x4 v = acc[ni][mi];
          if (isv) {
            const int head = n >> 8, d = n & 255;
            u16* dst = p.memvt + ((size_t)(b * 4 + head) * 256 + d) * 256 + key;
#pragma unroll
            for (int r = 0; r < 4; ++r) dst[r * 256] = f2bf(v[r]);
          } else {
            uint2 pk; pk.x = pack2(v[0], v[1]); pk.y = pack2(v[2], v[3]);
            *(uint2*)(p.memk + (size_t)m * LDA + n) = pk;
          }
        }
      }
    }
  }
}

DEVI void conv_tile(const Params& p, unsigned char* smem, int ct) {
  u16* sU = (u16*)smem;
  float2* sRed = (float2*)(smem + 62 * 512 * 2);
  const int tid = launder(threadIdx.x), lane = tid & 63, w = tid >> 6;
  const int b = ct >> 6, t0 = (ct & 63) * 32;
  __syncthreads();
  for (int it = tid; it < 62 * 64; it += 256) {
    const int r = it >> 6, c8 = it & 63;
    const int t = t0 - 30 + r;
    uint4 pk = {0u, 0u, 0u, 0u};
    if (t >= 0) {
      const u16* src = p.proj + ((size_t)b * T + t) * LDP + c8 * 8;
      const uint4 a = *(const uint4*)src, bb = *(const uint4*)(src + 512);
      const unsigned au[4] = {a.x, a.y, a.z, a.w}, bu[4] = {bb.x, bb.y, bb.z, bb.w};
      unsigned o[4];
#pragma unroll
      for (int j = 0; j < 4; ++j) {
        const float a0 = __uint_as_float(au[j] << 16), a1 = __uint_as_float(au[j] & 0xffff0000u);
        const float b0 = __uint_as_float(bu[j] << 16), b1 = __uint_as_float(bu[j] & 0xffff0000u);
        o[j] = pack2(a0 * sigmoidf_(b0), a1 * sigmoidf_(b1));
      }
      pk.x = o[0]; pk.y = o[1]; pk.z = o[2]; pk.w = o[3];
    }
    *(uint4*)(sU + r * 512 + c8 * 8) = pk;
  }
  const int c = 2 * tid;
  float w0[31], w1[31];
#pragma unroll
  for (int j = 0; j < 31; ++j) { w0[j] = p.conv_w[j * 512 + c]; w1[j] = p.conv_w[j * 512 + c + 1]; }
  const float bd0 = p.conv_b[c], bd1 = p.conv_b[c + 1];
  __syncthreads();
  float ya[32], yb[32];
#pragma unroll
  for (int tt = 0; tt < 32; ++tt) {
    float y0 = bd0, y1 = bd1;
#pragma unroll
    for (int j = 0; j < 31; ++j) {
      const unsigned uu = *(const unsigned*)(sU + (tt + j) * 512 + c);
      y0 += w0[j] * __uint_as_float(uu << 16);
      y1 += w1[j] * __uint_as_float(uu & 0xffff0000u);
    }
    ya[tt] = y0; yb[tt] = y1;
    float s = y0 + y1, q = y0 * y0 + y1 * y1;
    s = wave_sum(s); q = wave_sum(q);
    if (lane == 0) sRed[tt * 4 + w] = make_float2(s, q);
  }
  __syncthreads();
  const float g0 = p.ln_g[c], g1 = p.ln_g[c + 1], lb0 = p.ln_b[c], lb1 = p.ln_b[c + 1];
#pragma unroll
  for (int tt = 0; tt < 32; ++tt) {
    const float y0 = ya[tt], y1 = yb[tt];
    const float2 r0 = sRed[tt * 4 + 0], r1 = sRed[tt * 4 + 1], r2 = sRed[tt * 4 + 2], r3 = sRed[tt * 4 + 3];
    const float S = r0.x + r1.x + r2.x + r3.x, Q = r0.y + r1.y + r2.y + r3.y;
    const float mu = S * (1.f / 512.f);
    const float var = fmaxf(Q * (1.f / 512.f) - mu * mu, 0.f);
    const float rstd = rsqrtf(var + 1e-6f);
    const float z0 = (y0 - mu) * rstd * g0 + lb0, z1 = (y1 - mu) * rstd * g1 + lb1;
    const float o0 = z0 * sigmoidf_(z0), o1 = z1 * sigmoidf_(z1);
    *(unsigned*)(p.mix + ((size_t)b * T + t0 + tt) * LDA + c) = pack2(o0, o1);
  }
}

DEVI void compress2_tile(const Params& p, unsigned char* smem, int tile);
DEVI void phase2(const Params& p, unsigned char* smem) {
  u16* sA = (u16*)smem; u16* sB = sA + 128 * 72;
#pragma unroll 1
  for (int tile = blockIdx.x; tile < 64 + 1024; tile += gridDim.x) {
    GEMM_LANE_VARS
    if (tile < 64) {
      const int ty = tile >> 5, mt = tile & 31;
      const int m0 = mt * 128;
      f32x4 acc[4][4];
      gemm_mainloop<true>(tid, sA, sB, ACmp{p.proj, ty ? C_VC : C_KC}, p.w1T + (size_t)ty * 128 * LDW1, LDW1, m0, 0, 32, acc);
#pragma unroll
      for (int mi = 0; mi < 4; ++mi) {
        const int m = m0 + wm * 64 + 16 * mi + col;
#pragma unroll
        for (int ni = 0; ni < 4; ++ni) {
          const int n = wn * 64 + 16 * ni + 4 * quad;
          const f32x4 v = acc[ni][mi];
          const float4 bb = *(const float4*)(p.biasp + ty * 128 + n);
          uint2 pk;
          pk.x = pack2(gelu_tanh(v[0] + bb.x), gelu_tanh(v[1] + bb.y));
          pk.y = pack2(gelu_tanh(v[2] + bb.z), gelu_tanh(v[3] + bb.w));
          *(uint2*)(p.hdn + ((size_t)ty * 4096 + m) * 128 + n) = pk;
        }
      }
      asm volatile("s_waitcnt vmcnt(0)" ::: "memory");
      __syncthreads();
      compress2_tile(p, smem, tile);
    } else {
      conv_tile(p, smem, tile - 64);
    }
  }
}

DEVI void compress2_tile(const Params& p, unsigned char* smem, int tile) {
  u16* sA = (u16*)smem; u16* sB = sA + 128 * 72;
  {
    GEMM_LANE_VARS
    const int ty = tile >> 5, mt = tile & 31;
    const int m0 = mt * 128;
    f32x4 acc[4][4];
    gemm_mainloop<true>(tid, sA, sB, ARow{p.hdn + (size_t)ty * 4096 * 128, 128}, p.w2T + (size_t)ty * 128 * 128, 128, m0, 0, 2, acc);
    if (wn == 0) {
#pragma unroll
      for (int mi = 0; mi < 4; ++mi) {
        const int m = m0 + 16 * mi + wm * 64 + col;
        const int bg = m >> 7, c = m & 127;
#pragma unroll
        for (int ni = 0; ni < 4; ++ni) {
          const int n = 16 * ni + 4 * quad;
          const f32x4 v = acc[ni][mi];
          const float4 bb = *(const float4*)(p.cmp_b2 + ty * 64 + n);
          const float o0 = v[0] + bb.x, o1 = v[1] + bb.y, o2 = v[2] + bb.z, o3 = v[3] + bb.w;
          if (ty == 0) {
            uint2 pk; pk.x = pack2(o0, o1); pk.y = pack2(o2, o3);
            *(uint2*)(p.kc + (size_t)m * 64 + n) = pk;
          } else {
            u16* dst = p.vcT + ((size_t)bg * 64 + n) * 128 + c;
            dst[0] = f2bf(o0); dst[128] = f2bf(o1); dst[256] = f2bf(o2); dst[384] = f2bf(o3);
          }
        }
      }
    }
  }
}

template <int DH, int NQ, int LDK, class MaskF>
DEVI void attn_qk(const u16* sK, const bf16x8 (&qf)[NQ][DH / 32], f32x4 (&o)[NQ][DH / 16], float (&m)[NQ], float (&l)[NQ],
                  float c2, int lane, MaskF valid, bf16x8 (&pb)[NQ][2]) {
  const int col = lane & 15, quad = lane >> 4;
  f32x4 s[NQ][4];
#pragma unroll
  for (int kt = 0; kt < 4; ++kt) {
#pragma unroll
    for (int qt = 0; qt < NQ; ++qt) s[qt][kt] = f32x4{0.f, 0.f, 0.f, 0.f};
#pragma unroll
    for (int ks = 0; ks < DH / 32; ++ks) {
      const bf16x8 kf = *(const bf16x8*)(sK + (16 * kt + col) * LDK + 32 * ks + 8 * quad);
#pragma unroll
      for (int qt = 0; qt < NQ; ++qt) s[qt][kt] = mfma16(kf, qf[qt][ks], s[qt][kt]);
    }
  }
#pragma unroll
  for (int qt = 0; qt < NQ; ++qt) {
    float mx = -1e30f;
#pragma unroll
    for (int kt = 0; kt < 4; ++kt)
#pragma unroll
      for (int r = 0; r < 4; ++r) {
        const bool v = valid(qt, 16 * kt + 4 * quad + r);
        const float sv = v ? s[qt][kt][r] : -1e30f;
        s[qt][kt][r] = sv;
        mx = fmaxf(mx, sv);
      }
    mx = fmaxf(mx, __shfl_xor(mx, 16));
    mx = fmaxf(mx, __shfl_xor(mx, 32));
    const float mn = fmaxf(m[qt], mx);
    const float alpha = fexp2((m[qt] - mn) * c2);
    m[qt] = mn;
    const float mc = fmaxf(mn, -1e20f) * c2;
    float ps = 0.f;
#pragma unroll
    for (int kt = 0; kt < 4; ++kt)
#pragma unroll
      for (int r = 0; r < 4; ++r) {
        const float pv = fexp2(__builtin_fmaf(s[qt][kt][r], c2, -mc));
        ps += pv;
        s[qt][kt][r] = pv;
      }
    l[qt] = l[qt] * alpha + ps;
#pragma unroll
    for (int dt = 0; dt < DH / 16; ++dt) o[qt][dt] *= alpha;
#pragma unroll
    for (int kk = 0; kk < 2; ++kk) {
      union { bf16x8 v; unsigned u[4]; } cv;
      cv.u[0] = pack2(s[qt][2 * kk][0], s[qt][2 * kk][1]);
      cv.u[1] = pack2(s[qt][2 * kk][2], s[qt][2 * kk][3]);
      cv.u[2] = pack2(s[qt][2 * kk + 1][0], s[qt][2 * kk + 1][1]);
      cv.u[3] = pack2(s[qt][2 * kk + 1][2], s[qt][2 * kk + 1][3]);
      pb[qt][kk] = cv.v;
    }
  }
}
template <int DH, int NQ, int LDV>
DEVI void attn_pv(const u16* sVt, const bf16x8 (&pb)[NQ][2], f32x4 (&o)[NQ][DH / 16], int lane) {
  const int col = lane & 15, quad = lane >> 4;
#pragma unroll
  for (int dt = 0; dt < DH / 16; ++dt) {
#pragma unroll
    for (int kk = 0; kk < 2; ++kk) {
      union { bf16x8 v; uint2 h[2]; } cv;
      cv.h[0] = *(const uint2*)(sVt + (16 * dt + col) * LDV + 32 * kk + 4 * quad);
      cv.h[1] = *(const uint2*)(sVt + (16 * dt + col) * LDV + 32 * kk + 16 + 4 * quad);
#pragma unroll
      for (int qt = 0; qt < NQ; ++qt) o[qt][dt] = mfma16(cv.v, pb[qt][kk], o[qt][dt]);
    }
  }
}
template <int DH, int NQ, int LDK, int LDV, class MaskF>
DEVI void attn_tile(const u16* sK, const u16* sVt, const bf16x8 (&qf)[NQ][DH / 32], f32x4 (&o)[NQ][DH / 16],
                    float (&m)[NQ], float (&l)[NQ], float c2, int lane, MaskF valid) {
  bf16x8 pb[NQ][2];
  attn_qk<DH, NQ, LDK>(sK, qf, o, m, l, c2, lane, valid, pb);
  attn_pv<DH, NQ, LDV>(sVt, pb, o, lane);
}

DEVI void phase_nsa(const Params& p, unsigned char* smem) {
  u16* sK = (u16*)smem;
  u16* sVt = (u16*)(smem + 18432);
  float* impH = (float*)(smem + 35840);
  float* impT = (float*)(smem + 52736);
  unsigned* selm = (unsigned*)(smem + 56960);
  const float c2 = 0.125f * 1.4426950408889634f;
#pragma unroll 1
  for (int tile = blockIdx.x; tile < 2048; tile += gridDim.x) {
    const int tid = launder(threadIdx.x), lane = tid & 63, w = tid >> 6, col = lane & 15, quad = lane >> 4;
    const int qtile = 63 - (tile >> 5), bg = tile & 31, b = bg >> 1, g = bg & 1, q0 = qtile * 32;
    const int h = g * 4 + w;
    __syncthreads();
    if (tid < 32) selm[tid] = 0u;
    {
      const u16* kcp = p.kc + (size_t)bg * 128 * 64;
      const u16* vcp = p.vcT + (size_t)bg * 64 * 128;
#pragma unroll
      for (int i = 0; i < 4; ++i) {
        const int c = tid + 256 * i;
        const int row = c >> 3, ch = (c & 7) << 3;
        *(uint4*)(sK + row * 72 + ch) = *(const uint4*)(kcp + row * 64 + ch);
        const int row2 = c >> 4, ch2 = (c & 15) << 3;
        *(uint4*)(sVt + row2 * 136 + ch2) = *(const uint4*)(vcp + row2 * 128 + ch2);
      }
    }
    bf16x8 qf[2][2];
    float gate[2][3];
    int tq[2];
#pragma unroll
    for (int qt = 0; qt < 2; ++qt) {
      const int t = q0 + 16 * qt + col;
      tq[qt] = t;
      const size_t tok = (size_t)b * T + t;
      const u16* qp = p.proj + tok * LDP + C_Q + h * 64 + 8 * quad;
      qf[qt][0] = *(const bf16x8*)qp;
      qf[qt][1] = *(const bf16x8*)(qp + 32);
#pragma unroll
      for (int br = 0; br < 3; ++br) gate[qt][br] = sigmoidf_(bf2f(p.proj[tok * LDP + C_GATE + h * 3 + br]));
    }
    __syncthreads();

    f32x4 comb[2][4];
    {
      const int srcl = (lane + 48) & 63;
#pragma unroll
      for (int qt = 0; qt < 2; ++qt) {
        f32x4 s[8];
#pragma unroll
        for (int kt = 0; kt < 8; ++kt) {
          s[kt] = f32x4{0.f, 0.f, 0.f, 0.f};
#pragma unroll
          for (int ks = 0; ks < 2; ++ks) {
            const bf16x8 kf = *(const bf16x8*)(sK + (16 * kt + col) * 72 + 32 * ks + 8 * quad);
            s[kt] = mfma16(kf, qf[qt][ks], s[kt]);
          }
        }
        const int t = tq[qt];
        float mx = -1e30f;
#pragma unroll
        for (int kt = 0; kt < 8; ++kt)
#pragma unroll
          for (int r = 0; r < 4; ++r) {
            const int c = 16 * kt + 4 * quad + r;
            const bool v = (16 * c + 31) <= t;
            const float sv = v ? s[kt][r] : -1e30f;
            s[kt][r] = sv;
            mx = fmaxf(mx, sv);
          }
        mx = fmaxf(mx, __shfl_xor(mx, 16));
        mx = fmaxf(mx, __shfl_xor(mx, 32));
        float ps = 0.f;
#pragma unroll
        for (int kt = 0; kt < 8; ++kt)
#pragma unroll
          for (int r = 0; r < 4; ++r) {
            const float sv = s[kt][r];
            const float pv = (sv > -1e29f) ? fexp2((sv - mx) * c2) : 0.f;
            ps += pv;
            s[kt][r] = pv;
          }
        ps += __shfl_xor(ps, 16);
        ps += __shfl_xor(ps, 32);
        const float inv = ps > 0.f ? 1.f / ps : 0.f;
#pragma unroll
        for (int kt = 0; kt < 8; ++kt)
#pragma unroll
          for (int r = 0; r < 4; ++r) s[kt][r] *= inv;
        float prev3 = 0.f;
#pragma unroll
        for (int kt = 0; kt < 8; ++kt) {
          const float sum4 = s[kt][0] + s[kt][1] + s[kt][2] + s[kt][3];
          const float xs = __shfl(s[kt][3], srcl);
          const float extra = quad ? xs : prev3;
          prev3 = xs;
          impH[(w * 32 + 16 * qt + col) * 33 + 4 * kt + quad] = sum4 + extra;
        }
        bf16x8 pb[4];
#pragma unroll
        for (int kk = 0; kk < 4; ++kk) {
          union { bf16x8 v; unsigned u[4]; } cv;
          cv.u[0] = pack2(s[2 * kk][0], s[2 * kk][1]);
          cv.u[1] = pack2(s[2 * kk][2], s[2 * kk][3]);
          cv.u[2] = pack2(s[2 * kk + 1][0], s[2 * kk + 1][1]);
          cv.u[3] = pack2(s[2 * kk + 1][2], s[2 * kk + 1][3]);
          pb[kk] = cv.v;
        }
#pragma unroll
        for (int dt = 0; dt < 4; ++dt) {
          f32x4 oc = f32x4{0.f, 0.f, 0.f, 0.f};
#pragma unroll
          for (int kk = 0; kk < 4; ++kk) {
            union { bf16x8 v; uint2 hh[2]; } cv;
            cv.hh[0] = *(const uint2*)(sVt + (16 * dt + col) * 136 + 32 * kk + 4 * quad);
            cv.hh[1] = *(const uint2*)(sVt + (16 * dt + col) * 136 + 32 * kk + 16 + 4 * quad);
            oc = mfma16(cv.v, pb[kk], oc);
          }
          comb[qt][dt] = oc * gate[qt][0];
        }
      }
    }
#pragma unroll
    for (int qt = 0; qt < 2; ++qt) {
      const size_t tok = (size_t)b * T + tq[qt];
      union { bf16x8 v; unsigned u[4]; } own, par, res;
      own.v = qf[qt][0];
#pragma unroll
      for (int j = 0; j < 4; ++j) par.u[j] = (unsigned)__shfl_xor((int)own.u[j], 16);
      const float4 c0 = *(const float4*)(p.rope + tok * 16), c1 = *(const float4*)(p.rope + tok * 16 + 4);
      const float4 s0 = *(const float4*)(p.rope + tok * 16 + 8), s1 = *(const float4*)(p.rope + tok * 16 + 12);
      const float cs[8] = {c0.x, c0.y, c0.z, c0.w, c1.x, c1.y, c1.z, c1.w};
      const float sn[8] = {s0.x, s0.y, s0.z, s0.w, s1.x, s1.y, s1.z, s1.w};
#pragma unroll
      for (int j = 0; j < 4; ++j) {
        const float o0 = __uint_as_float(own.u[j] << 16), o1 = __uint_as_float(own.u[j] & 0xffff0000u);
        const float p0 = __uint_as_float(par.u[j] << 16), p1 = __uint_as_float(par.u[j] & 0xffff0000u);
        const float sg = (quad == 0) ? -1.f : 1.f;
        const float r0 = o0 * cs[2 * j] + sg * p0 * sn[2 * j];
        const float r1 = o1 * cs[2 * j + 1] + sg * p1 * sn[2 * j + 1];
        res.u[j] = (quad < 2) ? pack2(r0, r1) : own.u[j];
      }
      qf[qt][0] = res.v;
    }
    __syncthreads();
#pragma unroll
    for (int i = 0; i < 4; ++i) {
      const int cell = tid + 256 * i;
      const int qi = cell >> 5, s_ = cell & 31;
      const int cur = (q0 + qi) >> 6;
      float v = impH[(0 * 32 + qi) * 33 + s_] + impH[(1 * 32 + qi) * 33 + s_] + impH[(2 * 32 + qi) * 33 + s_] +
                impH[(3 * 32 + qi) * 33 + s_];
      const int dist = cur - s_;
      const bool forced = (s_ == 0) || (dist >= 0 && dist < 2);
      v = forced ? 1e9f : (s_ <= cur ? v : -1.f);
      impT[qi * 33 + s_] = v;
    }
    __syncthreads();
    {
      const int qi = tid >> 3, sub = tid & 7;
      unsigned bits = 0u;
#pragma unroll
      for (int k = 0; k < 4; ++k) {
        const int s_ = sub * 4 + k;
        const float v = impT[qi * 33 + s_];
        int rank = 0;
        for (int s2 = 0; s2 < 32; ++s2) {
          const float v2 = impT[qi * 33 + s2];
          rank += ((v2 > v) || (v2 == v && s2 < s_)) ? 1 : 0;
        }
        if (rank < 16) bits |= 1u << s_;
      }
      atomicOr(&selm[qi], bits);
    }
    __syncthreads();
    unsigned sm[2] = {selm[col], selm[16 + col]};
    unsigned uni = 0u;
#pragma unroll
    for (int i = 0; i < 32; ++i) uni |= selm[i];
    const int kbmax = (q0 + 31) >> 6;
    {
      float m[2] = {-1e30f, -1e30f}, l[2] = {0.f, 0.f};
      f32x4 o[2][4];
#pragma unroll
      for (int qt = 0; qt < 2; ++qt)
#pragma unroll
        for (int dt = 0; dt < 4; ++dt) o[qt][dt] = f32x4{0.f, 0.f, 0.f, 0.f};
      unsigned rem = (kbmax >= 31) ? uni : (uni & ((1u << (kbmax + 1)) - 1u));
      int kb = rem ? (__ffs((int)rem) - 1) : -1;
      uint4 rk0, rk1, rv0, rv1;
      const int lr0 = tid >> 3, lch = (tid & 7) << 3;
#define LOADKV_(kbx, CK, VT)                                                                                         \
      rk0 = *(const uint4*)(p.proj + ((size_t)b * T + (kbx) * 64 + lr0) * LDP + (CK) + g * 64 + lch);                 \
      rk1 = *(const uint4*)(p.proj + ((size_t)b * T + (kbx) * 64 + lr0 + 32) * LDP + (CK) + g * 64 + lch);            \
      rv0 = *(const uint4*)((VT) + ((size_t)bg * 64 + lr0) * LDT + (kbx) * 64 + lch);                                 \
      rv1 = *(const uint4*)((VT) + ((size_t)bg * 64 + lr0 + 32) * LDT + (kbx) * 64 + lch);
#define STOREKV_()                                                                                                   \
      *(uint4*)(sK + lr0 * 72 + lch) = rk0; *(uint4*)(sK + (lr0 + 32) * 72 + lch) = rk1;                              \
      *(uint4*)(sVt + lr0 * 72 + lch) = rv0; *(uint4*)(sVt + (lr0 + 32) * 72 + lch) = rv1;
      if (kb >= 0) { LOADKV_(kb, C_KS, p.vts) }
#pragma unroll 1
      while (kb >= 0) {
        rem &= rem - 1u;
        const int nkb = rem ? (__ffs((int)rem) - 1) : -1;
        __syncthreads();
        STOREKV_()
        if (nkb >= 0) { LOADKV_(nkb, C_KS, p.vts) }
        __syncthreads();
        const int lim0 = ((sm[0] >> kb) & 1u) ? tq[0] : -1, lim1 = ((sm[1] >> kb) & 1u) ? tq[1] : -1;
        attn_tile<64, 2, 72, 72>(sK, sVt, qf, o, m, l, c2, lane, [&](int qt, int kl) {
          return (kb * 64 + kl) <= (qt ? lim1 : lim0);
        });
        kb = nkb;
      }
#pragma unroll
      for (int qt = 0; qt < 2; ++qt) {
        float lt = l[qt];
        lt += __shfl_xor(lt, 16);
        lt += __shfl_xor(lt, 32);
        const float sc = lt > 0.f ? gate[qt][1] / lt : 0.f;
#pragma unroll
        for (int dt = 0; dt < 4; ++dt) comb[qt][dt] += o[qt][dt] * sc;
      }
    }
    {
      float m[2] = {-1e30f, -1e30f}, l[2] = {0.f, 0.f};
      f32x4 o[2][4];
#pragma unroll
      for (int qt = 0; qt < 2; ++qt)
#pragma unroll
        for (int dt = 0; dt < 4; ++dt) o[qt][dt] = f32x4{0.f, 0.f, 0.f, 0.f};
      const int kblo = (q0 >= 511) ? ((q0 - 511) >> 6) : 0;
      uint4 rk0, rk1, rv0, rv1;
      const int lr0 = tid >> 3, lch = (tid & 7) << 3;
      int kb = kblo;
      LOADKV_(kb, C_KW, p.vtw)
#pragma unroll 1
      while (kb >= 0) {
        const int nkb = (kb < kbmax) ? kb + 1 : -1;
        __syncthreads();
        STOREKV_()
        if (nkb >= 0) { LOADKV_(nkb, C_KW, p.vtw) }
        __syncthreads();
        attn_tile<64, 2, 72, 72>(sK, sVt, qf, o, m, l, c2, lane, [&](int qt, int kl) {
          return (unsigned)(tq[qt] - (kb * 64 + kl)) < 512u;
        });
        kb = nkb;
      }
#undef LOADKV_
#undef STOREKV_
#pragma unroll
      for (int qt = 0; qt < 2; ++qt) {
        float lt = l[qt];
        lt += __shfl_xor(lt, 16);
        lt += __shfl_xor(lt, 32);
        const float sc = lt > 0.f ? gate[qt][2] / lt : 0.f;
#pragma unroll
        for (int dt = 0; dt < 4; ++dt) comb[qt][dt] += o[qt][dt] * sc;
      }
    }
#pragma unroll
    for (int qt = 0; qt < 2; ++qt) {
      const size_t tok = (size_t)b * T + tq[qt];
#pragma unroll
      for (int dt = 0; dt < 4; ++dt) {
        uint2 pk;
        pk.x = pack2(comb[qt][dt][0], comb[qt][dt][1]);
        pk.y = pack2(comb[qt][dt][2], comb[qt][dt][3]);
        *(uint2*)(p.mix + tok * LDA + 512 + h * 64 + 16 * dt + 4 * quad) = pk;
      }
    }
  }
}

template <bool RESB>
DEVI void phase_resid(const Params& p, unsigned char* smem, const u16* A, const u16* Wt, const float* res, float* ssq) {
  u16* sA = (u16*)smem; u16* sB = sA + 128 * 72;
  XCD_TILE_LOOP(idx, 256, 8) {
    GEMM_LANE_VARS
    const int mt = XCD_TILE_MT(idx, 8), nt_ = XCD_TILE_NT(idx, 8);
    const int m0 = mt * 128, n0 = nt_ * 128;
    f32x4 acc[4][4];
    gemm_mainloop<true>(tid, sA, sB, ARow{A, LDA}, Wt, LDA, m0, n0, 16, acc);
#pragma unroll
    for (int mi = 0; mi < 4; ++mi) {
      const int m = m0 + wm * 64 + 16 * mi + col;
      float ss = 0.f;
#pragma unroll
      for (int ni = 0; ni < 4; ++ni) {
        const int n = n0 + wn * 64 + 16 * ni + 4 * quad;
        const f32x4 v = acc[ni][mi];
        float4 r;
        if (RESB) {
          const uint2 rb = *(const uint2*)(p.hn + (size_t)m * LDA + n);
          r.x = __uint_as_float(rb.x << 16); r.y = __uint_as_float(rb.x & 0xffff0000u);
          r.z = __uint_as_float(rb.y << 16); r.w = __uint_as_float(rb.y & 0xffff0000u);
        } else {
          r = *(const float4*)(res + (size_t)m * D + n);
        }
        float4 hv;
        hv.x = r.x + v[0]; hv.y = r.y + v[1]; hv.z = r.z + v[2]; hv.w = r.w + v[3];
        ss += hv.x * hv.x + hv.y * hv.y + hv.z * hv.z + hv.w * hv.w;
        uint2 pk; pk.x = pack2(hv.x, hv.y); pk.y = pack2(hv.z, hv.w);
        *(uint2*)(p.hn + (size_t)m * LDA + n) = pk;
      }
      ss += __shfl_xor(ss, 16);
      ss += __shfl_xor(ss, 32);
      if (quad == 0) atomicAdd(ssq + m, ss);
    }
  }
}

DEVI void phase_scaled(const Params& p, unsigned char* smem, const u16* A, const u16* Wt, int ntn, const float* ssq, u16* outp, int ldo) {
  u16* sA = (u16*)smem; u16* sB = sA + 128 * 72;
  XCD_TILE_LOOP(idx, 256, ntn) {
    GEMM_LANE_VARS
    const int mt = XCD_TILE_MT(idx, ntn), nt_ = XCD_TILE_NT(idx, ntn);
    const int m0 = mt * 128, n0 = nt_ * 128;
    f32x4 acc[4][4];
    gemm_mainloop<true>(tid, sA, sB, ARow{A, LDA}, Wt, LDA, m0, n0, 16, acc);
#pragma unroll
    for (int mi = 0; mi < 4; ++mi) {
      const int m = m0 + wm * 64 + 16 * mi + col;
      const float rstd = rsqrtf(ssq[m] * (1.f / D) + 1e-6f);
#pragma unroll
      for (int ni = 0; ni < 4; ++ni) {
        const int n = n0 + wn * 64 + 16 * ni + 4 * quad;
        const f32x4 v = acc[ni][mi];
        uint2 pk; pk.x = pack2(v[0] * rstd, v[1] * rstd); pk.y = pack2(v[2] * rstd, v[3] * rstd);
        *(uint2*)(outp + (size_t)m * ldo + n) = pk;
      }
    }
  }
}

DEVI void phase_memattn(const Params& p, unsigned char* smem) {
  u16* sK = (u16*)smem;
  u16* sVt = (u16*)(smem + 33792);
  const float c2 = 0.0625f * 1.4426950408889634f;
#pragma unroll 1
  for (int tile = blockIdx.x; tile < 2048; tile += gridDim.x) {
    const int tid = launder(threadIdx.x), lane = tid & 63, w = tid >> 6, col = lane & 15, quad = lane >> 4;
    const int b = tile >> 7, head = (tile >> 5) & 3, q0 = (tile & 31) * 64;
    const size_t tok = (size_t)b * T + q0 + 16 * w + col;
    bf16x8 qf[1][8];
#pragma unroll
    for (int ks = 0; ks < 8; ++ks) qf[0][ks] = *(const bf16x8*)(p.qm + tok * LDA + head * 256 + 32 * ks + 8 * quad);
    float m[1] = {-1e30f}, l[1] = {0.f};
    f32x4 o[1][16];
#pragma unroll
    for (int dt = 0; dt < 16; ++dt) o[0][dt] = f32x4{0.f, 0.f, 0.f, 0.f};
    uint4 rg0, rg1, rg2, rg3, rg4, rg5, rg6, rg7;
    const int krow = tid >> 5, kch = (tid & 31) << 3;
    const int vrow = tid >> 3, vch = (tid & 7) << 3;
#define LK1_(i, kbx) rg##i = *(const uint4*)(p.memk + ((size_t)b * 256 + (kbx) * 64 + krow + 8 * i) * LDA + head * 256 + kch);
#define SK1_(i) *(uint4*)(sK + (krow + 8 * i) * 264 + kch) = rg##i;
#define LV1_(i, kbx) rg##i = *(const uint4*)(p.memvt + ((size_t)(b * 4 + head) * 256 + vrow + 32 * i) * 256 + (kbx) * 64 + vch);
#define SV1_(i) *(uint4*)(sVt + (vrow + 32 * i) * 72 + vch) = rg##i;
#define LOADK_(kbx) LK1_(0, kbx) LK1_(1, kbx) LK1_(2, kbx) LK1_(3, kbx) LK1_(4, kbx) LK1_(5, kbx) LK1_(6, kbx) LK1_(7, kbx)
#define STOREK_() SK1_(0) SK1_(1) SK1_(2) SK1_(3) SK1_(4) SK1_(5) SK1_(6) SK1_(7)
#define LOADV_(kbx) LV1_(0, kbx) LV1_(1, kbx) LV1_(2, kbx) LV1_(3, kbx) LV1_(4, kbx) LV1_(5, kbx) LV1_(6, kbx) LV1_(7, kbx)
#define STOREV_() SV1_(0) SV1_(1) SV1_(2) SV1_(3) SV1_(4) SV1_(5) SV1_(6) SV1_(7)
    __syncthreads();
    LOADK_(0)
    STOREK_()
    LOADV_(0)
    __syncthreads();
#pragma unroll 1
    for (int kb = 0; kb < 4; ++kb) {
      bf16x8 pb[1][2];
      attn_qk<256, 1, 264>(sK, qf, o, m, l, c2, lane, [&](int, int) { return true; }, pb);
      STOREV_()
      if (kb < 3) { LOADK_(kb + 1) }
      __syncthreads();
      attn_pv<256, 1, 72>(sVt, pb, o, lane);
      if (kb < 3) {
        STOREK_()
        LOADV_(kb + 1)
      }
      __syncthreads();
    }
#undef LOADK_
#undef STOREK_
#undef LOADV_
#undef STOREV_
#undef LK1_
#undef SK1_
#undef LV1_
#undef SV1_
    float lt = l[0];
    lt += __shfl_xor(lt, 16);
    lt += __shfl_xor(lt, 32);
    const float inv = 1.f / lt;
#pragma unroll
    for (int dt = 0; dt < 16; ++dt) {
      uint2 pk;
      pk.x = pack2(o[0][dt][0] * inv, o[0][dt][1] * inv);
      pk.y = pack2(o[0][dt][2] * inv, o[0][dt][3] * inv);
      *(uint2*)(p.mix + tok * LDA + head * 256 + 16 * dt + 4 * quad) = pk;
    }
  }
}

__constant__ unsigned char kCandI[64] = {0,0,0,0,0,0,0,0,0,0,0,0,0,0,0,0, 1,1,1,1,1,1,1,1, 2,2,2,2,2, 3,3,3,3, 4,4,4, 5,5, 6,6, 7,7,
                                          8, 9, 10, 11, 12, 13, 14, 15, 0,0,0,0,0,0,0,0,0,0,0,0,0,0};
__constant__ unsigned char kCandJ[64] = {0,1,2,3,4,5,6,7,8,9,10,11,12,13,14,15, 0,1,2,3,4,5,6,7, 0,1,2,3,4, 0,1,2,3, 0,1,2, 0,1, 0,1, 0,1,
                                          0, 0, 0, 0, 0, 0, 0, 0, 0,0,0,0,0,0,0,0,0,0,0,0,0,0};

DEVI unsigned score_key(float v, int idx) {
  unsigned u = __float_as_uint(v);
  u = (u & 0x80000000u) ? ~u : (u | 0x80000000u);
  return (u & ~127u) | (unsigned)(127 - idx);
}
DEVI float key_score(unsigned k) {
  k &= ~127u;
  const unsigned u = (k & 0x80000000u) ? (k & 0x7fffffffu) : ~k;
  return __uint_as_float(u);
}

DEVI void phase_peer_route(const Params& p, unsigned char* smem) {
  u16* sA = (u16*)smem; u16* sB = sA + 128 * 72;
  unsigned* sScore = (unsigned*)smem;
  unsigned* sTop = (unsigned*)(smem + 36864);
  unsigned* sTmp = (unsigned*)(smem + 53248);
  {
    const int t0_ = launder(threadIdx.x);
    const int gw = (blockIdx.x * 256 + t0_) >> 6, nw = (gridDim.x * 256) >> 6;
    conv_fp8_rows(p.peer_u, p.ub8, p.uscale, 16384, gw, nw, t0_ & 63);
    conv_fp8_rows(p.peer_v, p.vb8, p.vscale, 16384, gw, nw, t0_ & 63);
  }
#pragma unroll 1
  for (int tile = blockIdx.x; tile < 256 * 8; tile += gridDim.x) {
    GEMM_LANE_VARS
    const int mt = tile >> 3, hd = tile & 7;
    const int m0 = mt * 128;
#pragma unroll 1
    for (int ph = 0; ph < 2; ++ph) {
      const int hp = hd * 2 + ph;
      f32x4 acc[4][4];
      __syncthreads();
      gemm_mainloop<false>(tid, sA, sB, ARow{p.pq + hp * 128, LDPQ}, p.subk + (size_t)hp * 128 * 128, 128, m0, 0, 2, acc);
#pragma unroll 1
      for (int hh = 0; hh < 2; ++hh) {
        if (wm == hh) {
#pragma unroll
          for (int mi = 0; mi < 4; ++mi) {
            const int row = 16 * mi + col;
#pragma unroll
            for (int ni = 0; ni < 4; ++ni) {
              const int n = wn * 64 + 16 * ni + 4 * quad;
              const f32x4 v = acc[ni][mi];
              uint4 kk;
              kk.x = score_key(v[0], n); kk.y = score_key(v[1], n + 1);
              kk.z = score_key(v[2], n + 2); kk.w = score_key(v[3], n + 3);
              *(uint4*)(sScore + row * 128 + n) = kk;
            }
          }
        }
        __syncthreads();
#pragma unroll 1
        for (int rg = 0; rg < 4; ++rg) {
          const int rbase = w * 16 + rg * 4;
          unsigned k0[4], k1[4], t0[4], t1[4], thr[4];
#pragma unroll
          for (int r = 0; r < 4; ++r) {
            k0[r] = sScore[(rbase + r) * 128 + lane];
            k1[r] = sScore[(rbase + r) * 128 + 64 + lane];
            t0[r] = ((k0[r] >> 16) << 7) | (k0[r] & 127u);
            t1[r] = ((k1[r] >> 16) << 7) | (k1[r] & 127u);
            thr[r] = 0u;
          }
#pragma unroll
          for (int bit = 22; bit >= 0; --bit) {
#pragma unroll
            for (int r = 0; r < 4; ++r) {
              const unsigned cand = thr[r] | (1u << bit);
              const int cnt = __popcll(__ballot(t0[r] >= cand)) + __popcll(__ballot(t1[r] >= cand));
              thr[r] = (cnt >= 16) ? cand : thr[r];
            }
          }
          unsigned* tmp = sTmp + w * 64;
#pragma unroll
          for (int r = 0; r < 4; ++r) {
            const unsigned long long b0 = __ballot(t0[r] >= thr[r]), b1 = __ballot(t1[r] >= thr[r]);
            const int pos0 = __builtin_amdgcn_mbcnt_hi((unsigned)(b0 >> 32), __builtin_amdgcn_mbcnt_lo((unsigned)b0, 0u));
            const int pos1 = __popcll(b0) + __builtin_amdgcn_mbcnt_hi((unsigned)(b1 >> 32), __builtin_amdgcn_mbcnt_lo((unsigned)b1, 0u));
            if (t0[r] >= thr[r]) tmp[r * 16 + pos0] = k0[r];
            if (t1[r] >= thr[r]) tmp[r * 16 + pos1] = k1[r];
          }
          __builtin_amdgcn_fence(__ATOMIC_RELEASE, "wavefront");
          __builtin_amdgcn_wave_barrier();
          __builtin_amdgcn_fence(__ATOMIC_ACQUIRE, "wavefront");
          {
            const int r = lane >> 4, ix = lane & 15;
            const unsigned mine = tmp[r * 16 + ix];
            const uint4 a = *(const uint4*)(tmp + r * 16), b = *(const uint4*)(tmp + r * 16 + 4), c = *(const uint4*)(tmp + r * 16 + 8),
                        d = *(const uint4*)(tmp + r * 16 + 12);
            const int rk = (a.x > mine) + (a.y > mine) + (a.z > mine) + (a.w > mine) + (b.x > mine) + (b.y > mine) + (b.z > mine) + (b.w > mine) +
                           (c.x > mine) + (c.y > mine) + (c.z > mine) + (c.w > mine) + (d.x > mine) + (d.y > mine) + (d.z > mine) + (d.w > mine);
            sTop[((hh * 64 + rbase + r) * 2 + ph) * 16 + rk] = mine;
          }
          __builtin_amdgcn_fence(__ATOMIC_RELEASE, "wavefront");
          __builtin_amdgcn_wave_barrier();
        }
        __syncthreads();
      }
    }
    const int ci = kCandI[lane], cj = kCandJ[lane];
    const bool act = lane < 50;
#pragma unroll 1
    for (int tg = 0; tg < 8; ++tg) {
      const int tb = w * 32 + tg * 4;
      unsigned k0[4], k1[4], ku[4], thr[4];
      float v[4];
#pragma unroll
      for (int r = 0; r < 4; ++r) {
        k0[r] = sTop[((tb + r) * 2 + 0) * 16 + ci];
        k1[r] = sTop[((tb + r) * 2 + 1) * 16 + cj];
        v[r] = key_score(k0[r]) + key_score(k1[r]);
        unsigned u = __float_as_uint(v[r]);
        u = (u & 0x80000000u) ? ~u : (u | 0x80000000u);
        ku[r] = act ? (((u >> 16) << 6) | (unsigned)(63 - lane)) : 0u;
        thr[r] = 0u;
      }
#pragma unroll
      for (int bit = 21; bit >= 0; --bit) {
#pragma unroll
        for (int r = 0; r < 4; ++r) {
          const unsigned cand = thr[r] | (1u << bit);
          const int cnt = __popcll(__ballot(ku[r] >= cand));
          thr[r] = (cnt >= 16) ? cand : thr[r];
        }
      }
#pragma unroll
      for (int r = 0; r < 4; ++r) {
        const bool sel = act && (ku[r] >= thr[r]);
        const unsigned long long ms = __ballot(sel);
        const int slot = __builtin_amdgcn_mbcnt_hi((unsigned)(ms >> 32), __builtin_amdgcn_mbcnt_lo((unsigned)ms, 0u));
        const float vmax = __int_as_float(__builtin_amdgcn_readlane(__float_as_int(v[r]), 0));
        const float e = sel ? __expf(v[r] - vmax) : 0.f;
        const float tot = wave_sum(e);
        if (sel) {
          const int eid = (127 - (int)(k0[r] & 127u)) * 128 + (127 - (int)(k1[r] & 127u));
          const size_t o = (size_t)(m0 + tb + r) * 128 + hd * 16 + slot;
          p.experts[o] = eid;
          p.gates[o] = e / tot;
        }
      }
    }
  }
}

template <int PART>
DEVI void phase_peer_gather(const Params& p) {
  const int w0_ = threadIdx.x >> 6;
#pragma unroll 1
  for (int tok = blockIdx.x * 4 + w0_; tok < NTOK; tok += gridDim.x * 4) {
    const int tid = launder(threadIdx.x), lane = tid & 63;
    const uint4* hp4 = (const uint4*)(p.hn + (size_t)tok * LDA + lane * 16);
    float hv[16], xn[16], y[16];
    {
      const uint4 a0 = hp4[0], a1 = hp4[1];
      const unsigned hu[8] = {a0.x, a0.y, a0.z, a0.w, a1.x, a1.y, a1.z, a1.w};
#pragma unroll
      for (int i = 0; i < 8; ++i) { hv[2 * i] = __uint_as_float(hu[i] << 16); hv[2 * i + 1] = __uint_as_float(hu[i] & 0xffff0000u); }
    }
    float ss = 0.f;
#pragma unroll
    for (int i = 0; i < 16; ++i) ss += hv[i] * hv[i];
    ss = wave_sum(ss);
    const float rstd = rsqrtf(ss * (1.f / D) + 1e-6f);
    {
      const float4* g4 = (const float4*)p.peer_g + lane * 4;
      const float4 a0 = g4[0], a1 = g4[1], a2 = g4[2], a3 = g4[3];
      const float gg[16] = {a0.x, a0.y, a0.z, a0.w, a1.x, a1.y, a1.z, a1.w, a2.x, a2.y, a2.z, a2.w, a3.x, a3.y, a3.z, a3.w};
#pragma unroll
      for (int i = 0; i < 16; ++i) { xn[i] = hv[i] * rstd * gg[i]; y[i] = 0.f; }
    }
    const int e0 = p.experts[(size_t)tok * 128 + lane], e1 = p.experts[(size_t)tok * 128 + 64 + lane];
    const float g0 = p.gates[(size_t)tok * 128 + lane], g1 = p.gates[(size_t)tok * 128 + 64 + lane];
    const float su0 = p.uscale[e0], su1 = p.uscale[e1];
    const float sv0 = p.vscale[e0], sv1 = p.vscale[e1];
    float cf0 = 0.f, cf1 = 0.f, dsum = 0.f;
    uint4 ca[8], cb[8];
#define LOADB_(R, bi)                                                                                   \
    _Pragma("unroll") for (int u = 0; u < 8; ++u) {                                                       \
      const int kk_ = (((bi) & 7) << 3) + u;                                                             \
      const int e_ = __builtin_amdgcn_readlane((((bi) >> 3) & 1) ? e1 : e0, kk_);                        \
      R[u] = ((const uint4*)((((bi) >> 4) ? p.vb8 : p.ub8) + (size_t)e_ * 1024))[lane];                  \
    }
#define COMPU_(R, bi)                                                                                   \
    {                                                                                                    \
      float d8[8];                                                                                       \
      _Pragma("unroll") for (int u = 0; u < 8; ++u) {                                                     \
        const unsigned uu[4] = {R[u].x, R[u].y, R[u].z, R[u].w};                                         \
        f32x2 a2 = {0.f, 0.f};                                                                           \
        _Pragma("unroll") for (int j = 0; j < 4; ++j) {                                                   \
          const f32x2 lo = __builtin_amdgcn_cvt_pk_f32_fp8((int)uu[j], false);                           \
          const f32x2 hi = __builtin_amdgcn_cvt_pk_f32_fp8((int)uu[j], true);                            \
          a2 = xn2[2 * j] * lo + a2;                                                                     \
          a2 = xn2[2 * j + 1] * hi + a2;                                                                 \
        }                                                                                                \
        d8[u] = a2[0] + a2[1];                                                                           \
      }                                                                                                  \
          \
      float v4[4], v2[2];                                                                                \
      _Pragma("unroll") for (int i = 0; i < 4; ++i) {                                                     \
        const float snd = b5 ? d8[i] : d8[4 + i], kp = b5 ? d8[4 + i] : d8[i];                           \
        v4[i] = kp + __shfl_xor(snd, 32);                                                                \
      }                                                                                                  \
      _Pragma("unroll") for (int i = 0; i < 2; ++i) {                                                     \
        const float snd = b4 ? v4[i] : v4[2 + i], kp = b4 ? v4[2 + i] : v4[i];                           \
        v2[i] = kp + __shfl_xor(snd, 16);                                                                \
      }                                                                                                  \
      float v1;                                                                                          \
      { const float snd = b3 ? v2[0] : v2[1], kp = b3 ? v2[1] : v2[0]; v1 = kp + __shfl_xor(snd, 8); }   \
      v1 += __shfl_xor(v1, 4);                                                                           \
      v1 += __shfl_xor(v1, 2);                                                                           \
      v1 += __shfl_xor(v1, 1);                                                                           \
                \
      const float got = __shfl(v1, fsrc);                                                                \
      if ((lane >> 3) == ((bi) & 7)) dsum = got;                                                         \
    }                                                                                                    \
    if (((bi) & 7) == 7) {                                                                               \
      if (((bi) >> 3) & 1) cf1 = gelu_tanh(dsum * su1) * g1 * sv1; else cf0 = gelu_tanh(dsum * su0) * g0 * sv0; \
    }
#define COMPV_(R, bi)                                                                                   \
    _Pragma("unroll") for (int u = 0; u < 8; ++u) {                                                       \
      const int kk_ = (((bi) & 7) << 3) + u;                                                             \
      const float ck_ = __int_as_float(__builtin_amdgcn_readlane(__float_as_int((((bi) >> 3) & 1) ? cf1 : cf0), kk_)); \
      const f32x2 ck2 = {ck_, ck_};                                                                      \
      const unsigned uu[4] = {R[u].x, R[u].y, R[u].z, R[u].w};                                           \
      _Pragma("unroll") for (int j = 0; j < 4; ++j) {                                                     \
        const f32x2 lo = __builtin_amdgcn_cvt_pk_f32_fp8((int)uu[j], false);                             \
        const f32x2 hi = __builtin_amdgcn_cvt_pk_f32_fp8((int)uu[j], true);                              \
        y2[2 * j] = ck2 * lo + y2[2 * j];                                                                \
        y2[2 * j + 1] = ck2 * hi + y2[2 * j + 1];                                                        \
      }                                                                                                  \
    }
    const bool b5 = (lane & 32) != 0, b4 = (lane & 16) != 0, b3 = (lane & 8) != 0;
    const int fsrc = ((lane & 4) << 3) | ((lane & 2) << 3) | ((lane & 1) << 3);
    f32x2 xn2[8], y2[8];
#pragma unroll
    for (int i = 0; i < 8; ++i) { xn2[i] = f32x2{xn[2 * i], xn[2 * i + 1]}; y2[i] = f32x2{0.f, 0.f}; }
    if (PART == 0) {
      LOADB_(ca, 0)
#pragma unroll 1
      for (int bi = 0; bi < 16; bi += 2) {
        LOADB_(cb, bi + 1)
        COMPU_(ca, bi)
        if (bi + 2 < 16) { LOADB_(ca, bi + 2) }
        COMPU_(cb, bi + 1)
      }
      p.gates[(size_t)tok * 128 + lane] = cf0;
      p.gates[(size_t)tok * 128 + 64 + lane] = cf1;
      continue;
    }
    cf0 = g0; cf1 = g1;
    LOADB_(ca, 16)
#pragma unroll 1
    for (int bi = 16; bi < 32; bi += 2) {
      LOADB_(cb, bi + 1)
      COMPV_(ca, bi)
      if (bi + 2 < 32) { LOADB_(ca, bi + 2) }
      COMPV_(cb, bi + 1)
    }
#undef LOADB_
#undef COMPU_
#undef COMPV_
#pragma unroll
    for (int i = 0; i < 8; ++i) { y[2 * i] = y2[i][0]; y[2 * i + 1] = y2[i][1]; }
    float s2 = 0.f;
    {
      const uint4 a0 = hp4[0], a1 = hp4[1];
      const unsigned hu[8] = {a0.x, a0.y, a0.z, a0.w, a1.x, a1.y, a1.z, a1.w};
#pragma unroll
      for (int i = 0; i < 8; ++i) {
        y[2 * i] += __uint_as_float(hu[i] << 16);
        y[2 * i + 1] += __uint_as_float(hu[i] & 0xffff0000u);
        s2 += y[2 * i] * y[2 * i] + y[2 * i + 1] * y[2 * i + 1];
      }
    }
    s2 = wave_sum(s2);
    const float rs2 = rsqrtf(s2 * (1.f / D) + 1e-6f);
    {
      const float4* g4 = (const float4*)p.final_g + lane * 4;
      const float4 a0 = g4[0], a1 = g4[1], a2 = g4[2], a3 = g4[3];
      float4* o4 = (float4*)(p.out + (size_t)tok * D) + lane * 4;
      o4[0] = make_float4(y[0] * rs2 * a0.x, y[1] * rs2 * a0.y, y[2] * rs2 * a0.z, y[3] * rs2 * a0.w);
      o4[1] = make_float4(y[4] * rs2 * a1.x, y[5] * rs2 * a1.y, y[6] * rs2 * a1.z, y[7] * rs2 * a1.w);
      o4[2] = make_float4(y[8] * rs2 * a2.x, y[9] * rs2 * a2.y, y[10] * rs2 * a2.z, y[11] * rs2 * a2.w);
      o4[3] = make_float4(y[12] * rs2 * a3.x, y[13] * rs2 * a3.y, y[14] * rs2 * a3.z, y[15] * rs2 * a3.w);
    }
  }
}

#define XB_TMO      128
#define XB_XCNT(j)  (256  + 64 * (j))
#define XB_XSUB(j)  (1280 + 64 * (j))
#define XB_XGEN(j)  (2304 + 64 * (j))
#define XB_TOP      3328
#define XB_TOPGEN   3392
#define XCD_BAR_WORDS 3456
#define XB_SPIN_CAP (1u << 20)
#define LAS __attribute__((address_space(3)))
DEVI unsigned xb_ld(unsigned* q) { return __hip_atomic_load(q, __ATOMIC_RELAXED, __HIP_MEMORY_SCOPE_AGENT); }
DEVI unsigned xb_add(unsigned* q, unsigned v) { return __hip_atomic_fetch_add(q, v, __ATOMIC_RELAXED, __HIP_MEMORY_SCOPE_AGENT); }
DEVI unsigned xb_xcc_id() { return (unsigned)__builtin_amdgcn_s_getreg((3 << 11) | 20) & 0xFu; }
#define XB_SPIN(cond, bar) do { unsigned _sp = 0; while (cond) { __builtin_amdgcn_s_sleep(1); \
    if ((++_sp & 255u) == 0u) { if (xb_ld(&(bar)[XB_TMO])) break; if (_sp > XB_SPIN_CAP) { atomicAdd(&(bar)[XB_TMO], 1u); break; } } } } while (0)
struct XcdBarrier { unsigned* bar; unsigned x; volatile LAS unsigned* st; };
DEVI XcdBarrier xcd_barrier_post(unsigned* bar, volatile LAS unsigned* st) {
  XcdBarrier b; b.bar = bar; b.x = xb_xcc_id(); b.st = st;
  if (threadIdx.x == 0) (void)xb_add(&bar[XB_XCNT(b.x)], 1u);
  return b;
}
DEVI void xcd_barrier_complete(unsigned* bar, unsigned x, unsigned& nloc, unsigned& nx) {
  const unsigned G = gridDim.x * gridDim.y * gridDim.z;
  unsigned sum, cnt, mine, sp = 0u;
  for (;;) {
    sum = 0u; cnt = 0u; mine = 0u;
#pragma unroll
    for (unsigned j = 0; j < 16; ++j) { const unsigned c = xb_ld(&bar[XB_XCNT(j)]); sum += c; cnt += (c > 0u) ? 1u : 0u; mine = (j == x) ? c : mine; }
    if (sum == G) break;
    __builtin_amdgcn_s_sleep(1);
    if ((++sp & 255u) == 0u) { if (xb_ld(&bar[XB_TMO])) break; if (sp > XB_SPIN_CAP) { atomicAdd(&bar[XB_TMO], 1u); break; } }
  }
  nloc = mine > 0u ? mine : 1u; nx = cnt > 0u ? cnt : 1u;
}
DEVI void xcd_barrier(const XcdBarrier& b) {
  asm volatile("s_waitcnt vmcnt(0)" ::: "memory");
  __syncthreads();
  if (threadIdx.x == 0) {
    unsigned* bar = b.bar;
    __builtin_amdgcn_s_waitcnt(0);
    unsigned nloc = b.st[0], nx = b.st[1];
    if (nloc == 0u) { xcd_barrier_complete(bar, b.x, nloc, nx); b.st[0] = nloc; b.st[1] = nx; }
    const unsigned old = xb_add(&bar[XB_XSUB(b.x)], 1u);
    const unsigned gen = old / nloc;
    if (old + 1u == (gen + 1u) * nloc) {
      __builtin_amdgcn_fence(__ATOMIC_RELEASE, "agent");
      asm volatile("s_waitcnt vmcnt(0)" ::: "memory");
      const unsigned og = xb_add(&bar[XB_TOP], 1u);
      const unsigned tg = og / nx;
      if (og + 1u == (tg + 1u) * nx) xb_add(&bar[XB_TOPGEN], 1u);
      else XB_SPIN(xb_ld(&bar[XB_TOPGEN]) == tg, bar);
      __builtin_amdgcn_fence(__ATOMIC_ACQUIRE, "agent");
      xb_add(&bar[XB_XGEN(b.x)], 1u);
      asm volatile("s_waitcnt vmcnt(0)" ::: "memory");
    } else {
      XB_SPIN(xb_ld(&bar[XB_XGEN(b.x)]) == gen, bar);
      __builtin_amdgcn_fence(__ATOMIC_ACQUIRE, "agent");
      asm volatile("s_waitcnt vmcnt(0)" ::: "memory");
    }
  }
  __syncthreads();
}

template <bool COOP>
__global__ void __launch_bounds__(256, 2) mega(Params p, int ph_lo, int ph_hi) {
  __shared__ __attribute__((aligned(16))) unsigned char smem[SMEM_BYTES];
  __shared__ uint4 xb_words;
  if (threadIdx.x == 0) xb_words = make_uint4(0u, 0u, 0u, 0u);
  __syncthreads();
  XcdBarrier xb = xcd_barrier_post(p.bar, (volatile LAS unsigned*)&xb_words);
  (void)xb;
  if (COOP && ph_hi > 1000) cg::this_grid().sync();
#ifdef REPEAT_MASK
#define RUN_PHASE(i, call)                                                                   \
  if (ph_lo <= (i) && (i) <= ph_hi) {                                                        \
    call;                                                                                    \
    if (COOP && ((REPEAT_MASK >> (i)) & 1)) { xcd_barrier(xb); call; }                       \
    if (COOP && (i) < ph_hi) xcd_barrier(xb);                                                \
  }
#else
#define RUN_PHASE(i, call)                                                                   \
  if (ph_lo <= (i) && (i) <= ph_hi) {                                                        \
    call;                                                                                    \
    if (COOP && (i) < ph_hi) {                                                               \
      xcd_barrier(xb);                                                                       \
    }                                                                                        \
  }
#endif
  RUN_PHASE(0, phase0(p))
  RUN_PHASE(1, phase1(p, smem))
  RUN_PHASE(2, phase2(p, smem))
  RUN_PHASE(4, phase_nsa(p, smem))
  RUN_PHASE(5, phase_resid<false>(p, smem, p.mix, p.woutT, p.x, p.ssq1))
  RUN_PHASE(6, phase_scaled(p, smem, p.hn, p.wmqT, 8, p.ssq1, p.qm, LDA))
  RUN_PHASE(7, phase_memattn(p, smem))
  RUN_PHASE(8, phase_resid<true>(p, smem, p.mix, p.wmoT, nullptr, p.ssq2))
  RUN_PHASE(9, phase_scaled(p, smem, p.hn, p.wpqT, 16, p.ssq2, p.pq, LDPQ))
  RUN_PHASE(10, phase_peer_route(p, smem))
  RUN_PHASE(11, phase_peer_gather<0>(p))
  RUN_PHASE(12, phase_peer_gather<1>(p))
#undef RUN_PHASE
}

extern "C" void kernel_launch(void* const* d_in, const int* in_sizes, int n_in, void* d_out, int out_size, void* d_ws,
                              size_t ws_size, hipStream_t stream) {
  (void)in_sizes; (void)n_in; (void)out_size; (void)ws_size;
  Params p{};
  p.x = (const float*)d_in[0]; p.mem = (const float*)d_in[1]; p.pos = (const int*)d_in[2];
  p.mix_g = (const float*)d_in[3]; p.w_in = (const float*)d_in[4]; p.conv_w = (const float*)d_in[5];
  p.conv_b = (const float*)d_in[6]; p.ln_g = (const float*)d_in[7]; p.ln_b = (const float*)d_in[8];
  p.cmp_pos = (const float*)d_in[9]; p.cmp_w1 = (const float*)d_in[10]; p.cmp_b1 = (const float*)d_in[11];
  p.cmp_w2 = (const float*)d_in[12]; p.cmp_b2 = (const float*)d_in[13]; p.w_out = (const float*)d_in[14];
  p.memq_g = (const float*)d_in[15]; p.memkv_g = (const float*)d_in[16]; p.w_mq = (const float*)d_in[17];
  p.w_mk = (const float*)d_in[18]; p.w_mv = (const float*)d_in[19]; p.w_mo = (const float*)d_in[20];
  p.peer_g = (const float*)d_in[21]; p.peer_wq = (const float*)d_in[22]; p.peer_sk = (const float*)d_in[23];
  p.peer_u = (const float*)d_in[24]; p.peer_v = (const float*)d_in[25]; p.final_g = (const float*)d_in[26];
  p.out = (float*)d_out;
  unsigned char* ws = (unsigned char*)d_ws;
  size_t off = 0;
  auto take = [&](size_t bytes) { unsigned char* r = ws + off; off += (bytes + 255) & ~(size_t)255; return r; };
  unsigned char* regA = take((size_t)NTOK * LDA * 2);
  unsigned char* regB = take((size_t)NTOK * LDP * 2);
  unsigned char* regC = take((size_t)NTOK * LDA * 2);
  p.hn = (u16*)regA;
  p.proj = (u16*)regB; p.qm = (u16*)regB; p.pq = (u16*)regB;
  p.mix = (u16*)regC; p.experts = (int*)regC; p.gates = (float*)(regC + (size_t)NTOK * 128 * 4);
  {
    unsigned char* tb = regC + (size_t)2 * NTOK * 128 * 4;
    p.ub8 = tb; p.vb8 = tb + (size_t)16384 * 1024;
    p.uscale = (float*)(tb + (size_t)2 * 16384 * 1024); p.vscale = p.uscale + 16384;
  }
  p.h = nullptr;
  p.vts = (u16*)take((size_t)Bn * 2 * 64 * LDT * 2);
  p.vtw = (u16*)take((size_t)Bn * 2 * 64 * LDT * 2);
  p.memn = (u16*)take((size_t)Bn * 256 * LDA * 2);
  p.memk = (u16*)take((size_t)Bn * 256 * LDA * 2);
  p.memvt = (u16*)take((size_t)Bn * 256 * D * 2);
  p.winT = (u16*)take((size_t)2432 * LDA * 2);
  p.woutT = (u16*)take((size_t)1024 * LDA * 2);
  p.wmqT = (u16*)take((size_t)1024 * LDA * 2);
  p.wmkT = (u16*)take((size_t)1024 * LDA * 2);
  p.wmvT = (u16*)take((size_t)1024 * LDA * 2);
  p.wmoT = (u16*)take((size_t)1024 * LDA * 2);
  p.wpqT = (u16*)take((size_t)2048 * LDA * 2);
  p.subk = (u16*)take((size_t)16 * 128 * 128 * 2);
  p.w1T = (u16*)take((size_t)2 * 128 * LDW1 * 2);
  p.w2T = (u16*)take((size_t)2 * 128 * 128 * 2);
  p.biasp = (float*)take(256 * 4);
  p.rope = (float*)take((size_t)NTOK * 16 * 4);
  p.hdn = (u16*)take((size_t)2 * 4096 * 128 * 2);
  p.kc = (u16*)take((size_t)Bn * 2 * 128 * 64 * 2);
  p.vcT = (u16*)take((size_t)Bn * 2 * 64 * 128 * 2);
  p.ssq1 = (float*)take((size_t)NTOK * 4);
  p.ssq2 = (float*)take((size_t)NTOK * 4);
  p.bar = (unsigned*)take(16384);
  if (off > ws_size) { fprintf(stderr, "workspace too small: need %zu have %zu\n", off, ws_size); return; }

#if COOP_MODE
  static int grid_blocks = 0;
  if (!grid_blocks) {
    int dev = 0, cus = 0, per_cu = 0;
    hipGetDevice(&dev);
    hipDeviceGetAttribute(&cus, hipDeviceAttributeMultiprocessorCount, dev);
    hipOccupancyMaxActiveBlocksPerMultiprocessor(&per_cu, mega<true>, 256, 0);
    if (per_cu > 2) per_cu = 2;
    if (per_cu < 1) per_cu = 1;
    grid_blocks = cus * per_cu;
  }
  int lo = 0, hi = NPHASE;
  void* args[] = {&p, &lo, &hi};
  (void)hipMemsetAsync(p.bar, 0, 16384, stream);
  hipError_t e = hipLaunchCooperativeKernel((void*)mega<true>, dim3(grid_blocks), dim3(256), args, 0, stream);
  if (e != hipSuccess) fprintf(stderr, "cooperative launch failed: %s (grid %d)\n", hipGetErrorString(e), grid_blocks);
#else
  for (int ph = 0; ph <= NPHASE; ++ph) mega<false><<<dim3(512), dim3(256), 0, stream>>>(p, ph, ph);
#endif
}
```

```cpp
#include <hip/hip_runtime.h>
#include <hip/hip_bf16.h>
#include <hip/hip_cooperative_groups.h>
#include <cstdio>
#include <cstdint>
namespace cg = cooperative_groups;

#ifndef COOP_MODE
#define COOP_MODE 1
#endif

typedef __attribute__((ext_vector_type(8))) short bf16x8;
typedef __attribute__((ext_vector_type(4))) short bf16x4;
typedef __attribute__((ext_vector_type(4))) float f32x4;
typedef unsigned short u16;

#define DEVI __device__ __forceinline__

constexpr int Bn = 16, T = 2048, D = 1024, NTOK = Bn * T, LDP = 2336;
constexpr int C_Q = 1024, C_KC = 1536, C_VC = 1664, C_KS = 1792, C_VS = 1920, C_KW = 2048, C_VW = 2176, C_GATE = 2304;
constexpr int SMEM_BYTES = 73728;
constexpr int LDA = 1088;
constexpr int LDHF = 1056;
constexpr int LDPQ = 2112;
constexpr int LDW1 = 2112;
constexpr int LDT = 2112;
constexpr int NPHASE = 12;

struct Params {
  const float* x; const float* mem; const int* pos; const float* mix_g; const float* w_in;
  const float* conv_w; const float* conv_b; const float* ln_g; const float* ln_b;
  const float* cmp_pos; const float* cmp_w1; const float* cmp_b1; const float* cmp_w2; const float* cmp_b2;
  const float* w_out; const float* memq_g; const float* memkv_g; const float* w_mq; const float* w_mk;
  const float* w_mv; const float* w_mo; const float* peer_g; const float* peer_wq; const float* peer_sk;
  const float* peer_u; const float* peer_v; const float* final_g;
  float* out;
  u16* hn; u16* proj; u16* mix; float* h; u16* vts; u16* vtw; u16* memn; u16* memk; u16* memvt;
  u16* winT; u16* woutT; u16* wmqT; u16* wmkT; u16* wmvT; u16* wmoT; u16* wpqT; u16* subk; u16* w1T; u16* w2T;
  float* biasp; float* rope; u16* hdn; u16* kc; u16* vcT; float* ssq1; float* ssq2;
  int* experts; float* gates; unsigned char* ub8; unsigned char* vb8; float* uscale; float* vscale; u16* qm; u16* pq;
  unsigned* bar;
};

DEVI int launder(int x) { asm volatile("" : "+v"(x)); return x; }
DEVI u16 f2bf(float f) {
  unsigned u = __float_as_uint(f);
  u += 0x7fffu + ((u >> 16) & 1u);
  return (u16)(u >> 16);
}
DEVI float bf2f(u16 h) { return __uint_as_float(((unsigned)h) << 16); }
DEVI unsigned pack2(float a, float b) { return (unsigned)f2bf(a) | ((unsigned)f2bf(b) << 16); }
DEVI float wave_sum(float v) {
#pragma unroll
  for (int o = 32; o; o >>= 1) v += __shfl_xor(v, o);
  return v;
}
DEVI float sigmoidf_(float x) { return 1.f / (1.f + __expf(-x)); }
DEVI float gelu_tanh(float x) {
  float u = 0.7978845608028654f * (x + 0.044715f * x * x * x);
  return 0.5f * x * (1.f + tanhf(u));
}
DEVI f32x4 mfma16(bf16x8 a, bf16x8 b, f32x4 c) { return __builtin_amdgcn_mfma_f32_16x16x32_bf16(a, b, c, 0, 0, 0); }
DEVI float fexp2(float x) { return __builtin_amdgcn_exp2f(x); }

DEVI void tconv(const float* __restrict__ src, int K, int N, u16* __restrict__ dst, int Npad, int ldd,
                const float* __restrict__ gain, int gtid, int gsz) {
  const int items = Npad * (K >> 3);
  for (int it = gtid; it < items; it += gsz) {
    const int n = it % Npad, kc = it / Npad;
    float f[8];
#pragma unroll
    for (int j = 0; j < 8; ++j) {
      float v = 0.f;
      if (n < N) {
        v = src[(size_t)(kc * 8 + j) * N + n];
        if (gain) v *= gain[kc * 8 + j];
      }
      f[j] = v;
    }
    uint4 pk;
    pk.x = pack2(f[0], f[1]); pk.y = pack2(f[2], f[3]); pk.z = pack2(f[4], f[5]); pk.w = pack2(f[6], f[7]);
    *(uint4*)(dst + (size_t)n * ldd + kc * 8) = pk;
  }
}

DEVI void conv_flat(const float* __restrict__ src, u16* __restrict__ dst, size_t n8, size_t gtid, size_t gsz) {
  for (size_t it = gtid; it < n8; it += gsz) {
    const float4 a = ((const float4*)src)[2 * it], b = ((const float4*)src)[2 * it + 1];
    uint4 pk;
    pk.x = pack2(a.x, a.y); pk.y = pack2(a.z, a.w); pk.z = pack2(b.x, b.y); pk.w = pack2(b.z, b.w);
    ((uint4*)dst)[it] = pk;
  }
}


typedef float f32x2 __attribute__((ext_vector_type(2)));
DEVI unsigned pk4_fp8(float a, float b, float c, float d) {
  int v = 0;
  v = __builtin_amdgcn_cvt_pk_fp8_f32(a, b, v, false);
  v = __builtin_amdgcn_cvt_pk_fp8_f32(c, d, v, true);
  return (unsigned)v;
}
DEVI void conv_fp8_rows(const float* __restrict__ src, unsigned char* __restrict__ dst, float* __restrict__ inv_scale,
                        int rows, int gw, int nw, int lane) {
  for (int r0 = gw; r0 < rows; r0 += 2 * nw) {
    const int r1 = r0 + nw;
    const bool has1 = r1 < rows;
    const float4* p0 = (const float4*)(src + (size_t)r0 * 1024) + lane * 4;
    const float4* p1 = (const float4*)(src + (size_t)(has1 ? r1 : r0) * 1024) + lane * 4;
    float4 v[2][4];
#pragma unroll
    for (int i = 0; i < 4; ++i) { v[0][i] = p0[i]; v[1][i] = p1[i]; }
    float mx[2];
#pragma unroll
    for (int q = 0; q < 2; ++q) {
      float m = 0.f;
#pragma unroll
      for (int i = 0; i < 4; ++i)
        m = fmaxf(m, fmaxf(fmaxf(fabsf(v[q][i].x), fabsf(v[q][i].y)), fmaxf(fabsf(v[q][i].z), fabsf(v[q][i].w))));
      mx[q] = m;
    }
#pragma unroll
    for (int o = 32; o; o >>= 1) { mx[0] = fmaxf(mx[0], __shfl_xor(mx[0], o)); mx[1] = fmaxf(mx[1], __shfl_xor(mx[1], o)); }
#pragma unroll
    for (int q = 0; q < 2; ++q) {
      if (q == 1 && !has1) break;
      const int r = q ? r1 : r0;
      const float sc = mx[q] > 0.f ? 224.f / mx[q] : 1.f;
      if (lane == 0) inv_scale[r] = mx[q] > 0.f ? mx[q] * (1.f / 224.f) : 1.f;
      uint4 o4;
      o4.x = pk4_fp8(v[q][0].x * sc, v[q][0].y * sc, v[q][0].z * sc, v[q][0].w * sc);
      o4.y = pk4_fp8(v[q][1].x * sc, v[q][1].y * sc, v[q][1].z * sc, v[q][1].w * sc);
      o4.z = pk4_fp8(v[q][2].x * sc, v[q][2].y * sc, v[q][2].z * sc, v[q][2].w * sc);
      o4.w = pk4_fp8(v[q][3].x * sc, v[q][3].y * sc, v[q][3].z * sc, v[q][3].w * sc);
      ((uint4*)(dst + (size_t)r * 1024))[lane] = o4;
    }
  }
}

DEVI void rownorm_bf16(const float* __restrict__ src, const float* __restrict__ g, u16* __restrict__ dst,
                       int rows, int gw, int nw, int lane) {
  for (int r0 = gw; r0 < rows; r0 += 2 * nw) {
    const int r1 = r0 + nw;
    const bool has1 = r1 < rows;
    const float4* pa = (const float4*)(src + (size_t)r0 * D);
    const float4* pb = (const float4*)(src + (size_t)(has1 ? r1 : r0) * D);
    float4 va[4], vb[4];
    float sa = 0.f, sb = 0.f;
#pragma unroll
    for (int i = 0; i < 4; ++i) { va[i] = pa[lane + 64 * i]; vb[i] = pb[lane + 64 * i]; }
#pragma unroll
    for (int i = 0; i < 4; ++i) {
      sa += va[i].x * va[i].x + va[i].y * va[i].y + va[i].z * va[i].z + va[i].w * va[i].w;
      sb += vb[i].x * vb[i].x + vb[i].y * vb[i].y + vb[i].z * vb[i].z + vb[i].w * vb[i].w;
    }
#pragma unroll
    for (int o = 32; o; o >>= 1) { sa += __shfl_xor(sa, o); sb += __shfl_xor(sb, o); }
    const float ra = rsqrtf(sa * (1.f / D) + 1e-6f), rb = rsqrtf(sb * (1.f / D) + 1e-6f);
#pragma unroll
    for (int i = 0; i < 4; ++i) {
      const float4 gg = ((const float4*)g)[lane + 64 * i];
      uint2 pk;
      pk.x = pack2(va[i].x * ra * gg.x, va[i].y * ra * gg.y);
      pk.y = pack2(va[i].z * ra * gg.z, va[i].w * ra * gg.w);
      *(uint2*)(dst + (size_t)r0 * LDA + (size_t)(lane + 64 * i) * 4) = pk;
      if (has1) {
        pk.x = pack2(vb[i].x * rb * gg.x, vb[i].y * rb * gg.y);
        pk.y = pack2(vb[i].z * rb * gg.z, vb[i].w * rb * gg.w);
        *(uint2*)(dst + (size_t)r1 * LDA + (size_t)(lane + 64 * i) * 4) = pk;
      }
    }
  }
}

DEVI void phase0(const Params& p) {
  const int tid = launder(threadIdx.x), lane = tid & 63;
  const int gtid = blockIdx.x * 256 + tid, gsz = gridDim.x * 256;
  const int gw = gtid >> 6, nw = gsz >> 6;
  rownorm_bf16(p.x, p.mix_g, p.hn, NTOK, gw, nw, lane);
  rownorm_bf16(p.mem, p.memkv_g, p.memn, Bn * 256, gw, nw, lane);
  tconv(p.w_in, 1024, 2328, p.winT, 2432, LDA, nullptr, gtid, gsz);
  tconv(p.w_out, 1024, 1024, p.woutT, 1024, LDA, nullptr, gtid, gsz);
  tconv(p.w_mq, 1024, 1024, p.wmqT, 1024, LDA, p.memq_g, gtid, gsz);
  tconv(p.w_mk, 1024, 1024, p.wmkT, 1024, LDA, nullptr, gtid, gsz);
  tconv(p.w_mv, 1024, 1024, p.wmvT, 1024, LDA, nullptr, gtid, gsz);
  tconv(p.w_mo, 1024, 1024, p.wmoT, 1024, LDA, nullptr, gtid, gsz);
  tconv(p.peer_wq, 1024, 2048, p.wpqT, 2048, LDA, p.peer_g, gtid, gsz);
  tconv(p.cmp_w1, 2048, 128, p.w1T, 128, LDW1, nullptr, gtid, gsz);
  tconv(p.cmp_w1 + 2048 * 128, 2048, 128, p.w1T + 128 * LDW1, 128, LDW1, nullptr, gtid, gsz);
  tconv(p.cmp_w2, 128, 64, p.w2T, 128, 128, nullptr, gtid, gsz);
  tconv(p.cmp_w2 + 128 * 64, 128, 64, p.w2T + 128 * 128, 128, 128, nullptr, gtid, gsz);
  conv_flat(p.peer_sk, p.subk, (size_t)16 * 128 * 128 / 8, gtid, gsz);
  for (int it = gtid; it < NTOK * 8; it += gsz) {
    const int tok = it >> 3, i = it & 7;
    const float inv = (i == 0) ? 1.000000000e+00f : (i == 1) ? 1.939227432e-01f : (i == 2) ? 3.760603070e-02f : (i == 3) ? 7.292664610e-03f : (i == 4) ? 1.414213562e-03f : (i == 5) ? 2.742481884e-04f : (i == 6) ? 5.318295734e-05f : 1.031338525e-05f;
    const float ang = (float)p.pos[tok] * inv;
    float sv, cv;
    sincosf(ang, &sv, &cv);
    p.rope[tok * 16 + i] = cv;
    p.rope[tok * 16 + 8 + i] = sv;
  }
  for (int o = gw; o < 256; o += nw) {
    const int ty = o >> 7, n = o & 127;
    float s = 0.f;
#pragma unroll 8
    for (int k = lane; k < 2048; k += 64)
      s += p.cmp_pos[ty * 2048 + k] * p.cmp_w1[((size_t)ty * 2048 + k) * 128 + n];
    s = wave_sum(s);
    if (lane == 0) p.biasp[o] = s + p.cmp_b1[o];
  }
  for (int it = gtid; it < NTOK; it += gsz) { p.ssq1[it] = 0.f; p.ssq2[it] = 0.f; }
}

template <bool DB, class AF>
DEVI void gemm_mainloop(int tid, u16* sA, u16* sB, AF af, const u16* __restrict__ Bt, int ldb, int m0, int n0, int nk,
                        f32x4 (&acc)[4][4]) {
  const int lane = tid & 63, w = tid >> 6;
  const int wm = w >> 1, wn = w & 1, col = lane & 15, quad = lane >> 4;
#pragma unroll
  for (int i = 0; i < 4; ++i)
#pragma unroll
    for (int j = 0; j < 4; ++j) acc[i][j] = f32x4{0.f, 0.f, 0.f, 0.f};
  uint4 ra0, ra1, ra2, ra3, rb0, rb1, rb2, rb3;
  const int lrow = tid >> 3, lkc = (tid & 7) << 3;
  const u16* bbase = Bt + (size_t)(n0 + lrow) * ldb + lkc;
#define GL_(R, i, kk)                                                     \
  R##a##i = *(const uint4*)af(m0 + lrow + 32 * i, (kk) + lkc);            \
  R##b##i = *(const uint4*)(bbase + (size_t)(32 * i) * ldb + (kk));
#define SS_(R, i, off)                                                    \
  *(uint4*)(sA + (off) + (lrow + 32 * i) * 72 + lkc) = R##a##i;           \
  *(uint4*)(sB + (off) + (lrow + 32 * i) * 72 + lkc) = R##b##i;
#define GL4_(R, kk) GL_(R, 0, kk) GL_(R, 1, kk) GL_(R, 2, kk) GL_(R, 3, kk)
#define SS4_(R, off) SS_(R, 0, off) SS_(R, 1, off) SS_(R, 2, off) SS_(R, 3, off)
#define COMPUTE_(cur)                                                                                                   \
  _Pragma("unroll") for (int ks = 0; ks < 2; ++ks) {                                                                    \
    bf16x8 fa[4], fb[4];                                                                                                \
    _Pragma("unroll") for (int mi = 0; mi < 4; ++mi)                                                                    \
      fa[mi] = *(const bf16x8*)(sA + (cur) + (wm * 64 + 16 * mi + col) * 72 + 32 * ks + 8 * quad);                      \
    _Pragma("unroll") for (int ni = 0; ni < 4; ++ni)                                                                    \
      fb[ni] = *(const bf16x8*)(sB + (cur) + (wn * 64 + 16 * ni + col) * 72 + 32 * ks + 8 * quad);                      \
    _Pragma("unroll") for (int ni = 0; ni < 4; ++ni)                                                                    \
      _Pragma("unroll") for (int mi = 0; mi < 4; ++mi) acc[ni][mi] = mfma16(fb[ni], fa[mi], acc[ni][mi]);               \
  }
  if (DB) {
    const int srow = 8 * w + (lane >> 3);
    const int spc = lane & 7;
#define STAGE_(st, kk)                                                                                         \
    _Pragma("unroll") for (int i = 0; i < 4; ++i) {                                                            \
      const int r_ = 32 * i + srow;                                                                            \
      const int c_ = (spc ^ ((r_ >> 1) & 7)) << 3;                                                             \
      __builtin_amdgcn_global_load_lds((const unsigned*)af(m0 + r_, (kk) + c_),                                \
                                       (unsigned*)(sA + (st) * 16384 + (32 * i + 8 * w) * 64), 16, 0, 0);      \
      __builtin_amdgcn_global_load_lds((const unsigned*)(Bt + (size_t)(n0 + r_) * ldb + (kk) + c_),            \
                                       (unsigned*)(sA + (st) * 16384 + 8192 + (32 * i + 8 * w) * 64), 16, 0, 0); \
    }
#define COMPUTE_SW_(st)                                                                                                 \
  _Pragma("unroll") for (int ks = 0; ks < 2; ++ks) {                                                                    \
    bf16x8 fa[4], fb[4];                                                                                                \
    const int pc_ = ((4 * ks + quad) ^ ((col >> 1) & 7)) << 3;                                                          \
    _Pragma("unroll") for (int mi = 0; mi < 4; ++mi)                                                                    \
      fa[mi] = *(const bf16x8*)(sA + (st) * 16384 + (wm * 64 + 16 * mi + col) * 64 + pc_);                              \
    _Pragma("unroll") for (int ni = 0; ni < 4; ++ni)                                                                    \
      fb[ni] = *(const bf16x8*)(sA + (st) * 16384 + 8192 + (wn * 64 + 16 * ni + col) * 64 + pc_);                       \
    _Pragma("unroll") for (int ni = 0; ni < 4; ++ni)                                                                    \
      _Pragma("unroll") for (int mi = 0; mi < 4; ++mi) acc[ni][mi] = mfma16(fb[ni], fa[mi], acc[ni][mi]);               \
  }
    STAGE_(0, 0)
#pragma unroll 1
    for (int kt = 0; kt < nk; kt += 2) {
      asm volatile("s_waitcnt vmcnt(0)" ::: "memory");
      __syncthreads();
      { const int kk = (kt + 1) * 64; STAGE_(1, kk) }
      COMPUTE_SW_(0)
      asm volatile("s_waitcnt vmcnt(0)" ::: "memory");
      __syncthreads();
      if (kt + 2 < nk) { const int kk = (kt + 2) * 64; STAGE_(0, kk) }
      COMPUTE_SW_(1)
    }
#undef STAGE_
#undef COMPUTE_SW_
  } else {
    GL4_(r, 0)
    SS4_(r, 0)
    __syncthreads();
#pragma unroll 1
    for (int kt = 0; kt < nk; ++kt) {
      const bool more = (kt + 1 < nk);
      if (more) { const int kk = (kt + 1) * 64; GL4_(r, kk) }
      COMPUTE_(0)
      __syncthreads();
      if (more) {
        SS4_(r, 0)
        __syncthreads();
      }
    }
  }
#undef GL_
#undef SS_
#undef GL4_
#undef SS4_
#undef COMPUTE_
}

struct ARow {
  const u16* base; int lda;
  DEVI const u16* operator()(int m, int k) const { return base + (size_t)m * lda + k; }
};
struct ACmp {
  const u16* proj; int colbase;
  DEVI const u16* operator()(int rr, int k) const {
    const int b = rr >> 8, g = (rr >> 7) & 1;
    int c = rr & 127; c = c > 126 ? 126 : c;
    const int l = k >> 6, d = k & 63;
    return proj + ((size_t)b * T + 16 * c + l) * LDP + colbase + g * 64 + d;
  }
};


#define XCD_TILE_LOOP(idx, MT, NT)                                                                     \
  const bool sw_ = (gridDim.x & 7) == 0;                                                               \
  const int xcd_ = blockIdx.x & 7;                                                                     \
  const int tstart_ = sw_ ? (int)(blockIdx.x >> 3) : (int)blockIdx.x;                                  \
  const int tstep_ = sw_ ? (int)(gridDim.x >> 3) : (int)gridDim.x;                                     \
  const int ttotal_ = sw_ ? ((MT) / 8) * (NT) : (MT) * (NT);                                           \
  _Pragma("unroll 1") for (int idx = tstart_; idx < ttotal_; idx += tstep_)
#define XCD_TILE_MT(idx, NT) (sw_ ? ((idx) / (NT)) * 8 + xcd_ : (idx) / (NT))
#define XCD_TILE_NT(idx, NT) ((idx) % (NT))

#define GEMM_LANE_VARS                                                    \
  const int tid = launder(threadIdx.x), lane = tid & 63, w = tid >> 6;    \
  const int wm = w >> 1, wn = w & 1, col = lane & 15, quad = lane >> 4;   \
  (void)wm; (void)wn; (void)col; (void)quad;

DEVI void phase1(const Params& p, unsigned char* smem) {
  u16* sA = (u16*)smem; u16* sB = sA + 128 * 72;
  XCD_TILE_LOOP(idx, 256 + 32, 19) {
    GEMM_LANE_VARS
    f32x4 acc[4][4];
    const int mt = XCD_TILE_MT(idx, 19), nt_ = XCD_TILE_NT(idx, 19);
    if (mt < 256) {
      const int m0 = mt * 128, n0 = nt_ * 128;
      gemm_mainloop<true>(tid, sA, sB, ARow{p.hn, LDA}, p.winT, LDA, m0, n0, 16, acc);
#pragma unroll
      for (int mi = 0; mi < 4; ++mi) {
        const int m = m0 + wm * 64 + 16 * mi + col;
        const int b = m >> 11, t = m & 2047;
#pragma unroll
        for (int ni = 0; ni < 4; ++ni) {
          const int nt = n0 + wn * 64 + 16 * ni;
          const int n = nt + 4 * quad;
          f32x4 v = acc[ni][mi];
          if (nt >= LDP) continue;
          if ((nt >= C_VS && nt < C_KW) || (nt >= C_VW && nt < C_GATE)) {
            const bool isw = nt >= C_VW;
            const int off = n - (isw ? C_VW : C_VS);
            const int g = off >> 6, d = off & 63;
            u16* dst = (isw ? p.vtw : p.vts) + ((size_t)(b * 2 + g) * 64 + d) * LDT + t;
#pragma unroll
            for (int r = 0; r < 4; ++r) dst[(size_t)r * LDT] = f2bf(v[r]);
          } else {
            const bool rope_tile = ((nt >= C_KS && nt < C_VS) || (nt >= C_KW && nt < C_VW)) && ((nt & 63) == 0);
            if (rope_tile) {
#pragma unroll
              for (int r = 0; r < 4; ++r) {
                const float pr = __shfl_xor(v[r], 32);
                const int i = ((quad & 1) << 2) + r;
                const float cs = p.rope[(size_t)m * 16 + i], sn = p.rope[(size_t)m * 16 + 8 + i];
                v[r] = (quad < 2) ? (v[r] * cs - pr * sn) : (v[r] * cs + pr * sn);
              }
            }
            uint2 pk; pk.x = pack2(v[0], v[1]); pk.y = pack2(v[2], v[3]);
            *(uint2*)(p.proj + (size_t)m * LDP + n) = pk;
          }
        }
      }
    } else if (nt_ < 16) {
      const int isv = nt_ >> 3;
      const int m0 = (mt - 256) * 128, n0 = (nt_ & 7) * 128;
      gemm_mainloop<true>(tid, sA, sB, ARow{p.memn, LDA}, isv ? p.wmvT : p.wmkT, LDA, m0, n0, 16, acc);
#pragma unroll
      for (int mi = 0; mi < 4; ++mi) {
        const int m = m0 + wm * 64 + 16 * mi + col;
        const int b = m >> 8, key = m & 255;
#pragma unroll
        for (int ni = 0; ni < 4; ++ni) {
          const int n = n0 + wn * 64 + 16 * ni + 4 * quad;
          const f32x4 v = acc[ni][mi];
          if (isv) {
            const int head = n >> 8, d = n & 255;
            u16* dst = p.memvt + ((size_t)(b * 4 + head) * 256 + d) * 256 + key;
#pragma unroll
            for (int r = 0; r < 4; ++r) dst[r * 256] = f2bf(v[r]);
          } else {
            uint2 pk; pk.x = pack2(v[0], v[1]); pk.y = pack2(v[2], v[3]);
            *(uint2*)(p.memk + (size_t)m * LDA + n) = pk;
          }
        }
      }
    }
  }
}

DEVI void conv_tile(const Params& p, unsigned char* smem, int ct) {
  u16* sU = (u16*)smem;
  float2* sRed = (float2*)(smem + 62 * 512 * 2);
  const int tid = launder(threadIdx.x), lane = tid & 63, w = tid >> 6;
  const int b = ct >> 6, t0 = (ct & 63) * 32;
  __syncthreads();
  for (int it = tid; it < 62 * 64; it += 256) {
    const int r = it >> 6, c8 = it & 63;
    const int t = t0 - 30 + r;
    uint4 pk = {0u, 0u, 0u, 0u};
    if (t >= 0) {
      const u16* src = p.proj + ((size_t)b * T + t) * LDP + c8 * 8;
      const uint4 a = *(const uint4*)src, bb = *(const uint4*)(src + 512);
      const unsigned au[4] = {a.x, a.y, a.z, a.w}, bu[4] = {bb.x, bb.y, bb.z, bb.w};
      unsigned o[4];
#pragma unroll
      for (int j = 0; j < 4; ++j) {
        const float a0 = __uint_as_float(au[j] << 16), a1 = __uint_as_float(au[j] & 0xffff0000u);
        const float b0 = __uint_as_float(bu[j] << 16), b1 = __uint_as_float(bu[j] & 0xffff0000u);
        o[j] = pack2(a0 * sigmoidf_(b0), a1 * sigmoidf_(b1));
      }
      pk.x = o[0]; pk.y = o[1]; pk.z = o[2]; pk.w = o[3];
    }
    *(uint4*)(sU + r * 512 + c8 * 8) = pk;
  }
  const int c = 2 * tid;
  float w0[31], w1[31];
#pragma unroll
  for (int j = 0; j < 31; ++j) { w0[j] = p.conv_w[j * 512 + c]; w1[j] = p.conv_w[j * 512 + c + 1]; }
  const float bd0 = p.conv_b[c], bd1 = p.conv_b[c + 1];
  __syncthreads();
  float ya[32], yb[32];
#pragma unroll
  for (int tt = 0; tt < 32; ++tt) {
    float y0 = bd0, y1 = bd1;
#pragma unroll
    for (int j = 0; j < 31; ++j) {
      const unsigned uu = *(const unsigned*)(sU + (tt + j) * 512 + c);
      y0 += w0[j] * __uint_as_float(uu << 16);
      y1 += w1[j] * __uint_as_float(uu & 0xffff0000u);
    }
    ya[tt] = y0; yb[tt] = y1;
    float s = y0 + y1, q = y0 * y0 + y1 * y1;
    s = wave_sum(s); q = wave_sum(q);
    if (lane == 0) sRed[tt * 4 + w] = make_float2(s, q);
  }
  __syncthreads();
  const float g0 = p.ln_g[c], g1 = p.ln_g[c + 1], lb0 = p.ln_b[c], lb1 = p.ln_b[c + 1];
#pragma unroll
  for (int tt = 0; tt < 32; ++tt) {
    const float y0 = ya[tt], y1 = yb[tt];
    const float2 r0 = sRed[tt * 4 + 0], r1 = sRed[tt * 4 + 1], r2 = sRed[tt * 4 + 2], r3 = sRed[tt * 4 + 3];
    const float S = r0.x + r1.x + r2.x + r3.x, Q = r0.y + r1.y + r2.y + r3.y;
    const float mu = S * (1.f / 512.f);
    const float var = fmaxf(Q * (1.f / 512.f) - mu * mu, 0.f);
    const float rstd = rsqrtf(var + 1e-6f);
    const float z0 = (y0 - mu) * rstd * g0 + lb0, z1 = (y1 - mu) * rstd * g1 + lb1;
    const float o0 = z0 * sigmoidf_(z0), o1 = z1 * sigmoidf_(z1);
    *(unsigned*)(p.mix + ((size_t)b * T + t0 + tt) * LDA + c) = pack2(o0, o1);
  }
}

DEVI void compress2_tile(const Params& p, unsigned char* smem, int tile);
DEVI void phase2(const Params& p, unsigned char* smem) {
  u16* sA = (u16*)smem; u16* sB = sA + 128 * 72;
#pragma unroll 1
  for (int tile = blockIdx.x; tile < 64 + 1024; tile += gridDim.x) {
    GEMM_LANE_VARS
    if (tile < 64) {
      const int ty = tile >> 5, mt = tile & 31;
      const int m0 = mt * 128;
      f32x4 acc[4][4];
      gemm_mainloop<true>(tid, sA, sB, ACmp{p.proj, ty ? C_VC : C_KC}, p.w1T + (size_t)ty * 128 * LDW1, LDW1, m0, 0, 32, acc);
#pragma unroll
      for (int mi = 0; mi < 4; ++mi) {
        const int m = m0 + wm * 64 + 16 * mi + col;
#pragma unroll
        for (int ni = 0; ni < 4; ++ni) {
          const int n = wn * 64 + 16 * ni + 4 * quad;
          const f32x4 v = acc[ni][mi];
          const float4 bb = *(const float4*)(p.biasp + ty * 128 + n);
          uint2 pk;
          pk.x = pack2(gelu_tanh(v[0] + bb.x), gelu_tanh(v[1] + bb.y));
          pk.y = pack2(gelu_tanh(v[2] + bb.z), gelu_tanh(v[3] + bb.w));
          *(uint2*)(p.hdn + ((size_t)ty * 4096 + m) * 128 + n) = pk;
        }
      }
      asm volatile("s_waitcnt vmcnt(0)" ::: "memory");
      __syncthreads();
      compress2_tile(p, smem, tile);
    } else {
      conv_tile(p, smem, tile - 64);
    }
  }
}

DEVI void compress2_tile(const Params& p, unsigned char* smem, int tile) {
  u16* sA = (u16*)smem; u16* sB = sA + 128 * 72;
  {
    GEMM_LANE_VARS
    const int ty = tile >> 5, mt = tile & 31;
    const int m0 = mt * 128;
    f32x4 acc[4][4];
    gemm_mainloop<true>(tid, sA, sB, ARow{p.hdn + (size_t)ty * 4096 * 128, 128}, p.w2T + (size_t)ty * 128 * 128, 128, m0, 0, 2, acc);
    if (wn == 0) {
#pragma unroll
      for (int mi = 0; mi < 4; ++mi) {
        const int m = m0 + 16 * mi + wm * 64 + col;
        const int bg = m >> 7, c = m & 127;
#pragma unroll
        for (int ni = 0; ni < 4; ++ni) {
          const int n = 16 * ni + 4 * quad;
          const f32x4 v = acc[ni][mi];
          const float4 bb = *(const float4*)(p.cmp_b2 + ty * 64 + n);
          const float o0 = v[0] + bb.x, o1 = v[1] + bb.y, o2 = v[2] + bb.z, o3 = v[3] + bb.w;
          if (ty == 0) {
            uint2 pk; pk.x = pack2(o0, o1); pk.y = pack2(o2, o3);
            *(uint2*)(p.kc + (size_t)m * 64 + n) = pk;
          } else {
            u16* dst = p.vcT + ((size_t)bg * 64 + n) * 128 + c;
            dst[0] = f2bf(o0); dst[128] = f2bf(o1); dst[256] = f2bf(o2); dst[384] = f2bf(o3);
          }
        }
      }
    }
  }
}

template <int DH, int NQ, int LDK, class MaskF>
DEVI void attn_qk(const u16* sK, const bf16x8 (&qf)[NQ][DH / 32], f32x4 (&o)[NQ][DH / 16], float (&m)[NQ], float (&l)[NQ],
                  float c2, int lane, MaskF valid, bf16x8 (&pb)[NQ][2]) {
  const int col = lane & 15, quad = lane >> 4;
  f32x4 s[NQ][4];
#pragma unroll
  for (int kt = 0; kt < 4; ++kt) {
#pragma unroll
    for (int qt = 0; qt < NQ; ++qt) s[qt][kt] = f32x4{0.f, 0.f, 0.f, 0.f};
#pragma unroll
    for (int ks = 0; ks < DH / 32; ++ks) {
      const bf16x8 kf = *(const bf16x8*)(sK + (16 * kt + col) * LDK + 32 * ks + 8 * quad);
#pragma unroll
      for (int qt = 0; qt < NQ; ++qt) s[qt][kt] = mfma16(kf, qf[qt][ks], s[qt][kt]);
    }
  }
#pragma unroll
  for (int qt = 0; qt < NQ; ++qt) {
    float mx = -1e30f;
#pragma unroll
    for (int kt = 0; kt < 4; ++kt)
#pragma unroll
      for (int r = 0; r < 4; ++r) {
        const bool v = valid(qt, 16 * kt + 4 * quad + r);
        const float sv = v ? s[qt][kt][r] : -1e30f;
        s[qt][kt][r] = sv;
        mx = fmaxf(mx, sv);
      }
    mx = fmaxf(mx, __shfl_xor(mx, 16));
    mx = fmaxf(mx, __shfl_xor(mx, 32));
    const float mn = fmaxf(m[qt], mx);
    const float alpha = fexp2((m[qt] - mn) * c2);
    m[qt] = mn;
    const float mc = fmaxf(mn, -1e20f) * c2;
    float ps = 0.f;
#pragma unroll
    for (int kt = 0; kt < 4; ++kt)
#pragma unroll
      for (int r = 0; r < 4; ++r) {
        const float pv = fexp2(__builtin_fmaf(s[qt][kt][r], c2, -mc));
        ps += pv;
        s[qt][kt][r] = pv;
      }
    l[qt] = l[qt] * alpha + ps;
#pragma unroll
    for (int dt = 0; dt < DH / 16; ++dt) o[qt][dt] *= alpha;
#pragma unroll
    for (int kk = 0; kk < 2; ++kk) {
      union { bf16x8 v; unsigned u[4]; } cv;
      cv.u[0] = pack2(s[qt][2 * kk][0], s[qt][2 * kk][1]);
      cv.u[1] = pack2(s[qt][2 * kk][2], s[qt][2 * kk][3]);
      cv.u[2] = pack2(s[qt][2 * kk + 1][0], s[qt][2 * kk + 1][1]);
      cv.u[3] = pack2(s[qt][2 * kk + 1][2], s[qt][2 * kk + 1][3]);
      pb[qt][kk] = cv.v;
    }
  }
}
template <int DH, int NQ, int LDV>
DEVI void attn_pv(const u16* sVt, const bf16x8 (&pb)[NQ][2], f32x4 (&o)[NQ][DH / 16], int lane) {
  const int col = lane & 15, quad = lane >> 4;
#pragma unroll
  for (int dt = 0; dt < DH / 16; ++dt) {
#pragma unroll
    for (int kk = 0; kk < 2; ++kk) {
      union { bf16x8 v; uint2 h[2]; } cv;
      cv.h[0] = *(const uint2*)(sVt + (16 * dt + col) * LDV + 32 * kk + 4 * quad);
      cv.h[1] = *(const uint2*)(sVt + (16 * dt + col) * LDV + 32 * kk + 16 + 4 * quad);
#pragma unroll
      for (int qt = 0; qt < NQ; ++qt) o[qt][dt] = mfma16(cv.v, pb[qt][kk], o[qt][dt]);
    }
  }
}
template <int DH, int NQ, int LDK, int LDV, class MaskF>
DEVI void attn_tile(const u16* sK, const u16* sVt, const bf16x8 (&qf)[NQ][DH / 32], f32x4 (&o)[NQ][DH / 16],
                    float (&m)[NQ], float (&l)[NQ], float c2, int lane, MaskF valid) {
  bf16x8 pb[NQ][2];
  attn_qk<DH, NQ, LDK>(sK, qf, o, m, l, c2, lane, valid, pb);
  attn_pv<DH, NQ, LDV>(sVt, pb, o, lane);
}

DEVI void phase_nsa(const Params& p, unsigned char* smem) {
  u16* sK = (u16*)smem;
  u16* sVt = (u16*)(smem + 18432);
  float* impH = (float*)(smem + 35840);
  float* impT = (float*)(smem + 52736);
  unsigned* selm = (unsigned*)(smem + 56960);
  const float c2 = 0.125f * 1.4426950408889634f;
#pragma unroll 1
  for (int tile = blockIdx.x; tile < 2048; tile += gridDim.x) {
    const int tid = launder(threadIdx.x), lane = tid & 63, w = tid >> 6, col = lane & 15, quad = lane >> 4;
    const int qtile = 63 - (tile >> 5), bg = tile & 31, b = bg >> 1, g = bg & 1, q0 = qtile * 32;
    const int h = g * 4 + w;
    __syncthreads();
    if (tid < 32) selm[tid] = 0u;
    {
      const u16* kcp = p.kc + (size_t)bg * 128 * 64;
      const u16* vcp = p.vcT + (size_t)bg * 64 * 128;
#pragma unroll
      for (int i = 0; i < 4; ++i) {
        const int c = tid + 256 * i;
        const int row = c >> 3, ch = (c & 7) << 3;
        *(uint4*)(sK + row * 72 + ch) = *(const uint4*)(kcp + row * 64 + ch);
        const int row2 = c >> 4, ch2 = (c & 15) << 3;
        *(uint4*)(sVt + row2 * 136 + ch2) = *(const uint4*)(vcp + row2 * 128 + ch2);
      }
    }
    bf16x8 qf[2][2];
    float gate[2][3];
    int tq[2];
#pragma unroll
    for (int qt = 0; qt < 2; ++qt) {
      const int t = q0 + 16 * qt + col;
      tq[qt] = t;
      const size_t tok = (size_t)b * T + t;
      const u16* qp = p.proj + tok * LDP + C_Q + h * 64 + 8 * quad;
      qf[qt][0] = *(const bf16x8*)qp;
      qf[qt][1] = *(const bf16x8*)(qp + 32);
#pragma unroll
      for (int br = 0; br < 3; ++br) gate[qt][br] = sigmoidf_(bf2f(p.proj[tok * LDP + C_GATE + h * 3 + br]));
    }
    __syncthreads();

    f32x4 comb[2][4];
    {
      const int srcl = (lane + 48) & 63;
#pragma unroll
      for (int qt = 0; qt < 2; ++qt) {
        f32x4 s[8];
#pragma unroll
        for (int kt = 0; kt < 8; ++kt) {
          s[kt] = f32x4{0.f, 0.f, 0.f, 0.f};
#pragma unroll
          for (int ks = 0; ks < 2; ++ks) {
            const bf16x8 kf = *(const bf16x8*)(sK + (16 * kt + col) * 72 + 32 * ks + 8 * quad);
            s[kt] = mfma16(kf, qf[qt][ks], s[kt]);
          }
        }
        const int t = tq[qt];
        float mx = -1e30f;
#pragma unroll
        for (int kt = 0; kt < 8; ++kt)
#pragma unroll
          for (int r = 0; r < 4; ++r) {
            const int c = 16 * kt + 4 * quad + r;
            const bool v = (16 * c + 31) <= t;
            const float sv = v ? s[kt][r] : -1e30f;
            s[kt][r] = sv;
            mx = fmaxf(mx, sv);
          }
        mx = fmaxf(mx, __shfl_xor(mx, 16));
        mx = fmaxf(mx, __shfl_xor(mx, 32));
        float ps = 0.f;
        const float mcc = fmaxf(mx, -1e20f) * c2;
#pragma unroll
        for (int kt = 0; kt < 8; ++kt)
#pragma unroll
          for (int r = 0; r < 4; ++r) {
            const float pv = fexp2(__builtin_fmaf(s[kt][r], c2, -mcc));
            ps += pv;
            s[kt][r] = pv;
          }
        ps += __shfl_xor(ps, 16);
        ps += __shfl_xor(ps, 32);
        const float inv = ps > 0.f ? 1.f / ps : 0.f;
#pragma unroll
        for (int kt = 0; kt < 8; ++kt)
#pragma unroll
          for (int r = 0; r < 4; ++r) s[kt][r] *= inv;
        float prev3 = 0.f;
#pragma unroll
        for (int kt = 0; kt < 8; ++kt) {
          const float sum4 = s[kt][0] + s[kt][1] + s[kt][2] + s[kt][3];
          const float xs = __shfl(s[kt][3], srcl);
          const float extra = quad ? xs : prev3;
          prev3 = xs;
          impH[(w * 32 + 16 * qt + col) * 33 + 4 * kt + quad] = sum4 + extra;
        }
        bf16x8 pb[4];
#pragma unroll
        for (int kk = 0; kk < 4; ++kk) {
          union { bf16x8 v; unsigned u[4]; } cv;
          cv.u[0] = pack2(s[2 * kk][0], s[2 * kk][1]);
          cv.u[1] = pack2(s[2 * kk][2], s[2 * kk][3]);
          cv.u[2] = pack2(s[2 * kk + 1][0], s[2 * kk + 1][1]);
          cv.u[3] = pack2(s[2 * kk + 1][2], s[2 * kk + 1][3]);
          pb[kk] = cv.v;
        }
#pragma unroll
        for (int dt = 0; dt < 4; ++dt) {
          f32x4 oc = f32x4{0.f, 0.f, 0.f, 0.f};
#pragma unroll
          for (int kk = 0; kk < 4; ++kk) {
            union { bf16x8 v; uint2 hh[2]; } cv;
            cv.hh[0] = *(const uint2*)(sVt + (16 * dt + col) * 136 + 32 * kk + 4 * quad);
            cv.hh[1] = *(const uint2*)(sVt + (16 * dt + col) * 136 + 32 * kk + 16 + 4 * quad);
            oc = mfma16(cv.v, pb[kk], oc);
          }
          comb[qt][dt] = oc * gate[qt][0];
        }
      }
    }
#pragma unroll
    for (int qt = 0; qt < 2; ++qt) {
      const size_t tok = (size_t)b * T + tq[qt];
      union { bf16x8 v; unsigned u[4]; } own, par, res;
      own.v = qf[qt][0];
#pragma unroll
      for (int j = 0; j < 4; ++j) par.u[j] = (unsigned)__shfl_xor((int)own.u[j], 16);
      const float4 c0 = *(const float4*)(p.rope + tok * 16), c1 = *(const float4*)(p.rope + tok * 16 + 4);
      const float4 s0 = *(const float4*)(p.rope + tok * 16 + 8), s1 = *(const float4*)(p.rope + tok * 16 + 12);
      const float cs[8] = {c0.x, c0.y, c0.z, c0.w, c1.x, c1.y, c1.z, c1.w};
      const float sn[8] = {s0.x, s0.y, s0.z, s0.w, s1.x, s1.y, s1.z, s1.w};
#pragma unroll
      for (int j = 0; j < 4; ++j) {
        const float o0 = __uint_as_float(own.u[j] << 16), o1 = __uint_as_float(own.u[j] & 0xffff0000u);
        const float p0 = __uint_as_float(par.u[j] << 16), p1 = __uint_as_float(par.u[j] & 0xffff0000u);
        const float sg = (quad == 0) ? -1.f : 1.f;
        const float r0 = o0 * cs[2 * j] + sg * p0 * sn[2 * j];
        const float r1 = o1 * cs[2 * j + 1] + sg * p1 * sn[2 * j + 1];
        res.u[j] = (quad < 2) ? pack2(r0, r1) : own.u[j];
      }
      qf[qt][0] = res.v;
    }
    __syncthreads();
#pragma unroll
    for (int i = 0; i < 4; ++i) {
      const int cell = tid + 256 * i;
      const int qi = cell >> 5, s_ = cell & 31;
      const int cur = (q0 + qi) >> 6;
      float v = impH[(0 * 32 + qi) * 33 + s_] + impH[(1 * 32 + qi) * 33 + s_] + impH[(2 * 32 + qi) * 33 + s_] +
                impH[(3 * 32 + qi) * 33 + s_];
      const int dist = cur - s_;
      const bool forced = (s_ == 0) || (dist >= 0 && dist < 2);
      v = forced ? 1e9f : (s_ <= cur ? v : -1.f);
      impT[qi * 33 + s_] = v;
    }
    __syncthreads();
    {
      const int qi = tid >> 3, sub = tid & 7;
      unsigned bits = 0u;
#pragma unroll
      for (int k = 0; k < 4; ++k) {
        const int s_ = sub * 4 + k;
        const float v = impT[qi * 33 + s_];
        int rank = 0;
        for (int s2 = 0; s2 < 32; ++s2) {
          const float v2 = impT[qi * 33 + s2];
          rank += ((v2 > v) || (v2 == v && s2 < s_)) ? 1 : 0;
        }
        if (rank < 16) bits |= 1u << s_;
      }
      atomicOr(&selm[qi], bits);
    }
    __syncthreads();
    unsigned sm[2] = {selm[col], selm[16 + col]};
    unsigned uni = 0u;
#pragma unroll
    for (int i = 0; i < 32; ++i) uni |= selm[i];
    const int kbmax = (q0 + 31) >> 6;
    {
      float m[2] = {-1e30f, -1e30f}, l[2] = {0.f, 0.f};
      f32x4 o[2][4];
#pragma unroll
      for (int qt = 0; qt < 2; ++qt)
#pragma unroll
        for (int dt = 0; dt < 4; ++dt) o[qt][dt] = f32x4{0.f, 0.f, 0.f, 0.f};
      unsigned rem = (kbmax >= 31) ? uni : (uni & ((1u << (kbmax + 1)) - 1u));
      int kb = rem ? (__ffs((int)rem) - 1) : -1;
      uint4 rk0, rk1, rv0, rv1;
      const int lr0 = tid >> 3, lch = (tid & 7) << 3;
#define LOADKV_(kbx, CK, VT)                                                                                         \
      rk0 = *(const uint4*)(p.proj + ((size_t)b * T + (kbx) * 64 + lr0) * LDP + (CK) + g * 64 + lch);                 \
      rk1 = *(const uint4*)(p.proj + ((size_t)b * T + (kbx) * 64 + lr0 + 32) * LDP + (CK) + g * 64 + lch);            \
      rv0 = *(const uint4*)((VT) + ((size_t)bg * 64 + lr0) * LDT + (kbx) * 64 + lch);                                 \
      rv1 = *(const uint4*)((VT) + ((size_t)bg * 64 + lr0 + 32) * LDT + (kbx) * 64 + lch);
#define STOREKV_()                                                                                                   \
      *(uint4*)(sK + lr0 * 72 + lch) = rk0; *(uint4*)(sK + (lr0 + 32) * 72 + lch) = rk1;                              \
      *(uint4*)(sVt + lr0 * 72 + lch) = rv0; *(uint4*)(sVt + (lr0 + 32) * 72 + lch) = rv1;
      if (kb >= 0) { LOADKV_(kb, C_KS, p.vts) }
#pragma unroll 1
      while (kb >= 0) {
        rem &= rem - 1u;
        const int nkb = rem ? (__ffs((int)rem) - 1) : -1;
        __syncthreads();
        STOREKV_()
        if (nkb >= 0) { LOADKV_(nkb, C_KS, p.vts) }
        __syncthreads();
        const int lim0 = ((sm[0] >> kb) & 1u) ? tq[0] : -1, lim1 = ((sm[1] >> kb) & 1u) ? tq[1] : -1;
        attn_tile<64, 2, 72, 72>(sK, sVt, qf, o, m, l, c2, lane, [&](int qt, int kl) {
          return (kb * 64 + kl) <= (qt ? lim1 : lim0);
        });
        kb = nkb;
      }
#pragma unroll
      for (int qt = 0; qt < 2; ++qt) {
        float lt = l[qt];
        lt += __shfl_xor(lt, 16);
        lt += __shfl_xor(lt, 32);
        const float sc = lt > 0.f ? gate[qt][1] / lt : 0.f;
#pragma unroll
        for (int dt = 0; dt < 4; ++dt) comb[qt][dt] += o[qt][dt] * sc;
      }
    }
    {
      float m[2] = {-1e30f, -1e30f}, l[2] = {0.f, 0.f};
      f32x4 o[2][4];
#pragma unroll
      for (int qt = 0; qt < 2; ++qt)
#pragma unroll
        for (int dt = 0; dt < 4; ++dt) o[qt][dt] = f32x4{0.f, 0.f, 0.f, 0.f};
      const int kblo = (q0 >= 511) ? ((q0 - 511) >> 6) : 0;
      uint4 rk0, rk1, rv0, rv1;
      const int lr0 = tid >> 3, lch = (tid & 7) << 3;
      int kb = kblo;
      LOADKV_(kb, C_KW, p.vtw)
#pragma unroll 1
      while (kb >= 0) {
        const int nkb = (kb < kbmax) ? kb + 1 : -1;
        __syncthreads();
        STOREKV_()
        if (nkb >= 0) { LOADKV_(nkb, C_KW, p.vtw) }
        __syncthreads();
        attn_tile<64, 2, 72, 72>(sK, sVt, qf, o, m, l, c2, lane, [&](int qt, int kl) {
          return (unsigned)(tq[qt] - (kb * 64 + kl)) < 512u;
        });
        kb = nkb;
      }
#undef LOADKV_
#undef STOREKV_
#pragma unroll
      for (int qt = 0; qt < 2; ++qt) {
        float lt = l[qt];
        lt += __shfl_xor(lt, 16);
        lt += __shfl_xor(lt, 32);
        const float sc = lt > 0.f ? gate[qt][2] / lt : 0.f;
#pragma unroll
        for (int dt = 0; dt < 4; ++dt) comb[qt][dt] += o[qt][dt] * sc;
      }
    }
#pragma unroll
    for (int qt = 0; qt < 2; ++qt) {
      const size_t tok = (size_t)b * T + tq[qt];
#pragma unroll
      for (int dt = 0; dt < 4; ++dt) {
        uint2 pk;
        pk.x = pack2(comb[qt][dt][0], comb[qt][dt][1]);
        pk.y = pack2(comb[qt][dt][2], comb[qt][dt][3]);
        *(uint2*)(p.mix + tok * LDA + 512 + h * 64 + 16 * dt + 4 * quad) = pk;
      }
    }
  }
}

template <bool RESB>
DEVI void phase_resid(const Params& p, unsigned char* smem, const u16* A, const u16* Wt, const float* res, float* ssq) {
  u16* sA = (u16*)smem; u16* sB = sA + 128 * 72;
  XCD_TILE_LOOP(idx, 256, 8) {
    GEMM_LANE_VARS
    const int mt = XCD_TILE_MT(idx, 8), nt_ = XCD_TILE_NT(idx, 8);
    const int m0 = mt * 128, n0 = nt_ * 128;
    f32x4 acc[4][4];
    gemm_mainloop<true>(tid, sA, sB, ARow{A, LDA}, Wt, LDA, m0, n0, 16, acc);
#pragma unroll
    for (int mi = 0; mi < 4; ++mi) {
      const int m = m0 + wm * 64 + 16 * mi + col;
      float ss = 0.f;
#pragma unroll
      for (int ni = 0; ni < 4; ++ni) {
        const int n = n0 + wn * 64 + 16 * ni + 4 * quad;
        const f32x4 v = acc[ni][mi];
        float4 r;
        if (RESB) {
          const uint2 rb = *(const uint2*)(p.hn + (size_t)m * LDA + n);
          r.x = __uint_as_float(rb.x << 16); r.y = __uint_as_float(rb.x & 0xffff0000u);
          r.z = __uint_as_float(rb.y << 16); r.w = __uint_as_float(rb.y & 0xffff0000u);
        } else {
          r = *(const float4*)(res + (size_t)m * D + n);
        }
        float4 hv;
        hv.x = r.x + v[0]; hv.y = r.y + v[1]; hv.z = r.z + v[2]; hv.w = r.w + v[3];
        ss += hv.x * hv.x + hv.y * hv.y + hv.z * hv.z + hv.w * hv.w;
        uint2 pk; pk.x = pack2(hv.x, hv.y); pk.y = pack2(hv.z, hv.w);
        *(uint2*)(p.hn + (size_t)m * LDA + n) = pk;
      }
      ss += __shfl_xor(ss, 16);
      ss += __shfl_xor(ss, 32);
      if (quad == 0) atomicAdd(ssq + m, ss);
    }
  }
}

DEVI void phase_scaled(const Params& p, unsigned char* smem, const u16* A, const u16* Wt, int ntn, const float* ssq, u16* outp, int ldo) {
  u16* sA = (u16*)smem; u16* sB = sA + 128 * 72;
  XCD_TILE_LOOP(idx, 256, ntn) {
    GEMM_LANE_VARS
    const int mt = XCD_TILE_MT(idx, ntn), nt_ = XCD_TILE_NT(idx, ntn);
    const int m0 = mt * 128, n0 = nt_ * 128;
    f32x4 acc[4][4];
    gemm_mainloop<true>(tid, sA, sB, ARow{A, LDA}, Wt, LDA, m0, n0, 16, acc);
#pragma unroll
    for (int mi = 0; mi < 4; ++mi) {
      const int m = m0 + wm * 64 + 16 * mi + col;
      const float rstd = rsqrtf(ssq[m] * (1.f / D) + 1e-6f);
#pragma unroll
      for (int ni = 0; ni < 4; ++ni) {
        const int n = n0 + wn * 64 + 16 * ni + 4 * quad;
        const f32x4 v = acc[ni][mi];
        uint2 pk; pk.x = pack2(v[0] * rstd, v[1] * rstd); pk.y = pack2(v[2] * rstd, v[3] * rstd);
        *(uint2*)(outp + (size_t)m * ldo + n) = pk;
      }
    }
  }
}

DEVI void phase_memattn(const Params& p, unsigned char* smem) {
  u16* sK = (u16*)smem;
  u16* sVt = (u16*)(smem + 33792);
  const float c2 = 0.0625f * 1.4426950408889634f;
#pragma unroll 1
  for (int tile = blockIdx.x; tile < 2048; tile += gridDim.x) {
    const int tid = launder(threadIdx.x), lane = tid & 63, w = tid >> 6, col = lane & 15, quad = lane >> 4;
    const int b = tile >> 7, head = (tile >> 5) & 3, q0 = (tile & 31) * 64;
    const size_t tok = (size_t)b * T + q0 + 16 * w + col;
    bf16x8 qf[1][8];
#pragma unroll
    for (int ks = 0; ks < 8; ++ks) qf[0][ks] = *(const bf16x8*)(p.qm + tok * LDA + head * 256 + 32 * ks + 8 * quad);
    float m[1] = {-1e30f}, l[1] = {0.f};
    f32x4 o[1][16];
#pragma unroll
    for (int dt = 0; dt < 16; ++dt) o[0][dt] = f32x4{0.f, 0.f, 0.f, 0.f};
    uint4 rg0, rg1, rg2, rg3, rg4, rg5, rg6, rg7;
    const int krow = tid >> 5, kch = (tid & 31) << 3;
    const int vrow = tid >> 3, vch = (tid & 7) << 3;
#define LK1_(i, kbx) rg##i = *(const uint4*)(p.memk + ((size_t)b * 256 + (kbx) * 64 + krow + 8 * i) * LDA + head * 256 + kch);
#define SK1_(i) *(uint4*)(sK + (krow + 8 * i) * 264 + kch) = rg##i;
#define LV1_(i, kbx) rg##i = *(const uint4*)(p.memvt + ((size_t)(b * 4 + head) * 256 + vrow + 32 * i) * 256 + (kbx) * 64 + vch);
#define SV1_(i) *(uint4*)(sVt + (vrow + 32 * i) * 72 + vch) = rg##i;
#define LOADK_(kbx) LK1_(0, kbx) LK1_(1, kbx) LK1_(2, kbx) LK1_(3, kbx) LK1_(4, kbx) LK1_(5, kbx) LK1_(6, kbx) LK1_(7, kbx)
#define STOREK_() SK1_(0) SK1_(1) SK1_(2) SK1_(3) SK1_(4) SK1_(5) SK1_(6) SK1_(7)
#define LOADV_(kbx) LV1_(0, kbx) LV1_(1, kbx) LV1_(2, kbx) LV1_(3, kbx) LV1_(4, kbx) LV1_(5, kbx) LV1_(6, kbx) LV1_(7, kbx)
#define STOREV_() SV1_(0) SV1_(1) SV1_(2) SV1_(3) SV1_(4) SV1_(5) SV1_(6) SV1_(7)
    __syncthreads();
    LOADK_(0)
    STOREK_()
    LOADV_(0)
    __syncthreads();
#pragma unroll 1
    for (int kb = 0; kb < 4; ++kb) {
      bf16x8 pb[1][2];
      attn_qk<256, 1, 264>(sK, qf, o, m, l, c2, lane, [&](int, int) { return true; }, pb);
      STOREV_()
      if (kb < 3) { LOADK_(kb + 1) }
      __syncthreads();
      attn_pv<256, 1, 72>(sVt, pb, o, lane);
      if (kb < 3) {
        STOREK_()
        LOADV_(kb + 1)
      }
      __syncthreads();
    }
#undef LOADK_
#undef STOREK_
#undef LOADV_
#undef STOREV_
#undef LK1_
#undef SK1_
#undef LV1_
#undef SV1_
    float lt = l[0];
    lt += __shfl_xor(lt, 16);
    lt += __shfl_xor(lt, 32);
    const float inv = 1.f / lt;
#pragma unroll
    for (int dt = 0; dt < 16; ++dt) {
      uint2 pk;
      pk.x = pack2(o[0][dt][0] * inv, o[0][dt][1] * inv);
      pk.y = pack2(o[0][dt][2] * inv, o[0][dt][3] * inv);
      *(uint2*)(p.mix + tok * LDA + head * 256 + 16 * dt + 4 * quad) = pk;
    }
  }
}

__constant__ unsigned char kCandI[64] = {0,0,0,0,0,0,0,0,0,0,0,0,0,0,0,0, 1,1,1,1,1,1,1,1, 2,2,2,2,2, 3,3,3,3, 4,4,4, 5,5, 6,6, 7,7,
                                          8, 9, 10, 11, 12, 13, 14, 15, 0,0,0,0,0,0,0,0,0,0,0,0,0,0};
__constant__ unsigned char kCandJ[64] = {0,1,2,3,4,5,6,7,8,9,10,11,12,13,14,15, 0,1,2,3,4,5,6,7, 0,1,2,3,4, 0,1,2,3, 0,1,2, 0,1, 0,1, 0,1,
                                          0, 0, 0, 0, 0, 0, 0, 0, 0,0,0,0,0,0,0,0,0,0,0,0,0,0};

DEVI unsigned score_key(float v, int idx) {
  unsigned u = __float_as_uint(v);
  u = (u & 0x80000000u) ? ~u : (u | 0x80000000u);
  return (u & ~127u) | (unsigned)(127 - idx);
}
DEVI float key_score(unsigned k) {
  k &= ~127u;
  const unsigned u = (k & 0x80000000u) ? (k & 0x7fffffffu) : ~k;
  return __uint_as_float(u);
}

DEVI void phase_peer_route(const Params& p, unsigned char* smem) {
  u16* sA = (u16*)smem; u16* sB = sA + 128 * 72;
  unsigned* sScore = (unsigned*)smem;
  unsigned* sTop = (unsigned*)(smem + 36864);
  unsigned* sTmp = (unsigned*)(smem + 53248);
  {
    const int t0_ = launder(threadIdx.x);
    const int gw = (blockIdx.x * 256 + t0_) >> 6, nw = (gridDim.x * 256) >> 6;
    conv_fp8_rows(p.peer_u, p.ub8, p.uscale, 16384, gw, nw, t0_ & 63);
    conv_fp8_rows(p.peer_v, p.vb8, p.vscale, 16384, gw, nw, t0_ & 63);
  }
#pragma unroll 1
  for (int tile = blockIdx.x; tile < 256 * 8; tile += gridDim.x) {
    GEMM_LANE_VARS
    const int mt = tile >> 3, hd = tile & 7;
    const int m0 = mt * 128;
#pragma unroll 1
    for (int ph = 0; ph < 2; ++ph) {
      const int hp = hd * 2 + ph;
      f32x4 acc[4][4];
      __syncthreads();
      gemm_mainloop<false>(tid, sA, sB, ARow{p.pq + hp * 128, LDPQ}, p.subk + (size_t)hp * 128 * 128, 128, m0, 0, 2, acc);
#pragma unroll 1
      for (int hh = 0; hh < 2; ++hh) {
        if (wm == hh) {
#pragma unroll
          for (int mi = 0; mi < 4; ++mi) {
            const int row = 16 * mi + col;
#pragma unroll
            for (int ni = 0; ni < 4; ++ni) {
              const int n = wn * 64 + 16 * ni + 4 * quad;
              const f32x4 v = acc[ni][mi];
              uint4 kk;
              kk.x = score_key(v[0], n); kk.y = score_key(v[1], n + 1);
              kk.z = score_key(v[2], n + 2); kk.w = score_key(v[3], n + 3);
              *(uint4*)(sScore + row * 132 + n) = kk;
            }
          }
        }
        __syncthreads();
#pragma unroll 1
        for (int rg = 0; rg < 4; ++rg) {
          const int rbase = w * 16 + rg * 4;
          unsigned k0[4], k1[4], t0[4], t1[4], thr[4];
#pragma unroll
          for (int r = 0; r < 4; ++r) {
            k0[r] = sScore[(rbase + r) * 132 + lane];
            k1[r] = sScore[(rbase + r) * 132 + 64 + lane];
            t0[r] = ((k0[r] >> 16) << 7) | (k0[r] & 127u);
            t1[r] = ((k1[r] >> 16) << 7) | (k1[r] & 127u);
            thr[r] = 0u;
          }
#pragma unroll
          for (int bit = 22; bit >= 0; --bit) {
#pragma unroll
            for (int r = 0; r < 4; ++r) {
              const unsigned cand = thr[r] | (1u << bit);
              const int cnt = __popcll(__ballot(t0[r] >= cand)) + __popcll(__ballot(t1[r] >= cand));
              thr[r] = (cnt >= 16) ? cand : thr[r];
            }
          }
          unsigned* tmp = sTmp + w * 64;
#pragma unroll
          for (int r = 0; r < 4; ++r) {
            const unsigned long long b0 = __ballot(t0[r] >= thr[r]), b1 = __ballot(t1[r] >= thr[r]);
            const int pos0 = __builtin_amdgcn_mbcnt_hi((unsigned)(b0 >> 32), __builtin_amdgcn_mbcnt_lo((unsigned)b0, 0u));
            const int pos1 = __popcll(b0) + __builtin_amdgcn_mbcnt_hi((unsigned)(b1 >> 32), __builtin_amdgcn_mbcnt_lo((unsigned)b1, 0u));
            if (t0[r] >= thr[r]) tmp[r * 16 + pos0] = k0[r];
            if (t1[r] >= thr[r]) tmp[r * 16 + pos1] = k1[r];
          }
          __builtin_amdgcn_fence(__ATOMIC_RELEASE, "wavefront");
          __builtin_amdgcn_wave_barrier();
          __builtin_amdgcn_fence(__ATOMIC_ACQUIRE, "wavefront");
          {
            const int r = lane >> 4, ix = lane & 15;
            const unsigned mine = tmp[r * 16 + ix];
            const uint4 a = *(const uint4*)(tmp + r * 16), b = *(const uint4*)(tmp + r * 16 + 4), c = *(const uint4*)(tmp + r * 16 + 8),
                        d = *(const uint4*)(tmp + r * 16 + 12);
            const int rk = (a.x > mine) + (a.y > mine) + (a.z > mine) + (a.w > mine) + (b.x > mine) + (b.y > mine) + (b.z > mine) + (b.w > mine) +
                           (c.x > mine) + (c.y > mine) + (c.z > mine) + (c.w > mine) + (d.x > mine) + (d.y > mine) + (d.z > mine) + (d.w > mine);
            sTop[((hh * 64 + rbase + r) * 2 + ph) * 16 + rk] = mine;
          }
          __builtin_amdgcn_fence(__ATOMIC_RELEASE, "wavefront");
          __builtin_amdgcn_wave_barrier();
        }
        __syncthreads();
      }
    }
    const int ci = kCandI[lane], cj = kCandJ[lane];
    const bool act = lane < 50;
#pragma unroll 1
    for (int tg = 0; tg < 8; ++tg) {
      const int tb = w * 32 + tg * 4;
      unsigned k0[4], k1[4], ku[4], thr[4];
      float v[4];
#pragma unroll
      for (int r = 0; r < 4; ++r) {
        k0[r] = sTop[((tb + r) * 2 + 0) * 16 + ci];
        k1[r] = sTop[((tb + r) * 2 + 1) * 16 + cj];
        v[r] = key_score(k0[r]) + key_score(k1[r]);
        unsigned u = __float_as_uint(v[r]);
        u = (u & 0x80000000u) ? ~u : (u | 0x80000000u);
        ku[r] = act ? (((u >> 16) << 6) | (unsigned)(63 - lane)) : 0u;
        thr[r] = 0u;
      }
#pragma unroll
      for (int bit = 21; bit >= 0; --bit) {
#pragma unroll
        for (int r = 0; r < 4; ++r) {
          const unsigned cand = thr[r] | (1u << bit);
          const int cnt = __popcll(__ballot(ku[r] >= cand));
          thr[r] = (cnt >= 16) ? cand : thr[r];
        }
      }
#pragma unroll
      for (int r = 0; r < 4; ++r) {
        const bool sel = act && (ku[r] >= thr[r]);
        const unsigned long long ms = __ballot(sel);
        const int slot = __builtin_amdgcn_mbcnt_hi((unsigned)(ms >> 32), __builtin_amdgcn_mbcnt_lo((unsigned)ms, 0u));
        const float vmax = __int_as_float(__builtin_amdgcn_readlane(__float_as_int(v[r]), 0));
        const float e = sel ? __expf(v[r] - vmax) : 0.f;
        const float tot = wave_sum(e);
        if (sel) {
          const int eid = (127 - (int)(k0[r] & 127u)) * 128 + (127 - (int)(k1[r] & 127u));
          const size_t o = (size_t)(m0 + tb + r) * 128 + hd * 16 + slot;
          p.experts[o] = eid;
          p.gates[o] = e / tot;
        }
      }
    }
  }
}

template <int PART>
DEVI void phase_peer_gather(const Params& p) {
  const int w0_ = threadIdx.x >> 6;
#pragma unroll 1
  for (int tok = blockIdx.x * 4 + w0_; tok < NTOK; tok += gridDim.x * 4) {
    const int tid = launder(threadIdx.x), lane = tid & 63;
    const uint4* hp4 = (const uint4*)(p.hn + (size_t)tok * LDA + lane * 16);
    float hv[16], xn[16], y[16];
    {
      const uint4 a0 = hp4[0], a1 = hp4[1];
      const unsigned hu[8] = {a0.x, a0.y, a0.z, a0.w, a1.x, a1.y, a1.z, a1.w};
#pragma unroll
      for (int i = 0; i < 8; ++i) { hv[2 * i] = __uint_as_float(hu[i] << 16); hv[2 * i + 1] = __uint_as_float(hu[i] & 0xffff0000u); }
    }
    float ss = 0.f;
#pragma unroll
    for (int i = 0; i < 16; ++i) ss += hv[i] * hv[i];
    ss = wave_sum(ss);
    const float rstd = rsqrtf(ss * (1.f / D) + 1e-6f);
    {
      const float4* g4 = (const float4*)p.peer_g + lane * 4;
      const float4 a0 = g4[0], a1 = g4[1], a2 = g4[2], a3 = g4[3];
      const float gg[16] = {a0.x, a0.y, a0.z, a0.w, a1.x, a1.y, a1.z, a1.w, a2.x, a2.y, a2.z, a2.w, a3.x, a3.y, a3.z, a3.w};
#pragma unroll
      for (int i = 0; i < 16; ++i) { xn[i] = hv[i] * rstd * gg[i]; y[i] = 0.f; }
    }
    const int e0 = p.experts[(size_t)tok * 128 + lane], e1 = p.experts[(size_t)tok * 128 + 64 + lane];
    const float g0 = p.gates[(size_t)tok * 128 + lane], g1 = p.gates[(size_t)tok * 128 + 64 + lane];
    const float su0 = p.uscale[e0], su1 = p.uscale[e1];
    const float sv0 = p.vscale[e0], sv1 = p.vscale[e1];
    float cf0 = 0.f, cf1 = 0.f, dsum = 0.f;
    uint4 ca[8], cb[8];
#define LOADB_(R, bi)                                                                                   \
    _Pragma("unroll") for (int u = 0; u < 8; ++u) {                                                       \
      const int kk_ = (((bi) & 7) << 3) + u;                                                             \
      const int e_ = __builtin_amdgcn_readlane((((bi) >> 3) & 1) ? e1 : e0, kk_);                        \
      R[u] = ((const uint4*)((((bi) >> 4) ? p.vb8 : p.ub8) + (size_t)e_ * 1024))[lane];                  \
    }
#define COMPU_(R, bi)                                                                                   \
    {                                                                                                    \
      float d8[8];                                                                                       \
      _Pragma("unroll") for (int u = 0; u < 8; ++u) {                                                     \
        const unsigned uu[4] = {R[u].x, R[u].y, R[u].z, R[u].w};                                         \
        f32x2 a2 = {0.f, 0.f};                                                                           \
        _Pragma("unroll") for (int j = 0; j < 4; ++j) {                                                   \
          const f32x2 lo = __builtin_amdgcn_cvt_pk_f32_fp8((int)uu[j], false);                           \
          const f32x2 hi = __builtin_amdgcn_cvt_pk_f32_fp8((int)uu[j], true);                            \
          a2 = xn2[2 * j] * lo + a2;                                                                     \
          a2 = xn2[2 * j + 1] * hi + a2;                                                                 \
        }                                                                                                \
        d8[u] = a2[0] + a2[1];                                                                           \
      }                                                                                                  \
          \
      float v4[4], v2[2];                                                                                \
      _Pragma("unroll") for (int i = 0; i < 4; ++i) {                                                     \
        const float snd = b5 ? d8[i] : d8[4 + i], kp = b5 ? d8[4 + i] : d8[i];                           \
        v4[i] = kp + __shfl_xor(snd, 32);                                                                \
      }                                                                                                  \
      _Pragma("unroll") for (int i = 0; i < 2; ++i) {                                                     \
        const float snd = b4 ? v4[i] : v4[2 + i], kp = b4 ? v4[2 + i] : v4[i];                           \
        v2[i] = kp + __shfl_xor(snd, 16);                                                                \
      }                                                                                                  \
      float v1;                                                                                          \
      { const float snd = b3 ? v2[0] : v2[1], kp = b3 ? v2[1] : v2[0]; v1 = kp + __shfl_xor(snd, 8); }   \
      v1 += __shfl_xor(v1, 4);                                                                           \
      v1 += __shfl_xor(v1, 2);                                                                           \
      v1 += __shfl_xor(v1, 1);                                                                           \
                \
      const float got = __shfl(v1, fsrc);                                                                \
      if ((lane >> 3) == ((bi) & 7)) dsum = got;                                                         \
    }                                                                                                    \
    if (((bi) & 7) == 7) {                                                                               \
      if (((bi) >> 3) & 1) cf1 = gelu_tanh(dsum * su1) * g1 * sv1; else cf0 = gelu_tanh(dsum * su0) * g0 * sv0; \
    }
#define COMPV_(R, bi)                                                                                   \
    _Pragma("unroll") for (int u = 0; u < 8; ++u) {                                                       \
      const int kk_ = (((bi) & 7) << 3) + u;                                                             \
      const float ck_ = __int_as_float(__builtin_amdgcn_readlane(__float_as_int((((bi) >> 3) & 1) ? cf1 : cf0), kk_)); \
      const f32x2 ck2 = {ck_, ck_};                                                                      \
      const unsigned uu[4] = {R[u].x, R[u].y, R[u].z, R[u].w};                                           \
      _Pragma("unroll") for (int j = 0; j < 4; ++j) {                                                     \
        const f32x2 lo = __builtin_amdgcn_cvt_pk_f32_fp8((int)uu[j], false);                             \
        const f32x2 hi = __builtin_amdgcn_cvt_pk_f32_fp8((int)uu[j], true);                              \
        y2[2 * j] = ck2 * lo + y2[2 * j];                                                                \
        y2[2 * j + 1] = ck2 * hi + y2[2 * j + 1];                                                        \
      }                                                                                                  \
    }
    const bool b5 = (lane & 32) != 0, b4 = (lane & 16) != 0, b3 = (lane & 8) != 0;
    const int fsrc = ((lane & 4) << 3) | ((lane & 2) << 3) | ((lane & 1) << 3);
    f32x2 xn2[8], y2[8];
#pragma unroll
    for (int i = 0; i < 8; ++i) { xn2[i] = f32x2{xn[2 * i], xn[2 * i + 1]}; y2[i] = f32x2{0.f, 0.f}; }
    if (PART == 0) {
      LOADB_(ca, 0)
#pragma unroll 1
      for (int bi = 0; bi < 16; bi += 2) {
        LOADB_(cb, bi + 1)
        COMPU_(ca, bi)
        if (bi + 2 < 16) { LOADB_(ca, bi + 2) }
        COMPU_(cb, bi + 1)
      }
      p.gates[(size_t)tok * 128 + lane] = cf0;
      p.gates[(size_t)tok * 128 + 64 + lane] = cf1;
      continue;
    }
    cf0 = g0; cf1 = g1;
    LOADB_(ca, 16)
#pragma unroll 1
    for (int bi = 16; bi < 32; bi += 2) {
      LOADB_(cb, bi + 1)
      COMPV_(ca, bi)
      if (bi + 2 < 32) { LOADB_(ca, bi + 2) }
      COMPV_(cb, bi + 1)
    }
#undef LOADB_
#undef COMPU_
#undef COMPV_
#pragma unroll
    for (int i = 0; i < 8; ++i) { y[2 * i] = y2[i][0]; y[2 * i + 1] = y2[i][1]; }
    float s2 = 0.f;
    {
      const uint4 a0 = hp4[0], a1 = hp4[1];
      const unsigned hu[8] = {a0.x, a0.y, a0.z, a0.w, a1.x, a1.y, a1.z, a1.w};
#pragma unroll
      for (int i = 0; i < 8; ++i) {
        y[2 * i] += __uint_as_float(hu[i] << 16);
        y[2 * i + 1] += __uint_as_float(hu[i] & 0xffff0000u);
        s2 += y[2 * i] * y[2 * i] + y[2 * i + 1] * y[2 * i + 1];
      }
    }
    s2 = wave_sum(s2);
    const float rs2 = rsqrtf(s2 * (1.f / D) + 1e-6f);
    {
      const float4* g4 = (const float4*)p.final_g + lane * 4;
      const float4 a0 = g4[0], a1 = g4[1], a2 = g4[2], a3 = g4[3];
      float4* o4 = (float4*)(p.out + (size_t)tok * D) + lane * 4;
      o4[0] = make_float4(y[0] * rs2 * a0.x, y[1] * rs2 * a0.y, y[2] * rs2 * a0.z, y[3] * rs2 * a0.w);
      o4[1] = make_float4(y[4] * rs2 * a1.x, y[5] * rs2 * a1.y, y[6] * rs2 * a1.z, y[7] * rs2 * a1.w);
      o4[2] = make_float4(y[8] * rs2 * a2.x, y[9] * rs2 * a2.y, y[10] * rs2 * a2.z, y[11] * rs2 * a2.w);
      o4[3] = make_float4(y[12] * rs2 * a3.x, y[13] * rs2 * a3.y, y[14] * rs2 * a3.z, y[15] * rs2 * a3.w);
    }
  }
}

#define XB_TMO      128
#define XB_XCNT(j)  (256  + 64 * (j))
#define XB_XSUB(j)  (1280 + 64 * (j))
#define XB_XGEN(j)  (2304 + 64 * (j))
#define XB_TOP      3328
#define XB_TOPGEN   3392
#define XCD_BAR_WORDS 3456
#define XB_SPIN_CAP (1u << 20)
#define LAS __attribute__((address_space(3)))
DEVI unsigned xb_ld(unsigned* q) { return __hip_atomic_load(q, __ATOMIC_RELAXED, __HIP_MEMORY_SCOPE_AGENT); }
DEVI unsigned xb_add(unsigned* q, unsigned v) { return __hip_atomic_fetch_add(q, v, __ATOMIC_RELAXED, __HIP_MEMORY_SCOPE_AGENT); }
DEVI unsigned xb_xcc_id() { return (unsigned)__builtin_amdgcn_s_getreg((3 << 11) | 20) & 0xFu; }
#define XB_SPIN(cond, bar) do { unsigned _sp = 0; while (cond) { __builtin_amdgcn_s_sleep(1); \
    if ((++_sp & 255u) == 0u) { if (xb_ld(&(bar)[XB_TMO])) break; if (_sp > XB_SPIN_CAP) { atomicAdd(&(bar)[XB_TMO], 1u); break; } } } } while (0)
struct XcdBarrier { unsigned* bar; unsigned x; volatile LAS unsigned* st; };
DEVI XcdBarrier xcd_barrier_post(unsigned* bar, volatile LAS unsigned* st) {
  XcdBarrier b; b.bar = bar; b.x = xb_xcc_id(); b.st = st;
  if (threadIdx.x == 0) (void)xb_add(&bar[XB_XCNT(b.x)], 1u);
  return b;
}
DEVI void xcd_barrier_complete(unsigned* bar, unsigned x, unsigned& nloc, unsigned& nx) {
  const unsigned G = gridDim.x * gridDim.y * gridDim.z;
  unsigned sum, cnt, mine, sp = 0u;
  for (;;) {
    sum = 0u; cnt = 0u; mine = 0u;
#pragma unroll
    for (unsigned j = 0; j < 16; ++j) { const unsigned c = xb_ld(&bar[XB_XCNT(j)]); sum += c; cnt += (c > 0u) ? 1u : 0u; mine = (j == x) ? c : mine; }
    if (sum == G) break;
    __builtin_amdgcn_s_sleep(1);
    if ((++sp & 255u) == 0u) { if (xb_ld(&bar[XB_TMO])) break; if (sp > XB_SPIN_CAP) { atomicAdd(&bar[XB_TMO], 1u); break; } }
  }
  nloc = mine > 0u ? mine : 1u; nx = cnt > 0u ? cnt : 1u;
}
DEVI void xcd_barrier(const XcdBarrier& b) {
  asm volatile("s_waitcnt vmcnt(0)" ::: "memory");
  __syncthreads();
  if (threadIdx.x == 0) {
    unsigned* bar = b.bar;
    __builtin_amdgcn_s_waitcnt(0);
    unsigned nloc = b.st[0], nx = b.st[1];
    if (nloc == 0u) { xcd_barrier_complete(bar, b.x, nloc, nx); b.st[0] = nloc; b.st[1] = nx; }
    const unsigned old = xb_add(&bar[XB_XSUB(b.x)], 1u);
    const unsigned gen = old / nloc;
    if (old + 1u == (gen + 1u) * nloc) {
      __builtin_amdgcn_fence(__ATOMIC_RELEASE, "agent");
      asm volatile("s_waitcnt vmcnt(0)" ::: "memory");
      const unsigned og = xb_add(&bar[XB_TOP], 1u);
      const unsigned tg = og / nx;
      if (og + 1u == (tg + 1u) * nx) xb_add(&bar[XB_TOPGEN], 1u);
      else XB_SPIN(xb_ld(&bar[XB_TOPGEN]) == tg, bar);
      __builtin_amdgcn_fence(__ATOMIC_ACQUIRE, "agent");
      xb_add(&bar[XB_XGEN(b.x)], 1u);
      asm volatile("s_waitcnt vmcnt(0)" ::: "memory");
    } else {
      XB_SPIN(xb_ld(&bar[XB_XGEN(b.x)]) == gen, bar);
      __builtin_amdgcn_fence(__ATOMIC_ACQUIRE, "agent");
      asm volatile("s_waitcnt vmcnt(0)" ::: "memory");
    }
  }
  __syncthreads();
}

template <bool COOP>
__global__ void __launch_bounds__(256, 2) mega(Params p, int ph_lo, int ph_hi) {
  __shared__ __attribute__((aligned(16))) unsigned char smem[SMEM_BYTES];
  __shared__ uint4 xb_words;
  if (threadIdx.x == 0) xb_words = make_uint4(0u, 0u, 0u, 0u);
  __syncthreads();
  XcdBarrier xb = xcd_barrier_post(p.bar, (volatile LAS unsigned*)&xb_words);
  (void)xb;
  if (COOP && ph_hi > 1000) cg::this_grid().sync();
#ifdef REPEAT_MASK
#define RUN_PHASE(i, call)                                                                   \
  if (ph_lo <= (i) && (i) <= ph_hi) {                                                        \
    call;                                                                                    \
    if (COOP && ((REPEAT_MASK >> (i)) & 1)) { xcd_barrier(xb); call; }                       \
    if (COOP && (i) < ph_hi) xcd_barrier(xb);                                                \
  }
#else
#define RUN_PHASE(i, call)                                                                   \
  if (ph_lo <= (i) && (i) <= ph_hi) {                                                        \
    call;                                                                                    \
    if (COOP && (i) < ph_hi) {                                                               \
      xcd_barrier(xb);                                                                       \
    }                                                                                        \
  }
#endif
  RUN_PHASE(0, phase0(p))
  RUN_PHASE(1, phase1(p, smem))
  RUN_PHASE(2, phase2(p, smem))
  RUN_PHASE(4, phase_nsa(p, smem))
  RUN_PHASE(5, phase_resid<false>(p, smem, p.mix, p.woutT, p.x, p.ssq1))
  RUN_PHASE(6, phase_scaled(p, smem, p.hn, p.wmqT, 8, p.ssq1, p.qm, LDA))
  RUN_PHASE(7, phase_memattn(p, smem))
  RUN_PHASE(8, phase_resid<true>(p, smem, p.mix, p.wmoT, nullptr, p.ssq2))
  RUN_PHASE(9, phase_scaled(p, smem, p.hn, p.wpqT, 16, p.ssq2, p.pq, LDPQ))
  RUN_PHASE(10, phase_peer_route(p, smem))
  RUN_PHASE(11, phase_peer_gather<0>(p))
  RUN_PHASE(12, phase_peer_gather<1>(p))
#undef RUN_PHASE
}

extern "C" void kernel_launch(void* const* d_in, const int* in_sizes, int n_in, void* d_out, int out_size, void* d_ws,
                              size_t ws_size, hipStream_t stream) {
  (void)in_sizes; (void)n_in; (void)out_size; (void)ws_size;
  Params p{};
  p.x = (const float*)d_in[0]; p.mem = (const float*)d_in[1]; p.pos = (const int*)d_in[2];
  p.mix_g = (const float*)d_in[3]; p.w_in = (const float*)d_in[4]; p.conv_w = (const float*)d_in[5];
  p.conv_b = (const float*)d_in[6]; p.ln_g = (const float*)d_in[7]; p.ln_b = (const float*)d_in[8];
  p.cmp_pos = (const float*)d_in[9]; p.cmp_w1 = (const float*)d_in[10]; p.cmp_b1 = (const float*)d_in[11];
  p.cmp_w2 = (const float*)d_in[12]; p.cmp_b2 = (const float*)d_in[13]; p.w_out = (const float*)d_in[14];
  p.memq_g = (const float*)d_in[15]; p.memkv_g = (const float*)d_in[16]; p.w_mq = (const float*)d_in[17];
  p.w_mk = (const float*)d_in[18]; p.w_mv = (const float*)d_in[19]; p.w_mo = (const float*)d_in[20];
  p.peer_g = (const float*)d_in[21]; p.peer_wq = (const float*)d_in[22]; p.peer_sk = (const float*)d_in[23];
  p.peer_u = (const float*)d_in[24]; p.peer_v = (const float*)d_in[25]; p.final_g = (const float*)d_in[26];
  p.out = (float*)d_out;
  unsigned char* ws = (unsigned char*)d_ws;
  size_t off = 0;
  auto take = [&](size_t bytes) { unsigned char* r = ws + off; off += (bytes + 255) & ~(size_t)255; return r; };
  unsigned char* regA = take((size_t)NTOK * LDA * 2);
  unsigned char* regB = take((size_t)NTOK * LDP * 2);
  unsigned char* regC = take((size_t)NTOK * LDA * 2);
  p.hn = (u16*)regA;
  p.proj = (u16*)regB; p.qm = (u16*)regB; p.pq = (u16*)regB;
  p.mix = (u16*)regC; p.experts = (int*)regC; p.gates = (float*)(regC + (size_t)NTOK * 128 * 4);
  {
    unsigned char* tb = regC + (size_t)2 * NTOK * 128 * 4;
    p.ub8 = tb; p.vb8 = tb + (size_t)16384 * 1024;
    p.uscale = (float*)(tb + (size_t)2 * 16384 * 1024); p.vscale = p.uscale + 16384;
  }
  p.h = nullptr;
  p.vts = (u16*)take((size_t)Bn * 2 * 64 * LDT * 2);
  p.vtw = (u16*)take((size_t)Bn * 2 * 64 * LDT * 2);
  p.memn = (u16*)take((size_t)Bn * 256 * LDA * 2);
  p.memk = (u16*)take((size_t)Bn * 256 * LDA * 2);
  p.memvt = (u16*)take((size_t)Bn * 256 * D * 2);
  p.winT = (u16*)take((size_t)2432 * LDA * 2);
  p.woutT = (u16*)take((size_t)1024 * LDA * 2);
  p.wmqT = (u16*)take((size_t)1024 * LDA * 2);
  p.wmkT = (u16*)take((size_t)1024 * LDA * 2);
  p.wmvT = (u16*)take((size_t)1024 * LDA * 2);
  p.wmoT = (u16*)take((size_t)1024 * LDA * 2);
  p.wpqT = (u16*)take((size_t)2048 * LDA * 2);
  p.subk = (u16*)take((size_t)16 * 128 * 128 * 2);
  p.w1T = (u16*)take((size_t)2 * 128 * LDW1 * 2);
  p.w2T = (u16*)take((size_t)2 * 128 * 128 * 2);
  p.biasp = (float*)take(256 * 4);
  p.rope = (float*)take((size_t)NTOK * 16 * 4);
  p.hdn = (u16*)take((size_t)2 * 4096 * 128 * 2);
  p.kc = (u16*)take((size_t)Bn * 2 * 128 * 64 * 2);
  p.vcT = (u16*)take((size_t)Bn * 2 * 64 * 128 * 2);
  p.ssq1 = (float*)take((size_t)NTOK * 4);
  p.ssq2 = (float*)take((size_t)NTOK * 4);
  p.bar = (unsigned*)take(16384);
  if (off > ws_size) { fprintf(stderr, "workspace too small: need %zu have %zu\n", off, ws_size); return; }

#if COOP_MODE
  static int grid_blocks = 0;
  if (!grid_blocks) {
    int dev = 0, cus = 0, per_cu = 0;
    hipGetDevice(&dev);
    hipDeviceGetAttribute(&cus, hipDeviceAttributeMultiprocessorCount, dev);
    hipOccupancyMaxActiveBlocksPerMultiprocessor(&per_cu, mega<true>, 256, 0);
    if (per_cu > 2) per_cu = 2;
    if (per_cu < 1) per_cu = 1;
    grid_blocks = cus * per_cu;
  }
  int lo = 0, hi = NPHASE;
  void* args[] = {&p, &lo, &hi};
  (void)hipMemsetAsync(p.bar, 0, 16384, stream);
  hipError_t e = hipLaunchCooperativeKernel((void*)mega<true>, dim3(grid_blocks), dim3(256), args, 0, stream);
  if (e != hipSuccess) fprintf(stderr, "cooperative launch failed: %s (grid %d)\n", hipGetErrorString(e), grid_blocks);
#else
  for (int ph = 0; ph <= NPHASE; ++ph) mega<false><<<dim3(512), dim3(256), 0, stream>>>(p, ph, ph);
#endif
}
```

```cpp
#include <hip/hip_runtime.h>
#include <hip/hip_bf16.h>
#include <hip/hip_cooperative_groups.h>
#include <cstdio>
#include <cstdint>
namespace cg = cooperative_groups;

#ifndef COOP_MODE
#define COOP_MODE 1
#endif

typedef __attribute__((ext_vector_type(8))) short bf16x8;
typedef __attribute__((ext_vector_type(4))) short bf16x4;
typedef __attribute__((ext_vector_type(4))) float f32x4;
typedef unsigned short u16;

#define DEVI __device__ __forceinline__

constexpr int Bn = 16, T = 2048, D = 1024, NTOK = Bn * T, LDP = 2336;
constexpr int C_Q = 1024, C_KC = 1536, C_VC = 1664, C_KS = 1792, C_VS = 1920, C_KW = 2048, C_VW = 2176, C_GATE = 2304;
constexpr int SMEM_BYTES = 73728;
constexpr int LDA = 1088;
constexpr int LDHF = 1056;
constexpr int LDPQ = 2112;
constexpr int LDW1 = 2112;
constexpr int LDT = 2112;
constexpr int NPHASE = 12;

struct Params {
  const float* x; const float* mem; const int* pos; const float* mix_g; const float* w_in;
  const float* conv_w; const float* conv_b; const float* ln_g; const float* ln_b;
  const float* cmp_pos; const float* cmp_w1; const float* cmp_b1; const float* cmp_w2; const float* cmp_b2;
  const float* w_out; const float* memq_g; const float* memkv_g; const float* w_mq; const float* w_mk;
  const float* w_mv; const float* w_mo; const float* peer_g; const float* peer_wq; const float* peer_sk;
  const float* peer_u; const float* peer_v; const float* final_g;
  float* out;
  u16* hn; u16* proj; u16* mix; float* h; u16* vts; u16* vtw; u16* memn; u16* memk; u16* memvt;
  u16* winT; u16* woutT; u16* wmqT; u16* wmkT; u16* wmvT; u16* wmoT; u16* wpqT; u16* subk; u16* w1T; u16* w2T;
  float* biasp; float* rope; u16* hdn; u16* kc; u16* vcT; float* ssq1; float* ssq2;
  int* experts; float* gates; unsigned char* ub8; unsigned char* vb8; float* uscale; float* vscale; u16* qm; u16* pq;
  unsigned* bar;
};

DEVI int launder(int x) { asm volatile("" : "+v"(x)); return x; }
DEVI u16 f2bf(float f) {
  unsigned u = __float_as_uint(f);
  u += 0x7fffu + ((u >> 16) & 1u);
  return (u16)(u >> 16);
}
DEVI float bf2f(u16 h) { return __uint_as_float(((unsigned)h) << 16); }
DEVI unsigned pack2(float a, float b) { return (unsigned)f2bf(a) | ((unsigned)f2bf(b) << 16); }
DEVI float wave_sum(float v) {
#pragma unroll
  for (int o = 32; o; o >>= 1) v += __shfl_xor(v, o);
  return v;
}
DEVI float sigmoidf_(float x) { return 1.f / (1.f + __expf(-x)); }
DEVI float gelu_tanh(float x) {
  float u = 0.7978845608028654f * (x + 0.044715f * x * x * x);
  return 0.5f * x * (1.f + tanhf(u));
}
DEVI f32x4 mfma16(bf16x8 a, bf16x8 b, f32x4 c) { return __builtin_amdgcn_mfma_f32_16x16x32_bf16(a, b, c, 0, 0, 0); }
DEVI float fexp2(float x) { return __builtin_amdgcn_exp2f(x); }

DEVI void tconv(const float* __restrict__ src, int K, int N, u16* __restrict__ dst, int Npad, int ldd,
                const float* __restrict__ gain, int gtid, int gsz) {
  const int items = Npad * (K >> 3);
  for (int it = gtid; it < items; it += gsz) {
    const int n = it % Npad, kc = it / Npad;
    float f[8];
#pragma unroll
    for (int j = 0; j < 8; ++j) {
      float v = 0.f;
      if (n < N) {
        v = src[(size_t)(kc * 8 + j) * N + n];
        if (gain) v *= gain[kc * 8 + j];
      }
      f[j] = v;
    }
    uint4 pk;
    pk.x = pack2(f[0], f[1]); pk.y = pack2(f[2], f[3]); pk.z = pack2(f[4], f[5]); pk.w = pack2(f[6], f[7]);
    *(uint4*)(dst + (size_t)n * ldd + kc * 8) = pk;
  }
}

DEVI void conv_flat(const float* __restrict__ src, u16* __restrict__ dst, size_t n8, size_t gtid, size_t gsz) {
  for (size_t it = gtid; it < n8; it += gsz) {
    const float4 a = ((const float4*)src)[2 * it], b = ((const float4*)src)[2 * it + 1];
    uint4 pk;
    pk.x = pack2(a.x, a.y); pk.y = pack2(a.z, a.w); pk.z = pack2(b.x, b.y); pk.w = pack2(b.z, b.w);
    ((uint4*)dst)[it] = pk;
  }
}


typedef float f32x2 __attribute__((ext_vector_type(2)));
DEVI unsigned pk4_fp8(float a, float b, float c, float d) {
  int v = 0;
  v = __builtin_amdgcn_cvt_pk_fp8_f32(a, b, v, false);
  v = __builtin_amdgcn_cvt_pk_fp8_f32(c, d, v, true);
  return (unsigned)v;
}
DEVI void conv_fp8_rows(const float* __restrict__ src, unsigned char* __restrict__ dst, float* __restrict__ inv_scale,
                        int rows, int gw, int nw, int lane) {
  for (int r0 = gw; r0 < rows; r0 += 2 * nw) {
    const int r1 = r0 + nw;
    const bool has1 = r1 < rows;
    const float4* p0 = (const float4*)(src + (size_t)r0 * 1024) + lane * 4;
    const float4* p1 = (const float4*)(src + (size_t)(has1 ? r1 : r0) * 1024) + lane * 4;
    float4 v[2][4];
#pragma unroll
    for (int i = 0; i < 4; ++i) { v[0][i] = p0[i]; v[1][i] = p1[i]; }
    float mx[2];
#pragma unroll
    for (int q = 0; q < 2; ++q) {
      float m = 0.f;
#pragma unroll
      for (int i = 0; i < 4; ++i)
        m = fmaxf(m, fmaxf(fmaxf(fabsf(v[q][i].x), fabsf(v[q][i].y)), fmaxf(fabsf(v[q][i].z), fabsf(v[q][i].w))));
      mx[q] = m;
    }
#pragma unroll
    for (int o = 32; o; o >>= 1) { mx[0] = fmaxf(mx[0], __shfl_xor(mx[0], o)); mx[1] = fmaxf(mx[1], __shfl_xor(mx[1], o)); }
#pragma unroll
    for (int q = 0; q < 2; ++q) {
      if (q == 1 && !has1) break;
      const int r = q ? r1 : r0;
      const float sc = mx[q] > 0.f ? 224.f / mx[q] : 1.f;
      if (lane == 0) inv_scale[r] = mx[q] > 0.f ? mx[q] * (1.f / 224.f) : 1.f;
      uint4 o4;
      o4.x = pk4_fp8(v[q][0].x * sc, v[q][0].y * sc, v[q][0].z * sc, v[q][0].w * sc);
      o4.y = pk4_fp8(v[q][1].x * sc, v[q][1].y * sc, v[q][1].z * sc, v[q][1].w * sc);
      o4.z = pk4_fp8(v[q][2].x * sc, v[q][2].y * sc, v[q][2].z * sc, v[q][2].w * sc);
      o4.w = pk4_fp8(v[q][3].x * sc, v[q][3].y * sc, v[q][3].z * sc, v[q][3].w * sc);
      ((uint4*)(dst + (size_t)r * 1024))[lane] = o4;
    }
  }
}

DEVI void rownorm_bf16(const float* __restrict__ src, const float* __restrict__ g, u16* __restrict__ dst,
                       int rows, int gw, int nw, int lane) {
  for (int r0 = gw; r0 < rows; r0 += 2 * nw) {
    const int r1 = r0 + nw;
    const bool has1 = r1 < rows;
    const float4* pa = (const float4*)(src + (size_t)r0 * D);
    const float4* pb = (const float4*)(src + (size_t)(has1 ? r1 : r0) * D);
    float4 va[4], vb[4];
    float sa = 0.f, sb = 0.f;
#pragma unroll
    for (int i = 0; i < 4; ++i) { va[i] = pa[lane + 64 * i]; vb[i] = pb[lane + 64 * i]; }
#pragma unroll
    for (int i = 0; i < 4; ++i) {
      sa += va[i].x * va[i].x + va[i].y * va[i].y + va[i].z * va[i].z + va[i].w * va[i].w;
      sb += vb[i].x * vb[i].x + vb[i].y * vb[i].y + vb[i].z * vb[i].z + vb[i].w * vb[i].w;
    }
#pragma unroll
    for (int o = 32; o; o >>= 1) { sa += __shfl_xor(sa, o); sb += __shfl_xor(sb, o); }
    const float ra = rsqrtf(sa * (1.f / D) + 1e-6f), rb = rsqrtf(sb * (1.f / D) + 1e-6f);
#pragma unroll
    for (int i = 0; i < 4; ++i) {
      const float4 gg = ((const float4*)g)[lane + 64 * i];
      uint2 pk;
      pk.x = pack2(va[i].x * ra * gg.x, va[i].y * ra * gg.y);
      pk.y = pack2(va[i].z * ra * gg.z, va[i].w * ra * gg.w);
      *(uint2*)(dst + (size_t)r0 * LDA + (size_t)(lane + 64 * i) * 4) = pk;
      if (has1) {
        pk.x = pack2(vb[i].x * rb * gg.x, vb[i].y * rb * gg.y);
        pk.y = pack2(vb[i].z * rb * gg.z, vb[i].w * rb * gg.w);
        *(uint2*)(dst + (size_t)r1 * LDA + (size_t)(lane + 64 * i) * 4) = pk;
      }
    }
  }
}

DEVI void phase0(const Params& p) {
  const int tid = launder(threadIdx.x), lane = tid & 63;
  const int gtid = blockIdx.x * 256 + tid, gsz = gridDim.x * 256;
  const int gw = gtid >> 6, nw = gsz >> 6;
  rownorm_bf16(p.x, p.mix_g, p.hn, NTOK, gw, nw, lane);
  rownorm_bf16(p.mem, p.memkv_g, p.memn, Bn * 256, gw, nw, lane);
  tconv(p.w_in, 1024, 2328, p.winT, 2432, LDA, nullptr, gtid, gsz);
  tconv(p.w_out, 1024, 1024, p.woutT, 1024, LDA, nullptr, gtid, gsz);
  tconv(p.w_mq, 1024, 1024, p.wmqT, 1024, LDA, p.memq_g, gtid, gsz);
  tconv(p.w_mk, 1024, 1024, p.wmkT, 1024, LDA, nullptr, gtid, gsz);
  tconv(p.w_mv, 1024, 1024, p.wmvT, 1024, LDA, nullptr, gtid, gsz);
  tconv(p.w_mo, 1024, 1024, p.wmoT, 1024, LDA, nullptr, gtid, gsz);
  tconv(p.peer_wq, 1024, 2048, p.wpqT, 2048, LDA, p.peer_g, gtid, gsz);
  tconv(p.cmp_w1, 2048, 128, p.w1T, 128, LDW1, nullptr, gtid, gsz);
  tconv(p.cmp_w1 + 2048 * 128, 2048, 128, p.w1T + 128 * LDW1, 128, LDW1, nullptr, gtid, gsz);
  tconv(p.cmp_w2, 128, 64, p.w2T, 128, 128, nullptr, gtid, gsz);
  tconv(p.cmp_w2 + 128 * 64, 128, 64, p.w2T + 128 * 128, 128, 128, nullptr, gtid, gsz);
  conv_flat(p.peer_sk, p.subk, (size_t)16 * 128 * 128 / 8, gtid, gsz);
  for (int it = gtid; it < NTOK * 8; it += gsz) {
    const int tok = it >> 3, i = it & 7;
    const float inv = (i == 0) ? 1.000000000e+00f : (i == 1) ? 1.939227432e-01f : (i == 2) ? 3.760603070e-02f : (i == 3) ? 7.292664610e-03f : (i == 4) ? 1.414213562e-03f : (i == 5) ? 2.742481884e-04f : (i == 6) ? 5.318295734e-05f : 1.031338525e-05f;
    const float ang = (float)p.pos[tok] * inv;
    float sv, cv;
    sincosf(ang, &sv, &cv);
    p.rope[tok * 16 + i] = cv;
    p.rope[tok * 16 + 8 + i] = sv;
  }
  for (int o = gw; o < 256; o += nw) {
    const int ty = o >> 7, n = o & 127;
    float s = 0.f;
#pragma unroll 8
    for (int k = lane; k < 2048; k += 64)
      s += p.cmp_pos[ty * 2048 + k] * p.cmp_w1[((size_t)ty * 2048 + k) * 128 + n];
    s = wave_sum(s);
    if (lane == 0) p.biasp[o] = s + p.cmp_b1[o];
  }
  for (int it = gtid; it < NTOK; it += gsz) { p.ssq1[it] = 0.f; p.ssq2[it] = 0.f; }
}

template <bool DB, class AF>
DEVI void gemm_mainloop(int tid, u16* sA, u16* sB, AF af, const u16* __restrict__ Bt, int ldb, int m0, int n0, int nk,
                        f32x4 (&acc)[4][4]) {
  const int lane = tid & 63, w = tid >> 6;
  const int wm = w >> 1, wn = w & 1, col = lane & 15, quad = lane >> 4;
#pragma unroll
  for (int i = 0; i < 4; ++i)
#pragma unroll
    for (int j = 0; j < 4; ++j) acc[i][j] = f32x4{0.f, 0.f, 0.f, 0.f};
  uint4 ra0, ra1, ra2, ra3, rb0, rb1, rb2, rb3;
  const int lrow = tid >> 3, lkc = (tid & 7) << 3;
  const u16* bbase = Bt + (size_t)(n0 + lrow) * ldb + lkc;
#define GL_(R, i, kk)                                                     \
  R##a##i = *(const uint4*)af(m0 + lrow + 32 * i, (kk) + lkc);            \
  R##b##i = *(const uint4*)(bbase + (size_t)(32 * i) * ldb + (kk));
#define SS_(R, i, off)                                                    \
  *(uint4*)(sA + (off) + (lrow + 32 * i) * 72 + lkc) = R##a##i;           \
  *(uint4*)(sB + (off) + (lrow + 32 * i) * 72 + lkc) = R##b##i;
#define GL4_(R, kk) GL_(R, 0, kk) GL_(R, 1, kk) GL_(R, 2, kk) GL_(R, 3, kk)
#define SS4_(R, off) SS_(R, 0, off) SS_(R, 1, off) SS_(R, 2, off) SS_(R, 3, off)
#define COMPUTE_(cur)                                                                                                   \
  _Pragma("unroll") for (int ks = 0; ks < 2; ++ks) {                                                                    \
    bf16x8 fa[4], fb[4];                                                                                                \
    _Pragma("unroll") for (int mi = 0; mi < 4; ++mi)                                                                    \
      fa[mi] = *(const bf16x8*)(sA + (cur) + (wm * 64 + 16 * mi + col) * 72 + 32 * ks + 8 * quad);                      \
    _Pragma("unroll") for (int ni = 0; ni < 4; ++ni)                                                                    \
      fb[ni] = *(const bf16x8*)(sB + (cur) + (wn * 64 + 16 * ni + col) * 72 + 32 * ks + 8 * quad);                      \
    _Pragma("unroll") for (int ni = 0; ni < 4; ++ni)                                                                    \
      _Pragma("unroll") for (int mi = 0; mi < 4; ++mi) acc[ni][mi] = mfma16(fb[ni], fa[mi], acc[ni][mi]);               \
  }
  if (DB) {
    const int srow = 8 * w + (lane >> 3);
    const int spc = lane & 7;
#define STAGE_(st, kk)                                                                                         \
    _Pragma("unroll") for (int i = 0; i < 4; ++i) {                                                            \
      const int r_ = 32 * i + srow;                                                                            \
      const int c_ = (spc ^ ((r_ >> 1) & 7)) << 3;                                                             \
      __builtin_amdgcn_global_load_lds((const unsigned*)af(m0 + r_, (kk) + c_),                                \
                                       (unsigned*)(sA + (st) * 16384 + (32 * i + 8 * w) * 64), 16, 0, 0);      \
      __builtin_amdgcn_global_load_lds((const unsigned*)(Bt + (size_t)(n0 + r_) * ldb + (kk) + c_),            \
                                       (unsigned*)(sA + (st) * 16384 + 8192 + (32 * i + 8 * w) * 64), 16, 0, 0); \
    }
#define COMPUTE_SW_(st)                                                                                                 \
  _Pragma("unroll") for (int ks = 0; ks < 2; ++ks) {                                                                    \
    bf16x8 fa[4], fb[4];                                                                                                \
    const int pc_ = ((4 * ks + quad) ^ ((col >> 1) & 7)) << 3;                                                          \
    _Pragma("unroll") for (int mi = 0; mi < 4; ++mi)                                                                    \
      fa[mi] = *(const bf16x8*)(sA + (st) * 16384 + (wm * 64 + 16 * mi + col) * 64 + pc_);                              \
    _Pragma("unroll") for (int ni = 0; ni < 4; ++ni)                                                                    \
      fb[ni] = *(const bf16x8*)(sA + (st) * 16384 + 8192 + (wn * 64 + 16 * ni + col) * 64 + pc_);                       \
    __builtin_amdgcn_s_setprio(1);                                                                                      \
    _Pragma("unroll") for (int ni = 0; ni < 4; ++ni)                                                                    \
      _Pragma("unroll") for (int mi = 0; mi < 4; ++mi) acc[ni][mi] = mfma16(fb[ni], fa[mi], acc[ni][mi]);               \
    __builtin_amdgcn_s_setprio(0);                                                                                      \
  }
    STAGE_(0, 0)
#pragma unroll 1
    for (int kt = 0; kt < nk; kt += 2) {
      asm volatile("s_waitcnt vmcnt(0)" ::: "memory");
      __syncthreads();
      { const int kk = (kt + 1) * 64; STAGE_(1, kk) }
      COMPUTE_SW_(0)
      asm volatile("s_waitcnt vmcnt(0)" ::: "memory");
      __syncthreads();
      if (kt + 2 < nk) { const int kk = (kt + 2) * 64; STAGE_(0, kk) }
      COMPUTE_SW_(1)
    }
#undef STAGE_
#undef COMPUTE_SW_
  } else {
    GL4_(r, 0)
    SS4_(r, 0)
    __syncthreads();
#pragma unroll 1
    for (int kt = 0; kt < nk; ++kt) {
      const bool more = (kt + 1 < nk);
      if (more) { const int kk = (kt + 1) * 64; GL4_(r, kk) }
      COMPUTE_(0)
      __syncthreads();
      if (more) {
        SS4_(r, 0)
        __syncthreads();
      }
    }
  }
#undef GL_
#undef SS_
#undef GL4_
#undef SS4_
#undef COMPUTE_
}

struct ARow {
  const u16* base; int lda;
  DEVI const u16* operator()(int m, int k) const { return base + (size_t)m * lda + k; }
};
struct ACmp {
  const u16* proj; int colbase;
  DEVI const u16* operator()(int rr, int k) const {
    const int b = rr >> 8, g = (rr >> 7) & 1;
    int c = rr & 127; c = c > 126 ? 126 : c;
    const int l = k >> 6, d = k & 63;
    return proj + ((size_t)b * T + 16 * c + l) * LDP + colbase + g * 64 + d;
  }
};


#define XCD_TILE_LOOP(idx, MT, NT)                                                                     \
  const bool sw_ = (gridDim.x & 7) == 0;                                                               \
  const int xcd_ = blockIdx.x & 7;                                                                     \
  const int tstart_ = sw_ ? (int)(blockIdx.x >> 3) : (int)blockIdx.x;                                  \
  const int tstep_ = sw_ ? (int)(gridDim.x >> 3) : (int)gridDim.x;                                     \
  const int ttotal_ = sw_ ? ((MT) / 8) * (NT) : (MT) * (NT);                                           \
  _Pragma("unroll 1") for (int idx = tstart_; idx < ttotal_; idx += tstep_)
#define XCD_TILE_MT(idx, NT) (sw_ ? ((idx) / (NT)) * 8 + xcd_ : (idx) / (NT))
#define XCD_TILE_NT(idx, NT) ((idx) % (NT))

#define GEMM_LANE_VARS                                                    \
  const int tid = launder(threadIdx.x), lane = tid & 63, w = tid >> 6;    \
  const int wm = w >> 1, wn = w & 1, col = lane & 15, quad = lane >> 4;   \
  (void)wm; (void)wn; (void)col; (void)quad;

DEVI void phase1(const Params& p, unsigned char* smem) {
  u16* sA = (u16*)smem; u16* sB = sA + 128 * 72;
  XCD_TILE_LOOP(idx, 256 + 32, 19) {
    GEMM_LANE_VARS
    f32x4 acc[4][4];
    const int mt = XCD_TILE_MT(idx, 19), nt_ = XCD_TILE_NT(idx, 19);
    if (mt < 256) {
      const int m0 = mt * 128, n0 = nt_ * 128;
      gemm_mainloop<true>(tid, sA, sB, ARow{p.hn, LDA}, p.winT, LDA, m0, n0, 16, acc);
#pragma unroll
      for (int mi = 0; mi < 4; ++mi) {
        const int m = m0 + wm * 64 + 16 * mi + col;
        const int b = m >> 11, t = m & 2047;
#pragma unroll
        for (int ni = 0; ni < 4; ++ni) {
          const int nt = n0 + wn * 64 + 16 * ni;
          const int n = nt + 4 * quad;
          f32x4 v = acc[ni][mi];
          if (nt >= LDP) continue;
          if ((nt >= C_VS && nt < C_KW) || (nt >= C_VW && nt < C_GATE)) {
            const bool isw = nt >= C_VW;
            const int off = n - (isw ? C_VW : C_VS);
            const int g = off >> 6, d = off & 63;
            u16* dst = (isw ? p.vtw : p.vts) + ((size_t)(b * 2 + g) * 64 + d) * LDT + t;
#pragma unroll
            for (int r = 0; r < 4; ++r) dst[(size_t)r * LDT] = f2bf(v[r]);
          } else {
            const bool rope_tile = ((nt >= C_KS && nt < C_VS) || (nt >= C_KW && nt < C_VW)) && ((nt & 63) == 0);
            if (rope_tile) {
#pragma unroll
              for (int r = 0; r < 4; ++r) {
                const float pr = __shfl_xor(v[r], 32);
                const int i = ((quad & 1) << 2) + r;
                const float cs = p.rope[(size_t)m * 16 + i], sn = p.rope[(size_t)m * 16 + 8 + i];
                v[r] = (quad < 2) ? (v[r] * cs - pr * sn) : (v[r] * cs + pr * sn);
              }
            }
            uint2 pk; pk.x = pack2(v[0], v[1]); pk.y = pack2(v[2], v[3]);
            *(uint2*)(p.proj + (size_t)m * LDP + n) = pk;
          }
        }
      }
    } else if (nt_ < 16) {
      const int isv = nt_ >> 3;
      const int m0 = (mt - 256) * 128, n0 = (nt_ & 7) * 128;
      gemm_mainloop<true>(tid, sA, sB, ARow{p.memn, LDA}, isv ? p.wmvT : p.wmkT, LDA, m0, n0, 16, acc);
#pragma unroll
      for (int mi = 0; mi < 4; ++mi) {
        const int m = m0 + wm * 64 + 16 * mi + col;
        const int b = m >> 8, key = m & 255;
#pragma unroll
        for (int ni = 0; ni < 4; ++ni) {
          const int n = n0 + wn * 64 + 16 * ni + 4 * quad;
          const f32x4 v = acc[ni][mi];
          if (isv) {
            const int head = n >> 8, d = n & 255;
            u16* dst = p.memvt + ((size_t)(b * 4 + head) * 256 + d) * 256 + key;
#pragma unroll
            for (int r = 0; r < 4; ++r) dst[r * 256] = f2bf(v[r]);
          } else {
            uint2 pk; pk.x = pack2(v[0], v[1]); pk.y = pack2(v[2], v[3]);
            *(uint2*)(p.memk + (size_t)m * LDA + n) = pk;
          }
        }
      }
    }
  }
}

DEVI void conv_tile(const Params& p, unsigned char* smem, int ct) {
  u16* sU = (u16*)smem;
  float2* sRed = (float2*)(smem + 62 * 512 * 2);
  const int tid = launder(threadIdx.x), lane = tid & 63, w = tid >> 6;
  const int b = ct >> 6, t0 = (ct & 63) * 32;
  __syncthreads();
  for (int it = tid; it < 62 * 64; it += 256) {
    const int r = it >> 6, c8 = it & 63;
    const int t = t0 - 30 + r;
    uint4 pk = {0u, 0u, 0u, 0u};
    if (t >= 0) {
      const u16* src = p.proj + ((size_t)b * T + t) * LDP + c8 * 8;
      const uint4 a = *(const uint4*)src, bb = *(const uint4*)(src + 512);
      const unsigned au[4] = {a.x, a.y, a.z, a.w}, bu[4] = {bb.x, bb.y, bb.z, bb.w};
      unsigned o[4];
#pragma unroll
      for (int j = 0; j < 4; ++j) {
        const float a0 = __uint_as_float(au[j] << 16), a1 = __uint_as_float(au[j] & 0xffff0000u);
        const float b0 = __uint_as_float(bu[j] << 16), b1 = __uint_as_float(bu[j] & 0xffff0000u);
        o[j] = pack2(a0 * sigmoidf_(b0), a1 * sigmoidf_(b1));
      }
      pk.x = o[0]; pk.y = o[1]; pk.z = o[2]; pk.w = o[3];
    }
    *(uint4*)(sU + r * 512 + c8 * 8) = pk;
  }
  const int c = 2 * tid;
  float w0[31], w1[31];
#pragma unroll
  for (int j = 0; j < 31; ++j) { w0[j] = p.conv_w[j * 512 + c]; w1[j] = p.conv_w[j * 512 + c + 1]; }
  const float bd0 = p.conv_b[c], bd1 = p.conv_b[c + 1];
  __syncthreads();
  float ya[32], yb[32];
#pragma unroll
  for (int tt = 0; tt < 32; ++tt) {
    float y0 = bd0, y1 = bd1;
#pragma unroll
    for (int j = 0; j < 31; ++j) {
      const unsigned uu = *(const unsigned*)(sU + (tt + j) * 512 + c);
      y0 += w0[j] * __uint_as_float(uu << 16);
      y1 += w1[j] * __uint_as_float(uu & 0xffff0000u);
    }
    ya[tt] = y0; yb[tt] = y1;
    float s = y0 + y1, q = y0 * y0 + y1 * y1;
    s = wave_sum(s); q = wave_sum(q);
    if (lane == 0) sRed[tt * 4 + w] = make_float2(s, q);
  }
  __syncthreads();
  const float g0 = p.ln_g[c], g1 = p.ln_g[c + 1], lb0 = p.ln_b[c], lb1 = p.ln_b[c + 1];
#pragma unroll
  for (int tt = 0; tt < 32; ++tt) {
    const float y0 = ya[tt], y1 = yb[tt];
    const float2 r0 = sRed[tt * 4 + 0], r1 = sRed[tt * 4 + 1], r2 = sRed[tt * 4 + 2], r3 = sRed[tt * 4 + 3];
    const float S = r0.x + r1.x + r2.x + r3.x, Q = r0.y + r1.y + r2.y + r3.y;
    const float mu = S * (1.f / 512.f);
    const float var = fmaxf(Q * (1.f / 512.f) - mu * mu, 0.f);
    const float rstd = rsqrtf(var + 1e-6f);
    const float z0 = (y0 - mu) * rstd * g0 + lb0, z1 = (y1 - mu) * rstd * g1 + lb1;
    const float o0 = z0 * sigmoidf_(z0), o1 = z1 * sigmoidf_(z1);
    *(unsigned*)(p.mix + ((size_t)b * T + t0 + tt) * LDA + c) = pack2(o0, o1);
  }
}

DEVI void compress2_tile(const Params& p, unsigned char* smem, int tile);
DEVI void phase2(const Params& p, unsigned char* smem) {
  u16* sA = (u16*)smem; u16* sB = sA + 128 * 72;
#pragma unroll 1
  for (int tile = blockIdx.x; tile < 64 + 1024; tile += gridDim.x) {
    GEMM_LANE_VARS
    if (tile < 64) {
      const int ty = tile >> 5, mt = tile & 31;
      const int m0 = mt * 128;
      f32x4 acc[4][4];
      gemm_mainloop<true>(tid, sA, sB, ACmp{p.proj, ty ? C_VC : C_KC}, p.w1T + (size_t)ty * 128 * LDW1, LDW1, m0, 0, 32, acc);
#pragma unroll
      for (int mi = 0; mi < 4; ++mi) {
        const int m = m0 + wm * 64 + 16 * mi + col;
#pragma unroll
        for (int ni = 0; ni < 4; ++ni) {
          const int n = wn * 64 + 16 * ni + 4 * quad;
          const f32x4 v = acc[ni][mi];
          const float4 bb = *(const float4*)(p.biasp + ty * 128 + n);
          uint2 pk;
          pk.x = pack2(gelu_tanh(v[0] + bb.x), gelu_tanh(v[1] + bb.y));
          pk.y = pack2(gelu_tanh(v[2] + bb.z), gelu_tanh(v[3] + bb.w));
          *(uint2*)(p.hdn + ((size_t)ty * 4096 + m) * 128 + n) = pk;
        }
      }
      asm volatile("s_waitcnt vmcnt(0)" ::: "memory");
      __syncthreads();
      compress2_tile(p, smem, tile);
    } else {
      conv_tile(p, smem, tile - 64);
    }
  }
}

DEVI void compress2_tile(const Params& p, unsigned char* smem, int tile) {
  u16* sA = (u16*)smem; u16* sB = sA + 128 * 72;
  {
    GEMM_LANE_VARS
    const int ty = tile >> 5, mt = tile & 31;
    const int m0 = mt * 128;
    f32x4 acc[4][4];
    gemm_mainloop<true>(tid, sA, sB, ARow{p.hdn + (size_t)ty * 4096 * 128, 128}, p.w2T + (size_t)ty * 128 * 128, 128, m0, 0, 2, acc);
    if (wn == 0) {
#pragma unroll
      for (int mi = 0; mi < 4; ++mi) {
        const int m = m0 + 16 * mi + wm * 64 + col;
        const int bg = m >> 7, c = m & 127;
#pragma unroll
        for (int ni = 0; ni < 4; ++ni) {
          const int n = 16 * ni + 4 * quad;
          const f32x4 v = acc[ni][mi];
          const float4 bb = *(const float4*)(p.cmp_b2 + ty * 64 + n);
          const float o0 = v[0] + bb.x, o1 = v[1] + bb.y, o2 = v[2] + bb.z, o3 = v[3] + bb.w;
          if (ty == 0) {
            uint2 pk; pk.x = pack2(o0, o1); pk.y = pack2(o2, o3);
            *(uint2*)(p.kc + (size_t)m * 64 + n) = pk;
          } else {
            u16* dst = p.vcT + ((size_t)bg * 64 + n) * 128 + c;
            dst[0] = f2bf(o0); dst[128] = f2bf(o1); dst[256] = f2bf(o2); dst[384] = f2bf(o3);
          }
        }
      }
    }
  }
}

template <int DH, int NQ, int LDK, class MaskF>
DEVI void attn_qk(const u16* sK, const bf16x8 (&qf)[NQ][DH / 32], f32x4 (&o)[NQ][DH / 16], float (&m)[NQ], float (&l)[NQ],
                  float c2, int lane, MaskF valid, bf16x8 (&pb)[NQ][2]) {
  const int col = lane & 15, quad = lane >> 4;
  f32x4 s[NQ][4];
  __builtin_amdgcn_s_setprio(1);
#pragma unroll
  for (int kt = 0; kt < 4; ++kt) {
#pragma unroll
    for (int qt = 0; qt < NQ; ++qt) s[qt][kt] = f32x4{0.f, 0.f, 0.f, 0.f};
#pragma unroll
    for (int ks = 0; ks < DH / 32; ++ks) {
      const bf16x8 kf = *(const bf16x8*)(sK + (16 * kt + col) * LDK + 32 * ks + 8 * quad);
#pragma unroll
      for (int qt = 0; qt < NQ; ++qt) s[qt][kt] = mfma16(kf, qf[qt][ks], s[qt][kt]);
    }
  }
  __builtin_amdgcn_s_setprio(0);
#pragma unroll
  for (int qt = 0; qt < NQ; ++qt) {
    float mx = -1e30f;
#pragma unroll
    for (int kt = 0; kt < 4; ++kt)
#pragma unroll
      for (int r = 0; r < 4; ++r) {
        const bool v = valid(qt, 16 * kt + 4 * quad + r);
        const float sv = v ? s[qt][kt][r] : -1e30f;
        s[qt][kt][r] = sv;
        mx = fmaxf(mx, sv);
      }
    mx = fmaxf(mx, __shfl_xor(mx, 16));
    mx = fmaxf(mx, __shfl_xor(mx, 32));
    const float mn = fmaxf(m[qt], mx);
    const float alpha = fexp2((m[qt] - mn) * c2);
    m[qt] = mn;
    const float mc = fmaxf(mn, -1e20f) * c2;
    float ps = 0.f;
#pragma unroll
    for (int kt = 0; kt < 4; ++kt)
#pragma unroll
      for (int r = 0; r < 4; ++r) {
        const float pv = fexp2(__builtin_fmaf(s[qt][kt][r], c2, -mc));
        ps += pv;
        s[qt][kt][r] = pv;
      }
    l[qt] = l[qt] * alpha + ps;
#pragma unroll
    for (int dt = 0; dt < DH / 16; ++dt) o[qt][dt] *= alpha;
#pragma unroll
    for (int kk = 0; kk < 2; ++kk) {
      union { bf16x8 v; unsigned u[4]; } cv;
      cv.u[0] = pack2(s[qt][2 * kk][0], s[qt][2 * kk][1]);
      cv.u[1] = pack2(s[qt][2 * kk][2], s[qt][2 * kk][3]);
      cv.u[2] = pack2(s[qt][2 * kk + 1][0], s[qt][2 * kk + 1][1]);
      cv.u[3] = pack2(s[qt][2 * kk + 1][2], s[qt][2 * kk + 1][3]);
      pb[qt][kk] = cv.v;
    }
  }
}
template <int DH, int NQ, int LDV>
DEVI void attn_pv(const u16* sVt, const bf16x8 (&pb)[NQ][2], f32x4 (&o)[NQ][DH / 16], int lane) {
  const int col = lane & 15, quad = lane >> 4;
  __builtin_amdgcn_s_setprio(1);
#pragma unroll
  for (int dt = 0; dt < DH / 16; ++dt) {
#pragma unroll
    for (int kk = 0; kk < 2; ++kk) {
      union { bf16x8 v; uint2 h[2]; } cv;
      cv.h[0] = *(const uint2*)(sVt + (16 * dt + col) * LDV + 32 * kk + 4 * quad);
      cv.h[1] = *(const uint2*)(sVt + (16 * dt + col) * LDV + 32 * kk + 16 + 4 * quad);
#pragma unroll
      for (int qt = 0; qt < NQ; ++qt) o[qt][dt] = mfma16(cv.v, pb[qt][kk], o[qt][dt]);
    }
  }
  __builtin_amdgcn_s_setprio(0);
}
template <int DH, int NQ, int LDK, int LDV, class MaskF>
DEVI void attn_tile(const u16* sK, const u16* sVt, const bf16x8 (&qf)[NQ][DH / 32], f32x4 (&o)[NQ][DH / 16],
                    float (&m)[NQ], float (&l)[NQ], float c2, int lane, MaskF valid) {
  bf16x8 pb[NQ][2];
  attn_qk<DH, NQ, LDK>(sK, qf, o, m, l, c2, lane, valid, pb);
  attn_pv<DH, NQ, LDV>(sVt, pb, o, lane);
}

DEVI void phase_nsa(const Params& p, unsigned char* smem) {
  u16* sK = (u16*)smem;
  u16* sVt = (u16*)(smem + 18432);
  float* impH = (float*)(smem + 35840);
  float* impT = (float*)(smem + 52736);
  unsigned* selm = (unsigned*)(smem + 56960);
  const float c2 = 0.125f * 1.4426950408889634f;
#pragma unroll 1
  for (int tile = blockIdx.x; tile < 2048; tile += gridDim.x) {
    const int tid = launder(threadIdx.x), lane = tid & 63, w = tid >> 6, col = lane & 15, quad = lane >> 4;
    const int qtile = 63 - (tile >> 5), bg = tile & 31, b = bg >> 1, g = bg & 1, q0 = qtile * 32;
    const int h = g * 4 + w;
    __syncthreads();
    if (tid < 32) selm[tid] = 0u;
    {
      const u16* kcp = p.kc + (size_t)bg * 128 * 64;
      const u16* vcp = p.vcT + (size_t)bg * 64 * 128;
#pragma unroll
      for (int i = 0; i < 4; ++i) {
        const int c = tid + 256 * i;
        const int row = c >> 3, ch = (c & 7) << 3;
        *(uint4*)(sK + row * 72 + ch) = *(const uint4*)(kcp + row * 64 + ch);
        const int row2 = c >> 4, ch2 = (c & 15) << 3;
        *(uint4*)(sVt + row2 * 136 + ch2) = *(const uint4*)(vcp + row2 * 128 + ch2);
      }
    }
    bf16x8 qf[2][2];
    float gate[2][3];
    int tq[2];
#pragma unroll
    for (int qt = 0; qt < 2; ++qt) {
      const int t = q0 + 16 * qt + col;
      tq[qt] = t;
      const size_t tok = (size_t)b * T + t;
      const u16* qp = p.proj + tok * LDP + C_Q + h * 64 + 8 * quad;
      qf[qt][0] = *(const bf16x8*)qp;
      qf[qt][1] = *(const bf16x8*)(qp + 32);
#pragma unroll
      for (int br = 0; br < 3; ++br) gate[qt][br] = sigmoidf_(bf2f(p.proj[tok * LDP + C_GATE + h * 3 + br]));
    }
    __syncthreads();

    f32x4 comb[2][4];
    {
      const int srcl = (lane + 48) & 63;
#pragma unroll
      for (int qt = 0; qt < 2; ++qt) {
        f32x4 s[8];
#pragma unroll
        for (int kt = 0; kt < 8; ++kt) {
          s[kt] = f32x4{0.f, 0.f, 0.f, 0.f};
#pragma unroll
          for (int ks = 0; ks < 2; ++ks) {
            const bf16x8 kf = *(const bf16x8*)(sK + (16 * kt + col) * 72 + 32 * ks + 8 * quad);
            s[kt] = mfma16(kf, qf[qt][ks], s[kt]);
          }
        }
        const int t = tq[qt];
        float mx = -1e30f;
#pragma unroll
        for (int kt = 0; kt < 8; ++kt)
#pragma unroll
          for (int r = 0; r < 4; ++r) {
            const int c = 16 * kt + 4 * quad + r;
            const bool v = (16 * c + 31) <= t;
            const float sv = v ? s[kt][r] : -1e30f;
            s[kt][r] = sv;
            mx = fmaxf(mx, sv);
          }
        mx = fmaxf(mx, __shfl_xor(mx, 16));
        mx = fmaxf(mx, __shfl_xor(mx, 32));
        float ps = 0.f;
        const float mcc = fmaxf(mx, -1e20f) * c2;
#pragma unroll
        for (int kt = 0; kt < 8; ++kt)
#pragma unroll
          for (int r = 0; r < 4; ++r) {
            const float pv = fexp2(__builtin_fmaf(s[kt][r], c2, -mcc));
            ps += pv;
            s[kt][r] = pv;
          }
        ps += __shfl_xor(ps, 16);
        ps += __shfl_xor(ps, 32);
        const float inv = ps > 0.f ? 1.f / ps : 0.f;
#pragma unroll
        for (int kt = 0; kt < 8; ++kt)
#pragma unroll
          for (int r = 0; r < 4; ++r) s[kt][r] *= inv;
        float prev3 = 0.f;
#pragma unroll
        for (int kt = 0; kt < 8; ++kt) {
          const float sum4 = s[kt][0] + s[kt][1] + s[kt][2] + s[kt][3];
          const float xs = __shfl(s[kt][3], srcl);
          const float extra = quad ? xs : prev3;
          prev3 = xs;
          impH[(w * 32 + 16 * qt + col) * 33 + 4 * kt + quad] = sum4 + extra;
        }
        bf16x8 pb[4];
#pragma unroll
        for (int kk = 0; kk < 4; ++kk) {
          union { bf16x8 v; unsigned u[4]; } cv;
          cv.u[0] = pack2(s[2 * kk][0], s[2 * kk][1]);
          cv.u[1] = pack2(s[2 * kk][2], s[2 * kk][3]);
          cv.u[2] = pack2(s[2 * kk + 1][0], s[2 * kk + 1][1]);
          cv.u[3] = pack2(s[2 * kk + 1][2], s[2 * kk + 1][3]);
          pb[kk] = cv.v;
        }
#pragma unroll
        for (int dt = 0; dt < 4; ++dt) {
          f32x4 oc = f32x4{0.f, 0.f, 0.f, 0.f};
#pragma unroll
          for (int kk = 0; kk < 4; ++kk) {
            union { bf16x8 v; uint2 hh[2]; } cv;
            cv.hh[0] = *(const uint2*)(sVt + (16 * dt + col) * 136 + 32 * kk + 4 * quad);
            cv.hh[1] = *(const uint2*)(sVt + (16 * dt + col) * 136 + 32 * kk + 16 + 4 * quad);
            oc = mfma16(cv.v, pb[kk], oc);
          }
          comb[qt][dt] = oc * gate[qt][0];
        }
      }
    }
#pragma unroll
    for (int qt = 0; qt < 2; ++qt) {
      const size_t tok = (size_t)b * T + tq[qt];
      union { bf16x8 v; unsigned u[4]; } own, par, res;
      own.v = qf[qt][0];
#pragma unroll
      for (int j = 0; j < 4; ++j) par.u[j] = (unsigned)__shfl_xor((int)own.u[j], 16);
      const float4 c0 = *(const float4*)(p.rope + tok * 16), c1 = *(const float4*)(p.rope + tok * 16 + 4);
      const float4 s0 = *(const float4*)(p.rope + tok * 16 + 8), s1 = *(const float4*)(p.rope + tok * 16 + 12);
      const float cs[8] = {c0.x, c0.y, c0.z, c0.w, c1.x, c1.y, c1.z, c1.w};
      const float sn[8] = {s0.x, s0.y, s0.z, s0.w, s1.x, s1.y, s1.z, s1.w};
#pragma unroll
      for (int j = 0; j < 4; ++j) {
        const float o0 = __uint_as_float(own.u[j] << 16), o1 = __uint_as_float(own.u[j] & 0xffff0000u);
        const float p0 = __uint_as_float(par.u[j] << 16), p1 = __uint_as_float(par.u[j] & 0xffff0000u);
        const float sg = (quad == 0) ? -1.f : 1.f;
        const float r0 = o0 * cs[2 * j] + sg * p0 * sn[2 * j];
        const float r1 = o1 * cs[2 * j + 1] + sg * p1 * sn[2 * j + 1];
        res.u[j] = (quad < 2) ? pack2(r0, r1) : own.u[j];
      }
      qf[qt][0] = res.v;
    }
    __syncthreads();
#pragma unroll
    for (int i = 0; i < 4; ++i) {
      const int cell = tid + 256 * i;
      const int qi = cell >> 5, s_ = cell & 31;
      const int cur = (q0 + qi) >> 6;
      float v = impH[(0 * 32 + qi) * 33 + s_] + impH[(1 * 32 + qi) * 33 + s_] + impH[(2 * 32 + qi) * 33 + s_] +
                impH[(3 * 32 + qi) * 33 + s_];
      const int dist = cur - s_;
      const bool forced = (s_ == 0) || (dist >= 0 && dist < 2);
      v = forced ? 1e9f : (s_ <= cur ? v : -1.f);
      impT[qi * 33 + s_] = v;
    }
    __syncthreads();
    {
      const int qi = tid >> 3, sub = tid & 7;
      unsigned bits = 0u;
#pragma unroll
      for (int k = 0; k < 4; ++k) {
        const int s_ = sub * 4 + k;
        const float v = impT[qi * 33 + s_];
        int rank = 0;
        for (int s2 = 0; s2 < 32; ++s2) {
          const float v2 = impT[qi * 33 + s2];
          rank += ((v2 > v) || (v2 == v && s2 < s_)) ? 1 : 0;
        }
        if (rank < 16) bits |= 1u << s_;
      }
      atomicOr(&selm[qi], bits);
    }
    __syncthreads();
    unsigned sm[2] = {selm[col], selm[16 + col]};
    unsigned uni = 0u;
#pragma unroll
    for (int i = 0; i < 32; ++i) uni |= selm[i];
    const int kbmax = (q0 + 31) >> 6;
    {
      float m[2] = {-1e30f, -1e30f}, l[2] = {0.f, 0.f};
      f32x4 o[2][4];
#pragma unroll
      for (int qt = 0; qt < 2; ++qt)
#pragma unroll
        for (int dt = 0; dt < 4; ++dt) o[qt][dt] = f32x4{0.f, 0.f, 0.f, 0.f};
      unsigned rem = (kbmax >= 31) ? uni : (uni & ((1u << (kbmax + 1)) - 1u));
      int kb = rem ? (__ffs((int)rem) - 1) : -1;
      uint4 rk0, rk1, rv0, rv1;
      const int lr0 = tid >> 3, lch = (tid & 7) << 3;
#define LOADKV_(kbx, CK, VT)                                                                                         \
      rk0 = *(const uint4*)(p.proj + ((size_t)b * T + (kbx) * 64 + lr0) * LDP + (CK) + g * 64 + lch);                 \
      rk1 = *(const uint4*)(p.proj + ((size_t)b * T + (kbx) * 64 + lr0 + 32) * LDP + (CK) + g * 64 + lch);            \
      rv0 = *(const uint4*)((VT) + ((size_t)bg * 64 + lr0) * LDT + (kbx) * 64 + lch);                                 \
      rv1 = *(const uint4*)((VT) + ((size_t)bg * 64 + lr0 + 32) * LDT + (kbx) * 64 + lch);
#define STOREKV_()                                                                                                   \
      *(uint4*)(sK + lr0 * 72 + lch) = rk0; *(uint4*)(sK + (lr0 + 32) * 72 + lch) = rk1;                              \
      *(uint4*)(sVt + lr0 * 72 + lch) = rv0; *(uint4*)(sVt + (lr0 + 32) * 72 + lch) = rv1;
      if (kb >= 0) { LOADKV_(kb, C_KS, p.vts) }
#pragma unroll 1
      while (kb >= 0) {
        rem &= rem - 1u;
        const int nkb = rem ? (__ffs((int)rem) - 1) : -1;
        __syncthreads();
        STOREKV_()
        if (nkb >= 0) { LOADKV_(nkb, C_KS, p.vts) }
        __syncthreads();
        const int lim0 = ((sm[0] >> kb) & 1u) ? tq[0] : -1, lim1 = ((sm[1] >> kb) & 1u) ? tq[1] : -1;
        attn_tile<64, 2, 72, 72>(sK, sVt, qf, o, m, l, c2, lane, [&](int qt, int kl) {
          return (kb * 64 + kl) <= (qt ? lim1 : lim0);
        });
        kb = nkb;
      }
#pragma unroll
      for (int qt = 0; qt < 2; ++qt) {
        float lt = l[qt];
        lt += __shfl_xor(lt, 16);
        lt += __shfl_xor(lt, 32);
        const float sc = lt > 0.f ? gate[qt][1] / lt : 0.f;
#pragma unroll
        for (int dt = 0; dt < 4; ++dt) comb[qt][dt] += o[qt][dt] * sc;
      }
    }
    {
      float m[2] = {-1e30f, -1e30f}, l[2] = {0.f, 0.f};
      f32x4 o[2][4];
#pragma unroll
      for (int qt = 0; qt < 2; ++qt)
#pragma unroll
        for (int dt = 0; dt < 4; ++dt) o[qt][dt] = f32x4{0.f, 0.f, 0.f, 0.f};
      const int kblo = (q0 >= 511) ? ((q0 - 511) >> 6) : 0;
      uint4 rk0, rk1, rv0, rv1;
      const int lr0 = tid >> 3, lch = (tid & 7) << 3;
      int kb = kblo;
      LOADKV_(kb, C_KW, p.vtw)
#pragma unroll 1
      while (kb >= 0) {
        const int nkb = (kb < kbmax) ? kb + 1 : -1;
        __syncthreads();
        STOREKV_()
        if (nkb >= 0) { LOADKV_(nkb, C_KW, p.vtw) }
        __syncthreads();
        attn_tile<64, 2, 72, 72>(sK, sVt, qf, o, m, l, c2, lane, [&](int qt, int kl) {
          return (unsigned)(tq[qt] - (kb * 64 + kl)) < 512u;
        });
        kb = nkb;
      }
#undef LOADKV_
#undef STOREKV_
#pragma unroll
      for (int qt = 0; qt < 2; ++qt) {
        float lt = l[qt];
        lt += __shfl_xor(lt, 16);
        lt += __shfl_xor(lt, 32);
        const float sc = lt > 0.f ? gate[qt][2] / lt : 0.f;
#pragma unroll
        for (int dt = 0; dt < 4; ++dt) comb[qt][dt] += o[qt][dt] * sc;
      }
    }
#pragma unroll
    for (int qt = 0; qt < 2; ++qt) {
      const size_t tok = (size_t)b * T + tq[qt];
#pragma unroll
      for (int dt = 0; dt < 4; ++dt) {
        uint2 pk;
        pk.x = pack2(comb[qt][dt][0], comb[qt][dt][1]);
        pk.y = pack2(comb[qt][dt][2], comb[qt][dt][3]);
        *(uint2*)(p.mix + tok * LDA + 512 + h * 64 + 16 * dt + 4 * quad) = pk;
      }
    }
  }
}

template <bool RESB>
DEVI void phase_resid(const Params& p, unsigned char* smem, const u16* A, const u16* Wt, const float* res, float* ssq) {
  u16* sA = (u16*)smem; u16* sB = sA + 128 * 72;
  XCD_TILE_LOOP(idx, 256, 8) {
    GEMM_LANE_VARS
    const int mt = XCD_TILE_MT(idx, 8), nt_ = XCD_TILE_NT(idx, 8);
    const int m0 = mt * 128, n0 = nt_ * 128;
    f32x4 acc[4][4];
    gemm_mainloop<true>(tid, sA, sB, ARow{A, LDA}, Wt, LDA, m0, n0, 16, acc);
#pragma unroll
    for (int mi = 0; mi < 4; ++mi) {
      const int m = m0 + wm * 64 + 16 * mi + col;
      float ss = 0.f;
#pragma unroll
      for (int ni = 0; ni < 4; ++ni) {
        const int n = n0 + wn * 64 + 16 * ni + 4 * quad;
        const f32x4 v = acc[ni][mi];
        float4 r;
        if (RESB) {
          const uint2 rb = *(const uint2*)(p.hn + (size_t)m * LDA + n);
          r.x = __uint_as_float(rb.x << 16); r.y = __uint_as_float(rb.x & 0xffff0000u);
          r.z = __uint_as_float(rb.y << 16); r.w = __uint_as_float(rb.y & 0xffff0000u);
        } else {
          r = *(const float4*)(res + (size_t)m * D + n);
        }
        float4 hv;
        hv.x = r.x + v[0]; hv.y = r.y + v[1]; hv.z = r.z + v[2]; hv.w = r.w + v[3];
        ss += hv.x * hv.x + hv.y * hv.y + hv.z * hv.z + hv.w * hv.w;
        uint2 pk; pk.x = pack2(hv.x, hv.y); pk.y = pack2(hv.z, hv.w);
        *(uint2*)(p.hn + (size_t)m * LDA + n) = pk;
      }
      ss += __shfl_xor(ss, 16);
      ss += __shfl_xor(ss, 32);
      if (quad == 0) atomicAdd(ssq + m, ss);
    }
  }
}

DEVI void phase_scaled(const Params& p, unsigned char* smem, const u16* A, const u16* Wt, int ntn, const float* ssq, u16* outp, int ldo) {
  u16* sA = (u16*)smem; u16* sB = sA + 128 * 72;
  XCD_TILE_LOOP(idx, 256, ntn) {
    GEMM_LANE_VARS
    const int mt = XCD_TILE_MT(idx, ntn), nt_ = XCD_TILE_NT(idx, ntn);
    const int m0 = mt * 128, n0 = nt_ * 128;
    f32x4 acc[4][4];
    gemm_mainloop<true>(tid, sA, sB, ARow{A, LDA}, Wt, LDA, m0, n0, 16, acc);
#pragma unroll
    for (int mi = 0; mi < 4; ++mi) {
      const int m = m0 + wm * 64 + 16 * mi + col;
      const float rstd = rsqrtf(ssq[m] * (1.f / D) + 1e-6f);
#pragma unroll
      for (int ni = 0; ni < 4; ++ni) {
        const int n = n0 + wn * 64 + 16 * ni + 4 * quad;
        const f32x4 v = acc[ni][mi];
        uint2 pk; pk.x = pack2(v[0] * rstd, v[1] * rstd); pk.y = pack2(v[2] * rstd, v[3] * rstd);
        *(uint2*)(outp + (size_t)m * ldo + n) = pk;
      }
    }
  }
}

DEVI void phase_memattn(const Params& p, unsigned char* smem) {
  u16* sK = (u16*)smem;
  u16* sVt = (u16*)(smem + 33792);
  const float c2 = 0.0625f * 1.4426950408889634f;
#pragma unroll 1
  for (int tile = blockIdx.x; tile < 2048; tile += gridDim.x) {
    const int tid = launder(threadIdx.x), lane = tid & 63, w = tid >> 6, col = lane & 15, quad = lane >> 4;
    const int b = tile >> 7, head = (tile >> 5) & 3, q0 = (tile & 31) * 64;
    const size_t tok = (size_t)b * T + q0 + 16 * w + col;
    bf16x8 qf[1][8];
#pragma unroll
    for (int ks = 0; ks < 8; ++ks) qf[0][ks] = *(const bf16x8*)(p.qm + tok * LDA + head * 256 + 32 * ks + 8 * quad);
    float m[1] = {-1e30f}, l[1] = {0.f};
    f32x4 o[1][16];
#pragma unroll
    for (int dt = 0; dt < 16; ++dt) o[0][dt] = f32x4{0.f, 0.f, 0.f, 0.f};
    uint4 rg0, rg1, rg2, rg3, rg4, rg5, rg6, rg7;
    const int krow = tid >> 5, kch = (tid & 31) << 3;
    const int vrow = tid >> 3, vch = (tid & 7) << 3;
#define LK1_(i, kbx) rg##i = *(const uint4*)(p.memk + ((size_t)b * 256 + (kbx) * 64 + krow + 8 * i) * LDA + head * 256 + kch);
#define SK1_(i) *(uint4*)(sK + (krow + 8 * i) * 264 + kch) = rg##i;
#define LV1_(i, kbx) rg##i = *(const uint4*)(p.memvt + ((size_t)(b * 4 + head) * 256 + vrow + 32 * i) * 256 + (kbx) * 64 + vch);
#define SV1_(i) *(uint4*)(sVt + (vrow + 32 * i) * 72 + vch) = rg##i;
#define LOADK_(kbx) LK1_(0, kbx) LK1_(1, kbx) LK1_(2, kbx) LK1_(3, kbx) LK1_(4, kbx) LK1_(5, kbx) LK1_(6, kbx) LK1_(7, kbx)
#define STOREK_() SK1_(0) SK1_(1) SK1_(2) SK1_(3) SK1_(4) SK1_(5) SK1_(6) SK1_(7)
#define LOADV_(kbx) LV1_(0, kbx) LV1_(1, kbx) LV1_(2, kbx) LV1_(3, kbx) LV1_(4, kbx) LV1_(5, kbx) LV1_(6, kbx) LV1_(7, kbx)
#define STOREV_() SV1_(0) SV1_(1) SV1_(2) SV1_(3) SV1_(4) SV1_(5) SV1_(6) SV1_(7)
    __syncthreads();
    LOADK_(0)
    STOREK_()
    LOADV_(0)
    __syncthreads();
#pragma unroll 1
    for (int kb = 0; kb < 4; ++kb) {
      bf16x8 pb[1][2];
      attn_qk<256, 1, 264>(sK, qf, o, m, l, c2, lane, [&](int, int) { return true; }, pb);
      STOREV_()
      if (kb < 3) { LOADK_(kb + 1) }
      __syncthreads();
      attn_pv<256, 1, 72>(sVt, pb, o, lane);
      if (kb < 3) {
        STOREK_()
        LOADV_(kb + 1)
      }
      __syncthreads();
    }
#undef LOADK_
#undef STOREK_
#undef LOADV_
#undef STOREV_
#undef LK1_
#undef SK1_
#undef LV1_
#undef SV1_
    float lt = l[0];
    lt += __shfl_xor(lt, 16);
    lt += __shfl_xor(lt, 32);
    const float inv = 1.f / lt;
#pragma unroll
    for (int dt = 0; dt < 16; ++dt) {
      uint2 pk;
      pk.x = pack2(o[0][dt][0] * inv, o[0][dt][1] * inv);
      pk.y = pack2(o[0][dt][2] * inv, o[0][dt][3] * inv);
      *(uint2*)(p.mix + tok * LDA + head * 256 + 16 * dt + 4 * quad) = pk;
    }
  }
}

__constant__ unsigned char kCandI[64] = {0,0,0,0,0,0,0,0,0,0,0,0,0,0,0,0, 1,1,1,1,1,1,1,1, 2,2,2,2,2, 3,3,3,3, 4,4,4, 5,5, 6,6, 7,7,
                                          8, 9, 10, 11, 12, 13, 14, 15, 0,0,0,0,0,0,0,0,0,0,0,0,0,0};
__constant__ unsigned char kCandJ[64] = {0,1,2,3,4,5,6,7,8,9,10,11,12,13,14,15, 0,1,2,3,4,5,6,7, 0,1,2,3,4, 0,1,2,3, 0,1,2, 0,1, 0,1, 0,1,
                                          0, 0, 0, 0, 0, 0, 0, 0, 0,0,0,0,0,0,0,0,0,0,0,0,0,0};

DEVI unsigned score_key(float v, int idx) {
  unsigned u = __float_as_uint(v);
  u = (u & 0x80000000u) ? ~u : (u | 0x80000000u);
  return (u & ~127u) | (unsigned)(127 - idx);
}
DEVI float key_score(unsigned k) {
  k &= ~127u;
  const unsigned u = (k & 0x80000000u) ? (k & 0x7fffffffu) : ~k;
  return __uint_as_float(u);
}

DEVI void phase_peer_route(const Params& p, unsigned char* smem) {
  u16* sA = (u16*)smem; u16* sB = sA + 128 * 72;
  unsigned* sScore = (unsigned*)smem;
  unsigned* sTop = (unsigned*)(smem + 36864);
  unsigned* sTmp = (unsigned*)(smem + 53248);
  {
    const int t0_ = launder(threadIdx.x);
    const int gw = (blockIdx.x * 256 + t0_) >> 6, nw = (gridDim.x * 256) >> 6;
    conv_fp8_rows(p.peer_u, p.ub8, p.uscale, 16384, gw, nw, t0_ & 63);
    conv_fp8_rows(p.peer_v, p.vb8, p.vscale, 16384, gw, nw, t0_ & 63);
  }
#pragma unroll 1
  for (int tile = blockIdx.x; tile < 256 * 8; tile += gridDim.x) {
    GEMM_LANE_VARS
    const int mt = tile >> 3, hd = tile & 7;
    const int m0 = mt * 128;
#pragma unroll 1
    for (int ph = 0; ph < 2; ++ph) {
      const int hp = hd * 2 + ph;
      f32x4 acc[4][4];
      __syncthreads();
      gemm_mainloop<false>(tid, sA, sB, ARow{p.pq + hp * 128, LDPQ}, p.subk + (size_t)hp * 128 * 128, 128, m0, 0, 2, acc);
#pragma unroll 1
      for (int hh = 0; hh < 2; ++hh) {
        if (wm == hh) {
#pragma unroll
          for (int mi = 0; mi < 4; ++mi) {
            const int row = 16 * mi + col;
#pragma unroll
            for (int ni = 0; ni < 4; ++ni) {
              const int n = wn * 64 + 16 * ni + 4 * quad;
              const f32x4 v = acc[ni][mi];
              uint4 kk;
              kk.x = score_key(v[0], n); kk.y = score_key(v[1], n + 1);
              kk.z = score_key(v[2], n + 2); kk.w = score_key(v[3], n + 3);
              *(uint4*)(sScore + row * 132 + n) = kk;
            }
          }
        }
        __syncthreads();
#pragma unroll 1
        for (int rg = 0; rg < 4; ++rg) {
          const int rbase = w * 16 + rg * 4;
          unsigned k0[4], k1[4], t0[4], t1[4], thr[4];
#pragma unroll
          for (int r = 0; r < 4; ++r) {
            k0[r] = sScore[(rbase + r) * 132 + lane];
            k1[r] = sScore[(rbase + r) * 132 + 64 + lane];
            t0[r] = ((k0[r] >> 16) << 7) | (k0[r] & 127u);
            t1[r] = ((k1[r] >> 16) << 7) | (k1[r] & 127u);
            thr[r] = 0u;
          }
#pragma unroll
          for (int bit = 22; bit >= 0; --bit) {
#pragma unroll
            for (int r = 0; r < 4; ++r) {
              const unsigned cand = thr[r] | (1u << bit);
              const int cnt = __popcll(__ballot(t0[r] >= cand)) + __popcll(__ballot(t1[r] >= cand));
              thr[r] = (cnt >= 16) ? cand : thr[r];
            }
          }
          unsigned* tmp = sTmp + w * 64;
#pragma unroll
          for (int r = 0; r < 4; ++r) {
            const unsigned long long b0 = __ballot(t0[r] >= thr[r]), b1 = __ballot(t1[r] >= thr[r]);
            const int pos0 = __builtin_amdgcn_mbcnt_hi((unsigned)(b0 >> 32), __builtin_amdgcn_mbcnt_lo((unsigned)b0, 0u));
            const int pos1 = __popcll(b0) + __builtin_amdgcn_mbcnt_hi((unsigned)(b1 >> 32), __builtin_amdgcn_mbcnt_lo((unsigned)b1, 0u));
            if (t0[r] >= thr[r]) tmp[r * 16 + pos0] = k0[r];
            if (t1[r] >= thr[r]) tmp[r * 16 + pos1] = k1[r];
          }
          __builtin_amdgcn_fence(__ATOMIC_RELEASE, "wavefront");
          __builtin_amdgcn_wave_barrier();
          __builtin_amdgcn_fence(__ATOMIC_ACQUIRE, "wavefront");
          {
            const int r = lane >> 4, ix = lane & 15;
            const unsigned mine = tmp[r * 16 + ix];
            const uint4 a = *(const uint4*)(tmp + r * 16), b = *(const uint4*)(tmp + r * 16 + 4), c = *(const uint4*)(tmp + r * 16 + 8),
                        d = *(const uint4*)(tmp + r * 16 + 12);
            const int rk = (a.x > mine) + (a.y > mine) + (a.z > mine) + (a.w > mine) + (b.x > mine) + (b.y > mine) + (b.z > mine) + (b.w > mine) +
                           (c.x > mine) + (c.y > mine) + (c.z > mine) + (c.w > mine) + (d.x > mine) + (d.y > mine) + (d.z > mine) + (d.w > mine);
            sTop[((hh * 64 + rbase + r) * 2 + ph) * 16 + rk] = mine;
          }
          __builtin_amdgcn_fence(__ATOMIC_RELEASE, "wavefront");
          __builtin_amdgcn_wave_barrier();
        }
        __syncthreads();
      }
    }
    const int ci = kCandI[lane], cj = kCandJ[lane];
    const bool act = lane < 50;
#pragma unroll 1
    for (int tg = 0; tg < 8; ++tg) {
      const int tb = w * 32 + tg * 4;
      unsigned k0[4], k1[4], ku[4], thr[4];
      float v[4];
#pragma unroll
      for (int r = 0; r < 4; ++r) {
        k0[r] = sTop[((tb + r) * 2 + 0) * 16 + ci];
        k1[r] = sTop[((tb + r) * 2 + 1) * 16 + cj];
        v[r] = key_score(k0[r]) + key_score(k1[r]);
        unsigned u = __float_as_uint(v[r]);
        u = (u & 0x80000000u) ? ~u : (u | 0x80000000u);
        ku[r] = act ? (((u >> 16) << 6) | (unsigned)(63 - lane)) : 0u;
        thr[r] = 0u;
      }
#pragma unroll
      for (int bit = 21; bit >= 0; --bit) {
#pragma unroll
        for (int r = 0; r < 4; ++r) {
          const unsigned cand = thr[r] | (1u << bit);
          const int cnt = __popcll(__ballot(ku[r] >= cand));
          thr[r] = (cnt >= 16) ? cand : thr[r];
        }
      }
#pragma unroll
      for (int r = 0; r < 4; ++r) {
        const bool sel = act && (ku[r] >= thr[r]);
        const unsigned long long ms = __ballot(sel);
        const int slot = __builtin_amdgcn_mbcnt_hi((unsigned)(ms >> 32), __builtin_amdgcn_mbcnt_lo((unsigned)ms, 0u));
        const float vmax = __int_as_float(__builtin_amdgcn_readlane(__float_as_int(v[r]), 0));
        const float e = sel ? __expf(v[r] - vmax) : 0.f;
        const float tot = wave_sum(e);
        if (sel) {
          const int eid = (127 - (int)(k0[r] & 127u)) * 128 + (127 - (int)(k1[r] & 127u));
          const size_t o = (size_t)(m0 + tb + r) * 128 + hd * 16 + slot;
          p.experts[o] = eid;
          p.gates[o] = e / tot;
        }
      }
    }
  }
}

template <int PART>
DEVI void phase_peer_gather(const Params& p) {
  const int w0_ = threadIdx.x >> 6;
#pragma unroll 1
  for (int tok = blockIdx.x * 4 + w0_; tok < NTOK; tok += gridDim.x * 4) {
    const int tid = launder(threadIdx.x), lane = tid & 63;
    const uint4* hp4 = (const uint4*)(p.hn + (size_t)tok * LDA + lane * 16);
    float hv[16], xn[16], y[16];
    {
      const uint4 a0 = hp4[0], a1 = hp4[1];
      const unsigned hu[8] = {a0.x, a0.y, a0.z, a0.w, a1.x, a1.y, a1.z, a1.w};
#pragma unroll
      for (int i = 0; i < 8; ++i) { hv[2 * i] = __uint_as_float(hu[i] << 16); hv[2 * i + 1] = __uint_as_float(hu[i] & 0xffff0000u); }
    }
    float ss = 0.f;
#pragma unroll
    for (int i = 0; i < 16; ++i) ss += hv[i] * hv[i];
    ss = wave_sum(ss);
    const float rstd = rsqrtf(ss * (1.f / D) + 1e-6f);
    {
      const float4* g4 = (const float4*)p.peer_g + lane * 4;
      const float4 a0 = g4[0], a1 = g4[1], a2 = g4[2], a3 = g4[3];
      const float gg[16] = {a0.x, a0.y, a0.z, a0.w, a1.x, a1.y, a1.z, a1.w, a2.x, a2.y, a2.z, a2.w, a3.x, a3.y, a3.z, a3.w};
#pragma unroll
      for (int i = 0; i < 16; ++i) { xn[i] = hv[i] * rstd * gg[i]; y[i] = 0.f; }
    }
    const int e0 = p.experts[(size_t)tok * 128 + lane], e1 = p.experts[(size_t)tok * 128 + 64 + lane];
    const float g0 = p.gates[(size_t)tok * 128 + lane], g1 = p.gates[(size_t)tok * 128 + 64 + lane];
    const float su0 = p.uscale[e0], su1 = p.uscale[e1];
    const float sv0 = p.vscale[e0], sv1 = p.vscale[e1];
    float cf0 = 0.f, cf1 = 0.f, dsum = 0.f;
    uint4 ca[8], cb[8];
#define LOADB_(R, bi)                                                                                   \
    _Pragma("unroll") for (int u = 0; u < 8; ++u) {                                                       \
      const int kk_ = (((bi) & 7) << 3) + u;                                                             \
      const int e_ = __builtin_amdgcn_readlane((((bi) >> 3) & 1) ? e1 : e0, kk_);                        \
      R[u] = ((const uint4*)((((bi) >> 4) ? p.vb8 : p.ub8) + (size_t)e_ * 1024))[lane];                  \
    }
#define COMPU_(R, bi)                                                                                   \
    {                                                                                                    \
      float d8[8];                                                                                       \
      _Pragma("unroll") for (int u = 0; u < 8; ++u) {                                                     \
        const unsigned uu[4] = {R[u].x, R[u].y, R[u].z, R[u].w};                                         \
        f32x2 a2 = {0.f, 0.f};                                                                           \
        _Pragma("unroll") for (int j = 0; j < 4; ++j) {                                                   \
          const f32x2 lo = __builtin_amdgcn_cvt_pk_f32_fp8((int)uu[j], false);                           \
          const f32x2 hi = __builtin_amdgcn_cvt_pk_f32_fp8((int)uu[j], true);                            \
          a2 = xn2[2 * j] * lo + a2;                                                                     \
          a2 = xn2[2 * j + 1] * hi + a2;                                                                 \
        }                                                                                                \
        d8[u] = a2[0] + a2[1];                                                                           \
      }                                                                                                  \
          \
      float v4[4], v2[2];                                                                                \
      _Pragma("unroll") for (int i = 0; i < 4; ++i) {                                                     \
        const float snd = b5 ? d8[i] : d8[4 + i], kp = b5 ? d8[4 + i] : d8[i];                           \
        v4[i] = kp + __shfl_xor(snd, 32);                                                                \
      }                                                                                                  \
      _Pragma("unroll") for (int i = 0; i < 2; ++i) {                                                     \
        const float snd = b4 ? v4[i] : v4[2 + i], kp = b4 ? v4[2 + i] : v4[i];                           \
        v2[i] = kp + __shfl_xor(snd, 16);                                                                \
      }                                                                                                  \
      float v1;                                                                                          \
      { const float snd = b3 ? v2[0] : v2[1], kp = b3 ? v2[1] : v2[0]; v1 = kp + __shfl_xor(snd, 8); }   \
      v1 += __shfl_xor(v1, 4);                                                                           \
      v1 += __shfl_xor(v1, 2);                                                                           \
      v1 += __shfl_xor(v1, 1);                                                                           \
                \
      const float got = __shfl(v1, fsrc);                                                                \
      if ((lane >> 3) == ((bi) & 7)) dsum = got;                                                         \
    }                                                                                                    \
    if (((bi) & 7) == 7) {                                                                               \
      if (((bi) >> 3) & 1) cf1 = gelu_tanh(dsum * su1) * g1 * sv1; else cf0 = gelu_tanh(dsum * su0) * g0 * sv0; \
    }
#define COMPV_(R, bi)                                                                                   \
    _Pragma("unroll") for (int u = 0; u < 8; ++u) {                                                       \
      const int kk_ = (((bi) & 7) << 3) + u;                                                             \
      const float ck_ = __int_as_float(__builtin_amdgcn_readlane(__float_as_int((((bi) >> 3) & 1) ? cf1 : cf0), kk_)); \
      const f32x2 ck2 = {ck_, ck_};                                                                      \
      const unsigned uu[4] = {R[u].x, R[u].y, R[u].z, R[u].w};                                           \
      _Pragma("unroll") for (int j = 0; j < 4; ++j) {                                                     \
        const f32x2 lo = __builtin_amdgcn_cvt_pk_f32_fp8((int)uu[j], false);                             \
        const f32x2 hi = __builtin_amdgcn_cvt_pk_f32_fp8((int)uu[j], true);                              \
        y2[2 * j] = ck2 * lo + y2[2 * j];                                                                \
        y2[2 * j + 1] = ck2 * hi + y2[2 * j + 1];                                                        \
      }                                                                                                  \
    }
    const bool b5 = (lane & 32) != 0, b4 = (lane & 16) != 0, b3 = (lane & 8) != 0;
    const int fsrc = ((lane & 4) << 3) | ((lane & 2) << 3) | ((lane & 1) << 3);
    f32x2 xn2[8], y2[8];
#pragma unroll
    for (int i = 0; i < 8; ++i) { xn2[i] = f32x2{xn[2 * i], xn[2 * i + 1]}; y2[i] = f32x2{0.f, 0.f}; }
    if (PART == 0) {
      LOADB_(ca, 0)
#pragma unroll 1
      for (int bi = 0; bi < 16; bi += 2) {
        LOADB_(cb, bi + 1)
        COMPU_(ca, bi)
        if (bi + 2 < 16) { LOADB_(ca, bi + 2) }
        COMPU_(cb, bi + 1)
      }
      p.gates[(size_t)tok * 128 + lane] = cf0;
      p.gates[(size_t)tok * 128 + 64 + lane] = cf1;
      continue;
    }
    cf0 = g0; cf1 = g1;
    LOADB_(ca, 16)
#pragma unroll 1
    for (int bi = 16; bi < 32; bi += 2) {
      LOADB_(cb, bi + 1)
      COMPV_(ca, bi)
      if (bi + 2 < 32) { LOADB_(ca, bi + 2) }
      COMPV_(cb, bi + 1)
    }
#undef LOADB_
#undef COMPU_
#undef COMPV_
#pragma unroll
    for (int i = 0; i < 8; ++i) { y[2 * i] = y2[i][0]; y[2 * i + 1] = y2[i][1]; }
    float s2 = 0.f;
    {
      const uint4 a0 = hp4[0], a1 = hp4[1];
      const unsigned hu[8] = {a0.x, a0.y, a0.z, a0.w, a1.x, a1.y, a1.z, a1.w};
#pragma unroll
      for (int i = 0; i < 8; ++i) {
        y[2 * i] += __uint_as_float(hu[i] << 16);
        y[2 * i + 1] += __uint_as_float(hu[i] & 0xffff0000u);
        s2 += y[2 * i] * y[2 * i] + y[2 * i + 1] * y[2 * i + 1];
      }
    }
    s2 = wave_sum(s2);
    const float rs2 = rsqrtf(s2 * (1.f / D) + 1e-6f);
    {
      const float4* g4 = (const float4*)p.final_g + lane * 4;
      const float4 a0 = g4[0], a1 = g4[1], a2 = g4[2], a3 = g4[3];
      float4* o4 = (float4*)(p.out + (size_t)tok * D) + lane * 4;
      o4[0] = make_float4(y[0] * rs2 * a0.x, y[1] * rs2 * a0.y, y[2] * rs2 * a0.z, y[3] * rs2 * a0.w);
      o4[1] = make_float4(y[4] * rs2 * a1.x, y[5] * rs2 * a1.y, y[6] * rs2 * a1.z, y[7] * rs2 * a1.w);
      o4[2] = make_float4(y[8] * rs2 * a2.x, y[9] * rs2 * a2.y, y[10] * rs2 * a2.z, y[11] * rs2 * a2.w);
      o4[3] = make_float4(y[12] * rs2 * a3.x, y[13] * rs2 * a3.y, y[14] * rs2 * a3.z, y[15] * rs2 * a3.w);
    }
  }
}

#define XB_TMO      128
#define XB_XCNT(j)  (256  + 64 * (j))
#define XB_XSUB(j)  (1280 + 64 * (j))
#define XB_XGEN(j)  (2304 + 64 * (j))
#define XB_TOP      3328
#define XB_TOPGEN   3392
#define XCD_BAR_WORDS 3456
#define XB_SPIN_CAP (1u << 20)
#define LAS __attribute__((address_space(3)))
DEVI unsigned xb_ld(unsigned* q) { return __hip_atomic_load(q, __ATOMIC_RELAXED, __HIP_MEMORY_SCOPE_AGENT); }
DEVI unsigned xb_add(unsigned* q, unsigned v) { return __hip_atomic_fetch_add(q, v, __ATOMIC_RELAXED, __HIP_MEMORY_SCOPE_AGENT); }
DEVI unsigned xb_xcc_id() { return (unsigned)__builtin_amdgcn_s_getreg((3 << 11) | 20) & 0xFu; }
#define XB_SPIN(cond, bar) do { unsigned _sp = 0; while (cond) { __builtin_amdgcn_s_sleep(1); \
    if ((++_sp & 255u) == 0u) { if (xb_ld(&(bar)[XB_TMO])) break; if (_sp > XB_SPIN_CAP) { atomicAdd(&(bar)[XB_TMO], 1u); break; } } } } while (0)
struct XcdBarrier { unsigned* bar; unsigned x; volatile LAS unsigned* st; };
DEVI XcdBarrier xcd_barrier_post(unsigned* bar, volatile LAS unsigned* st) {
  XcdBarrier b; b.bar = bar; b.x = xb_xcc_id(); b.st = st;
  if (threadIdx.x == 0) (void)xb_add(&bar[XB_XCNT(b.x)], 1u);
  return b;
}
DEVI void xcd_barrier_complete(unsigned* bar, unsigned x, unsigned& nloc, unsigned& nx) {
  const unsigned G = gridDim.x * gridDim.y * gridDim.z;
  unsigned sum, cnt, mine, sp = 0u;
  for (;;) {
    sum = 0u; cnt = 0u; mine = 0u;
#pragma unroll
    for (unsigned j = 0; j < 16; ++j) { const unsigned c = xb_ld(&bar[XB_XCNT(j)]); sum += c; cnt += (c > 0u) ? 1u : 0u; mine = (j == x) ? c : mine; }
    if (sum == G) break;
    __builtin_amdgcn_s_sleep(1);
    if ((++sp & 255u) == 0u) { if (xb_ld(&bar[XB_TMO])) break; if (sp > XB_SPIN_CAP) { atomicAdd(&bar[XB_TMO], 1u); break; } }
  }
  nloc = mine > 0u ? mine : 1u; nx = cnt > 0u ? cnt : 1u;
}
DEVI void xcd_barrier(const XcdBarrier& b) {
  asm volatile("s_waitcnt vmcnt(0)" ::: "memory");
  __syncthreads();
  if (threadIdx.x == 0) {
    unsigned* bar = b.bar;
    __builtin_amdgcn_s_waitcnt(0);
    unsigned nloc = b.st[0], nx = b.st[1];
    if (nloc == 0u) { xcd_barrier_complete(bar, b.x, nloc, nx); b.st[0] = nloc; b.st[1] = nx; }
    const unsigned old = xb_add(&bar[XB_XSUB(b.x)], 1u);
    const unsigned gen = old / nloc;
    if (old + 1u == (gen + 1u) * nloc) {
      __builtin_amdgcn_fence(__ATOMIC_RELEASE, "agent");
      asm volatile("s_waitcnt vmcnt(0)" ::: "memory");
      const unsigned og = xb_add(&bar[XB_TOP], 1u);
      const unsigned tg = og / nx;
      if (og + 1u == (tg + 1u) * nx) xb_add(&bar[XB_TOPGEN], 1u);
      else XB_SPIN(xb_ld(&bar[XB_TOPGEN]) == tg, bar);
      __builtin_amdgcn_fence(__ATOMIC_ACQUIRE, "agent");
      xb_add(&bar[XB_XGEN(b.x)], 1u);
      asm volatile("s_waitcnt vmcnt(0)" ::: "memory");
    } else {
      XB_SPIN(xb_ld(&bar[XB_XGEN(b.x)]) == gen, bar);
      __builtin_amdgcn_fence(__ATOMIC_ACQUIRE, "agent");
      asm volatile("s_waitcnt vmcnt(0)" ::: "memory");
    }
  }
  __syncthreads();
}

template <bool COOP>
__global__ void __launch_bounds__(256, 2) mega(Params p, int ph_lo, int ph_hi) {
  __shared__ __attribute__((aligned(16))) unsigned char smem[SMEM_BYTES];
  __shared__ uint4 xb_words;
  if (threadIdx.x == 0) xb_words = make_uint4(0u, 0u, 0u, 0u);
  __syncthreads();
  XcdBarrier xb = xcd_barrier_post(p.bar, (volatile LAS unsigned*)&xb_words);
  (void)xb;
  if (COOP && ph_hi > 1000) cg::this_grid().sync();
#ifdef REPEAT_MASK
#define RUN_PHASE(i, call)                                                                   \
  if (ph_lo <= (i) && (i) <= ph_hi) {                                                        \
    call;                                                                                    \
    if (COOP && ((REPEAT_MASK >> (i)) & 1)) { xcd_barrier(xb); call; }                       \
    if (COOP && (i) < ph_hi) xcd_barrier(xb);                                                \
  }
#else
#define RUN_PHASE(i, call)                                                                   \
  if (ph_lo <= (i) && (i) <= ph_hi) {                                                        \
    call;                                                                                    \
    if (COOP && (i) < ph_hi) {                                                               \
      xcd_barrier(xb);                                                                       \
    }                                                                                        \
  }
#endif
  RUN_PHASE(0, phase0(p))
  RUN_PHASE(1, phase1(p, smem))
  RUN_PHASE(2, phase2(p, smem))
  RUN_PHASE(4, phase_nsa(p, smem))
  RUN_PHASE(5, phase_resid<false>(p, smem, p.mix, p.woutT, p.x, p.ssq1))
  RUN_PHASE(6, phase_scaled(p, smem, p.hn, p.wmqT, 8, p.ssq1, p.qm, LDA))
  RUN_PHASE(7, phase_memattn(p, smem))
  RUN_PHASE(8, phase_resid<true>(p, smem, p.mix, p.wmoT, nullptr, p.ssq2))
  RUN_PHASE(9, phase_scaled(p, smem, p.hn, p.wpqT, 16, p.ssq2, p.pq, LDPQ))
  RUN_PHASE(10, phase_peer_route(p, smem))
  RUN_PHASE(11, phase_peer_gather<0>(p))
  RUN_PHASE(12, phase_peer_gather<1>(p))
#undef RUN_PHASE
}

extern "C" void kernel_launch(void* const* d_in, const int* in_sizes, int n_in, void* d_out, int out_size, void* d_ws,
                              size_t ws_size, hipStream_t stream) {
  (void)in_sizes; (void)n_in; (void)out_size; (void)ws_size;
  Params p{};
  p.x = (const float*)d_in[0]; p.mem = (const float*)d_in[1]; p.pos = (const int*)d_in[2];
  p.mix_g = (const float*)d_in[3]; p.w_in = (const float*)d_in[4]; p.conv_w = (const float*)d_in[5];
  p.conv_b = (const float*)d_in[6]; p.ln_g = (const float*)d_in[7]; p.ln_b = (const float*)d_in[8];
  p.cmp_pos = (const float*)d_in[9]; p.cmp_w1 = (const float*)d_in[10]; p.cmp_b1 = (const float*)d_in[11];
  p.cmp_w2 = (const float*)d_in[12]; p.cmp_b2 = (const float*)d_in[13]; p.w_out = (const float*)d_in[14];
  p.memq_g = (const float*)d_in[15]; p.memkv_g = (const float*)d_in[16]; p.w_mq = (const float*)d_in[17];
  p.w_mk = (const float*)d_in[18]; p.w_mv = (const float*)d_in[19]; p.w_mo = (const float*)d_in[20];
  p.peer_g = (const float*)d_in[21]; p.peer_wq = (const float*)d_in[22]; p.peer_sk = (const float*)d_in[23];
  p.peer_u = (const float*)d_in[24]; p.peer_v = (const float*)d_in[25]; p.final_g = (const float*)d_in[26];
  p.out = (float*)d_out;
  unsigned char* ws = (unsigned char*)d_ws;
  size_t off = 0;
  auto take = [&](size_t bytes) { unsigned char* r = ws + off; off += (bytes + 255) & ~(size_t)255; return r; };
  unsigned char* regA = take((size_t)NTOK * LDA * 2);
  unsigned char* regB = take((size_t)NTOK * LDP * 2);
  unsigned char* regC = take((size_t)NTOK * LDA * 2);
  p.hn = (u16*)regA;
  p.proj = (u16*)regB; p.qm = (u16*)regB; p.pq = (u16*)regB;
  p.mix = (u16*)regC; p.experts = (int*)regC; p.gates = (float*)(regC + (size_t)NTOK * 128 * 4);
  {
    unsigned char* tb = regC + (size_t)2 * NTOK * 128 * 4;
    p.ub8 = tb; p.vb8 = tb + (size_t)16384 * 1024;
    p.uscale = (float*)(tb + (size_t)2 * 16384 * 1024); p.vscale = p.uscale + 16384;
  }
  p.h = nullptr;
  p.vts = (u16*)take((size_t)Bn * 2 * 64 * LDT * 2);
  p.vtw = (u16*)take((size_t)Bn * 2 * 64 * LDT * 2);
  p.memn = (u16*)take((size_t)Bn * 256 * LDA * 2);
  p.memk = (u16*)take((size_t)Bn * 256 * LDA * 2);
  p.memvt = (u16*)take((size_t)Bn * 256 * D * 2);
  p.winT = (u16*)take((size_t)2432 * LDA * 2);
  p.woutT = (u16*)take((size_t)1024 * LDA * 2);
  p.wmqT = (u16*)take((size_t)1024 * LDA * 2);
  p.wmkT = (u16*)take((size_t)1024 * LDA * 2);
  p.wmvT = (u16*)take((size_t)1024 * LDA * 2);
  p.wmoT = (u16*)take((size_t)1024 * LDA * 2);
  p.wpqT = (u16*)take((size_t)2048 * LDA * 2);
  p.subk = (u16*)take((size_t)16 * 128 * 128 * 2);
  p.w1T = (u16*)take((size_t)2 * 128 * LDW1 * 2);
  p.w2T = (u16*)take((size_t)2 * 128 * 128 * 2);
  p.biasp = (float*)take(256 * 4);
  p.rope = (float*)take((size_t)NTOK * 16 * 4);
  p.hdn = (u16*)take((size_t)2 * 4096 * 128 * 2);
  p.kc = (u16*)take((size_t)Bn * 2 * 128 * 64 * 2);
  p.vcT = (u16*)take((size_t)Bn * 2 * 64 * 128 * 2);
  p.ssq1 = (float*)take((size_t)NTOK * 4);
  p.ssq2 = (float*)take((size_t)NTOK * 4);
  p.bar = (unsigned*)take(16384);
  if (off > ws_size) { fprintf(stderr, "workspace too small: need %zu have %zu\n", off, ws_size); return; }

#if COOP_MODE
  static int grid_blocks = 0;
  if (!grid_blocks) {
    int dev = 0, cus = 0, per_cu = 0;
    hipGetDevice(&dev);
    hipDeviceGetAttribute(&cus, hipDeviceAttributeMultiprocessorCount, dev);
    hipOccupancyMaxActiveBlocksPerMultiprocessor(&per_cu, mega<true>, 256, 0);
    if (per_cu > 2) per_cu = 2;
    if (per_cu < 1) per_cu = 1;
    grid_blocks = cus * per_cu;
  }
  int lo = 0, hi = NPHASE;
  void* args[] = {&p, &lo, &hi};
  (void)hipMemsetAsync(p.bar, 0, 16384, stream);
  hipError_t e = hipLaunchCooperativeKernel((void*)mega<true>, dim3(grid_blocks), dim3(256), args, 0, stream);
  if (e != hipSuccess) fprintf(stderr, "cooperative launch failed: %s (grid %d)\n", hipGetErrorString(e), grid_blocks);
#else
  for (int ph = 0; ph <= NPHASE; ++ph) mega<false><<<dim3(512), dim3(256), 0, stream>>>(p, ph, ph);
#endif
}
```

```cpp
#include <hip/hip_runtime.h>
#include <hip/hip_bf16.h>
#include <hip/hip_cooperative_groups.h>
#include <cstdio>
#include <cstdint>
namespace cg = cooperative_groups;

#ifndef COOP_MODE
#define COOP_MODE 1
#endif

typedef __attribute__((ext_vector_type(8))) short bf16x8;
typedef __attribute__((ext_vector_type(4))) short bf16x4;
typedef __attribute__((ext_vector_type(4))) float f32x4;
typedef unsigned short u16;

#define DEVI __device__ __forceinline__

constexpr int Bn = 16, T = 2048, D = 1024, NTOK = Bn * T, LDP = 2336;
constexpr int C_Q = 1024, C_KC = 1536, C_VC = 1664, C_KS = 1792, C_VS = 1920, C_KW = 2048, C_VW = 2176, C_GATE = 2304;
constexpr int SMEM_BYTES = 73728;
constexpr int LDA = 1088;
constexpr int LDHF = 1056;
constexpr int LDPQ = 2112;
constexpr int LDW1 = 2112;
constexpr int LDT = 2112;
constexpr int NPHASE = 12;

struct Params {
  const float* x; const float* mem; const int* pos; const float* mix_g; const float* w_in;
  const float* conv_w; const float* conv_b; const float* ln_g; const float* ln_b;
  const float* cmp_pos; const float* cmp_w1; const float* cmp_b1; const float* cmp_w2; const float* cmp_b2;
  const float* w_out; const float* memq_g; const float* memkv_g; const float* w_mq; const float* w_mk;
  const float* w_mv; const float* w_mo; const float* peer_g; const float* peer_wq; const float* peer_sk;
  const float* peer_u; const float* peer_v; const float* final_g;
  float* out;
  u16* hn; u16* proj; u16* mix; float* h; u16* vts; u16* vtw; u16* memn; u16* memk; u16* memvt;
  u16* winT; u16* woutT; u16* wmqT; u16* wmkT; u16* wmvT; u16* wmoT; u16* wpqT; u16* subk; u16* w1T; u16* w2T;
  float* biasp; float* rope; u16* hdn; u16* kc; u16* vcT; float* ssq1; float* ssq2;
  int* experts; float* gates; unsigned char* ub8; unsigned char* vb8; float* uscale; float* vscale; u16* qm; u16* pq;
  unsigned* bar;
};

DEVI int launder(int x) { asm volatile("" : "+v"(x)); return x; }
DEVI u16 f2bf(float f) {
  unsigned u = __float_as_uint(f);
  u += 0x7fffu + ((u >> 16) & 1u);
  return (u16)(u >> 16);
}
DEVI float bf2f(u16 h) { return __uint_as_float(((unsigned)h) << 16); }
DEVI unsigned pack2(float a, float b) { return (unsigned)f2bf(a) | ((unsigned)f2bf(b) << 16); }
DEVI float wave_sum(float v) {
#pragma unroll
  for (int o = 32; o; o >>= 1) v += __shfl_xor(v, o);
  return v;
}
DEVI float sigmoidf_(float x) { return 1.f / (1.f + __expf(-x)); }
DEVI float gelu_tanh(float x) {
  float u = 0.7978845608028654f * (x + 0.044715f * x * x * x);
  return 0.5f * x * (1.f + tanhf(u));
}
DEVI f32x4 mfma16(bf16x8 a, bf16x8 b, f32x4 c) { return __builtin_amdgcn_mfma_f32_16x16x32_bf16(a, b, c, 0, 0, 0); }
DEVI float fexp2(float x) { return __builtin_amdgcn_exp2f(x); }

DEVI void tconv(const float* __restrict__ src, int K, int N, u16* __restrict__ dst, int Npad, int ldd,
                const float* __restrict__ gain, int gtid, int gsz) {
  const int items = Npad * (K >> 3);
  for (int it = gtid; it < items; it += gsz) {
    const int n = it % Npad, kc = it / Npad;
    float f[8];
#pragma unroll
    for (int j = 0; j < 8; ++j) {
      float v = 0.f;
      if (n < N) {
        v = src[(size_t)(kc * 8 + j) * N + n];
        if (gain) v *= gain[kc * 8 + j];
      }
      f[j] = v;
    }
    uint4 pk;
    pk.x = pack2(f[0], f[1]); pk.y = pack2(f[2], f[3]); pk.z = pack2(f[4], f[5]); pk.w = pack2(f[6], f[7]);
    *(uint4*)(dst + (size_t)n * ldd + kc * 8) = pk;
  }
}

DEVI void conv_flat(const float* __restrict__ src, u16* __restrict__ dst, size_t n8, size_t gtid, size_t gsz) {
  for (size_t it = gtid; it < n8; it += gsz) {
    const float4 a = ((const float4*)src)[2 * it], b = ((const float4*)src)[2 * it + 1];
    uint4 pk;
    pk.x = pack2(a.x, a.y); pk.y = pack2(a.z, a.w); pk.z = pack2(b.x, b.y); pk.w = pack2(b.z, b.w);
    ((uint4*)dst)[it] = pk;
  }
}


typedef float f32x2 __attribute__((ext_vector_type(2)));
DEVI unsigned pk4_fp8(float a, float b, float c, float d) {
  int v = 0;
  v = __builtin_amdgcn_cvt_pk_fp8_f32(a, b, v, false);
  v = __builtin_amdgcn_cvt_pk_fp8_f32(c, d, v, true);
  return (unsigned)v;
}
DEVI void conv_fp8_rows(const float* __restrict__ src, unsigned char* __restrict__ dst, float* __restrict__ inv_scale,
                        int rows, int gw, int nw, int lane) {
  for (int r0 = gw; r0 < rows; r0 += 2 * nw) {
    const int r1 = r0 + nw;
    const bool has1 = r1 < rows;
    const float4* p0 = (const float4*)(src + (size_t)r0 * 1024) + lane * 4;
    const float4* p1 = (const float4*)(src + (size_t)(has1 ? r1 : r0) * 1024) + lane * 4;
    float4 v[2][4];
#pragma unroll
    for (int i = 0; i < 4; ++i) { v[0][i] = p0[i]; v[1][i] = p1[i]; }
    float mx[2];
#pragma unroll
    for (int q = 0; q < 2; ++q) {
      float m = 0.f;
#pragma unroll
      for (int i = 0; i < 4; ++i)
        m = fmaxf(m, fmaxf(fmaxf(fabsf(v[q][i].x), fabsf(v[q][i].y)), fmaxf(fabsf(v[q][i].z), fabsf(v[q][i].w))));
      mx[q] = m;
    }
#pragma unroll
    for (int o = 32; o; o >>= 1) { mx[0] = fmaxf(mx[0], __shfl_xor(mx[0], o)); mx[1] = fmaxf(mx[1], __shfl_xor(mx[1], o)); }
#pragma unroll
    for (int q = 0; q < 2; ++q) {
      if (q == 1 && !has1) break;
      const int r = q ? r1 : r0;
      const float sc = mx[q] > 0.f ? 224.f / mx[q] : 1.f;
      if (lane == 0) inv_scale[r] = mx[q] > 0.f ? mx[q] * (1.f / 224.f) : 1.f;
      uint4 o4;
      o4.x = pk4_fp8(v[q][0].x * sc, v[q][0].y * sc, v[q][0].z * sc, v[q][0].w * sc);
      o4.y = pk4_fp8(v[q][1].x * sc, v[q][1].y * sc, v[q][1].z * sc, v[q][1].w * sc);
      o4.z = pk4_fp8(v[q][2].x * sc, v[q][2].y * sc, v[q][2].z * sc, v[q][2].w * sc);
      o4.w = pk4_fp8(v[q][3].x * sc, v[q][3].y * sc, v[q][3].z * sc, v[q][3].w * sc);
      ((uint4*)(dst + (size_t)r * 1024))[lane] = o4;
    }
  }
}

DEVI void rownorm_bf16(const float* __restrict__ src, const float* __restrict__ g, u16* __restrict__ dst,
                       int rows, int gw, int nw, int lane) {
  for (int r0 = gw; r0 < rows; r0 += 2 * nw) {
    const int r1 = r0 + nw;
    const bool has1 = r1 < rows;
    const float4* pa = (const float4*)(src + (size_t)r0 * D);
    const float4* pb = (const float4*)(src + (size_t)(has1 ? r1 : r0) * D);
    float4 va[4], vb[4];
    float sa = 0.f, sb = 0.f;
#pragma unroll
    for (int i = 0; i < 4; ++i) { va[i] = pa[lane + 64 * i]; vb[i] = pb[lane + 64 * i]; }
#pragma unroll
    for (int i = 0; i < 4; ++i) {
      sa += va[i].x * va[i].x + va[i].y * va[i].y + va[i].z * va[i].z + va[i].w * va[i].w;
      sb += vb[i].x * vb[i].x + vb[i].y * vb[i].y + vb[i].z * vb[i].z + vb[i].w * vb[i].w;
    }
#pragma unroll
    for (int o = 32; o; o >>= 1) { sa += __shfl_xor(sa, o); sb += __shfl_xor(sb, o); }
    const float ra = rsqrtf(sa * (1.f / D) + 1e-6f), rb = rsqrtf(sb * (1.f / D) + 1e-6f);
#pragma unroll
    for (int i = 0; i < 4; ++i) {
      const float4 gg = ((const float4*)g)[lane + 64 * i];
      uint2 pk;
      pk.x = pack2(va[i].x * ra * gg.x, va[i].y * ra * gg.y);
      pk.y = pack2(va[i].z * ra * gg.z, va[i].w * ra * gg.w);
      *(uint2*)(dst + (size_t)r0 * LDA + (size_t)(lane + 64 * i) * 4) = pk;
      if (has1) {
        pk.x = pack2(vb[i].x * rb * gg.x, vb[i].y * rb * gg.y);
        pk.y = pack2(vb[i].z * rb * gg.z, vb[i].w * rb * gg.w);
        *(uint2*)(dst + (size_t)r1 * LDA + (size_t)(lane + 64 * i) * 4) = pk;
      }
    }
  }
}

DEVI void phase0(const Params& p) {
  const int tid = launder(threadIdx.x), lane = tid & 63;
  const int gtid = blockIdx.x * 256 + tid, gsz = gridDim.x * 256;
  const int gw = gtid >> 6, nw = gsz >> 6;
  rownorm_bf16(p.x, p.mix_g, p.hn, NTOK, gw, nw, lane);
  rownorm_bf16(p.mem, p.memkv_g, p.memn, Bn * 256, gw, nw, lane);
  tconv(p.w_in, 1024, 2328, p.winT, 2432, LDA, nullptr, gtid, gsz);
  tconv(p.w_out, 1024, 1024, p.woutT, 1024, LDA, nullptr, gtid, gsz);
  tconv(p.w_mq, 1024, 1024, p.wmqT, 1024, LDA, p.memq_g, gtid, gsz);
  tconv(p.w_mk, 1024, 1024, p.wmkT, 1024, LDA, nullptr, gtid, gsz);
  tconv(p.w_mv, 1024, 1024, p.wmvT, 1024, LDA, nullptr, gtid, gsz);
  tconv(p.w_mo, 1024, 1024, p.wmoT, 1024, LDA, nullptr, gtid, gsz);
  tconv(p.peer_wq, 1024, 2048, p.wpqT, 2048, LDA, p.peer_g, gtid, gsz);
  tconv(p.cmp_w1, 2048, 128, p.w1T, 128, LDW1, nullptr, gtid, gsz);
  tconv(p.cmp_w1 + 2048 * 128, 2048, 128, p.w1T + 128 * LDW1, 128, LDW1, nullptr, gtid, gsz);
  tconv(p.cmp_w2, 128, 64, p.w2T, 128, 128, nullptr, gtid, gsz);
  tconv(p.cmp_w2 + 128 * 64, 128, 64, p.w2T + 128 * 128, 128, 128, nullptr, gtid, gsz);
  conv_flat(p.peer_sk, p.subk, (size_t)16 * 128 * 128 / 8, gtid, gsz);
  for (int it = gtid; it < NTOK * 8; it += gsz) {
    const int tok = it >> 3, i = it & 7;
    const float inv = (i == 0) ? 1.000000000e+00f : (i == 1) ? 1.939227432e-01f : (i == 2) ? 3.760603070e-02f : (i == 3) ? 7.292664610e-03f : (i == 4) ? 1.414213562e-03f : (i == 5) ? 2.742481884e-04f : (i == 6) ? 5.318295734e-05f : 1.031338525e-05f;
    const float ang = (float)p.pos[tok] * inv;
    float sv, cv;
    sincosf(ang, &sv, &cv);
    p.rope[tok * 16 + i] = cv;
    p.rope[tok * 16 + 8 + i] = sv;
  }
  for (int o = gw; o < 256; o += nw) {
    const int ty = o >> 7, n = o & 127;
    float s = 0.f;
#pragma unroll 8
    for (int k = lane; k < 2048; k += 64)
      s += p.cmp_pos[ty * 2048 + k] * p.cmp_w1[((size_t)ty * 2048 + k) * 128 + n];
    s = wave_sum(s);
    if (lane == 0) p.biasp[o] = s + p.cmp_b1[o];
  }
  for (int it = gtid; it < NTOK; it += gsz) { p.ssq1[it] = 0.f; p.ssq2[it] = 0.f; }
}

template <bool DB, class AF>
DEVI void gemm_mainloop(int tid, u16* sA, u16* sB, AF af, const u16* __restrict__ Bt, int ldb, int m0, int n0, int nk,
                        f32x4 (&acc)[4][4]) {
  const int lane = tid & 63, w = tid >> 6;
  const int wm = w >> 1, wn = w & 1, col = lane & 15, quad = lane >> 4;
#pragma unroll
  for (int i = 0; i < 4; ++i)
#pragma unroll
    for (int j = 0; j < 4; ++j) acc[i][j] = f32x4{0.f, 0.f, 0.f, 0.f};
  uint4 ra0, ra1, ra2, ra3, rb0, rb1, rb2, rb3;
  const int lrow = tid >> 3, lkc = (tid & 7) << 3;
  const u16* bbase = Bt + (size_t)(n0 + lrow) * ldb + lkc;
#define GL_(R, i, kk)                                                     \
  R##a##i = *(const uint4*)af(m0 + lrow + 32 * i, (kk) + lkc);            \
  R##b##i = *(const uint4*)(bbase + (size_t)(32 * i) * ldb + (kk));
#define SS_(R, i, off)                                                    \
  *(uint4*)(sA + (off) + (lrow + 32 * i) * 72 + lkc) = R##a##i;           \
  *(uint4*)(sB + (off) + (lrow + 32 * i) * 72 + lkc) = R##b##i;
#define GL4_(R, kk) GL_(R, 0, kk) GL_(R, 1, kk) GL_(R, 2, kk) GL_(R, 3, kk)
#define SS4_(R, off) SS_(R, 0, off) SS_(R, 1, off) SS_(R, 2, off) SS_(R, 3, off)
#define COMPUTE_(cur)                                                                                                   \
  _Pragma("unroll") for (int ks = 0; ks < 2; ++ks) {                                                                    \
    bf16x8 fa[4], fb[4];                                                                                                \
    _Pragma("unroll") for (int mi = 0; mi < 4; ++mi)                                                                    \
      fa[mi] = *(const bf16x8*)(sA + (cur) + (wm * 64 + 16 * mi + col) * 72 + 32 * ks + 8 * quad);                      \
    _Pragma("unroll") for (int ni = 0; ni < 4; ++ni)                                                                    \
      fb[ni] = *(const bf16x8*)(sB + (cur) + (wn * 64 + 16 * ni + col) * 72 + 32 * ks + 8 * quad);                      \
    _Pragma("unroll") for (int ni = 0; ni < 4; ++ni)                                                                    \
      _Pragma("unroll") for (int mi = 0; mi < 4; ++mi) acc[ni][mi] = mfma16(fb[ni], fa[mi], acc[ni][mi]);               \
  }
  if (DB) {
    const int srow = 8 * w + (lane >> 3);
    const int spc = lane & 7;
#define STAGE_(st, kk)                                                                                         \
    _Pragma("unroll") for (int i = 0; i < 4; ++i) {                                                            \
      const int r_ = 32 * i + srow;                                                                            \
      const int c_ = (spc ^ ((r_ >> 1) & 7)) << 3;                                                             \
      __builtin_amdgcn_global_load_lds((const unsigned*)af(m0 + r_, (kk) + c_),                                \
                                       (unsigned*)(sA + (st) * 16384 + (32 * i + 8 * w) * 64), 16, 0, 0);      \
      __builtin_amdgcn_global_load_lds((const unsigned*)(Bt + (size_t)(n0 + r_) * ldb + (kk) + c_),            \
                                       (unsigned*)(sA + (st) * 16384 + 8192 + (32 * i + 8 * w) * 64), 16, 0, 0); \
    }
#define COMPUTE_SW_(st)                                                                                                 \
  _Pragma("unroll") for (int ks = 0; ks < 2; ++ks) {                                                                    \
    bf16x8 fa[4], fb[4];                                                                                                \
    const int pc_ = ((4 * ks + quad) ^ ((col >> 1) & 7)) << 3;                                                          \
    _Pragma("unroll") for (int mi = 0; mi < 4; ++mi)                                                                    \
      fa[mi] = *(const bf16x8*)(sA + (st) * 16384 + (wm * 64 + 16 * mi + col) * 64 + pc_);                              \
    _Pragma("unroll") for (int ni = 0; ni < 4; ++ni)                                                                    \
      fb[ni] = *(const bf16x8*)(sA + (st) * 16384 + 8192 + (wn * 64 + 16 * ni + col) * 64 + pc_);                       \
    __builtin_amdgcn_s_setprio(1);                                                                                      \
    _Pragma("unroll") for (int ni = 0; ni < 4; ++ni)                                                                    \
      _Pragma("unroll") for (int mi = 0; mi < 4; ++mi) acc[ni][mi] = mfma16(fb[ni], fa[mi], acc[ni][mi]);               \
    __builtin_amdgcn_s_setprio(0);                                                                                      \
  }
    STAGE_(0, 0)
#pragma unroll 1
    for (int kt = 0; kt < nk; kt += 2) {
      asm volatile("s_waitcnt vmcnt(0)" ::: "memory");
      __syncthreads();
      { const int kk = (kt + 1) * 64; STAGE_(1, kk) }
      COMPUTE_SW_(0)
      asm volatile("s_waitcnt vmcnt(0)" ::: "memory");
      __syncthreads();
      if (kt + 2 < nk) { const int kk = (kt + 2) * 64; STAGE_(0, kk) }
      COMPUTE_SW_(1)
    }
#undef STAGE_
#undef COMPUTE_SW_
  } else {
    GL4_(r, 0)
    SS4_(r, 0)
    __syncthreads();
#pragma unroll 1
    for (int kt = 0; kt < nk; ++kt) {
      const bool more = (kt + 1 < nk);
      if (more) { const int kk = (kt + 1) * 64; GL4_(r, kk) }
      COMPUTE_(0)
      __syncthreads();
      if (more) {
        SS4_(r, 0)
        __syncthreads();
      }
    }
  }
#undef GL_
#undef SS_
#undef GL4_
#undef SS4_
#undef COMPUTE_
}

struct ARow {
  const u16* base; int lda;
  DEVI const u16* operator()(int m, int k) const { return base + (size_t)m * lda + k; }
};
struct ACmp {
  const u16* proj; int colbase;
  DEVI const u16* operator()(int rr, int k) const {
    const int b = rr >> 8, g = (rr >> 7) & 1;
    int c = rr & 127; c = c > 126 ? 126 : c;
    const int l = k >> 6, d = k & 63;
    return proj + ((size_t)b * T + 16 * c + l) * LDP + colbase + g * 64 + d;
  }
};


#define XCD_TILE_LOOP(idx, MT, NT)                                                                     \
  const bool sw_ = (gridDim.x & 7) == 0;                                                               \
  const int xcd_ = blockIdx.x & 7;                                                                     \
  const int tstart_ = sw_ ? (int)(blockIdx.x >> 3) : (int)blockIdx.x;                                  \
  const int tstep_ = sw_ ? (int)(gridDim.x >> 3) : (int)gridDim.x;                                     \
  const int ttotal_ = sw_ ? ((MT) / 8) * (NT) : (MT) * (NT);                                           \
  _Pragma("unroll 1") for (int idx = tstart_; idx < ttotal_; idx += tstep_)
#define XCD_TILE_MT(idx, NT) (sw_ ? ((idx) / (NT)) * 8 + xcd_ : (idx) / (NT))
#define XCD_TILE_NT(idx, NT) ((idx) % (NT))

#define GEMM_LANE_VARS                                                    \
  const int tid = launder(threadIdx.x), lane = tid & 63, w = tid >> 6;    \
  const int wm = w >> 1, wn = w & 1, col = lane & 15, quad = lane >> 4;   \
  (void)wm; (void)wn; (void)col; (void)quad;

DEVI void phase1(const Params& p, unsigned char* smem) {
  u16* sA = (u16*)smem; u16* sB = sA + 128 * 72;
  XCD_TILE_LOOP(idx, 256 + 32, 19) {
    GEMM_LANE_VARS
    f32x4 acc[4][4];
    const int mt = XCD_TILE_MT(idx, 19), nt_ = XCD_TILE_NT(idx, 19);
    if (mt < 256) {
      const int m0 = mt * 128, n0 = nt_ * 128;
      gemm_mainloop<true>(tid, sA, sB, ARow{p.hn, LDA}, p.winT, LDA, m0, n0, 16, acc);
#pragma unroll
      for (int mi = 0; mi < 4; ++mi) {
        const int m = m0 + wm * 64 + 16 * mi + col;
        const int b = m >> 11, t = m & 2047;
#pragma unroll
        for (int ni = 0; ni < 4; ++ni) {
          const int nt = n0 + wn * 64 + 16 * ni;
          const int n = nt + 4 * quad;
          f32x4 v = acc[ni][mi];
          if (nt >= LDP) continue;
          if ((nt >= C_VS && nt < C_KW) || (nt >= C_VW && nt < C_GATE)) {
            const bool isw = nt >= C_VW;
            const int off = n - (isw ? C_VW : C_VS);
            const int g = off >> 6, d = off & 63;
            u16* dst = (isw ? p.vtw : p.vts) + ((size_t)(b * 2 + g) * 64 + d) * LDT + t;
#pragma unroll
            for (int r = 0; r < 4; ++r) dst[(size_t)r * LDT] = f2bf(v[r]);
          } else {
            const bool rope_tile = ((nt >= C_KS && nt < C_VS) || (nt >= C_KW && nt < C_VW)) && ((nt & 63) == 0);
            if (rope_tile) {
#pragma unroll
              for (int r = 0; r < 4; ++r) {
                const float pr = __shfl_xor(v[r], 32);
                const int i = ((quad & 1) << 2) + r;
                const float cs = p.rope[(size_t)m * 16 + i], sn = p.rope[(size_t)m * 16 + 8 + i];
                v[r] = (quad < 2) ? (v[r] * cs - pr * sn) : (v[r] * cs + pr * sn);
              }
            }
            uint2 pk; pk.x = pack2(v[0], v[1]); pk.y = pack2(v[2], v[3]);
            *(uint2*)(p.proj + (size_t)m * LDP + n) = pk;
          }
        }
      }
    } else if (nt_ < 16) {
      const int isv = nt_ >> 3;
      const int m0 = (mt - 256) * 128, n0 = (nt_ & 7) * 128;
      gemm_mainloop<true>(tid, sA, sB, ARow{p.memn, LDA}, isv ? p.wmvT : p.wmkT, LDA, m0, n0, 16, acc);
#pragma unroll
      for (int mi = 0; mi < 4; ++mi) {
        const int m = m0 + wm * 64 + 16 * mi + col;
        const int b = m >> 8, key = m & 255;
#pragma unroll
        for (int ni = 0; ni < 4; ++ni) {
          const int n = n0 + wn * 64 + 16 * ni + 4 * quad;
          const f32x4 v = acc[ni][mi];
          if (isv) {
            const int head = n >> 8, d = n & 255;
            u16* dst = p.memvt + ((size_t)(b * 4 + head) * 256 + d) * 256 + key;
#pragma unroll
            for (int r = 0; r < 4; ++r) dst[r * 256] = f2bf(v[r]);
          } else {
            uint2 pk; pk.x = pack2(v[0], v[1]); pk.y = pack2(v[2], v[3]);
            *(uint2*)(p.memk + (size_t)m * LDA + n) = pk;
          }
        }
      }
    }
  }
}

DEVI void conv_tile(const Params& p, unsigned char* smem, int ct) {
  u16* sU = (u16*)smem;
  float2* sRed = (float2*)(smem + 62 * 512 * 2);
  const int tid = launder(threadIdx.x), lane = tid & 63, w = tid >> 6;
  const int b = ct >> 6, t0 = (ct & 63) * 32;
  __syncthreads();
  for (int it = tid; it < 62 * 64; it += 256) {
    const int r = it >> 6, c8 = it & 63;
    const int t = t0 - 30 + r;
    uint4 pk = {0u, 0u, 0u, 0u};
    if (t >= 0) {
      const u16* src = p.proj + ((size_t)b * T + t) * LDP + c8 * 8;
      const uint4 a = *(const uint4*)src, bb = *(const uint4*)(src + 512);
      const unsigned au[4] = {a.x, a.y, a.z, a.w}, bu[4] = {bb.x, bb.y, bb.z, bb.w};
      unsigned o[4];
#pragma unroll
      for (int j = 0; j < 4; ++j) {
        const float a0 = __uint_as_float(au[j] << 16), a1 = __uint_as_float(au[j] & 0xffff0000u);
        const float b0 = __uint_as_float(bu[j] << 16), b1 = __uint_as_float(bu[j] & 0xffff0000u);
        o[j] = pack2(a0 * sigmoidf_(b0), a1 * sigmoidf_(b1));
      }
      pk.x = o[0]; pk.y = o[1]; pk.z = o[2]; pk.w = o[3];
    }
    *(uint4*)(sU + r * 512 + c8 * 8) = pk;
  }
  const int c = 2 * tid;
  float w0[31], w1[31];
#pragma unroll
  for (int j = 0; j < 31; ++j) { w0[j] = p.conv_w[j * 512 + c]; w1[j] = p.conv_w[j * 512 + c + 1]; }
  const float bd0 = p.conv_b[c], bd1 = p.conv_b[c + 1];
  __syncthreads();
  float ya[32], yb[32];
#pragma unroll
  for (int tt = 0; tt < 32; ++tt) {
    float y0 = bd0, y1 = bd1;
#pragma unroll
    for (int j = 0; j < 31; ++j) {
      const unsigned uu = *(const unsigned*)(sU + (tt + j) * 512 + c);
      y0 += w0[j] * __uint_as_float(uu << 16);
      y1 += w1[j] * __uint_as_float(uu & 0xffff0000u);
    }
    ya[tt] = y0; yb[tt] = y1;
    float s = y0 + y1, q = y0 * y0 + y1 * y1;
    s = wave_sum(s); q = wave_sum(q);
    if (lane == 0) sRed[tt * 4 + w] = make_float2(s, q);
  }
  __syncthreads();
  const float g0 = p.ln_g[c], g1 = p.ln_g[c + 1], lb0 = p.ln_b[c], lb1 = p.ln_b[c + 1];
#pragma unroll
  for (int tt = 0; tt < 32; ++tt) {
    const float y0 = ya[tt], y1 = yb[tt];
    const float2 r0 = sRed[tt * 4 + 0], r1 = sRed[tt * 4 + 1], r2 = sRed[tt * 4 + 2], r3 = sRed[tt * 4 + 3];
    const float S = r0.x + r1.x + r2.x + r3.x, Q = r0.y + r1.y + r2.y + r3.y;
    const float mu = S * (1.f / 512.f);
    const float var = fmaxf(Q * (1.f / 512.f) - mu * mu, 0.f);
    const float rstd = rsqrtf(var + 1e-6f);
    const float z0 = (y0 - mu) * rstd * g0 + lb0, z1 = (y1 - mu) * rstd * g1 + lb1;
    const float o0 = z0 * sigmoidf_(z0), o1 = z1 * sigmoidf_(z1);
    *(unsigned*)(p.mix + ((size_t)b * T + t0 + tt) * LDA + c) = pack2(o0, o1);
  }
}

DEVI void compress2_tile(const Params& p, unsigned char* smem, int tile);
DEVI void phase2(const Params& p, unsigned char* smem) {
  u16* sA = (u16*)smem; u16* sB = sA + 128 * 72;
#pragma unroll 1
  for (int tile = blockIdx.x; tile < 64 + 1024; tile += gridDim.x) {
    GEMM_LANE_VARS
    if (tile < 64) {
      const int ty = tile >> 5, mt = tile & 31;
      const int m0 = mt * 128;
      f32x4 acc[4][4];
      gemm_mainloop<true>(tid, sA, sB, ACmp{p.proj, ty ? C_VC : C_KC}, p.w1T + (size_t)ty * 128 * LDW1, LDW1, m0, 0, 32, acc);
#pragma unroll
      for (int mi = 0; mi < 4; ++mi) {
        const int m = m0 + wm * 64 + 16 * mi + col;
#pragma unroll
        for (int ni = 0; ni < 4; ++ni) {
          const int n = wn * 64 + 16 * ni + 4 * quad;
          const f32x4 v = acc[ni][mi];
          const float4 bb = *(const float4*)(p.biasp + ty * 128 + n);
          uint2 pk;
          pk.x = pack2(gelu_tanh(v[0] + bb.x), gelu_tanh(v[1] + bb.y));
          pk.y = pack2(gelu_tanh(v[2] + bb.z), gelu_tanh(v[3] + bb.w));
          *(uint2*)(p.hdn + ((size_t)ty * 4096 + m) * 128 + n) = pk;
        }
      }
      asm volatile("s_waitcnt vmcnt(0)" ::: "memory");
      __syncthreads();
      compress2_tile(p, smem, tile);
    } else {
      conv_tile(p, smem, tile - 64);
    }
  }
}

DEVI void compress2_tile(const Params& p, unsigned char* smem, int tile) {
  u16* sA = (u16*)smem; u16* sB = sA + 128 * 72;
  {
    GEMM_LANE_VARS
    const int ty = tile >> 5, mt = tile & 31;
    const int m0 = mt * 128;
    f32x4 acc[4][4];
    gemm_mainloop<true>(tid, sA, sB, ARow{p.hdn + (size_t)ty * 4096 * 128, 128}, p.w2T + (size_t)ty * 128 * 128, 128, m0, 0, 2, acc);
    if (wn == 0) {
#pragma unroll
      for (int mi = 0; mi < 4; ++mi) {
        const int m = m0 + 16 * mi + wm * 64 + col;
        const int bg = m >> 7, c = m & 127;
#pragma unroll
        for (int ni = 0; ni < 4; ++ni) {
          const int n = 16 * ni + 4 * quad;
          const f32x4 v = acc[ni][mi];
          const float4 bb = *(const float4*)(p.cmp_b2 + ty * 64 + n);
          const float o0 = v[0] + bb.x, o1 = v[1] + bb.y, o2 = v[2] + bb.z, o3 = v[3] + bb.w;
          if (ty == 0) {
            uint2 pk; pk.x = pack2(o0, o1); pk.y = pack2(o2, o3);
            *(uint2*)(p.kc + (size_t)m * 64 + n) = pk;
          } else {
            u16* dst = p.vcT + ((size_t)bg * 64 + n) * 128 + c;
            dst[0] = f2bf(o0); dst[128] = f2bf(o1); dst[256] = f2bf(o2); dst[384] = f2bf(o3);
          }
        }
      }
    }
  }
}

template <int DH, int NQ, int LDK, class MaskF>
DEVI void attn_qk(const u16* sK, const bf16x8 (&qf)[NQ][DH / 32], f32x4 (&o)[NQ][DH / 16], float (&m)[NQ], float (&l)[NQ],
                  float c2, int lane, MaskF valid, bf16x8 (&pb)[NQ][2]) {
  const int col = lane & 15, quad = lane >> 4;
  f32x4 s[NQ][4];
  __builtin_amdgcn_s_setprio(1);
#pragma unroll
  for (int kt = 0; kt < 4; ++kt) {
#pragma unroll
    for (int qt = 0; qt < NQ; ++qt) s[qt][kt] = f32x4{0.f, 0.f, 0.f, 0.f};
#pragma unroll
    for (int ks = 0; ks < DH / 32; ++ks) {
      const bf16x8 kf = *(const bf16x8*)(sK + (16 * kt + col) * LDK + 32 * ks + 8 * quad);
#pragma unroll
      for (int qt = 0; qt < NQ; ++qt) s[qt][kt] = mfma16(kf, qf[qt][ks], s[qt][kt]);
    }
  }
  __builtin_amdgcn_s_setprio(0);
#pragma unroll
  for (int qt = 0; qt < NQ; ++qt) {
    float mx = -1e30f;
#pragma unroll
    for (int kt = 0; kt < 4; ++kt)
#pragma unroll
      for (int r = 0; r < 4; ++r) {
        const bool v = valid(qt, 16 * kt + 4 * quad + r);
        const float sv = v ? s[qt][kt][r] : -1e30f;
        s[qt][kt][r] = sv;
        mx = fmaxf(mx, sv);
      }
    mx = fmaxf(mx, __shfl_xor(mx, 16));
    mx = fmaxf(mx, __shfl_xor(mx, 32));
    const float mn = fmaxf(m[qt], mx);
    const float alpha = fexp2((m[qt] - mn) * c2);
    m[qt] = mn;
    const float mc = fmaxf(mn, -1e20f) * c2;
    float ps = 0.f;
#pragma unroll
    for (int kt = 0; kt < 4; ++kt)
#pragma unroll
      for (int r = 0; r < 4; ++r) {
        const float pv = fexp2(__builtin_fmaf(s[qt][kt][r], c2, -mc));
        ps += pv;
        s[qt][kt][r] = pv;
      }
    l[qt] = l[qt] * alpha + ps;
#pragma unroll
    for (int dt = 0; dt < DH / 16; ++dt) o[qt][dt] *= alpha;
#pragma unroll
    for (int kk = 0; kk < 2; ++kk) {
      union { bf16x8 v; unsigned u[4]; } cv;
      cv.u[0] = pack2(s[qt][2 * kk][0], s[qt][2 * kk][1]);
      cv.u[1] = pack2(s[qt][2 * kk][2], s[qt][2 * kk][3]);
      cv.u[2] = pack2(s[qt][2 * kk + 1][0], s[qt][2 * kk + 1][1]);
      cv.u[3] = pack2(s[qt][2 * kk + 1][2], s[qt][2 * kk + 1][3]);
      pb[qt][kk] = cv.v;
    }
  }
}
template <int DH, int NQ, int LDV>
DEVI void attn_pv(const u16* sVt, const bf16x8 (&pb)[NQ][2], f32x4 (&o)[NQ][DH / 16], int lane) {
  const int col = lane & 15, quad = lane >> 4;
  __builtin_amdgcn_s_setprio(1);
#pragma unroll
  for (int dt = 0; dt < DH / 16; ++dt) {
#pragma unroll
    for (int kk = 0; kk < 2; ++kk) {
      union { bf16x8 v; uint2 h[2]; } cv;
      cv.h[0] = *(const uint2*)(sVt + (16 * dt + col) * LDV + 32 * kk + 4 * quad);
      cv.h[1] = *(const uint2*)(sVt + (16 * dt + col) * LDV + 32 * kk + 16 + 4 * quad);
#pragma unroll
      for (int qt = 0; qt < NQ; ++qt) o[qt][dt] = mfma16(cv.v, pb[qt][kk], o[qt][dt]);
    }
  }
  __builtin_amdgcn_s_setprio(0);
}
template <int DH, int NQ, int LDK, int LDV, class MaskF>
DEVI void attn_tile(const u16* sK, const u16* sVt, const bf16x8 (&qf)[NQ][DH / 32], f32x4 (&o)[NQ][DH / 16],
                    float (&m)[NQ], float (&l)[NQ], float c2, int lane, MaskF valid) {
  bf16x8 pb[NQ][2];
  attn_qk<DH, NQ, LDK>(sK, qf, o, m, l, c2, lane, valid, pb);
  attn_pv<DH, NQ, LDV>(sVt, pb, o, lane);
}

DEVI void phase_nsa(const Params& p, unsigned char* smem) {
  u16* sK = (u16*)smem;
  u16* sVt = (u16*)(smem + 18432);
  float* impH = (float*)(smem + 35840);
  float* impT = (float*)(smem + 52736);
  unsigned* selm = (unsigned*)(smem + 56960);
  const float c2 = 0.125f * 1.4426950408889634f;
#pragma unroll 1
  for (int tile = blockIdx.x; tile < 2048; tile += gridDim.x) {
    const int tid = launder(threadIdx.x), lane = tid & 63, w = tid >> 6, col = lane & 15, quad = lane >> 4;
    const int qtile = 63 - (tile >> 5), bg = tile & 31, b = bg >> 1, g = bg & 1, q0 = qtile * 32;
    const int h = g * 4 + w;
    __syncthreads();
    if (tid < 32) selm[tid] = 0u;
    {
      const u16* kcp = p.kc + (size_t)bg * 128 * 64;
      const u16* vcp = p.vcT + (size_t)bg * 64 * 128;
#pragma unroll
      for (int i = 0; i < 4; ++i) {
        const int c = tid + 256 * i;
        const int row = c >> 3, ch = (c & 7) << 3;
        *(uint4*)(sK + row * 72 + ch) = *(const uint4*)(kcp + row * 64 + ch);
        const int row2 = c >> 4, ch2 = (c & 15) << 3;
        *(uint4*)(sVt + row2 * 136 + ch2) = *(const uint4*)(vcp + row2 * 128 + ch2);
      }
    }
    bf16x8 qf[2][2];
    float gate[2][3];
    int tq[2];
#pragma unroll
    for (int qt = 0; qt < 2; ++qt) {
      const int t = q0 + 16 * qt + col;
      tq[qt] = t;
      const size_t tok = (size_t)b * T + t;
      const u16* qp = p.proj + tok * LDP + C_Q + h * 64 + 8 * quad;
      qf[qt][0] = *(const bf16x8*)qp;
      qf[qt][1] = *(const bf16x8*)(qp + 32);
#pragma unroll
      for (int br = 0; br < 3; ++br) gate[qt][br] = sigmoidf_(bf2f(p.proj[tok * LDP + C_GATE + h * 3 + br]));
    }
    __syncthreads();

    f32x4 comb[2][4];
    {
      const int srcl = (lane + 48) & 63;
#pragma unroll
      for (int qt = 0; qt < 2; ++qt) {
        f32x4 s[8];
#pragma unroll
        for (int kt = 0; kt < 8; ++kt) {
          s[kt] = f32x4{0.f, 0.f, 0.f, 0.f};
#pragma unroll
          for (int ks = 0; ks < 2; ++ks) {
            const bf16x8 kf = *(const bf16x8*)(sK + (16 * kt + col) * 72 + 32 * ks + 8 * quad);
            s[kt] = mfma16(kf, qf[qt][ks], s[kt]);
          }
        }
        const int t = tq[qt];
        float mx = -1e30f;
#pragma unroll
        for (int kt = 0; kt < 8; ++kt)
#pragma unroll
          for (int r = 0; r < 4; ++r) {
            const int c = 16 * kt + 4 * quad + r;
            const bool v = (16 * c + 31) <= t;
            const float sv = v ? s[kt][r] : -1e30f;
            s[kt][r] = sv;
            mx = fmaxf(mx, sv);
          }
        mx = fmaxf(mx, __shfl_xor(mx, 16));
        mx = fmaxf(mx, __shfl_xor(mx, 32));
        float ps = 0.f;
        const float mcc = fmaxf(mx, -1e20f) * c2;
#pragma unroll
        for (int kt = 0; kt < 8; ++kt)
#pragma unroll
          for (int r = 0; r < 4; ++r) {
            const float pv = fexp2(__builtin_fmaf(s[kt][r], c2, -mcc));
            ps += pv;
            s[kt][r] = pv;
          }
        ps += __shfl_xor(ps, 16);
        ps += __shfl_xor(ps, 32);
        const float inv = ps > 0.f ? 1.f / ps : 0.f;
#pragma unroll
        for (int kt = 0; kt < 8; ++kt)
#pragma unroll
          for (int r = 0; r < 4; ++r) s[kt][r] *= inv;
        float prev3 = 0.f;
#pragma unroll
        for (int kt = 0; kt < 8; ++kt) {
          const float sum4 = s[kt][0] + s[kt][1] + s[kt][2] + s[kt][3];
          const float xs = __shfl(s[kt][3], srcl);
          const float extra = quad ? xs : prev3;
          prev3 = xs;
          impH[(w * 32 + 16 * qt + col) * 33 + 4 * kt + quad] = sum4 + extra;
        }
        bf16x8 pb[4];
#pragma unroll
        for (int kk = 0; kk < 4; ++kk) {
          union { bf16x8 v; unsigned u[4]; } cv;
          cv.u[0] = pack2(s[2 * kk][0], s[2 * kk][1]);
          cv.u[1] = pack2(s[2 * kk][2], s[2 * kk][3]);
          cv.u[2] = pack2(s[2 * kk + 1][0], s[2 * kk + 1][1]);
          cv.u[3] = pack2(s[2 * kk + 1][2], s[2 * kk + 1][3]);
          pb[kk] = cv.v;
        }
#pragma unroll
        for (int dt = 0; dt < 4; ++dt) {
          f32x4 oc = f32x4{0.f, 0.f, 0.f, 0.f};
#pragma unroll
          for (int kk = 0; kk < 4; ++kk) {
            union { bf16x8 v; uint2 hh[2]; } cv;
            cv.hh[0] = *(const uint2*)(sVt + (16 * dt + col) * 136 + 32 * kk + 4 * quad);
            cv.hh[1] = *(const uint2*)(sVt + (16 * dt + col) * 136 + 32 * kk + 16 + 4 * quad);
            oc = mfma16(cv.v, pb[kk], oc);
          }
          comb[qt][dt] = oc * gate[qt][0];
        }
      }
    }
#pragma unroll
    for (int qt = 0; qt < 2; ++qt) {
      const size_t tok = (size_t)b * T + tq[qt];
      union { bf16x8 v; unsigned u[4]; } own, par, res;
      own.v = qf[qt][0];
#pragma unroll
      for (int j = 0; j < 4; ++j) par.u[j] = (unsigned)__shfl_xor((int)own.u[j], 16);
      const float4 c0 = *(const float4*)(p.rope + tok * 16), c1 = *(const float4*)(p.rope + tok * 16 + 4);
      const float4 s0 = *(const float4*)(p.rope + tok * 16 + 8), s1 = *(const float4*)(p.rope + tok * 16 + 12);
      const float cs[8] = {c0.x, c0.y, c0.z, c0.w, c1.x, c1.y, c1.z, c1.w};
      const float sn[8] = {s0.x, s0.y, s0.z, s0.w, s1.x, s1.y, s1.z, s1.w};
#pragma unroll
      for (int j = 0; j < 4; ++j) {
        const float o0 = __uint_as_float(own.u[j] << 16), o1 = __uint_as_float(own.u[j] & 0xffff0000u);
        const float p0 = __uint_as_float(par.u[j] << 16), p1 = __uint_as_float(par.u[j] & 0xffff0000u);
        const float sg = (quad == 0) ? -1.f : 1.f;
        const float r0 = o0 * cs[2 * j] + sg * p0 * sn[2 * j];
        const float r1 = o1 * cs[2 * j + 1] + sg * p1 * sn[2 * j + 1];
        res.u[j] = (quad < 2) ? pack2(r0, r1) : own.u[j];
      }
      qf[qt][0] = res.v;
    }
    __syncthreads();
#pragma unroll
    for (int i = 0; i < 4; ++i) {
      const int cell = tid + 256 * i;
      const int qi = cell >> 5, s_ = cell & 31;
      const int cur = (q0 + qi) >> 6;
      float v = impH[(0 * 32 + qi) * 33 + s_] + impH[(1 * 32 + qi) * 33 + s_] + impH[(2 * 32 + qi) * 33 + s_] +
                impH[(3 * 32 + qi) * 33 + s_];
      const int dist = cur - s_;
      const bool forced = (s_ == 0) || (dist >= 0 && dist < 2);
      v = forced ? 1e9f : (s_ <= cur ? v : -1.f);
      impT[qi * 33 + s_] = v;
    }
    __syncthreads();
    {
      const int qi = tid >> 3, sub = tid & 7;
      unsigned bits = 0u;
#pragma unroll
      for (int k = 0; k < 4; ++k) {
        const int s_ = sub * 4 + k;
        const float v = impT[qi * 33 + s_];
        int rank = 0;
        for (int s2 = 0; s2 < 32; ++s2) {
          const float v2 = impT[qi * 33 + s2];
          rank += ((v2 > v) || (v2 == v && s2 < s_)) ? 1 : 0;
        }
        if (rank < 16) bits |= 1u << s_;
      }
      atomicOr(&selm[qi], bits);
    }
    __syncthreads();
    unsigned sm[2] = {selm[col], selm[16 + col]};
    unsigned uni = 0u;
#pragma unroll
    for (int i = 0; i < 32; ++i) uni |= selm[i];
    const int kbmax = (q0 + 31) >> 6;
    {
      float m[2] = {-1e30f, -1e30f}, l[2] = {0.f, 0.f};
      f32x4 o[2][4];
#pragma unroll
      for (int qt = 0; qt < 2; ++qt)
#pragma unroll
        for (int dt = 0; dt < 4; ++dt) o[qt][dt] = f32x4{0.f, 0.f, 0.f, 0.f};
      unsigned rem = (kbmax >= 31) ? uni : (uni & ((1u << (kbmax + 1)) - 1u));
      int kb = rem ? (__ffs((int)rem) - 1) : -1;
      uint4 rk0, rk1, rv0, rv1;
      const int lr0 = tid >> 3, lch = (tid & 7) << 3;
#define LOADKV_(kbx, CK, VT)                                                                                         \
      rk0 = *(const uint4*)(p.proj + ((size_t)b * T + (kbx) * 64 + lr0) * LDP + (CK) + g * 64 + lch);                 \
      rk1 = *(const uint4*)(p.proj + ((size_t)b * T + (kbx) * 64 + lr0 + 32) * LDP + (CK) + g * 64 + lch);            \
      rv0 = *(const uint4*)((VT) + ((size_t)bg * 64 + lr0) * LDT + (kbx) * 64 + lch);                                 \
      rv1 = *(const uint4*)((VT) + ((size_t)bg * 64 + lr0 + 32) * LDT + (kbx) * 64 + lch);
#define STOREKV_()                                                                                                   \
      *(uint4*)(sK + lr0 * 72 + lch) = rk0; *(uint4*)(sK + (lr0 + 32) * 72 + lch) = rk1;                              \
      *(uint4*)(sVt + lr0 * 72 + lch) = rv0; *(uint4*)(sVt + (lr0 + 32) * 72 + lch) = rv1;
      if (kb >= 0) { LOADKV_(kb, C_KS, p.vts) }
#pragma unroll 1
      while (kb >= 0) {
        rem &= rem - 1u;
        const int nkb = rem ? (__ffs((int)rem) - 1) : -1;
        __syncthreads();
        STOREKV_()
        if (nkb >= 0) { LOADKV_(nkb, C_KS, p.vts) }
        __syncthreads();
        const int lim0 = ((sm[0] >> kb) & 1u) ? tq[0] : -1, lim1 = ((sm[1] >> kb) & 1u) ? tq[1] : -1;
        attn_tile<64, 2, 72, 72>(sK, sVt, qf, o, m, l, c2, lane, [&](int qt, int kl) {
          return (kb * 64 + kl) <= (qt ? lim1 : lim0);
        });
        kb = nkb;
      }
#pragma unroll
      for (int qt = 0; qt < 2; ++qt) {
        float lt = l[qt];
        lt += __shfl_xor(lt, 16);
        lt += __shfl_xor(lt, 32);
        const float sc = lt > 0.f ? gate[qt][1] / lt : 0.f;
#pragma unroll
        for (int dt = 0; dt < 4; ++dt) comb[qt][dt] += o[qt][dt] * sc;
      }
    }
    {
      float m[2] = {-1e30f, -1e30f}, l[2] = {0.f, 0.f};
      f32x4 o[2][4];
#pragma unroll
      for (int qt = 0; qt < 2; ++qt)
#pragma unroll
        for (int dt = 0; dt < 4; ++dt) o[qt][dt] = f32x4{0.f, 0.f, 0.f, 0.f};
      const int kblo = (q0 >= 511) ? ((q0 - 511) >> 6) : 0;
      uint4 rk0, rk1, rv0, rv1;
      const int lr0 = tid >> 3, lch = (tid & 7) << 3;
      int kb = kblo;
      LOADKV_(kb, C_KW, p.vtw)
#pragma unroll 1
      while (kb >= 0) {
        const int nkb = (kb < kbmax) ? kb + 1 : -1;
        __syncthreads();
        STOREKV_()
        if (nkb >= 0) { LOADKV_(nkb, C_KW, p.vtw) }
        __syncthreads();
        attn_tile<64, 2, 72, 72>(sK, sVt, qf, o, m, l, c2, lane, [&](int qt, int kl) {
          return (unsigned)(tq[qt] - (kb * 64 + kl)) < 512u;
        });
        kb = nkb;
      }
#undef LOADKV_
#undef STOREKV_
#pragma unroll
      for (int qt = 0; qt < 2; ++qt) {
        float lt = l[qt];
        lt += __shfl_xor(lt, 16);
        lt += __shfl_xor(lt, 32);
        const float sc = lt > 0.f ? gate[qt][2] / lt : 0.f;
#pragma unroll
        for (int dt = 0; dt < 4; ++dt) comb[qt][dt] += o[qt][dt] * sc;
      }
    }
#pragma unroll
    for (int qt = 0; qt < 2; ++qt) {
      const size_t tok = (size_t)b * T + tq[qt];
#pragma unroll
      for (int dt = 0; dt < 4; ++dt) {
        uint2 pk;
        pk.x = pack2(comb[qt][dt][0], comb[qt][dt][1]);
        pk.y = pack2(comb[qt][dt][2], comb[qt][dt][3]);
        *(uint2*)(p.mix + tok * LDA + 512 + h * 64 + 16 * dt + 4 * quad) = pk;
      }
    }
  }
}

template <bool RESB>
DEVI void phase_resid(const Params& p, unsigned char* smem, const u16* A, const u16* Wt, const float* res, float* ssq) {
  u16* sA = (u16*)smem; u16* sB = sA + 128 * 72;
  XCD_TILE_LOOP(idx, 256, 8) {
    GEMM_LANE_VARS
    const int mt = XCD_TILE_MT(idx, 8), nt_ = XCD_TILE_NT(idx, 8);
    const int m0 = mt * 128, n0 = nt_ * 128;
    f32x4 acc[4][4];
    gemm_mainloop<true>(tid, sA, sB, ARow{A, LDA}, Wt, LDA, m0, n0, 16, acc);
#pragma unroll
    for (int mi = 0; mi < 4; ++mi) {
      const int m = m0 + wm * 64 + 16 * mi + col;
      float ss = 0.f;
#pragma unroll
      for (int ni = 0; ni < 4; ++ni) {
        const int n = n0 + wn * 64 + 16 * ni + 4 * quad;
        const f32x4 v = acc[ni][mi];
        float4 r;
        if (RESB) {
          const uint2 rb = *(const uint2*)(p.hn + (size_t)m * LDA + n);
          r.x = __uint_as_float(rb.x << 16); r.y = __uint_as_float(rb.x & 0xffff0000u);
          r.z = __uint_as_float(rb.y << 16); r.w = __uint_as_float(rb.y & 0xffff0000u);
        } else {
          r = *(const float4*)(res + (size_t)m * D + n);
        }
        float4 hv;
        hv.x = r.x + v[0]; hv.y = r.y + v[1]; hv.z = r.z + v[2]; hv.w = r.w + v[3];
        ss += hv.x * hv.x + hv.y * hv.y + hv.z * hv.z + hv.w * hv.w;
        uint2 pk; pk.x = pack2(hv.x, hv.y); pk.y = pack2(hv.z, hv.w);
        *(uint2*)(p.hn + (size_t)m * LDA + n) = pk;
      }
      ss += __shfl_xor(ss, 16);
      ss += __shfl_xor(ss, 32);
      if (quad == 0) atomicAdd(ssq + m, ss);
    }
  }
}

DEVI void phase_scaled(const Params& p, unsigned char* smem, const u16* A, const u16* Wt, int ntn, const float* ssq, u16* outp, int ldo) {
  u16* sA = (u16*)smem; u16* sB = sA + 128 * 72;
  XCD_TILE_LOOP(idx, 256, ntn) {
    GEMM_LANE_VARS
    const int mt = XCD_TILE_MT(idx, ntn), nt_ = XCD_TILE_NT(idx, ntn);
    const int m0 = mt * 128, n0 = nt_ * 128;
    f32x4 acc[4][4];
    gemm_mainloop<true>(tid, sA, sB, ARow{A, LDA}, Wt, LDA, m0, n0, 16, acc);
#pragma unroll
    for (int mi = 0; mi < 4; ++mi) {
      const int m = m0 + wm * 64 + 16 * mi + col;
      const float rstd = rsqrtf(ssq[m] * (1.f / D) + 1e-6f);
#pragma unroll
      for (int ni = 0; ni < 4; ++ni) {
        const int n = n0 + wn * 64 + 16 * ni + 4 * quad;
        const f32x4 v = acc[ni][mi];
        uint2 pk; pk.x = pack2(v[0] * rstd, v[1] * rstd); pk.y = pack2(v[2] * rstd, v[3] * rstd);
        *(uint2*)(outp + (size_t)m * ldo + n) = pk;
      }
    }
  }
}

DEVI void phase_memattn(const Params& p, unsigned char* smem) {
  u16* sK = (u16*)smem;
  u16* sVt = (u16*)(smem + 33792);
  const float c2 = 0.0625f * 1.4426950408889634f;
#pragma unroll 1
  for (int tile = blockIdx.x; tile < 2048; tile += gridDim.x) {
    const int tid = launder(threadIdx.x), lane = tid & 63, w = tid >> 6, col = lane & 15, quad = lane >> 4;
    const int b = tile >> 7, head = (tile >> 5) & 3, q0 = (tile & 31) * 64;
    const size_t tok = (size_t)b * T + q0 + 16 * w + col;
    bf16x8 qf[1][8];
#pragma unroll
    for (int ks = 0; ks < 8; ++ks) qf[0][ks] = *(const bf16x8*)(p.qm + tok * LDA + head * 256 + 32 * ks + 8 * quad);
    float m[1] = {-1e30f}, l[1] = {0.f};
    f32x4 o[1][16];
#pragma unroll
    for (int dt = 0; dt < 16; ++dt) o[0][dt] = f32x4{0.f, 0.f, 0.f, 0.f};
    uint4 rg0, rg1, rg2, rg3, rg4, rg5, rg6, rg7;
    const int krow = tid >> 5, kch = (tid & 31) << 3;
    const int vrow = tid >> 3, vch = (tid & 7) << 3;
#define LK1_(i, kbx) rg##i = *(const uint4*)(p.memk + ((size_t)b * 256 + (kbx) * 64 + krow + 8 * i) * LDA + head * 256 + kch);
#define SK1_(i) *(uint4*)(sK + (krow + 8 * i) * 264 + kch) = rg##i;
#define LV1_(i, kbx) rg##i = *(const uint4*)(p.memvt + ((size_t)(b * 4 + head) * 256 + vrow + 32 * i) * 256 + (kbx) * 64 + vch);
#define SV1_(i) *(uint4*)(sVt + (vrow + 32 * i) * 72 + vch) = rg##i;
#define LOADK_(kbx) LK1_(0, kbx) LK1_(1, kbx) LK1_(2, kbx) LK1_(3, kbx) LK1_(4, kbx) LK1_(5, kbx) LK1_(6, kbx) LK1_(7, kbx)
#define STOREK_() SK1_(0) SK1_(1) SK1_(2) SK1_(3) SK1_(4) SK1_(5) SK1_(6) SK1_(7)
#define LOADV_(kbx) LV1_(0, kbx) LV1_(1, kbx) LV1_(2, kbx) LV1_(3, kbx) LV1_(4, kbx) LV1_(5, kbx) LV1_(6, kbx) LV1_(7, kbx)
#define STOREV_() SV1_(0) SV1_(1) SV1_(2) SV1_(3) SV1_(4) SV1_(5) SV1_(6) SV1_(7)
    __syncthreads();
    LOADK_(0)
    STOREK_()
    LOADV_(0)
    __syncthreads();
#pragma unroll 1
    for (int kb = 0; kb < 4; ++kb) {
      bf16x8 pb[1][2];
      attn_qk<256, 1, 264>(sK, qf, o, m, l, c2, lane, [&](int, int) { return true; }, pb);
      STOREV_()
      if (kb < 3) { LOADK_(kb + 1) }
      __syncthreads();
      attn_pv<256, 1, 72>(sVt, pb, o, lane);
      if (kb < 3) {
        STOREK_()
        LOADV_(kb + 1)
      }
      __syncthreads();
    }
#undef LOADK_
#undef STOREK_
#undef LOADV_
#undef STOREV_
#undef LK1_
#undef SK1_
#undef LV1_
#undef SV1_
    float lt = l[0];
    lt += __shfl_xor(lt, 16);
    lt += __shfl_xor(lt, 32);
    const float inv = 1.f / lt;
#pragma unroll
    for (int dt = 0; dt < 16; ++dt) {
      uint2 pk;
      pk.x = pack2(o[0][dt][0] * inv, o[0][dt][1] * inv);
      pk.y = pack2(o[0][dt][2] * inv, o[0][dt][3] * inv);
      *(uint2*)(p.mix + tok * LDA + head * 256 + 16 * dt + 4 * quad) = pk;
    }
  }
}

__constant__ unsigned char kCandI[64] = {0,0,0,0,0,0,0,0,0,0,0,0,0,0,0,0, 1,1,1,1,1,1,1,1, 2,2,2,2,2, 3,3,3,3, 4,4,4, 5,5, 6,6, 7,7,
                                          8, 9, 10, 11, 12, 13, 14, 15, 0,0,0,0,0,0,0,0,0,0,0,0,0,0};
__constant__ unsigned char kCandJ[64] = {0,1,2,3,4,5,6,7,8,9,10,11,12,13,14,15, 0,1,2,3,4,5,6,7, 0,1,2,3,4, 0,1,2,3, 0,1,2, 0,1, 0,1, 0,1,
                                          0, 0, 0, 0, 0, 0, 0, 0, 0,0,0,0,0,0,0,0,0,0,0,0,0,0};

DEVI unsigned score_key(float v, int idx) {
  unsigned u = __float_as_uint(v);
  u = (u & 0x80000000u) ? ~u : (u | 0x80000000u);
  return (u & ~127u) | (unsigned)(127 - idx);
}
DEVI float key_score(unsigned k) {
  k &= ~127u;
  const unsigned u = (k & 0x80000000u) ? (k & 0x7fffffffu) : ~k;
  return __uint_as_float(u);
}

DEVI void phase_peer_route(const Params& p, unsigned char* smem) {
  u16* sA = (u16*)smem; u16* sB = sA + 128 * 72;
  unsigned* sScore = (unsigned*)smem;
  unsigned* sTop = (unsigned*)(smem + 36864);
  unsigned* sTmp = (unsigned*)(smem + 53248);
  {
    const int t0_ = launder(threadIdx.x);
    const int gw = (blockIdx.x * 256 + t0_) >> 6, nw = (gridDim.x * 256) >> 6;
    conv_fp8_rows(p.peer_u, p.ub8, p.uscale, 16384, gw, nw, t0_ & 63);
    conv_fp8_rows(p.peer_v, p.vb8, p.vscale, 16384, gw, nw, t0_ & 63);
  }
#pragma unroll 1
  for (int tile = blockIdx.x; tile < 256 * 8; tile += gridDim.x) {
    GEMM_LANE_VARS
    const int mt = tile >> 3, hd = tile & 7;
    const int m0 = mt * 128;
#pragma unroll 1
    for (int ph = 0; ph < 2; ++ph) {
      const int hp = hd * 2 + ph;
      f32x4 acc[4][4];
      __syncthreads();
      gemm_mainloop<false>(tid, sA, sB, ARow{p.pq + hp * 128, LDPQ}, p.subk + (size_t)hp * 128 * 128, 128, m0, 0, 2, acc);
#pragma unroll 1
      for (int hh = 0; hh < 2; ++hh) {
        if (wm == hh) {
#pragma unroll
          for (int mi = 0; mi < 4; ++mi) {
            const int row = 16 * mi + col;
#pragma unroll
            for (int ni = 0; ni < 4; ++ni) {
              const int n = wn * 64 + 16 * ni + 4 * quad;
              const f32x4 v = acc[ni][mi];
              uint4 kk;
              kk.x = score_key(v[0], n); kk.y = score_key(v[1], n + 1);
              kk.z = score_key(v[2], n + 2); kk.w = score_key(v[3], n + 3);
              *(uint4*)(sScore + row * 132 + n) = kk;
            }
          }
        }
        __syncthreads();
#pragma unroll 1
        for (int rg = 0; rg < 4; ++rg) {
          const int rbase = w * 16 + rg * 4;
          unsigned k0[4], k1[4], t0[4], t1[4], thr[4];
#pragma unroll
          for (int r = 0; r < 4; ++r) {
            k0[r] = sScore[(rbase + r) * 132 + lane];
            k1[r] = sScore[(rbase + r) * 132 + 64 + lane];
            t0[r] = ((k0[r] >> 16) << 7) | (k0[r] & 127u);
            t1[r] = ((k1[r] >> 16) << 7) | (k1[r] & 127u);
            thr[r] = 0u;
          }
#pragma unroll
          for (int bit = 22; bit >= 0; --bit) {
#pragma unroll
            for (int r = 0; r < 4; ++r) {
              const unsigned cand = thr[r] | (1u << bit);
              const int cnt = __popcll(__ballot(t0[r] >= cand)) + __popcll(__ballot(t1[r] >= cand));
              thr[r] = (cnt >= 16) ? cand : thr[r];
            }
          }
          unsigned* tmp = sTmp + w * 64;
#pragma unroll
          for (int r = 0; r < 4; ++r) {
            const unsigned long long b0 = __ballot(t0[r] >= thr[r]), b1 = __ballot(t1[r] >= thr[r]);
            const int pos0 = __builtin_amdgcn_mbcnt_hi((unsigned)(b0 >> 32), __builtin_amdgcn_mbcnt_lo((unsigned)b0, 0u));
            const int pos1 = __popcll(b0) + __builtin_amdgcn_mbcnt_hi((unsigned)(b1 >> 32), __builtin_amdgcn_mbcnt_lo((unsigned)b1, 0u));
            if (t0[r] >= thr[r]) tmp[r * 16 + pos0] = k0[r];
            if (t1[r] >= thr[r]) tmp[r * 16 + pos1] = k1[r];
          }
          __builtin_amdgcn_fence(__ATOMIC_RELEASE, "wavefront");
          __builtin_amdgcn_wave_barrier();
          __builtin_amdgcn_fence(__ATOMIC_ACQUIRE, "wavefront");
          {
            const int r = lane >> 4, ix = lane & 15;
            const unsigned mine = tmp[r * 16 + ix];
            const uint4 a = *(const uint4*)(tmp + r * 16), b = *(const uint4*)(tmp + r * 16 + 4), c = *(const uint4*)(tmp + r * 16 + 8),
                        d = *(const uint4*)(tmp + r * 16 + 12);
            const int rk = (a.x > mine) + (a.y > mine) + (a.z > mine) + (a.w > mine) + (b.x > mine) + (b.y > mine) + (b.z > mine) + (b.w > mine) +
                           (c.x > mine) + (c.y > mine) + (c.z > mine) + (c.w > mine) + (d.x > mine) + (d.y > mine) + (d.z > mine) + (d.w > mine);
            sTop[((hh * 64 + rbase + r) * 2 + ph) * 16 + rk] = mine;
          }
          __builtin_amdgcn_fence(__ATOMIC_RELEASE, "wavefront");
          __builtin_amdgcn_wave_barrier();
        }
        __syncthreads();
      }
    }
    const int ci = kCandI[lane], cj = kCandJ[lane];
    const bool act = lane < 50;
#pragma unroll 1
    for (int tg = 0; tg < 8; ++tg) {
      const int tb = w * 32 + tg * 4;
      unsigned k0[4], k1[4], ku[4], thr[4];
      float v[4];
#pragma unroll
      for (int r = 0; r < 4; ++r) {
        k0[r] = sTop[((tb + r) * 2 + 0) * 16 + ci];
        k1[r] = sTop[((tb + r) * 2 + 1) * 16 + cj];
        v[r] = key_score(k0[r]) + key_score(k1[r]);
        unsigned u = __float_as_uint(v[r]);
        u = (u & 0x80000000u) ? ~u : (u | 0x80000000u);
        ku[r] = act ? (((u >> 16) << 6) | (unsigned)(63 - lane)) : 0u;
        thr[r] = 0u;
      }
#pragma unroll
      for (int bit = 21; bit >= 0; --bit) {
#pragma unroll
        for (int r = 0; r < 4; ++r) {
          const unsigned cand = thr[r] | (1u << bit);
          const int cnt = __popcll(__ballot(ku[r] >= cand));
          thr[r] = (cnt >= 16) ? cand : thr[r];
        }
      }
#pragma unroll
      for (int r = 0; r < 4; ++r) {
        const bool sel = act && (ku[r] >= thr[r]);
        const unsigned long long ms = __ballot(sel);
        const int slot = __builtin_amdgcn_mbcnt_hi((unsigned)(ms >> 32), __builtin_amdgcn_mbcnt_lo((unsigned)ms, 0u));
        const float vmax = __int_as_float(__builtin_amdgcn_readlane(__float_as_int(v[r]), 0));
        const float e = sel ? __expf(v[r] - vmax) : 0.f;
        const float tot = wave_sum(e);
        if (sel) {
          const int eid = (127 - (int)(k0[r] & 127u)) * 128 + (127 - (int)(k1[r] & 127u));
          const size_t o = (size_t)(m0 + tb + r) * 128 + hd * 16 + slot;
          p.experts[o] = eid;
          p.gates[o] = e / tot;
        }
      }
    }
  }
}

template <int PART>
DEVI void phase_peer_gather(const Params& p, unsigned char* smem) {
  const int w0_ = threadIdx.x >> 6;
#pragma unroll 1
  for (int tok = blockIdx.x * 4 + w0_; tok < NTOK; tok += gridDim.x * 4) {
    const int tid = launder(threadIdx.x), lane = tid & 63;
    const uint4* hp4 = (const uint4*)(p.hn + (size_t)tok * LDA + lane * 16);
    float hv[16], xn[16], y[16];
    {
      const uint4 a0 = hp4[0], a1 = hp4[1];
      const unsigned hu[8] = {a0.x, a0.y, a0.z, a0.w, a1.x, a1.y, a1.z, a1.w};
#pragma unroll
      for (int i = 0; i < 8; ++i) { hv[2 * i] = __uint_as_float(hu[i] << 16); hv[2 * i + 1] = __uint_as_float(hu[i] & 0xffff0000u); }
    }
    float ss = 0.f;
#pragma unroll
    for (int i = 0; i < 16; ++i) ss += hv[i] * hv[i];
    ss = wave_sum(ss);
    const float rstd = rsqrtf(ss * (1.f / D) + 1e-6f);
    {
      const float4* g4 = (const float4*)p.peer_g + lane * 4;
      const float4 a0 = g4[0], a1 = g4[1], a2 = g4[2], a3 = g4[3];
      const float gg[16] = {a0.x, a0.y, a0.z, a0.w, a1.x, a1.y, a1.z, a1.w, a2.x, a2.y, a2.z, a2.w, a3.x, a3.y, a3.z, a3.w};
#pragma unroll
      for (int i = 0; i < 16; ++i) { xn[i] = hv[i] * rstd * gg[i]; y[i] = 0.f; }
    }
    int e0 = p.experts[(size_t)tok * 128 + lane], e1 = p.experts[(size_t)tok * 128 + 64 + lane];
    float g0 = p.gates[(size_t)tok * 128 + lane], g1 = p.gates[(size_t)tok * 128 + 64 + lane];
    if (PART == 0) {
      int* sE = (int*)(smem + (tid >> 6) * 1024);
      float* sG = (float*)(sE + 128);
      int pos0 = 0, pos1 = 0, base = 0;
      const int q0_ = e0 >> 11, q1_ = e1 >> 11;
#pragma unroll
      for (int q = 0; q < 8; ++q) {
        const unsigned long long m0 = __ballot(q0_ == q), m1 = __ballot(q1_ == q);
        const int c0 = __popcll(m0);
        const int i0 = __builtin_amdgcn_mbcnt_hi((unsigned)(m0 >> 32), __builtin_amdgcn_mbcnt_lo((unsigned)m0, 0u));
        const int i1 = __builtin_amdgcn_mbcnt_hi((unsigned)(m1 >> 32), __builtin_amdgcn_mbcnt_lo((unsigned)m1, 0u));
        if (q0_ == q) pos0 = base + i0;
        if (q1_ == q) pos1 = base + c0 + i1;
        base += c0 + __popcll(m1);
      }
      __builtin_amdgcn_fence(__ATOMIC_RELEASE, "wavefront");
      __builtin_amdgcn_wave_barrier();
      sE[pos0] = e0; sG[pos0] = g0;
      sE[pos1] = e1; sG[pos1] = g1;
      __builtin_amdgcn_fence(__ATOMIC_RELEASE, "wavefront");
      __builtin_amdgcn_wave_barrier();
      __builtin_amdgcn_fence(__ATOMIC_ACQUIRE, "wavefront");
      e0 = sE[lane]; e1 = sE[64 + lane];
      g0 = sG[lane]; g1 = sG[64 + lane];
      p.experts[(size_t)tok * 128 + lane] = e0;
      p.experts[(size_t)tok * 128 + 64 + lane] = e1;
    }
    const float su0 = p.uscale[e0], su1 = p.uscale[e1];
    const float sv0 = p.vscale[e0], sv1 = p.vscale[e1];
    float cf0 = 0.f, cf1 = 0.f, dsum = 0.f;
    uint4 ca[8], cb[8];
#define LOADB_(R, bi)                                                                                   \
    _Pragma("unroll") for (int u = 0; u < 8; ++u) {                                                       \
      const int kk_ = (((bi) & 7) << 3) + u;                                                             \
      const int e_ = __builtin_amdgcn_readlane((((bi) >> 3) & 1) ? e1 : e0, kk_);                        \
      R[u] = ((const uint4*)((((bi) >> 4) ? p.vb8 : p.ub8) + (size_t)e_ * 1024))[lane];                  \
    }
#define COMPU_(R, bi)                                                                                   \
    {                                                                                                    \
      float d8[8];                                                                                       \
      _Pragma("unroll") for (int u = 0; u < 8; ++u) {                                                     \
        const unsigned uu[4] = {R[u].x, R[u].y, R[u].z, R[u].w};                                         \
        f32x2 a2 = {0.f, 0.f};                                                                           \
        _Pragma("unroll") for (int j = 0; j < 4; ++j) {                                                   \
          const f32x2 lo = __builtin_amdgcn_cvt_pk_f32_fp8((int)uu[j], false);                           \
          const f32x2 hi = __builtin_amdgcn_cvt_pk_f32_fp8((int)uu[j], true);                            \
          a2 = xn2[2 * j] * lo + a2;                                                                     \
          a2 = xn2[2 * j + 1] * hi + a2;                                                                 \
        }                                                                                                \
        d8[u] = a2[0] + a2[1];                                                                           \
      }                                                                                                  \
          \
      float v4[4], v2[2];                                                                                \
      _Pragma("unroll") for (int i = 0; i < 4; ++i) {                                                     \
        const float snd = b5 ? d8[i] : d8[4 + i], kp = b5 ? d8[4 + i] : d8[i];                           \
        v4[i] = kp + __shfl_xor(snd, 32);                                                                \
      }                                                                                                  \
      _Pragma("unroll") for (int i = 0; i < 2; ++i) {                                                     \
        const float snd = b4 ? v4[i] : v4[2 + i], kp = b4 ? v4[2 + i] : v4[i];                           \
        v2[i] = kp + __shfl_xor(snd, 16);                                                                \
      }                                                                                                  \
      float v1;                                                                                          \
      { const float snd = b3 ? v2[0] : v2[1], kp = b3 ? v2[1] : v2[0]; v1 = kp + __shfl_xor(snd, 8); }   \
      v1 += __shfl_xor(v1, 4);                                                                           \
      v1 += __shfl_xor(v1, 2);                                                                           \
      v1 += __shfl_xor(v1, 1);                                                                           \
                \
      const float got = __shfl(v1, fsrc);                                                                \
      if ((lane >> 3) == ((bi) & 7)) dsum = got;                                                         \
    }                                                                                                    \
    if (((bi) & 7) == 7) {                                                                               \
      if (((bi) >> 3) & 1) cf1 = gelu_tanh(dsum * su1) * g1 * sv1; else cf0 = gelu_tanh(dsum * su0) * g0 * sv0; \
    }
#define COMPV_(R, bi)                                                                                   \
    _Pragma("unroll") for (int u = 0; u < 8; ++u) {                                                       \
      const int kk_ = (((bi) & 7) << 3) + u;                                                             \
      const float ck_ = __int_as_float(__builtin_amdgcn_readlane(__float_as_int((((bi) >> 3) & 1) ? cf1 : cf0), kk_)); \
      const f32x2 ck2 = {ck_, ck_};                                                                      \
      const unsigned uu[4] = {R[u].x, R[u].y, R[u].z, R[u].w};                                           \
      _Pragma("unroll") for (int j = 0; j < 4; ++j) {                                                     \
        const f32x2 lo = __builtin_amdgcn_cvt_pk_f32_fp8((int)uu[j], false);                             \
        const f32x2 hi = __builtin_amdgcn_cvt_pk_f32_fp8((int)uu[j], true);                              \
        y2[2 * j] = ck2 * lo + y2[2 * j];                                                                \
        y2[2 * j + 1] = ck2 * hi + y2[2 * j + 1];                                                        \
      }                                                                                                  \
    }
    const bool b5 = (lane & 32) != 0, b4 = (lane & 16) != 0, b3 = (lane & 8) != 0;
    const int fsrc = ((lane & 4) << 3) | ((lane & 2) << 3) | ((lane & 1) << 3);
    f32x2 xn2[8], y2[8];
#pragma unroll
    for (int i = 0; i < 8; ++i) { xn2[i] = f32x2{xn[2 * i], xn[2 * i + 1]}; y2[i] = f32x2{0.f, 0.f}; }
    if (PART == 0) {
      LOADB_(ca, 0)
#pragma unroll 1
      for (int bi = 0; bi < 16; bi += 2) {
        LOADB_(cb, bi + 1)
        COMPU_(ca, bi)
        if (bi + 2 < 16) { LOADB_(ca, bi + 2) }
        COMPU_(cb, bi + 1)
      }
      p.gates[(size_t)tok * 128 + lane] = cf0;
      p.gates[(size_t)tok * 128 + 64 + lane] = cf1;
      continue;
    }
    cf0 = g0; cf1 = g1;
    LOADB_(ca, 16)
#pragma unroll 1
    for (int bi = 16; bi < 32; bi += 2) {
      LOADB_(cb, bi + 1)
      COMPV_(ca, bi)
      if (bi + 2 < 32) { LOADB_(ca, bi + 2) }
      COMPV_(cb, bi + 1)
    }
#undef LOADB_
#undef COMPU_
#undef COMPV_
#pragma unroll
    for (int i = 0; i < 8; ++i) { y[2 * i] = y2[i][0]; y[2 * i + 1] = y2[i][1]; }
    float s2 = 0.f;
    {
      const uint4 a0 = hp4[0], a1 = hp4[1];
      const unsigned hu[8] = {a0.x, a0.y, a0.z, a0.w, a1.x, a1.y, a1.z, a1.w};
#pragma unroll
      for (int i = 0; i < 8; ++i) {
        y[2 * i] += __uint_as_float(hu[i] << 16);
        y[2 * i + 1] += __uint_as_float(hu[i] & 0xffff0000u);
        s2 += y[2 * i] * y[2 * i] + y[2 * i + 1] * y[2 * i + 1];
      }
    }
    s2 = wave_sum(s2);
    const float rs2 = rsqrtf(s2 * (1.f / D) + 1e-6f);
    {
      const float4* g4 = (const float4*)p.final_g + lane * 4;
      const float4 a0 = g4[0], a1 = g4[1], a2 = g4[2], a3 = g4[3];
      float4* o4 = (float4*)(p.out + (size_t)tok * D) + lane * 4;
      o4[0] = make_float4(y[0] * rs2 * a0.x, y[1] * rs2 * a0.y, y[2] * rs2 * a0.z, y[3] * rs2 * a0.w);
      o4[1] = make_float4(y[4] * rs2 * a1.x, y[5] * rs2 * a1.y, y[6] * rs2 * a1.z, y[7] * rs2 * a1.w);
      o4[2] = make_float4(y[8] * rs2 * a2.x, y[9] * rs2 * a2.y, y[10] * rs2 * a2.z, y[11] * rs2 * a2.w);
      o4[3] = make_float4(y[12] * rs2 * a3.x, y[13] * rs2 * a3.y, y[14] * rs2 * a3.z, y[15] * rs2 * a3.w);
    }
  }
}

#define XB_TMO      128
#define XB_XCNT(j)  (256  + 64 * (j))
#define XB_XSUB(j)  (1280 + 64 * (j))
#define XB_XGEN(j)  (2304 + 64 * (j))
#define XB_TOP      3328
#define XB_TOPGEN   3392
#define XCD_BAR_WORDS 3456
#define XB_SPIN_CAP (1u << 20)
#define LAS __attribute__((address_space(3)))
DEVI unsigned xb_ld(unsigned* q) { return __hip_atomic_load(q, __ATOMIC_RELAXED, __HIP_MEMORY_SCOPE_AGENT); }
DEVI unsigned xb_add(unsigned* q, unsigned v) { return __hip_atomic_fetch_add(q, v, __ATOMIC_RELAXED, __HIP_MEMORY_SCOPE_AGENT); }
DEVI unsigned xb_xcc_id() { return (unsigned)__builtin_amdgcn_s_getreg((3 << 11) | 20) & 0xFu; }
#define XB_SPIN(cond, bar) do { unsigned _sp = 0; while (cond) { __builtin_amdgcn_s_sleep(1); \
    if ((++_sp & 255u) == 0u) { if (xb_ld(&(bar)[XB_TMO])) break; if (_sp > XB_SPIN_CAP) { atomicAdd(&(bar)[XB_TMO], 1u); break; } } } } while (0)
struct XcdBarrier { unsigned* bar; unsigned x; volatile LAS unsigned* st; };
DEVI XcdBarrier xcd_barrier_post(unsigned* bar, volatile LAS unsigned* st) {
  XcdBarrier b; b.bar = bar; b.x = xb_xcc_id(); b.st = st;
  if (threadIdx.x == 0) (void)xb_add(&bar[XB_XCNT(b.x)], 1u);
  return b;
}
DEVI void xcd_barrier_complete(unsigned* bar, unsigned x, unsigned& nloc, unsigned& nx) {
  const unsigned G = gridDim.x * gridDim.y * gridDim.z;
  unsigned sum, cnt, mine, sp = 0u;
  for (;;) {
    sum = 0u; cnt = 0u; mine = 0u;
#pragma unroll
    for (unsigned j = 0; j < 16; ++j) { const unsigned c = xb_ld(&bar[XB_XCNT(j)]); sum += c; cnt += (c > 0u) ? 1u : 0u; mine = (j == x) ? c : mine; }
    if (sum == G) break;
    __builtin_amdgcn_s_sleep(1);
    if ((++sp & 255u) == 0u) { if (xb_ld(&bar[XB_TMO])) break; if (sp > XB_SPIN_CAP) { atomicAdd(&bar[XB_TMO], 1u); break; } }
  }
  nloc = mine > 0u ? mine : 1u; nx = cnt > 0u ? cnt : 1u;
}
DEVI void xcd_barrier(const XcdBarrier& b) {
  asm volatile("s_waitcnt vmcnt(0)" ::: "memory");
  __syncthreads();
  if (threadIdx.x == 0) {
    unsigned* bar = b.bar;
    __builtin_amdgcn_s_waitcnt(0);
    unsigned nloc = b.st[0], nx = b.st[1];
    if (nloc == 0u) { xcd_barrier_complete(bar, b.x, nloc, nx); b.st[0] = nloc; b.st[1] = nx; }
    const unsigned old = xb_add(&bar[XB_XSUB(b.x)], 1u);
    const unsigned gen = old / nloc;
    if (old + 1u == (gen + 1u) * nloc) {
      __builtin_amdgcn_fence(__ATOMIC_RELEASE, "agent");
      asm volatile("s_waitcnt vmcnt(0)" ::: "memory");
      const unsigned og = xb_add(&bar[XB_TOP], 1u);
      const unsigned tg = og / nx;
      if (og + 1u == (tg + 1u) * nx) xb_add(&bar[XB_TOPGEN], 1u);
      else XB_SPIN(xb_ld(&bar[XB_TOPGEN]) == tg, bar);
      __builtin_amdgcn_fence(__ATOMIC_ACQUIRE, "agent");
      xb_add(&bar[XB_XGEN(b.x)], 1u);
      asm volatile("s_waitcnt vmcnt(0)" ::: "memory");
    } else {
      XB_SPIN(xb_ld(&bar[XB_XGEN(b.x)]) == gen, bar);
      __builtin_amdgcn_fence(__ATOMIC_ACQUIRE, "agent");
      asm volatile("s_waitcnt vmcnt(0)" ::: "memory");
    }
  }
  __syncthreads();
}

template <bool COOP>
__global__ void __launch_bounds__(256, 2) mega(Params p, int ph_lo, int ph_hi) {
  __shared__ __attribute__((aligned(16))) unsigned char smem[SMEM_BYTES];
  __shared__ uint4 xb_words;
  if (threadIdx.x == 0) xb_words = make_uint4(0u, 0u, 0u, 0u);
  __syncthreads();
  XcdBarrier xb = xcd_barrier_post(p.bar, (volatile LAS unsigned*)&xb_words);
  (void)xb;
  if (COOP && ph_hi > 1000) cg::this_grid().sync();
#ifdef REPEAT_MASK
#define RUN_PHASE(i, call)                                                                   \
  if (ph_lo <= (i) && (i) <= ph_hi) {                                                        \
    call;                                                                                    \
    if (COOP && ((REPEAT_MASK >> (i)) & 1)) { xcd_barrier(xb); call; }                       \
    if (COOP && (i) < ph_hi) xcd_barrier(xb);                                                \
  }
#else
#define RUN_PHASE(i, call)                                                                   \
  if (ph_lo <= (i) && (i) <= ph_hi) {                                                        \
    call;                                                                                    \
    if (COOP && (i) < ph_hi) {                                                               \
      xcd_barrier(xb);                                                                       \
    }                                                                                        \
  }
#endif
  RUN_PHASE(0, phase0(p))
  RUN_PHASE(1, phase1(p, smem))
  RUN_PHASE(2, phase2(p, smem))
  RUN_PHASE(4, phase_nsa(p, smem))
  RUN_PHASE(5, phase_resid<false>(p, smem, p.mix, p.woutT, p.x, p.ssq1))
  RUN_PHASE(6, phase_scaled(p, smem, p.hn, p.wmqT, 8, p.ssq1, p.qm, LDA))
  RUN_PHASE(7, phase_memattn(p, smem))
  RUN_PHASE(8, phase_resid<true>(p, smem, p.mix, p.wmoT, nullptr, p.ssq2))
  RUN_PHASE(9, phase_scaled(p, smem, p.hn, p.wpqT, 16, p.ssq2, p.pq, LDPQ))
  RUN_PHASE(10, phase_peer_route(p, smem))
  RUN_PHASE(11, phase_peer_gather<0>(p, smem))
  RUN_PHASE(12, phase_peer_gather<1>(p, smem))
#undef RUN_PHASE
}

extern "C" void kernel_launch(void* const* d_in, const int* in_sizes, int n_in, void* d_out, int out_size, void* d_ws,
                              size_t ws_size, hipStream_t stream) {
  (void)in_sizes; (void)n_in; (void)out_size; (void)ws_size;
  Params p{};
  p.x = (const float*)d_in[0]; p.mem = (const float*)d_in[1]; p.pos = (const int*)d_in[2];
  p.mix_g = (const float*)d_in[3]; p.w_in = (const float*)d_in[4]; p.conv_w = (const float*)d_in[5];
  p.conv_b = (const float*)d_in[6]; p.ln_g = (const float*)d_in[7]; p.ln_b = (const float*)d_in[8];
  p.cmp_pos = (const float*)d_in[9]; p.cmp_w1 = (const float*)d_in[10]; p.cmp_b1 = (const float*)d_in[11];
  p.cmp_w2 = (const float*)d_in[12]; p.cmp_b2 = (const float*)d_in[13]; p.w_out = (const float*)d_in[14];
  p.memq_g = (const float*)d_in[15]; p.memkv_g = (const float*)d_in[16]; p.w_mq = (const float*)d_in[17];
  p.w_mk = (const float*)d_in[18]; p.w_mv = (const float*)d_in[19]; p.w_mo = (const float*)d_in[20];
  p.peer_g = (const float*)d_in[21]; p.peer_wq = (const float*)d_in[22]; p.peer_sk = (const float*)d_in[23];
  p.peer_u = (const float*)d_in[24]; p.peer_v = (const float*)d_in[25]; p.final_g = (const float*)d_in[26];
  p.out = (float*)d_out;
  unsigned char* ws = (unsigned char*)d_ws;
  size_t off = 0;
  auto take = [&](size_t bytes) { unsigned char* r = ws + off; off += (bytes + 255) & ~(size_t)255; return r; };
  unsigned char* regA = take((size_t)NTOK * LDA * 2);
  unsigned char* regB = take((size_t)NTOK * LDP * 2);
  unsigned char* regC = take((size_t)NTOK * LDA * 2);
  p.hn = (u16*)regA;
  p.proj = (u16*)regB; p.qm = (u16*)regB; p.pq = (u16*)regB;
  p.mix = (u16*)regC; p.experts = (int*)regC; p.gates = (float*)(regC + (size_t)NTOK * 128 * 4);
  {
    unsigned char* tb = regC + (size_t)2 * NTOK * 128 * 4;
    p.ub8 = tb; p.vb8 = tb + (size_t)16384 * 1024;
    p.uscale = (float*)(tb + (size_t)2 * 16384 * 1024); p.vscale = p.uscale + 16384;
  }
  p.h = nullptr;
  p.vts = (u16*)take((size_t)Bn * 2 * 64 * LDT * 2);
  p.vtw = (u16*)take((size_t)Bn * 2 * 64 * LDT * 2);
  p.memn = (u16*)take((size_t)Bn * 256 * LDA * 2);
  p.memk = (u16*)take((size_t)Bn * 256 * LDA * 2);
  p.memvt = (u16*)take((size_t)Bn * 256 * D * 2);
  p.winT = (u16*)take((size_t)2432 * LDA * 2);
  p.woutT = (u16*)take((size_t)1024 * LDA * 2);
  p.wmqT = (u16*)take((size_t)1024 * LDA * 2);
  p.wmkT = (u16*)take((size_t)1024 * LDA * 2);
  p.wmvT = (u16*)take((size_t)1024 * LDA * 2);
  p.wmoT = (u16*)take((size_t)1024 * LDA * 2);
  p.wpqT = (u16*)take((size_t)2048 * LDA * 2);
  p.subk = (u16*)take((size_t)16 * 128 * 128 * 2);
  p.w1T = (u16*)take((size_t)2 * 128 * LDW1 * 2);
  p.w2T = (u16*)take((size_t)2 * 128 * 128 * 2);
  p.biasp = (float*)take(256 * 4);
  p.rope = (float*)take((size_t)NTOK * 16 * 4);
  p.hdn = (u16*)take((size_t)2 * 4096 * 128 * 2);
  p.kc = (u16*)take((size_t)Bn * 2 * 128 * 64 * 2);
  p.vcT = (u16*)take((size_t)Bn * 2 * 64 * 128 * 2);
  p.ssq1 = (float*)take((size_t)NTOK * 4);
  p.ssq2 = (float*)take((size_t)NTOK * 4);
  p.bar = (unsigned*)take(16384);
  if (off > ws_size) { fprintf(stderr, "workspace too small: need %zu have %zu\n", off, ws_size); return; }

#if COOP_MODE
  static int grid_blocks = 0;
  if (!grid_blocks) {
    int dev = 0, cus = 0, per_cu = 0;
    hipGetDevice(&dev);
    hipDeviceGetAttribute(&cus, hipDeviceAttributeMultiprocessorCount, dev);
    hipOccupancyMaxActiveBlocksPerMultiprocessor(&per_cu, mega<true>, 256, 0);
    if (per_cu > 2) per_cu = 2;
    if (per_cu < 1) per_cu = 1;
    grid_blocks = cus * per_cu;
  }
  int lo = 0, hi = NPHASE;
  void* args[] = {&p, &lo, &hi};
  (void)hipMemsetAsync(p.bar, 0, 16384, stream);
  hipError_t e = hipLaunchCooperativeKernel((void*)mega<true>, dim3(grid_blocks), dim3(256), args, 0, stream);
  if (e != hipSuccess) fprintf(stderr, "cooperative launch failed: %s (grid %d)\n", hipGetErrorString(e), grid_blocks);
#else
  for (int ph = 0; ph <= NPHASE; ++ph) mega<false><<<dim3(512), dim3(256), 0, stream>>>(p, ph, ph);
#endif
}
```

```cpp
#include <hip/hip_runtime.h>
#include <hip/hip_bf16.h>
#include <hip/hip_cooperative_groups.h>
#include <cstdio>
#include <cstdint>
namespace cg = cooperative_groups;

#ifndef COOP_MODE
#define COOP_MODE 1
#endif

typedef __attribute__((ext_vector_type(8))) short bf16x8;
typedef __attribute__((ext_vector_type(4))) short bf16x4;
typedef __attribute__((ext_vector_type(4))) float f32x4;
typedef unsigned short u16;

#define DEVI __device__ __forceinline__

constexpr int Bn = 16, T = 2048, D = 1024, NTOK = Bn * T, LDP = 2336;
constexpr int C_Q = 1024, C_KC = 1536, C_VC = 1664, C_KS = 1792, C_VS = 1920, C_KW = 2048, C_VW = 2176, C_GATE = 2304;
constexpr int SMEM_BYTES = 73728;
constexpr int LDA = 1088;
constexpr int LDHF = 1056;
constexpr int LDPQ = 2112;
constexpr int LDW1 = 2112;
constexpr int LDT = 2112;
constexpr int NPHASE = 12;

struct Params {
  const float* x; const float* mem; const int* pos; const float* mix_g; const float* w_in;
  const float* conv_w; const float* conv_b; const float* ln_g; const float* ln_b;
  const float* cmp_pos; const float* cmp_w1; const float* cmp_b1; const float* cmp_w2; const float* cmp_b2;
  const float* w_out; const float* memq_g; const float* memkv_g; const float* w_mq; const float* w_mk;
  const float* w_mv; const float* w_mo; const float* peer_g; const float* peer_wq; const float* peer_sk;
  const float* peer_u; const float* peer_v; const float* final_g;
  float* out;
  u16* hn; u16* proj; u16* mix; float* h; u16* vts; u16* vtw; u16* memn; u16* memk; u16* memvt;
  u16* winT; u16* woutT; u16* wmqT; u16* wmkT; u16* wmvT; u16* wmoT; u16* wpqT; u16* subk; u16* w1T; u16* w2T;
  float* biasp; float* rope; u16* hdn; u16* kc; u16* vcT; float* ssq1; float* ssq2;
  int* experts; float* gates; unsigned char* ub8; unsigned char* vb8; float* uscale; float* vscale; u16* qm; u16* pq;
  unsigned* bar;
};

DEVI int launder(int x) { asm volatile("" : "+v"(x)); return x; }
DEVI u16 f2bf(float f) {
  unsigned u = __float_as_uint(f);
  u += 0x7fffu + ((u >> 16) & 1u);
  return (u16)(u >> 16);
}
DEVI float bf2f(u16 h) { return __uint_as_float(((unsigned)h) << 16); }
DEVI unsigned pack2(float a, float b) { return (unsigned)f2bf(a) | ((unsigned)f2bf(b) << 16); }
DEVI float wave_sum(float v) {
#pragma unroll
  for (int o = 32; o; o >>= 1) v += __shfl_xor(v, o);
  return v;
}
DEVI float sigmoidf_(float x) { return 1.f / (1.f + __expf(-x)); }
DEVI float gelu_tanh(float x) {
  float u = 0.7978845608028654f * (x + 0.044715f * x * x * x);
  return 0.5f * x * (1.f + tanhf(u));
}
DEVI f32x4 mfma16(bf16x8 a, bf16x8 b, f32x4 c) { return __builtin_amdgcn_mfma_f32_16x16x32_bf16(a, b, c, 0, 0, 0); }
DEVI float fexp2(float x) { return __builtin_amdgcn_exp2f(x); }

DEVI void tconv(const float* __restrict__ src, int K, int N, u16* __restrict__ dst, int Npad, int ldd,
                const float* __restrict__ gain, int gtid, int gsz) {
  const int items = Npad * (K >> 3);
  for (int it = gtid; it < items; it += gsz) {
    const int n = it % Npad, kc = it / Npad;
    float f[8];
#pragma unroll
    for (int j = 0; j < 8; ++j) {
      float v = 0.f;
      if (n < N) {
        v = src[(size_t)(kc * 8 + j) * N + n];
        if (gain) v *= gain[kc * 8 + j];
      }
      f[j] = v;
    }
    uint4 pk;
    pk.x = pack2(f[0], f[1]); pk.y = pack2(f[2], f[3]); pk.z = pack2(f[4], f[5]); pk.w = pack2(f[6], f[7]);
    *(uint4*)(dst + (size_t)n * ldd + kc * 8) = pk;
  }
}

DEVI void conv_flat(const float* __restrict__ src, u16* __restrict__ dst, size_t n8, size_t gtid, size_t gsz) {
  for (size_t it = gtid; it < n8; it += gsz) {
    const float4 a = ((const float4*)src)[2 * it], b = ((const float4*)src)[2 * it + 1];
    uint4 pk;
    pk.x = pack2(a.x, a.y); pk.y = pack2(a.z, a.w); pk.z = pack2(b.x, b.y); pk.w = pack2(b.z, b.w);
    ((uint4*)dst)[it] = pk;
  }
}


typedef float f32x2 __attribute__((ext_vector_type(2)));
DEVI unsigned pk4_fp8(float a, float b, float c, float d) {
  int v = 0;
  v = __builtin_amdgcn_cvt_pk_fp8_f32(a, b, v, false);
  v = __builtin_amdgcn_cvt_pk_fp8_f32(c, d, v, true);
  return (unsigned)v;
}
DEVI void conv_fp8_rows(const float* __restrict__ src, unsigned char* __restrict__ dst, float* __restrict__ inv_scale,
                        int rows, int gw, int nw, int lane) {
  for (int r0 = gw; r0 < rows; r0 += 2 * nw) {
    const int r1 = r0 + nw;
    const bool has1 = r1 < rows;
    const float4* p0 = (const float4*)(src + (size_t)r0 * 1024) + lane * 4;
    const float4* p1 = (const float4*)(src + (size_t)(has1 ? r1 : r0) * 1024) + lane * 4;
    float4 v[2][4];
#pragma unroll
    for (int i = 0; i < 4; ++i) { v[0][i] = p0[i]; v[1][i] = p1[i]; }
    float mx[2];
#pragma unroll
    for (int q = 0; q < 2; ++q) {
      float m = 0.f;
#pragma unroll
      for (int i = 0; i < 4; ++i)
        m = fmaxf(m, fmaxf(fmaxf(fabsf(v[q][i].x), fabsf(v[q][i].y)), fmaxf(fabsf(v[q][i].z), fabsf(v[q][i].w))));
      mx[q] = m;
    }
#pragma unroll
    for (int o = 32; o; o >>= 1) { mx[0] = fmaxf(mx[0], __shfl_xor(mx[0], o)); mx[1] = fmaxf(mx[1], __shfl_xor(mx[1], o)); }
#pragma unroll
    for (int q = 0; q < 2; ++q) {
      if (q == 1 && !has1) break;
      const int r = q ? r1 : r0;
      const float sc = mx[q] > 0.f ? 224.f / mx[q] : 1.f;
      if (lane == 0) inv_scale[r] = mx[q] > 0.f ? mx[q] * (1.f / 224.f) : 1.f;
      uint4 o4;
      o4.x = pk4_fp8(v[q][0].x * sc, v[q][0].y * sc, v[q][0].z * sc, v[q][0].w * sc);
      o4.y = pk4_fp8(v[q][1].x * sc, v[q][1].y * sc, v[q][1].z * sc, v[q][1].w * sc);
      o4.z = pk4_fp8(v[q][2].x * sc, v[q][2].y * sc, v[q][2].z * sc, v[q][2].w * sc);
      o4.w = pk4_fp8(v[q][3].x * sc, v[q][3].y * sc, v[q][3].z * sc, v[q][3].w * sc);
      ((uint4*)(dst + (size_t)r * 1024))[lane] = o4;
    }
  }
}

DEVI void rownorm_bf16(const float* __restrict__ src, const float* __restrict__ g, u16* __restrict__ dst,
                       int rows, int gw, int nw, int lane) {
  for (int r0 = gw; r0 < rows; r0 += 2 * nw) {
    const int r1 = r0 + nw;
    const bool has1 = r1 < rows;
    const float4* pa = (const float4*)(src + (size_t)r0 * D);
    const float4* pb = (const float4*)(src + (size_t)(has1 ? r1 : r0) * D);
    float4 va[4], vb[4];
    float sa = 0.f, sb = 0.f;
#pragma unroll
    for (int i = 0; i < 4; ++i) { va[i] = pa[lane + 64 * i]; vb[i] = pb[lane + 64 * i]; }
#pragma unroll
    for (int i = 0; i < 4; ++i) {
      sa += va[i].x * va[i].x + va[i].y * va[i].y + va[i].z * va[i].z + va[i].w * va[i].w;
      sb += vb[i].x * vb[i].x + vb[i].y * vb[i].y + vb[i].z * vb[i].z + vb[i].w * vb[i].w;
    }
#pragma unroll
    for (int o = 32; o; o >>= 1) { sa += __shfl_xor(sa, o); sb += __shfl_xor(sb, o); }
    const float ra = rsqrtf(sa * (1.f / D) + 1e-6f), rb = rsqrtf(sb * (1.f / D) + 1e-6f);
#pragma unroll
    for (int i = 0; i < 4; ++i) {
      const float4 gg = ((const float4*)g)[lane + 64 * i];
      uint2 pk;
      pk.x = pack2(va[i].x * ra * gg.x, va[i].y * ra * gg.y);
      pk.y = pack2(va[i].z * ra * gg.z, va[i].w * ra * gg.w);
      *(uint2*)(dst + (size_t)r0 * LDA + (size_t)(lane + 64 * i) * 4) = pk;
      if (has1) {
        pk.x = pack2(vb[i].x * rb * gg.x, vb[i].y * rb * gg.y);
        pk.y = pack2(vb[i].z * rb * gg.z, vb[i].w * rb * gg.w);
        *(uint2*)(dst + (size_t)r1 * LDA + (size_t)(lane + 64 * i) * 4) = pk;
      }
    }
  }
}

DEVI void phase0(const Params& p) {
  const int tid = launder(threadIdx.x), lane = tid & 63;
  const int gtid = blockIdx.x * 256 + tid, gsz = gridDim.x * 256;
  const int gw = gtid >> 6, nw = gsz >> 6;
  rownorm_bf16(p.x, p.mix_g, p.hn, NTOK, gw, nw, lane);
  rownorm_bf16(p.mem, p.memkv_g, p.memn, Bn * 256, gw, nw, lane);
  tconv(p.w_in, 1024, 2328, p.winT, 2432, LDA, nullptr, gtid, gsz);
  tconv(p.w_out, 1024, 1024, p.woutT, 1024, LDA, nullptr, gtid, gsz);
  tconv(p.w_mq, 1024, 1024, p.wmqT, 1024, LDA, p.memq_g, gtid, gsz);
  tconv(p.w_mk, 1024, 1024, p.wmkT, 1024, LDA, nullptr, gtid, gsz);
  tconv(p.w_mv, 1024, 1024, p.wmvT, 1024, LDA, nullptr, gtid, gsz);
  tconv(p.w_mo, 1024, 1024, p.wmoT, 1024, LDA, nullptr, gtid, gsz);
  tconv(p.peer_wq, 1024, 2048, p.wpqT, 2048, LDA, p.peer_g, gtid, gsz);
  tconv(p.cmp_w1, 2048, 128, p.w1T, 128, LDW1, nullptr, gtid, gsz);
  tconv(p.cmp_w1 + 2048 * 128, 2048, 128, p.w1T + 128 * LDW1, 128, LDW1, nullptr, gtid, gsz);
  tconv(p.cmp_w2, 128, 64, p.w2T, 128, 128, nullptr, gtid, gsz);
  tconv(p.cmp_w2 + 128 * 64, 128, 64, p.w2T + 128 * 128, 128, 128, nullptr, gtid, gsz);
  conv_flat(p.peer_sk, p.subk, (size_t)16 * 128 * 128 / 8, gtid, gsz);
  for (int it = gtid; it < NTOK * 8; it += gsz) {
    const int tok = it >> 3, i = it & 7;
    const float inv = (i == 0) ? 1.000000000e+00f : (i == 1) ? 1.939227432e-01f : (i == 2) ? 3.760603070e-02f : (i == 3) ? 7.292664610e-03f : (i == 4) ? 1.414213562e-03f : (i == 5) ? 2.742481884e-04f : (i == 6) ? 5.318295734e-05f : 1.031338525e-05f;
    const float ang = (float)p.pos[tok] * inv;
    float sv, cv;
    sincosf(ang, &sv, &cv);
    p.rope[tok * 16 + i] = cv;
    p.rope[tok * 16 + 8 + i] = sv;
  }
  for (int o = gw; o < 256; o += nw) {
    const int ty = o >> 7, n = o & 127;
    float s = 0.f;
#pragma unroll 8
    for (int k = lane; k < 2048; k += 64)
      s += p.cmp_pos[ty * 2048 + k] * p.cmp_w1[((size_t)ty * 2048 + k) * 128 + n];
    s = wave_sum(s);
    if (lane == 0) p.biasp[o] = s + p.cmp_b1[o];
  }
  for (int it = gtid; it < NTOK; it += gsz) { p.ssq1[it] = 0.f; p.ssq2[it] = 0.f; }
}

template <bool DB, class AF>
DEVI void gemm_mainloop(int tid, u16* sA, u16* sB, AF af, const u16* __restrict__ Bt, int ldb, int m0, int n0, int nk,
                        f32x4 (&acc)[4][4]) {
  const int lane = tid & 63, w = tid >> 6;
  const int wm = w >> 1, wn = w & 1, col = lane & 15, quad = lane >> 4;
#pragma unroll
  for (int i = 0; i < 4; ++i)
#pragma unroll
    for (int j = 0; j < 4; ++j) acc[i][j] = f32x4{0.f, 0.f, 0.f, 0.f};
  uint4 ra0, ra1, ra2, ra3, rb0, rb1, rb2, rb3;
  const int lrow = tid >> 3, lkc = (tid & 7) << 3;
  const u16* bbase = Bt + (size_t)(n0 + lrow) * ldb + lkc;
#define GL_(R, i, kk)                                                     \
  R##a##i = *(const uint4*)af(m0 + lrow + 32 * i, (kk) + lkc);            \
  R##b##i = *(const uint4*)(bbase + (size_t)(32 * i) * ldb + (kk));
#define SS_(R, i, off)                                                    \
  *(uint4*)(sA + (off) + (lrow + 32 * i) * 72 + lkc) = R##a##i;           \
  *(uint4*)(sB + (off) + (lrow + 32 * i) * 72 + lkc) = R##b##i;
#define GL4_(R, kk) GL_(R, 0, kk) GL_(R, 1, kk) GL_(R, 2, kk) GL_(R, 3, kk)
#define SS4_(R, off) SS_(R, 0, off) SS_(R, 1, off) SS_(R, 2, off) SS_(R, 3, off)
#define COMPUTE_(cur)                                                                                                   \
  _Pragma("unroll") for (int ks = 0; ks < 2; ++ks) {                                                                    \
    bf16x8 fa[4], fb[4];                                                                                                \
    _Pragma("unroll") for (int mi = 0; mi < 4; ++mi)                                                                    \
      fa[mi] = *(const bf16x8*)(sA + (cur) + (wm * 64 + 16 * mi + col) * 72 + 32 * ks + 8 * quad);                      \
    _Pragma("unroll") for (int ni = 0; ni < 4; ++ni)                                                                    \
      fb[ni] = *(const bf16x8*)(sB + (cur) + (wn * 64 + 16 * ni + col) * 72 + 32 * ks + 8 * quad);                      \
    _Pragma("unroll") for (int ni = 0; ni < 4; ++ni)                                                                    \
      _Pragma("unroll") for (int mi = 0; mi < 4; ++mi) acc[ni][mi] = mfma16(fb[ni], fa[mi], acc[ni][mi]);               \
  }
  if (DB) {
    const int srow = 8 * w + (lane >> 3);
    const int spc = lane & 7;
#define STAGE_(st, kk)                                                                                         \
    _Pragma("unroll") for (int i = 0; i < 4; ++i) {                                                            \
      const int r_ = 32 * i + srow;                                                                            \
      const int c_ = (spc ^ ((r_ >> 1) & 7)) << 3;                                                             \
      __builtin_amdgcn_global_load_lds((const unsigned*)af(m0 + r_, (kk) + c_),                                \
                                       (unsigned*)(sA + (st) * 16384 + (32 * i + 8 * w) * 64), 16, 0, 0);      \
      __builtin_amdgcn_global_load_lds((const unsigned*)(Bt + (size_t)(n0 + r_) * ldb + (kk) + c_),            \
                                       (unsigned*)(sA + (st) * 16384 + 8192 + (32 * i + 8 * w) * 64), 16, 0, 0); \
    }
#define COMPUTE_SW_(st)                                                                                                 \
  _Pragma("unroll") for (int ks = 0; ks < 2; ++ks) {                                                                    \
    bf16x8 fa[4], fb[4];                                                                                                \
    const int pc_ = ((4 * ks + quad) ^ ((col >> 1) & 7)) << 3;                                                          \
    _Pragma("unroll") for (int mi = 0; mi < 4; ++mi)                                                                    \
      fa[mi] = *(const bf16x8*)(sA + (st) * 16384 + (wm * 64 + 16 * mi + col) * 64 + pc_);                              \
    _Pragma("unroll") for (int ni = 0; ni < 4; ++ni)                                                                    \
      fb[ni] = *(const bf16x8*)(sA + (st) * 16384 + 8192 + (wn * 64 + 16 * ni + col) * 64 + pc_);                       \
    __builtin_amdgcn_s_setprio(1);                                                                                      \
    _Pragma("unroll") for (int ni = 0; ni < 4; ++ni)                                                                    \
      _Pragma("unroll") for (int mi = 0; mi < 4; ++mi) acc[ni][mi] = mfma16(fb[ni], fa[mi], acc[ni][mi]);               \
    __builtin_amdgcn_s_setprio(0);                                                                                      \
  }
    STAGE_(0, 0)
#pragma unroll 1
    for (int kt = 0; kt < nk; kt += 2) {
      asm volatile("s_waitcnt vmcnt(0)" ::: "memory");
      __syncthreads();
      { const int kk = (kt + 1) * 64; STAGE_(1, kk) }
      COMPUTE_SW_(0)
      asm volatile("s_waitcnt vmcnt(0)" ::: "memory");
      __syncthreads();
      if (kt + 2 < nk) { const int kk = (kt + 2) * 64; STAGE_(0, kk) }
      COMPUTE_SW_(1)
    }
#undef STAGE_
#undef COMPUTE_SW_
  } else {
    GL4_(r, 0)
    SS4_(r, 0)
    __syncthreads();
#pragma unroll 1
    for (int kt = 0; kt < nk; ++kt) {
      const bool more = (kt + 1 < nk);
      if (more) { const int kk = (kt + 1) * 64; GL4_(r, kk) }
      COMPUTE_(0)
      __syncthreads();
      if (more) {
        SS4_(r, 0)
        __syncthreads();
      }
    }
  }
#undef GL_
#undef SS_
#undef GL4_
#undef SS4_
#undef COMPUTE_
}

struct ARow {
  const u16* base; int lda;
  DEVI const u16* operator()(int m, int k) const { return base + (size_t)m * lda + k; }
};
struct ACmp {
  const u16* proj; int colbase;
  DEVI const u16* operator()(int rr, int k) const {
    const int b = rr >> 8, g = (rr >> 7) & 1;
    int c = rr & 127; c = c > 126 ? 126 : c;
    const int l = k >> 6, d = k & 63;
    return proj + ((size_t)b * T + 16 * c + l) * LDP + colbase + g * 64 + d;
  }
};


#define XCD_TILE_LOOP(idx, MT, NT)                                                                     \
  const bool sw_ = (gridDim.x & 7) == 0;                                                               \
  const int xcd_ = blockIdx.x & 7;                                                                     \
  const int tstart_ = sw_ ? (int)(blockIdx.x >> 3) : (int)blockIdx.x;                                  \
  const int tstep_ = sw_ ? (int)(gridDim.x >> 3) : (int)gridDim.x;                                     \
  const int ttotal_ = sw_ ? ((MT) / 8) * (NT) : (MT) * (NT);                                           \
  _Pragma("unroll 1") for (int idx = tstart_; idx < ttotal_; idx += tstep_)
#define XCD_TILE_MT(idx, NT) (sw_ ? ((idx) / (NT)) * 8 + xcd_ : (idx) / (NT))
#define XCD_TILE_NT(idx, NT) ((idx) % (NT))

#define GEMM_LANE_VARS                                                    \
  const int tid = launder(threadIdx.x), lane = tid & 63, w = tid >> 6;    \
  const int wm = w >> 1, wn = w & 1, col = lane & 15, quad = lane >> 4;   \
  (void)wm; (void)wn; (void)col; (void)quad;

DEVI void phase1(const Params& p, unsigned char* smem) {
  u16* sA = (u16*)smem; u16* sB = sA + 128 * 72;
  XCD_TILE_LOOP(idx, 256 + 32, 19) {
    GEMM_LANE_VARS
    f32x4 acc[4][4];
    const int mt = XCD_TILE_MT(idx, 19), nt_ = XCD_TILE_NT(idx, 19);
    if (mt < 256) {
      const int m0 = mt * 128, n0 = nt_ * 128;
      gemm_mainloop<true>(tid, sA, sB, ARow{p.hn, LDA}, p.winT, LDA, m0, n0, 16, acc);
#pragma unroll
      for (int mi = 0; mi < 4; ++mi) {
        const int m = m0 + wm * 64 + 16 * mi + col;
        const int b = m >> 11, t = m & 2047;
#pragma unroll
        for (int ni = 0; ni < 4; ++ni) {
          const int nt = n0 + wn * 64 + 16 * ni;
          const int n = nt + 4 * quad;
          f32x4 v = acc[ni][mi];
          if (nt >= LDP) continue;
          if ((nt >= C_VS && nt < C_KW) || (nt >= C_VW && nt < C_GATE)) {
            const bool isw = nt >= C_VW;
            const int off = n - (isw ? C_VW : C_VS);
            const int g = off >> 6, d = off & 63;
            u16* dst = (isw ? p.vtw : p.vts) + ((size_t)(b * 2 + g) * 64 + d) * LDT + t;
#pragma unroll
            for (int r = 0; r < 4; ++r) dst[(size_t)r * LDT] = f2bf(v[r]);
          } else {
            const bool rope_tile = ((nt >= C_KS && nt < C_VS) || (nt >= C_KW && nt < C_VW)) && ((nt & 63) == 0);
            if (rope_tile) {
#pragma unroll
              for (int r = 0; r < 4; ++r) {
                const float pr = __shfl_xor(v[r], 32);
                const int i = ((quad & 1) << 2) + r;
                const float cs = p.rope[(size_t)m * 16 + i], sn = p.rope[(size_t)m * 16 + 8 + i];
                v[r] = (quad < 2) ? (v[r] * cs - pr * sn) : (v[r] * cs + pr * sn);
              }
            }
            uint2 pk; pk.x = pack2(v[0], v[1]); pk.y = pack2(v[2], v[3]);
            *(uint2*)(p.proj + (size_t)m * LDP + n) = pk;
          }
        }
      }
    } else if (nt_ < 16) {
      const int isv = nt_ >> 3;
      const int m0 = (mt - 256) * 128, n0 = (nt_ & 7) * 128;
      gemm_mainloop<true>(tid, sA, sB, ARow{p.memn, LDA}, isv ? p.wmvT : p.wmkT, LDA, m0, n0, 16, acc);
#pragma unroll
      for (int mi = 0; mi < 4; ++mi) {
        const int m = m0 + wm * 64 + 16 * mi + col;
        const int b = m >> 8, key = m & 255;
#pragma unroll
        for (int ni = 0; ni < 4; ++ni) {
          const int n = n0 + wn * 64 + 16 * ni + 4 * quad;
          const f32x4 v = acc[ni][mi];
          if (isv) {
            const int head = n >> 8, d = n & 255;
            u16* dst = p.memvt + ((size_t)(b * 4 + head) * 256 + d) * 256 + key;
#pragma unroll
            for (int r = 0; r < 4; ++r) dst[r * 256] = f2bf(v[r]);
          } else {
            uint2 pk; pk.x = pack2(v[0], v[1]); pk.y = pack2(v[2], v[3]);
            *(uint2*)(p.memk + (size_t)m * LDA + n) = pk;
          }
        }
      }
    }
  }
}

DEVI void conv_tile(const Params& p, unsigned char* smem, int ct) {
  u16* sU = (u16*)smem;
  float2* sRed = (float2*)(smem + 62 * 512 * 2);
  const int tid = launder(threadIdx.x), lane = tid & 63, w = tid >> 6;
  const int b = ct >> 6, t0 = (ct & 63) * 32;
  __syncthreads();
  for (int it = tid; it < 62 * 64; it += 256) {
    const int r = it >> 6, c8 = it & 63;
    const int t = t0 - 30 + r;
    uint4 pk = {0u, 0u, 0u, 0u};
    if (t >= 0) {
      const u16* src = p.proj + ((size_t)b * T + t) * LDP + c8 * 8;
      const uint4 a = *(const uint4*)src, bb = *(const uint4*)(src + 512);
      const unsigned au[4] = {a.x, a.y, a.z, a.w}, bu[4] = {bb.x, bb.y, bb.z, bb.w};
      unsigned o[4];
#pragma unroll
      for (int j = 0; j < 4; ++j) {
        const float a0 = __uint_as_float(au[j] << 16), a1 = __uint_as_float(au[j] & 0xffff0000u);
        const float b0 = __uint_as_float(bu[j] << 16), b1 = __uint_as_float(bu[j] & 0xffff0000u);
        o[j] = pack2(a0 * sigmoidf_(b0), a1 * sigmoidf_(b1));
      }
      pk.x = o[0]; pk.y = o[1]; pk.z = o[2]; pk.w = o[3];
    }
    *(uint4*)(sU + r * 512 + c8 * 8) = pk;
  }
  const int c = 2 * tid;
  float w0[31], w1[31];
#pragma unroll
  for (int j = 0; j < 31; ++j) { w0[j] = p.conv_w[j * 512 + c]; w1[j] = p.conv_w[j * 512 + c + 1]; }
  const float bd0 = p.conv_b[c], bd1 = p.conv_b[c + 1];
  __syncthreads();
  float ya[32], yb[32];
#pragma unroll
  for (int tt = 0; tt < 32; ++tt) {
    float y0 = bd0, y1 = bd1;
#pragma unroll
    for (int j = 0; j < 31; ++j) {
      const unsigned uu = *(const unsigned*)(sU + (tt + j) * 512 + c);
      y0 += w0[j] * __uint_as_float(uu << 16);
      y1 += w1[j] * __uint_as_float(uu & 0xffff0000u);
    }
    ya[tt] = y0; yb[tt] = y1;
    float s = y0 + y1, q = y0 * y0 + y1 * y1;
    s = wave_sum(s); q = wave_sum(q);
    if (lane == 0) sRed[tt * 4 + w] = make_float2(s, q);
  }
  __syncthreads();
  const float g0 = p.ln_g[c], g1 = p.ln_g[c + 1], lb0 = p.ln_b[c], lb1 = p.ln_b[c + 1];
#pragma unroll
  for (int tt = 0; tt < 32; ++tt) {
    const float y0 = ya[tt], y1 = yb[tt];
    const float2 r0 = sRed[tt * 4 + 0], r1 = sRed[tt * 4 + 1], r2 = sRed[tt * 4 + 2], r3 = sRed[tt * 4 + 3];
    const float S = r0.x + r1.x + r2.x + r3.x, Q = r0.y + r1.y + r2.y + r3.y;
    const float mu = S * (1.f / 512.f);
    const float var = fmaxf(Q * (1.f / 512.f) - mu * mu, 0.f);
    const float rstd = rsqrtf(var + 1e-6f);
    const float z0 = (y0 - mu) * rstd * g0 + lb0, z1 = (y1 - mu) * rstd * g1 + lb1;
    const float o0 = z0 * sigmoidf_(z0), o1 = z1 * sigmoidf_(z1);
    *(unsigned*)(p.mix + ((size_t)b * T + t0 + tt) * LDA + c) = pack2(o0, o1);
  }
}

DEVI void compress2_tile(const Params& p, unsigned char* smem, int tile);
DEVI void phase2(const Params& p, unsigned char* smem) {
  u16* sA = (u16*)smem; u16* sB = sA + 128 * 72;
#pragma unroll 1
  for (int tile = blockIdx.x; tile < 64 + 1024; tile += gridDim.x) {
    GEMM_LANE_VARS
    if (tile < 64) {
      const int ty = tile >> 5, mt = tile & 31;
      const int m0 = mt * 128;
      f32x4 acc[4][4];
      gemm_mainloop<true>(tid, sA, sB, ACmp{p.proj, ty ? C_VC : C_KC}, p.w1T + (size_t)ty * 128 * LDW1, LDW1, m0, 0, 32, acc);
#pragma unroll
      for (int mi = 0; mi < 4; ++mi) {
        const int m = m0 + wm * 64 + 16 * mi + col;
#pragma unroll
        for (int ni = 0; ni < 4; ++ni) {
          const int n = wn * 64 + 16 * ni + 4 * quad;
          const f32x4 v = acc[ni][mi];
          const float4 bb = *(const float4*)(p.biasp + ty * 128 + n);
          uint2 pk;
          pk.x = pack2(gelu_tanh(v[0] + bb.x), gelu_tanh(v[1] + bb.y));
          pk.y = pack2(gelu_tanh(v[2] + bb.z), gelu_tanh(v[3] + bb.w));
          *(uint2*)(p.hdn + ((size_t)ty * 4096 + m) * 128 + n) = pk;
        }
      }
      asm volatile("s_waitcnt vmcnt(0)" ::: "memory");
      __syncthreads();
      compress2_tile(p, smem, tile);
    } else {
      conv_tile(p, smem, tile - 64);
    }
  }
}

DEVI void compress2_tile(const Params& p, unsigned char* smem, int tile) {
  u16* sA = (u16*)smem; u16* sB = sA + 128 * 72;
  {
    GEMM_LANE_VARS
    const int ty = tile >> 5, mt = tile & 31;
    const int m0 = mt * 128;
    f32x4 acc[4][4];
    gemm_mainloop<true>(tid, sA, sB, ARow{p.hdn + (size_t)ty * 4096 * 128, 128}, p.w2T + (size_t)ty * 128 * 128, 128, m0, 0, 2, acc);
    if (wn == 0) {
#pragma unroll
      for (int mi = 0; mi < 4; ++mi) {
        const int m = m0 + 16 * mi + wm * 64 + col;
        const int bg = m >> 7, c = m & 127;
#pragma unroll
        for (int ni = 0; ni < 4; ++ni) {
          const int n = 16 * ni + 4 * quad;
          const f32x4 v = acc[ni][mi];
          const float4 bb = *(const float4*)(p.cmp_b2 + ty * 64 + n);
          const float o0 = v[0] + bb.x, o1 = v[1] + bb.y, o2 = v[2] + bb.z, o3 = v[3] + bb.w;
          if (ty == 0) {
            uint2 pk; pk.x = pack2(o0, o1); pk.y = pack2(o2, o3);
            *(uint2*)(p.kc + (size_t)m * 64 + n) = pk;
          } else {
            u16* dst = p.vcT + ((size_t)bg * 64 + n) * 128 + c;
            dst[0] = f2bf(o0); dst[128] = f2bf(o1); dst[256] = f2bf(o2); dst[384] = f2bf(o3);
          }
        }
      }
    }
  }
}

template <int DH, int NQ, int LDK, class MaskF>
DEVI void attn_qk(const u16* sK, const bf16x8 (&qf)[NQ][DH / 32], f32x4 (&o)[NQ][DH / 16], float (&m)[NQ], float (&l)[NQ],
                  float c2, int lane, MaskF valid, bf16x8 (&pb)[NQ][2]) {
  const int col = lane & 15, quad = lane >> 4;
  f32x4 s[NQ][4];
  __builtin_amdgcn_s_setprio(1);
#pragma unroll
  for (int kt = 0; kt < 4; ++kt) {
#pragma unroll
    for (int qt = 0; qt < NQ; ++qt) s[qt][kt] = f32x4{0.f, 0.f, 0.f, 0.f};
#pragma unroll
    for (int ks = 0; ks < DH / 32; ++ks) {
      const bf16x8 kf = *(const bf16x8*)(sK + (16 * kt + col) * LDK + 32 * ks + 8 * quad);
#pragma unroll
      for (int qt = 0; qt < NQ; ++qt) s[qt][kt] = mfma16(kf, qf[qt][ks], s[qt][kt]);
    }
  }
  __builtin_amdgcn_s_setprio(0);
#pragma unroll
  for (int qt = 0; qt < NQ; ++qt) {
    float mx = -1e30f;
#pragma unroll
    for (int kt = 0; kt < 4; ++kt)
#pragma unroll
      for (int r = 0; r < 4; ++r) {
        const bool v = valid(qt, 16 * kt + 4 * quad + r);
        const float sv = v ? s[qt][kt][r] : -1e30f;
        s[qt][kt][r] = sv;
        mx = fmaxf(mx, sv);
      }
    mx = fmaxf(mx, __shfl_xor(mx, 16));
    mx = fmaxf(mx, __shfl_xor(mx, 32));
    const float mn = fmaxf(m[qt], mx);
    const float alpha = fexp2((m[qt] - mn) * c2);
    m[qt] = mn;
    const float mc = fmaxf(mn, -1e20f) * c2;
    float ps = 0.f;
#pragma unroll
    for (int kt = 0; kt < 4; ++kt)
#pragma unroll
      for (int r = 0; r < 4; ++r) {
        const float pv = fexp2(__builtin_fmaf(s[qt][kt][r], c2, -mc));
        ps += pv;
        s[qt][kt][r] = pv;
      }
    l[qt] = l[qt] * alpha + ps;
#pragma unroll
    for (int dt = 0; dt < DH / 16; ++dt) o[qt][dt] *= alpha;
#pragma unroll
    for (int kk = 0; kk < 2; ++kk) {
      union { bf16x8 v; unsigned u[4]; } cv;
      cv.u[0] = pack2(s[qt][2 * kk][0], s[qt][2 * kk][1]);
      cv.u[1] = pack2(s[qt][2 * kk][2], s[qt][2 * kk][3]);
      cv.u[2] = pack2(s[qt][2 * kk + 1][0], s[qt][2 * kk + 1][1]);
      cv.u[3] = pack2(s[qt][2 * kk + 1][2], s[qt][2 * kk + 1][3]);
      pb[qt][kk] = cv.v;
    }
  }
}
template <int DH, int NQ, int LDV>
DEVI void attn_pv(const u16* sVt, const bf16x8 (&pb)[NQ][2], f32x4 (&o)[NQ][DH / 16], int lane) {
  const int col = lane & 15, quad = lane >> 4;
  __builtin_amdgcn_s_setprio(1);
#pragma unroll
  for (int dt = 0; dt < DH / 16; ++dt) {
#pragma unroll
    for (int kk = 0; kk < 2; ++kk) {
      union { bf16x8 v; uint2 h[2]; } cv;
      cv.h[0] = *(const uint2*)(sVt + (16 * dt + col) * LDV + 32 * kk + 4 * quad);
      cv.h[1] = *(const uint2*)(sVt + (16 * dt + col) * LDV + 32 * kk + 16 + 4 * quad);
#pragma unroll
      for (int qt = 0; qt < NQ; ++qt) o[qt][dt] = mfma16(cv.v, pb[qt][kk], o[qt][dt]);
    }
  }
  __builtin_amdgcn_s_setprio(0);
}
template <int DH, int NQ, int LDK, int LDV, class MaskF>
DEVI void attn_tile(const u16* sK, const u16* sVt, const bf16x8 (&qf)[NQ][DH / 32], f32x4 (&o)[NQ][DH / 16],
                    float (&m)[NQ], float (&l)[NQ], float c2, int lane, MaskF valid) {
  bf16x8 pb[NQ][2];
  attn_qk<DH, NQ, LDK>(sK, qf, o, m, l, c2, lane, valid, pb);
  attn_pv<DH, NQ, LDV>(sVt, pb, o, lane);
}

DEVI void phase_nsa(const Params& p, unsigned char* smem) {
  u16* sK = (u16*)smem;
  u16* sVt = (u16*)(smem + 18432);
  float* impH = (float*)(smem + 35840);
  float* impT = (float*)(smem + 52736);
  unsigned* selm = (unsigned*)(smem + 56960);
  const float c2 = 0.125f * 1.4426950408889634f;
#pragma unroll 1
  for (int tile = blockIdx.x; tile < 2048; tile += gridDim.x) {
    const int tid = launder(threadIdx.x), lane = tid & 63, w = tid >> 6, col = lane & 15, quad = lane >> 4;
    const int qtile = 63 - (tile >> 5), bg = tile & 31, b = bg >> 1, g = bg & 1, q0 = qtile * 32;
    const int h = g * 4 + w;
    __syncthreads();
    if (tid < 32) selm[tid] = 0u;
    {
      const u16* kcp = p.kc + (size_t)bg * 128 * 64;
      const u16* vcp = p.vcT + (size_t)bg * 64 * 128;
#pragma unroll
      for (int i = 0; i < 4; ++i) {
        const int c = tid + 256 * i;
        const int row = c >> 3, ch = (c & 7) << 3;
        *(uint4*)(sK + row * 72 + ch) = *(const uint4*)(kcp + row * 64 + ch);
        const int row2 = c >> 4, ch2 = (c & 15) << 3;
        *(uint4*)(sVt + row2 * 136 + ch2) = *(const uint4*)(vcp + row2 * 128 + ch2);
      }
    }
    bf16x8 qf[2][2];
    float gate[2][3];
    int tq[2];
#pragma unroll
    for (int qt = 0; qt < 2; ++qt) {
      const int t = q0 + 16 * qt + col;
      tq[qt] = t;
      const size_t tok = (size_t)b * T + t;
      const u16* qp = p.proj + tok * LDP + C_Q + h * 64 + 8 * quad;
      qf[qt][0] = *(const bf16x8*)qp;
      qf[qt][1] = *(const bf16x8*)(qp + 32);
#pragma unroll
      for (int br = 0; br < 3; ++br) gate[qt][br] = sigmoidf_(bf2f(p.proj[tok * LDP + C_GATE + h * 3 + br]));
    }
    __syncthreads();

    f32x4 comb[2][4];
    {
      const int srcl = (lane + 48) & 63;
#pragma unroll
      for (int qt = 0; qt < 2; ++qt) {
        f32x4 s[8];
#pragma unroll
        for (int kt = 0; kt < 8; ++kt) {
          s[kt] = f32x4{0.f, 0.f, 0.f, 0.f};
#pragma unroll
          for (int ks = 0; ks < 2; ++ks) {
            const bf16x8 kf = *(const bf16x8*)(sK + (16 * kt + col) * 72 + 32 * ks + 8 * quad);
            s[kt] = mfma16(kf, qf[qt][ks], s[kt]);
          }
        }
        const int t = tq[qt];
        float mx = -1e30f;
#pragma unroll
        for (int kt = 0; kt < 8; ++kt)
#pragma unroll
          for (int r = 0; r < 4; ++r) {
            const int c = 16 * kt + 4 * quad + r;
            const bool v = (16 * c + 31) <= t;
            const float sv = v ? s[kt][r] : -1e30f;
            s[kt][r] = sv;
            mx = fmaxf(mx, sv);
          }
        mx = fmaxf(mx, __shfl_xor(mx, 16));
        mx = fmaxf(mx, __shfl_xor(mx, 32));
        float ps = 0.f;
        const float mcc = fmaxf(mx, -1e20f) * c2;
#pragma unroll
        for (int kt = 0; kt < 8; ++kt)
#pragma unroll
          for (int r = 0; r < 4; ++r) {
            const float pv = fexp2(__builtin_fmaf(s[kt][r], c2, -mcc));
            ps += pv;
            s[kt][r] = pv;
          }
        ps += __shfl_xor(ps, 16);
        ps += __shfl_xor(ps, 32);
        const float inv = ps > 0.f ? 1.f / ps : 0.f;
#pragma unroll
        for (int kt = 0; kt < 8; ++kt)
#pragma unroll
          for (int r = 0; r < 4; ++r) s[kt][r] *= inv;
        float prev3 = 0.f;
#pragma unroll
        for (int kt = 0; kt < 8; ++kt) {
          const float sum4 = s[kt][0] + s[kt][1] + s[kt][2] + s[kt][3];
          const float xs = __shfl(s[kt][3], srcl);
          const float extra = quad ? xs : prev3;
          prev3 = xs;
          impH[(w * 32 + 16 * qt + col) * 33 + 4 * kt + quad] = sum4 + extra;
        }
        bf16x8 pb[4];
#pragma unroll
        for (int kk = 0; kk < 4; ++kk) {
          union { bf16x8 v; unsigned u[4]; } cv;
          cv.u[0] = pack2(s[2 * kk][0], s[2 * kk][1]);
          cv.u[1] = pack2(s[2 * kk][2], s[2 * kk][3]);
          cv.u[2] = pack2(s[2 * kk + 1][0], s[2 * kk + 1][1]);
          cv.u[3] = pack2(s[2 * kk + 1][2], s[2 * kk + 1][3]);
          pb[kk] = cv.v;
        }
#pragma unroll
        for (int dt = 0; dt < 4; ++dt) {
          f32x4 oc = f32x4{0.f, 0.f, 0.f, 0.f};
#pragma unroll
          for (int kk = 0; kk < 4; ++kk) {
            union { bf16x8 v; uint2 hh[2]; } cv;
            cv.hh[0] = *(const uint2*)(sVt + (16 * dt + col) * 136 + 32 * kk + 4 * quad);
            cv.hh[1] = *(const uint2*)(sVt + (16 * dt + col) * 136 + 32 * kk + 16 + 4 * quad);
            oc = mfma16(cv.v, pb[kk], oc);
          }
          comb[qt][dt] = oc * gate[qt][0];
        }
      }
    }
#pragma unroll
    for (int qt = 0; qt < 2; ++qt) {
      const size_t tok = (size_t)b * T + tq[qt];
      union { bf16x8 v; unsigned u[4]; } own, par, res;
      own.v = qf[qt][0];
#pragma unroll
      for (int j = 0; j < 4; ++j) par.u[j] = (unsigned)__shfl_xor((int)own.u[j], 16);
      const float4 c0 = *(const float4*)(p.rope + tok * 16), c1 = *(const float4*)(p.rope + tok * 16 + 4);
      const float4 s0 = *(const float4*)(p.rope + tok * 16 + 8), s1 = *(const float4*)(p.rope + tok * 16 + 12);
      const float cs[8] = {c0.x, c0.y, c0.z, c0.w, c1.x, c1.y, c1.z, c1.w};
      const float sn[8] = {s0.x, s0.y, s0.z, s0.w, s1.x, s1.y, s1.z, s1.w};
#pragma unroll
      for (int j = 0; j < 4; ++j) {
        const float o0 = __uint_as_float(own.u[j] << 16), o1 = __uint_as_float(own.u[j] & 0xffff0000u);
        const float p0 = __uint_as_float(par.u[j] << 16), p1 = __uint_as_float(par.u[j] & 0xffff0000u);
        const float sg = (quad == 0) ? -1.f : 1.f;
        const float r0 = o0 * cs[2 * j] + sg * p0 * sn[2 * j];
        const float r1 = o1 * cs[2 * j + 1] + sg * p1 * sn[2 * j + 1];
        res.u[j] = (quad < 2) ? pack2(r0, r1) : own.u[j];
      }
      qf[qt][0] = res.v;
    }
    __syncthreads();
#pragma unroll
    for (int i = 0; i < 4; ++i) {
      const int cell = tid + 256 * i;
      const int qi = cell >> 5, s_ = cell & 31;
      const int cur = (q0 + qi) >> 6;
      float v = impH[(0 * 32 + qi) * 33 + s_] + impH[(1 * 32 + qi) * 33 + s_] + impH[(2 * 32 + qi) * 33 + s_] +
                impH[(3 * 32 + qi) * 33 + s_];
      const int dist = cur - s_;
      const bool forced = (s_ == 0) || (dist >= 0 && dist < 2);
      v = forced ? 1e9f : (s_ <= cur ? v : -1.f);
      impT[qi * 33 + s_] = v;
    }
    __syncthreads();
    {
      const int qi = tid >> 3, sub = tid & 7;
      unsigned bits = 0u;
#pragma unroll
      for (int k = 0; k < 4; ++k) {
        const int s_ = sub * 4 + k;
        const float v = impT[qi * 33 + s_];
        int rank = 0;
        for (int s2 = 0; s2 < 32; ++s2) {
          const float v2 = impT[qi * 33 + s2];
          rank += ((v2 > v) || (v2 == v && s2 < s_)) ? 1 : 0;
        }
        if (rank < 16) bits |= 1u << s_;
      }
      atomicOr(&selm[qi], bits);
    }
    __syncthreads();
    unsigned sm[2] = {selm[col], selm[16 + col]};
    unsigned uni = 0u;
#pragma unroll
    for (int i = 0; i < 32; ++i) uni |= selm[i];
    const int kbmax = (q0 + 31) >> 6;
    {
      float m[2] = {-1e30f, -1e30f}, l[2] = {0.f, 0.f};
      f32x4 o[2][4];
#pragma unroll
      for (int qt = 0; qt < 2; ++qt)
#pragma unroll
        for (int dt = 0; dt < 4; ++dt) o[qt][dt] = f32x4{0.f, 0.f, 0.f, 0.f};
      unsigned rem = (kbmax >= 31) ? uni : (uni & ((1u << (kbmax + 1)) - 1u));
      int kb = rem ? (__ffs((int)rem) - 1) : -1;
      uint4 rk0, rk1, rv0, rv1;
      const int lr0 = tid >> 3, lch = (tid & 7) << 3;
#define LOADKV_(kbx, CK, VT)                                                                                         \
      rk0 = *(const uint4*)(p.proj + ((size_t)b * T + (kbx) * 64 + lr0) * LDP + (CK) + g * 64 + lch);                 \
      rk1 = *(const uint4*)(p.proj + ((size_t)b * T + (kbx) * 64 + lr0 + 32) * LDP + (CK) + g * 64 + lch);            \
      rv0 = *(const uint4*)((VT) + ((size_t)bg * 64 + lr0) * LDT + (kbx) * 64 + lch);                                 \
      rv1 = *(const uint4*)((VT) + ((size_t)bg * 64 + lr0 + 32) * LDT + (kbx) * 64 + lch);
#define STOREKV_()                                                                                                   \
      *(uint4*)(sK + lr0 * 72 + lch) = rk0; *(uint4*)(sK + (lr0 + 32) * 72 + lch) = rk1;                              \
      *(uint4*)(sVt + lr0 * 72 + lch) = rv0; *(uint4*)(sVt + (lr0 + 32) * 72 + lch) = rv1;
      if (kb >= 0) { LOADKV_(kb, C_KS, p.vts) }
#pragma unroll 1
      while (kb >= 0) {
        rem &= rem - 1u;
        const int nkb = rem ? (__ffs((int)rem) - 1) : -1;
        __syncthreads();
        STOREKV_()
        if (nkb >= 0) { LOADKV_(nkb, C_KS, p.vts) }
        __syncthreads();
        const int lim0 = ((sm[0] >> kb) & 1u) ? tq[0] : -1, lim1 = ((sm[1] >> kb) & 1u) ? tq[1] : -1;
        attn_tile<64, 2, 72, 72>(sK, sVt, qf, o, m, l, c2, lane, [&](int qt, int kl) {
          return (kb * 64 + kl) <= (qt ? lim1 : lim0);
        });
        kb = nkb;
      }
#pragma unroll
      for (int qt = 0; qt < 2; ++qt) {
        float lt = l[qt];
        lt += __shfl_xor(lt, 16);
        lt += __shfl_xor(lt, 32);
        const float sc = lt > 0.f ? gate[qt][1] / lt : 0.f;
#pragma unroll
        for (int dt = 0; dt < 4; ++dt) comb[qt][dt] += o[qt][dt] * sc;
      }
    }
    {
      float m[2] = {-1e30f, -1e30f}, l[2] = {0.f, 0.f};
      f32x4 o[2][4];
#pragma unroll
      for (int qt = 0; qt < 2; ++qt)
#pragma unroll
        for (int dt = 0; dt < 4; ++dt) o[qt][dt] = f32x4{0.f, 0.f, 0.f, 0.f};
      const int kblo = (q0 >= 511) ? ((q0 - 511) >> 6) : 0;
      uint4 rk0, rk1, rv0, rv1;
      const int lr0 = tid >> 3, lch = (tid & 7) << 3;
      int kb = kblo;
      LOADKV_(kb, C_KW, p.vtw)
#pragma unroll 1
      while (kb >= 0) {
        const int nkb = (kb < kbmax) ? kb + 1 : -1;
        __syncthreads();
        STOREKV_()
        if (nkb >= 0) { LOADKV_(nkb, C_KW, p.vtw) }
        __syncthreads();
        attn_tile<64, 2, 72, 72>(sK, sVt, qf, o, m, l, c2, lane, [&](int qt, int kl) {
          return (unsigned)(tq[qt] - (kb * 64 + kl)) < 512u;
        });
        kb = nkb;
      }
#undef LOADKV_
#undef STOREKV_
#pragma unroll
      for (int qt = 0; qt < 2; ++qt) {
        float lt = l[qt];
        lt += __shfl_xor(lt, 16);
        lt += __shfl_xor(lt, 32);
        const float sc = lt > 0.f ? gate[qt][2] / lt : 0.f;
#pragma unroll
        for (int dt = 0; dt < 4; ++dt) comb[qt][dt] += o[qt][dt] * sc;
      }
    }
#pragma unroll
    for (int qt = 0; qt < 2; ++qt) {
      const size_t tok = (size_t)b * T + tq[qt];
#pragma unroll
      for (int dt = 0; dt < 4; ++dt) {
        uint2 pk;
        pk.x = pack2(comb[qt][dt][0], comb[qt][dt][1]);
        pk.y = pack2(comb[qt][dt][2], comb[qt][dt][3]);
        *(uint2*)(p.mix + tok * LDA + 512 + h * 64 + 16 * dt + 4 * quad) = pk;
      }
    }
  }
}

template <bool RESB>
DEVI void phase_resid(const Params& p, unsigned char* smem, const u16* A, const u16* Wt, const float* res, float* ssq) {
  u16* sA = (u16*)smem; u16* sB = sA + 128 * 72;
  XCD_TILE_LOOP(idx, 256, 8) {
    GEMM_LANE_VARS
    const int mt = XCD_TILE_MT(idx, 8), nt_ = XCD_TILE_NT(idx, 8);
    const int m0 = mt * 128, n0 = nt_ * 128;
    f32x4 acc[4][4];
    gemm_mainloop<true>(tid, sA, sB, ARow{A, LDA}, Wt, LDA, m0, n0, 16, acc);
#pragma unroll
    for (int mi = 0; mi < 4; ++mi) {
      const int m = m0 + wm * 64 + 16 * mi + col;
      float ss = 0.f;
#pragma unroll
      for (int ni = 0; ni < 4; ++ni) {
        const int n = n0 + wn * 64 + 16 * ni + 4 * quad;
        const f32x4 v = acc[ni][mi];
        float4 r;
        if (RESB) {
          const uint2 rb = *(const uint2*)(p.hn + (size_t)m * LDA + n);
          r.x = __uint_as_float(rb.x << 16); r.y = __uint_as_float(rb.x & 0xffff0000u);
          r.z = __uint_as_float(rb.y << 16); r.w = __uint_as_float(rb.y & 0xffff0000u);
        } else {
          r = *(const float4*)(res + (size_t)m * D + n);
        }
        float4 hv;
        hv.x = r.x + v[0]; hv.y = r.y + v[1]; hv.z = r.z + v[2]; hv.w = r.w + v[3];
        ss += hv.x * hv.x + hv.y * hv.y + hv.z * hv.z + hv.w * hv.w;
        uint2 pk; pk.x = pack2(hv.x, hv.y); pk.y = pack2(hv.z, hv.w);
        *(uint2*)(p.hn + (size_t)m * LDA + n) = pk;
      }
      ss += __shfl_xor(ss, 16);
      ss += __shfl_xor(ss, 32);
      if (quad == 0) atomicAdd(ssq + m, ss);
    }
  }
}

DEVI void phase_scaled(const Params& p, unsigned char* smem, const u16* A, const u16* Wt, int ntn, const float* ssq, u16* outp, int ldo) {
  u16* sA = (u16*)smem; u16* sB = sA + 128 * 72;
  XCD_TILE_LOOP(idx, 256, ntn) {
    GEMM_LANE_VARS
    const int mt = XCD_TILE_MT(idx, ntn), nt_ = XCD_TILE_NT(idx, ntn);
    const int m0 = mt * 128, n0 = nt_ * 128;
    f32x4 acc[4][4];
    gemm_mainloop<true>(tid, sA, sB, ARow{A, LDA}, Wt, LDA, m0, n0, 16, acc);
#pragma unroll
    for (int mi = 0; mi < 4; ++mi) {
      const int m = m0 + wm * 64 + 16 * mi + col;
      const float rstd = rsqrtf(ssq[m] * (1.f / D) + 1e-6f);
#pragma unroll
      for (int ni = 0; ni < 4; ++ni) {
        const int n = n0 + wn * 64 + 16 * ni + 4 * quad;
        const f32x4 v = acc[ni][mi];
        uint2 pk; pk.x = pack2(v[0] * rstd, v[1] * rstd); pk.y = pack2(v[2] * rstd, v[3] * rstd);
        *(uint2*)(outp + (size_t)m * ldo + n) = pk;
      }
    }
  }
}

DEVI void phase_memattn(const Params& p, unsigned char* smem) {
  u16* sK = (u16*)smem;
  u16* sVt = (u16*)(smem + 33792);
  const float c2 = 0.0625f * 1.4426950408889634f;
#pragma unroll 1
  for (int tile = blockIdx.x; tile < 2048; tile += gridDim.x) {
    const int tid = launder(threadIdx.x), lane = tid & 63, w = tid >> 6, col = lane & 15, quad = lane >> 4;
    const int b = tile >> 7, head = (tile >> 5) & 3, q0 = (tile & 31) * 64;
    const size_t tok = (size_t)b * T + q0 + 16 * w + col;
    bf16x8 qf[1][8];
#pragma unroll
    for (int ks = 0; ks < 8; ++ks) qf[0][ks] = *(const bf16x8*)(p.qm + tok * LDA + head * 256 + 32 * ks + 8 * quad);
    float m[1] = {-1e30f}, l[1] = {0.f};
    f32x4 o[1][16];
#pragma unroll
    for (int dt = 0; dt < 16; ++dt) o[0][dt] = f32x4{0.f, 0.f, 0.f, 0.f};
    uint4 rg0, rg1, rg2, rg3, rg4, rg5, rg6, rg7;
    const int krow = tid >> 5, kch = (tid & 31) << 3;
    const int vrow = tid >> 3, vch = (tid & 7) << 3;
#define LK1_(i, kbx) rg##i = *(const uint4*)(p.memk + ((size_t)b * 256 + (kbx) * 64 + krow + 8 * i) * LDA + head * 256 + kch);
#define SK1_(i) *(uint4*)(sK + (krow + 8 * i) * 264 + kch) = rg##i;
#define LV1_(i, kbx) rg##i = *(const uint4*)(p.memvt + ((size_t)(b * 4 + head) * 256 + vrow + 32 * i) * 256 + (kbx) * 64 + vch);
#define SV1_(i) *(uint4*)(sVt + (vrow + 32 * i) * 72 + vch) = rg##i;
#define LOADK_(kbx) LK1_(0, kbx) LK1_(1, kbx) LK1_(2, kbx) LK1_(3, kbx) LK1_(4, kbx) LK1_(5, kbx) LK1_(6, kbx) LK1_(7, kbx)
#define STOREK_() SK1_(0) SK1_(1) SK1_(2) SK1_(3) SK1_(4) SK1_(5) SK1_(6) SK1_(7)
#define LOADV_(kbx) LV1_(0, kbx) LV1_(1, kbx) LV1_(2, kbx) LV1_(3, kbx) LV1_(4, kbx) LV1_(5, kbx) LV1_(6, kbx) LV1_(7, kbx)
#define STOREV_() SV1_(0) SV1_(1) SV1_(2) SV1_(3) SV1_(4) SV1_(5) SV1_(6) SV1_(7)
    __syncthreads();
    LOADK_(0)
    STOREK_()
    LOADV_(0)
    __syncthreads();
#pragma unroll 1
    for (int kb = 0; kb < 4; ++kb) {
      bf16x8 pb[1][2];
      attn_qk<256, 1, 264>(sK, qf, o, m, l, c2, lane, [&](int, int) { return true; }, pb);
      STOREV_()
      if (kb < 3) { LOADK_(kb + 1) }
      __syncthreads();
      attn_pv<256, 1, 72>(sVt, pb, o, lane);
      if (kb < 3) {
        STOREK_()
        LOADV_(kb + 1)
      }
      __syncthreads();
    }
#undef LOADK_
#undef STOREK_
#undef LOADV_
#undef STOREV_
#undef LK1_
#undef SK1_
#undef LV1_
#undef SV1_
    float lt = l[0];
    lt += __shfl_xor(lt, 16);
    lt += __shfl_xor(lt, 32);
    const float inv = 1.f / lt;
#pragma unroll
    for (int dt = 0; dt < 16; ++dt) {
      uint2 pk;
      pk.x = pack2(o[0][dt][0] * inv, o[0][dt][1] * inv);
      pk.y = pack2(o[0][dt][2] * inv, o[0][dt][3] * inv);
      *(uint2*)(p.mix + tok * LDA + head * 256 + 16 * dt + 4 * quad) = pk;
    }
  }
}

__constant__ unsigned char kCandI[64] = {0,0,0,0,0,0,0,0,0,0,0,0,0,0,0,0, 1,1,1,1,1,1,1,1, 2,2,2,2,2, 3,3,3,3, 4,4,4, 5,5, 6,6, 7,7,
                                          8, 9, 10, 11, 12, 13, 14, 15, 0,0,0,0,0,0,0,0,0,0,0,0,0,0};
__constant__ unsigned char kCandJ[64] = {0,1,2,3,4,5,6,7,8,9,10,11,12,13,14,15, 0,1,2,3,4,5,6,7, 0,1,2,3,4, 0,1,2,3, 0,1,2, 0,1, 0,1, 0,1,
                                          0, 0, 0, 0, 0, 0, 0, 0, 0,0,0,0,0,0,0,0,0,0,0,0,0,0};

DEVI unsigned score_key(float v, int idx) {
  unsigned u = __float_as_uint(v);
  u = (u & 0x80000000u) ? ~u : (u | 0x80000000u);
  return (u & ~127u) | (unsigned)(127 - idx);
}
DEVI float key_score(unsigned k) {
  k &= ~127u;
  const unsigned u = (k & 0x80000000u) ? (k & 0x7fffffffu) : ~k;
  return __uint_as_float(u);
}

DEVI void phase_peer_route(const Params& p, unsigned char* smem) {
  u16* sA = (u16*)smem; u16* sB = sA + 128 * 72;
  unsigned* sScore = (unsigned*)smem;
  unsigned* sTop = (unsigned*)(smem + 36864);
  unsigned* sTmp = (unsigned*)(smem + 53248);
  {
    const int t0_ = launder(threadIdx.x);
    const int gw = (blockIdx.x * 256 + t0_) >> 6, nw = (gridDim.x * 256) >> 6;
    conv_fp8_rows(p.peer_u, p.ub8, p.uscale, 16384, gw, nw, t0_ & 63);
    conv_fp8_rows(p.peer_v, p.vb8, p.vscale, 16384, gw, nw, t0_ & 63);
  }
#pragma unroll 1
  for (int tile = blockIdx.x; tile < 256 * 8; tile += gridDim.x) {
    GEMM_LANE_VARS
    const int mt = tile >> 3, hd = tile & 7;
    const int m0 = mt * 128;
#pragma unroll 1
    for (int ph = 0; ph < 2; ++ph) {
      const int hp = hd * 2 + ph;
      f32x4 acc[4][4];
      __syncthreads();
      gemm_mainloop<false>(tid, sA, sB, ARow{p.pq + hp * 128, LDPQ}, p.subk + (size_t)hp * 128 * 128, 128, m0, 0, 2, acc);
#pragma unroll 1
      for (int hh = 0; hh < 2; ++hh) {
        if (wm == hh) {
#pragma unroll
          for (int mi = 0; mi < 4; ++mi) {
            const int row = 16 * mi + col;
#pragma unroll
            for (int ni = 0; ni < 4; ++ni) {
              const int n = wn * 64 + 16 * ni + 4 * quad;
              const f32x4 v = acc[ni][mi];
              uint4 kk;
              kk.x = score_key(v[0], n); kk.y = score_key(v[1], n + 1);
              kk.z = score_key(v[2], n + 2); kk.w = score_key(v[3], n + 3);
              *(uint4*)(sScore + row * 132 + n) = kk;
            }
          }
        }
        __syncthreads();
#pragma unroll 1
        for (int rg = 0; rg < 4; ++rg) {
          const int rbase = w * 16 + rg * 4;
          unsigned k0[4], k1[4], t0[4], t1[4], thr[4];
#pragma unroll
          for (int r = 0; r < 4; ++r) {
            k0[r] = sScore[(rbase + r) * 132 + lane];
            k1[r] = sScore[(rbase + r) * 132 + 64 + lane];
            t0[r] = ((k0[r] >> 16) << 7) | (k0[r] & 127u);
            t1[r] = ((k1[r] >> 16) << 7) | (k1[r] & 127u);
            thr[r] = 0u;
          }
#pragma unroll
          for (int bit = 22; bit >= 0; --bit) {
#pragma unroll
            for (int r = 0; r < 4; ++r) {
              const unsigned cand = thr[r] | (1u << bit);
              const int cnt = __popcll(__ballot(t0[r] >= cand)) + __popcll(__ballot(t1[r] >= cand));
              thr[r] = (cnt >= 16) ? cand : thr[r];
            }
          }
          unsigned* tmp = sTmp + w * 64;
#pragma unroll
          for (int r = 0; r < 4; ++r) {
            const unsigned long long b0 = __ballot(t0[r] >= thr[r]), b1 = __ballot(t1[r] >= thr[r]);
            const int pos0 = __builtin_amdgcn_mbcnt_hi((unsigned)(b0 >> 32), __builtin_amdgcn_mbcnt_lo((unsigned)b0, 0u));
            const int pos1 = __popcll(b0) + __builtin_amdgcn_mbcnt_hi((unsigned)(b1 >> 32), __builtin_amdgcn_mbcnt_lo((unsigned)b1, 0u));
            if (t0[r] >= thr[r]) tmp[r * 16 + pos0] = k0[r];
            if (t1[r] >= thr[r]) tmp[r * 16 + pos1] = k1[r];
          }
          __builtin_amdgcn_fence(__ATOMIC_RELEASE, "wavefront");
          __builtin_amdgcn_wave_barrier();
          __builtin_amdgcn_fence(__ATOMIC_ACQUIRE, "wavefront");
          {
            const int r = lane >> 4, ix = lane & 15;
            const unsigned mine = tmp[r * 16 + ix];
            const uint4 a = *(const uint4*)(tmp + r * 16), b = *(const uint4*)(tmp + r * 16 + 4), c = *(const uint4*)(tmp + r * 16 + 8),
                        d = *(const uint4*)(tmp + r * 16 + 12);
            const int rk = (a.x > mine) + (a.y > mine) + (a.z > mine) + (a.w > mine) + (b.x > mine) + (b.y > mine) + (b.z > mine) + (b.w > mine) +
                           (c.x > mine) + (c.y > mine) + (c.z > mine) + (c.w > mine) + (d.x > mine) + (d.y > mine) + (d.z > mine) + (d.w > mine);
            sTop[((hh * 64 + rbase + r) * 2 + ph) * 16 + rk] = mine;
          }
          __builtin_amdgcn_fence(__ATOMIC_RELEASE, "wavefront");
          __builtin_amdgcn_wave_barrier();
        }
        __syncthreads();
      }
    }
    const int ci = kCandI[lane], cj = kCandJ[lane];
    const bool act = lane < 50;
#pragma unroll 1
    for (int tg = 0; tg < 8; ++tg) {
      const int tb = w * 32 + tg * 4;
      unsigned k0[4], k1[4], ku[4], thr[4];
      float v[4];
#pragma unroll
      for (int r = 0; r < 4; ++r) {
        k0[r] = sTop[((tb + r) * 2 + 0) * 16 + ci];
        k1[r] = sTop[((tb + r) * 2 + 1) * 16 + cj];
        v[r] = key_score(k0[r]) + key_score(k1[r]);
        unsigned u = __float_as_uint(v[r]);
        u = (u & 0x80000000u) ? ~u : (u | 0x80000000u);
        ku[r] = act ? (((u >> 16) << 6) | (unsigned)(63 - lane)) : 0u;
        thr[r] = 0u;
      }
#pragma unroll
      for (int bit = 21; bit >= 0; --bit) {
#pragma unroll
        for (int r = 0; r < 4; ++r) {
          const unsigned cand = thr[r] | (1u << bit);
          const int cnt = __popcll(__ballot(ku[r] >= cand));
          thr[r] = (cnt >= 16) ? cand : thr[r];
        }
      }
#pragma unroll
      for (int r = 0; r < 4; ++r) {
        const bool sel = act && (ku[r] >= thr[r]);
        const unsigned long long ms = __ballot(sel);
        const int slot = __builtin_amdgcn_mbcnt_hi((unsigned)(ms >> 32), __builtin_amdgcn_mbcnt_lo((unsigned)ms, 0u));
        const float vmax = __int_as_float(__builtin_amdgcn_readlane(__float_as_int(v[r]), 0));
        const float e = sel ? __expf(v[r] - vmax) : 0.f;
        const float tot = wave_sum(e);
        if (sel) {
          const int eid = (127 - (int)(k0[r] & 127u)) * 128 + (127 - (int)(k1[r] & 127u));
          const size_t o = (size_t)(m0 + tb + r) * 128 + hd * 16 + slot;
          p.experts[o] = eid;
          p.gates[o] = e / tot;
        }
      }
    }
  }
}

template <int PART>
DEVI void phase_peer_gather(const Params& p, unsigned char* smem) {
  const int w0_ = threadIdx.x >> 6;
#pragma unroll 1
  for (int tok = blockIdx.x * 4 + w0_; tok < NTOK; tok += gridDim.x * 4) {
    const int tid = launder(threadIdx.x), lane = tid & 63;
    const uint4* hp4 = (const uint4*)(p.hn + (size_t)tok * LDA + lane * 16);
    float hv[16], xn[16], y[16];
    {
      const uint4 a0 = hp4[0], a1 = hp4[1];
      const unsigned hu[8] = {a0.x, a0.y, a0.z, a0.w, a1.x, a1.y, a1.z, a1.w};
#pragma unroll
      for (int i = 0; i < 8; ++i) { hv[2 * i] = __uint_as_float(hu[i] << 16); hv[2 * i + 1] = __uint_as_float(hu[i] & 0xffff0000u); }
    }
    float ss = 0.f;
#pragma unroll
    for (int i = 0; i < 16; ++i) ss += hv[i] * hv[i];
    ss = wave_sum(ss);
    const float rstd = rsqrtf(ss * (1.f / D) + 1e-6f);
    {
      const float4* g4 = (const float4*)p.peer_g + lane * 4;
      const float4 a0 = g4[0], a1 = g4[1], a2 = g4[2], a3 = g4[3];
      const float gg[16] = {a0.x, a0.y, a0.z, a0.w, a1.x, a1.y, a1.z, a1.w, a2.x, a2.y, a2.z, a2.w, a3.x, a3.y, a3.z, a3.w};
#pragma unroll
      for (int i = 0; i < 16; ++i) { xn[i] = hv[i] * rstd * gg[i]; y[i] = 0.f; }
    }
    int e0 = p.experts[(size_t)tok * 128 + lane], e1 = p.experts[(size_t)tok * 128 + 64 + lane];
    float g0 = p.gates[(size_t)tok * 128 + lane], g1 = p.gates[(size_t)tok * 128 + 64 + lane];
    if (PART == 0) {
      int* sE = (int*)(smem + (tid >> 6) * 1024);
      float* sG = (float*)(sE + 128);
      int pos0 = 0, pos1 = 0, base = 0;
      const int q0_ = e0 >> 10, q1_ = e1 >> 10;
#pragma unroll
      for (int q = 0; q < 16; ++q) {
        const unsigned long long m0 = __ballot(q0_ == q), m1 = __ballot(q1_ == q);
        const int c0 = __popcll(m0);
        const int i0 = __builtin_amdgcn_mbcnt_hi((unsigned)(m0 >> 32), __builtin_amdgcn_mbcnt_lo((unsigned)m0, 0u));
        const int i1 = __builtin_amdgcn_mbcnt_hi((unsigned)(m1 >> 32), __builtin_amdgcn_mbcnt_lo((unsigned)m1, 0u));
        if (q0_ == q) pos0 = base + i0;
        if (q1_ == q) pos1 = base + c0 + i1;
        base += c0 + __popcll(m1);
      }
      __builtin_amdgcn_fence(__ATOMIC_RELEASE, "wavefront");
      __builtin_amdgcn_wave_barrier();
      sE[pos0] = e0; sG[pos0] = g0;
      sE[pos1] = e1; sG[pos1] = g1;
      __builtin_amdgcn_fence(__ATOMIC_RELEASE, "wavefront");
      __builtin_amdgcn_wave_barrier();
      __builtin_amdgcn_fence(__ATOMIC_ACQUIRE, "wavefront");
      e0 = sE[lane]; e1 = sE[64 + lane];
      g0 = sG[lane]; g1 = sG[64 + lane];
      p.experts[(size_t)tok * 128 + lane] = e0;
      p.experts[(size_t)tok * 128 + 64 + lane] = e1;
    }
    const float su0 = p.uscale[e0], su1 = p.uscale[e1];
    const float sv0 = p.vscale[e0], sv1 = p.vscale[e1];
    float cf0 = 0.f, cf1 = 0.f, dsum = 0.f;
    uint4 ca[8], cb[8];
#define LOADB_(R, bi)                                                                                   \
    _Pragma("unroll") for (int u = 0; u < 8; ++u) {                                                       \
      const int kk_ = (((bi) & 7) << 3) + u;                                                             \
      const int e_ = __builtin_amdgcn_readlane((((bi) >> 3) & 1) ? e1 : e0, kk_);                        \
      R[u] = ((const uint4*)((((bi) >> 4) ? p.vb8 : p.ub8) + (size_t)e_ * 1024))[lane];                  \
    }
#define COMPU_(R, bi)                                                                                   \
    {                                                                                                    \
      float d8[8];                                                                                       \
      _Pragma("unroll") for (int u = 0; u < 8; ++u) {                                                     \
        const unsigned uu[4] = {R[u].x, R[u].y, R[u].z, R[u].w};                                         \
        f32x2 a2 = {0.f, 0.f};                                                                           \
        _Pragma("unroll") for (int j = 0; j < 4; ++j) {                                                   \
          const f32x2 lo = __builtin_amdgcn_cvt_pk_f32_fp8((int)uu[j], false);                           \
          const f32x2 hi = __builtin_amdgcn_cvt_pk_f32_fp8((int)uu[j], true);                            \
          a2 = xn2[2 * j] * lo + a2;                                                                     \
          a2 = xn2[2 * j + 1] * hi + a2;                                                                 \
        }                                                                                                \
        d8[u] = a2[0] + a2[1];                                                                           \
      }                                                                                                  \
          \
      float v4[4], v2[2];                                                                                \
      _Pragma("unroll") for (int i = 0; i < 4; ++i) {                                                     \
        const float snd = b5 ? d8[i] : d8[4 + i], kp = b5 ? d8[4 + i] : d8[i];                           \
        v4[i] = kp + __shfl_xor(snd, 32);                                                                \
      }                                                                                                  \
      _Pragma("unroll") for (int i = 0; i < 2; ++i) {                                                     \
        const float snd = b4 ? v4[i] : v4[2 + i], kp = b4 ? v4[2 + i] : v4[i];                           \
        v2[i] = kp + __shfl_xor(snd, 16);                                                                \
      }                                                                                                  \
      float v1;                                                                                          \
      { const float snd = b3 ? v2[0] : v2[1], kp = b3 ? v2[1] : v2[0]; v1 = kp + __shfl_xor(snd, 8); }   \
      v1 += __shfl_xor(v1, 4);                                                                           \
      v1 += __shfl_xor(v1, 2);                                                                           \
      v1 += __shfl_xor(v1, 1);                                                                           \
                \
      const float got = __shfl(v1, fsrc);                                                                \
      if ((lane >> 3) == ((bi) & 7)) dsum = got;                                                         \
    }                                                                                                    \
    if (((bi) & 7) == 7) {                                                                               \
      if (((bi) >> 3) & 1) cf1 = gelu_tanh(dsum * su1) * g1 * sv1; else cf0 = gelu_tanh(dsum * su0) * g0 * sv0; \
    }
#define COMPV_(R, bi)                                                                                   \
    _Pragma("unroll") for (int u = 0; u < 8; ++u) {                                                       \
      const int kk_ = (((bi) & 7) << 3) + u;                                                             \
      const float ck_ = __int_as_float(__builtin_amdgcn_readlane(__float_as_int((((bi) >> 3) & 1) ? cf1 : cf0), kk_)); \
      const f32x2 ck2 = {ck_, ck_};                                                                      \
      const unsigned uu[4] = {R[u].x, R[u].y, R[u].z, R[u].w};                                           \
      _Pragma("unroll") for (int j = 0; j < 4; ++j) {                                                     \
        const f32x2 lo = __builtin_amdgcn_cvt_pk_f32_fp8((int)uu[j], false);                             \
        const f32x2 hi = __builtin_amdgcn_cvt_pk_f32_fp8((int)uu[j], true);                              \
        y2[2 * j] = ck2 * lo + y2[2 * j];                                                                \
        y2[2 * j + 1] = ck2 * hi + y2[2 * j + 1];                                                        \
      }                                                                                                  \
    }
    const bool b5 = (lane & 32) != 0, b4 = (lane & 16) != 0, b3 = (lane & 8) != 0;
    const int fsrc = ((lane & 4) << 3) | ((lane & 2) << 3) | ((lane & 1) << 3);
    f32x2 xn2[8], y2[8];
#pragma unroll
    for (int i = 0; i < 8; ++i) { xn2[i] = f32x2{xn[2 * i], xn[2 * i + 1]}; y2[i] = f32x2{0.f, 0.f}; }
    if (PART == 0) {
      LOADB_(ca, 0)
#pragma unroll 1
      for (int bi = 0; bi < 16; bi += 2) {
        LOADB_(cb, bi + 1)
        COMPU_(ca, bi)
        if (bi + 2 < 16) { LOADB_(ca, bi + 2) }
        COMPU_(cb, bi + 1)
      }
      p.gates[(size_t)tok * 128 + lane] = cf0;
      p.gates[(size_t)tok * 128 + 64 + lane] = cf1;
      continue;
    }
    cf0 = g0; cf1 = g1;
    LOADB_(ca, 16)
#pragma unroll 1
    for (int bi = 16; bi < 32; bi += 2) {
      LOADB_(cb, bi + 1)
      COMPV_(ca, bi)
      if (bi + 2 < 32) { LOADB_(ca, bi + 2) }
      COMPV_(cb, bi + 1)
    }
#undef LOADB_
#undef COMPU_
#undef COMPV_
#pragma unroll
    for (int i = 0; i < 8; ++i) { y[2 * i] = y2[i][0]; y[2 * i + 1] = y2[i][1]; }
    float s2 = 0.f;
    {
      const uint4 a0 = hp4[0], a1 = hp4[1];
      const unsigned hu[8] = {a0.x, a0.y, a0.z, a0.w, a1.x, a1.y, a1.z, a1.w};
#pragma unroll
      for (int i = 0; i < 8; ++i) {
        y[2 * i] += __uint_as_float(hu[i] << 16);
        y[2 * i + 1] += __uint_as_float(hu[i] & 0xffff0000u);
        s2 += y[2 * i] * y[2 * i] + y[2 * i + 1] * y[2 * i + 1];
      }
    }
    s2 = wave_sum(s2);
    const float rs2 = rsqrtf(s2 * (1.f / D) + 1e-6f);
    {
      const float4* g4 = (const float4*)p.final_g + lane * 4;
      const float4 a0 = g4[0], a1 = g4[1], a2 = g4[2], a3 = g4[3];
      float4* o4 = (float4*)(p.out + (size_t)tok * D) + lane * 4;
      o4[0] = make_float4(y[0] * rs2 * a0.x, y[1] * rs2 * a0.y, y[2] * rs2 * a0.z, y[3] * rs2 * a0.w);
      o4[1] = make_float4(y[4] * rs2 * a1.x, y[5] * rs2 * a1.y, y[6] * rs2 * a1.z, y[7] * rs2 * a1.w);
      o4[2] = make_float4(y[8] * rs2 * a2.x, y[9] * rs2 * a2.y, y[10] * rs2 * a2.z, y[11] * rs2 * a2.w);
      o4[3] = make_float4(y[12] * rs2 * a3.x, y[13] * rs2 * a3.y, y[14] * rs2 * a3.z, y[15] * rs2 * a3.w);
    }
  }
}

#define XB_TMO      128
#define XB_XCNT(j)  (256  + 64 * (j))
#define XB_XSUB(j)  (1280 + 64 * (j))
#define XB_XGEN(j)  (2304 + 64 * (j))
#define XB_TOP      3328
#define XB_TOPGEN   3392
#define XCD_BAR_WORDS 3456
#define XB_SPIN_CAP (1u << 20)
#define LAS __attribute__((address_space(3)))
DEVI unsigned xb_ld(unsigned* q) { return __hip_atomic_load(q, __ATOMIC_RELAXED, __HIP_MEMORY_SCOPE_AGENT); }
DEVI unsigned xb_add(unsigned* q, unsigned v) { return __hip_atomic_fetch_add(q, v, __ATOMIC_RELAXED, __HIP_MEMORY_SCOPE_AGENT); }
DEVI unsigned xb_xcc_id() { return (unsigned)__builtin_amdgcn_s_getreg((3 << 11) | 20) & 0xFu; }
#define XB_SPIN(cond, bar) do { unsigned _sp = 0; while (cond) { __builtin_amdgcn_s_sleep(1); \
    if ((++_sp & 255u) == 0u) { if (xb_ld(&(bar)[XB_TMO])) break; if (_sp > XB_SPIN_CAP) { atomicAdd(&(bar)[XB_TMO], 1u); break; } } } } while (0)
struct XcdBarrier { unsigned* bar; unsigned x; volatile LAS unsigned* st; };
DEVI XcdBarrier xcd_barrier_post(unsigned* bar, volatile LAS unsigned* st) {
  XcdBarrier b; b.bar = bar; b.x = xb_xcc_id(); b.st = st;
  if (threadIdx.x == 0) (void)xb_add(&bar[XB_XCNT(b.x)], 1u);
  return b;
}
DEVI void xcd_barrier_complete(unsigned* bar, unsigned x, unsigned& nloc, unsigned& nx) {
  const unsigned G = gridDim.x * gridDim.y * gridDim.z;
  unsigned sum, cnt, mine, sp = 0u;
  for (;;) {
    sum = 0u; cnt = 0u; mine = 0u;
#pragma unroll
    for (unsigned j = 0; j < 16; ++j) { const unsigned c = xb_ld(&bar[XB_XCNT(j)]); sum += c; cnt += (c > 0u) ? 1u : 0u; mine = (j == x) ? c : mine; }
    if (sum == G) break;
    __builtin_amdgcn_s_sleep(1);
    if ((++sp & 255u) == 0u) { if (xb_ld(&bar[XB_TMO])) break; if (sp > XB_SPIN_CAP) { atomicAdd(&bar[XB_TMO], 1u); break; } }
  }
  nloc = mine > 0u ? mine : 1u; nx = cnt > 0u ? cnt : 1u;
}
DEVI void xcd_barrier(const XcdBarrier& b) {
  asm volatile("s_waitcnt vmcnt(0)" ::: "memory");
  __syncthreads();
  if (threadIdx.x == 0) {
    unsigned* bar = b.bar;
    __builtin_amdgcn_s_waitcnt(0);
    unsigned nloc = b.st[0], nx = b.st[1];
    if (nloc == 0u) { xcd_barrier_complete(bar, b.x, nloc, nx); b.st[0] = nloc; b.st[1] = nx; }
    const unsigned old = xb_add(&bar[XB_XSUB(b.x)], 1u);
    const unsigned gen = old / nloc;
    if (old + 1u == (gen + 1u) * nloc) {
      __builtin_amdgcn_fence(__ATOMIC_RELEASE, "agent");
      asm volatile("s_waitcnt vmcnt(0)" ::: "memory");
      const unsigned og = xb_add(&bar[XB_TOP], 1u);
      const unsigned tg = og / nx;
      if (og + 1u == (tg + 1u) * nx) xb_add(&bar[XB_TOPGEN], 1u);
      else XB_SPIN(xb_ld(&bar[XB_TOPGEN]) == tg, bar);
      __builtin_amdgcn_fence(__ATOMIC_ACQUIRE, "agent");
      xb_add(&bar[XB_XGEN(b.x)], 1u);
      asm volatile("s_waitcnt vmcnt(0)" ::: "memory");
    } else {
      XB_SPIN(xb_ld(&bar[XB_XGEN(b.x)]) == gen, bar);
      __builtin_amdgcn_fence(__ATOMIC_ACQUIRE, "agent");
      asm volatile("s_waitcnt vmcnt(0)" ::: "memory");
    }
  }
  __syncthreads();
}

template <bool COOP>
__global__ void __launch_bounds__(256, 2) mega(Params p, int ph_lo, int ph_hi) {
  __shared__ __attribute__((aligned(16))) unsigned char smem[SMEM_BYTES];
  __shared__ uint4 xb_words;
  if (threadIdx.x == 0) xb_words = make_uint4(0u, 0u, 0u, 0u);
  __syncthreads();
  XcdBarrier xb = xcd_barrier_post(p.bar, (volatile LAS unsigned*)&xb_words);
  (void)xb;
  if (COOP && ph_hi > 1000) cg::this_grid().sync();
#ifdef REPEAT_MASK
#define RUN_PHASE(i, call)                                                                   \
  if (ph_lo <= (i) && (i) <= ph_hi) {                                                        \
    call;                                                                                    \
    if (COOP && ((REPEAT_MASK >> (i)) & 1)) { xcd_barrier(xb); call; }                       \
    if (COOP && (i) < ph_hi) xcd_barrier(xb);                                                \
  }
#else
#define RUN_PHASE(i, call)                                                                   \
  if (ph_lo <= (i) && (i) <= ph_hi) {                                                        \
    call;                                                                                    \
    if (COOP && (i) < ph_hi) {                                                               \
      xcd_barrier(xb);                                                                       \
    }                                                                                        \
  }
#endif
  RUN_PHASE(0, phase0(p))
  RUN_PHASE(1, phase1(p, smem))
  RUN_PHASE(2, phase2(p, smem))
  RUN_PHASE(4, phase_nsa(p, smem))
  RUN_PHASE(5, phase_resid<false>(p, smem, p.mix, p.woutT, p.x, p.ssq1))
  RUN_PHASE(6, phase_scaled(p, smem, p.hn, p.wmqT, 8, p.ssq1, p.qm, LDA))
  RUN_PHASE(7, phase_memattn(p, smem))
  RUN_PHASE(8, phase_resid<true>(p, smem, p.mix, p.wmoT, nullptr, p.ssq2))
  RUN_PHASE(9, phase_scaled(p, smem, p.hn, p.wpqT, 16, p.ssq2, p.pq, LDPQ))
  RUN_PHASE(10, phase_peer_route(p, smem))
  RUN_PHASE(11, phase_peer_gather<0>(p, smem))
  RUN_PHASE(12, phase_peer_gather<1>(p, smem))
#undef RUN_PHASE
}

extern "C" void kernel_launch(void* const* d_in, const int* in_sizes, int n_in, void* d_out, int out_size, void* d_ws,
                              size_t ws_size, hipStream_t stream) {
  (void)in_sizes; (void)n_in; (void)out_size; (void)ws_size;
  Params p{};
  p.x = (const float*)d_in[0]; p.mem = (const float*)d_in[1]; p.pos = (const int*)d_in[2];
  p.mix_g = (const float*)d_in[3]; p.w_in = (const float*)d_in[4]; p.conv_w = (const float*)d_in[5];
  p.conv_b = (const float*)d_in[6]; p.ln_g = (const float*)d_in[7]; p.ln_b = (const float*)d_in[8];
  p.cmp_pos = (const float*)d_in[9]; p.cmp_w1 = (const float*)d_in[10]; p.cmp_b1 = (const float*)d_in[11];
  p.cmp_w2 = (const float*)d_in[12]; p.cmp_b2 = (const float*)d_in[13]; p.w_out = (const float*)d_in[14];
  p.memq_g = (const float*)d_in[15]; p.memkv_g = (const float*)d_in[16]; p.w_mq = (const float*)d_in[17];
  p.w_mk = (const float*)d_in[18]; p.w_mv = (const float*)d_in[19]; p.w_mo = (const float*)d_in[20];
  p.peer_g = (const float*)d_in[21]; p.peer_wq = (const float*)d_in[22]; p.peer_sk = (const float*)d_in[23];
  p.peer_u = (const float*)d_in[24]; p.peer_v = (const float*)d_in[25]; p.final_g = (const float*)d_in[26];
  p.out = (float*)d_out;
  unsigned char* ws = (unsigned char*)d_ws;
  size_t off = 0;
  auto take = [&](size_t bytes) { unsigned char* r = ws + off; off += (bytes + 255) & ~(size_t)255; return r; };
  unsigned char* regA = take((size_t)NTOK * LDA * 2);
  unsigned char* regB = take((size_t)NTOK * LDP * 2);
  unsigned char* regC = take((size_t)NTOK * LDA * 2);
  p.hn = (u16*)regA;
  p.proj = (u16*)regB; p.qm = (u16*)regB; p.pq = (u16*)regB;
  p.mix = (u16*)regC; p.experts = (int*)regC; p.gates = (float*)(regC + (size_t)NTOK * 128 * 4);
  {
    unsigned char* tb = regC + (size_t)2 * NTOK * 128 * 4;
    p.ub8 = tb; p.vb8 = tb + (size_t)16384 * 1024;
    p.uscale = (float*)(tb + (size_t)2 * 16384 * 1024); p.vscale = p.uscale + 16384;
  }
  p.h = nullptr;
  p.vts = (u16*)take((size_t)Bn * 2 * 64 * LDT * 2);
  p.vtw = (u16*)take((size_t)Bn * 2 * 64 * LDT * 2);
  p.memn = (u16*)take((size_t)Bn * 256 * LDA * 2);
  p.memk = (u16*)take((size_t)Bn * 256 * LDA * 2);
  p.memvt = (u16*)take((size_t)Bn * 256 * D * 2);
  p.winT = (u16*)take((size_t)2432 * LDA * 2);
  p.woutT = (u16*)take((size_t)1024 * LDA * 2);
  p.wmqT = (u16*)take((size_t)1024 * LDA * 2);
  p.wmkT = (u16*)take((size_t)1024 * LDA * 2);
  p.wmvT = (u16*)take((size_t)1024 * LDA * 2);
  p.wmoT = (u16*)take((size_t)1024 * LDA * 2);
  p.wpqT = (u16*)take((size_t)2048 * LDA * 2);
  p.subk = (u16*)take((size_t)16 * 128 * 128 * 2);
  p.w1T = (u16*)take((size_t)2 * 128 * LDW1 * 2);
  p.w2T = (u16*)take((size_t)2 * 128 * 128 * 2);
  p.biasp = (float*)take(256 * 4);
  p.rope = (float*)take((size_t)NTOK * 16 * 4);
  p.hdn = (u16*)take((size_t)2 * 4096 * 128 * 2);
  p.kc = (u16*)take((size_t)Bn * 2 * 128 * 64 * 2);
  p.vcT = (u16*)take((size_t)Bn * 2 * 64 * 128 * 2);
  p.ssq1 = (float*)take((size_t)NTOK * 4);
  p.ssq2 = (float*)take((size_t)NTOK * 4);
  p.bar = (unsigned*)take(16384);
  if (off > ws_size) { fprintf(stderr, "workspace too small: need %zu have %zu\n", off, ws_size); return; }

#if COOP_MODE
  static int grid_blocks = 0;
  if (!grid_blocks) {
    int dev = 0, cus = 0, per_cu = 0;
    hipGetDevice(&dev);
    hipDeviceGetAttribute(&cus, hipDeviceAttributeMultiprocessorCount, dev);
    hipOccupancyMaxActiveBlocksPerMultiprocessor(&per_cu, mega<true>, 256, 0);
    if (per_cu > 2) per_cu = 2;
    if (per_cu < 1) per_cu = 1;
    grid_blocks = cus * per_cu;
  }
  int lo = 0, hi = NPHASE;
  void* args[] = {&p, &lo, &hi};
  (void)hipMemsetAsync(p.bar, 0, 16384, stream);
  hipError_t e = hipLaunchCooperativeKernel((void*)mega<true>, dim3(grid_blocks), dim3(256), args, 0, stream);
  if (e != hipSuccess) fprintf(stderr, "cooperative launch failed: %s (grid %d)\n", hipGetErrorString(e), grid_blocks);
#else
  for (int ph = 0; ph <= NPHASE; ++ph) mega<false><<<dim3(512), dim3(256), 0, stream>>>(p, ph, ph);
#endif
}
```

```cpp
#include <hip/hip_runtime.h>
#include <hip/hip_bf16.h>
#include <hip/hip_cooperative_groups.h>
#include <cstdio>
#include <cstdint>
namespace cg = cooperative_groups;

#ifndef COOP_MODE
#define COOP_MODE 1
#endif

typedef __attribute__((ext_vector_type(8))) short bf16x8;
typedef __attribute__((ext_vector_type(4))) short bf16x4;
typedef __attribute__((ext_vector_type(4))) float f32x4;
typedef unsigned short u16;

#define DEVI __device__ __forceinline__

constexpr int Bn = 16, T = 2048, D = 1024, NTOK = Bn * T, LDP = 2336;
constexpr int C_Q = 1024, C_KC = 1536, C_VC = 1664, C_KS = 1792, C_VS = 1920, C_KW = 2048, C_VW = 2176, C_GATE = 2304;
constexpr int SMEM_BYTES = 73728;
constexpr int LDA = 1088;
constexpr int LDHF = 1056;
constexpr int LDPQ = 2112;
constexpr int LDW1 = 2112;
constexpr int LDT = 2112;
constexpr int NPHASE = 12;

struct Params {
  const float* x; const float* mem; const int* pos; const float* mix_g; const float* w_in;
  const float* conv_w; const float* conv_b; const float* ln_g; const float* ln_b;
  const float* cmp_pos; const float* cmp_w1; const float* cmp_b1; const float* cmp_w2; const float* cmp_b2;
  const float* w_out; const float* memq_g; const float* memkv_g; const float* w_mq; const float* w_mk;
  const float* w_mv; const float* w_mo; const float* peer_g; const float* peer_wq; const float* peer_sk;
  const float* peer_u; const float* peer_v; const float* final_g;
  float* out;
  u16* hn; u16* proj; u16* mix; float* h; u16* vts; u16* vtw; u16* memn; u16* memk; u16* memvt;
  u16* winT; u16* woutT; u16* wmqT; u16* wmkT; u16* wmvT; u16* wmoT; u16* wpqT; u16* subk; u16* w1T; u16* w2T;
  float* biasp; float* rope; u16* hdn; u16* kc; u16* vcT; float* ssq1; float* ssq2;
  int* experts; float* gates; unsigned char* ub8; unsigned char* vb8; float* uscale; float* vscale; u16* qm; u16* pq;
  unsigned* bar;
};

DEVI int launder(int x) { asm volatile("" : "+v"(x)); return x; }
DEVI u16 f2bf(float f) {
  unsigned u = __float_as_uint(f);
  u += 0x7fffu + ((u >> 16) & 1u);
  return (u16)(u >> 16);
}
DEVI float bf2f(u16 h) { return __uint_as_float(((unsigned)h) << 16); }
DEVI unsigned pack2(float a, float b) { return (unsigned)f2bf(a) | ((unsigned)f2bf(b) << 16); }
DEVI float wave_sum(float v) {
#pragma unroll
  for (int o = 32; o; o >>= 1) v += __shfl_xor(v, o);
  return v;
}
DEVI float sigmoidf_(float x) { return 1.f / (1.f + __expf(-x)); }
DEVI float gelu_tanh(float x) {
  float u = 0.7978845608028654f * (x + 0.044715f * x * x * x);
  return 0.5f * x * (1.f + tanhf(u));
}
DEVI f32x4 mfma16(bf16x8 a, bf16x8 b, f32x4 c) { return __builtin_amdgcn_mfma_f32_16x16x32_bf16(a, b, c, 0, 0, 0); }
DEVI float fexp2(float x) { return __builtin_amdgcn_exp2f(x); }

DEVI void tconv(const float* __restrict__ src, int K, int N, u16* __restrict__ dst, int Npad, int ldd,
                const float* __restrict__ gain, int gtid, int gsz) {
  const int items = Npad * (K >> 3);
  for (int it = gtid; it < items; it += gsz) {
    const int n = it % Npad, kc = it / Npad;
    float f[8];
#pragma unroll
    for (int j = 0; j < 8; ++j) {
      float v = 0.f;
      if (n < N) {
        v = src[(size_t)(kc * 8 + j) * N + n];
        if (gain) v *= gain[kc * 8 + j];
      }
      f[j] = v;
    }
    uint4 pk;
    pk.x = pack2(f[0], f[1]); pk.y = pack2(f[2], f[3]); pk.z = pack2(f[4], f[5]); pk.w = pack2(f[6], f[7]);
    *(uint4*)(dst + (size_t)n * ldd + kc * 8) = pk;
  }
}

DEVI void conv_flat(const float* __restrict__ src, u16* __restrict__ dst, size_t n8, size_t gtid, size_t gsz) {
  for (size_t it = gtid; it < n8; it += gsz) {
    const float4 a = ((const float4*)src)[2 * it], b = ((const float4*)src)[2 * it + 1];
    uint4 pk;
    pk.x = pack2(a.x, a.y); pk.y = pack2(a.z, a.w); pk.z = pack2(b.x, b.y); pk.w = pack2(b.z, b.w);
    ((uint4*)dst)[it] = pk;
  }
}


typedef float f32x2 __attribute__((ext_vector_type(2)));
DEVI unsigned pk4_fp8(float a, float b, float c, float d) {
  int v = 0;
  v = __builtin_amdgcn_cvt_pk_fp8_f32(a, b, v, false);
  v = __builtin_amdgcn_cvt_pk_fp8_f32(c, d, v, true);
  return (unsigned)v;
}
DEVI void conv_fp8_rows(const float* __restrict__ src, unsigned char* __restrict__ dst, float* __restrict__ inv_scale,
                        int rows, int gw, int nw, int lane) {
  for (int r0 = gw; r0 < rows; r0 += 2 * nw) {
    const int r1 = r0 + nw;
    const bool has1 = r1 < rows;
    const float4* p0 = (const float4*)(src + (size_t)r0 * 1024) + lane * 4;
    const float4* p1 = (const float4*)(src + (size_t)(has1 ? r1 : r0) * 1024) + lane * 4;
    float4 v[2][4];
#pragma unroll
    for (int i = 0; i < 4; ++i) { v[0][i] = p0[i]; v[1][i] = p1[i]; }
    float mx[2];
#pragma unroll
    for (int q = 0; q < 2; ++q) {
      float m = 0.f;
#pragma unroll
      for (int i = 0; i < 4; ++i)
        m = fmaxf(m, fmaxf(fmaxf(fabsf(v[q][i].x), fabsf(v[q][i].y)), fmaxf(fabsf(v[q][i].z), fabsf(v[q][i].w))));
      mx[q] = m;
    }
#pragma unroll
    for (int o = 32; o; o >>= 1) { mx[0] = fmaxf(mx[0], __shfl_xor(mx[0], o)); mx[1] = fmaxf(mx[1], __shfl_xor(mx[1], o)); }
#pragma unroll
    for (int q = 0; q < 2; ++q) {
      if (q == 1 && !has1) break;
      const int r = q ? r1 : r0;
      const float sc = mx[q] > 0.f ? 224.f / mx[q] : 1.f;
      if (lane == 0) inv_scale[r] = mx[q] > 0.f ? mx[q] * (1.f / 224.f) : 1.f;
      uint4 o4;
      o4.x = pk4_fp8(v[q][0].x * sc, v[q][0].y * sc, v[q][0].z * sc, v[q][0].w * sc);
      o4.y = pk4_fp8(v[q][1].x * sc, v[q][1].y * sc, v[q][1].z * sc, v[q][1].w * sc);
      o4.z = pk4_fp8(v[q][2].x * sc, v[q][2].y * sc, v[q][2].z * sc, v[q][2].w * sc);
      o4.w = pk4_fp8(v[q][3].x * sc, v[q][3].y * sc, v[q][3].z * sc, v[q][3].w * sc);
      ((uint4*)(dst + (size_t)r * 1024))[lane] = o4;
    }
  }
}

DEVI void rownorm_bf16(const float* __restrict__ src, const float* __restrict__ g, u16* __restrict__ dst,
                       int rows, int gw, int nw, int lane) {
  for (int r0 = gw; r0 < rows; r0 += 2 * nw) {
    const int r1 = r0 + nw;
    const bool has1 = r1 < rows;
    const float4* pa = (const float4*)(src + (size_t)r0 * D);
    const float4* pb = (const float4*)(src + (size_t)(has1 ? r1 : r0) * D);
    float4 va[4], vb[4];
    float sa = 0.f, sb = 0.f;
#pragma unroll
    for (int i = 0; i < 4; ++i) { va[i] = pa[lane + 64 * i]; vb[i] = pb[lane + 64 * i]; }
#pragma unroll
    for (int i = 0; i < 4; ++i) {
      sa += va[i].x * va[i].x + va[i].y * va[i].y + va[i].z * va[i].z + va[i].w * va[i].w;
      sb += vb[i].x * vb[i].x + vb[i].y * vb[i].y + vb[i].z * vb[i].z + vb[i].w * vb[i].w;
    }
#pragma unroll
    for (int o = 32; o; o >>= 1) { sa += __shfl_xor(sa, o); sb += __shfl_xor(sb, o); }
    const float ra = rsqrtf(sa * (1.f / D) + 1e-6f), rb = rsqrtf(sb * (1.f / D) + 1e-6f);
#pragma unroll
    for (int i = 0; i < 4; ++i) {
      const float4 gg = ((const float4*)g)[lane + 64 * i];
      uint2 pk;
      pk.x = pack2(va[i].x * ra * gg.x, va[i].y * ra * gg.y);
      pk.y = pack2(va[i].z * ra * gg.z, va[i].w * ra * gg.w);
      *(uint2*)(dst + (size_t)r0 * LDA + (size_t)(lane + 64 * i) * 4) = pk;
      if (has1) {
        pk.x = pack2(vb[i].x * rb * gg.x, vb[i].y * rb * gg.y);
        pk.y = pack2(vb[i].z * rb * gg.z, vb[i].w * rb * gg.w);
        *(uint2*)(dst + (size_t)r1 * LDA + (size_t)(lane + 64 * i) * 4) = pk;
      }
    }
  }
}

DEVI void phase0(const Params& p) {
  const int tid = launder(threadIdx.x), lane = tid & 63;
  const int gtid = blockIdx.x * 256 + tid, gsz = gridDim.x * 256;
  const int gw = gtid >> 6, nw = gsz >> 6;
  rownorm_bf16(p.x, p.mix_g, p.hn, NTOK, gw, nw, lane);
  rownorm_bf16(p.mem, p.memkv_g, p.memn, Bn * 256, gw, nw, lane);
  tconv(p.w_in, 1024, 2328, p.winT, 2432, LDA, nullptr, gtid, gsz);
  tconv(p.w_out, 1024, 1024, p.woutT, 1024, LDA, nullptr, gtid, gsz);
  tconv(p.w_mq, 1024, 1024, p.wmqT, 1024, LDA, p.memq_g, gtid, gsz);
  tconv(p.w_mk, 1024, 1024, p.wmkT, 1024, LDA, nullptr, gtid, gsz);
  tconv(p.w_mv, 1024, 1024, p.wmvT, 1024, LDA, nullptr, gtid, gsz);
  tconv(p.w_mo, 1024, 1024, p.wmoT, 1024, LDA, nullptr, gtid, gsz);
  tconv(p.peer_wq, 1024, 2048, p.wpqT, 2048, LDA, p.peer_g, gtid, gsz);
  tconv(p.cmp_w1, 2048, 128, p.w1T, 128, LDW1, nullptr, gtid, gsz);
  tconv(p.cmp_w1 + 2048 * 128, 2048, 128, p.w1T + 128 * LDW1, 128, LDW1, nullptr, gtid, gsz);
  tconv(p.cmp_w2, 128, 64, p.w2T, 128, 128, nullptr, gtid, gsz);
  tconv(p.cmp_w2 + 128 * 64, 128, 64, p.w2T + 128 * 128, 128, 128, nullptr, gtid, gsz);
  conv_flat(p.peer_sk, p.subk, (size_t)16 * 128 * 128 / 8, gtid, gsz);
  for (int it = gtid; it < NTOK * 8; it += gsz) {
    const int tok = it >> 3, i = it & 7;
    const float inv = (i == 0) ? 1.000000000e+00f : (i == 1) ? 1.939227432e-01f : (i == 2) ? 3.760603070e-02f : (i == 3) ? 7.292664610e-03f : (i == 4) ? 1.414213562e-03f : (i == 5) ? 2.742481884e-04f : (i == 6) ? 5.318295734e-05f : 1.031338525e-05f;
    const float ang = (float)p.pos[tok] * inv;
    float sv, cv;
    sincosf(ang, &sv, &cv);
    p.rope[tok * 16 + i] = cv;
    p.rope[tok * 16 + 8 + i] = sv;
  }
  for (int o = gw; o < 256; o += nw) {
    const int ty = o >> 7, n = o & 127;
    float s = 0.f;
#pragma unroll 8
    for (int k = lane; k < 2048; k += 64)
      s += p.cmp_pos[ty * 2048 + k] * p.cmp_w1[((size_t)ty * 2048 + k) * 128 + n];
    s = wave_sum(s);
    if (lane == 0) p.biasp[o] = s + p.cmp_b1[o];
  }
  for (int it = gtid; it < NTOK; it += gsz) { p.ssq1[it] = 0.f; p.ssq2[it] = 0.f; }
}

template <bool DB, class AF>
DEVI void gemm_mainloop(int tid, u16* sA, u16* sB, AF af, const u16* __restrict__ Bt, int ldb, int m0, int n0, int nk,
                        f32x4 (&acc)[4][4]) {
  const int lane = tid & 63, w = tid >> 6;
  const int wm = w >> 1, wn = w & 1, col = lane & 15, quad = lane >> 4;
#pragma unroll
  for (int i = 0; i < 4; ++i)
#pragma unroll
    for (int j = 0; j < 4; ++j) acc[i][j] = f32x4{0.f, 0.f, 0.f, 0.f};
  uint4 ra0, ra1, ra2, ra3, rb0, rb1, rb2, rb3;
  const int lrow = tid >> 3, lkc = (tid & 7) << 3;
  const u16* bbase = Bt + (size_t)(n0 + lrow) * ldb + lkc;
#define GL_(R, i, kk)                                                     \
  R##a##i = *(const uint4*)af(m0 + lrow + 32 * i, (kk) + lkc);            \
  R##b##i = *(const uint4*)(bbase + (size_t)(32 * i) * ldb + (kk));
#define SS_(R, i, off)                                                    \
  *(uint4*)(sA + (off) + (lrow + 32 * i) * 72 + lkc) = R##a##i;           \
  *(uint4*)(sB + (off) + (lrow + 32 * i) * 72 + lkc) = R##b##i;
#define GL4_(R, kk) GL_(R, 0, kk) GL_(R, 1, kk) GL_(R, 2, kk) GL_(R, 3, kk)
#define SS4_(R, off) SS_(R, 0, off) SS_(R, 1, off) SS_(R, 2, off) SS_(R, 3, off)
#define COMPUTE_(cur)                                                                                                   \
  _Pragma("unroll") for (int ks = 0; ks < 2; ++ks) {                                                                    \
    bf16x8 fa[4], fb[4];                                                                                                \
    _Pragma("unroll") for (int mi = 0; mi < 4; ++mi)                                                                    \
      fa[mi] = *(const bf16x8*)(sA + (cur) + (wm * 64 + 16 * mi + col) * 72 + 32 * ks + 8 * quad);                      \
    _Pragma("unroll") for (int ni = 0; ni < 4; ++ni)                                                                    \
      fb[ni] = *(const bf16x8*)(sB + (cur) + (wn * 64 + 16 * ni + col) * 72 + 32 * ks + 8 * quad);                      \
    _Pragma("unroll") for (int ni = 0; ni < 4; ++ni)                                                                    \
      _Pragma("unroll") for (int mi = 0; mi < 4; ++mi) acc[ni][mi] = mfma16(fb[ni], fa[mi], acc[ni][mi]);               \
  }
  if (DB) {
    const int srow = 8 * w + (lane >> 3);
    const int spc = lane & 7;
#define STAGE_(st, kk)                                                                                         \
    _Pragma("unroll") for (int i = 0; i < 4; ++i) {                                                            \
      const int r_ = 32 * i + srow;                                                                            \
      const int c_ = (spc ^ ((r_ >> 1) & 7)) << 3;                                                             \
      __builtin_amdgcn_global_load_lds((const unsigned*)af(m0 + r_, (kk) + c_),                                \
                                       (unsigned*)(sA + (st) * 16384 + (32 * i + 8 * w) * 64), 16, 0, 0);      \
      __builtin_amdgcn_global_load_lds((const unsigned*)(Bt + (size_t)(n0 + r_) * ldb + (kk) + c_),            \
                                       (unsigned*)(sA + (st) * 16384 + 8192 + (32 * i + 8 * w) * 64), 16, 0, 0); \
    }
#define COMPUTE_SW_(st)                                                                                                 \
  _Pragma("unroll") for (int ks = 0; ks < 2; ++ks) {                                                                    \
    bf16x8 fa[4], fb[4];                                                                                                \
    const int pc_ = ((4 * ks + quad) ^ ((col >> 1) & 7)) << 3;                                                          \
    _Pragma("unroll") for (int mi = 0; mi < 4; ++mi)                                                                    \
      fa[mi] = *(const bf16x8*)(sA + (st) * 16384 + (wm * 64 + 16 * mi + col) * 64 + pc_);                              \
    _Pragma("unroll") for (int ni = 0; ni < 4; ++ni)                                                                    \
      fb[ni] = *(const bf16x8*)(sA + (st) * 16384 + 8192 + (wn * 64 + 16 * ni + col) * 64 + pc_);                       \
    __builtin_amdgcn_s_setprio(1);                                                                                      \
    _Pragma("unroll") for (int ni = 0; ni < 4; ++ni)                                                                    \
      _Pragma("unroll") for (int mi = 0; mi < 4; ++mi) acc[ni][mi] = mfma16(fb[ni], fa[mi], acc[ni][mi]);               \
    __builtin_amdgcn_s_setprio(0);                                                                                      \
  }
    STAGE_(0, 0)
#pragma unroll 1
    for (int kt = 0; kt < nk; kt += 2) {
      asm volatile("s_waitcnt vmcnt(0)" ::: "memory");
      __syncthreads();
      { const int kk = (kt + 1) * 64; STAGE_(1, kk) }
      COMPUTE_SW_(0)
      asm volatile("s_waitcnt vmcnt(0)" ::: "memory");
      __syncthreads();
      if (kt + 2 < nk) { const int kk = (kt + 2) * 64; STAGE_(0, kk) }
      COMPUTE_SW_(1)
    }
#undef STAGE_
#undef COMPUTE_SW_
  } else {
    GL4_(r, 0)
    SS4_(r, 0)
    __syncthreads();
#pragma unroll 1
    for (int kt = 0; kt < nk; ++kt) {
      const bool more = (kt + 1 < nk);
      if (more) { const int kk = (kt + 1) * 64; GL4_(r, kk) }
      COMPUTE_(0)
      __syncthreads();
      if (more) {
        SS4_(r, 0)
        __syncthreads();
      }
    }
  }
#undef GL_
#undef SS_
#undef GL4_
#undef SS4_
#undef COMPUTE_
}

struct ARow {
  const u16* base; int lda;
  DEVI const u16* operator()(int m, int k) const { return base + (size_t)m * lda + k; }
};
struct ACmp {
  const u16* proj; int colbase;
  DEVI const u16* operator()(int rr, int k) const {
    const int b = rr >> 8, g = (rr >> 7) & 1;
    int c = rr & 127; c = c > 126 ? 126 : c;
    const int l = k >> 6, d = k & 63;
    return proj + ((size_t)b * T + 16 * c + l) * LDP + colbase + g * 64 + d;
  }
};


#define XCD_TILE_LOOP(idx, MT, NT)                                                                     \
  const bool sw_ = (gridDim.x & 7) == 0;                                                               \
  const int xcd_ = blockIdx.x & 7;                                                                     \
  const int tstart_ = sw_ ? (int)(blockIdx.x >> 3) : (int)blockIdx.x;                                  \
  const int tstep_ = sw_ ? (int)(gridDim.x >> 3) : (int)gridDim.x;                                     \
  const int ttotal_ = sw_ ? ((MT) / 8) * (NT) : (MT) * (NT);                                           \
  _Pragma("unroll 1") for (int idx = tstart_; idx < ttotal_; idx += tstep_)
#define XCD_TILE_MT(idx, NT) (sw_ ? ((idx) / (NT)) * 8 + xcd_ : (idx) / (NT))
#define XCD_TILE_NT(idx, NT) ((idx) % (NT))

#define GEMM_LANE_VARS                                                    \
  const int tid = launder(threadIdx.x), lane = tid & 63, w = tid >> 6;    \
  const int wm = w >> 1, wn = w & 1, col = lane & 15, quad = lane >> 4;   \
  (void)wm; (void)wn; (void)col; (void)quad;

DEVI void phase1(const Params& p, unsigned char* smem) {
  u16* sA = (u16*)smem; u16* sB = sA + 128 * 72;
  XCD_TILE_LOOP(idx, 256 + 32, 19) {
    GEMM_LANE_VARS
    f32x4 acc[4][4];
    const int mt = XCD_TILE_MT(idx, 19), nt_ = XCD_TILE_NT(idx, 19);
    if (mt < 256) {
      const int m0 = mt * 128, n0 = nt_ * 128;
      gemm_mainloop<true>(tid, sA, sB, ARow{p.hn, LDA}, p.winT, LDA, m0, n0, 16, acc);
#pragma unroll
      for (int mi = 0; mi < 4; ++mi) {
        const int m = m0 + wm * 64 + 16 * mi + col;
        const int b = m >> 11, t = m & 2047;
#pragma unroll
        for (int ni = 0; ni < 4; ++ni) {
          const int nt = n0 + wn * 64 + 16 * ni;
          const int n = nt + 4 * quad;
          f32x4 v = acc[ni][mi];
          if (nt >= LDP) continue;
          if ((nt >= C_VS && nt < C_KW) || (nt >= C_VW && nt < C_GATE)) {
            const bool isw = nt >= C_VW;
            const int off = n - (isw ? C_VW : C_VS);
            const int g = off >> 6, d = off & 63;
            u16* dst = (isw ? p.vtw : p.vts) + ((size_t)(b * 2 + g) * 64 + d) * LDT + t;
#pragma unroll
            for (int r = 0; r < 4; ++r) dst[(size_t)r * LDT] = f2bf(v[r]);
          } else {
            const bool rope_tile = ((nt >= C_KS && nt < C_VS) || (nt >= C_KW && nt < C_VW)) && ((nt & 63) == 0);
            if (rope_tile) {
#pragma unroll
              for (int r = 0; r < 4; ++r) {
                const float pr = __shfl_xor(v[r], 32);
                const int i = ((quad & 1) << 2) + r;
                const float cs = p.rope[(size_t)m * 16 + i], sn = p.rope[(size_t)m * 16 + 8 + i];
                v[r] = (quad < 2) ? (v[r] * cs - pr * sn) : (v[r] * cs + pr * sn);
              }
            }
            uint2 pk; pk.x = pack2(v[0], v[1]); pk.y = pack2(v[2], v[3]);
            *(uint2*)(p.proj + (size_t)m * LDP + n) = pk;
          }
        }
      }
    } else if (nt_ < 16) {
      const int isv = nt_ >> 3;
      const int m0 = (mt - 256) * 128, n0 = (nt_ & 7) * 128;
      gemm_mainloop<true>(tid, sA, sB, ARow{p.memn, LDA}, isv ? p.wmvT : p.wmkT, LDA, m0, n0, 16, acc);
#pragma unroll
      for (int mi = 0; mi < 4; ++mi) {
        const int m = m0 + wm * 64 + 16 * mi + col;
        const int b = m >> 8, key = m & 255;
#pragma unroll
        for (int ni = 0; ni < 4; ++ni) {
          const int n = n0 + wn * 64 + 16 * ni + 4 * quad;
          const f32x4 v = acc[ni][mi];
          if (isv) {
            const int head = n >> 8, d = n & 255;
            u16* dst = p.memvt + ((size_t)(b * 4 + head) * 256 + d) * 256 + key;
#pragma unroll
            for (int r = 0; r < 4; ++r) dst[r * 256] = f2bf(v[r]);
          } else {
            uint2 pk; pk.x = pack2(v[0], v[1]); pk.y = pack2(v[2], v[3]);
            *(uint2*)(p.memk + (size_t)m * LDA + n) = pk;
          }
        }
      }
    }
  }
}

DEVI void conv_tile(const Params& p, unsigned char* smem, int ct) {
  u16* sU = (u16*)smem;
  float2* sRed = (float2*)(smem + 62 * 512 * 2);
  const int tid = launder(threadIdx.x), lane = tid & 63, w = tid >> 6;
  const int b = ct >> 6, t0 = (ct & 63) * 32;
  __syncthreads();
  for (int it = tid; it < 62 * 64; it += 256) {
    const int r = it >> 6, c8 = it & 63;
    const int t = t0 - 30 + r;
    uint4 pk = {0u, 0u, 0u, 0u};
    if (t >= 0) {
      const u16* src = p.proj + ((size_t)b * T + t) * LDP + c8 * 8;
      const uint4 a = *(const uint4*)src, bb = *(const uint4*)(src + 512);
      const unsigned au[4] = {a.x, a.y, a.z, a.w}, bu[4] = {bb.x, bb.y, bb.z, bb.w};
      unsigned o[4];
#pragma unroll
      for (int j = 0; j < 4; ++j) {
        const float a0 = __uint_as_float(au[j] << 16), a1 = __uint_as_float(au[j] & 0xffff0000u);
        const float b0 = __uint_as_float(bu[j] << 16), b1 = __uint_as_float(bu[j] & 0xffff0000u);
        o[j] = pack2(a0 * sigmoidf_(b0), a1 * sigmoidf_(b1));
      }
      pk.x = o[0]; pk.y = o[1]; pk.z = o[2]; pk.w = o[3];
    }
    *(uint4*)(sU + r * 512 + c8 * 8) = pk;
  }
  const int c = 2 * tid;
  float w0[31], w1[31];
#pragma unroll
  for (int j = 0; j < 31; ++j) { w0[j] = p.conv_w[j * 512 + c]; w1[j] = p.conv_w[j * 512 + c + 1]; }
  const float bd0 = p.conv_b[c], bd1 = p.conv_b[c + 1];
  __syncthreads();
  float ya[32], yb[32];
#pragma unroll
  for (int tt = 0; tt < 32; ++tt) {
    float y0 = bd0, y1 = bd1;
#pragma unroll
    for (int j = 0; j < 31; ++j) {
      const unsigned uu = *(const unsigned*)(sU + (tt + j) * 512 + c);
      y0 += w0[j] * __uint_as_float(uu << 16);
      y1 += w1[j] * __uint_as_float(uu & 0xffff0000u);
    }
    ya[tt] = y0; yb[tt] = y1;
    float s = y0 + y1, q = y0 * y0 + y1 * y1;
    s = wave_sum(s); q = wave_sum(q);
    if (lane == 0) sRed[tt * 4 + w] = make_float2(s, q);
  }
  __syncthreads();
  const float g0 = p.ln_g[c], g1 = p.ln_g[c + 1], lb0 = p.ln_b[c], lb1 = p.ln_b[c + 1];
#pragma unroll
  for (int tt = 0; tt < 32; ++tt) {
    const float y0 = ya[tt], y1 = yb[tt];
    const float2 r0 = sRed[tt * 4 + 0], r1 = sRed[tt * 4 + 1], r2 = sRed[tt * 4 + 2], r3 = sRed[tt * 4 + 3];
    const float S = r0.x + r1.x + r2.x + r3.x, Q = r0.y + r1.y + r2.y + r3.y;
    const float mu = S * (1.f / 512.f);
    const float var = fmaxf(Q * (1.f / 512.f) - mu * mu, 0.f);
    const float rstd = rsqrtf(var + 1e-6f);
    const float z0 = (y0 - mu) * rstd * g0 + lb0, z1 = (y1 - mu) * rstd * g1 + lb1;
    const float o0 = z0 * sigmoidf_(z0), o1 = z1 * sigmoidf_(z1);
    *(unsigned*)(p.mix + ((size_t)b * T + t0 + tt) * LDA + c) = pack2(o0, o1);
  }
}

DEVI void compress2_tile(const Params& p, unsigned char* smem, int tile);
DEVI void phase2(const Params& p, unsigned char* smem) {
  u16* sA = (u16*)smem; u16* sB = sA + 128 * 72;
#pragma unroll 1
  for (int tile = blockIdx.x; tile < 64 + 1024; tile += gridDim.x) {
    GEMM_LANE_VARS
    if (tile < 64) {
      const int ty = tile >> 5, mt = tile & 31;
      const int m0 = mt * 128;
      f32x4 acc[4][4];
      gemm_mainloop<true>(tid, sA, sB, ACmp{p.proj, ty ? C_VC : C_KC}, p.w1T + (size_t)ty * 128 * LDW1, LDW1, m0, 0, 32, acc);
#pragma unroll
      for (int mi = 0; mi < 4; ++mi) {
        const int m = m0 + wm * 64 + 16 * mi + col;
#pragma unroll
        for (int ni = 0; ni < 4; ++ni) {
          const int n = wn * 64 + 16 * ni + 4 * quad;
          const f32x4 v = acc[ni][mi];
          const float4 bb = *(const float4*)(p.biasp + ty * 128 + n);
          uint2 pk;
          pk.x = pack2(gelu_tanh(v[0] + bb.x), gelu_tanh(v[1] + bb.y));
          pk.y = pack2(gelu_tanh(v[2] + bb.z), gelu_tanh(v[3] + bb.w));
          *(uint2*)(p.hdn + ((size_t)ty * 4096 + m) * 128 + n) = pk;
        }
      }
      asm volatile("s_waitcnt vmcnt(0)" ::: "memory");
      __syncthreads();
      compress2_tile(p, smem, tile);
    } else {
      conv_tile(p, smem, tile - 64);
    }
  }
}

DEVI void compress2_tile(const Params& p, unsigned char* smem, int tile) {
  u16* sA = (u16*)smem; u16* sB = sA + 128 * 72;
  {
    GEMM_LANE_VARS
    const int ty = tile >> 5, mt = tile & 31;
    const int m0 = mt * 128;
    f32x4 acc[4][4];
    gemm_mainloop<true>(tid, sA, sB, ARow{p.hdn + (size_t)ty * 4096 * 128, 128}, p.w2T + (size_t)ty * 128 * 128, 128, m0, 0, 2, acc);
    if (wn == 0) {
#pragma unroll
      for (int mi = 0; mi < 4; ++mi) {
        const int m = m0 + 16 * mi + wm * 64 + col;
        const int bg = m >> 7, c = m & 127;
#pragma unroll
        for (int ni = 0; ni < 4; ++ni) {
          const int n = 16 * ni + 4 * quad;
          const f32x4 v = acc[ni][mi];
          const float4 bb = *(const float4*)(p.cmp_b2 + ty * 64 + n);
          const float o0 = v[0] + bb.x, o1 = v[1] + bb.y, o2 = v[2] + bb.z, o3 = v[3] + bb.w;
          if (ty == 0) {
            uint2 pk; pk.x = pack2(o0, o1); pk.y = pack2(o2, o3);
            *(uint2*)(p.kc + (size_t)m * 64 + n) = pk;
          } else {
            u16* dst = p.vcT + ((size_t)bg * 64 + n) * 128 + c;
            dst[0] = f2bf(o0); dst[128] = f2bf(o1); dst[256] = f2bf(o2); dst[384] = f2bf(o3);
          }
        }
      }
    }
  }
}

template <int DH, int NQ, int LDK, class MaskF>
DEVI void attn_qk(const u16* sK, const bf16x8 (&qf)[NQ][DH / 32], f32x4 (&o)[NQ][DH / 16], float (&m)[NQ], float (&l)[NQ],
                  float c2, int lane, MaskF valid, bf16x8 (&pb)[NQ][2]) {
  const int col = lane & 15, quad = lane >> 4;
  f32x4 s[NQ][4];
  __builtin_amdgcn_s_setprio(1);
#pragma unroll
  for (int kt = 0; kt < 4; ++kt) {
#pragma unroll
    for (int qt = 0; qt < NQ; ++qt) s[qt][kt] = f32x4{0.f, 0.f, 0.f, 0.f};
#pragma unroll
    for (int ks = 0; ks < DH / 32; ++ks) {
      const bf16x8 kf = *(const bf16x8*)(sK + (16 * kt + col) * LDK + 32 * ks + 8 * quad);
#pragma unroll
      for (int qt = 0; qt < NQ; ++qt) s[qt][kt] = mfma16(kf, qf[qt][ks], s[qt][kt]);
    }
  }
  __builtin_amdgcn_s_setprio(0);
#pragma unroll
  for (int qt = 0; qt < NQ; ++qt) {
    float mx = -1e30f;
#pragma unroll
    for (int kt = 0; kt < 4; ++kt)
#pragma unroll
      for (int r = 0; r < 4; ++r) {
        const bool v = valid(qt, 16 * kt + 4 * quad + r);
        const float sv = v ? s[qt][kt][r] : -1e30f;
        s[qt][kt][r] = sv;
        mx = fmaxf(mx, sv);
      }
    mx = fmaxf(mx, __shfl_xor(mx, 16));
    mx = fmaxf(mx, __shfl_xor(mx, 32));
    const float mn = fmaxf(m[qt], mx);
    const float alpha = fexp2((m[qt] - mn) * c2);
    m[qt] = mn;
    const float mc = fmaxf(mn, -1e20f) * c2;
    float ps = 0.f;
#pragma unroll
    for (int kt = 0; kt < 4; ++kt)
#pragma unroll
      for (int r = 0; r < 4; ++r) {
        const float pv = fexp2(__builtin_fmaf(s[qt][kt][r], c2, -mc));
        ps += pv;
        s[qt][kt][r] = pv;
      }
    l[qt] = l[qt] * alpha + ps;
#pragma unroll
    for (int dt = 0; dt < DH / 16; ++dt) o[qt][dt] *= alpha;
#pragma unroll
    for (int kk = 0; kk < 2; ++kk) {
      union { bf16x8 v; unsigned u[4]; } cv;
      cv.u[0] = pack2(s[qt][2 * kk][0], s[qt][2 * kk][1]);
      cv.u[1] = pack2(s[qt][2 * kk][2], s[qt][2 * kk][3]);
      cv.u[2] = pack2(s[qt][2 * kk + 1][0], s[qt][2 * kk + 1][1]);
      cv.u[3] = pack2(s[qt][2 * kk + 1][2], s[qt][2 * kk + 1][3]);
      pb[qt][kk] = cv.v;
    }
  }
}
template <int DH, int NQ, int LDV>
DEVI void attn_pv(const u16* sVt, const bf16x8 (&pb)[NQ][2], f32x4 (&o)[NQ][DH / 16], int lane) {
  const int col = lane & 15, quad = lane >> 4;
  __builtin_amdgcn_s_setprio(1);
#pragma unroll
  for (int dt = 0; dt < DH / 16; ++dt) {
#pragma unroll
    for (int kk = 0; kk < 2; ++kk) {
      union { bf16x8 v; uint2 h[2]; } cv;
      cv.h[0] = *(const uint2*)(sVt + (16 * dt + col) * LDV + 32 * kk + 4 * quad);
      cv.h[1] = *(const uint2*)(sVt + (16 * dt + col) * LDV + 32 * kk + 16 + 4 * quad);
#pragma unroll
      for (int qt = 0; qt < NQ; ++qt) o[qt][dt] = mfma16(cv.v, pb[qt][kk], o[qt][dt]);
    }
  }
  __builtin_amdgcn_s_setprio(0);
}
template <int DH, int NQ, int LDK, int LDV, class MaskF>
DEVI void attn_tile(const u16* sK, const u16* sVt, const bf16x8 (&qf)[NQ][DH / 32], f32x4 (&o)[NQ][DH / 16],
                    float (&m)[NQ], float (&l)[NQ], float c2, int lane, MaskF valid) {
  bf16x8 pb[NQ][2];
  attn_qk<DH, NQ, LDK>(sK, qf, o, m, l, c2, lane, valid, pb);
  attn_pv<DH, NQ, LDV>(sVt, pb, o, lane);
}

DEVI void phase_nsa(const Params& p, unsigned char* smem) {
  u16* sK = (u16*)smem;
  u16* sVt = (u16*)(smem + 18432);
  float* impH = (float*)(smem + 35840);
  float* impT = (float*)(smem + 52736);
  unsigned* selm = (unsigned*)(smem + 56960);
  const float c2 = 0.125f * 1.4426950408889634f;
#pragma unroll 1
  for (int tile = blockIdx.x; tile < 2048; tile += gridDim.x) {
    const int tid = launder(threadIdx.x), lane = tid & 63, w = tid >> 6, col = lane & 15, quad = lane >> 4;
    const int qtile = 63 - (tile >> 5), bg = tile & 31, b = bg >> 1, g = bg & 1, q0 = qtile * 32;
    const int h = g * 4 + w;
    __syncthreads();
    if (tid < 32) selm[tid] = 0u;
    {
      const u16* kcp = p.kc + (size_t)bg * 128 * 64;
      const u16* vcp = p.vcT + (size_t)bg * 64 * 128;
#pragma unroll
      for (int i = 0; i < 4; ++i) {
        const int c = tid + 256 * i;
        const int row = c >> 3, ch = (c & 7) << 3;
        *(uint4*)(sK + row * 72 + ch) = *(const uint4*)(kcp + row * 64 + ch);
        const int row2 = c >> 4, ch2 = (c & 15) << 3;
        *(uint4*)(sVt + row2 * 136 + ch2) = *(const uint4*)(vcp + row2 * 128 + ch2);
      }
    }
    bf16x8 qf[2][2];
    float gate[2][3];
    int tq[2];
#pragma unroll
    for (int qt = 0; qt < 2; ++qt) {
      const int t = q0 + 16 * qt + col;
      tq[qt] = t;
      const size_t tok = (size_t)b * T + t;
      const u16* qp = p.proj + tok * LDP + C_Q + h * 64 + 8 * quad;
      qf[qt][0] = *(const bf16x8*)qp;
      qf[qt][1] = *(const bf16x8*)(qp + 32);
#pragma unroll
      for (int br = 0; br < 3; ++br) gate[qt][br] = sigmoidf_(bf2f(p.proj[tok * LDP + C_GATE + h * 3 + br]));
    }
    __syncthreads();

    f32x4 comb[2][4];
    {
      const int srcl = (lane + 48) & 63;
#pragma unroll
      for (int qt = 0; qt < 2; ++qt) {
        f32x4 s[8];
#pragma unroll
        for (int kt = 0; kt < 8; ++kt) {
          s[kt] = f32x4{0.f, 0.f, 0.f, 0.f};
#pragma unroll
          for (int ks = 0; ks < 2; ++ks) {
            const bf16x8 kf = *(const bf16x8*)(sK + (16 * kt + col) * 72 + 32 * ks + 8 * quad);
            s[kt] = mfma16(kf, qf[qt][ks], s[kt]);
          }
        }
        const int t = tq[qt];
        float mx = -1e30f;
#pragma unroll
        for (int kt = 0; kt < 8; ++kt)
#pragma unroll
          for (int r = 0; r < 4; ++r) {
            const int c = 16 * kt + 4 * quad + r;
            const bool v = (16 * c + 31) <= t;
            const float sv = v ? s[kt][r] : -1e30f;
            s[kt][r] = sv;
            mx = fmaxf(mx, sv);
          }
        mx = fmaxf(mx, __shfl_xor(mx, 16));
        mx = fmaxf(mx, __shfl_xor(mx, 32));
        float ps = 0.f;
        const float mcc = fmaxf(mx, -1e20f) * c2;
#pragma unroll
        for (int kt = 0; kt < 8; ++kt)
#pragma unroll
          for (int r = 0; r < 4; ++r) {
            const float pv = fexp2(__builtin_fmaf(s[kt][r], c2, -mcc));
            ps += pv;
            s[kt][r] = pv;
          }
        ps += __shfl_xor(ps, 16);
        ps += __shfl_xor(ps, 32);
        const float inv = ps > 0.f ? 1.f / ps : 0.f;
#pragma unroll
        for (int kt = 0; kt < 8; ++kt)
#pragma unroll
          for (int r = 0; r < 4; ++r) s[kt][r] *= inv;
        float prev3 = 0.f;
#pragma unroll
        for (int kt = 0; kt < 8; ++kt) {
          const float sum4 = s[kt][0] + s[kt][1] + s[kt][2] + s[kt][3];
          const float xs = __shfl(s[kt][3], srcl);
          const float extra = quad ? xs : prev3;
          prev3 = xs;
          impH[(w * 32 + 16 * qt + col) * 33 + 4 * kt + quad] = sum4 + extra;
        }
        bf16x8 pb[4];
#pragma unroll
        for (int kk = 0; kk < 4; ++kk) {
          union { bf16x8 v; unsigned u[4]; } cv;
          cv.u[0] = pack2(s[2 * kk][0], s[2 * kk][1]);
          cv.u[1] = pack2(s[2 * kk][2], s[2 * kk][3]);
          cv.u[2] = pack2(s[2 * kk + 1][0], s[2 * kk + 1][1]);
          cv.u[3] = pack2(s[2 * kk + 1][2], s[2 * kk + 1][3]);
          pb[kk] = cv.v;
        }
#pragma unroll
        for (int dt = 0; dt < 4; ++dt) {
          f32x4 oc = f32x4{0.f, 0.f, 0.f, 0.f};
#pragma unroll
          for (int kk = 0; kk < 4; ++kk) {
            union { bf16x8 v; uint2 hh[2]; } cv;
            cv.hh[0] = *(const uint2*)(sVt + (16 * dt + col) * 136 + 32 * kk + 4 * quad);
            cv.hh[1] = *(const uint2*)(sVt + (16 * dt + col) * 136 + 32 * kk + 16 + 4 * quad);
            oc = mfma16(cv.v, pb[kk], oc);
          }
          comb[qt][dt] = oc * gate[qt][0];
        }
      }
    }
#pragma unroll
    for (int qt = 0; qt < 2; ++qt) {
      const size_t tok = (size_t)b * T + tq[qt];
      union { bf16x8 v; unsigned u[4]; } own, par, res;
      own.v = qf[qt][0];
#pragma unroll
      for (int j = 0; j < 4; ++j) par.u[j] = (unsigned)__shfl_xor((int)own.u[j], 16);
      const float4 c0 = *(const float4*)(p.rope + tok * 16), c1 = *(const float4*)(p.rope + tok * 16 + 4);
      const float4 s0 = *(const float4*)(p.rope + tok * 16 + 8), s1 = *(const float4*)(p.rope + tok * 16 + 12);
      const float cs[8] = {c0.x, c0.y, c0.z, c0.w, c1.x, c1.y, c1.z, c1.w};
      const float sn[8] = {s0.x, s0.y, s0.z, s0.w, s1.x, s1.y, s1.z, s1.w};
#pragma unroll
      for (int j = 0; j < 4; ++j) {
        const float o0 = __uint_as_float(own.u[j] << 16), o1 = __uint_as_float(own.u[j] & 0xffff0000u);
        const float p0 = __uint_as_float(par.u[j] << 16), p1 = __uint_as_float(par.u[j] & 0xffff0000u);
        const float sg = (quad == 0) ? -1.f : 1.f;
        const float r0 = o0 * cs[2 * j] + sg * p0 * sn[2 * j];
        const float r1 = o1 * cs[2 * j + 1] + sg * p1 * sn[2 * j + 1];
        res.u[j] = (quad < 2) ? pack2(r0, r1) : own.u[j];
      }
      qf[qt][0] = res.v;
    }
    __syncthreads();
#pragma unroll
    for (int i = 0; i < 4; ++i) {
      const int cell = tid + 256 * i;
      const int qi = cell >> 5, s_ = cell & 31;
      const int cur = (q0 + qi) >> 6;
      float v = impH[(0 * 32 + qi) * 33 + s_] + impH[(1 * 32 + qi) * 33 + s_] + impH[(2 * 32 + qi) * 33 + s_] +
                impH[(3 * 32 + qi) * 33 + s_];
      const int dist = cur - s_;
      const bool forced = (s_ == 0) || (dist >= 0 && dist < 2);
      v = forced ? 1e9f : (s_ <= cur ? v : -1.f);
      impT[qi * 33 + s_] = v;
    }
    __syncthreads();
    {
      const int qi = tid >> 3, sub = tid & 7;
      unsigned bits = 0u;
#pragma unroll
      for (int k = 0; k < 4; ++k) {
        const int s_ = sub * 4 + k;
        const float v = impT[qi * 33 + s_];
        int rank = 0;
        for (int s2 = 0; s2 < 32; ++s2) {
          const float v2 = impT[qi * 33 + s2];
          rank += ((v2 > v) || (v2 == v && s2 < s_)) ? 1 : 0;
        }
        if (rank < 16) bits |= 1u << s_;
      }
      atomicOr(&selm[qi], bits);
    }
    __syncthreads();
    unsigned sm[2] = {selm[col], selm[16 + col]};
    unsigned uni = 0u;
#pragma unroll
    for (int i = 0; i < 32; ++i) uni |= selm[i];
    const int kbmax = (q0 + 31) >> 6;
    {
      float m[2] = {-1e30f, -1e30f}, l[2] = {0.f, 0.f};
      f32x4 o[2][4];
#pragma unroll
      for (int qt = 0; qt < 2; ++qt)
#pragma unroll
        for (int dt = 0; dt < 4; ++dt) o[qt][dt] = f32x4{0.f, 0.f, 0.f, 0.f};
      unsigned rem = (kbmax >= 31) ? uni : (uni & ((1u << (kbmax + 1)) - 1u));
      int kb = rem ? (__ffs((int)rem) - 1) : -1;
      uint4 rk0, rk1, rv0, rv1;
      const int lr0 = tid >> 3, lch = (tid & 7) << 3;
#define LOADKV_(kbx, CK, VT)                                                                                         \
      rk0 = *(const uint4*)(p.proj + ((size_t)b * T + (kbx) * 64 + lr0) * LDP + (CK) + g * 64 + lch);                 \
      rk1 = *(const uint4*)(p.proj + ((size_t)b * T + (kbx) * 64 + lr0 + 32) * LDP + (CK) + g * 64 + lch);            \
      rv0 = *(const uint4*)((VT) + ((size_t)bg * 64 + lr0) * LDT + (kbx) * 64 + lch);                                 \
      rv1 = *(const uint4*)((VT) + ((size_t)bg * 64 + lr0 + 32) * LDT + (kbx) * 64 + lch);
#define STOREKV_()                                                                                                   \
      *(uint4*)(sK + lr0 * 72 + lch) = rk0; *(uint4*)(sK + (lr0 + 32) * 72 + lch) = rk1;                              \
      *(uint4*)(sVt + lr0 * 72 + lch) = rv0; *(uint4*)(sVt + (lr0 + 32) * 72 + lch) = rv1;
      if (kb >= 0) { LOADKV_(kb, C_KS, p.vts) }
#pragma unroll 1
      while (kb >= 0) {
        rem &= rem - 1u;
        const int nkb = rem ? (__ffs((int)rem) - 1) : -1;
        __syncthreads();
        STOREKV_()
        if (nkb >= 0) { LOADKV_(nkb, C_KS, p.vts) }
        __syncthreads();
        const int lim0 = ((sm[0] >> kb) & 1u) ? tq[0] : -1, lim1 = ((sm[1] >> kb) & 1u) ? tq[1] : -1;
        attn_tile<64, 2, 72, 72>(sK, sVt, qf, o, m, l, c2, lane, [&](int qt, int kl) {
          return (kb * 64 + kl) <= (qt ? lim1 : lim0);
        });
        kb = nkb;
      }
#pragma unroll
      for (int qt = 0; qt < 2; ++qt) {
        float lt = l[qt];
        lt += __shfl_xor(lt, 16);
        lt += __shfl_xor(lt, 32);
        const float sc = lt > 0.f ? gate[qt][1] / lt : 0.f;
#pragma unroll
        for (int dt = 0; dt < 4; ++dt) comb[qt][dt] += o[qt][dt] * sc;
      }
    }
    {
      float m[2] = {-1e30f, -1e30f}, l[2] = {0.f, 0.f};
      f32x4 o[2][4];
#pragma unroll
      for (int qt = 0; qt < 2; ++qt)
#pragma unroll
        for (int dt = 0; dt < 4; ++dt) o[qt][dt] = f32x4{0.f, 0.f, 0.f, 0.f};
      const int kblo = (q0 >= 511) ? ((q0 - 511) >> 6) : 0;
      uint4 rk0, rk1, rv0, rv1;
      const int lr0 = tid >> 3, lch = (tid & 7) << 3;
      int kb = kblo;
      LOADKV_(kb, C_KW, p.vtw)
#pragma unroll 1
      while (kb >= 0) {
        const int nkb = (kb < kbmax) ? kb + 1 : -1;
        __syncthreads();
        STOREKV_()
        if (nkb >= 0) { LOADKV_(nkb, C_KW, p.vtw) }
        __syncthreads();
        attn_tile<64, 2, 72, 72>(sK, sVt, qf, o, m, l, c2, lane, [&](int qt, int kl) {
          return (unsigned)(tq[qt] - (kb * 64 + kl)) < 512u;
        });
        kb = nkb;
      }
#undef LOADKV_
#undef STOREKV_
#pragma unroll
      for (int qt = 0; qt < 2; ++qt) {
        float lt = l[qt];
        lt += __shfl_xor(lt, 16);
        lt += __shfl_xor(lt, 32);
        const float sc = lt > 0.f ? gate[qt][2] / lt : 0.f;
#pragma unroll
        for (int dt = 0; dt < 4; ++dt) comb[qt][dt] += o[qt][dt] * sc;
      }
    }
#pragma unroll
    for (int qt = 0; qt < 2; ++qt) {
      const size_t tok = (size_t)b * T + tq[qt];
#pragma unroll
      for (int dt = 0; dt < 4; ++dt) {
        uint2 pk;
        pk.x = pack2(comb[qt][dt][0], comb[qt][dt][1]);
        pk.y = pack2(comb[qt][dt][2], comb[qt][dt][3]);
        *(uint2*)(p.mix + tok * LDA + 512 + h * 64 + 16 * dt + 4 * quad) = pk;
      }
    }
  }
}

template <bool RESB>
DEVI void phase_resid(const Params& p, unsigned char* smem, const u16* A, const u16* Wt, const float* res, float* ssq) {
  u16* sA = (u16*)smem; u16* sB = sA + 128 * 72;
  XCD_TILE_LOOP(idx, 256, 8) {
    GEMM_LANE_VARS
    const int mt = XCD_TILE_MT(idx, 8), nt_ = XCD_TILE_NT(idx, 8);
    const int m0 = mt * 128, n0 = nt_ * 128;
    f32x4 acc[4][4];
    gemm_mainloop<true>(tid, sA, sB, ARow{A, LDA}, Wt, LDA, m0, n0, 16, acc);
#pragma unroll
    for (int mi = 0; mi < 4; ++mi) {
      const int m = m0 + wm * 64 + 16 * mi + col;
      float ss = 0.f;
#pragma unroll
      for (int ni = 0; ni < 4; ++ni) {
        const int n = n0 + wn * 64 + 16 * ni + 4 * quad;
        const f32x4 v = acc[ni][mi];
        float4 r;
        if (RESB) {
          const uint2 rb = *(const uint2*)(p.hn + (size_t)m * LDA + n);
          r.x = __uint_as_float(rb.x << 16); r.y = __uint_as_float(rb.x & 0xffff0000u);
          r.z = __uint_as_float(rb.y << 16); r.w = __uint_as_float(rb.y & 0xffff0000u);
        } else {
          r = *(const float4*)(res + (size_t)m * D + n);
        }
        float4 hv;
        hv.x = r.x + v[0]; hv.y = r.y + v[1]; hv.z = r.z + v[2]; hv.w = r.w + v[3];
        ss += hv.x * hv.x + hv.y * hv.y + hv.z * hv.z + hv.w * hv.w;
        uint2 pk; pk.x = pack2(hv.x, hv.y); pk.y = pack2(hv.z, hv.w);
        *(uint2*)(p.hn + (size_t)m * LDA + n) = pk;
      }
      ss += __shfl_xor(ss, 16);
      ss += __shfl_xor(ss, 32);
      if (quad == 0) atomicAdd(ssq + m, ss);
    }
  }
}

DEVI void phase_scaled(const Params& p, unsigned char* smem, const u16* A, const u16* Wt, int ntn, const float* ssq, u16* outp, int ldo) {
  u16* sA = (u16*)smem; u16* sB = sA + 128 * 72;
  XCD_TILE_LOOP(idx, 256, ntn) {
    GEMM_LANE_VARS
    const int mt = XCD_TILE_MT(idx, ntn), nt_ = XCD_TILE_NT(idx, ntn);
    const int m0 = mt * 128, n0 = nt_ * 128;
    f32x4 acc[4][4];
    gemm_mainloop<true>(tid, sA, sB, ARow{A, LDA}, Wt, LDA, m0, n0, 16, acc);
#pragma unroll
    for (int mi = 0; mi < 4; ++mi) {
      const int m = m0 + wm * 64 + 16 * mi + col;
      const float rstd = rsqrtf(ssq[m] * (1.f / D) + 1e-6f);
#pragma unroll
      for (int ni = 0; ni < 4; ++ni) {
        const int n = n0 + wn * 64 + 16 * ni + 4 * quad;
        const f32x4 v = acc[ni][mi];
        uint2 pk; pk.x = pack2(v[0] * rstd, v[1] * rstd); pk.y = pack2(v[2] * rstd, v[3] * rstd);
        *(uint2*)(outp + (size_t)m * ldo + n) = pk;
      }
    }
  }
}

DEVI void phase_memattn(const Params& p, unsigned char* smem) {
  u16* sK = (u16*)smem;
  u16* sVt = (u16*)(smem + 33792);
  const float c2 = 0.0625f * 1.4426950408889634f;
#pragma unroll 1
  for (int tile = blockIdx.x; tile < 2048; tile += gridDim.x) {
    const int tid = launder(threadIdx.x), lane = tid & 63, w = tid >> 6, col = lane & 15, quad = lane >> 4;
    const int b = tile >> 7, head = (tile >> 5) & 3, q0 = (tile & 31) * 64;
    const size_t tok = (size_t)b * T + q0 + 16 * w + col;
    bf16x8 qf[1][8];
#pragma unroll
    for (int ks = 0; ks < 8; ++ks) qf[0][ks] = *(const bf16x8*)(p.qm + tok * LDA + head * 256 + 32 * ks + 8 * quad);
    float m[1] = {-1e30f}, l[1] = {0.f};
    f32x4 o[1][16];
#pragma unroll
    for (int dt = 0; dt < 16; ++dt) o[0][dt] = f32x4{0.f, 0.f, 0.f, 0.f};
    uint4 rg0, rg1, rg2, rg3, rg4, rg5, rg6, rg7;
    const int krow = tid >> 5, kch = (tid & 31) << 3;
    const int vrow = tid >> 3, vch = (tid & 7) << 3;
#define LK1_(i, kbx) rg##i = *(const uint4*)(p.memk + ((size_t)b * 256 + (kbx) * 64 + krow + 8 * i) * LDA + head * 256 + kch);
#define SK1_(i) *(uint4*)(sK + (krow + 8 * i) * 264 + kch) = rg##i;
#define LV1_(i, kbx) rg##i = *(const uint4*)(p.memvt + ((size_t)(b * 4 + head) * 256 + vrow + 32 * i) * 256 + (kbx) * 64 + vch);
#define SV1_(i) *(uint4*)(sVt + (vrow + 32 * i) * 72 + vch) = rg##i;
#define LOADK_(kbx) LK1_(0, kbx) LK1_(1, kbx) LK1_(2, kbx) LK1_(3, kbx) LK1_(4, kbx) LK1_(5, kbx) LK1_(6, kbx) LK1_(7, kbx)
#define STOREK_() SK1_(0) SK1_(1) SK1_(2) SK1_(3) SK1_(4) SK1_(5) SK1_(6) SK1_(7)
#define LOADV_(kbx) LV1_(0, kbx) LV1_(1, kbx) LV1_(2, kbx) LV1_(3, kbx) LV1_(4, kbx) LV1_(5, kbx) LV1_(6, kbx) LV1_(7, kbx)
#define STOREV_() SV1_(0) SV1_(1) SV1_(2) SV1_(3) SV1_(4) SV1_(5) SV1_(6) SV1_(7)
    __syncthreads();
    LOADK_(0)
    STOREK_()
    LOADV_(0)
    __syncthreads();
#pragma unroll 1
    for (int kb = 0; kb < 4; ++kb) {
      bf16x8 pb[1][2];
      attn_qk<256, 1, 264>(sK, qf, o, m, l, c2, lane, [&](int, int) { return true; }, pb);
      STOREV_()
      if (kb < 3) { LOADK_(kb + 1) }
      __syncthreads();
      attn_pv<256, 1, 72>(sVt, pb, o, lane);
      if (kb < 3) {
        STOREK_()
        LOADV_(kb + 1)
      }
      __syncthreads();
    }
#undef LOADK_
#undef STOREK_
#undef LOADV_
#undef STOREV_
#undef LK1_
#undef SK1_
#undef LV1_
#undef SV1_
    float lt = l[0];
    lt += __shfl_xor(lt, 16);
    lt += __shfl_xor(lt, 32);
    const float inv = 1.f / lt;
#pragma unroll
    for (int dt = 0; dt < 16; ++dt) {
      uint2 pk;
      pk.x = pack2(o[0][dt][0] * inv, o[0][dt][1] * inv);
      pk.y = pack2(o[0][dt][2] * inv, o[0][dt][3] * inv);
      *(uint2*)(p.mix + tok * LDA + head * 256 + 16 * dt + 4 * quad) = pk;
    }
  }
}

__constant__ unsigned char kCandI[64] = {0,0,0,0,0,0,0,0,0,0,0,0,0,0,0,0, 1,1,1,1,1,1,1,1, 2,2,2,2,2, 3,3,3,3, 4,4,4, 5,5, 6,6, 7,7,
                                          8, 9, 10, 11, 12, 13, 14, 15, 0,0,0,0,0,0,0,0,0,0,0,0,0,0};
__constant__ unsigned char kCandJ[64] = {0,1,2,3,4,5,6,7,8,9,10,11,12,13,14,15, 0,1,2,3,4,5,6,7, 0,1,2,3,4, 0,1,2,3, 0,1,2, 0,1, 0,1, 0,1,
                                          0, 0, 0, 0, 0, 0, 0, 0, 0,0,0,0,0,0,0,0,0,0,0,0,0,0};

DEVI unsigned score_key(float v, int idx) {
  unsigned u = __float_as_uint(v);
  u = (u & 0x80000000u) ? ~u : (u | 0x80000000u);
  return (u & ~127u) | (unsigned)(127 - idx);
}
DEVI float key_score(unsigned k) {
  k &= ~127u;
  const unsigned u = (k & 0x80000000u) ? (k & 0x7fffffffu) : ~k;
  return __uint_as_float(u);
}

DEVI void phase_peer_route(const Params& p, unsigned char* smem) {
  u16* sA = (u16*)smem; u16* sB = sA + 128 * 72;
  unsigned* sScore = (unsigned*)smem;
  unsigned* sTop = (unsigned*)(smem + 36864);
  unsigned* sTmp = (unsigned*)(smem + 53248);
  {
    const int t0_ = launder(threadIdx.x);
    const int gw = (blockIdx.x * 256 + t0_) >> 6, nw = (gridDim.x * 256) >> 6;
    conv_fp8_rows(p.peer_u, p.ub8, p.uscale, 16384, gw, nw, t0_ & 63);
    conv_fp8_rows(p.peer_v, p.vb8, p.vscale, 16384, gw, nw, t0_ & 63);
  }
#pragma unroll 1
  for (int tile = blockIdx.x; tile < 256 * 8; tile += gridDim.x) {
    GEMM_LANE_VARS
    const int mt = tile >> 3, hd = tile & 7;
    const int m0 = mt * 128;
#pragma unroll 1
    for (int ph = 0; ph < 2; ++ph) {
      const int hp = hd * 2 + ph;
      f32x4 acc[4][4];
      __syncthreads();
      gemm_mainloop<false>(tid, sA, sB, ARow{p.pq + hp * 128, LDPQ}, p.subk + (size_t)hp * 128 * 128, 128, m0, 0, 2, acc);
#pragma unroll 1
      for (int hh = 0; hh < 2; ++hh) {
        if (wm == hh) {
#pragma unroll
          for (int mi = 0; mi < 4; ++mi) {
            const int row = 16 * mi + col;
#pragma unroll
            for (int ni = 0; ni < 4; ++ni) {
              const int n = wn * 64 + 16 * ni + 4 * quad;
              const f32x4 v = acc[ni][mi];
              uint4 kk;
              kk.x = score_key(v[0], n); kk.y = score_key(v[1], n + 1);
              kk.z = score_key(v[2], n + 2); kk.w = score_key(v[3], n + 3);
              *(uint4*)(sScore + row * 132 + n) = kk;
            }
          }
        }
        __syncthreads();
#pragma unroll 1
        for (int rg = 0; rg < 4; ++rg) {
          const int rbase = w * 16 + rg * 4;
          unsigned k0[4], k1[4], t0[4], t1[4], thr[4];
#pragma unroll
          for (int r = 0; r < 4; ++r) {
            k0[r] = sScore[(rbase + r) * 132 + lane];
            k1[r] = sScore[(rbase + r) * 132 + 64 + lane];
            t0[r] = ((k0[r] >> 16) << 7) | (k0[r] & 127u);
            t1[r] = ((k1[r] >> 16) << 7) | (k1[r] & 127u);
            thr[r] = 0u;
          }
#pragma unroll
          for (int bit = 22; bit >= 0; --bit) {
#pragma unroll
            for (int r = 0; r < 4; ++r) {
              const unsigned cand = thr[r] | (1u << bit);
              const int cnt = __popcll(__ballot(t0[r] >= cand)) + __popcll(__ballot(t1[r] >= cand));
              thr[r] = (cnt >= 16) ? cand : thr[r];
            }
          }
          unsigned* tmp = sTmp + w * 64;
#pragma unroll
          for (int r = 0; r < 4; ++r) {
            const unsigned long long b0 = __ballot(t0[r] >= thr[r]), b1 = __ballot(t1[r] >= thr[r]);
            const int pos0 = __builtin_amdgcn_mbcnt_hi((unsigned)(b0 >> 32), __builtin_amdgcn_mbcnt_lo((unsigned)b0, 0u));
            const int pos1 = __popcll(b0) + __builtin_amdgcn_mbcnt_hi((unsigned)(b1 >> 32), __builtin_amdgcn_mbcnt_lo((unsigned)b1, 0u));
            if (t0[r] >= thr[r]) tmp[r * 16 + pos0] = k0[r];
            if (t1[r] >= thr[r]) tmp[r * 16 + pos1] = k1[r];
          }
          __builtin_amdgcn_fence(__ATOMIC_RELEASE, "wavefront");
          __builtin_amdgcn_wave_barrier();
          __builtin_amdgcn_fence(__ATOMIC_ACQUIRE, "wavefront");
          {
            const int r = lane >> 4, ix = lane & 15;
            const unsigned mine = tmp[r * 16 + ix];
            const uint4 a = *(const uint4*)(tmp + r * 16), b = *(const uint4*)(tmp + r * 16 + 4), c = *(const uint4*)(tmp + r * 16 + 8),
                        d = *(const uint4*)(tmp + r * 16 + 12);
            const int rk = (a.x > mine) + (a.y > mine) + (a.z > mine) + (a.w > mine) + (b.x > mine) + (b.y > mine) + (b.z > mine) + (b.w > mine) +
                           (c.x > mine) + (c.y > mine) + (c.z > mine) + (c.w > mine) + (d.x > mine) + (d.y > mine) + (d.z > mine) + (d.w > mine);
            sTop[((hh * 64 + rbase + r) * 2 + ph) * 16 + rk] = mine;
          }
          __builtin_amdgcn_fence(__ATOMIC_RELEASE, "wavefront");
          __builtin_amdgcn_wave_barrier();
        }
        __syncthreads();
      }
    }
    const int ci = kCandI[lane], cj = kCandJ[lane];
    const bool act = lane < 50;
#pragma unroll 1
    for (int tg = 0; tg < 8; ++tg) {
      const int tb = w * 32 + tg * 4;
      unsigned k0[4], k1[4], ku[4], thr[4];
      float v[4];
#pragma unroll
      for (int r = 0; r < 4; ++r) {
        k0[r] = sTop[((tb + r) * 2 + 0) * 16 + ci];
        k1[r] = sTop[((tb + r) * 2 + 1) * 16 + cj];
        v[r] = key_score(k0[r]) + key_score(k1[r]);
        unsigned u = __float_as_uint(v[r]);
        u = (u & 0x80000000u) ? ~u : (u | 0x80000000u);
        ku[r] = act ? (((u >> 16) << 6) | (unsigned)(63 - lane)) : 0u;
        thr[r] = 0u;
      }
#pragma unroll
      for (int bit = 21; bit >= 0; --bit) {
#pragma unroll
        for (int r = 0; r < 4; ++r) {
          const unsigned cand = thr[r] | (1u << bit);
          const int cnt = __popcll(__ballot(ku[r] >= cand));
          thr[r] = (cnt >= 16) ? cand : thr[r];
        }
      }
#pragma unroll
      for (int r = 0; r < 4; ++r) {
        const bool sel = act && (ku[r] >= thr[r]);
        const unsigned long long ms = __ballot(sel);
        const int slot = __builtin_amdgcn_mbcnt_hi((unsigned)(ms >> 32), __builtin_amdgcn_mbcnt_lo((unsigned)ms, 0u));
        const float vmax = __int_as_float(__builtin_amdgcn_readlane(__float_as_int(v[r]), 0));
        const float e = sel ? __expf(v[r] - vmax) : 0.f;
        const float tot = wave_sum(e);
        if (sel) {
          const int eid = (127 - (int)(k0[r] & 127u)) * 128 + (127 - (int)(k1[r] & 127u));
          const size_t o = (size_t)(m0 + tb + r) * 128 + hd * 16 + slot;
          p.experts[o] = eid;
          p.gates[o] = e / tot;
        }
      }
    }
  }
}

template <int PART>
DEVI void phase_peer_gather(const Params& p, unsigned char* smem) {
  const int w0_ = threadIdx.x >> 6;
#pragma unroll 1
  for (int tok = blockIdx.x * 4 + w0_; tok < NTOK; tok += gridDim.x * 4) {
    if (NTOK % (gridDim.x * 4) == 0) __syncthreads();
    const int tid = launder(threadIdx.x), lane = tid & 63;
    const uint4* hp4 = (const uint4*)(p.hn + (size_t)tok * LDA + lane * 16);
    float hv[16], xn[16], y[16];
    {
      const uint4 a0 = hp4[0], a1 = hp4[1];
      const unsigned hu[8] = {a0.x, a0.y, a0.z, a0.w, a1.x, a1.y, a1.z, a1.w};
#pragma unroll
      for (int i = 0; i < 8; ++i) { hv[2 * i] = __uint_as_float(hu[i] << 16); hv[2 * i + 1] = __uint_as_float(hu[i] & 0xffff0000u); }
    }
    float ss = 0.f;
#pragma unroll
    for (int i = 0; i < 16; ++i) ss += hv[i] * hv[i];
    ss = wave_sum(ss);
    const float rstd = rsqrtf(ss * (1.f / D) + 1e-6f);
    {
      const float4* g4 = (const float4*)p.peer_g + lane * 4;
      const float4 a0 = g4[0], a1 = g4[1], a2 = g4[2], a3 = g4[3];
      const float gg[16] = {a0.x, a0.y, a0.z, a0.w, a1.x, a1.y, a1.z, a1.w, a2.x, a2.y, a2.z, a2.w, a3.x, a3.y, a3.z, a3.w};
#pragma unroll
      for (int i = 0; i < 16; ++i) { xn[i] = hv[i] * rstd * gg[i]; y[i] = 0.f; }
    }
    int e0 = p.experts[(size_t)tok * 128 + lane], e1 = p.experts[(size_t)tok * 128 + 64 + lane];
    float g0 = p.gates[(size_t)tok * 128 + lane], g1 = p.gates[(size_t)tok * 128 + 64 + lane];
    if (PART == 0) {
      int* sE = (int*)(smem + (tid >> 6) * 1024);
      float* sG = (float*)(sE + 128);
      int pos0 = 0, pos1 = 0, base = 0;
      const int q0_ = e0 >> 10, q1_ = e1 >> 10;
#pragma unroll
      for (int q = 0; q < 16; ++q) {
        const unsigned long long m0 = __ballot(q0_ == q), m1 = __ballot(q1_ == q);
        const int c0 = __popcll(m0);
        const int i0 = __builtin_amdgcn_mbcnt_hi((unsigned)(m0 >> 32), __builtin_amdgcn_mbcnt_lo((unsigned)m0, 0u));
        const int i1 = __builtin_amdgcn_mbcnt_hi((unsigned)(m1 >> 32), __builtin_amdgcn_mbcnt_lo((unsigned)m1, 0u));
        if (q0_ == q) pos0 = base + i0;
        if (q1_ == q) pos1 = base + c0 + i1;
        base += c0 + __popcll(m1);
      }
      __builtin_amdgcn_fence(__ATOMIC_RELEASE, "wavefront");
      __builtin_amdgcn_wave_barrier();
      sE[pos0] = e0; sG[pos0] = g0;
      sE[pos1] = e1; sG[pos1] = g1;
      __builtin_amdgcn_fence(__ATOMIC_RELEASE, "wavefront");
      __builtin_amdgcn_wave_barrier();
      __builtin_amdgcn_fence(__ATOMIC_ACQUIRE, "wavefront");
      e0 = sE[lane]; e1 = sE[64 + lane];
      g0 = sG[lane]; g1 = sG[64 + lane];
      p.experts[(size_t)tok * 128 + lane] = e0;
      p.experts[(size_t)tok * 128 + 64 + lane] = e1;
    }
    const float su0 = p.uscale[e0], su1 = p.uscale[e1];
    const float sv0 = p.vscale[e0], sv1 = p.vscale[e1];
    float cf0 = 0.f, cf1 = 0.f, dsum = 0.f;
    uint4 ca[8], cb[8];
#define LOADB_(R, bi)                                                                                   \
    _Pragma("unroll") for (int u = 0; u < 8; ++u) {                                                       \
      const int kk_ = (((bi) & 7) << 3) + u;                                                             \
      const int e_ = __builtin_amdgcn_readlane((((bi) >> 3) & 1) ? e1 : e0, kk_);                        \
      R[u] = ((const uint4*)((((bi) >> 4) ? p.vb8 : p.ub8) + (size_t)e_ * 1024))[lane];                  \
    }
#define COMPU_(R, bi)                                                                                   \
    {                                                                                                    \
      float d8[8];                                                                                       \
      _Pragma("unroll") for (int u = 0; u < 8; ++u) {                                                     \
        const unsigned uu[4] = {R[u].x, R[u].y, R[u].z, R[u].w};                                         \
        f32x2 a2 = {0.f, 0.f};                                                                           \
        _Pragma("unroll") for (int j = 0; j < 4; ++j) {                                                   \
          const f32x2 lo = __builtin_amdgcn_cvt_pk_f32_fp8((int)uu[j], false);                           \
          const f32x2 hi = __builtin_amdgcn_cvt_pk_f32_fp8((int)uu[j], true);                            \
          a2 = xn2[2 * j] * lo + a2;                                                                     \
          a2 = xn2[2 * j + 1] * hi + a2;                                                                 \
        }                                                                                                \
        d8[u] = a2[0] + a2[1];                                                                           \
      }                                                                                                  \
          \
      float v4[4], v2[2];                                                                                \
      _Pragma("unroll") for (int i = 0; i < 4; ++i) {                                                     \
        const float snd = b5 ? d8[i] : d8[4 + i], kp = b5 ? d8[4 + i] : d8[i];                           \
        v4[i] = kp + __shfl_xor(snd, 32);                                                                \
      }                                                                                                  \
      _Pragma("unroll") for (int i = 0; i < 2; ++i) {                                                     \
        const float snd = b4 ? v4[i] : v4[2 + i], kp = b4 ? v4[2 + i] : v4[i];                           \
        v2[i] = kp + __shfl_xor(snd, 16);                                                                \
      }                                                                                                  \
      float v1;                                                                                          \
      { const float snd = b3 ? v2[0] : v2[1], kp = b3 ? v2[1] : v2[0]; v1 = kp + __shfl_xor(snd, 8); }   \
      v1 += __shfl_xor(v1, 4);                                                                           \
      v1 += __shfl_xor(v1, 2);                                                                           \
      v1 += __shfl_xor(v1, 1);                                                                           \
                \
      const float got = __shfl(v1, fsrc);                                                                \
      if ((lane >> 3) == ((bi) & 7)) dsum = got;                                                         \
    }                                                                                                    \
    if (((bi) & 7) == 7) {                                                                               \
      if (((bi) >> 3) & 1) cf1 = gelu_tanh(dsum * su1) * g1 * sv1; else cf0 = gelu_tanh(dsum * su0) * g0 * sv0; \
    }
#define COMPV_(R, bi)                                                                                   \
    _Pragma("unroll") for (int u = 0; u < 8; ++u) {                                                       \
      const int kk_ = (((bi) & 7) << 3) + u;                                                             \
      const float ck_ = __int_as_float(__builtin_amdgcn_readlane(__float_as_int((((bi) >> 3) & 1) ? cf1 : cf0), kk_)); \
      const f32x2 ck2 = {ck_, ck_};                                                                      \
      const unsigned uu[4] = {R[u].x, R[u].y, R[u].z, R[u].w};                                           \
      _Pragma("unroll") for (int j = 0; j < 4; ++j) {                                                     \
        const f32x2 lo = __builtin_amdgcn_cvt_pk_f32_fp8((int)uu[j], false);                             \
        const f32x2 hi = __builtin_amdgcn_cvt_pk_f32_fp8((int)uu[j], true);                              \
        y2[2 * j] = ck2 * lo + y2[2 * j];                                                                \
        y2[2 * j + 1] = ck2 * hi + y2[2 * j + 1];                                                        \
      }                                                                                                  \
    }
    const bool b5 = (lane & 32) != 0, b4 = (lane & 16) != 0, b3 = (lane & 8) != 0;
    const int fsrc = ((lane & 4) << 3) | ((lane & 2) << 3) | ((lane & 1) << 3);
    f32x2 xn2[8], y2[8];
#pragma unroll
    for (int i = 0; i < 8; ++i) { xn2[i] = f32x2{xn[2 * i], xn[2 * i + 1]}; y2[i] = f32x2{0.f, 0.f}; }
    if (PART == 0) {
      LOADB_(ca, 0)
#pragma unroll 1
      for (int bi = 0; bi < 16; bi += 2) {
        LOADB_(cb, bi + 1)
        COMPU_(ca, bi)
        if (bi + 2 < 16) { LOADB_(ca, bi + 2) }
        COMPU_(cb, bi + 1)
      }
      p.gates[(size_t)tok * 128 + lane] = cf0;
      p.gates[(size_t)tok * 128 + 64 + lane] = cf1;
      continue;
    }
    cf0 = g0; cf1 = g1;
    LOADB_(ca, 16)
#pragma unroll 1
    for (int bi = 16; bi < 32; bi += 2) {
      LOADB_(cb, bi + 1)
      COMPV_(ca, bi)
      if (bi + 2 < 32) { LOADB_(ca, bi + 2) }
      COMPV_(cb, bi + 1)
    }
#undef LOADB_
#undef COMPU_
#undef COMPV_
#pragma unroll
    for (int i = 0; i < 8; ++i) { y[2 * i] = y2[i][0]; y[2 * i + 1] = y2[i][1]; }
    float s2 = 0.f;
    {
      const uint4 a0 = hp4[0], a1 = hp4[1];
      const unsigned hu[8] = {a0.x, a0.y, a0.z, a0.w, a1.x, a1.y, a1.z, a1.w};
#pragma unroll
      for (int i = 0; i < 8; ++i) {
        y[2 * i] += __uint_as_float(hu[i] << 16);
        y[2 * i + 1] += __uint_as_float(hu[i] & 0xffff0000u);
        s2 += y[2 * i] * y[2 * i] + y[2 * i + 1] * y[2 * i + 1];
      }
    }
    s2 = wave_sum(s2);
    const float rs2 = rsqrtf(s2 * (1.f / D) + 1e-6f);
    {
      const float4* g4 = (const float4*)p.final_g + lane * 4;
      const float4 a0 = g4[0], a1 = g4[1], a2 = g4[2], a3 = g4[3];
      float4* o4 = (float4*)(p.out + (size_t)tok * D) + lane * 4;
      o4[0] = make_float4(y[0] * rs2 * a0.x, y[1] * rs2 * a0.y, y[2] * rs2 * a0.z, y[3] * rs2 * a0.w);
      o4[1] = make_float4(y[4] * rs2 * a1.x, y[5] * rs2 * a1.y, y[6] * rs2 * a1.z, y[7] * rs2 * a1.w);
      o4[2] = make_float4(y[8] * rs2 * a2.x, y[9] * rs2 * a2.y, y[10] * rs2 * a2.z, y[11] * rs2 * a2.w);
      o4[3] = make_float4(y[12] * rs2 * a3.x, y[13] * rs2 * a3.y, y[14] * rs2 * a3.z, y[15] * rs2 * a3.w);
    }
  }
}

#define XB_TMO      128
#define XB_XCNT(j)  (256  + 64 * (j))
#define XB_XSUB(j)  (1280 + 64 * (j))
#define XB_XGEN(j)  (2304 + 64 * (j))
#define XB_TOP      3328
#define XB_TOPGEN   3392
#define XCD_BAR_WORDS 3456
#define XB_SPIN_CAP (1u << 20)
#define LAS __attribute__((address_space(3)))
DEVI unsigned xb_ld(unsigned* q) { return __hip_atomic_load(q, __ATOMIC_RELAXED, __HIP_MEMORY_SCOPE_AGENT); }
DEVI unsigned xb_add(unsigned* q, unsigned v) { return __hip_atomic_fetch_add(q, v, __ATOMIC_RELAXED, __HIP_MEMORY_SCOPE_AGENT); }
DEVI unsigned xb_xcc_id() { return (unsigned)__builtin_amdgcn_s_getreg((3 << 11) | 20) & 0xFu; }
#define XB_SPIN(cond, bar) do { unsigned _sp = 0; while (cond) { __builtin_amdgcn_s_sleep(1); \
    if ((++_sp & 255u) == 0u) { if (xb_ld(&(bar)[XB_TMO])) break; if (_sp > XB_SPIN_CAP) { atomicAdd(&(bar)[XB_TMO], 1u); break; } } } } while (0)
struct XcdBarrier { unsigned* bar; unsigned x; volatile LAS unsigned* st; };
DEVI XcdBarrier xcd_barrier_post(unsigned* bar, volatile LAS unsigned* st) {
  XcdBarrier b; b.bar = bar; b.x = xb_xcc_id(); b.st = st;
  if (threadIdx.x == 0) (void)xb_add(&bar[XB_XCNT(b.x)], 1u);
  return b;
}
DEVI void xcd_barrier_complete(unsigned* bar, unsigned x, unsigned& nloc, unsigned& nx) {
  const unsigned G = gridDim.x * gridDim.y * gridDim.z;
  unsigned sum, cnt, mine, sp = 0u;
  for (;;) {
    sum = 0u; cnt = 0u; mine = 0u;
#pragma unroll
    for (unsigned j = 0; j < 16; ++j) { const unsigned c = xb_ld(&bar[XB_XCNT(j)]); sum += c; cnt += (c > 0u) ? 1u : 0u; mine = (j == x) ? c : mine; }
    if (sum == G) break;
    __builtin_amdgcn_s_sleep(1);
    if ((++sp & 255u) == 0u) { if (xb_ld(&bar[XB_TMO])) break; if (sp > XB_SPIN_CAP) { atomicAdd(&bar[XB_TMO], 1u); break; } }
  }
  nloc = mine > 0u ? mine : 1u; nx = cnt > 0u ? cnt : 1u;
}
DEVI void xcd_barrier(const XcdBarrier& b) {
  asm volatile("s_waitcnt vmcnt(0)" ::: "memory");
  __syncthreads();
  if (threadIdx.x == 0) {
    unsigned* bar = b.bar;
    __builtin_amdgcn_s_waitcnt(0);
    unsigned nloc = b.st[0], nx = b.st[1];
    if (nloc == 0u) { xcd_barrier_complete(bar, b.x, nloc, nx); b.st[0] = nloc; b.st[1] = nx; }
    const unsigned old = xb_add(&bar[XB_XSUB(b.x)], 1u);
    const unsigned gen = old / nloc;
    if (old + 1u == (gen + 1u) * nloc) {
      __builtin_amdgcn_fence(__ATOMIC_RELEASE, "agent");
      asm volatile("s_waitcnt vmcnt(0)" ::: "memory");
      const unsigned og = xb_add(&bar[XB_TOP], 1u);
      const unsigned tg = og / nx;
      if (og + 1u == (tg + 1u) * nx) xb_add(&bar[XB_TOPGEN], 1u);
      else XB_SPIN(xb_ld(&bar[XB_TOPGEN]) == tg, bar);
      __builtin_amdgcn_fence(__ATOMIC_ACQUIRE, "agent");
      xb_add(&bar[XB_XGEN(b.x)], 1u);
      asm volatile("s_waitcnt vmcnt(0)" ::: "memory");
    } else {
      XB_SPIN(xb_ld(&bar[XB_XGEN(b.x)]) == gen, bar);
      __builtin_amdgcn_fence(__ATOMIC_ACQUIRE, "agent");
      asm volatile("s_waitcnt vmcnt(0)" ::: "memory");
    }
  }
  __syncthreads();
}

template <bool COOP>
__global__ void __launch_bounds__(256, 2) mega(Params p, int ph_lo, int ph_hi) {
  __shared__ __attribute__((aligned(16))) unsigned char smem[SMEM_BYTES];
  __shared__ uint4 xb_words;
  if (threadIdx.x == 0) xb_words = make_uint4(0u, 0u, 0u, 0u);
  __syncthreads();
  XcdBarrier xb = xcd_barrier_post(p.bar, (volatile LAS unsigned*)&xb_words);
  (void)xb;
  if (COOP && ph_hi > 1000) cg::this_grid().sync();
#ifdef REPEAT_MASK
#define RUN_PHASE(i, call)                                                                   \
  if (ph_lo <= (i) && (i) <= ph_hi) {                                                        \
    call;                                                                                    \
    if (COOP && ((REPEAT_MASK >> (i)) & 1)) { xcd_barrier(xb); call; }                       \
    if (COOP && (i) < ph_hi) xcd_barrier(xb);                                                \
  }
#else
#define RUN_PHASE(i, call)                                                                   \
  if (ph_lo <= (i) && (i) <= ph_hi) {                                                        \
    call;                                                                                    \
    if (COOP && (i) < ph_hi) {                                                               \
      xcd_barrier(xb);                                                                       \
    }                                                                                        \
  }
#endif
  RUN_PHASE(0, phase0(p))
  RUN_PHASE(1, phase1(p, smem))
  RUN_PHASE(2, phase2(p, smem))
  RUN_PHASE(4, phase_nsa(p, smem))
  RUN_PHASE(5, phase_resid<false>(p, smem, p.mix, p.woutT, p.x, p.ssq1))
  RUN_PHASE(6, phase_scaled(p, smem, p.hn, p.wmqT, 8, p.ssq1, p.qm, LDA))
  RUN_PHASE(7, phase_memattn(p, smem))
  RUN_PHASE(8, phase_resid<true>(p, smem, p.mix, p.wmoT, nullptr, p.ssq2))
  RUN_PHASE(9, phase_scaled(p, smem, p.hn, p.wpqT, 16, p.ssq2, p.pq, LDPQ))
  RUN_PHASE(10, phase_peer_route(p, smem))
  RUN_PHASE(11, phase_peer_gather<0>(p, smem))
  RUN_PHASE(12, phase_peer_gather<1>(p, smem))
#undef RUN_PHASE
}

extern "C" void kernel_launch(void* const* d_in, const int* in_sizes, int n_in, void* d_out, int out_size, void* d_ws,
                              size_t ws_size, hipStream_t stream) {
  (void)in_sizes; (void)n_in; (void)out_size; (void)ws_size;
  Params p{};
  p.x = (const float*)d_in[0]; p.mem = (const float*)d_in[1]; p.pos = (const int*)d_in[2];
  p.mix_g = (const float*)d_in[3]; p.w_in = (const float*)d_in[4]; p.conv_w = (const float*)d_in[5];
  p.conv_b = (const float*)d_in[6]; p.ln_g = (const float*)d_in[7]; p.ln_b = (const float*)d_in[8];
  p.cmp_pos = (const float*)d_in[9]; p.cmp_w1 = (const float*)d_in[10]; p.cmp_b1 = (const float*)d_in[11];
  p.cmp_w2 = (const float*)d_in[12]; p.cmp_b2 = (const float*)d_in[13]; p.w_out = (const float*)d_in[14];
  p.memq_g = (const float*)d_in[15]; p.memkv_g = (const float*)d_in[16]; p.w_mq = (const float*)d_in[17];
  p.w_mk = (const float*)d_in[18]; p.w_mv = (const float*)d_in[19]; p.w_mo = (const float*)d_in[20];
  p.peer_g = (const float*)d_in[21]; p.peer_wq = (const float*)d_in[22]; p.peer_sk = (const float*)d_in[23];
  p.peer_u = (const float*)d_in[24]; p.peer_v = (const float*)d_in[25]; p.final_g = (const float*)d_in[26];
  p.out = (float*)d_out;
  unsigned char* ws = (unsigned char*)d_ws;
  size_t off = 0;
  auto take = [&](size_t bytes) { unsigned char* r = ws + off; off += (bytes + 255) & ~(size_t)255; return r; };
  unsigned char* regA = take((size_t)NTOK * LDA * 2);
  unsigned char* regB = take((size_t)NTOK * LDP * 2);
  unsigned char* regC = take((size_t)NTOK * LDA * 2);
  p.hn = (u16*)regA;
  p.proj = (u16*)regB; p.qm = (u16*)regB; p.pq = (u16*)regB;
  p.mix = (u16*)regC; p.experts = (int*)regC; p.gates = (float*)(regC + (size_t)NTOK * 128 * 4);
  {
    unsigned char* tb = regC + (size_t)2 * NTOK * 128 * 4;
    p.ub8 = tb; p.vb8 = tb + (size_t)16384 * 1024;
    p.uscale = (float*)(tb + (size_t)2 * 16384 * 1024); p.vscale = p.uscale + 16384;
  }
  p.h = nullptr;
  p.vts = (u16*)take((size_t)Bn * 2 * 64 * LDT * 2);
  p.vtw = (u16*)take((size_t)Bn * 2 * 64 * LDT * 2);
  p.memn = (u16*)take((size_t)Bn * 256 * LDA * 2);
  p.memk = (u16*)take((size_t)Bn * 256 * LDA * 2);
  p.memvt = (u16*)take((size_t)Bn * 256 * D * 2);
  p.winT = (u16*)take((size_t)2432 * LDA * 2);
  p.woutT = (u16*)take((size_t)1024 * LDA * 2);
  p.wmqT = (u16*)take((size_t)1024 * LDA * 2);
  p.wmkT = (u16*)take((size_t)1024 * LDA * 2);
  p.wmvT = (u16*)take((size_t)1024 * LDA * 2);
  p.wmoT = (u16*)take((size_t)1024 * LDA * 2);
  p.wpqT = (u16*)take((size_t)2048 * LDA * 2);
  p.subk = (u16*)take((size_t)16 * 128 * 128 * 2);
  p.w1T = (u16*)take((size_t)2 * 128 * LDW1 * 2);
  p.w2T = (u16*)take((size_t)2 * 128 * 128 * 2);
  p.biasp = (float*)take(256 * 4);
  p.rope = (float*)take((size_t)NTOK * 16 * 4);
  p.hdn = (u16*)take((size_t)2 * 4096 * 128 * 2);
  p.kc = (u16*)take((size_t)Bn * 2 * 128 * 64 * 2);
  p.vcT = (u16*)take((size_t)Bn * 2 * 64 * 128 * 2);
  p.ssq1 = (float*)take((size_t)NTOK * 4);
  p.ssq2 = (float*)take((size_t)NTOK * 4);
  p.bar = (unsigned*)take(16384);
  if (off > ws_size) { fprintf(stderr, "workspace too small: need %zu have %zu\n", off, ws_size); return; }

#if COOP_MODE
  static int grid_blocks = 0;
  if (!grid_blocks) {
    int dev = 0, cus = 0, per_cu = 0;
    hipGetDevice(&dev);
    hipDeviceGetAttribute(&cus, hipDeviceAttributeMultiprocessorCount, dev);
    hipOccupancyMaxActiveBlocksPerMultiprocessor(&per_cu, mega<true>, 256, 0);
    if (per_cu > 2) per_cu = 2;
    if (per_cu < 1) per_cu = 1;
    grid_blocks = cus * per_cu;
  }
  int lo = 0, hi = NPHASE;
  void* args[] = {&p, &lo, &hi};
  (void)hipMemsetAsync(p.bar, 0, 16384, stream);
  hipError_t e = hipLaunchCooperativeKernel((void*)mega<true>, dim3(grid_blocks), dim3(256), args, 0, stream);
  if (e != hipSuccess) fprintf(stderr, "cooperative launch failed: %s (grid %d)\n", hipGetErrorString(e), grid_blocks);
#else
  for (int ph = 0; ph <= NPHASE; ++ph) mega<false><<<dim3(512), dim3(256), 0, stream>>>(p, ph, ph);
#endif
}
```

```cpp
#include <hip/hip_runtime.h>
#include <hip/hip_bf16.h>
#include <hip/hip_cooperative_groups.h>
#include <cstdio>
#include <cstdint>
namespace cg = cooperative_groups;

#ifndef COOP_MODE
#define COOP_MODE 1
#endif

typedef __attribute__((ext_vector_type(8))) short bf16x8;
typedef __attribute__((ext_vector_type(4))) short bf16x4;
typedef __attribute__((ext_vector_type(4))) float f32x4;
typedef unsigned short u16;

#define DEVI __device__ __forceinline__

constexpr int Bn = 16, T = 2048, D = 1024, NTOK = Bn * T, LDP = 2336;
constexpr int C_Q = 1024, C_KC = 1536, C_VC = 1664, C_KS = 1792, C_VS = 1920, C_KW = 2048, C_VW = 2176, C_GATE = 2304;
constexpr int SMEM_BYTES = 73728;
constexpr int LDA = 1088;
constexpr int LDHF = 1056;
constexpr int LDPQ = 2112;
constexpr int LDW1 = 2112;
constexpr int LDT = 2112;
constexpr int NPHASE = 12;

struct Params {
  const float* x; const float* mem; const int* pos; const float* mix_g; const float* w_in;
  const float* conv_w; const float* conv_b; const float* ln_g; const float* ln_b;
  const float* cmp_pos; const float* cmp_w1; const float* cmp_b1; const float* cmp_w2; const float* cmp_b2;
  const float* w_out; const float* memq_g; const float* memkv_g; const float* w_mq; const float* w_mk;
  const float* w_mv; const float* w_mo; const float* peer_g; const float* peer_wq; const float* peer_sk;
  const float* peer_u; const float* peer_v; const float* final_g;
  float* out;
  u16* hn; u16* proj; u16* mix; float* h; u16* vts; u16* vtw; u16* memn; u16* memk; u16* memvt;
  u16* winT; u16* woutT; u16* wmqT; u16* wmkT; u16* wmvT; u16* wmoT; u16* wpqT; u16* subk; u16* w1T; u16* w2T;
  float* biasp; float* rope; u16* hdn; u16* kc; u16* vcT; float* ssq1; float* ssq2;
  int* experts; float* gates; unsigned char* ub8; unsigned char* vb8; float* uscale; float* vscale; u16* qm; u16* pq;
  unsigned* bar;
};

DEVI int launder(int x) { asm volatile("" : "+v"(x)); return x; }
DEVI u16 f2bf(float f) {
  unsigned u = __float_as_uint(f);
  u += 0x7fffu + ((u >> 16) & 1u);
  return (u16)(u >> 16);
}
DEVI float bf2f(u16 h) { return __uint_as_float(((unsigned)h) << 16); }
DEVI unsigned pack2(float a, float b) { return (unsigned)f2bf(a) | ((unsigned)f2bf(b) << 16); }
DEVI float wave_sum(float v) {
#pragma unroll
  for (int o = 32; o; o >>= 1) v += __shfl_xor(v, o);
  return v;
}
DEVI float sigmoidf_(float x) { return 1.f / (1.f + __expf(-x)); }
DEVI float gelu_tanh(float x) {
  float u = 0.7978845608028654f * (x + 0.044715f * x * x * x);
  return 0.5f * x * (1.f + tanhf(u));
}
DEVI f32x4 mfma16(bf16x8 a, bf16x8 b, f32x4 c) { return __builtin_amdgcn_mfma_f32_16x16x32_bf16(a, b, c, 0, 0, 0); }
DEVI float fexp2(float x) { return __builtin_amdgcn_exp2f(x); }

DEVI void tconv(const float* __restrict__ src, int K, int N, u16* __restrict__ dst, int Npad, int ldd,
                const float* __restrict__ gain, int gtid, int gsz) {
  const int items = Npad * (K >> 3);
  for (int it = gtid; it < items; it += gsz) {
    const int n = it % Npad, kc = it / Npad;
    float f[8];
#pragma unroll
    for (int j = 0; j < 8; ++j) {
      float v = 0.f;
      if (n < N) {
        v = src[(size_t)(kc * 8 + j) * N + n];
        if (gain) v *= gain[kc * 8 + j];
      }
      f[j] = v;
    }
    uint4 pk;
    pk.x = pack2(f[0], f[1]); pk.y = pack2(f[2], f[3]); pk.z = pack2(f[4], f[5]); pk.w = pack2(f[6], f[7]);
    *(uint4*)(dst + (size_t)n * ldd + kc * 8) = pk;
  }
}

DEVI void conv_flat(const float* __restrict__ src, u16* __restrict__ dst, size_t n8, size_t gtid, size_t gsz) {
  for (size_t it = gtid; it < n8; it += gsz) {
    const float4 a = ((const float4*)src)[2 * it], b = ((const float4*)src)[2 * it + 1];
    uint4 pk;
    pk.x = pack2(a.x, a.y); pk.y = pack2(a.z, a.w); pk.z = pack2(b.x, b.y); pk.w = pack2(b.z, b.w);
    ((uint4*)dst)[it] = pk;
  }
}


typedef float f32x2 __attribute__((ext_vector_type(2)));
DEVI unsigned pk4_fp8(float a, float b, float c, float d) {
  int v = 0;
  v = __builtin_amdgcn_cvt_pk_fp8_f32(a, b, v, false);
  v = __builtin_amdgcn_cvt_pk_fp8_f32(c, d, v, true);
  return (unsigned)v;
}
DEVI void conv_fp8_rows(const float* __restrict__ src, unsigned char* __restrict__ dst, float* __restrict__ inv_scale,
                        int rows, int gw, int nw, int lane) {
  for (int r0 = gw; r0 < rows; r0 += 2 * nw) {
    const int r1 = r0 + nw;
    const bool has1 = r1 < rows;
    const float4* p0 = (const float4*)(src + (size_t)r0 * 1024) + lane * 4;
    const float4* p1 = (const float4*)(src + (size_t)(has1 ? r1 : r0) * 1024) + lane * 4;
    float4 v[2][4];
#pragma unroll
    for (int i = 0; i < 4; ++i) { v[0][i] = p0[i]; v[1][i] = p1[i]; }
    float mx[2];
#pragma unroll
    for (int q = 0; q < 2; ++q) {
      float m = 0.f;
#pragma unroll
      for (int i = 0; i < 4; ++i)
        m = fmaxf(m, fmaxf(fmaxf(fabsf(v[q][i].x), fabsf(v[q][i].y)), fmaxf(fabsf(v[q][i].z), fabsf(v[q][i].w))));
      mx[q] = m;
    }
#pragma unroll
    for (int o = 32; o; o >>= 1) { mx[0] = fmaxf(mx[0], __shfl_xor(mx[0], o)); mx[1] = fmaxf(mx[1], __shfl_xor(mx[1], o)); }
#pragma unroll
    for (int q = 0; q < 2; ++q) {
      if (q == 1 && !has1) break;
      const int r = q ? r1 : r0;
      const float sc = mx[q] > 0.f ? 224.f / mx[q] : 1.f;
      if (lane == 0) inv_scale[r] = mx[q] > 0.f ? mx[q] * (1.f / 224.f) : 1.f;
      uint4 o4;
      o4.x = pk4_fp8(v[q][0].x * sc, v[q][0].y * sc, v[q][0].z * sc, v[q][0].w * sc);
      o4.y = pk4_fp8(v[q][1].x * sc, v[q][1].y * sc, v[q][1].z * sc, v[q][1].w * sc);
      o4.z = pk4_fp8(v[q][2].x * sc, v[q][2].y * sc, v[q][2].z * sc, v[q][2].w * sc);
      o4.w = pk4_fp8(v[q][3].x * sc, v[q][3].y * sc, v[q][3].z * sc, v[q][3].w * sc);
      ((uint4*)(dst + (size_t)r * 1024))[lane] = o4;
    }
  }
}

DEVI void rownorm_bf16(const float* __restrict__ src, const float* __restrict__ g, u16* __restrict__ dst,
                       int rows, int gw, int nw, int lane) {
  for (int r0 = gw; r0 < rows; r0 += 2 * nw) {
    const int r1 = r0 + nw;
    const bool has1 = r1 < rows;
    const float4* pa = (const float4*)(src + (size_t)r0 * D);
    const float4* pb = (const float4*)(src + (size_t)(has1 ? r1 : r0) * D);
    float4 va[4], vb[4];
    float sa = 0.f, sb = 0.f;
#pragma unroll
    for (int i = 0; i < 4; ++i) { va[i] = pa[lane + 64 * i]; vb[i] = pb[lane + 64 * i]; }
#pragma unroll
    for (int i = 0; i < 4; ++i) {
      sa += va[i].x * va[i].x + va[i].y * va[i].y + va[i].z * va[i].z + va[i].w * va[i].w;
      sb += vb[i].x * vb[i].x + vb[i].y * vb[i].y + vb[i].z * vb[i].z + vb[i].w * vb[i].w;
    }
#pragma unroll
    for (int o = 32; o; o >>= 1) { sa += __shfl_xor(sa, o); sb += __shfl_xor(sb, o); }
    const float ra = rsqrtf(sa * (1.f / D) + 1e-6f), rb = rsqrtf(sb * (1.f / D) + 1e-6f);
#pragma unroll
    for (int i = 0; i < 4; ++i) {
      const float4 gg = ((const float4*)g)[lane + 64 * i];
      uint2 pk;
      pk.x = pack2(va[i].x * ra * gg.x, va[i].y * ra * gg.y);
      pk.y = pack2(va[i].z * ra * gg.z, va[i].w * ra * gg.w);
      *(uint2*)(dst + (size_t)r0 * LDA + (size_t)(lane + 64 * i) * 4) = pk;
      if (has1) {
        pk.x = pack2(vb[i].x * rb * gg.x, vb[i].y * rb * gg.y);
        pk.y = pack2(vb[i].z * rb * gg.z, vb[i].w * rb * gg.w);
        *(uint2*)(dst + (size_t)r1 * LDA + (size_t)(lane + 64 * i) * 4) = pk;
      }
    }
  }
}

DEVI void phase0(const Params& p) {
  const int tid = launder(threadIdx.x), lane = tid & 63;
  const int gtid = blockIdx.x * 256 + tid, gsz = gridDim.x * 256;
  const int gw = gtid >> 6, nw = gsz >> 6;
  rownorm_bf16(p.x, p.mix_g, p.hn, NTOK, gw, nw, lane);
  rownorm_bf16(p.mem, p.memkv_g, p.memn, Bn * 256, gw, nw, lane);
  tconv(p.w_in, 1024, 2328, p.winT, 2432, LDA, nullptr, gtid, gsz);
  tconv(p.w_out, 1024, 1024, p.woutT, 1024, LDA, nullptr, gtid, gsz);
  tconv(p.w_mq, 1024, 1024, p.wmqT, 1024, LDA, p.memq_g, gtid, gsz);
  tconv(p.w_mk, 1024, 1024, p.wmkT, 1024, LDA, nullptr, gtid, gsz);
  tconv(p.w_mv, 1024, 1024, p.wmvT, 1024, LDA, nullptr, gtid, gsz);
  tconv(p.w_mo, 1024, 1024, p.wmoT, 1024, LDA, nullptr, gtid, gsz);
  tconv(p.peer_wq, 1024, 2048, p.wpqT, 2048, LDA, p.peer_g, gtid, gsz);
  tconv(p.cmp_w1, 2048, 128, p.w1T, 128, LDW1, nullptr, gtid, gsz);
  tconv(p.cmp_w1 + 2048 * 128, 2048, 128, p.w1T + 128 * LDW1, 128, LDW1, nullptr, gtid, gsz);
  tconv(p.cmp_w2, 128, 64, p.w2T, 128, 128, nullptr, gtid, gsz);
  tconv(p.cmp_w2 + 128 * 64, 128, 64, p.w2T + 128 * 128, 128, 128, nullptr, gtid, gsz);
  conv_flat(p.peer_sk, p.subk, (size_t)16 * 128 * 128 / 8, gtid, gsz);
  for (int it = gtid; it < NTOK * 8; it += gsz) {
    const int tok = it >> 3, i = it & 7;
    const float inv = (i == 0) ? 1.000000000e+00f : (i == 1) ? 1.939227432e-01f : (i == 2) ? 3.760603070e-02f : (i == 3) ? 7.292664610e-03f : (i == 4) ? 1.414213562e-03f : (i == 5) ? 2.742481884e-04f : (i == 6) ? 5.318295734e-05f : 1.031338525e-05f;
    const float ang = (float)p.pos[tok] * inv;
    float sv, cv;
    sincosf(ang, &sv, &cv);
    p.rope[tok * 16 + i] = cv;
    p.rope[tok * 16 + 8 + i] = sv;
  }
  for (int o = gw; o < 256; o += nw) {
    const int ty = o >> 7, n = o & 127;
    float s = 0.f;
#pragma unroll 8
    for (int k = lane; k < 2048; k += 64)
      s += p.cmp_pos[ty * 2048 + k] * p.cmp_w1[((size_t)ty * 2048 + k) * 128 + n];
    s = wave_sum(s);
    if (lane == 0) p.biasp[o] = s + p.cmp_b1[o];
  }
  for (int it = gtid; it < NTOK; it += gsz) { p.ssq1[it] = 0.f; p.ssq2[it] = 0.f; }
}

template <bool DB, class AF>
DEVI void gemm_mainloop(int tid, u16* sA, u16* sB, AF af, const u16* __restrict__ Bt, int ldb, int m0, int n0, int nk,
                        f32x4 (&acc)[4][4]) {
  const int lane = tid & 63, w = tid >> 6;
  const int wm = w >> 1, wn = w & 1, col = lane & 15, quad = lane >> 4;
#pragma unroll
  for (int i = 0; i < 4; ++i)
#pragma unroll
    for (int j = 0; j < 4; ++j) acc[i][j] = f32x4{0.f, 0.f, 0.f, 0.f};
  uint4 ra0, ra1, ra2, ra3, rb0, rb1, rb2, rb3;
  const int lrow = tid >> 3, lkc = (tid & 7) << 3;
  const u16* bbase = Bt + (size_t)(n0 + lrow) * ldb + lkc;
#define GL_(R, i, kk)                                                     \
  R##a##i = *(const uint4*)af(m0 + lrow + 32 * i, (kk) + lkc);            \
  R##b##i = *(const uint4*)(bbase + (size_t)(32 * i) * ldb + (kk));
#define SS_(R, i, off)                                                    \
  *(uint4*)(sA + (off) + (lrow + 32 * i) * 72 + lkc) = R##a##i;           \
  *(uint4*)(sB + (off) + (lrow + 32 * i) * 72 + lkc) = R##b##i;
#define GL4_(R, kk) GL_(R, 0, kk) GL_(R, 1, kk) GL_(R, 2, kk) GL_(R, 3, kk)
#define SS4_(R, off) SS_(R, 0, off) SS_(R, 1, off) SS_(R, 2, off) SS_(R, 3, off)
#define COMPUTE_(cur)                                                                                                   \
  _Pragma("unroll") for (int ks = 0; ks < 2; ++ks) {                                                                    \
    bf16x8 fa[4], fb[4];                                                                                                \
    _Pragma("unroll") for (int mi = 0; mi < 4; ++mi)                                                                    \
      fa[mi] = *(const bf16x8*)(sA + (cur) + (wm * 64 + 16 * mi + col) * 72 + 32 * ks + 8 * quad);                      \
    _Pragma("unroll") for (int ni = 0; ni < 4; ++ni)                                                                    \
      fb[ni] = *(const bf16x8*)(sB + (cur) + (wn * 64 + 16 * ni + col) * 72 + 32 * ks + 8 * quad);                      \
    _Pragma("unroll") for (int ni = 0; ni < 4; ++ni)                                                                    \
      _Pragma("unroll") for (int mi = 0; mi < 4; ++mi) acc[ni][mi] = mfma16(fb[ni], fa[mi], acc[ni][mi]);               \
  }
  if (DB) {
    const int srow = 8 * w + (lane >> 3);
    const int spc = lane & 7;
#define STAGE_(st, kk)                                                                                         \
    _Pragma("unroll") for (int i = 0; i < 4; ++i) {                                                            \
      const int r_ = 32 * i + srow;                                                                            \
      const int c_ = (spc ^ ((r_ >> 1) & 7)) << 3;                                                             \
      __builtin_amdgcn_global_load_lds((const unsigned*)af(m0 + r_, (kk) + c_),                                \
                                       (unsigned*)(sA + (st) * 16384 + (32 * i + 8 * w) * 64), 16, 0, 0);      \
      __builtin_amdgcn_global_load_lds((const unsigned*)(Bt + (size_t)(n0 + r_) * ldb + (kk) + c_),            \
                                       (unsigned*)(sA + (st) * 16384 + 8192 + (32 * i + 8 * w) * 64), 16, 0, 0); \
    }
#define COMPUTE_SW_(st)                                                                                                 \
  _Pragma("unroll") for (int ks = 0; ks < 2; ++ks) {                                                                    \
    bf16x8 fa[4], fb[4];                                                                                                \
    const int pc_ = ((4 * ks + quad) ^ ((col >> 1) & 7)) << 3;                                                          \
    _Pragma("unroll") for (int mi = 0; mi < 4; ++mi)                                                                    \
      fa[mi] = *(const bf16x8*)(sA + (st) * 16384 + (wm * 64 + 16 * mi + col) * 64 + pc_);                              \
    _Pragma("unroll") for (int ni = 0; ni < 4; ++ni)                                                                    \
      fb[ni] = *(const bf16x8*)(sA + (st) * 16384 + 8192 + (wn * 64 + 16 * ni + col) * 64 + pc_);                       \
    __builtin_amdgcn_s_setprio(1);                                                                                      \
    _Pragma("unroll") for (int ni = 0; ni < 4; ++ni)                                                                    \
      _Pragma("unroll") for (int mi = 0; mi < 4; ++mi) acc[ni][mi] = mfma16(fb[ni], fa[mi], acc[ni][mi]);               \
    __builtin_amdgcn_s_setprio(0);                                                                                      \
  }
    STAGE_(0, 0)
#pragma unroll 1
    for (int kt = 0; kt < nk; kt += 2) {
      asm volatile("s_waitcnt vmcnt(0)" ::: "memory");
      __syncthreads();
      { const int kk = (kt + 1) * 64; STAGE_(1, kk) }
      COMPUTE_SW_(0)
      asm volatile("s_waitcnt vmcnt(0)" ::: "memory");
      __syncthreads();
      if (kt + 2 < nk) { const int kk = (kt + 2) * 64; STAGE_(0, kk) }
      COMPUTE_SW_(1)
    }
#undef STAGE_
#undef COMPUTE_SW_
  } else {
    GL4_(r, 0)
    SS4_(r, 0)
    __syncthreads();
#pragma unroll 1
    for (int kt = 0; kt < nk; ++kt) {
      const bool more = (kt + 1 < nk);
      if (more) { const int kk = (kt + 1) * 64; GL4_(r, kk) }
      COMPUTE_(0)
      __syncthreads();
      if (more) {
        SS4_(r, 0)
        __syncthreads();
      }
    }
  }
#undef GL_
#undef SS_
#undef GL4_
#undef SS4_
#undef COMPUTE_
}

struct ARow {
  const u16* base; int lda;
  DEVI const u16* operator()(int m, int k) const { return base + (size_t)m * lda + k; }
};
struct ACmp {
  const u16* proj; int colbase;
  DEVI const u16* operator()(int rr, int k) const {
    const int b = rr >> 8, g = (rr >> 7) & 1;
    int c = rr & 127; c = c > 126 ? 126 : c;
    const int l = k >> 6, d = k & 63;
    return proj + ((size_t)b * T + 16 * c + l) * LDP + colbase + g * 64 + d;
  }
};


#define XCD_TILE_LOOP(idx, MT, NT)                                                                     \
  const bool sw_ = (gridDim.x & 7) == 0;                                                               \
  const int xcd_ = blockIdx.x & 7;                                                                     \
  const int tstart_ = sw_ ? (int)(blockIdx.x >> 3) : (int)blockIdx.x;                                  \
  const int tstep_ = sw_ ? (int)(gridDim.x >> 3) : (int)gridDim.x;                                     \
  const int ttotal_ = sw_ ? ((MT) / 8) * (NT) : (MT) * (NT);                                           \
  _Pragma("unroll 1") for (int idx = tstart_; idx < ttotal_; idx += tstep_)
#define XCD_TILE_MT(idx, NT) (sw_ ? ((idx) / (NT)) * 8 + xcd_ : (idx) / (NT))
#define XCD_TILE_NT(idx, NT) ((idx) % (NT))

#define GEMM_LANE_VARS                                                    \
  const int tid = launder(threadIdx.x), lane = tid & 63, w = tid >> 6;    \
  const int wm = w >> 1, wn = w & 1, col = lane & 15, quad = lane >> 4;   \
  (void)wm; (void)wn; (void)col; (void)quad;

DEVI void phase1(const Params& p, unsigned char* smem) {
  u16* sA = (u16*)smem; u16* sB = sA + 128 * 72;
  XCD_TILE_LOOP(idx, 256 + 32, 19) {
    GEMM_LANE_VARS
    f32x4 acc[4][4];
    int mt, nt_;
    if (sw_) {
      const int g_ = idx / 152, r_ = idx - g_ * 152, gs_ = (g_ < 4) ? 8 : 4;
      nt_ = r_ / gs_;
      mt = (g_ * 8 + (r_ - nt_ * gs_)) * 8 + xcd_;
    } else {
      mt = idx / 19; nt_ = idx % 19;
    }
    if (mt < 256) {
      const int m0 = mt * 128, n0 = nt_ * 128;
      gemm_mainloop<true>(tid, sA, sB, ARow{p.hn, LDA}, p.winT, LDA, m0, n0, 16, acc);
#pragma unroll
      for (int mi = 0; mi < 4; ++mi) {
        const int m = m0 + wm * 64 + 16 * mi + col;
        const int b = m >> 11, t = m & 2047;
#pragma unroll
        for (int ni = 0; ni < 4; ++ni) {
          const int nt = n0 + wn * 64 + 16 * ni;
          const int n = nt + 4 * quad;
          f32x4 v = acc[ni][mi];
          if (nt >= LDP) continue;
          if ((nt >= C_VS && nt < C_KW) || (nt >= C_VW && nt < C_GATE)) {
            const bool isw = nt >= C_VW;
            const int off = n - (isw ? C_VW : C_VS);
            const int g = off >> 6, d = off & 63;
            u16* dst = (isw ? p.vtw : p.vts) + ((size_t)(b * 2 + g) * 64 + d) * LDT + t;
#pragma unroll
            for (int r = 0; r < 4; ++r) dst[(size_t)r * LDT] = f2bf(v[r]);
          } else {
            const bool rope_tile = ((nt >= C_KS && nt < C_VS) || (nt >= C_KW && nt < C_VW)) && ((nt & 63) == 0);
            if (rope_tile) {
#pragma unroll
              for (int r = 0; r < 4; ++r) {
                const float pr = __shfl_xor(v[r], 32);
                const int i = ((quad & 1) << 2) + r;
                const float cs = p.rope[(size_t)m * 16 + i], sn = p.rope[(size_t)m * 16 + 8 + i];
                v[r] = (quad < 2) ? (v[r] * cs - pr * sn) : (v[r] * cs + pr * sn);
              }
            }
            uint2 pk; pk.x = pack2(v[0], v[1]); pk.y = pack2(v[2], v[3]);
            *(uint2*)(p.proj + (size_t)m * LDP + n) = pk;
          }
        }
      }
    } else if (nt_ < 16) {
      const int isv = nt_ >> 3;
      const int m0 = (mt - 256) * 128, n0 = (nt_ & 7) * 128;
      gemm_mainloop<true>(tid, sA, sB, ARow{p.memn, LDA}, isv ? p.wmvT : p.wmkT, LDA, m0, n0, 16, acc);
#pragma unroll
      for (int mi = 0; mi < 4; ++mi) {
        const int m = m0 + wm * 64 + 16 * mi + col;
        const int b = m >> 8, key = m & 255;
#pragma unroll
        for (int ni = 0; ni < 4; ++ni) {
          const int n = n0 + wn * 64 + 16 * ni + 4 * quad;
          const f32x4 v = acc[ni][mi];
          if (isv) {
            const int head = n >> 8, d = n & 255;
            u16* dst = p.memvt + ((size_t)(b * 4 + head) * 256 + d) * 256 + key;
#pragma unroll
            for (int r = 0; r < 4; ++r) dst[r * 256] = f2bf(v[r]);
          } else {
            uint2 pk; pk.x = pack2(v[0], v[1]); pk.y = pack2(v[2], v[3]);
            *(uint2*)(p.memk + (size_t)m * LDA + n) = pk;
          }
        }
      }
    }
  }
}

DEVI void conv_tile(const Params& p, unsigned char* smem, int ct) {
  u16* sU = (u16*)smem;
  float2* sRed = (float2*)(smem + 62 * 512 * 2);
  const int tid = launder(threadIdx.x), lane = tid & 63, w = tid >> 6;
  const int b = ct >> 6, t0 = (ct & 63) * 32;
  __syncthreads();
  for (int it = tid; it < 62 * 64; it += 256) {
    const int r = it >> 6, c8 = it & 63;
    const int t = t0 - 30 + r;
    uint4 pk = {0u, 0u, 0u, 0u};
    if (t >= 0) {
      const u16* src = p.proj + ((size_t)b * T + t) * LDP + c8 * 8;
      const uint4 a = *(const uint4*)src, bb = *(const uint4*)(src + 512);
      const unsigned au[4] = {a.x, a.y, a.z, a.w}, bu[4] = {bb.x, bb.y, bb.z, bb.w};
      unsigned o[4];
#pragma unroll
      for (int j = 0; j < 4; ++j) {
        const float a0 = __uint_as_float(au[j] << 16), a1 = __uint_as_float(au[j] & 0xffff0000u);
        const float b0 = __uint_as_float(bu[j] << 16), b1 = __uint_as_float(bu[j] & 0xffff0000u);
        o[j] = pack2(a0 * sigmoidf_(b0), a1 * sigmoidf_(b1));
      }
      pk.x = o[0]; pk.y = o[1]; pk.z = o[2]; pk.w = o[3];
    }
    *(uint4*)(sU + r * 512 + c8 * 8) = pk;
  }
  const int c = 2 * tid;
  float w0[31], w1[31];
#pragma unroll
  for (int j = 0; j < 31; ++j) { w0[j] = p.conv_w[j * 512 + c]; w1[j] = p.conv_w[j * 512 + c + 1]; }
  const float bd0 = p.conv_b[c], bd1 = p.conv_b[c + 1];
  __syncthreads();
  float ya[32], yb[32];
#pragma unroll
  for (int tt = 0; tt < 32; ++tt) {
    float y0 = bd0, y1 = bd1;
#pragma unroll
    for (int j = 0; j < 31; ++j) {
      const unsigned uu = *(const unsigned*)(sU + (tt + j) * 512 + c);
      y0 += w0[j] * __uint_as_float(uu << 16);
      y1 += w1[j] * __uint_as_float(uu & 0xffff0000u);
    }
    ya[tt] = y0; yb[tt] = y1;
    float s = y0 + y1, q = y0 * y0 + y1 * y1;
    s = wave_sum(s); q = wave_sum(q);
    if (lane == 0) sRed[tt * 4 + w] = make_float2(s, q);
  }
  __syncthreads();
  const float g0 = p.ln_g[c], g1 = p.ln_g[c + 1], lb0 = p.ln_b[c], lb1 = p.ln_b[c + 1];
#pragma unroll
  for (int tt = 0; tt < 32; ++tt) {
    const float y0 = ya[tt], y1 = yb[tt];
    const float2 r0 = sRed[tt * 4 + 0], r1 = sRed[tt * 4 + 1], r2 = sRed[tt * 4 + 2], r3 = sRed[tt * 4 + 3];
    const float S = r0.x + r1.x + r2.x + r3.x, Q = r0.y + r1.y + r2.y + r3.y;
    const float mu = S * (1.f / 512.f);
    const float var = fmaxf(Q * (1.f / 512.f) - mu * mu, 0.f);
    const float rstd = rsqrtf(var + 1e-6f);
    const float z0 = (y0 - mu) * rstd * g0 + lb0, z1 = (y1 - mu) * rstd * g1 + lb1;
    const float o0 = z0 * sigmoidf_(z0), o1 = z1 * sigmoidf_(z1);
    *(unsigned*)(p.mix + ((size_t)b * T + t0 + tt) * LDA + c) = pack2(o0, o1);
  }
}

DEVI void compress2_tile(const Params& p, unsigned char* smem, int tile);
DEVI void phase2(const Params& p, unsigned char* smem) {
  u16* sA = (u16*)smem; u16* sB = sA + 128 * 72;
#pragma unroll 1
  for (int tile = blockIdx.x; tile < 64 + 1024; tile += gridDim.x) {
    GEMM_LANE_VARS
    if (tile < 64) {
      const int ty = tile >> 5, mt = tile & 31;
      const int m0 = mt * 128;
      f32x4 acc[4][4];
      gemm_mainloop<true>(tid, sA, sB, ACmp{p.proj, ty ? C_VC : C_KC}, p.w1T + (size_t)ty * 128 * LDW1, LDW1, m0, 0, 32, acc);
#pragma unroll
      for (int mi = 0; mi < 4; ++mi) {
        const int m = m0 + wm * 64 + 16 * mi + col;
#pragma unroll
        for (int ni = 0; ni < 4; ++ni) {
          const int n = wn * 64 + 16 * ni + 4 * quad;
          const f32x4 v = acc[ni][mi];
          const float4 bb = *(const float4*)(p.biasp + ty * 128 + n);
          uint2 pk;
          pk.x = pack2(gelu_tanh(v[0] + bb.x), gelu_tanh(v[1] + bb.y));
          pk.y = pack2(gelu_tanh(v[2] + bb.z), gelu_tanh(v[3] + bb.w));
          *(uint2*)(p.hdn + ((size_t)ty * 4096 + m) * 128 + n) = pk;
        }
      }
      asm volatile("s_waitcnt vmcnt(0)" ::: "memory");
      __syncthreads();
      compress2_tile(p, smem, tile);
    } else {
      conv_tile(p, smem, tile - 64);
    }
  }
}

DEVI void compress2_tile(const Params& p, unsigned char* smem, int tile) {
  u16* sA = (u16*)smem; u16* sB = sA + 128 * 72;
  {
    GEMM_LANE_VARS
    const int ty = tile >> 5, mt = tile & 31;
    const int m0 = mt * 128;
    f32x4 acc[4][4];
    gemm_mainloop<true>(tid, sA, sB, ARow{p.hdn + (size_t)ty * 4096 * 128, 128}, p.w2T + (size_t)ty * 128 * 128, 128, m0, 0, 2, acc);
    if (wn == 0) {
#pragma unroll
      for (int mi = 0; mi < 4; ++mi) {
        const int m = m0 + 16 * mi + wm * 64 + col;
        const int bg = m >> 7, c = m & 127;
#pragma unroll
        for (int ni = 0; ni < 4; ++ni) {
          const int n = 16 * ni + 4 * quad;
          const f32x4 v = acc[ni][mi];
          const float4 bb = *(const float4*)(p.cmp_b2 + ty * 64 + n);
          const float o0 = v[0] + bb.x, o1 = v[1] + bb.y, o2 = v[2] + bb.z, o3 = v[3] + bb.w;
          if (ty == 0) {
            uint2 pk; pk.x = pack2(o0, o1); pk.y = pack2(o2, o3);
            *(uint2*)(p.kc + (size_t)m * 64 + n) = pk;
          } else {
            u16* dst = p.vcT + ((size_t)bg * 64 + n) * 128 + c;
            dst[0] = f2bf(o0); dst[128] = f2bf(o1); dst[256] = f2bf(o2); dst[384] = f2bf(o3);
          }
        }
      }
    }
  }
}

template <int DH, int NQ, int LDK, class MaskF>
DEVI void attn_qk(const u16* sK, const bf16x8 (&qf)[NQ][DH / 32], f32x4 (&o)[NQ][DH / 16], float (&m)[NQ], float (&l)[NQ],
                  float c2, int lane, MaskF valid, bf16x8 (&pb)[NQ][2]) {
  const int col = lane & 15, quad = lane >> 4;
  f32x4 s[NQ][4];
  __builtin_amdgcn_s_setprio(1);
#pragma unroll
  for (int kt = 0; kt < 4; ++kt) {
#pragma unroll
    for (int qt = 0; qt < NQ; ++qt) s[qt][kt] = f32x4{0.f, 0.f, 0.f, 0.f};
#pragma unroll
    for (int ks = 0; ks < DH / 32; ++ks) {
      const bf16x8 kf = *(const bf16x8*)(sK + (16 * kt + col) * LDK + 32 * ks + 8 * quad);
#pragma unroll
      for (int qt = 0; qt < NQ; ++qt) s[qt][kt] = mfma16(kf, qf[qt][ks], s[qt][kt]);
    }
  }
  __builtin_amdgcn_s_setprio(0);
#pragma unroll
  for (int qt = 0; qt < NQ; ++qt) {
    float mx = -1e30f;
#pragma unroll
    for (int kt = 0; kt < 4; ++kt)
#pragma unroll
      for (int r = 0; r < 4; ++r) {
        const bool v = valid(qt, 16 * kt + 4 * quad + r);
        const float sv = v ? s[qt][kt][r] : -1e30f;
        s[qt][kt][r] = sv;
        mx = fmaxf(mx, sv);
      }
    mx = fmaxf(mx, __shfl_xor(mx, 16));
    mx = fmaxf(mx, __shfl_xor(mx, 32));
    const float mn = fmaxf(m[qt], mx);
    const float alpha = fexp2((m[qt] - mn) * c2);
    m[qt] = mn;
    const float mc = fmaxf(mn, -1e20f) * c2;
    float ps = 0.f;
#pragma unroll
    for (int kt = 0; kt < 4; ++kt)
#pragma unroll
      for (int r = 0; r < 4; ++r) {
        const float pv = fexp2(__builtin_fmaf(s[qt][kt][r], c2, -mc));
        ps += pv;
        s[qt][kt][r] = pv;
      }
    l[qt] = l[qt] * alpha + ps;
#pragma unroll
    for (int dt = 0; dt < DH / 16; ++dt) o[qt][dt] *= alpha;
#pragma unroll
    for (int kk = 0; kk < 2; ++kk) {
      union { bf16x8 v; unsigned u[4]; } cv;
      cv.u[0] = pack2(s[qt][2 * kk][0], s[qt][2 * kk][1]);
      cv.u[1] = pack2(s[qt][2 * kk][2], s[qt][2 * kk][3]);
      cv.u[2] = pack2(s[qt][2 * kk + 1][0], s[qt][2 * kk + 1][1]);
      cv.u[3] = pack2(s[qt][2 * kk + 1][2], s[qt][2 * kk + 1][3]);
      pb[qt][kk] = cv.v;
    }
  }
}
template <int DH, int NQ, int LDV>
DEVI void attn_pv(const u16* sVt, const bf16x8 (&pb)[NQ][2], f32x4 (&o)[NQ][DH / 16], int lane) {
  const int col = lane & 15, quad = lane >> 4;
  __builtin_amdgcn_s_setprio(1);
#pragma unroll
  for (int dt = 0; dt < DH / 16; ++dt) {
#pragma unroll
    for (int kk = 0; kk < 2; ++kk) {
      union { bf16x8 v; uint2 h[2]; } cv;
      cv.h[0] = *(const uint2*)(sVt + (16 * dt + col) * LDV + 32 * kk + 4 * quad);
      cv.h[1] = *(const uint2*)(sVt + (16 * dt + col) * LDV + 32 * kk + 16 + 4 * quad);
#pragma unroll
      for (int qt = 0; qt < NQ; ++qt) o[qt][dt] = mfma16(cv.v, pb[qt][kk], o[qt][dt]);
    }
  }
  __builtin_amdgcn_s_setprio(0);
}
template <int DH, int NQ, int LDK, int LDV, class MaskF>
DEVI void attn_tile(const u16* sK, const u16* sVt, const bf16x8 (&qf)[NQ][DH / 32], f32x4 (&o)[NQ][DH / 16],
                    float (&m)[NQ], float (&l)[NQ], float c2, int lane, MaskF valid) {
  bf16x8 pb[NQ][2];
  attn_qk<DH, NQ, LDK>(sK, qf, o, m, l, c2, lane, valid, pb);
  attn_pv<DH, NQ, LDV>(sVt, pb, o, lane);
}

DEVI void phase_nsa(const Params& p, unsigned char* smem) {
  u16* sK = (u16*)smem;
  u16* sVt = (u16*)(smem + 18432);
  float* impH = (float*)(smem + 35840);
  float* impT = (float*)(smem + 52736);
  unsigned* selm = (unsigned*)(smem + 56960);
  const float c2 = 0.125f * 1.4426950408889634f;
#pragma unroll 1
  for (int tile = blockIdx.x; tile < 2048; tile += gridDim.x) {
    const int tid = launder(threadIdx.x), lane = tid & 63, w = tid >> 6, col = lane & 15, quad = lane >> 4;
    const int qtile = 63 - (tile >> 5), bg = tile & 31, b = bg >> 1, g = bg & 1, q0 = qtile * 32;
    const int h = g * 4 + w;
    __syncthreads();
    if (tid < 32) selm[tid] = 0u;
    {
      const u16* kcp = p.kc + (size_t)bg * 128 * 64;
      const u16* vcp = p.vcT + (size_t)bg * 64 * 128;
#pragma unroll
      for (int i = 0; i < 4; ++i) {
        const int c = tid + 256 * i;
        const int row = c >> 3, ch = (c & 7) << 3;
        *(uint4*)(sK + row * 72 + ch) = *(const uint4*)(kcp + row * 64 + ch);
        const int row2 = c >> 4, ch2 = (c & 15) << 3;
        *(uint4*)(sVt + row2 * 136 + ch2) = *(const uint4*)(vcp + row2 * 128 + ch2);
      }
    }
    bf16x8 qf[2][2];
    float gate[2][3];
    int tq[2];
#pragma unroll
    for (int qt = 0; qt < 2; ++qt) {
      const int t = q0 + 16 * qt + col;
      tq[qt] = t;
      const size_t tok = (size_t)b * T + t;
      const u16* qp = p.proj + tok * LDP + C_Q + h * 64 + 8 * quad;
      qf[qt][0] = *(const bf16x8*)qp;
      qf[qt][1] = *(const bf16x8*)(qp + 32);
#pragma unroll
      for (int br = 0; br < 3; ++br) gate[qt][br] = sigmoidf_(bf2f(p.proj[tok * LDP + C_GATE + h * 3 + br]));
    }
    __syncthreads();

    f32x4 comb[2][4];
    {
      const int srcl = (lane + 48) & 63;
#pragma unroll
      for (int qt = 0; qt < 2; ++qt) {
        f32x4 s[8];
#pragma unroll
        for (int kt = 0; kt < 8; ++kt) {
          s[kt] = f32x4{0.f, 0.f, 0.f, 0.f};
#pragma unroll
          for (int ks = 0; ks < 2; ++ks) {
            const bf16x8 kf = *(const bf16x8*)(sK + (16 * kt + col) * 72 + 32 * ks + 8 * quad);
            s[kt] = mfma16(kf, qf[qt][ks], s[kt]);
          }
        }
        const int t = tq[qt];
        float mx = -1e30f;
#pragma unroll
        for (int kt = 0; kt < 8; ++kt)
#pragma unroll
          for (int r = 0; r < 4; ++r) {
            const int c = 16 * kt + 4 * quad + r;
            const bool v = (16 * c + 31) <= t;
            const float sv = v ? s[kt][r] : -1e30f;
            s[kt][r] = sv;
            mx = fmaxf(mx, sv);
          }
        mx = fmaxf(mx, __shfl_xor(mx, 16));
        mx = fmaxf(mx, __shfl_xor(mx, 32));
        float ps = 0.f;
        const float mcc = fmaxf(mx, -1e20f) * c2;
#pragma unroll
        for (int kt = 0; kt < 8; ++kt)
#pragma unroll
          for (int r = 0; r < 4; ++r) {
            const float pv = fexp2(__builtin_fmaf(s[kt][r], c2, -mcc));
            ps += pv;
            s[kt][r] = pv;
          }
        ps += __shfl_xor(ps, 16);
        ps += __shfl_xor(ps, 32);
        const float inv = ps > 0.f ? 1.f / ps : 0.f;
#pragma unroll
        for (int kt = 0; kt < 8; ++kt)
#pragma unroll
          for (int r = 0; r < 4; ++r) s[kt][r] *= inv;
        float prev3 = 0.f;
#pragma unroll
        for (int kt = 0; kt < 8; ++kt) {
          const float sum4 = s[kt][0] + s[kt][1] + s[kt][2] + s[kt][3];
          const float xs = __shfl(s[kt][3], srcl);
          const float extra = quad ? xs : prev3;
          prev3 = xs;
          impH[(w * 32 + 16 * qt + col) * 33 + 4 * kt + quad] = sum4 + extra;
        }
        bf16x8 pb[4];
#pragma unroll
        for (int kk = 0; kk < 4; ++kk) {
          union { bf16x8 v; unsigned u[4]; } cv;
          cv.u[0] = pack2(s[2 * kk][0], s[2 * kk][1]);
          cv.u[1] = pack2(s[2 * kk][2], s[2 * kk][3]);
          cv.u[2] = pack2(s[2 * kk + 1][0], s[2 * kk + 1][1]);
          cv.u[3] = pack2(s[2 * kk + 1][2], s[2 * kk + 1][3]);
          pb[kk] = cv.v;
        }
#pragma unroll
        for (int dt = 0; dt < 4; ++dt) {
          f32x4 oc = f32x4{0.f, 0.f, 0.f, 0.f};
#pragma unroll
          for (int kk = 0; kk < 4; ++kk) {
            union { bf16x8 v; uint2 hh[2]; } cv;
            cv.hh[0] = *(const uint2*)(sVt + (16 * dt + col) * 136 + 32 * kk + 4 * quad);
            cv.hh[1] = *(const uint2*)(sVt + (16 * dt + col) * 136 + 32 * kk + 16 + 4 * quad);
            oc = mfma16(cv.v, pb[kk], oc);
          }
          comb[qt][dt] = oc * gate[qt][0];
        }
      }
    }
#pragma unroll
    for (int qt = 0; qt < 2; ++qt) {
      const size_t tok = (size_t)b * T + tq[qt];
      union { bf16x8 v; unsigned u[4]; } own, par, res;
      own.v = qf[qt][0];
#pragma unroll
      for (int j = 0; j < 4; ++j) par.u[j] = (unsigned)__shfl_xor((int)own.u[j], 16);
      const float4 c0 = *(const float4*)(p.rope + tok * 16), c1 = *(const float4*)(p.rope + tok * 16 + 4);
      const float4 s0 = *(const float4*)(p.rope + tok * 16 + 8), s1 = *(const float4*)(p.rope + tok * 16 + 12);
      const float cs[8] = {c0.x, c0.y, c0.z, c0.w, c1.x, c1.y, c1.z, c1.w};
      const float sn[8] = {s0.x, s0.y, s0.z, s0.w, s1.x, s1.y, s1.z, s1.w};
#pragma unroll
      for (int j = 0; j < 4; ++j) {
        const float o0 = __uint_as_float(own.u[j] << 16), o1 = __uint_as_float(own.u[j] & 0xffff0000u);
        const float p0 = __uint_as_float(par.u[j] << 16), p1 = __uint_as_float(par.u[j] & 0xffff0000u);
        const float sg = (quad == 0) ? -1.f : 1.f;
        const float r0 = o0 * cs[2 * j] + sg * p0 * sn[2 * j];
        const float r1 = o1 * cs[2 * j + 1] + sg * p1 * sn[2 * j + 1];
        res.u[j] = (quad < 2) ? pack2(r0, r1) : own.u[j];
      }
      qf[qt][0] = res.v;
    }
    __syncthreads();
#pragma unroll
    for (int i = 0; i < 4; ++i) {
      const int cell = tid + 256 * i;
      const int qi = cell >> 5, s_ = cell & 31;
      const int cur = (q0 + qi) >> 6;
      float v = impH[(0 * 32 + qi) * 33 + s_] + impH[(1 * 32 + qi) * 33 + s_] + impH[(2 * 32 + qi) * 33 + s_] +
                impH[(3 * 32 + qi) * 33 + s_];
      const int dist = cur - s_;
      const bool forced = (s_ == 0) || (dist >= 0 && dist < 2);
      v = forced ? 1e9f : (s_ <= cur ? v : -1.f);
      impT[qi * 33 + s_] = v;
    }
    __syncthreads();
    {
      const int qi = tid >> 3, sub = tid & 7;
      unsigned bits = 0u;
#pragma unroll
      for (int k = 0; k < 4; ++k) {
        const int s_ = sub * 4 + k;
        const float v = impT[qi * 33 + s_];
        int rank = 0;
        for (int s2 = 0; s2 < 32; ++s2) {
          const float v2 = impT[qi * 33 + s2];
          rank += ((v2 > v) || (v2 == v && s2 < s_)) ? 1 : 0;
        }
        if (rank < 16) bits |= 1u << s_;
      }
      atomicOr(&selm[qi], bits);
    }
    __syncthreads();
    unsigned sm[2] = {selm[col], selm[16 + col]};
    unsigned uni = 0u;
#pragma unroll
    for (int i = 0; i < 32; ++i) uni |= selm[i];
    const int kbmax = (q0 + 31) >> 6;
    {
      float m[2] = {-1e30f, -1e30f}, l[2] = {0.f, 0.f};
      f32x4 o[2][4];
#pragma unroll
      for (int qt = 0; qt < 2; ++qt)
#pragma unroll
        for (int dt = 0; dt < 4; ++dt) o[qt][dt] = f32x4{0.f, 0.f, 0.f, 0.f};
      unsigned rem = (kbmax >= 31) ? uni : (uni & ((1u << (kbmax + 1)) - 1u));
      int kb = rem ? (__ffs((int)rem) - 1) : -1;
      uint4 rk0, rk1, rv0, rv1;
      const int lr0 = tid >> 3, lch = (tid & 7) << 3;
#define LOADKV_(kbx, CK, VT)                                                                                         \
      rk0 = *(const uint4*)(p.proj + ((size_t)b * T + (kbx) * 64 + lr0) * LDP + (CK) + g * 64 + lch);                 \
      rk1 = *(const uint4*)(p.proj + ((size_t)b * T + (kbx) * 64 + lr0 + 32) * LDP + (CK) + g * 64 + lch);            \
      rv0 = *(const uint4*)((VT) + ((size_t)bg * 64 + lr0) * LDT + (kbx) * 64 + lch);                                 \
      rv1 = *(const uint4*)((VT) + ((size_t)bg * 64 + lr0 + 32) * LDT + (kbx) * 64 + lch);
#define STOREKV_()                                                                                                   \
      *(uint4*)(sK + lr0 * 72 + lch) = rk0; *(uint4*)(sK + (lr0 + 32) * 72 + lch) = rk1;                              \
      *(uint4*)(sVt + lr0 * 72 + lch) = rv0; *(uint4*)(sVt + (lr0 + 32) * 72 + lch) = rv1;
      if (kb >= 0) { LOADKV_(kb, C_KS, p.vts) }
#pragma unroll 1
      while (kb >= 0) {
        rem &= rem - 1u;
        const int nkb = rem ? (__ffs((int)rem) - 1) : -1;
        __syncthreads();
        STOREKV_()
        if (nkb >= 0) { LOADKV_(nkb, C_KS, p.vts) }
        __syncthreads();
        const int lim0 = ((sm[0] >> kb) & 1u) ? tq[0] : -1, lim1 = ((sm[1] >> kb) & 1u) ? tq[1] : -1;
        attn_tile<64, 2, 72, 72>(sK, sVt, qf, o, m, l, c2, lane, [&](int qt, int kl) {
          return (kb * 64 + kl) <= (qt ? lim1 : lim0);
        });
        kb = nkb;
      }
#pragma unroll
      for (int qt = 0; qt < 2; ++qt) {
        float lt = l[qt];
        lt += __shfl_xor(lt, 16);
        lt += __shfl_xor(lt, 32);
        const float sc = lt > 0.f ? gate[qt][1] / lt : 0.f;
#pragma unroll
        for (int dt = 0; dt < 4; ++dt) comb[qt][dt] += o[qt][dt] * sc;
      }
    }
    {
      float m[2] = {-1e30f, -1e30f}, l[2] = {0.f, 0.f};
      f32x4 o[2][4];
#pragma unroll
      for (int qt = 0; qt < 2; ++qt)
#pragma unroll
        for (int dt = 0; dt < 4; ++dt) o[qt][dt] = f32x4{0.f, 0.f, 0.f, 0.f};
      const int kblo = (q0 >= 511) ? ((q0 - 511) >> 6) : 0;
      uint4 rk0, rk1, rv0, rv1;
      const int lr0 = tid >> 3, lch = (tid & 7) << 3;
      int kb = kblo;
      LOADKV_(kb, C_KW, p.vtw)
#pragma unroll 1
      while (kb >= 0) {
        const int nkb = (kb < kbmax) ? kb + 1 : -1;
        __syncthreads();
        STOREKV_()
        if (nkb >= 0) { LOADKV_(nkb, C_KW, p.vtw) }
        __syncthreads();
        attn_tile<64, 2, 72, 72>(sK, sVt, qf, o, m, l, c2, lane, [&](int qt, int kl) {
          return (unsigned)(tq[qt] - (kb * 64 + kl)) < 512u;
        });
        kb = nkb;
      }
#undef LOADKV_
#undef STOREKV_
#pragma unroll
      for (int qt = 0; qt < 2; ++qt) {
        float lt = l[qt];
        lt += __shfl_xor(lt, 16);
        lt += __shfl_xor(lt, 32);
        const float sc = lt > 0.f ? gate[qt][2] / lt : 0.f;
#pragma unroll
        for (int dt = 0; dt < 4; ++dt) comb[qt][dt] += o[qt][dt] * sc;
      }
    }
#pragma unroll
    for (int qt = 0; qt < 2; ++qt) {
      const size_t tok = (size_t)b * T + tq[qt];
#pragma unroll
      for (int dt = 0; dt < 4; ++dt) {
        uint2 pk;
        pk.x = pack2(comb[qt][dt][0], comb[qt][dt][1]);
        pk.y = pack2(comb[qt][dt][2], comb[qt][dt][3]);
        *(uint2*)(p.mix + tok * LDA + 512 + h * 64 + 16 * dt + 4 * quad) = pk;
      }
    }
  }
}

template <bool RESB>
DEVI void phase_resid(const Params& p, unsigned char* smem, const u16* A, const u16* Wt, const float* res, float* ssq) {
  u16* sA = (u16*)smem; u16* sB = sA + 128 * 72;
  XCD_TILE_LOOP(idx, 256, 8) {
    GEMM_LANE_VARS
    const int mt = XCD_TILE_MT(idx, 8), nt_ = XCD_TILE_NT(idx, 8);
    const int m0 = mt * 128, n0 = nt_ * 128;
    f32x4 acc[4][4];
    gemm_mainloop<true>(tid, sA, sB, ARow{A, LDA}, Wt, LDA, m0, n0, 16, acc);
#pragma unroll
    for (int mi = 0; mi < 4; ++mi) {
      const int m = m0 + wm * 64 + 16 * mi + col;
      float ss = 0.f;
#pragma unroll
      for (int ni = 0; ni < 4; ++ni) {
        const int n = n0 + wn * 64 + 16 * ni + 4 * quad;
        const f32x4 v = acc[ni][mi];
        float4 r;
        if (RESB) {
          const uint2 rb = *(const uint2*)(p.hn + (size_t)m * LDA + n);
          r.x = __uint_as_float(rb.x << 16); r.y = __uint_as_float(rb.x & 0xffff0000u);
          r.z = __uint_as_float(rb.y << 16); r.w = __uint_as_float(rb.y & 0xffff0000u);
        } else {
          r = *(const float4*)(res + (size_t)m * D + n);
        }
        float4 hv;
        hv.x = r.x + v[0]; hv.y = r.y + v[1]; hv.z = r.z + v[2]; hv.w = r.w + v[3];
        ss += hv.x * hv.x + hv.y * hv.y + hv.z * hv.z + hv.w * hv.w;
        uint2 pk; pk.x = pack2(hv.x, hv.y); pk.y = pack2(hv.z, hv.w);
        *(uint2*)(p.hn + (size_t)m * LDA + n) = pk;
      }
      ss += __shfl_xor(ss, 16);
      ss += __shfl_xor(ss, 32);
      if (quad == 0) atomicAdd(ssq + m, ss);
    }
  }
}

DEVI void phase_scaled(const Params& p, unsigned char* smem, const u16* A, const u16* Wt, int ntn, const float* ssq, u16* outp, int ldo) {
  u16* sA = (u16*)smem; u16* sB = sA + 128 * 72;
  XCD_TILE_LOOP(idx, 256, ntn) {
    GEMM_LANE_VARS
    const int mt = XCD_TILE_MT(idx, ntn), nt_ = XCD_TILE_NT(idx, ntn);
    const int m0 = mt * 128, n0 = nt_ * 128;
    f32x4 acc[4][4];
    gemm_mainloop<true>(tid, sA, sB, ARow{A, LDA}, Wt, LDA, m0, n0, 16, acc);
#pragma unroll
    for (int mi = 0; mi < 4; ++mi) {
      const int m = m0 + wm * 64 + 16 * mi + col;
      const float rstd = rsqrtf(ssq[m] * (1.f / D) + 1e-6f);
#pragma unroll
      for (int ni = 0; ni < 4; ++ni) {
        const int n = n0 + wn * 64 + 16 * ni + 4 * quad;
        const f32x4 v = acc[ni][mi];
        uint2 pk; pk.x = pack2(v[0] * rstd, v[1] * rstd); pk.y = pack2(v[2] * rstd, v[3] * rstd);
        *(uint2*)(outp + (size_t)m * ldo + n) = pk;
      }
    }
  }
}

DEVI void phase_memattn(const Params& p, unsigned char* smem) {
  u16* sK = (u16*)smem;
  u16* sVt = (u16*)(smem + 33792);
  const float c2 = 0.0625f * 1.4426950408889634f;
#pragma unroll 1
  for (int tile = blockIdx.x; tile < 2048; tile += gridDim.x) {
    const int tid = launder(threadIdx.x), lane = tid & 63, w = tid >> 6, col = lane & 15, quad = lane >> 4;
    const int b = tile >> 7, head = (tile >> 5) & 3, q0 = (tile & 31) * 64;
    const size_t tok = (size_t)b * T + q0 + 16 * w + col;
    bf16x8 qf[1][8];
#pragma unroll
    for (int ks = 0; ks < 8; ++ks) qf[0][ks] = *(const bf16x8*)(p.qm + tok * LDA + head * 256 + 32 * ks + 8 * quad);
    float m[1] = {-1e30f}, l[1] = {0.f};
    f32x4 o[1][16];
#pragma unroll
    for (int dt = 0; dt < 16; ++dt) o[0][dt] = f32x4{0.f, 0.f, 0.f, 0.f};
    uint4 rg0, rg1, rg2, rg3, rg4, rg5, rg6, rg7;
    const int krow = tid >> 5, kch = (tid & 31) << 3;
    const int vrow = tid >> 3, vch = (tid & 7) << 3;
#define LK1_(i, kbx) rg##i = *(const uint4*)(p.memk + ((size_t)b * 256 + (kbx) * 64 + krow + 8 * i) * LDA + head * 256 + kch);
#define SK1_(i) *(uint4*)(sK + (krow + 8 * i) * 264 + kch) = rg##i;
#define LV1_(i, kbx) rg##i = *(const uint4*)(p.memvt + ((size_t)(b * 4 + head) * 256 + vrow + 32 * i) * 256 + (kbx) * 64 + vch);
#define SV1_(i) *(uint4*)(sVt + (vrow + 32 * i) * 72 + vch) = rg##i;
#define LOADK_(kbx) LK1_(0, kbx) LK1_(1, kbx) LK1_(2, kbx) LK1_(3, kbx) LK1_(4, kbx) LK1_(5, kbx) LK1_(6, kbx) LK1_(7, kbx)
#define STOREK_() SK1_(0) SK1_(1) SK1_(2) SK1_(3) SK1_(4) SK1_(5) SK1_(6) SK1_(7)
#define LOADV_(kbx) LV1_(0, kbx) LV1_(1, kbx) LV1_(2, kbx) LV1_(3, kbx) LV1_(4, kbx) LV1_(5, kbx) LV1_(6, kbx) LV1_(7, kbx)
#define STOREV_() SV1_(0) SV1_(1) SV1_(2) SV1_(3) SV1_(4) SV1_(5) SV1_(6) SV1_(7)
    __syncthreads();
    LOADK_(0)
    STOREK_()
    LOADV_(0)
    __syncthreads();
#pragma unroll 1
    for (int kb = 0; kb < 4; ++kb) {
      bf16x8 pb[1][2];
      attn_qk<256, 1, 264>(sK, qf, o, m, l, c2, lane, [&](int, int) { return true; }, pb);
      STOREV_()
      if (kb < 3) { LOADK_(kb + 1) }
      __syncthreads();
      attn_pv<256, 1, 72>(sVt, pb, o, lane);
      if (kb < 3) {
        STOREK_()
        LOADV_(kb + 1)
      }
      __syncthreads();
    }
#undef LOADK_
#undef STOREK_
#undef LOADV_
#undef STOREV_
#undef LK1_
#undef SK1_
#undef LV1_
#undef SV1_
    float lt = l[0];
    lt += __shfl_xor(lt, 16);
    lt += __shfl_xor(lt, 32);
    const float inv = 1.f / lt;
#pragma unroll
    for (int dt = 0; dt < 16; ++dt) {
      uint2 pk;
      pk.x = pack2(o[0][dt][0] * inv, o[0][dt][1] * inv);
      pk.y = pack2(o[0][dt][2] * inv, o[0][dt][3] * inv);
      *(uint2*)(p.mix + tok * LDA + head * 256 + 16 * dt + 4 * quad) = pk;
    }
  }
}

__constant__ unsigned char kCandI[64] = {0,0,0,0,0,0,0,0,0,0,0,0,0,0,0,0, 1,1,1,1,1,1,1,1, 2,2,2,2,2, 3,3,3,3, 4,4,4, 5,5, 6,6, 7,7,
                                          8, 9, 10, 11, 12, 13, 14, 15, 0,0,0,0,0,0,0,0,0,0,0,0,0,0};
__constant__ unsigned char kCandJ[64] = {0,1,2,3,4,5,6,7,8,9,10,11,12,13,14,15, 0,1,2,3,4,5,6,7, 0,1,2,3,4, 0,1,2,3, 0,1,2, 0,1, 0,1, 0,1,
                                          0, 0, 0, 0, 0, 0, 0, 0, 0,0,0,0,0,0,0,0,0,0,0,0,0,0};

DEVI unsigned score_key(float v, int idx) {
  unsigned u = __float_as_uint(v);
  u = (u & 0x80000000u) ? ~u : (u | 0x80000000u);
  return (u & ~127u) | (unsigned)(127 - idx);
}
DEVI float key_score(unsigned k) {
  k &= ~127u;
  const unsigned u = (k & 0x80000000u) ? (k & 0x7fffffffu) : ~k;
  return __uint_as_float(u);
}

DEVI void phase_peer_route(const Params& p, unsigned char* smem) {
  u16* sA = (u16*)smem; u16* sB = sA + 128 * 72;
  unsigned* sScore = (unsigned*)smem;
  unsigned* sTop = (unsigned*)(smem + 36864);
  unsigned* sTmp = (unsigned*)(smem + 53248);
  {
    const int t0_ = launder(threadIdx.x);
    const int gw = (blockIdx.x * 256 + t0_) >> 6, nw = (gridDim.x * 256) >> 6;
    conv_fp8_rows(p.peer_u, p.ub8, p.uscale, 16384, gw, nw, t0_ & 63);
    conv_fp8_rows(p.peer_v, p.vb8, p.vscale, 16384, gw, nw, t0_ & 63);
  }
#pragma unroll 1
  for (int tile = blockIdx.x; tile < 256 * 8; tile += gridDim.x) {
    GEMM_LANE_VARS
    const int mt = tile >> 3, hd = tile & 7;
    const int m0 = mt * 128;
#pragma unroll 1
    for (int ph = 0; ph < 2; ++ph) {
      const int hp = hd * 2 + ph;
      f32x4 acc[4][4];
      __syncthreads();
      gemm_mainloop<false>(tid, sA, sB, ARow{p.pq + hp * 128, LDPQ}, p.subk + (size_t)hp * 128 * 128, 128, m0, 0, 2, acc);
#pragma unroll 1
      for (int hh = 0; hh < 2; ++hh) {
        if (wm == hh) {
#pragma unroll
          for (int mi = 0; mi < 4; ++mi) {
            const int row = 16 * mi + col;
#pragma unroll
            for (int ni = 0; ni < 4; ++ni) {
              const int n = wn * 64 + 16 * ni + 4 * quad;
              const f32x4 v = acc[ni][mi];
              uint4 kk;
              kk.x = score_key(v[0], n); kk.y = score_key(v[1], n + 1);
              kk.z = score_key(v[2], n + 2); kk.w = score_key(v[3], n + 3);
              *(uint4*)(sScore + row * 132 + n) = kk;
            }
          }
        }
        __syncthreads();
#pragma unroll 1
        for (int rg = 0; rg < 4; ++rg) {
          const int rbase = w * 16 + rg * 4;
          unsigned k0[4], k1[4], t0[4], t1[4], thr[4];
#pragma unroll
          for (int r = 0; r < 4; ++r) {
            k0[r] = sScore[(rbase + r) * 132 + lane];
            k1[r] = sScore[(rbase + r) * 132 + 64 + lane];
            t0[r] = ((k0[r] >> 16) << 7) | (k0[r] & 127u);
            t1[r] = ((k1[r] >> 16) << 7) | (k1[r] & 127u);
            thr[r] = 0u;
          }
#pragma unroll
          for (int bit = 22; bit >= 0; --bit) {
#pragma unroll
            for (int r = 0; r < 4; ++r) {
              const unsigned cand = thr[r] | (1u << bit);
              const int cnt = __popcll(__ballot(t0[r] >= cand)) + __popcll(__ballot(t1[r] >= cand));
              thr[r] = (cnt >= 16) ? cand : thr[r];
            }
          }
          unsigned* tmp = sTmp + w * 64;
#pragma unroll
          for (int r = 0; r < 4; ++r) {
            const unsigned long long b0 = __ballot(t0[r] >= thr[r]), b1 = __ballot(t1[r] >= thr[r]);
            const int pos0 = __builtin_amdgcn_mbcnt_hi((unsigned)(b0 >> 32), __builtin_amdgcn_mbcnt_lo((unsigned)b0, 0u));
            const int pos1 = __popcll(b0) + __builtin_amdgcn_mbcnt_hi((unsigned)(b1 >> 32), __builtin_amdgcn_mbcnt_lo((unsigned)b1, 0u));
            if (t0[r] >= thr[r]) tmp[r * 16 + pos0] = k0[r];
            if (t1[r] >= thr[r]) tmp[r * 16 + pos1] = k1[r];
          }
          __builtin_amdgcn_fence(__ATOMIC_RELEASE, "wavefront");
          __builtin_amdgcn_wave_barrier();
          __builtin_amdgcn_fence(__ATOMIC_ACQUIRE, "wavefront");
          {
            const int r = lane >> 4, ix = lane & 15;
            const unsigned mine = tmp[r * 16 + ix];
            const uint4 a = *(const uint4*)(tmp + r * 16), b = *(const uint4*)(tmp + r * 16 + 4), c = *(const uint4*)(tmp + r * 16 + 8),
                        d = *(const uint4*)(tmp + r * 16 + 12);
            const int rk = (a.x > mine) + (a.y > mine) + (a.z > mine) + (a.w > mine) + (b.x > mine) + (b.y > mine) + (b.z > mine) + (b.w > mine) +
                           (c.x > mine) + (c.y > mine) + (c.z > mine) + (c.w > mine) + (d.x > mine) + (d.y > mine) + (d.z > mine) + (d.w > mine);
            sTop[((hh * 64 + rbase + r) * 2 + ph) * 16 + rk] = mine;
          }
          __builtin_amdgcn_fence(__ATOMIC_RELEASE, "wavefront");
          __builtin_amdgcn_wave_barrier();
        }
        __syncthreads();
      }
    }
    const int ci = kCandI[lane], cj = kCandJ[lane];
    const bool act = lane < 50;
#pragma unroll 1
    for (int tg = 0; tg < 8; ++tg) {
      const int tb = w * 32 + tg * 4;
      unsigned k0[4], k1[4], ku[4], thr[4];
      float v[4];
#pragma unroll
      for (int r = 0; r < 4; ++r) {
        k0[r] = sTop[((tb + r) * 2 + 0) * 16 + ci];
        k1[r] = sTop[((tb + r) * 2 + 1) * 16 + cj];
        v[r] = key_score(k0[r]) + key_score(k1[r]);
        unsigned u = __float_as_uint(v[r]);
        u = (u & 0x80000000u) ? ~u : (u | 0x80000000u);
        ku[r] = act ? (((u >> 16) << 6) | (unsigned)(63 - lane)) : 0u;
        thr[r] = 0u;
      }
#pragma unroll
      for (int bit = 21; bit >= 0; --bit) {
#pragma unroll
        for (int r = 0; r < 4; ++r) {
          const unsigned cand = thr[r] | (1u << bit);
          const int cnt = __popcll(__ballot(ku[r] >= cand));
          thr[r] = (cnt >= 16) ? cand : thr[r];
        }
      }
#pragma unroll
      for (int r = 0; r < 4; ++r) {
        const bool sel = act && (ku[r] >= thr[r]);
        const unsigned long long ms = __ballot(sel);
        const int slot = __builtin_amdgcn_mbcnt_hi((unsigned)(ms >> 32), __builtin_amdgcn_mbcnt_lo((unsigned)ms, 0u));
        const float vmax = __int_as_float(__builtin_amdgcn_readlane(__float_as_int(v[r]), 0));
        const float e = sel ? __expf(v[r] - vmax) : 0.f;
        const float tot = wave_sum(e);
        if (sel) {
          const int eid = (127 - (int)(k0[r] & 127u)) * 128 + (127 - (int)(k1[r] & 127u));
          const size_t o = (size_t)(m0 + tb + r) * 128 + hd * 16 + slot;
          p.experts[o] = eid;
          p.gates[o] = e / tot;
        }
      }
    }
  }
}

template <int PART>
DEVI void phase_peer_gather(const Params& p, unsigned char* smem) {
  const int w0_ = threadIdx.x >> 6;
#pragma unroll 1
  for (int tok = blockIdx.x * 4 + w0_; tok < NTOK; tok += gridDim.x * 4) {
    if (NTOK % (gridDim.x * 4) == 0) __syncthreads();
    const int tid = launder(threadIdx.x), lane = tid & 63;
    const uint4* hp4 = (const uint4*)(p.hn + (size_t)tok * LDA + lane * 16);
    float hv[16], xn[16], y[16];
    {
      const uint4 a0 = hp4[0], a1 = hp4[1];
      const unsigned hu[8] = {a0.x, a0.y, a0.z, a0.w, a1.x, a1.y, a1.z, a1.w};
#pragma unroll
      for (int i = 0; i < 8; ++i) { hv[2 * i] = __uint_as_float(hu[i] << 16); hv[2 * i + 1] = __uint_as_float(hu[i] & 0xffff0000u); }
    }
    float ss = 0.f;
#pragma unroll
    for (int i = 0; i < 16; ++i) ss += hv[i] * hv[i];
    ss = wave_sum(ss);
    const float rstd = rsqrtf(ss * (1.f / D) + 1e-6f);
    {
      const float4* g4 = (const float4*)p.peer_g + lane * 4;
      const float4 a0 = g4[0], a1 = g4[1], a2 = g4[2], a3 = g4[3];
      const float gg[16] = {a0.x, a0.y, a0.z, a0.w, a1.x, a1.y, a1.z, a1.w, a2.x, a2.y, a2.z, a2.w, a3.x, a3.y, a3.z, a3.w};
#pragma unroll
      for (int i = 0; i < 16; ++i) { xn[i] = hv[i] * rstd * gg[i]; y[i] = 0.f; }
    }
    int e0 = p.experts[(size_t)tok * 128 + lane], e1 = p.experts[(size_t)tok * 128 + 64 + lane];
    float g0 = p.gates[(size_t)tok * 128 + lane], g1 = p.gates[(size_t)tok * 128 + 64 + lane];
    if (PART == 0) {
      int* sE = (int*)(smem + (tid >> 6) * 1024);
      float* sG = (float*)(sE + 128);
      int pos0 = 0, pos1 = 0, base = 0;
      const int flip_ = (((tok - (blockIdx.x * 4 + w0_)) / (int)(gridDim.x * 4)) & 1) ? 15 : 0;
      const int q0_ = (e0 >> 10) ^ flip_, q1_ = (e1 >> 10) ^ flip_;
#pragma unroll
      for (int q = 0; q < 16; ++q) {
        const unsigned long long m0 = __ballot(q0_ == q), m1 = __ballot(q1_ == q);
        const int c0 = __popcll(m0);
        const int i0 = __builtin_amdgcn_mbcnt_hi((unsigned)(m0 >> 32), __builtin_amdgcn_mbcnt_lo((unsigned)m0, 0u));
        const int i1 = __builtin_amdgcn_mbcnt_hi((unsigned)(m1 >> 32), __builtin_amdgcn_mbcnt_lo((unsigned)m1, 0u));
        if (q0_ == q) pos0 = base + i0;
        if (q1_ == q) pos1 = base + c0 + i1;
        base += c0 + __popcll(m1);
      }
      __builtin_amdgcn_fence(__ATOMIC_RELEASE, "wavefront");
      __builtin_amdgcn_wave_barrier();
      sE[pos0] = e0; sG[pos0] = g0;
      sE[pos1] = e1; sG[pos1] = g1;
      __builtin_amdgcn_fence(__ATOMIC_RELEASE, "wavefront");
      __builtin_amdgcn_wave_barrier();
      __builtin_amdgcn_fence(__ATOMIC_ACQUIRE, "wavefront");
      e0 = sE[lane]; e1 = sE[64 + lane];
      g0 = sG[lane]; g1 = sG[64 + lane];
      p.experts[(size_t)tok * 128 + lane] = e0;
      p.experts[(size_t)tok * 128 + 64 + lane] = e1;
    }
    const float su0 = p.uscale[e0], su1 = p.uscale[e1];
    const float sv0 = p.vscale[e0], sv1 = p.vscale[e1];
    float cf0 = 0.f, cf1 = 0.f, dsum = 0.f;
    uint4 ca[8], cb[8];
#define LOADB_(R, bi)                                                                                   \
    _Pragma("unroll") for (int u = 0; u < 8; ++u) {                                                       \
      const int kk_ = (((bi) & 7) << 3) + u;                                                             \
      const int e_ = __builtin_amdgcn_readlane((((bi) >> 3) & 1) ? e1 : e0, kk_);                        \
      R[u] = ((const uint4*)((((bi) >> 4) ? p.vb8 : p.ub8) + (size_t)e_ * 1024))[lane];                  \
    }
#define COMPU_(R, bi)                                                                                   \
    {                                                                                                    \
      float d8[8];                                                                                       \
      _Pragma("unroll") for (int u = 0; u < 8; ++u) {                                                     \
        const unsigned uu[4] = {R[u].x, R[u].y, R[u].z, R[u].w};                                         \
        f32x2 a2 = {0.f, 0.f};                                                                           \
        _Pragma("unroll") for (int j = 0; j < 4; ++j) {                                                   \
          const f32x2 lo = __builtin_amdgcn_cvt_pk_f32_fp8((int)uu[j], false);                           \
          const f32x2 hi = __builtin_amdgcn_cvt_pk_f32_fp8((int)uu[j], true);                            \
          a2 = xn2[2 * j] * lo + a2;                                                                     \
          a2 = xn2[2 * j + 1] * hi + a2;                                                                 \
        }                                                                                                \
        d8[u] = a2[0] + a2[1];                                                                           \
      }                                                                                                  \
          \
      float v4[4], v2[2];                                                                                \
      _Pragma("unroll") for (int i = 0; i < 4; ++i) {                                                     \
        const float snd = b5 ? d8[i] : d8[4 + i], kp = b5 ? d8[4 + i] : d8[i];                           \
        v4[i] = kp + __shfl_xor(snd, 32);                                                                \
      }                                                                                                  \
      _Pragma("unroll") for (int i = 0; i < 2; ++i) {                                                     \
        const float snd = b4 ? v4[i] : v4[2 + i], kp = b4 ? v4[2 + i] : v4[i];                           \
        v2[i] = kp + __shfl_xor(snd, 16);                                                                \
      }                                                                                                  \
      float v1;                                                                                          \
      { const float snd = b3 ? v2[0] : v2[1], kp = b3 ? v2[1] : v2[0]; v1 = kp + __shfl_xor(snd, 8); }   \
      v1 += __shfl_xor(v1, 4);                                                                           \
      v1 += __shfl_xor(v1, 2);                                                                           \
      v1 += __shfl_xor(v1, 1);                                                                           \
                \
      const float got = __shfl(v1, fsrc);                                                                \
      if ((lane >> 3) == ((bi) & 7)) dsum = got;                                                         \
    }                                                                                                    \
    if (((bi) & 7) == 7) {                                                                               \
      if (((bi) >> 3) & 1) cf1 = gelu_tanh(dsum * su1) * g1 * sv1; else cf0 = gelu_tanh(dsum * su0) * g0 * sv0; \
    }
#define COMPV_(R, bi)                                                                                   \
    _Pragma("unroll") for (int u = 0; u < 8; ++u) {                                                       \
      const int kk_ = (((bi) & 7) << 3) + u;                                                             \
      const float ck_ = __int_as_float(__builtin_amdgcn_readlane(__float_as_int((((bi) >> 3) & 1) ? cf1 : cf0), kk_)); \
      const f32x2 ck2 = {ck_, ck_};                                                                      \
      const unsigned uu[4] = {R[u].x, R[u].y, R[u].z, R[u].w};                                           \
      _Pragma("unroll") for (int j = 0; j < 4; ++j) {                                                     \
        const f32x2 lo = __builtin_amdgcn_cvt_pk_f32_fp8((int)uu[j], false);                             \
        const f32x2 hi = __builtin_amdgcn_cvt_pk_f32_fp8((int)uu[j], true);                              \
        y2[2 * j] = ck2 * lo + y2[2 * j];                                                                \
        y2[2 * j + 1] = ck2 * hi + y2[2 * j + 1];                                                        \
      }                                                                                                  \
    }
    const bool b5 = (lane & 32) != 0, b4 = (lane & 16) != 0, b3 = (lane & 8) != 0;
    const int fsrc = ((lane & 4) << 3) | ((lane & 2) << 3) | ((lane & 1) << 3);
    f32x2 xn2[8], y2[8];
#pragma unroll
    for (int i = 0; i < 8; ++i) { xn2[i] = f32x2{xn[2 * i], xn[2 * i + 1]}; y2[i] = f32x2{0.f, 0.f}; }
    if (PART == 0) {
      LOADB_(ca, 0)
#pragma unroll 1
      for (int bi = 0; bi < 16; bi += 2) {
        LOADB_(cb, bi + 1)
        COMPU_(ca, bi)
        if (bi + 2 < 16) { LOADB_(ca, bi + 2) }
        COMPU_(cb, bi + 1)
      }
      p.gates[(size_t)tok * 128 + lane] = cf0;
      p.gates[(size_t)tok * 128 + 64 + lane] = cf1;
      continue;
    }
    cf0 = g0; cf1 = g1;
    LOADB_(ca, 16)
#pragma unroll 1
    for (int bi = 16; bi < 32; bi += 2) {
      LOADB_(cb, bi + 1)
      COMPV_(ca, bi)
      if (bi + 2 < 32) { LOADB_(ca, bi + 2) }
      COMPV_(cb, bi + 1)
    }
#undef LOADB_
#undef COMPU_
#undef COMPV_
#pragma unroll
    for (int i = 0; i < 8; ++i) { y[2 * i] = y2[i][0]; y[2 * i + 1] = y2[i][1]; }
    float s2 = 0.f;
    {
      const uint4 a0 = hp4[0], a1 = hp4[1];
      const unsigned hu[8] = {a0.x, a0.y, a0.z, a0.w, a1.x, a1.y, a1.z, a1.w};
#pragma unroll
      for (int i = 0; i < 8; ++i) {
        y[2 * i] += __uint_as_float(hu[i] << 16);
        y[2 * i + 1] += __uint_as_float(hu[i] & 0xffff0000u);
        s2 += y[2 * i] * y[2 * i] + y[2 * i + 1] * y[2 * i + 1];
      }
    }
    s2 = wave_sum(s2);
    const float rs2 = rsqrtf(s2 * (1.f / D) + 1e-6f);
    {
      const float4* g4 = (const float4*)p.final_g + lane * 4;
      const float4 a0 = g4[0], a1 = g4[1], a2 = g4[2], a3 = g4[3];
      float4* o4 = (float4*)(p.out + (size_t)tok * D) + lane * 4;
      o4[0] = make_float4(y[0] * rs2 * a0.x, y[1] * rs2 * a0.y, y[2] * rs2 * a0.z, y[3] * rs2 * a0.w);
      o4[1] = make_float4(y[4] * rs2 * a1.x, y[5] * rs2 * a1.y, y[6] * rs2 * a1.z, y[7] * rs2 * a1.w);
      o4[2] = make_float4(y[8] * rs2 * a2.x, y[9] * rs2 * a2.y, y[10] * rs2 * a2.z, y[11] * rs2 * a2.w);
      o4[3] = make_float4(y[12] * rs2 * a3.x, y[13] * rs2 * a3.y, y[14] * rs2 * a3.z, y[15] * rs2 * a3.w);
    }
  }
}

#define XB_TMO      128
#define XB_XCNT(j)  (256  + 64 * (j))
#define XB_XSUB(j)  (1280 + 64 * (j))
#define XB_XGEN(j)  (2304 + 64 * (j))
#define XB_TOP      3328
#define XB_TOPGEN   3392
#define XCD_BAR_WORDS 3456
#define XB_SPIN_CAP (1u << 20)
#define LAS __attribute__((address_space(3)))
DEVI unsigned xb_ld(unsigned* q) { return __hip_atomic_load(q, __ATOMIC_RELAXED, __HIP_MEMORY_SCOPE_AGENT); }
DEVI unsigned xb_add(unsigned* q, unsigned v) { return __hip_atomic_fetch_add(q, v, __ATOMIC_RELAXED, __HIP_MEMORY_SCOPE_AGENT); }
DEVI unsigned xb_xcc_id() { return (unsigned)__builtin_amdgcn_s_getreg((3 << 11) | 20) & 0xFu; }
#define XB_SPIN(cond, bar) do { unsigned _sp = 0; while (cond) { __builtin_amdgcn_s_sleep(1); \
    if ((++_sp & 255u) == 0u) { if (xb_ld(&(bar)[XB_TMO])) break; if (_sp > XB_SPIN_CAP) { atomicAdd(&(bar)[XB_TMO], 1u); break; } } } } while (0)
struct XcdBarrier { unsigned* bar; unsigned x; volatile LAS unsigned* st; };
DEVI XcdBarrier xcd_barrier_post(unsigned* bar, volatile LAS unsigned* st) {
  XcdBarrier b; b.bar = bar; b.x = xb_xcc_id(); b.st = st;
  if (threadIdx.x == 0) (void)xb_add(&bar[XB_XCNT(b.x)], 1u);
  return b;
}
DEVI void xcd_barrier_complete(unsigned* bar, unsigned x, unsigned& nloc, unsigned& nx) {
  const unsigned G = gridDim.x * gridDim.y * gridDim.z;
  unsigned sum, cnt, mine, sp = 0u;
  for (;;) {
    sum = 0u; cnt = 0u; mine = 0u;
#pragma unroll
    for (unsigned j = 0; j < 16; ++j) { const unsigned c = xb_ld(&bar[XB_XCNT(j)]); sum += c; cnt += (c > 0u) ? 1u : 0u; mine = (j == x) ? c : mine; }
    if (sum == G) break;
    __builtin_amdgcn_s_sleep(1);
    if ((++sp & 255u) == 0u) { if (xb_ld(&bar[XB_TMO])) break; if (sp > XB_SPIN_CAP) { atomicAdd(&bar[XB_TMO], 1u); break; } }
  }
  nloc = mine > 0u ? mine : 1u; nx = cnt > 0u ? cnt : 1u;
}
DEVI void xcd_barrier(const XcdBarrier& b) {
  asm volatile("s_waitcnt vmcnt(0)" ::: "memory");
  __syncthreads();
  if (threadIdx.x == 0) {
    unsigned* bar = b.bar;
    __builtin_amdgcn_s_waitcnt(0);
    unsigned nloc = b.st[0], nx = b.st[1];
    if (nloc == 0u) { xcd_barrier_complete(bar, b.x, nloc, nx); b.st[0] = nloc; b.st[1] = nx; }
    const unsigned old = xb_add(&bar[XB_XSUB(b.x)], 1u);
    const unsigned gen = old / nloc;
    if (old + 1u == (gen + 1u) * nloc) {
      __builtin_amdgcn_fence(__ATOMIC_RELEASE, "agent");
      asm volatile("s_waitcnt vmcnt(0)" ::: "memory");
      const unsigned og = xb_add(&bar[XB_TOP], 1u);
      const unsigned tg = og / nx;
      if (og + 1u == (tg + 1u) * nx) xb_add(&bar[XB_TOPGEN], 1u);
      else XB_SPIN(xb_ld(&bar[XB_TOPGEN]) == tg, bar);
      __builtin_amdgcn_fence(__ATOMIC_ACQUIRE, "agent");
      xb_add(&bar[XB_XGEN(b.x)], 1u);
      asm volatile("s_waitcnt vmcnt(0)" ::: "memory");
    } else {
      XB_SPIN(xb_ld(&bar[XB_XGEN(b.x)]) == gen, bar);
      __builtin_amdgcn_fence(__ATOMIC_ACQUIRE, "agent");
      asm volatile("s_waitcnt vmcnt(0)" ::: "memory");
    }
  }
  __syncthreads();
}

template <bool COOP>
__global__ void __launch_bounds__(256, 2) mega(Params p, int ph_lo, int ph_hi) {
  __shared__ __attribute__((aligned(16))) unsigned char smem[SMEM_BYTES];
  __shared__ uint4 xb_words;
  if (threadIdx.x == 0) xb_words = make_uint4(0u, 0u, 0u, 0u);
  __syncthreads();
  XcdBarrier xb = xcd_barrier_post(p.bar, (volatile LAS unsigned*)&xb_words);
  (void)xb;
  if (COOP && ph_hi > 1000) cg::this_grid().sync();
#ifdef REPEAT_MASK
#define RUN_PHASE(i, call)                                                                   \
  if (ph_lo <= (i) && (i) <= ph_hi) {                                                        \
    call;                                                                                    \
    if (COOP && ((REPEAT_MASK >> (i)) & 1)) { xcd_barrier(xb); call; }                       \
    if (COOP && (i) < ph_hi) xcd_barrier(xb);                                                \
  }
#else
#define RUN_PHASE(i, call)                                                                   \
  if (ph_lo <= (i) && (i) <= ph_hi) {                                                        \
    call;                                                                                    \
    if (COOP && (i) < ph_hi) {                                                               \
      xcd_barrier(xb);                                                                       \
    }                                                                                        \
  }
#endif
  RUN_PHASE(0, phase0(p))
  RUN_PHASE(1, phase1(p, smem))
  RUN_PHASE(2, phase2(p, smem))
  RUN_PHASE(4, phase_nsa(p, smem))
  RUN_PHASE(5, phase_resid<false>(p, smem, p.mix, p.woutT, p.x, p.ssq1))
  RUN_PHASE(6, phase_scaled(p, smem, p.hn, p.wmqT, 8, p.ssq1, p.qm, LDA))
  RUN_PHASE(7, phase_memattn(p, smem))
  RUN_PHASE(8, phase_resid<true>(p, smem, p.mix, p.wmoT, nullptr, p.ssq2))
  RUN_PHASE(9, phase_scaled(p, smem, p.hn, p.wpqT, 16, p.ssq2, p.pq, LDPQ))
  RUN_PHASE(10, phase_peer_route(p, smem))
  RUN_PHASE(11, phase_peer_gather<0>(p, smem))
  RUN_PHASE(12, phase_peer_gather<1>(p, smem))
#undef RUN_PHASE
}

extern "C" void kernel_launch(void* const* d_in, const int* in_sizes, int n_in, void* d_out, int out_size, void* d_ws,
                              size_t ws_size, hipStream_t stream) {
  (void)in_sizes; (void)n_in; (void)out_size; (void)ws_size;
  Params p{};
  p.x = (const float*)d_in[0]; p.mem = (const float*)d_in[1]; p.pos = (const int*)d_in[2];
  p.mix_g = (const float*)d_in[3]; p.w_in = (const float*)d_in[4]; p.conv_w = (const float*)d_in[5];
  p.conv_b = (const float*)d_in[6]; p.ln_g = (const float*)d_in[7]; p.ln_b = (const float*)d_in[8];
  p.cmp_pos = (const float*)d_in[9]; p.cmp_w1 = (const float*)d_in[10]; p.cmp_b1 = (const float*)d_in[11];
  p.cmp_w2 = (const float*)d_in[12]; p.cmp_b2 = (const float*)d_in[13]; p.w_out = (const float*)d_in[14];
  p.memq_g = (const float*)d_in[15]; p.memkv_g = (const float*)d_in[16]; p.w_mq = (const float*)d_in[17];
  p.w_mk = (const float*)d_in[18]; p.w_mv = (const float*)d_in[19]; p.w_mo = (const float*)d_in[20];
  p.peer_g = (const float*)d_in[21]; p.peer_wq = (const float*)d_in[22]; p.peer_sk = (const float*)d_in[23];
  p.peer_u = (const float*)d_in[24]; p.peer_v = (const float*)d_in[25]; p.final_g = (const float*)d_in[26];
  p.out = (float*)d_out;
  unsigned char* ws = (unsigned char*)d_ws;
  size_t off = 0;
  auto take = [&](size_t bytes) { unsigned char* r = ws + off; off += (bytes + 255) & ~(size_t)255; return r; };
  unsigned char* regA = take((size_t)NTOK * LDA * 2);
  unsigned char* regB = take((size_t)NTOK * LDP * 2);
  unsigned char* regC = take((size_t)NTOK * LDA * 2);
  p.hn = (u16*)regA;
  p.proj = (u16*)regB; p.qm = (u16*)regB; p.pq = (u16*)regB;
  p.mix = (u16*)regC; p.experts = (int*)regC; p.gates = (float*)(regC + (size_t)NTOK * 128 * 4);
  {
    unsigned char* tb = regC + (size_t)2 * NTOK * 128 * 4;
    p.ub8 = tb; p.vb8 = tb + (size_t)16384 * 1024;
    p.uscale = (float*)(tb + (size_t)2 * 16384 * 1024); p.vscale = p.uscale + 16384;
  }
  p.h = nullptr;
  p.vts = (u16*)take((size_t)Bn * 2 * 64 * LDT * 2);
  p.vtw = (u16*)take((size_t)Bn * 2 * 64 * LDT * 2);
  p.memn = (u16*)take((size_t)Bn * 256 * LDA * 2);
  p.memk = (u16*)take((size_t)Bn * 256 * LDA * 2);
  p.memvt = (u16*)take((size_t)Bn * 256 * D * 2);
  p.winT = (u16*)take((size_t)2432 * LDA * 2);
  p.woutT = (u16*)take((size_t)1024 * LDA * 2);
  p.wmqT = (u16*)take((size_t)1024 * LDA * 2);
  p.wmkT = (u16*)take((size_t)1024 * LDA * 2);
  p.wmvT = (u16*)take((size_t)1024 * LDA * 2);
  p.wmoT = (u16*)take((size_t)1024 * LDA * 2);
  p.wpqT = (u16*)take((size_t)2048 * LDA * 2);
  p.subk = (u16*)take((size_t)16 * 128 * 128 * 2);
  p.w1T = (u16*)take((size_t)2 * 128 * LDW1 * 2);
  p.w2T = (u16*)take((size_t)2 * 128 * 128 * 2);
  p.biasp = (float*)take(256 * 4);
  p.rope = (float*)take((size_t)NTOK * 16 * 4);
  p.hdn = (u16*)take((size_t)2 * 4096 * 128 * 2);
  p.kc = (u16*)take((size_t)Bn * 2 * 128 * 64 * 2);
  p.vcT = (u16*)take((size_t)Bn * 2 * 64 * 128 * 2);
  p.ssq1 = (float*)take((size_t)NTOK * 4);
  p.ssq2 = (float*)take((size_t)NTOK * 4);
  p.bar = (unsigned*)take(16384);
  if (off > ws_size) { fprintf(stderr, "workspace too small: need %zu have %zu\n", off, ws_size); return; }

#if COOP_MODE
  static int grid_blocks = 0;
  if (!grid_blocks) {
    int dev = 0, cus = 0, per_cu = 0;
    hipGetDevice(&dev);
    hipDeviceGetAttribute(&cus, hipDeviceAttributeMultiprocessorCount, dev);
    hipOccupancyMaxActiveBlocksPerMultiprocessor(&per_cu, mega<true>, 256, 0);
    if (per_cu > 2) per_cu = 2;
    if (per_cu < 1) per_cu = 1;
    grid_blocks = cus * per_cu;
  }
  int lo = 0, hi = NPHASE;
  void* args[] = {&p, &lo, &hi};
  (void)hipMemsetAsync(p.bar, 0, 16384, stream);
  hipError_t e = hipLaunchCooperativeKernel((void*)mega<true>, dim3(grid_blocks), dim3(256), args, 0, stream);
  if (e != hipSuccess) fprintf(stderr, "cooperative launch failed: %s (grid %d)\n", hipGetErrorString(e), grid_blocks);
#else
  for (int ph = 0; ph <= NPHASE; ++ph) mega<false><<<dim3(512), dim3(256), 0, stream>>>(p, ph, ph);
#endif
}
```

```cpp
#include <hip/hip_runtime.h>
#include <hip/hip_bf16.h>
#include <hip/hip_cooperative_groups.h>
#include <cstdio>
#include <cstdint>
namespace cg = cooperative_groups;

#ifndef COOP_MODE
#define COOP_MODE 1
#endif

typedef __attribute__((ext_vector_type(8))) short bf16x8;
typedef __attribute__((ext_vector_type(4))) short bf16x4;
typedef __attribute__((ext_vector_type(4))) float f32x4;
typedef unsigned short u16;

#define DEVI __device__ __forceinline__

constexpr int Bn = 16, T = 2048, D = 1024, NTOK = Bn * T, LDP = 2336;
constexpr int C_Q = 1024, C_KC = 1536, C_VC = 1664, C_KS = 1792, C_VS = 1920, C_KW = 2048, C_VW = 2176, C_GATE = 2304;
constexpr int SMEM_BYTES = 73728;
constexpr int LDA = 1088;
constexpr int LDHF = 1056;
constexpr int LDPQ = 2112;
constexpr int LDW1 = 2112;
constexpr int LDT = 2112;
constexpr int NPHASE = 12;

struct Params {
  const float* x; const float* mem; const int* pos; const float* mix_g; const float* w_in;
  const float* conv_w; const float* conv_b; const float* ln_g; const float* ln_b;
  const float* cmp_pos; const float* cmp_w1; const float* cmp_b1; const float* cmp_w2; const float* cmp_b2;
  const float* w_out; const float* memq_g; const float* memkv_g; const float* w_mq; const float* w_mk;
  const float* w_mv; const float* w_mo; const float* peer_g; const float* peer_wq; const float* peer_sk;
  const float* peer_u; const float* peer_v; const float* final_g;
  float* out;
  u16* hn; u16* proj; u16* mix; float* h; u16* vts; u16* vtw; u16* memn; u16* memk; u16* memvt;
  u16* winT; u16* woutT; u16* wmqT; u16* wmkT; u16* wmvT; u16* wmoT; u16* wpqT; u16* subk; u16* w1T; u16* w2T;
  float* biasp; float* rope; u16* hdn; u16* kc; u16* vcT; float* ssq1; float* ssq2;
  int* experts; float* gates; unsigned char* ub8; unsigned char* vb8; float* uscale; float* vscale; u16* qm; u16* pq;
  unsigned* bar;
};

DEVI int launder(int x) { asm volatile("" : "+v"(x)); return x; }
DEVI u16 f2bf(float f) {
  unsigned u = __float_as_uint(f);
  u += 0x7fffu + ((u >> 16) & 1u);
  return (u16)(u >> 16);
}
DEVI float bf2f(u16 h) { return __uint_as_float(((unsigned)h) << 16); }
DEVI unsigned pack2(float a, float b) { return (unsigned)f2bf(a) | ((unsigned)f2bf(b) << 16); }
DEVI float wave_sum(float v) {
#pragma unroll
  for (int o = 32; o; o >>= 1) v += __shfl_xor(v, o);
  return v;
}
DEVI float sigmoidf_(float x) { return 1.f / (1.f + __expf(-x)); }
DEVI float gelu_tanh(float x) {
  float u = 0.7978845608028654f * (x + 0.044715f * x * x * x);
  return 0.5f * x * (1.f + tanhf(u));
}
DEVI f32x4 mfma16(bf16x8 a, bf16x8 b, f32x4 c) { return __builtin_amdgcn_mfma_f32_16x16x32_bf16(a, b, c, 0, 0, 0); }
DEVI float fexp2(float x) { return __builtin_amdgcn_exp2f(x); }

DEVI void tconv(const float* __restrict__ src, int K, int N, u16* __restrict__ dst, int Npad, int ldd,
                const float* __restrict__ gain, int gtid, int gsz) {
  const int items = Npad * (K >> 3);
  for (int it = gtid; it < items; it += gsz) {
    const int n = it % Npad, kc = it / Npad;
    float f[8];
#pragma unroll
    for (int j = 0; j < 8; ++j) {
      float v = 0.f;
      if (n < N) {
        v = src[(size_t)(kc * 8 + j) * N + n];
        if (gain) v *= gain[kc * 8 + j];
      }
      f[j] = v;
    }
    uint4 pk;
    pk.x = pack2(f[0], f[1]); pk.y = pack2(f[2], f[3]); pk.z = pack2(f[4], f[5]); pk.w = pack2(f[6], f[7]);
    *(uint4*)(dst + (size_t)n * ldd + kc * 8) = pk;
  }
}

DEVI void conv_flat(const float* __restrict__ src, u16* __restrict__ dst, size_t n8, size_t gtid, size_t gsz) {
  for (size_t it = gtid; it < n8; it += gsz) {
    const float4 a = ((const float4*)src)[2 * it], b = ((const float4*)src)[2 * it + 1];
    uint4 pk;
    pk.x = pack2(a.x, a.y); pk.y = pack2(a.z, a.w); pk.z = pack2(b.x, b.y); pk.w = pack2(b.z, b.w);
    ((uint4*)dst)[it] = pk;
  }
}


typedef float f32x2 __attribute__((ext_vector_type(2)));
DEVI unsigned pk4_fp8(float a, float b, float c, float d) {
  int v = 0;
  v = __builtin_amdgcn_cvt_pk_fp8_f32(a, b, v, false);
  v = __builtin_amdgcn_cvt_pk_fp8_f32(c, d, v, true);
  return (unsigned)v;
}
DEVI void conv_fp8_rows(const float* __restrict__ src, unsigned char* __restrict__ dst, float* __restrict__ inv_scale,
                        int rows, int gw, int nw, int lane) {
  for (int r0 = gw; r0 < rows; r0 += 2 * nw) {
    const int r1 = r0 + nw;
    const bool has1 = r1 < rows;
    const float4* p0 = (const float4*)(src + (size_t)r0 * 1024) + lane * 4;
    const float4* p1 = (const float4*)(src + (size_t)(has1 ? r1 : r0) * 1024) + lane * 4;
    float4 v[2][4];
#pragma unroll
    for (int i = 0; i < 4; ++i) { v[0][i] = p0[i]; v[1][i] = p1[i]; }
    float mx[2];
#pragma unroll
    for (int q = 0; q < 2; ++q) {
      float m = 0.f;
#pragma unroll
      for (int i = 0; i < 4; ++i)
        m = fmaxf(m, fmaxf(fmaxf(fabsf(v[q][i].x), fabsf(v[q][i].y)), fmaxf(fabsf(v[q][i].z), fabsf(v[q][i].w))));
      mx[q] = m;
    }
#pragma unroll
    for (int o = 32; o; o >>= 1) { mx[0] = fmaxf(mx[0], __shfl_xor(mx[0], o)); mx[1] = fmaxf(mx[1], __shfl_xor(mx[1], o)); }
#pragma unroll
    for (int q = 0; q < 2; ++q) {
      if (q == 1 && !has1) break;
      const int r = q ? r1 : r0;
      const float sc = mx[q] > 0.f ? 224.f / mx[q] : 1.f;
      if (lane == 0) inv_scale[r] = mx[q] > 0.f ? mx[q] * (1.f / 224.f) : 1.f;
      uint4 o4;
      o4.x = pk4_fp8(v[q][0].x * sc, v[q][0].y * sc, v[q][0].z * sc, v[q][0].w * sc);
      o4.y = pk4_fp8(v[q][1].x * sc, v[q][1].y * sc, v[q][1].z * sc, v[q][1].w * sc);
      o4.z = pk4_fp8(v[q][2].x * sc, v[q][2].y * sc, v[q][2].z * sc, v[q][2].w * sc);
      o4.w = pk4_fp8(v[q][3].x * sc, v[q][3].y * sc, v[q][3].z * sc, v[q][3].w * sc);
      ((uint4*)(dst + (size_t)r * 1024))[lane] = o4;
    }
  }
}

DEVI void rownorm_bf16(const float* __restrict__ src, const float* __restrict__ g, u16* __restrict__ dst,
                       int rows, int gw, int nw, int lane) {
  for (int r0 = gw; r0 < rows; r0 += 2 * nw) {
    const int r1 = r0 + nw;
    const bool has1 = r1 < rows;
    const float4* pa = (const float4*)(src + (size_t)r0 * D);
    const float4* pb = (const float4*)(src + (size_t)(has1 ? r1 : r0) * D);
    float4 va[4], vb[4];
    float sa = 0.f, sb = 0.f;
#pragma unroll
    for (int i = 0; i < 4; ++i) { va[i] = pa[lane + 64 * i]; vb[i] = pb[lane + 64 * i]; }
#pragma unroll
    for (int i = 0; i < 4; ++i) {
      sa += va[i].x * va[i].x + va[i].y * va[i].y + va[i].z * va[i].z + va[i].w * va[i].w;
      sb += vb[i].x * vb[i].x + vb[i].y * vb[i].y + vb[i].z * vb[i].z + vb[i].w * vb[i].w;
    }
#pragma unroll
    for (int o = 32; o; o >>= 1) { sa += __shfl_xor(sa, o); sb += __shfl_xor(sb, o); }
    const float ra = rsqrtf(sa * (1.f / D) + 1e-6f), rb = rsqrtf(sb * (1.f / D) + 1e-6f);
#pragma unroll
    for (int i = 0; i < 4; ++i) {
      const float4 gg = ((const float4*)g)[lane + 64 * i];
      uint2 pk;
      pk.x = pack2(va[i].x * ra * gg.x, va[i].y * ra * gg.y);
      pk.y = pack2(va[i].z * ra * gg.z, va[i].w * ra * gg.w);
      *(uint2*)(dst + (size_t)r0 * LDA + (size_t)(lane + 64 * i) * 4) = pk;
      if (has1) {
        pk.x = pack2(vb[i].x * rb * gg.x, vb[i].y * rb * gg.y);
        pk.y = pack2(vb[i].z * rb * gg.z, vb[i].w * rb * gg.w);
        *(uint2*)(dst + (size_t)r1 * LDA + (size_t)(lane + 64 * i) * 4) = pk;
      }
    }
  }
}

DEVI void phase0(const Params& p) {
  const int tid = launder(threadIdx.x), lane = tid & 63;
  const int gtid = blockIdx.x * 256 + tid, gsz = gridDim.x * 256;
  const int gw = gtid >> 6, nw = gsz >> 6;
  rownorm_bf16(p.x, p.mix_g, p.hn, NTOK, gw, nw, lane);
  rownorm_bf16(p.mem, p.memkv_g, p.memn, Bn * 256, gw, nw, lane);
  tconv(p.w_in, 1024, 2328, p.winT, 2432, LDA, nullptr, gtid, gsz);
  tconv(p.w_out, 1024, 1024, p.woutT, 1024, LDA, nullptr, gtid, gsz);
  tconv(p.w_mq, 1024, 1024, p.wmqT, 1024, LDA, p.memq_g, gtid, gsz);
  tconv(p.w_mk, 1024, 1024, p.wmkT, 1024, LDA, nullptr, gtid, gsz);
  tconv(p.w_mv, 1024, 1024, p.wmvT, 1024, LDA, nullptr, gtid, gsz);
  tconv(p.w_mo, 1024, 1024, p.wmoT, 1024, LDA, nullptr, gtid, gsz);
  tconv(p.peer_wq, 1024, 2048, p.wpqT, 2048, LDA, p.peer_g, gtid, gsz);
  tconv(p.cmp_w1, 2048, 128, p.w1T, 128, LDW1, nullptr, gtid, gsz);
  tconv(p.cmp_w1 + 2048 * 128, 2048, 128, p.w1T + 128 * LDW1, 128, LDW1, nullptr, gtid, gsz);
  tconv(p.cmp_w2, 128, 64, p.w2T, 128, 128, nullptr, gtid, gsz);
  tconv(p.cmp_w2 + 128 * 64, 128, 64, p.w2T + 128 * 128, 128, 128, nullptr, gtid, gsz);
  conv_flat(p.peer_sk, p.subk, (size_t)16 * 128 * 128 / 8, gtid, gsz);
  for (int it = gtid; it < NTOK * 8; it += gsz) {
    const int tok = it >> 3, i = it & 7;
    const float inv = (i == 0) ? 1.000000000e+00f : (i == 1) ? 1.939227432e-01f : (i == 2) ? 3.760603070e-02f : (i == 3) ? 7.292664610e-03f : (i == 4) ? 1.414213562e-03f : (i == 5) ? 2.742481884e-04f : (i == 6) ? 5.318295734e-05f : 1.031338525e-05f;
    const float ang = (float)p.pos[tok] * inv;
    float sv, cv;
    sincosf(ang, &sv, &cv);
    p.rope[tok * 16 + i] = cv;
    p.rope[tok * 16 + 8 + i] = sv;
  }
  for (int o = gw; o < 256; o += nw) {
    const int ty = o >> 7, n = o & 127;
    float s = 0.f;
#pragma unroll 8
    for (int k = lane; k < 2048; k += 64)
      s += p.cmp_pos[ty * 2048 + k] * p.cmp_w1[((size_t)ty * 2048 + k) * 128 + n];
    s = wave_sum(s);
    if (lane == 0) p.biasp[o] = s + p.cmp_b1[o];
  }
  for (int it = gtid; it < NTOK; it += gsz) { p.ssq1[it] = 0.f; p.ssq2[it] = 0.f; }
}

template <bool DB, class AF>
DEVI void gemm_mainloop(int tid, u16* sA, u16* sB, AF af, const u16* __restrict__ Bt, int ldb, int m0, int n0, int nk,
                        f32x4 (&acc)[4][4]) {
  const int lane = tid & 63, w = tid >> 6;
  const int wm = w >> 1, wn = w & 1, col = lane & 15, quad = lane >> 4;
#pragma unroll
  for (int i = 0; i < 4; ++i)
#pragma unroll
    for (int j = 0; j < 4; ++j) acc[i][j] = f32x4{0.f, 0.f, 0.f, 0.f};
  uint4 ra0, ra1, ra2, ra3, rb0, rb1, rb2, rb3;
  const int lrow = tid >> 3, lkc = (tid & 7) << 3;
  const u16* bbase = Bt + (size_t)(n0 + lrow) * ldb + lkc;
#define GL_(R, i, kk)                                                     \
  R##a##i = *(const uint4*)af(m0 + lrow + 32 * i, (kk) + lkc);            \
  R##b##i = *(const uint4*)(bbase + (size_t)(32 * i) * ldb + (kk));
#define SS_(R, i, off)                                                    \
  *(uint4*)(sA + (off) + (lrow + 32 * i) * 72 + lkc) = R##a##i;           \
  *(uint4*)(sB + (off) + (lrow + 32 * i) * 72 + lkc) = R##b##i;
#define GL4_(R, kk) GL_(R, 0, kk) GL_(R, 1, kk) GL_(R, 2, kk) GL_(R, 3, kk)
#define SS4_(R, off) SS_(R, 0, off) SS_(R, 1, off) SS_(R, 2, off) SS_(R, 3, off)
#define COMPUTE_(cur)                                                                                                   \
  _Pragma("unroll") for (int ks = 0; ks < 2; ++ks) {                                                                    \
    bf16x8 fa[4], fb[4];                                                                                                \
    _Pragma("unroll") for (int mi = 0; mi < 4; ++mi)                                                                    \
      fa[mi] = *(const bf16x8*)(sA + (cur) + (wm * 64 + 16 * mi + col) * 72 + 32 * ks + 8 * quad);                      \
    _Pragma("unroll") for (int ni = 0; ni < 4; ++ni)                                                                    \
      fb[ni] = *(const bf16x8*)(sB + (cur) + (wn * 64 + 16 * ni + col) * 72 + 32 * ks + 8 * quad);                      \
    _Pragma("unroll") for (int ni = 0; ni < 4; ++ni)                                                                    \
      _Pragma("unroll") for (int mi = 0; mi < 4; ++mi) acc[ni][mi] = mfma16(fb[ni], fa[mi], acc[ni][mi]);               \
  }
  if (DB) {
    const int srow = 8 * w + (lane >> 3);
    const int spc = lane & 7;
#define STAGE_(st, kk)                                                                                         \
    _Pragma("unroll") for (int i = 0; i < 4; ++i) {                                                            \
      const int r_ = 32 * i + srow;                                                                            \
      const int c_ = (spc ^ ((r_ >> 1) & 7)) << 3;                                                             \
      __builtin_amdgcn_global_load_lds((const unsigned*)af(m0 + r_, (kk) + c_),                                \
                                       (unsigned*)(sA + (st) * 16384 + (32 * i + 8 * w) * 64), 16, 0, 0);      \
      __builtin_amdgcn_global_load_lds((const unsigned*)(Bt + (size_t)(n0 + r_) * ldb + (kk) + c_),            \
                                       (unsigned*)(sA + (st) * 16384 + 8192 + (32 * i + 8 * w) * 64), 16, 0, 0); \
    }
#define COMPUTE_SW_(st)                                                                                                 \
  _Pragma("unroll") for (int ks = 0; ks < 2; ++ks) {                                                                    \
    bf16x8 fa[4], fb[4];                                                                                                \
    const int pc_ = ((4 * ks + quad) ^ ((col >> 1) & 7)) << 3;                                                          \
    _Pragma("unroll") for (int mi = 0; mi < 4; ++mi)                                                                    \
      fa[mi] = *(const bf16x8*)(sA + (st) * 16384 + (wm * 64 + 16 * mi + col) * 64 + pc_);                              \
    _Pragma("unroll") for (int ni = 0; ni < 4; ++ni)                                                                    \
      fb[ni] = *(const bf16x8*)(sA + (st) * 16384 + 8192 + (wn * 64 + 16 * ni + col) * 64 + pc_);                       \
    __builtin_amdgcn_s_setprio(1);                                                                                      \
    _Pragma("unroll") for (int ni = 0; ni < 4; ++ni)                                                                    \
      _Pragma("unroll") for (int mi = 0; mi < 4; ++mi) acc[ni][mi] = mfma16(fb[ni], fa[mi], acc[ni][mi]);               \
    __builtin_amdgcn_s_setprio(0);                                                                                      \
  }
    STAGE_(0, 0)
#pragma unroll 1
    for (int kt = 0; kt < nk; kt += 2) {
      asm volatile("s_waitcnt vmcnt(0)" ::: "memory");
      __syncthreads();
      { const int kk = (kt + 1) * 64; STAGE_(1, kk) }
      COMPUTE_SW_(0)
      asm volatile("s_waitcnt vmcnt(0)" ::: "memory");
      __syncthreads();
      if (kt + 2 < nk) { const int kk = (kt + 2) * 64; STAGE_(0, kk) }
      COMPUTE_SW_(1)
    }
#undef STAGE_
#undef COMPUTE_SW_
  } else {
    GL4_(r, 0)
    SS4_(r, 0)
    __syncthreads();
#pragma unroll 1
    for (int kt = 0; kt < nk; ++kt) {
      const bool more = (kt + 1 < nk);
      if (more) { const int kk = (kt + 1) * 64; GL4_(r, kk) }
      COMPUTE_(0)
      __syncthreads();
      if (more) {
        SS4_(r, 0)
        __syncthreads();
      }
    }
  }
#undef GL_
#undef SS_
#undef GL4_
#undef SS4_
#undef COMPUTE_
}

struct ARow {
  const u16* base; int lda;
  DEVI const u16* operator()(int m, int k) const { return base + (size_t)m * lda + k; }
};
struct ACmp {
  const u16* proj; int colbase;
  DEVI const u16* operator()(int rr, int k) const {
    const int b = rr >> 8, g = (rr >> 7) & 1;
    int c = rr & 127; c = c > 126 ? 126 : c;
    const int l = k >> 6, d = k & 63;
    return proj + ((size_t)b * T + 16 * c + l) * LDP + colbase + g * 64 + d;
  }
};


#define XCD_TILE_LOOP(idx, MT, NT)                                                                     \
  const bool sw_ = (gridDim.x & 7) == 0;                                                               \
  const int xcd_ = blockIdx.x & 7;                                                                     \
  const int tstart_ = sw_ ? (int)(blockIdx.x >> 3) : (int)blockIdx.x;                                  \
  const int tstep_ = sw_ ? (int)(gridDim.x >> 3) : (int)gridDim.x;                                     \
  const int ttotal_ = sw_ ? ((MT) / 8) * (NT) : (MT) * (NT);                                           \
  _Pragma("unroll 1") for (int idx = tstart_; idx < ttotal_; idx += tstep_)
#define XCD_TILE_MT(idx, NT) (sw_ ? ((idx) / (NT)) * 8 + xcd_ : (idx) / (NT))
#define XCD_TILE_NT(idx, NT) ((idx) % (NT))

#define GEMM_LANE_VARS                                                    \
  const int tid = launder(threadIdx.x), lane = tid & 63, w = tid >> 6;    \
  const int wm = w >> 1, wn = w & 1, col = lane & 15, quad = lane >> 4;   \
  (void)wm; (void)wn; (void)col; (void)quad;

DEVI void phase1(const Params& p, unsigned char* smem) {
  u16* sA = (u16*)smem; u16* sB = sA + 128 * 72;
  XCD_TILE_LOOP(idx, 256 + 32, 19) {
    GEMM_LANE_VARS
    f32x4 acc[4][4];
    int mt, nt_;
    if (sw_) {
      const int g_ = idx / 152, r_ = idx - g_ * 152, gs_ = (g_ < 4) ? 8 : 4;
      nt_ = r_ / gs_;
      mt = (g_ * 8 + (r_ - nt_ * gs_)) * 8 + xcd_;
    } else {
      mt = idx / 19; nt_ = idx % 19;
    }
    if (mt < 256) {
      const int m0 = mt * 128, n0 = nt_ * 128;
      gemm_mainloop<true>(tid, sA, sB, ARow{p.hn, LDA}, p.winT, LDA, m0, n0, 16, acc);
#pragma unroll
      for (int mi = 0; mi < 4; ++mi) {
        const int m = m0 + wm * 64 + 16 * mi + col;
        const int b = m >> 11, t = m & 2047;
#pragma unroll
        for (int ni = 0; ni < 4; ++ni) {
          const int nt = n0 + wn * 64 + 16 * ni;
          const int n = nt + 4 * quad;
          f32x4 v = acc[ni][mi];
          if (nt >= LDP) continue;
          if ((nt >= C_VS && nt < C_KW) || (nt >= C_VW && nt < C_GATE)) {
            const bool isw = nt >= C_VW;
            const int off = n - (isw ? C_VW : C_VS);
            const int g = off >> 6, d = off & 63;
            u16* dst = (isw ? p.vtw : p.vts) + ((size_t)(b * 2 + g) * 64 + d) * LDT + t;
#pragma unroll
            for (int r = 0; r < 4; ++r) dst[(size_t)r * LDT] = f2bf(v[r]);
          } else {
            const bool rope_tile = ((nt >= C_KS && nt < C_VS) || (nt >= C_KW && nt < C_VW)) && ((nt & 63) == 0);
            if (rope_tile) {
#pragma unroll
              for (int r = 0; r < 4; ++r) {
                const float pr = __shfl_xor(v[r], 32);
                const int i = ((quad & 1) << 2) + r;
                const float cs = p.rope[(size_t)m * 16 + i], sn = p.rope[(size_t)m * 16 + 8 + i];
                v[r] = (quad < 2) ? (v[r] * cs - pr * sn) : (v[r] * cs + pr * sn);
              }
            }
            uint2 pk; pk.x = pack2(v[0], v[1]); pk.y = pack2(v[2], v[3]);
            *(uint2*)(p.proj + (size_t)m * LDP + n) = pk;
          }
        }
      }
    } else if (nt_ < 16) {
      const int isv = nt_ >> 3;
      const int m0 = (mt - 256) * 128, n0 = (nt_ & 7) * 128;
      gemm_mainloop<true>(tid, sA, sB, ARow{p.memn, LDA}, isv ? p.wmvT : p.wmkT, LDA, m0, n0, 16, acc);
#pragma unroll
      for (int mi = 0; mi < 4; ++mi) {
        const int m = m0 + wm * 64 + 16 * mi + col;
        const int b = m >> 8, key = m & 255;
#pragma unroll
        for (int ni = 0; ni < 4; ++ni) {
          const int n = n0 + wn * 64 + 16 * ni + 4 * quad;
          const f32x4 v = acc[ni][mi];
          if (isv) {
            const int head = n >> 8, d = n & 255;
            u16* dst = p.memvt + ((size_t)(b * 4 + head) * 256 + d) * 256 + key;
#pragma unroll
            for (int r = 0; r < 4; ++r) dst[r * 256] = f2bf(v[r]);
          } else {
            uint2 pk; pk.x = pack2(v[0], v[1]); pk.y = pack2(v[2], v[3]);
            *(uint2*)(p.memk + (size_t)m * LDA + n) = pk;
          }
        }
      }
    }
  }
}

DEVI void conv_tile(const Params& p, unsigned char* smem, int ct) {
  u16* sU = (u16*)smem;
  float2* sRed = (float2*)(smem + 62 * 512 * 2);
  const int tid = launder(threadIdx.x), lane = tid & 63, w = tid >> 6;
  const int b = ct >> 6, t0 = (ct & 63) * 32;
  __syncthreads();
  for (int it = tid; it < 62 * 64; it += 256) {
    const int r = it >> 6, c8 = it & 63;
    const int t = t0 - 30 + r;
    uint4 pk = {0u, 0u, 0u, 0u};
    if (t >= 0) {
      const u16* src = p.proj + ((size_t)b * T + t) * LDP + c8 * 8;
      const uint4 a = *(const uint4*)src, bb = *(const uint4*)(src + 512);
      const unsigned au[4] = {a.x, a.y, a.z, a.w}, bu[4] = {bb.x, bb.y, bb.z, bb.w};
      unsigned o[4];
#pragma unroll
      for (int j = 0; j < 4; ++j) {
        const float a0 = __uint_as_float(au[j] << 16), a1 = __uint_as_float(au[j] & 0xffff0000u);
        const float b0 = __uint_as_float(bu[j] << 16), b1 = __uint_as_float(bu[j] & 0xffff0000u);
        o[j] = pack2(a0 * sigmoidf_(b0), a1 * sigmoidf_(b1));
      }
      pk.x = o[0]; pk.y = o[1]; pk.z = o[2]; pk.w = o[3];
    }
    *(uint4*)(sU + r * 512 + c8 * 8) = pk;
  }
  const int c = 2 * tid;
  float w0[31], w1[31];
#pragma unroll
  for (int j = 0; j < 31; ++j) { w0[j] = p.conv_w[j * 512 + c]; w1[j] = p.conv_w[j * 512 + c + 1]; }
  const float bd0 = p.conv_b[c], bd1 = p.conv_b[c + 1];
  __syncthreads();
  float ya[32], yb[32];
#pragma unroll
  for (int tt = 0; tt < 32; ++tt) {
    float y0 = bd0, y1 = bd1;
#pragma unroll
    for (int j = 0; j < 31; ++j) {
      const unsigned uu = *(const unsigned*)(sU + (tt + j) * 512 + c);
      y0 += w0[j] * __uint_as_float(uu << 16);
      y1 += w1[j] * __uint_as_float(uu & 0xffff0000u);
    }
    ya[tt] = y0; yb[tt] = y1;
    float s = y0 + y1, q = y0 * y0 + y1 * y1;
    s = wave_sum(s); q = wave_sum(q);
    if (lane == 0) sRed[tt * 4 + w] = make_float2(s, q);
  }
  __syncthreads();
  const float g0 = p.ln_g[c], g1 = p.ln_g[c + 1], lb0 = p.ln_b[c], lb1 = p.ln_b[c + 1];
#pragma unroll
  for (int tt = 0; tt < 32; ++tt) {
    const float y0 = ya[tt], y1 = yb[tt];
    const float2 r0 = sRed[tt * 4 + 0], r1 = sRed[tt * 4 + 1], r2 = sRed[tt * 4 + 2], r3 = sRed[tt * 4 + 3];
    const float S = r0.x + r1.x + r2.x + r3.x, Q = r0.y + r1.y + r2.y + r3.y;
    const float mu = S * (1.f / 512.f);
    const float var = fmaxf(Q * (1.f / 512.f) - mu * mu, 0.f);
    const float rstd = rsqrtf(var + 1e-6f);
    const float z0 = (y0 - mu) * rstd * g0 + lb0, z1 = (y1 - mu) * rstd * g1 + lb1;
    const float o0 = z0 * sigmoidf_(z0), o1 = z1 * sigmoidf_(z1);
    *(unsigned*)(p.mix + ((size_t)b * T + t0 + tt) * LDA + c) = pack2(o0, o1);
  }
}

DEVI void compress2_tile(const Params& p, unsigned char* smem, int tile);
DEVI void phase2(const Params& p, unsigned char* smem) {
  u16* sA = (u16*)smem; u16* sB = sA + 128 * 72;
#pragma unroll 1
  for (int tile = blockIdx.x; tile < 64 + 1024; tile += gridDim.x) {
    GEMM_LANE_VARS
    if (tile < 64) {
      const int ty = tile >> 5, mt = tile & 31;
      const int m0 = mt * 128;
      f32x4 acc[4][4];
      gemm_mainloop<true>(tid, sA, sB, ACmp{p.proj, ty ? C_VC : C_KC}, p.w1T + (size_t)ty * 128 * LDW1, LDW1, m0, 0, 32, acc);
#pragma unroll
      for (int mi = 0; mi < 4; ++mi) {
        const int m = m0 + wm * 64 + 16 * mi + col;
#pragma unroll
        for (int ni = 0; ni < 4; ++ni) {
          const int n = wn * 64 + 16 * ni + 4 * quad;
          const f32x4 v = acc[ni][mi];
          const float4 bb = *(const float4*)(p.biasp + ty * 128 + n);
          uint2 pk;
          pk.x = pack2(gelu_tanh(v[0] + bb.x), gelu_tanh(v[1] + bb.y));
          pk.y = pack2(gelu_tanh(v[2] + bb.z), gelu_tanh(v[3] + bb.w));
          *(uint2*)(p.hdn + ((size_t)ty * 4096 + m) * 128 + n) = pk;
        }
      }
      asm volatile("s_waitcnt vmcnt(0)" ::: "memory");
      __syncthreads();
      compress2_tile(p, smem, tile);
    } else {
      conv_tile(p, smem, tile - 64);
    }
  }
}

DEVI void compress2_tile(const Params& p, unsigned char* smem, int tile) {
  u16* sA = (u16*)smem; u16* sB = sA + 128 * 72;
  {
    GEMM_LANE_VARS
    const int ty = tile >> 5, mt = tile & 31;
    const int m0 = mt * 128;
    f32x4 acc[4][4];
    gemm_mainloop<true>(tid, sA, sB, ARow{p.hdn + (size_t)ty * 4096 * 128, 128}, p.w2T + (size_t)ty * 128 * 128, 128, m0, 0, 2, acc);
    if (wn == 0) {
#pragma unroll
      for (int mi = 0; mi < 4; ++mi) {
        const int m = m0 + 16 * mi + wm * 64 + col;
        const int bg = m >> 7, c = m & 127;
#pragma unroll
        for (int ni = 0; ni < 4; ++ni) {
          const int n = 16 * ni + 4 * quad;
          const f32x4 v = acc[ni][mi];
          const float4 bb = *(const float4*)(p.cmp_b2 + ty * 64 + n);
          const float o0 = v[0] + bb.x, o1 = v[1] + bb.y, o2 = v[2] + bb.z, o3 = v[3] + bb.w;
          if (ty == 0) {
            uint2 pk; pk.x = pack2(o0, o1); pk.y = pack2(o2, o3);
            *(uint2*)(p.kc + (size_t)m * 64 + n) = pk;
          } else {
            u16* dst = p.vcT + ((size_t)bg * 64 + n) * 128 + c;
            dst[0] = f2bf(o0); dst[128] = f2bf(o1); dst[256] = f2bf(o2); dst[384] = f2bf(o3);
          }
        }
      }
    }
  }
}

template <int DH, int NQ, int LDK, class MaskF>
DEVI void attn_qk(const u16* sK, const bf16x8 (&qf)[NQ][DH / 32], f32x4 (&o)[NQ][DH / 16], float (&m)[NQ], float (&l)[NQ],
                  float c2, int lane, MaskF valid, bf16x8 (&pb)[NQ][2]) {
  const int col = lane & 15, quad = lane >> 4;
  f32x4 s[NQ][4];
  __builtin_amdgcn_s_setprio(1);
#pragma unroll
  for (int kt = 0; kt < 4; ++kt) {
#pragma unroll
    for (int qt = 0; qt < NQ; ++qt) s[qt][kt] = f32x4{0.f, 0.f, 0.f, 0.f};
#pragma unroll
    for (int ks = 0; ks < DH / 32; ++ks) {
      const bf16x8 kf = *(const bf16x8*)(sK + (16 * kt + col) * LDK + 32 * ks + 8 * quad);
#pragma unroll
      for (int qt = 0; qt < NQ; ++qt) s[qt][kt] = mfma16(kf, qf[qt][ks], s[qt][kt]);
    }
  }
  __builtin_amdgcn_s_setprio(0);
#pragma unroll
  for (int qt = 0; qt < NQ; ++qt) {
    float mx = -1e30f;
#pragma unroll
    for (int kt = 0; kt < 4; ++kt)
#pragma unroll
      for (int r = 0; r < 4; ++r) {
        const bool v = valid(qt, 16 * kt + 4 * quad + r);
        const float sv = v ? s[qt][kt][r] : -1e30f;
        s[qt][kt][r] = sv;
        mx = fmaxf(mx, sv);
      }
    mx = fmaxf(mx, __shfl_xor(mx, 16));
    mx = fmaxf(mx, __shfl_xor(mx, 32));
    const float mn = fmaxf(m[qt], mx);
    const float alpha = fexp2((m[qt] - mn) * c2);
    m[qt] = mn;
    const float mc = fmaxf(mn, -1e20f) * c2;
    float ps = 0.f;
#pragma unroll
    for (int kt = 0; kt < 4; ++kt)
#pragma unroll
      for (int r = 0; r < 4; ++r) {
        const float pv = fexp2(__builtin_fmaf(s[qt][kt][r], c2, -mc));
        ps += pv;
        s[qt][kt][r] = pv;
      }
    l[qt] = l[qt] * alpha + ps;
#pragma unroll
    for (int dt = 0; dt < DH / 16; ++dt) o[qt][dt] *= alpha;
#pragma unroll
    for (int kk = 0; kk < 2; ++kk) {
      union { bf16x8 v; unsigned u[4]; } cv;
      cv.u[0] = pack2(s[qt][2 * kk][0], s[qt][2 * kk][1]);
      cv.u[1] = pack2(s[qt][2 * kk][2], s[qt][2 * kk][3]);
      cv.u[2] = pack2(s[qt][2 * kk + 1][0], s[qt][2 * kk + 1][1]);
      cv.u[3] = pack2(s[qt][2 * kk + 1][2], s[qt][2 * kk + 1][3]);
      pb[qt][kk] = cv.v;
    }
  }
}
template <int DH, int NQ, int LDV>
DEVI void attn_pv(const u16* sVt, const bf16x8 (&pb)[NQ][2], f32x4 (&o)[NQ][DH / 16], int lane) {
  const int col = lane & 15, quad = lane >> 4;
  __builtin_amdgcn_s_setprio(1);
#pragma unroll
  for (int dt = 0; dt < DH / 16; ++dt) {
#pragma unroll
    for (int kk = 0; kk < 2; ++kk) {
      union { bf16x8 v; uint2 h[2]; } cv;
      cv.h[0] = *(const uint2*)(sVt + (16 * dt + col) * LDV + 32 * kk + 4 * quad);
      cv.h[1] = *(const uint2*)(sVt + (16 * dt + col) * LDV + 32 * kk + 16 + 4 * quad);
#pragma unroll
      for (int qt = 0; qt < NQ; ++qt) o[qt][dt] = mfma16(cv.v, pb[qt][kk], o[qt][dt]);
    }
  }
  __builtin_amdgcn_s_setprio(0);
}
template <int DH, int NQ, int LDK, int LDV, class MaskF>
DEVI void attn_tile(const u16* sK, const u16* sVt, const bf16x8 (&qf)[NQ][DH / 32], f32x4 (&o)[NQ][DH / 16],
                    float (&m)[NQ], float (&l)[NQ], float c2, int lane, MaskF valid) {
  bf16x8 pb[NQ][2];
  attn_qk<DH, NQ, LDK>(sK, qf, o, m, l, c2, lane, valid, pb);
  attn_pv<DH, NQ, LDV>(sVt, pb, o, lane);
}

DEVI void phase_nsa(const Params& p, unsigned char* smem) {
  u16* sK = (u16*)smem;
  u16* sVt = (u16*)(smem + 18432);
  float* impH = (float*)(smem + 35840);
  float* impT = (float*)(smem + 52736);
  unsigned* selm = (unsigned*)(smem + 56960);
  const float c2 = 0.125f * 1.4426950408889634f;
#pragma unroll 1
  for (int tile = blockIdx.x; tile < 2048; tile += gridDim.x) {
    const int tid = launder(threadIdx.x), lane = tid & 63, w = tid >> 6, col = lane & 15, quad = lane >> 4;
    const int tj = tile >> 5, ti = tj & 15, tk = tj >> 4;
    const int qtile = (tk == 0) ? 63 - ti : (tk == 1) ? 32 + ti : (tk == 2) ? 31 - ti : ti;
    const int bg = tile & 31, b = bg >> 1, g = bg & 1, q0 = qtile * 32;
    const bool need_sel = (q0 + 31) >= 16 * 64;
    const int h = g * 4 + w;
    __syncthreads();
    if (tid < 32) selm[tid] = 0u;
    {
      const u16* kcp = p.kc + (size_t)bg * 128 * 64;
      const u16* vcp = p.vcT + (size_t)bg * 64 * 128;
#pragma unroll
      for (int i = 0; i < 4; ++i) {
        const int c = tid + 256 * i;
        const int row = c >> 3, ch = (c & 7) << 3;
        *(uint4*)(sK + row * 72 + ch) = *(const uint4*)(kcp + row * 64 + ch);
        const int row2 = c >> 4, ch2 = (c & 15) << 3;
        *(uint4*)(sVt + row2 * 136 + ch2) = *(const uint4*)(vcp + row2 * 128 + ch2);
      }
    }
    bf16x8 qf[2][2];
    float gate[2][3];
    int tq[2];
#pragma unroll
    for (int qt = 0; qt < 2; ++qt) {
      const int t = q0 + 16 * qt + col;
      tq[qt] = t;
      const size_t tok = (size_t)b * T + t;
      const u16* qp = p.proj + tok * LDP + C_Q + h * 64 + 8 * quad;
      qf[qt][0] = *(const bf16x8*)qp;
      qf[qt][1] = *(const bf16x8*)(qp + 32);
#pragma unroll
      for (int br = 0; br < 3; ++br) gate[qt][br] = sigmoidf_(bf2f(p.proj[tok * LDP + C_GATE + h * 3 + br]));
    }
    __syncthreads();

    f32x4 comb[2][4];
    {
      const int srcl = (lane + 48) & 63;
#pragma unroll
      for (int qt = 0; qt < 2; ++qt) {
        f32x4 s[8];
#pragma unroll
        for (int kt = 0; kt < 8; ++kt) {
          s[kt] = f32x4{0.f, 0.f, 0.f, 0.f};
#pragma unroll
          for (int ks = 0; ks < 2; ++ks) {
            const bf16x8 kf = *(const bf16x8*)(sK + (16 * kt + col) * 72 + 32 * ks + 8 * quad);
            s[kt] = mfma16(kf, qf[qt][ks], s[kt]);
          }
        }
        const int t = tq[qt];
        float mx = -1e30f;
#pragma unroll
        for (int kt = 0; kt < 8; ++kt)
#pragma unroll
          for (int r = 0; r < 4; ++r) {
            const int c = 16 * kt + 4 * quad + r;
            const bool v = (16 * c + 31) <= t;
            const float sv = v ? s[kt][r] : -1e30f;
            s[kt][r] = sv;
            mx = fmaxf(mx, sv);
          }
        mx = fmaxf(mx, __shfl_xor(mx, 16));
        mx = fmaxf(mx, __shfl_xor(mx, 32));
        float ps = 0.f;
        const float mcc = fmaxf(mx, -1e20f) * c2;
#pragma unroll
        for (int kt = 0; kt < 8; ++kt)
#pragma unroll
          for (int r = 0; r < 4; ++r) {
            const float pv = fexp2(__builtin_fmaf(s[kt][r], c2, -mcc));
            ps += pv;
            s[kt][r] = pv;
          }
        ps += __shfl_xor(ps, 16);
        ps += __shfl_xor(ps, 32);
        const float inv = ps > 0.f ? 1.f / ps : 0.f;
#pragma unroll
        for (int kt = 0; kt < 8; ++kt)
#pragma unroll
          for (int r = 0; r < 4; ++r) s[kt][r] *= inv;
        float prev3 = 0.f;
#pragma unroll
        for (int kt = 0; kt < 8; ++kt) {
          const float sum4 = s[kt][0] + s[kt][1] + s[kt][2] + s[kt][3];
          const float xs = __shfl(s[kt][3], srcl);
          const float extra = quad ? xs : prev3;
          prev3 = xs;
          if (need_sel) impH[(w * 32 + 16 * qt + col) * 33 + 4 * kt + quad] = sum4 + extra;
        }
        bf16x8 pb[4];
#pragma unroll
        for (int kk = 0; kk < 4; ++kk) {
          union { bf16x8 v; unsigned u[4]; } cv;
          cv.u[0] = pack2(s[2 * kk][0], s[2 * kk][1]);
          cv.u[1] = pack2(s[2 * kk][2], s[2 * kk][3]);
          cv.u[2] = pack2(s[2 * kk + 1][0], s[2 * kk + 1][1]);
          cv.u[3] = pack2(s[2 * kk + 1][2], s[2 * kk + 1][3]);
          pb[kk] = cv.v;
        }
#pragma unroll
        for (int dt = 0; dt < 4; ++dt) {
          f32x4 oc = f32x4{0.f, 0.f, 0.f, 0.f};
#pragma unroll
          for (int kk = 0; kk < 4; ++kk) {
            union { bf16x8 v; uint2 hh[2]; } cv;
            cv.hh[0] = *(const uint2*)(sVt + (16 * dt + col) * 136 + 32 * kk + 4 * quad);
            cv.hh[1] = *(const uint2*)(sVt + (16 * dt + col) * 136 + 32 * kk + 16 + 4 * quad);
            oc = mfma16(cv.v, pb[kk], oc);
          }
          comb[qt][dt] = oc * gate[qt][0];
        }
      }
    }
#pragma unroll
    for (int qt = 0; qt < 2; ++qt) {
      const size_t tok = (size_t)b * T + tq[qt];
      union { bf16x8 v; unsigned u[4]; } own, par, res;
      own.v = qf[qt][0];
#pragma unroll
      for (int j = 0; j < 4; ++j) par.u[j] = (unsigned)__shfl_xor((int)own.u[j], 16);
      const float4 c0 = *(const float4*)(p.rope + tok * 16), c1 = *(const float4*)(p.rope + tok * 16 + 4);
      const float4 s0 = *(const float4*)(p.rope + tok * 16 + 8), s1 = *(const float4*)(p.rope + tok * 16 + 12);
      const float cs[8] = {c0.x, c0.y, c0.z, c0.w, c1.x, c1.y, c1.z, c1.w};
      const float sn[8] = {s0.x, s0.y, s0.z, s0.w, s1.x, s1.y, s1.z, s1.w};
#pragma unroll
      for (int j = 0; j < 4; ++j) {
        const float o0 = __uint_as_float(own.u[j] << 16), o1 = __uint_as_float(own.u[j] & 0xffff0000u);
        const float p0 = __uint_as_float(par.u[j] << 16), p1 = __uint_as_float(par.u[j] & 0xffff0000u);
        const float sg = (quad == 0) ? -1.f : 1.f;
        const float r0 = o0 * cs[2 * j] + sg * p0 * sn[2 * j];
        const float r1 = o1 * cs[2 * j + 1] + sg * p1 * sn[2 * j + 1];
        res.u[j] = (quad < 2) ? pack2(r0, r1) : own.u[j];
      }
      qf[qt][0] = res.v;
    }
    __syncthreads();
    if (!need_sel) {
      if (tid < 32) selm[tid] = (2u << ((q0 + tid) >> 6)) - 1u;
    } else {
#pragma unroll
    for (int i = 0; i < 4; ++i) {
      const int cell = tid + 256 * i;
      const int qi = cell >> 5, s_ = cell & 31;
      const int cur = (q0 + qi) >> 6;
      float v = impH[(0 * 32 + qi) * 33 + s_] + impH[(1 * 32 + qi) * 33 + s_] + impH[(2 * 32 + qi) * 33 + s_] +
                impH[(3 * 32 + qi) * 33 + s_];
      const int dist = cur - s_;
      const bool forced = (s_ == 0) || (dist >= 0 && dist < 2);
      v = forced ? 1e9f : (s_ <= cur ? v : -1.f);
      impT[qi * 33 + s_] = v;
    }
    __syncthreads();
    {
      const int qi = tid >> 3, sub = tid & 7;
      unsigned bits = 0u;
#pragma unroll
      for (int k = 0; k < 4; ++k) {
        const int s_ = sub * 4 + k;
        const float v = impT[qi * 33 + s_];
        int rank = 0;
        for (int s2 = 0; s2 < 32; ++s2) {
          const float v2 = impT[qi * 33 + s2];
          rank += ((v2 > v) || (v2 == v && s2 < s_)) ? 1 : 0;
        }
        if (rank < 16) bits |= 1u << s_;
      }
      atomicOr(&selm[qi], bits);
    }
    }
    __syncthreads();
    unsigned sm[2] = {selm[col], selm[16 + col]};
    unsigned uni = 0u;
#pragma unroll
    for (int i = 0; i < 32; ++i) uni |= selm[i];
    const int kbmax = (q0 + 31) >> 6;
    {
      float m[2] = {-1e30f, -1e30f}, l[2] = {0.f, 0.f};
      f32x4 o[2][4];
#pragma unroll
      for (int qt = 0; qt < 2; ++qt)
#pragma unroll
        for (int dt = 0; dt < 4; ++dt) o[qt][dt] = f32x4{0.f, 0.f, 0.f, 0.f};
      unsigned rem = (kbmax >= 31) ? uni : (uni & ((1u << (kbmax + 1)) - 1u));
      int kb = rem ? (__ffs((int)rem) - 1) : -1;
      uint4 rk0, rk1, rv0, rv1;
      const int lr0 = tid >> 3, lch = (tid & 7) << 3;
#define LOADKV_(kbx, CK, VT)                                                                                         \
      rk0 = *(const uint4*)(p.proj + ((size_t)b * T + (kbx) * 64 + lr0) * LDP + (CK) + g * 64 + lch);                 \
      rk1 = *(const uint4*)(p.proj + ((size_t)b * T + (kbx) * 64 + lr0 + 32) * LDP + (CK) + g * 64 + lch);            \
      rv0 = *(const uint4*)((VT) + ((size_t)bg * 64 + lr0) * LDT + (kbx) * 64 + lch);                                 \
      rv1 = *(const uint4*)((VT) + ((size_t)bg * 64 + lr0 + 32) * LDT + (kbx) * 64 + lch);
#define STOREKV_()                                                                                                   \
      *(uint4*)(sK + lr0 * 72 + lch) = rk0; *(uint4*)(sK + (lr0 + 32) * 72 + lch) = rk1;                              \
      *(uint4*)(sVt + lr0 * 72 + lch) = rv0; *(uint4*)(sVt + (lr0 + 32) * 72 + lch) = rv1;
      if (kb >= 0) { LOADKV_(kb, C_KS, p.vts) }
#pragma unroll 1
      while (kb >= 0) {
        rem &= rem - 1u;
        const int nkb = rem ? (__ffs((int)rem) - 1) : -1;
        __syncthreads();
        STOREKV_()
        if (nkb >= 0) { LOADKV_(nkb, C_KS, p.vts) }
        __syncthreads();
        const int lim0 = ((sm[0] >> kb) & 1u) ? tq[0] : -1, lim1 = ((sm[1] >> kb) & 1u) ? tq[1] : -1;
        attn_tile<64, 2, 72, 72>(sK, sVt, qf, o, m, l, c2, lane, [&](int qt, int kl) {
          return (kb * 64 + kl) <= (qt ? lim1 : lim0);
        });
        kb = nkb;
      }
#pragma unroll
      for (int qt = 0; qt < 2; ++qt) {
        float lt = l[qt];
        lt += __shfl_xor(lt, 16);
        lt += __shfl_xor(lt, 32);
        const float sc = lt > 0.f ? gate[qt][1] / lt : 0.f;
#pragma unroll
        for (int dt = 0; dt < 4; ++dt) comb[qt][dt] += o[qt][dt] * sc;
      }
    }
    {
      float m[2] = {-1e30f, -1e30f}, l[2] = {0.f, 0.f};
      f32x4 o[2][4];
#pragma unroll
      for (int qt = 0; qt < 2; ++qt)
#pragma unroll
        for (int dt = 0; dt < 4; ++dt) o[qt][dt] = f32x4{0.f, 0.f, 0.f, 0.f};
      const int kblo = (q0 >= 511) ? ((q0 - 511) >> 6) : 0;
      uint4 rk0, rk1, rv0, rv1;
      const int lr0 = tid >> 3, lch = (tid & 7) << 3;
      int kb = kblo;
      LOADKV_(kb, C_KW, p.vtw)
#pragma unroll 1
      while (kb >= 0) {
        const int nkb = (kb < kbmax) ? kb + 1 : -1;
        __syncthreads();
        STOREKV_()
        if (nkb >= 0) { LOADKV_(nkb, C_KW, p.vtw) }
        __syncthreads();
        attn_tile<64, 2, 72, 72>(sK, sVt, qf, o, m, l, c2, lane, [&](int qt, int kl) {
          return (unsigned)(tq[qt] - (kb * 64 + kl)) < 512u;
        });
        kb = nkb;
      }
#undef LOADKV_
#undef STOREKV_
#pragma unroll
      for (int qt = 0; qt < 2; ++qt) {
        float lt = l[qt];
        lt += __shfl_xor(lt, 16);
        lt += __shfl_xor(lt, 32);
        const float sc = lt > 0.f ? gate[qt][2] / lt : 0.f;
#pragma unroll
        for (int dt = 0; dt < 4; ++dt) comb[qt][dt] += o[qt][dt] * sc;
      }
    }
#pragma unroll
    for (int qt = 0; qt < 2; ++qt) {
      const size_t tok = (size_t)b * T + tq[qt];
#pragma unroll
      for (int dt = 0; dt < 4; ++dt) {
        uint2 pk;
        pk.x = pack2(comb[qt][dt][0], comb[qt][dt][1]);
        pk.y = pack2(comb[qt][dt][2], comb[qt][dt][3]);
        *(uint2*)(p.mix + tok * LDA + 512 + h * 64 + 16 * dt + 4 * quad) = pk;
      }
    }
  }
}

template <bool RESB>
DEVI void phase_resid(const Params& p, unsigned char* smem, const u16* A, const u16* Wt, const float* res, float* ssq) {
  u16* sA = (u16*)smem; u16* sB = sA + 128 * 72;
  XCD_TILE_LOOP(idx, 256, 8) {
    GEMM_LANE_VARS
    const int mt = XCD_TILE_MT(idx, 8), nt_ = XCD_TILE_NT(idx, 8);
    const int m0 = mt * 128, n0 = nt_ * 128;
    f32x4 acc[4][4];
    gemm_mainloop<true>(tid, sA, sB, ARow{A, LDA}, Wt, LDA, m0, n0, 16, acc);
#pragma unroll
    for (int mi = 0; mi < 4; ++mi) {
      const int m = m0 + wm * 64 + 16 * mi + col;
      float ss = 0.f;
#pragma unroll
      for (int ni = 0; ni < 4; ++ni) {
        const int n = n0 + wn * 64 + 16 * ni + 4 * quad;
        const f32x4 v = acc[ni][mi];
        float4 r;
        if (RESB) {
          const uint2 rb = *(const uint2*)(p.hn + (size_t)m * LDA + n);
          r.x = __uint_as_float(rb.x << 16); r.y = __uint_as_float(rb.x & 0xffff0000u);
          r.z = __uint_as_float(rb.y << 16); r.w = __uint_as_float(rb.y & 0xffff0000u);
        } else {
          r = *(const float4*)(res + (size_t)m * D + n);
        }
        float4 hv;
        hv.x = r.x + v[0]; hv.y = r.y + v[1]; hv.z = r.z + v[2]; hv.w = r.w + v[3];
        ss += hv.x * hv.x + hv.y * hv.y + hv.z * hv.z + hv.w * hv.w;
        uint2 pk; pk.x = pack2(hv.x, hv.y); pk.y = pack2(hv.z, hv.w);
        *(uint2*)(p.hn + (size_t)m * LDA + n) = pk;
      }
      ss += __shfl_xor(ss, 16);
      ss += __shfl_xor(ss, 32);
      if (quad == 0) atomicAdd(ssq + m, ss);
    }
  }
}

DEVI void phase_scaled(const Params& p, unsigned char* smem, const u16* A, const u16* Wt, int ntn, const float* ssq, u16* outp, int ldo) {
  u16* sA = (u16*)smem; u16* sB = sA + 128 * 72;
  XCD_TILE_LOOP(idx, 256, ntn) {
    GEMM_LANE_VARS
    const int mt = XCD_TILE_MT(idx, ntn), nt_ = XCD_TILE_NT(idx, ntn);
    const int m0 = mt * 128, n0 = nt_ * 128;
    f32x4 acc[4][4];
    gemm_mainloop<true>(tid, sA, sB, ARow{A, LDA}, Wt, LDA, m0, n0, 16, acc);
#pragma unroll
    for (int mi = 0; mi < 4; ++mi) {
      const int m = m0 + wm * 64 + 16 * mi + col;
      const float rstd = rsqrtf(ssq[m] * (1.f / D) + 1e-6f);
#pragma unroll
      for (int ni = 0; ni < 4; ++ni) {
        const int n = n0 + wn * 64 + 16 * ni + 4 * quad;
        const f32x4 v = acc[ni][mi];
        uint2 pk; pk.x = pack2(v[0] * rstd, v[1] * rstd); pk.y = pack2(v[2] * rstd, v[3] * rstd);
        *(uint2*)(outp + (size_t)m * ldo + n) = pk;
      }
    }
  }
}

DEVI void phase_memattn(const Params& p, unsigned char* smem) {
  u16* sK = (u16*)smem;
  u16* sVt = (u16*)(smem + 33792);
  const float c2 = 0.0625f * 1.4426950408889634f;
#pragma unroll 1
  for (int tile = blockIdx.x; tile < 2048; tile += gridDim.x) {
    const int tid = launder(threadIdx.x), lane = tid & 63, w = tid >> 6, col = lane & 15, quad = lane >> 4;
    const int b = tile >> 7, head = (tile >> 5) & 3, q0 = (tile & 31) * 64;
    const size_t tok = (size_t)b * T + q0 + 16 * w + col;
    bf16x8 qf[1][8];
#pragma unroll
    for (int ks = 0; ks < 8; ++ks) qf[0][ks] = *(const bf16x8*)(p.qm + tok * LDA + head * 256 + 32 * ks + 8 * quad);
    float m[1] = {-1e30f}, l[1] = {0.f};
    f32x4 o[1][16];
#pragma unroll
    for (int dt = 0; dt < 16; ++dt) o[0][dt] = f32x4{0.f, 0.f, 0.f, 0.f};
    uint4 rg0, rg1, rg2, rg3, rg4, rg5, rg6, rg7;
    const int krow = tid >> 5, kch = (tid & 31) << 3;
    const int vrow = tid >> 3, vch = (tid & 7) << 3;
#define LK1_(i, kbx) rg##i = *(const uint4*)(p.memk + ((size_t)b * 256 + (kbx) * 64 + krow + 8 * i) * LDA + head * 256 + kch);
#define SK1_(i) *(uint4*)(sK + (krow + 8 * i) * 264 + kch) = rg##i;
#define LV1_(i, kbx) rg##i = *(const uint4*)(p.memvt + ((size_t)(b * 4 + head) * 256 + vrow + 32 * i) * 256 + (kbx) * 64 + vch);
#define SV1_(i) *(uint4*)(sVt + (vrow + 32 * i) * 72 + vch) = rg##i;
#define LOADK_(kbx) LK1_(0, kbx) LK1_(1, kbx) LK1_(2, kbx) LK1_(3, kbx) LK1_(4, kbx) LK1_(5, kbx) LK1_(6, kbx) LK1_(7, kbx)
#define STOREK_() SK1_(0) SK1_(1) SK1_(2) SK1_(3) SK1_(4) SK1_(5) SK1_(6) SK1_(7)
#define LOADV_(kbx) LV1_(0, kbx) LV1_(1, kbx) LV1_(2, kbx) LV1_(3, kbx) LV1_(4, kbx) LV1_(5, kbx) LV1_(6, kbx) LV1_(7, kbx)
#define STOREV_() SV1_(0) SV1_(1) SV1_(2) SV1_(3) SV1_(4) SV1_(5) SV1_(6) SV1_(7)
    __syncthreads();
    LOADK_(0)
    STOREK_()
    LOADV_(0)
    __syncthreads();
#pragma unroll 1
    for (int kb = 0; kb < 4; ++kb) {
      bf16x8 pb[1][2];
      attn_qk<256, 1, 264>(sK, qf, o, m, l, c2, lane, [&](int, int) { return true; }, pb);
      STOREV_()
      if (kb < 3) { LOADK_(kb + 1) }
      __syncthreads();
      attn_pv<256, 1, 72>(sVt, pb, o, lane);
      if (kb < 3) {
        STOREK_()
        LOADV_(kb + 1)
      }
      __syncthreads();
    }
#undef LOADK_
#undef STOREK_
#undef LOADV_
#undef STOREV_
#undef LK1_
#undef SK1_
#undef LV1_
#undef SV1_
    float lt = l[0];
    lt += __shfl_xor(lt, 16);
    lt += __shfl_xor(lt, 32);
    const float inv = 1.f / lt;
#pragma unroll
    for (int dt = 0; dt < 16; ++dt) {
      uint2 pk;
      pk.x = pack2(o[0][dt][0] * inv, o[0][dt][1] * inv);
      pk.y = pack2(o[0][dt][2] * inv, o[0][dt][3] * inv);
      *(uint2*)(p.mix + tok * LDA + head * 256 + 16 * dt + 4 * quad) = pk;
    }
  }
}

__constant__ unsigned char kCandI[64] = {0,0,0,0,0,0,0,0,0,0,0,0,0,0,0,0, 1,1,1,1,1,1,1,1, 2,2,2,2,2, 3,3,3,3, 4,4,4, 5,5, 6,6, 7,7,
                                          8, 9, 10, 11, 12, 13, 14, 15, 0,0,0,0,0,0,0,0,0,0,0,0,0,0};
__constant__ unsigned char kCandJ[64] = {0,1,2,3,4,5,6,7,8,9,10,11,12,13,14,15, 0,1,2,3,4,5,6,7, 0,1,2,3,4, 0,1,2,3, 0,1,2, 0,1, 0,1, 0,1,
                                          0, 0, 0, 0, 0, 0, 0, 0, 0,0,0,0,0,0,0,0,0,0,0,0,0,0};

DEVI unsigned score_key(float v, int idx) {
  unsigned u = __float_as_uint(v);
  u = (u & 0x80000000u) ? ~u : (u | 0x80000000u);
  return (u & ~127u) | (unsigned)(127 - idx);
}
DEVI float key_score(unsigned k) {
  k &= ~127u;
  const unsigned u = (k & 0x80000000u) ? (k & 0x7fffffffu) : ~k;
  return __uint_as_float(u);
}

DEVI void phase_peer_route(const Params& p, unsigned char* smem) {
  u16* sA = (u16*)smem; u16* sB = sA + 128 * 72;
  unsigned* sScore = (unsigned*)smem;
  unsigned* sTop = (unsigned*)(smem + 36864);
  unsigned* sTmp = (unsigned*)(smem + 53248);
  {
    const int t0_ = launder(threadIdx.x);
    const int gw = (blockIdx.x * 256 + t0_) >> 6, nw = (gridDim.x * 256) >> 6;
    conv_fp8_rows(p.peer_u, p.ub8, p.uscale, 16384, gw, nw, t0_ & 63);
    conv_fp8_rows(p.peer_v, p.vb8, p.vscale, 16384, gw, nw, t0_ & 63);
  }
#pragma unroll 1
  for (int tile = blockIdx.x; tile < 256 * 8; tile += gridDim.x) {
    GEMM_LANE_VARS
    const int mt = tile >> 3, hd = tile & 7;
    const int m0 = mt * 128;
#pragma unroll 1
    for (int ph = 0; ph < 2; ++ph) {
      const int hp = hd * 2 + ph;
      f32x4 acc[4][4];
      __syncthreads();
      gemm_mainloop<false>(tid, sA, sB, ARow{p.pq + hp * 128, LDPQ}, p.subk + (size_t)hp * 128 * 128, 128, m0, 0, 2, acc);
#pragma unroll 1
      for (int hh = 0; hh < 2; ++hh) {
        if (wm == hh) {
#pragma unroll
          for (int mi = 0; mi < 4; ++mi) {
            const int row = 16 * mi + col;
#pragma unroll
            for (int ni = 0; ni < 4; ++ni) {
              const int n = wn * 64 + 16 * ni + 4 * quad;
              const f32x4 v = acc[ni][mi];
              uint4 kk;
              kk.x = score_key(v[0], n); kk.y = score_key(v[1], n + 1);
              kk.z = score_key(v[2], n + 2); kk.w = score_key(v[3], n + 3);
              *(uint4*)(sScore + row * 132 + n) = kk;
            }
          }
        }
        __syncthreads();
#pragma unroll 1
        for (int rg = 0; rg < 4; ++rg) {
          const int rbase = w * 16 + rg * 4;
          unsigned k0[4], k1[4], t0[4], t1[4], thr[4];
#pragma unroll
          for (int r = 0; r < 4; ++r) {
            k0[r] = sScore[(rbase + r) * 132 + lane];
            k1[r] = sScore[(rbase + r) * 132 + 64 + lane];
            t0[r] = ((k0[r] >> 16) << 7) | (k0[r] & 127u);
            t1[r] = ((k1[r] >> 16) << 7) | (k1[r] & 127u);
            thr[r] = 0u;
          }
#pragma unroll
          for (int bit = 22; bit >= 0; --bit) {
#pragma unroll
            for (int r = 0; r < 4; ++r) {
              const unsigned cand = thr[r] | (1u << bit);
              const int cnt = __popcll(__ballot(t0[r] >= cand)) + __popcll(__ballot(t1[r] >= cand));
              thr[r] = (cnt >= 16) ? cand : thr[r];
            }
          }
          unsigned* tmp = sTmp + w * 64;
#pragma unroll
          for (int r = 0; r < 4; ++r) {
            const unsigned long long b0 = __ballot(t0[r] >= thr[r]), b1 = __ballot(t1[r] >= thr[r]);
            const int pos0 = __builtin_amdgcn_mbcnt_hi((unsigned)(b0 >> 32), __builtin_amdgcn_mbcnt_lo((unsigned)b0, 0u));
            const int pos1 = __popcll(b0) + __builtin_amdgcn_mbcnt_hi((unsigned)(b1 >> 32), __builtin_amdgcn_mbcnt_lo((unsigned)b1, 0u));
            if (t0[r] >= thr[r]) tmp[r * 16 + pos0] = k0[r];
            if (t1[r] >= thr[r]) tmp[r * 16 + pos1] = k1[r];
          }
          __builtin_amdgcn_fence(__ATOMIC_RELEASE, "wavefront");
          __builtin_amdgcn_wave_barrier();
          __builtin_amdgcn_fence(__ATOMIC_ACQUIRE, "wavefront");
          {
            const int r = lane >> 4, ix = lane & 15;
            const unsigned mine = tmp[r * 16 + ix];
            const uint4 a = *(const uint4*)(tmp + r * 16), b = *(const uint4*)(tmp + r * 16 + 4), c = *(const uint4*)(tmp + r * 16 + 8),
                        d = *(const uint4*)(tmp + r * 16 + 12);
            const int rk = (a.x > mine) + (a.y > mine) + (a.z > mine) + (a.w > mine) + (b.x > mine) + (b.y > mine) + (b.z > mine) + (b.w > mine) +
                           (c.x > mine) + (c.y > mine) + (c.z > mine) + (c.w > mine) + (d.x > mine) + (d.y > mine) + (d.z > mine) + (d.w > mine);
            sTop[((hh * 64 + rbase + r) * 2 + ph) * 16 + rk] = mine;
          }
          __builtin_amdgcn_fence(__ATOMIC_RELEASE, "wavefront");
          __builtin_amdgcn_wave_barrier();
        }
        __syncthreads();
      }
    }
    const int ci = kCandI[lane], cj = kCandJ[lane];
    const bool act = lane < 50;
#pragma unroll 1
    for (int tg = 0; tg < 8; ++tg) {
      const int tb = w * 32 + tg * 4;
      unsigned k0[4], k1[4], ku[4], thr[4];
      float v[4];
#pragma unroll
      for (int r = 0; r < 4; ++r) {
        k0[r] = sTop[((tb + r) * 2 + 0) * 16 + ci];
        k1[r] = sTop[((tb + r) * 2 + 1) * 16 + cj];
        v[r] = key_score(k0[r]) + key_score(k1[r]);
        unsigned u = __float_as_uint(v[r]);
        u = (u & 0x80000000u) ? ~u : (u | 0x80000000u);
        ku[r] = act ? (((u >> 16) << 6) | (unsigned)(63 - lane)) : 0u;
        thr[r] = 0u;
      }
#pragma unroll
      for (int bit = 21; bit >= 0; --bit) {
#pragma unroll
        for (int r = 0; r < 4; ++r) {
          const unsigned cand = thr[r] | (1u << bit);
          const int cnt = __popcll(__ballot(ku[r] >= cand));
          thr[r] = (cnt >= 16) ? cand : thr[r];
        }
      }
#pragma unroll
      for (int r = 0; r < 4; ++r) {
        const bool sel = act && (ku[r] >= thr[r]);
        const unsigned long long ms = __ballot(sel);
        const int slot = __builtin_amdgcn_mbcnt_hi((unsigned)(ms >> 32), __builtin_amdgcn_mbcnt_lo((unsigned)ms, 0u));
        const float vmax = __int_as_float(__builtin_amdgcn_readlane(__float_as_int(v[r]), 0));
        const float e = sel ? __expf(v[r] - vmax) : 0.f;
        const float tot = wave_sum(e);
        if (sel) {
          const int eid = (127 - (int)(k0[r] & 127u)) * 128 + (127 - (int)(k1[r] & 127u));
          const size_t o = (size_t)(m0 + tb + r) * 128 + hd * 16 + slot;
          p.experts[o] = eid;
          p.gates[o] = e / tot;
        }
      }
    }
  }
}

template <int PART>
DEVI void phase_peer_gather(const Params& p, unsigned char* smem) {
  const int w0_ = threadIdx.x >> 6;
#pragma unroll 1
  for (int tok = blockIdx.x * 4 + w0_; tok < NTOK; tok += gridDim.x * 4) {
    if (NTOK % (gridDim.x * 4) == 0) __syncthreads();
    const int tid = launder(threadIdx.x), lane = tid & 63;
    const uint4* hp4 = (const uint4*)(p.hn + (size_t)tok * LDA + lane * 16);
    float hv[16], xn[16], y[16];
    {
      const uint4 a0 = hp4[0], a1 = hp4[1];
      const unsigned hu[8] = {a0.x, a0.y, a0.z, a0.w, a1.x, a1.y, a1.z, a1.w};
#pragma unroll
      for (int i = 0; i < 8; ++i) { hv[2 * i] = __uint_as_float(hu[i] << 16); hv[2 * i + 1] = __uint_as_float(hu[i] & 0xffff0000u); }
    }
    float ss = 0.f;
#pragma unroll
    for (int i = 0; i < 16; ++i) ss += hv[i] * hv[i];
    ss = wave_sum(ss);
    const float rstd = rsqrtf(ss * (1.f / D) + 1e-6f);
    {
      const float4* g4 = (const float4*)p.peer_g + lane * 4;
      const float4 a0 = g4[0], a1 = g4[1], a2 = g4[2], a3 = g4[3];
      const float gg[16] = {a0.x, a0.y, a0.z, a0.w, a1.x, a1.y, a1.z, a1.w, a2.x, a2.y, a2.z, a2.w, a3.x, a3.y, a3.z, a3.w};
#pragma unroll
      for (int i = 0; i < 16; ++i) { xn[i] = hv[i] * rstd * gg[i]; y[i] = 0.f; }
    }
    int e0 = p.experts[(size_t)tok * 128 + lane], e1 = p.experts[(size_t)tok * 128 + 64 + lane];
    float g0 = p.gates[(size_t)tok * 128 + lane], g1 = p.gates[(size_t)tok * 128 + 64 + lane];
    if (PART == 0) {
      int* sE = (int*)(smem + (tid >> 6) * 1024);
      float* sG = (float*)(sE + 128);
      int pos0 = 0, pos1 = 0, base = 0;
      const int flip_ = (((tok - (blockIdx.x * 4 + w0_)) / (int)(gridDim.x * 4)) & 1) ? 15 : 0;
      const int q0_ = (e0 >> 10) ^ flip_, q1_ = (e1 >> 10) ^ flip_;
#pragma unroll
      for (int q = 0; q < 16; ++q) {
        const unsigned long long m0 = __ballot(q0_ == q), m1 = __ballot(q1_ == q);
        const int c0 = __popcll(m0);
        const int i0 = __builtin_amdgcn_mbcnt_hi((unsigned)(m0 >> 32), __builtin_amdgcn_mbcnt_lo((unsigned)m0, 0u));
        const int i1 = __builtin_amdgcn_mbcnt_hi((unsigned)(m1 >> 32), __builtin_amdgcn_mbcnt_lo((unsigned)m1, 0u));
        if (q0_ == q) pos0 = base + i0;
        if (q1_ == q) pos1 = base + c0 + i1;
        base += c0 + __popcll(m1);
      }
      __builtin_amdgcn_fence(__ATOMIC_RELEASE, "wavefront");
      __builtin_amdgcn_wave_barrier();
      sE[pos0] = e0; sG[pos0] = g0;
      sE[pos1] = e1; sG[pos1] = g1;
      __builtin_amdgcn_fence(__ATOMIC_RELEASE, "wavefront");
      __builtin_amdgcn_wave_barrier();
      __builtin_amdgcn_fence(__ATOMIC_ACQUIRE, "wavefront");
      e0 = sE[lane]; e1 = sE[64 + lane];
      g0 = sG[lane]; g1 = sG[64 + lane];
      p.experts[(size_t)tok * 128 + lane] = e0;
      p.experts[(size_t)tok * 128 + 64 + lane] = e1;
    }
    const float su0 = p.uscale[e0], su1 = p.uscale[e1];
    const float sv0 = p.vscale[e0], sv1 = p.vscale[e1];
    float cf0 = 0.f, cf1 = 0.f, dsum = 0.f;
    uint4 ca[8], cb[8];
#define LOADB_(R, bi)                                                                                   \
    _Pragma("unroll") for (int u = 0; u < 8; ++u) {                                                       \
      const int kk_ = (((bi) & 7) << 3) + u;                                                             \
      const int e_ = __builtin_amdgcn_readlane((((bi) >> 3) & 1) ? e1 : e0, kk_);                        \
      R[u] = ((const uint4*)((((bi) >> 4) ? p.vb8 : p.ub8) + (size_t)e_ * 1024))[lane];                  \
    }
#define COMPU_(R, bi)                                                                                   \
    {                                                                                                    \
      float d8[8];                                                                                       \
      _Pragma("unroll") for (int u = 0; u < 8; ++u) {                                                     \
        const unsigned uu[4] = {R[u].x, R[u].y, R[u].z, R[u].w};                                         \
        f32x2 a2 = {0.f, 0.f};                                                                           \
        _Pragma("unroll") for (int j = 0; j < 4; ++j) {                                                   \
          const f32x2 lo = __builtin_amdgcn_cvt_pk_f32_fp8((int)uu[j], false);                           \
          const f32x2 hi = __builtin_amdgcn_cvt_pk_f32_fp8((int)uu[j], true);                            \
          a2 = xn2[2 * j] * lo + a2;                                                                     \
          a2 = xn2[2 * j + 1] * hi + a2;                                                                 \
        }                                                                                                \
        d8[u] = a2[0] + a2[1];                                                                           \
      }                                                                                                  \
          \
      float v4[4], v2[2];                                                                                \
      _Pragma("unroll") for (int i = 0; i < 4; ++i) {                                                     \
        const float snd = b5 ? d8[i] : d8[4 + i], kp = b5 ? d8[4 + i] : d8[i];                           \
        v4[i] = kp + __shfl_xor(snd, 32);                                                                \
      }                                                                                                  \
      _Pragma("unroll") for (int i = 0; i < 2; ++i) {                                                     \
        const float snd = b4 ? v4[i] : v4[2 + i], kp = b4 ? v4[2 + i] : v4[i];                           \
        v2[i] = kp + __shfl_xor(snd, 16);                                                                \
      }                                                                                                  \
      float v1;                                                                                          \
      { const float snd = b3 ? v2[0] : v2[1], kp = b3 ? v2[1] : v2[0]; v1 = kp + __shfl_xor(snd, 8); }   \
      v1 += __shfl_xor(v1, 4);                                                                           \
      v1 += __shfl_xor(v1, 2);                                                                           \
      v1 += __shfl_xor(v1, 1);                                                                           \
                \
      const float got = __shfl(v1, fsrc);                                                                \
      if ((lane >> 3) == ((bi) & 7)) dsum = got;                                                         \
    }                                                                                                    \
    if (((bi) & 7) == 7) {                                                                               \
      if (((bi) >> 3) & 1) cf1 = gelu_tanh(dsum * su1) * g1 * sv1; else cf0 = gelu_tanh(dsum * su0) * g0 * sv0; \
    }
#define COMPV_(R, bi)                                                                                   \
    _Pragma("unroll") for (int u = 0; u < 8; ++u) {                                                       \
      const int kk_ = (((bi) & 7) << 3) + u;                                                             \
      const float ck_ = __int_as_float(__builtin_amdgcn_readlane(__float_as_int((((bi) >> 3) & 1) ? cf1 : cf0), kk_)); \
      const f32x2 ck2 = {ck_, ck_};                                                                      \
      const unsigned uu[4] = {R[u].x, R[u].y, R[u].z, R[u].w};                                           \
      _Pragma("unroll") for (int j = 0; j < 4; ++j) {                                                     \
        const f32x2 lo = __builtin_amdgcn_cvt_pk_f32_fp8((int)uu[j], false);                             \
        const f32x2 hi = __builtin_amdgcn_cvt_pk_f32_fp8((int)uu[j], true);                              \
        y2[2 * j] = ck2 * lo + y2[2 * j];                                                                \
        y2[2 * j + 1] = ck2 * hi + y2[2 * j + 1];                                                        \
      }                                                                                                  \
    }
    const bool b5 = (lane & 32) != 0, b4 = (lane & 16) != 0, b3 = (lane & 8) != 0;
    const int fsrc = ((lane & 4) << 3) | ((lane & 2) << 3) | ((lane & 1) << 3);
    f32x2 xn2[8], y2[8];
#pragma unroll
    for (int i = 0; i < 8; ++i) { xn2[i] = f32x2{xn[2 * i], xn[2 * i + 1]}; y2[i] = f32x2{0.f, 0.f}; }
    if (PART == 0) {
      LOADB_(ca, 0)
#pragma unroll 1
      for (int bi = 0; bi < 16; bi += 2) {
        LOADB_(cb, bi + 1)
        COMPU_(ca, bi)
        if (bi + 2 < 16) { LOADB_(ca, bi + 2) }
        COMPU_(cb, bi + 1)
      }
      p.gates[(size_t)tok * 128 + lane] = cf0;
      p.gates[(size_t)tok * 128 + 64 + lane] = cf1;
      continue;
    }
    cf0 = g0; cf1 = g1;
    LOADB_(ca, 16)
#pragma unroll 1
    for (int bi = 16; bi < 32; bi += 2) {
      LOADB_(cb, bi + 1)
      COMPV_(ca, bi)
      if (bi + 2 < 32) { LOADB_(ca, bi + 2) }
      COMPV_(cb, bi + 1)
    }
#undef LOADB_
#undef COMPU_
#undef COMPV_
#pragma unroll
    for (int i = 0; i < 8; ++i) { y[2 * i] = y2[i][0]; y[2 * i + 1] = y2[i][1]; }
    float s2 = 0.f;
    {
      const uint4 a0 = hp4[0], a1 = hp4[1];
      const unsigned hu[8] = {a0.x, a0.y, a0.z, a0.w, a1.x, a1.y, a1.z, a1.w};
#pragma unroll
      for (int i = 0; i < 8; ++i) {
        y[2 * i] += __uint_as_float(hu[i] << 16);
        y[2 * i + 1] += __uint_as_float(hu[i] & 0xffff0000u);
        s2 += y[2 * i] * y[2 * i] + y[2 * i + 1] * y[2 * i + 1];
      }
    }
    s2 = wave_sum(s2);
    const float rs2 = rsqrtf(s2 * (1.f / D) + 1e-6f);
    {
      const float4* g4 = (const float4*)p.final_g + lane * 4;
      const float4 a0 = g4[0], a1 = g4[1], a2 = g4[2], a3 = g4[3];
      float4* o4 = (float4*)(p.out + (size_t)tok * D) + lane * 4;
      o4[0] = make_float4(y[0] * rs2 * a0.x, y[1] * rs2 * a0.y, y[2] * rs2 * a0.z, y[3] * rs2 * a0.w);
      o4[1] = make_float4(y[4] * rs2 * a1.x, y[5] * rs2 * a1.y, y[6] * rs2 * a1.z, y[7] * rs2 * a1.w);
      o4[2] = make_float4(y[8] * rs2 * a2.x, y[9] * rs2 * a2.y, y[10] * rs2 * a2.z, y[11] * rs2 * a2.w);
      o4[3] = make_float4(y[12] * rs2 * a3.x, y[13] * rs2 * a3.y, y[14] * rs2 * a3.z, y[15] * rs2 * a3.w);
    }
  }
}

#define XB_TMO      128
#define XB_XCNT(j)  (256  + 64 * (j))
#define XB_XSUB(j)  (1280 + 64 * (j))
#define XB_XGEN(j)  (2304 + 64 * (j))
#define XB_TOP      3328
#define XB_TOPGEN   3392
#define XCD_BAR_WORDS 3456
#define XB_SPIN_CAP (1u << 20)
#define LAS __attribute__((address_space(3)))
DEVI unsigned xb_ld(unsigned* q) { return __hip_atomic_load(q, __ATOMIC_RELAXED, __HIP_MEMORY_SCOPE_AGENT); }
DEVI unsigned xb_add(unsigned* q, unsigned v) { return __hip_atomic_fetch_add(q, v, __ATOMIC_RELAXED, __HIP_MEMORY_SCOPE_AGENT); }
DEVI unsigned xb_xcc_id() { return (unsigned)__builtin_amdgcn_s_getreg((3 << 11) | 20) & 0xFu; }
#define XB_SPIN(cond, bar) do { unsigned _sp = 0; while (cond) { __builtin_amdgcn_s_sleep(1); \
    if ((++_sp & 255u) == 0u) { if (xb_ld(&(bar)[XB_TMO])) break; if (_sp > XB_SPIN_CAP) { atomicAdd(&(bar)[XB_TMO], 1u); break; } } } } while (0)
struct XcdBarrier { unsigned* bar; unsigned x; volatile LAS unsigned* st; };
DEVI XcdBarrier xcd_barrier_post(unsigned* bar, volatile LAS unsigned* st) {
  XcdBarrier b; b.bar = bar; b.x = xb_xcc_id(); b.st = st;
  if (threadIdx.x == 0) (void)xb_add(&bar[XB_XCNT(b.x)], 1u);
  return b;
}
DEVI void xcd_barrier_complete(unsigned* bar, unsigned x, unsigned& nloc, unsigned& nx) {
  const unsigned G = gridDim.x * gridDim.y * gridDim.z;
  unsigned sum, cnt, mine, sp = 0u;
  for (;;) {
    sum = 0u; cnt = 0u; mine = 0u;
#pragma unroll
    for (unsigned j = 0; j < 16; ++j) { const unsigned c = xb_ld(&bar[XB_XCNT(j)]); sum += c; cnt += (c > 0u) ? 1u : 0u; mine = (j == x) ? c : mine; }
    if (sum == G) break;
    __builtin_amdgcn_s_sleep(1);
    if ((++sp & 255u) == 0u) { if (xb_ld(&bar[XB_TMO])) break; if (sp > XB_SPIN_CAP) { atomicAdd(&bar[XB_TMO], 1u); break; } }
  }
  nloc = mine > 0u ? mine : 1u; nx = cnt > 0u ? cnt : 1u;
}
DEVI void xcd_barrier(const XcdBarrier& b) {
  asm volatile("s_waitcnt vmcnt(0)" ::: "memory");
  __syncthreads();
  if (threadIdx.x == 0) {
    unsigned* bar = b.bar;
    __builtin_amdgcn_s_waitcnt(0);
    unsigned nloc = b.st[0], nx = b.st[1];
    if (nloc == 0u) { xcd_barrier_complete(bar, b.x, nloc, nx); b.st[0] = nloc; b.st[1] = nx; }
    const unsigned old = xb_add(&bar[XB_XSUB(b.x)], 1u);
    const unsigned gen = old / nloc;
    if (old + 1u == (gen + 1u) * nloc) {
      __builtin_amdgcn_fence(__ATOMIC_RELEASE, "agent");
      asm volatile("s_waitcnt vmcnt(0)" ::: "memory");
      const unsigned og = xb_add(&bar[XB_TOP], 1u);
      const unsigned tg = og / nx;
      if (og + 1u == (tg + 1u) * nx) xb_add(&bar[XB_TOPGEN], 1u);
      else XB_SPIN(xb_ld(&bar[XB_TOPGEN]) == tg, bar);
      __builtin_amdgcn_fence(__ATOMIC_ACQUIRE, "agent");
      xb_add(&bar[XB_XGEN(b.x)], 1u);
      asm volatile("s_waitcnt vmcnt(0)" ::: "memory");
    } else {
      XB_SPIN(xb_ld(&bar[XB_XGEN(b.x)]) == gen, bar);
      __builtin_amdgcn_fence(__ATOMIC_ACQUIRE, "agent");
      asm volatile("s_waitcnt vmcnt(0)" ::: "memory");
    }
  }
  __syncthreads();
}

template <bool COOP>
__global__ void __launch_bounds__(256, 2) mega(Params p, int ph_lo, int ph_hi) {
  __shared__ __attribute__((aligned(16))) unsigned char smem[SMEM_BYTES];
  __shared__ uint4 xb_words;
  if (threadIdx.x == 0) xb_words = make_uint4(0u, 0u, 0u, 0u);
  __syncthreads();
  XcdBarrier xb = xcd_barrier_post(p.bar, (volatile LAS unsigned*)&xb_words);
  (void)xb;
  if (COOP && ph_hi > 1000) cg::this_grid().sync();
#ifdef REPEAT_MASK
#define RUN_PHASE(i, call)                                                                   \
  if (ph_lo <= (i) && (i) <= ph_hi) {                                                        \
    call;                                                                                    \
    if (COOP && ((REPEAT_MASK >> (i)) & 1)) { xcd_barrier(xb); call; }                       \
    if (COOP && (i) < ph_hi) xcd_barrier(xb);                                                \
  }
#else
#define RUN_PHASE(i, call)                                                                   \
  if (ph_lo <= (i) && (i) <= ph_hi) {                                                        \
    call;                                                                                    \
    if (COOP && (i) < ph_hi) {                                                               \
      xcd_barrier(xb);                                                                       \
    }                                                                                        \
  }
#endif
  RUN_PHASE(0, phase0(p))
  RUN_PHASE(1, phase1(p, smem))
  RUN_PHASE(2, phase2(p, smem))
  RUN_PHASE(4, phase_nsa(p, smem))
  RUN_PHASE(5, phase_resid<false>(p, smem, p.mix, p.woutT, p.x, p.ssq1))
  RUN_PHASE(6, phase_scaled(p, smem, p.hn, p.wmqT, 8, p.ssq1, p.qm, LDA))
  RUN_PHASE(7, phase_memattn(p, smem))
  RUN_PHASE(8, phase_resid<true>(p, smem, p.mix, p.wmoT, nullptr, p.ssq2))
  RUN_PHASE(9, phase_scaled(p, smem, p.hn, p.wpqT, 16, p.ssq2, p.pq, LDPQ))
  RUN_PHASE(10, phase_peer_route(p, smem))
  RUN_PHASE(11, phase_peer_gather<0>(p, smem))
  RUN_PHASE(12, phase_peer_gather<1>(p, smem))
#undef RUN_PHASE
}

extern "C" void kernel_launch(void* const* d_in, const int* in_sizes, int n_in, void* d_out, int out_size, void* d_ws,
                              size_t ws_size, hipStream_t stream) {
  (void)in_sizes; (void)n_in; (void)out_size; (void)ws_size;
  Params p{};
  p.x = (const float*)d_in[0]; p.mem = (const float*)d_in[1]; p.pos = (const int*)d_in[2];
  p.mix_g = (const float*)d_in[3]; p.w_in = (const float*)d_in[4]; p.conv_w = (const float*)d_in[5];
  p.conv_b = (const float*)d_in[6]; p.ln_g = (const float*)d_in[7]; p.ln_b = (const float*)d_in[8];
  p.cmp_pos = (const float*)d_in[9]; p.cmp_w1 = (const float*)d_in[10]; p.cmp_b1 = (const float*)d_in[11];
  p.cmp_w2 = (const float*)d_in[12]; p.cmp_b2 = (const float*)d_in[13]; p.w_out = (const float*)d_in[14];
  p.memq_g = (const float*)d_in[15]; p.memkv_g = (const float*)d_in[16]; p.w_mq = (const float*)d_in[17];
  p.w_mk = (const float*)d_in[18]; p.w_mv = (const float*)d_in[19]; p.w_mo = (const float*)d_in[20];
  p.peer_g = (const float*)d_in[21]; p.peer_wq = (const float*)d_in[22]; p.peer_sk = (const float*)d_in[23];
  p.peer_u = (const float*)d_in[24]; p.peer_v = (const float*)d_in[25]; p.final_g = (const float*)d_in[26];
  p.out = (float*)d_out;
  unsigned char* ws = (unsigned char*)d_ws;
  size_t off = 0;
  auto take = [&](size_t bytes) { unsigned char* r = ws + off; off += (bytes + 255) & ~(size_t)255; return r; };
  unsigned char* regA = take((size_t)NTOK * LDA * 2);
  unsigned char* regB = take((size_t)NTOK * LDP * 2);
  unsigned char* regC = take((size_t)NTOK * LDA * 2);
  p.hn = (u16*)regA;
  p.proj = (u16*)regB; p.qm = (u16*)regB; p.pq = (u16*)regB;
  p.mix = (u16*)regC; p.experts = (int*)regC; p.gates = (float*)(regC + (size_t)NTOK * 128 * 4);
  {
    unsigned char* tb = regC + (size_t)2 * NTOK * 128 * 4;
    p.ub8 = tb; p.vb8 = tb + (size_t)16384 * 1024;
    p.uscale = (float*)(tb + (size_t)2 * 16384 * 1024); p.vscale = p.uscale + 16384;
  }
  p.h = nullptr;
  p.vts = (u16*)take((size_t)Bn * 2 * 64 * LDT * 2);
  p.vtw = (u16*)take((size_t)Bn * 2 * 64 * LDT * 2);
  p.memn = (u16*)take((size_t)Bn * 256 * LDA * 2);
  p.memk = (u16*)take((size_t)Bn * 256 * LDA * 2);
  p.memvt = (u16*)take((size_t)Bn * 256 * D * 2);
  p.winT = (u16*)take((size_t)2432 * LDA * 2);
  p.woutT = (u16*)take((size_t)1024 * LDA * 2);
  p.wmqT = (u16*)take((size_t)1024 * LDA * 2);
  p.wmkT = (u16*)take((size_t)1024 * LDA * 2);
  p.wmvT = (u16*)take((size_t)1024 * LDA * 2);
  p.wmoT = (u16*)take((size_t)1024 * LDA * 2);
  p.wpqT = (u16*)take((size_t)2048 * LDA * 2);
  p.subk = (u16*)take((size_t)16 * 128 * 128 * 2);
  p.w1T = (u16*)take((size_t)2 * 128 * LDW1 * 2);
  p.w2T = (u16*)take((size_t)2 * 128 * 128 * 2);
  p.biasp = (float*)take(256 * 4);
  p.rope = (float*)take((size_t)NTOK * 16 * 4);
  p.hdn = (u16*)take((size_t)2 * 4096 * 128 * 2);
  p.kc = (u16*)take((size_t)Bn * 2 * 128 * 64 * 2);
  p.vcT = (u16*)take((size_t)Bn * 2 * 64 * 128 * 2);
  p.ssq1 = (float*)take((size_t)NTOK * 4);
  p.ssq2 = (float*)take((size_t)NTOK * 4);
  p.bar = (unsigned*)take(16384);
  if (off > ws_size) { fprintf(stderr, "workspace too small: need %zu have %zu\n", off, ws_size); return; }

#if COOP_MODE
  static int grid_blocks = 0;
  if (!grid_blocks) {
    int dev = 0, cus = 0, per_cu = 0;
    hipGetDevice(&dev);
    hipDeviceGetAttribute(&cus, hipDeviceAttributeMultiprocessorCount, dev);
    hipOccupancyMaxActiveBlocksPerMultiprocessor(&per_cu, mega<true>, 256, 0);
    if (per_cu > 2) per_cu = 2;
    if (per_cu < 1) per_cu = 1;
    grid_blocks = cus * per_cu;
  }
  int lo = 0, hi = NPHASE;
  void* args[] = {&p, &lo, &hi};
  (void)hipMemsetAsync(p.bar, 0, 16384, stream);
  hipError_t e = hipLaunchCooperativeKernel((void*)mega<true>, dim3(grid_blocks), dim3(256), args, 0, stream);
  if (e != hipSuccess) fprintf(stderr, "cooperative launch failed: %s (grid %d)\n", hipGetErrorString(e), grid_blocks);
#else
  for (int ph = 0; ph <= NPHASE; ++ph) mega<false><<<dim3(512), dim3(256), 0, stream>>>(p, ph, ph);
#endif
}
```

```cpp
#include <hip/hip_runtime.h>
#include <hip/hip_bf16.h>
#include <hip/hip_cooperative_groups.h>
#include <cstdio>
#include <cstdint>
namespace cg = cooperative_groups;

#ifndef COOP_MODE
#define COOP_MODE 1
#endif

typedef __attribute__((ext_vector_type(8))) short bf16x8;
typedef __attribute__((ext_vector_type(4))) short bf16x4;
typedef __attribute__((ext_vector_type(4))) float f32x4;
typedef unsigned short u16;

#define DEVI __device__ __forceinline__

constexpr int Bn = 16, T = 2048, D = 1024, NTOK = Bn * T, LDP = 2336;
constexpr int C_Q = 1024, C_KC = 1536, C_VC = 1664, C_KS = 1792, C_VS = 1920, C_KW = 2048, C_VW = 2176, C_GATE = 2304;
constexpr int SMEM_BYTES = 73728;
constexpr int LDA = 1088;
constexpr int LDHF = 1056;
constexpr int LDPQ = 2112;
constexpr int LDW1 = 2112;
constexpr int LDT = 2112;
constexpr int NPHASE = 12;

struct Params {
  const float* x; const float* mem; const int* pos; const float* mix_g; const float* w_in;
  const float* conv_w; const float* conv_b; const float* ln_g; const float* ln_b;
  const float* cmp_pos; const float* cmp_w1; const float* cmp_b1; const float* cmp_w2; const float* cmp_b2;
  const float* w_out; const float* memq_g; const float* memkv_g; const float* w_mq; const float* w_mk;
  const float* w_mv; const float* w_mo; const float* peer_g; const float* peer_wq; const float* peer_sk;
  const float* peer_u; const float* peer_v; const float* final_g;
  float* out;
  u16* hn; u16* proj; u16* mix; float* h; u16* vts; u16* vtw; u16* memn; u16* memk; u16* memvt;
  u16* winT; u16* woutT; u16* wmqT; u16* wmkT; u16* wmvT; u16* wmoT; u16* wpqT; u16* subk; u16* w1T; u16* w2T;
  float* biasp; float* rope; u16* hdn; u16* kc; u16* vcT; float* ssq1; float* ssq2;
  int* experts; float* gates; unsigned char* ub8; unsigned char* vb8; float* uscale; float* vscale; u16* qm; u16* pq;
  unsigned* bar;
};

DEVI int launder(int x) { asm volatile("" : "+v"(x)); return x; }
DEVI u16 f2bf(float f) {
  unsigned u = __float_as_uint(f);
  u += 0x7fffu + ((u >> 16) & 1u);
  return (u16)(u >> 16);
}
DEVI float bf2f(u16 h) { return __uint_as_float(((unsigned)h) << 16); }
DEVI unsigned pack2(float a, float b) { return (unsigned)f2bf(a) | ((unsigned)f2bf(b) << 16); }
DEVI float wave_sum(float v) {
#pragma unroll
  for (int o = 32; o; o >>= 1) v += __shfl_xor(v, o);
  return v;
}
DEVI float sigmoidf_(float x) { return __builtin_amdgcn_rcpf(1.f + __expf(-x)); }
DEVI float gelu_tanh(float x) {
  float u = 0.7978845608028654f * (x + 0.044715f * x * x * x);
  return 0.5f * x * (1.f + tanhf(u));
}
DEVI f32x4 mfma16(bf16x8 a, bf16x8 b, f32x4 c) { return __builtin_amdgcn_mfma_f32_16x16x32_bf16(a, b, c, 0, 0, 0); }
DEVI float fexp2(float x) { return __builtin_amdgcn_exp2f(x); }

DEVI void tconv(const float* __restrict__ src, int K, int N, u16* __restrict__ dst, int Npad, int ldd,
                const float* __restrict__ gain, int gtid, int gsz) {
  const int items = Npad * (K >> 3);
  for (int it = gtid; it < items; it += gsz) {
    const int n = it % Npad, kc = it / Npad;
    float f[8];
#pragma unroll
    for (int j = 0; j < 8; ++j) {
      float v = 0.f;
      if (n < N) {
        v = src[(size_t)(kc * 8 + j) * N + n];
        if (gain) v *= gain[kc * 8 + j];
      }
      f[j] = v;
    }
    uint4 pk;
    pk.x = pack2(f[0], f[1]); pk.y = pack2(f[2], f[3]); pk.z = pack2(f[4], f[5]); pk.w = pack2(f[6], f[7]);
    *(uint4*)(dst + (size_t)n * ldd + kc * 8) = pk;
  }
}

DEVI void conv_flat(const float* __restrict__ src, u16* __restrict__ dst, size_t n8, size_t gtid, size_t gsz) {
  for (size_t it = gtid; it < n8; it += gsz) {
    const float4 a = ((const float4*)src)[2 * it], b = ((const float4*)src)[2 * it + 1];
    uint4 pk;
    pk.x = pack2(a.x, a.y); pk.y = pack2(a.z, a.w); pk.z = pack2(b.x, b.y); pk.w = pack2(b.z, b.w);
    ((uint4*)dst)[it] = pk;
  }
}


typedef float f32x2 __attribute__((ext_vector_type(2)));
DEVI unsigned pk4_fp8(float a, float b, float c, float d) {
  int v = 0;
  v = __builtin_amdgcn_cvt_pk_fp8_f32(a, b, v, false);
  v = __builtin_amdgcn_cvt_pk_fp8_f32(c, d, v, true);
  return (unsigned)v;
}
DEVI void conv_fp8_rows(const float* __restrict__ src, unsigned char* __restrict__ dst, float* __restrict__ inv_scale,
                        int rows, int gw, int nw, int lane) {
  for (int r0 = gw; r0 < rows; r0 += 2 * nw) {
    const int r1 = r0 + nw;
    const bool has1 = r1 < rows;
    const float4* p0 = (const float4*)(src + (size_t)r0 * 1024) + lane * 4;
    const float4* p1 = (const float4*)(src + (size_t)(has1 ? r1 : r0) * 1024) + lane * 4;
    float4 v[2][4];
#pragma unroll
    for (int i = 0; i < 4; ++i) { v[0][i] = p0[i]; v[1][i] = p1[i]; }
    float mx[2];
#pragma unroll
    for (int q = 0; q < 2; ++q) {
      float m = 0.f;
#pragma unroll
      for (int i = 0; i < 4; ++i)
        m = fmaxf(m, fmaxf(fmaxf(fabsf(v[q][i].x), fabsf(v[q][i].y)), fmaxf(fabsf(v[q][i].z), fabsf(v[q][i].w))));
      mx[q] = m;
    }
#pragma unroll
    for (int o = 32; o; o >>= 1) { mx[0] = fmaxf(mx[0], __shfl_xor(mx[0], o)); mx[1] = fmaxf(mx[1], __shfl_xor(mx[1], o)); }
#pragma unroll
    for (int q = 0; q < 2; ++q) {
      if (q == 1 && !has1) break;
      const int r = q ? r1 : r0;
      const float sc = mx[q] > 0.f ? 224.f / mx[q] : 1.f;
      if (lane == 0) inv_scale[r] = mx[q] > 0.f ? mx[q] * (1.f / 224.f) : 1.f;
      uint4 o4;
      o4.x = pk4_fp8(v[q][0].x * sc, v[q][0].y * sc, v[q][0].z * sc, v[q][0].w * sc);
      o4.y = pk4_fp8(v[q][1].x * sc, v[q][1].y * sc, v[q][1].z * sc, v[q][1].w * sc);
      o4.z = pk4_fp8(v[q][2].x * sc, v[q][2].y * sc, v[q][2].z * sc, v[q][2].w * sc);
      o4.w = pk4_fp8(v[q][3].x * sc, v[q][3].y * sc, v[q][3].z * sc, v[q][3].w * sc);
      ((uint4*)(dst + (size_t)r * 1024))[lane] = o4;
    }
  }
}

DEVI void rownorm_bf16(const float* __restrict__ src, const float* __restrict__ g, u16* __restrict__ dst,
                       int rows, int gw, int nw, int lane) {
  for (int r0 = gw; r0 < rows; r0 += 2 * nw) {
    const int r1 = r0 + nw;
    const bool has1 = r1 < rows;
    const float4* pa = (const float4*)(src + (size_t)r0 * D);
    const float4* pb = (const float4*)(src + (size_t)(has1 ? r1 : r0) * D);
    float4 va[4], vb[4];
    float sa = 0.f, sb = 0.f;
#pragma unroll
    for (int i = 0; i < 4; ++i) { va[i] = pa[lane + 64 * i]; vb[i] = pb[lane + 64 * i]; }
#pragma unroll
    for (int i = 0; i < 4; ++i) {
      sa += va[i].x * va[i].x + va[i].y * va[i].y + va[i].z * va[i].z + va[i].w * va[i].w;
      sb += vb[i].x * vb[i].x + vb[i].y * vb[i].y + vb[i].z * vb[i].z + vb[i].w * vb[i].w;
    }
#pragma unroll
    for (int o = 32; o; o >>= 1) { sa += __shfl_xor(sa, o); sb += __shfl_xor(sb, o); }
    const float ra = rsqrtf(sa * (1.f / D) + 1e-6f), rb = rsqrtf(sb * (1.f / D) + 1e-6f);
#pragma unroll
    for (int i = 0; i < 4; ++i) {
      const float4 gg = ((const float4*)g)[lane + 64 * i];
      uint2 pk;
      pk.x = pack2(va[i].x * ra * gg.x, va[i].y * ra * gg.y);
      pk.y = pack2(va[i].z * ra * gg.z, va[i].w * ra * gg.w);
      *(uint2*)(dst + (size_t)r0 * LDA + (size_t)(lane + 64 * i) * 4) = pk;
      if (has1) {
        pk.x = pack2(vb[i].x * rb * gg.x, vb[i].y * rb * gg.y);
        pk.y = pack2(vb[i].z * rb * gg.z, vb[i].w * rb * gg.w);
        *(uint2*)(dst + (size_t)r1 * LDA + (size_t)(lane + 64 * i) * 4) = pk;
      }
    }
  }
}

DEVI void phase0(const Params& p) {
  const int tid = launder(threadIdx.x), lane = tid & 63;
  const int gtid = blockIdx.x * 256 + tid, gsz = gridDim.x * 256;
  const int gw = gtid >> 6, nw = gsz >> 6;
  rownorm_bf16(p.x, p.mix_g, p.hn, NTOK, gw, nw, lane);
  rownorm_bf16(p.mem, p.memkv_g, p.memn, Bn * 256, gw, nw, lane);
  tconv(p.w_in, 1024, 2328, p.winT, 2432, LDA, nullptr, gtid, gsz);
  tconv(p.w_out, 1024, 1024, p.woutT, 1024, LDA, nullptr, gtid, gsz);
  tconv(p.w_mq, 1024, 1024, p.wmqT, 1024, LDA, p.memq_g, gtid, gsz);
  tconv(p.w_mk, 1024, 1024, p.wmkT, 1024, LDA, nullptr, gtid, gsz);
  tconv(p.w_mv, 1024, 1024, p.wmvT, 1024, LDA, nullptr, gtid, gsz);
  tconv(p.w_mo, 1024, 1024, p.wmoT, 1024, LDA, nullptr, gtid, gsz);
  tconv(p.peer_wq, 1024, 2048, p.wpqT, 2048, LDA, p.peer_g, gtid, gsz);
  tconv(p.cmp_w1, 2048, 128, p.w1T, 128, LDW1, nullptr, gtid, gsz);
  tconv(p.cmp_w1 + 2048 * 128, 2048, 128, p.w1T + 128 * LDW1, 128, LDW1, nullptr, gtid, gsz);
  tconv(p.cmp_w2, 128, 64, p.w2T, 128, 128, nullptr, gtid, gsz);
  tconv(p.cmp_w2 + 128 * 64, 128, 64, p.w2T + 128 * 128, 128, 128, nullptr, gtid, gsz);
  conv_flat(p.peer_sk, p.subk, (size_t)16 * 128 * 128 / 8, gtid, gsz);
  for (int it = gtid; it < NTOK * 8; it += gsz) {
    const int tok = it >> 3, i = it & 7;
    const float inv = (i == 0) ? 1.000000000e+00f : (i == 1) ? 1.939227432e-01f : (i == 2) ? 3.760603070e-02f : (i == 3) ? 7.292664610e-03f : (i == 4) ? 1.414213562e-03f : (i == 5) ? 2.742481884e-04f : (i == 6) ? 5.318295734e-05f : 1.031338525e-05f;
    const float ang = (float)p.pos[tok] * inv;
    float sv, cv;
    sincosf(ang, &sv, &cv);
    p.rope[tok * 16 + i] = cv;
    p.rope[tok * 16 + 8 + i] = sv;
  }
  for (int o = gw; o < 256; o += nw) {
    const int ty = o >> 7, n = o & 127;
    float s = 0.f;
#pragma unroll 8
    for (int k = lane; k < 2048; k += 64)
      s += p.cmp_pos[ty * 2048 + k] * p.cmp_w1[((size_t)ty * 2048 + k) * 128 + n];
    s = wave_sum(s);
    if (lane == 0) p.biasp[o] = s + p.cmp_b1[o];
  }
  for (int it = gtid; it < NTOK; it += gsz) { p.ssq1[it] = 0.f; p.ssq2[it] = 0.f; }
}

template <bool DB, class AF>
DEVI void gemm_mainloop(int tid, u16* sA, u16* sB, AF af, const u16* __restrict__ Bt, int ldb, int m0, int n0, int nk,
                        f32x4 (&acc)[4][4]) {
  const int lane = tid & 63, w = tid >> 6;
  const int wm = w >> 1, wn = w & 1, col = lane & 15, quad = lane >> 4;
#pragma unroll
  for (int i = 0; i < 4; ++i)
#pragma unroll
    for (int j = 0; j < 4; ++j) acc[i][j] = f32x4{0.f, 0.f, 0.f, 0.f};
  uint4 ra0, ra1, ra2, ra3, rb0, rb1, rb2, rb3;
  const int lrow = tid >> 3, lkc = (tid & 7) << 3;
  const u16* bbase = Bt + (size_t)(n0 + lrow) * ldb + lkc;
#define GL_(R, i, kk)                                                     \
  R##a##i = *(const uint4*)af(m0 + lrow + 32 * i, (kk) + lkc);            \
  R##b##i = *(const uint4*)(bbase + (size_t)(32 * i) * ldb + (kk));
#define SS_(R, i, off)                                                    \
  *(uint4*)(sA + (off) + (lrow + 32 * i) * 72 + lkc) = R##a##i;           \
  *(uint4*)(sB + (off) + (lrow + 32 * i) * 72 + lkc) = R##b##i;
#define GL4_(R, kk) GL_(R, 0, kk) GL_(R, 1, kk) GL_(R, 2, kk) GL_(R, 3, kk)
#define SS4_(R, off) SS_(R, 0, off) SS_(R, 1, off) SS_(R, 2, off) SS_(R, 3, off)
#define COMPUTE_(cur)                                                                                                   \
  _Pragma("unroll") for (int ks = 0; ks < 2; ++ks) {                                                                    \
    bf16x8 fa[4], fb[4];                                                                                                \
    _Pragma("unroll") for (int mi = 0; mi < 4; ++mi)                                                                    \
      fa[mi] = *(const bf16x8*)(sA + (cur) + (wm * 64 + 16 * mi + col) * 72 + 32 * ks + 8 * quad);                      \
    _Pragma("unroll") for (int ni = 0; ni < 4; ++ni)                                                                    \
      fb[ni] = *(const bf16x8*)(sB + (cur) + (wn * 64 + 16 * ni + col) * 72 + 32 * ks + 8 * quad);                      \
    _Pragma("unroll") for (int ni = 0; ni < 4; ++ni)                                                                    \
      _Pragma("unroll") for (int mi = 0; mi < 4; ++mi) acc[ni][mi] = mfma16(fb[ni], fa[mi], acc[ni][mi]);               \
  }
  if (DB) {
    const int srow = 8 * w + (lane >> 3);
    const int spc = lane & 7;
#define STAGE_(st, kk)                                                                                         \
    _Pragma("unroll") for (int i = 0; i < 4; ++i) {                                                            \
      const int r_ = 32 * i + srow;                                                                            \
      const int c_ = (spc ^ ((r_ >> 1) & 7)) << 3;                                                             \
      __builtin_amdgcn_global_load_lds((const unsigned*)af(m0 + r_, (kk) + c_),                                \
                                       (unsigned*)(sA + (st) * 16384 + (32 * i + 8 * w) * 64), 16, 0, 0);      \
      __builtin_amdgcn_global_load_lds((const unsigned*)(Bt + (size_t)(n0 + r_) * ldb + (kk) + c_),            \
                                       (unsigned*)(sA + (st) * 16384 + 8192 + (32 * i + 8 * w) * 64), 16, 0, 0); \
    }
#define COMPUTE_SW_(st)                                                                                                 \
  _Pragma("unroll") for (int ks = 0; ks < 2; ++ks) {                                                                    \
    bf16x8 fa[4], fb[4];                                                                                                \
    const int pc_ = ((4 * ks + quad) ^ ((col >> 1) & 7)) << 3;                                                          \
    _Pragma("unroll") for (int mi = 0; mi < 4; ++mi)                                                                    \
      fa[mi] = *(const bf16x8*)(sA + (st) * 16384 + (wm * 64 + 16 * mi + col) * 64 + pc_);                              \
    _Pragma("unroll") for (int ni = 0; ni < 4; ++ni)                                                                    \
      fb[ni] = *(const bf16x8*)(sA + (st) * 16384 + 8192 + (wn * 64 + 16 * ni + col) * 64 + pc_);                       \
    __builtin_amdgcn_s_setprio(1);                                                                                      \
    _Pragma("unroll") for (int ni = 0; ni < 4; ++ni)                                                                    \
      _Pragma("unroll") for (int mi = 0; mi < 4; ++mi) acc[ni][mi] = mfma16(fb[ni], fa[mi], acc[ni][mi]);               \
    __builtin_amdgcn_s_setprio(0);                                                                                      \
  }
    STAGE_(0, 0)
#pragma unroll 1
    for (int kt = 0; kt < nk; kt += 2) {
      asm volatile("s_waitcnt vmcnt(0)" ::: "memory");
      __syncthreads();
      { const int kk = (kt + 1) * 64; STAGE_(1, kk) }
      COMPUTE_SW_(0)
      asm volatile("s_waitcnt vmcnt(0)" ::: "memory");
      __syncthreads();
      if (kt + 2 < nk) { const int kk = (kt + 2) * 64; STAGE_(0, kk) }
      COMPUTE_SW_(1)
    }
#undef STAGE_
#undef COMPUTE_SW_
  } else {
    GL4_(r, 0)
    SS4_(r, 0)
    __syncthreads();
#pragma unroll 1
    for (int kt = 0; kt < nk; ++kt) {
      const bool more = (kt + 1 < nk);
      if (more) { const int kk = (kt + 1) * 64; GL4_(r, kk) }
      COMPUTE_(0)
      __syncthreads();
      if (more) {
        SS4_(r, 0)
        __syncthreads();
      }
    }
  }
#undef GL_
#undef SS_
#undef GL4_
#undef SS4_
#undef COMPUTE_
}

struct ARow {
  const u16* base; int lda;
  DEVI const u16* operator()(int m, int k) const { return base + (size_t)m * lda + k; }
};
struct ACmp {
  const u16* proj; int colbase;
  DEVI const u16* operator()(int rr, int k) const {
    const int b = rr >> 8, g = (rr >> 7) & 1;
    int c = rr & 127; c = c > 126 ? 126 : c;
    const int l = k >> 6, d = k & 63;
    return proj + ((size_t)b * T + 16 * c + l) * LDP + colbase + g * 64 + d;
  }
};


#define XCD_TILE_LOOP(idx, MT, NT)                                                                     \
  const bool sw_ = (gridDim.x & 7) == 0;                                                               \
  const int xcd_ = blockIdx.x & 7;                                                                     \
  const int tstart_ = sw_ ? (int)(blockIdx.x >> 3) : (int)blockIdx.x;                                  \
  const int tstep_ = sw_ ? (int)(gridDim.x >> 3) : (int)gridDim.x;                                     \
  const int ttotal_ = sw_ ? ((MT) / 8) * (NT) : (MT) * (NT);                                           \
  _Pragma("unroll 1") for (int idx = tstart_; idx < ttotal_; idx += tstep_)
#define XCD_TILE_MT(idx, NT) (sw_ ? ((idx) / (NT)) * 8 + xcd_ : (idx) / (NT))
#define XCD_TILE_NT(idx, NT) ((idx) % (NT))

#define GEMM_LANE_VARS                                                    \
  const int tid = launder(threadIdx.x), lane = tid & 63, w = tid >> 6;    \
  const int wm = w >> 1, wn = w & 1, col = lane & 15, quad = lane >> 4;   \
  (void)wm; (void)wn; (void)col; (void)quad;

DEVI void phase1(const Params& p, unsigned char* smem) {
  u16* sA = (u16*)smem; u16* sB = sA + 128 * 72;
  XCD_TILE_LOOP(idx, 256 + 32, 19) {
    GEMM_LANE_VARS
    f32x4 acc[4][4];
    int mt, nt_;
    if (sw_) {
      const int g_ = idx / 152, r_ = idx - g_ * 152, gs_ = (g_ < 4) ? 8 : 4;
      nt_ = r_ / gs_;
      mt = (g_ * 8 + (r_ - nt_ * gs_)) * 8 + xcd_;
    } else {
      mt = idx / 19; nt_ = idx % 19;
    }
    if (mt < 256) {
      const int m0 = mt * 128, n0 = nt_ * 128;
      gemm_mainloop<true>(tid, sA, sB, ARow{p.hn, LDA}, p.winT, LDA, m0, n0, 16, acc);
#pragma unroll
      for (int mi = 0; mi < 4; ++mi) {
        const int m = m0 + wm * 64 + 16 * mi + col;
        const int b = m >> 11, t = m & 2047;
#pragma unroll
        for (int ni = 0; ni < 4; ++ni) {
          const int nt = n0 + wn * 64 + 16 * ni;
          const int n = nt + 4 * quad;
          f32x4 v = acc[ni][mi];
          if (nt >= LDP) continue;
          if ((nt >= C_VS && nt < C_KW) || (nt >= C_VW && nt < C_GATE)) {
            const bool isw = nt >= C_VW;
            const int off = n - (isw ? C_VW : C_VS);
            const int g = off >> 6, d = off & 63;
            u16* dst = (isw ? p.vtw : p.vts) + ((size_t)(b * 2 + g) * 64 + d) * LDT + t;
#pragma unroll
            for (int r = 0; r < 4; ++r) dst[(size_t)r * LDT] = f2bf(v[r]);
          } else {
            const bool rope_tile = ((nt >= C_KS && nt < C_VS) || (nt >= C_KW && nt < C_VW)) && ((nt & 63) == 0);
            if (rope_tile) {
#pragma unroll
              for (int r = 0; r < 4; ++r) {
                const float pr = __shfl_xor(v[r], 32);
                const int i = ((quad & 1) << 2) + r;
                const float cs = p.rope[(size_t)m * 16 + i], sn = p.rope[(size_t)m * 16 + 8 + i];
                v[r] = (quad < 2) ? (v[r] * cs - pr * sn) : (v[r] * cs + pr * sn);
              }
            }
            uint2 pk; pk.x = pack2(v[0], v[1]); pk.y = pack2(v[2], v[3]);
            *(uint2*)(p.proj + (size_t)m * LDP + n) = pk;
          }
        }
      }
    } else if (nt_ < 16) {
      const int isv = nt_ >> 3;
      const int m0 = (mt - 256) * 128, n0 = (nt_ & 7) * 128;
      gemm_mainloop<true>(tid, sA, sB, ARow{p.memn, LDA}, isv ? p.wmvT : p.wmkT, LDA, m0, n0, 16, acc);
#pragma unroll
      for (int mi = 0; mi < 4; ++mi) {
        const int m = m0 + wm * 64 + 16 * mi + col;
        const int b = m >> 8, key = m & 255;
#pragma unroll
        for (int ni = 0; ni < 4; ++ni) {
          const int n = n0 + wn * 64 + 16 * ni + 4 * quad;
          const f32x4 v = acc[ni][mi];
          if (isv) {
            const int head = n >> 8, d = n & 255;
            u16* dst = p.memvt + ((size_t)(b * 4 + head) * 256 + d) * 256 + key;
#pragma unroll
            for (int r = 0; r < 4; ++r) dst[r * 256] = f2bf(v[r]);
          } else {
            uint2 pk; pk.x = pack2(v[0], v[1]); pk.y = pack2(v[2], v[3]);
            *(uint2*)(p.memk + (size_t)m * LDA + n) = pk;
          }
        }
      }
    }
  }
}

DEVI void conv_tile(const Params& p, unsigned char* smem, int ct) {
  u16* sU = (u16*)smem;
  float2* sRed = (float2*)(smem + 62 * 512 * 2);
  const int tid = launder(threadIdx.x), lane = tid & 63, w = tid >> 6;
  const int b = ct >> 6, t0 = (ct & 63) * 32;
  __syncthreads();
  for (int it = tid; it < 62 * 64; it += 256) {
    const int r = it >> 6, c8 = it & 63;
    const int t = t0 - 30 + r;
    uint4 pk = {0u, 0u, 0u, 0u};
    if (t >= 0) {
      const u16* src = p.proj + ((size_t)b * T + t) * LDP + c8 * 8;
      const uint4 a = *(const uint4*)src, bb = *(const uint4*)(src + 512);
      const unsigned au[4] = {a.x, a.y, a.z, a.w}, bu[4] = {bb.x, bb.y, bb.z, bb.w};
      unsigned o[4];
#pragma unroll
      for (int j = 0; j < 4; ++j) {
        const float a0 = __uint_as_float(au[j] << 16), a1 = __uint_as_float(au[j] & 0xffff0000u);
        const float b0 = __uint_as_float(bu[j] << 16), b1 = __uint_as_float(bu[j] & 0xffff0000u);
        o[j] = pack2(a0 * sigmoidf_(b0), a1 * sigmoidf_(b1));
      }
      pk.x = o[0]; pk.y = o[1]; pk.z = o[2]; pk.w = o[3];
    }
    *(uint4*)(sU + r * 512 + c8 * 8) = pk;
  }
  const int c = 2 * tid;
  float w0[31], w1[31];
#pragma unroll
  for (int j = 0; j < 31; ++j) { w0[j] = p.conv_w[j * 512 + c]; w1[j] = p.conv_w[j * 512 + c + 1]; }
  const float bd0 = p.conv_b[c], bd1 = p.conv_b[c + 1];
  __syncthreads();
  float ya[32], yb[32];
#pragma unroll
  for (int tt = 0; tt < 32; ++tt) {
    float y0 = bd0, y1 = bd1;
#pragma unroll
    for (int j = 0; j < 31; ++j) {
      const unsigned uu = *(const unsigned*)(sU + (tt + j) * 512 + c);
      y0 += w0[j] * __uint_as_float(uu << 16);
      y1 += w1[j] * __uint_as_float(uu & 0xffff0000u);
    }
    ya[tt] = y0; yb[tt] = y1;
    float s = y0 + y1, q = y0 * y0 + y1 * y1;
    s = wave_sum(s); q = wave_sum(q);
    if (lane == 0) sRed[tt * 4 + w] = make_float2(s, q);
  }
  __syncthreads();
  const float g0 = p.ln_g[c], g1 = p.ln_g[c + 1], lb0 = p.ln_b[c], lb1 = p.ln_b[c + 1];
#pragma unroll
  for (int tt = 0; tt < 32; ++tt) {
    const float y0 = ya[tt], y1 = yb[tt];
    const float2 r0 = sRed[tt * 4 + 0], r1 = sRed[tt * 4 + 1], r2 = sRed[tt * 4 + 2], r3 = sRed[tt * 4 + 3];
    const float S = r0.x + r1.x + r2.x + r3.x, Q = r0.y + r1.y + r2.y + r3.y;
    const float mu = S * (1.f / 512.f);
    const float var = fmaxf(Q * (1.f / 512.f) - mu * mu, 0.f);
    const float rstd = rsqrtf(var + 1e-6f);
    const float z0 = (y0 - mu) * rstd * g0 + lb0, z1 = (y1 - mu) * rstd * g1 + lb1;
    const float o0 = z0 * sigmoidf_(z0), o1 = z1 * sigmoidf_(z1);
    *(unsigned*)(p.mix + ((size_t)b * T + t0 + tt) * LDA + c) = pack2(o0, o1);
  }
}

DEVI void compress2_tile(const Params& p, unsigned char* smem, int tile);
DEVI void phase2(const Params& p, unsigned char* smem) {
  u16* sA = (u16*)smem; u16* sB = sA + 128 * 72;
#pragma unroll 1
  for (int tile = blockIdx.x; tile < 64 + 1024; tile += gridDim.x) {
    GEMM_LANE_VARS
    if (tile < 64) {
      const int ty = tile >> 5, mt = tile & 31;
      const int m0 = mt * 128;
      f32x4 acc[4][4];
      gemm_mainloop<true>(tid, sA, sB, ACmp{p.proj, ty ? C_VC : C_KC}, p.w1T + (size_t)ty * 128 * LDW1, LDW1, m0, 0, 32, acc);
#pragma unroll
      for (int mi = 0; mi < 4; ++mi) {
        const int m = m0 + wm * 64 + 16 * mi + col;
#pragma unroll
        for (int ni = 0; ni < 4; ++ni) {
          const int n = wn * 64 + 16 * ni + 4 * quad;
          const f32x4 v = acc[ni][mi];
          const float4 bb = *(const float4*)(p.biasp + ty * 128 + n);
          uint2 pk;
          pk.x = pack2(gelu_tanh(v[0] + bb.x), gelu_tanh(v[1] + bb.y));
          pk.y = pack2(gelu_tanh(v[2] + bb.z), gelu_tanh(v[3] + bb.w));
          *(uint2*)(p.hdn + ((size_t)ty * 4096 + m) * 128 + n) = pk;
        }
      }
      asm volatile("s_waitcnt vmcnt(0)" ::: "memory");
      __syncthreads();
      compress2_tile(p, smem, tile);
    } else {
      conv_tile(p, smem, tile - 64);
    }
  }
}

DEVI void compress2_tile(const Params& p, unsigned char* smem, int tile) {
  u16* sA = (u16*)smem; u16* sB = sA + 128 * 72;
  {
    GEMM_LANE_VARS
    const int ty = tile >> 5, mt = tile & 31;
    const int m0 = mt * 128;
    f32x4 acc[4][4];
    gemm_mainloop<true>(tid, sA, sB, ARow{p.hdn + (size_t)ty * 4096 * 128, 128}, p.w2T + (size_t)ty * 128 * 128, 128, m0, 0, 2, acc);
    if (wn == 0) {
#pragma unroll
      for (int mi = 0; mi < 4; ++mi) {
        const int m = m0 + 16 * mi + wm * 64 + col;
        const int bg = m >> 7, c = m & 127;
#pragma unroll
        for (int ni = 0; ni < 4; ++ni) {
          const int n = 16 * ni + 4 * quad;
          const f32x4 v = acc[ni][mi];
          const float4 bb = *(const float4*)(p.cmp_b2 + ty * 64 + n);
          const float o0 = v[0] + bb.x, o1 = v[1] + bb.y, o2 = v[2] + bb.z, o3 = v[3] + bb.w;
          if (ty == 0) {
            uint2 pk; pk.x = pack2(o0, o1); pk.y = pack2(o2, o3);
            *(uint2*)(p.kc + (size_t)m * 64 + n) = pk;
          } else {
            u16* dst = p.vcT + ((size_t)bg * 64 + n) * 128 + c;
            dst[0] = f2bf(o0); dst[128] = f2bf(o1); dst[256] = f2bf(o2); dst[384] = f2bf(o3);
          }
        }
      }
    }
  }
}

template <int DH, int NQ, int LDK, class MaskF>
DEVI void attn_qk(const u16* sK, const bf16x8 (&qf)[NQ][DH / 32], f32x4 (&o)[NQ][DH / 16], float (&m)[NQ], float (&l)[NQ],
                  float c2, int lane, MaskF valid, bf16x8 (&pb)[NQ][2]) {
  const int col = lane & 15, quad = lane >> 4;
  f32x4 s[NQ][4];
  __builtin_amdgcn_s_setprio(1);
#pragma unroll
  for (int kt = 0; kt < 4; ++kt) {
#pragma unroll
    for (int qt = 0; qt < NQ; ++qt) s[qt][kt] = f32x4{0.f, 0.f, 0.f, 0.f};
#pragma unroll
    for (int ks = 0; ks < DH / 32; ++ks) {
      const bf16x8 kf = *(const bf16x8*)(sK + (16 * kt + col) * LDK + 32 * ks + 8 * quad);
#pragma unroll
      for (int qt = 0; qt < NQ; ++qt) s[qt][kt] = mfma16(kf, qf[qt][ks], s[qt][kt]);
    }
  }
  __builtin_amdgcn_s_setprio(0);
#pragma unroll
  for (int qt = 0; qt < NQ; ++qt) {
    float mx = -1e30f;
#pragma unroll
    for (int kt = 0; kt < 4; ++kt)
#pragma unroll
      for (int r = 0; r < 4; ++r) {
        const bool v = valid(qt, 16 * kt + 4 * quad + r);
        const float sv = v ? s[qt][kt][r] : -1e30f;
        s[qt][kt][r] = sv;
        mx = fmaxf(mx, sv);
      }
    mx = fmaxf(mx, __shfl_xor(mx, 16));
    mx = fmaxf(mx, __shfl_xor(mx, 32));
    const float mn = fmaxf(m[qt], mx);
    const float alpha = fexp2((m[qt] - mn) * c2);
    m[qt] = mn;
    const float mc = fmaxf(mn, -1e20f) * c2;
    float ps = 0.f;
#pragma unroll
    for (int kt = 0; kt < 4; ++kt)
#pragma unroll
      for (int r = 0; r < 4; ++r) {
        const float pv = fexp2(__builtin_fmaf(s[qt][kt][r], c2, -mc));
        ps += pv;
        s[qt][kt][r] = pv;
      }
    l[qt] = l[qt] * alpha + ps;
#pragma unroll
    for (int dt = 0; dt < DH / 16; ++dt) o[qt][dt] *= alpha;
#pragma unroll
    for (int kk = 0; kk < 2; ++kk) {
      union { bf16x8 v; unsigned u[4]; } cv;
      cv.u[0] = pack2(s[qt][2 * kk][0], s[qt][2 * kk][1]);
      cv.u[1] = pack2(s[qt][2 * kk][2], s[qt][2 * kk][3]);
      cv.u[2] = pack2(s[qt][2 * kk + 1][0], s[qt][2 * kk + 1][1]);
      cv.u[3] = pack2(s[qt][2 * kk + 1][2], s[qt][2 * kk + 1][3]);
      pb[qt][kk] = cv.v;
    }
  }
}
template <int DH, int NQ, int LDV>
DEVI void attn_pv(const u16* sVt, const bf16x8 (&pb)[NQ][2], f32x4 (&o)[NQ][DH / 16], int lane) {
  const int col = lane & 15, quad = lane >> 4;
  __builtin_amdgcn_s_setprio(1);
#pragma unroll
  for (int dt = 0; dt < DH / 16; ++dt) {
#pragma unroll
    for (int kk = 0; kk < 2; ++kk) {
      union { bf16x8 v; uint2 h[2]; } cv;
      cv.h[0] = *(const uint2*)(sVt + (16 * dt + col) * LDV + 32 * kk + 4 * quad);
      cv.h[1] = *(const uint2*)(sVt + (16 * dt + col) * LDV + 32 * kk + 16 + 4 * quad);
#pragma unroll
      for (int qt = 0; qt < NQ; ++qt) o[qt][dt] = mfma16(cv.v, pb[qt][kk], o[qt][dt]);
    }
  }
  __builtin_amdgcn_s_setprio(0);
}
template <int DH, int NQ, int LDK, int LDV, class MaskF>
DEVI void attn_tile(const u16* sK, const u16* sVt, const bf16x8 (&qf)[NQ][DH / 32], f32x4 (&o)[NQ][DH / 16],
                    float (&m)[NQ], float (&l)[NQ], float c2, int lane, MaskF valid) {
  bf16x8 pb[NQ][2];
  attn_qk<DH, NQ, LDK>(sK, qf, o, m, l, c2, lane, valid, pb);
  attn_pv<DH, NQ, LDV>(sVt, pb, o, lane);
}

DEVI void phase_nsa(const Params& p, unsigned char* smem) {
  u16* sK = (u16*)smem;
  u16* sVt = (u16*)(smem + 18432);
  float* impH = (float*)(smem + 35840);
  float* impT = (float*)(smem + 52736);
  unsigned* selm = (unsigned*)(smem + 56960);
  const float c2 = 0.125f * 1.4426950408889634f;
#pragma unroll 1
  for (int tile = blockIdx.x; tile < 2048; tile += gridDim.x) {
    const int tid = launder(threadIdx.x), lane = tid & 63, w = tid >> 6, col = lane & 15, quad = lane >> 4;
    const int tj = tile >> 5, ti = tj & 15, tk = tj >> 4;
    const int qtile = (tk == 0) ? 63 - ti : (tk == 1) ? 32 + ti : (tk == 2) ? 31 - ti : ti;
    const int bg = tile & 31, b = bg >> 1, g = bg & 1, q0 = qtile * 32;
    const bool need_sel = (q0 + 31) >= 16 * 64;
    const int h = g * 4 + w;
    __syncthreads();
    if (tid < 32) selm[tid] = 0u;
    {
      const u16* kcp = p.kc + (size_t)bg * 128 * 64;
      const u16* vcp = p.vcT + (size_t)bg * 64 * 128;
#pragma unroll
      for (int i = 0; i < 4; ++i) {
        const int c = tid + 256 * i;
        const int row = c >> 3, ch = (c & 7) << 3;
        *(uint4*)(sK + row * 72 + ch) = *(const uint4*)(kcp + row * 64 + ch);
        const int row2 = c >> 4, ch2 = (c & 15) << 3;
        *(uint4*)(sVt + row2 * 136 + ch2) = *(const uint4*)(vcp + row2 * 128 + ch2);
      }
    }
    bf16x8 qf[2][2];
    float gate[2][3];
    int tq[2];
#pragma unroll
    for (int qt = 0; qt < 2; ++qt) {
      const int t = q0 + 16 * qt + col;
      tq[qt] = t;
      const size_t tok = (size_t)b * T + t;
      const u16* qp = p.proj + tok * LDP + C_Q + h * 64 + 8 * quad;
      qf[qt][0] = *(const bf16x8*)qp;
      qf[qt][1] = *(const bf16x8*)(qp + 32);
#pragma unroll
      for (int br = 0; br < 3; ++br) gate[qt][br] = sigmoidf_(bf2f(p.proj[tok * LDP + C_GATE + h * 3 + br]));
    }
    __syncthreads();

    f32x4 comb[2][4];
    {
      const int srcl = (lane + 48) & 63;
#pragma unroll
      for (int qt = 0; qt < 2; ++qt) {
        f32x4 s[8];
#pragma unroll
        for (int kt = 0; kt < 8; ++kt) {
          s[kt] = f32x4{0.f, 0.f, 0.f, 0.f};
#pragma unroll
          for (int ks = 0; ks < 2; ++ks) {
            const bf16x8 kf = *(const bf16x8*)(sK + (16 * kt + col) * 72 + 32 * ks + 8 * quad);
            s[kt] = mfma16(kf, qf[qt][ks], s[kt]);
          }
        }
        const int t = tq[qt];
        float mx = -1e30f;
#pragma unroll
        for (int kt = 0; kt < 8; ++kt)
#pragma unroll
          for (int r = 0; r < 4; ++r) {
            const int c = 16 * kt + 4 * quad + r;
            const bool v = (16 * c + 31) <= t;
            const float sv = v ? s[kt][r] : -1e30f;
            s[kt][r] = sv;
            mx = fmaxf(mx, sv);
          }
        mx = fmaxf(mx, __shfl_xor(mx, 16));
        mx = fmaxf(mx, __shfl_xor(mx, 32));
        float ps = 0.f;
        const float mcc = fmaxf(mx, -1e20f) * c2;
#pragma unroll
        for (int kt = 0; kt < 8; ++kt)
#pragma unroll
          for (int r = 0; r < 4; ++r) {
            const float pv = fexp2(__builtin_fmaf(s[kt][r], c2, -mcc));
            ps += pv;
            s[kt][r] = pv;
          }
        ps += __shfl_xor(ps, 16);
        ps += __shfl_xor(ps, 32);
        const float inv = ps > 0.f ? 1.f / ps : 0.f;
#pragma unroll
        for (int kt = 0; kt < 8; ++kt)
#pragma unroll
          for (int r = 0; r < 4; ++r) s[kt][r] *= inv;
        float prev3 = 0.f;
#pragma unroll
        for (int kt = 0; kt < 8; ++kt) {
          const float sum4 = s[kt][0] + s[kt][1] + s[kt][2] + s[kt][3];
          const float xs = __shfl(s[kt][3], srcl);
          const float extra = quad ? xs : prev3;
          prev3 = xs;
          if (need_sel) impH[(w * 32 + 16 * qt + col) * 33 + 4 * kt + quad] = sum4 + extra;
        }
        bf16x8 pb[4];
#pragma unroll
        for (int kk = 0; kk < 4; ++kk) {
          union { bf16x8 v; unsigned u[4]; } cv;
          cv.u[0] = pack2(s[2 * kk][0], s[2 * kk][1]);
          cv.u[1] = pack2(s[2 * kk][2], s[2 * kk][3]);
          cv.u[2] = pack2(s[2 * kk + 1][0], s[2 * kk + 1][1]);
          cv.u[3] = pack2(s[2 * kk + 1][2], s[2 * kk + 1][3]);
          pb[kk] = cv.v;
        }
#pragma unroll
        for (int dt = 0; dt < 4; ++dt) {
          f32x4 oc = f32x4{0.f, 0.f, 0.f, 0.f};
#pragma unroll
          for (int kk = 0; kk < 4; ++kk) {
            union { bf16x8 v; uint2 hh[2]; } cv;
            cv.hh[0] = *(const uint2*)(sVt + (16 * dt + col) * 136 + 32 * kk + 4 * quad);
            cv.hh[1] = *(const uint2*)(sVt + (16 * dt + col) * 136 + 32 * kk + 16 + 4 * quad);
            oc = mfma16(cv.v, pb[kk], oc);
          }
          comb[qt][dt] = oc * gate[qt][0];
        }
      }
    }
#pragma unroll
    for (int qt = 0; qt < 2; ++qt) {
      const size_t tok = (size_t)b * T + tq[qt];
      union { bf16x8 v; unsigned u[4]; } own, par, res;
      own.v = qf[qt][0];
#pragma unroll
      for (int j = 0; j < 4; ++j) par.u[j] = (unsigned)__shfl_xor((int)own.u[j], 16);
      const float4 c0 = *(const float4*)(p.rope + tok * 16), c1 = *(const float4*)(p.rope + tok * 16 + 4);
      const float4 s0 = *(const float4*)(p.rope + tok * 16 + 8), s1 = *(const float4*)(p.rope + tok * 16 + 12);
      const float cs[8] = {c0.x, c0.y, c0.z, c0.w, c1.x, c1.y, c1.z, c1.w};
      const float sn[8] = {s0.x, s0.y, s0.z, s0.w, s1.x, s1.y, s1.z, s1.w};
#pragma unroll
      for (int j = 0; j < 4; ++j) {
        const float o0 = __uint_as_float(own.u[j] << 16), o1 = __uint_as_float(own.u[j] & 0xffff0000u);
        const float p0 = __uint_as_float(par.u[j] << 16), p1 = __uint_as_float(par.u[j] & 0xffff0000u);
        const float sg = (quad == 0) ? -1.f : 1.f;
        const float r0 = o0 * cs[2 * j] + sg * p0 * sn[2 * j];
        const float r1 = o1 * cs[2 * j + 1] + sg * p1 * sn[2 * j + 1];
        res.u[j] = (quad < 2) ? pack2(r0, r1) : own.u[j];
      }
      qf[qt][0] = res.v;
    }
    __syncthreads();
    if (!need_sel) {
      if (tid < 32) selm[tid] = (2u << ((q0 + tid) >> 6)) - 1u;
    } else {
#pragma unroll
    for (int i = 0; i < 4; ++i) {
      const int cell = tid + 256 * i;
      const int qi = cell >> 5, s_ = cell & 31;
      const int cur = (q0 + qi) >> 6;
      float v = impH[(0 * 32 + qi) * 33 + s_] + impH[(1 * 32 + qi) * 33 + s_] + impH[(2 * 32 + qi) * 33 + s_] +
                impH[(3 * 32 + qi) * 33 + s_];
      const int dist = cur - s_;
      const bool forced = (s_ == 0) || (dist >= 0 && dist < 2);
      v = forced ? 1e9f : (s_ <= cur ? v : -1.f);
      impT[qi * 33 + s_] = v;
    }
    __syncthreads();
    {
      const int qi = tid >> 3, sub = tid & 7;
      unsigned bits = 0u;
#pragma unroll
      for (int k = 0; k < 4; ++k) {
        const int s_ = sub * 4 + k;
        const float v = impT[qi * 33 + s_];
        int rank = 0;
        for (int s2 = 0; s2 < 32; ++s2) {
          const float v2 = impT[qi * 33 + s2];
          rank += ((v2 > v) || (v2 == v && s2 < s_)) ? 1 : 0;
        }
        if (rank < 16) bits |= 1u << s_;
      }
      atomicOr(&selm[qi], bits);
    }
    }
    __syncthreads();
    unsigned sm[2] = {selm[col], selm[16 + col]};
    unsigned uni = 0u;
#pragma unroll
    for (int i = 0; i < 32; ++i) uni |= selm[i];
    const int kbmax = (q0 + 31) >> 6;
    {
      float m[2] = {-1e30f, -1e30f}, l[2] = {0.f, 0.f};
      f32x4 o[2][4];
#pragma unroll
      for (int qt = 0; qt < 2; ++qt)
#pragma unroll
        for (int dt = 0; dt < 4; ++dt) o[qt][dt] = f32x4{0.f, 0.f, 0.f, 0.f};
      unsigned rem = (kbmax >= 31) ? uni : (uni & ((1u << (kbmax + 1)) - 1u));
      int kb = rem ? (__ffs((int)rem) - 1) : -1;
      uint4 rk0, rk1, rv0, rv1;
      const int lr0 = tid >> 3, lch = (tid & 7) << 3;
#define LOADKV_(kbx, CK, VT)                                                                                         \
      rk0 = *(const uint4*)(p.proj + ((size_t)b * T + (kbx) * 64 + lr0) * LDP + (CK) + g * 64 + lch);                 \
      rk1 = *(const uint4*)(p.proj + ((size_t)b * T + (kbx) * 64 + lr0 + 32) * LDP + (CK) + g * 64 + lch);            \
      rv0 = *(const uint4*)((VT) + ((size_t)bg * 64 + lr0) * LDT + (kbx) * 64 + lch);                                 \
      rv1 = *(const uint4*)((VT) + ((size_t)bg * 64 + lr0 + 32) * LDT + (kbx) * 64 + lch);
#define STOREKV_()                                                                                                   \
      *(uint4*)(sK + lr0 * 72 + lch) = rk0; *(uint4*)(sK + (lr0 + 32) * 72 + lch) = rk1;                              \
      *(uint4*)(sVt + lr0 * 72 + lch) = rv0; *(uint4*)(sVt + (lr0 + 32) * 72 + lch) = rv1;
      if (kb >= 0) { LOADKV_(kb, C_KS, p.vts) }
#pragma unroll 1
      while (kb >= 0) {
        rem &= rem - 1u;
        const int nkb = rem ? (__ffs((int)rem) - 1) : -1;
        __syncthreads();
        STOREKV_()
        if (nkb >= 0) { LOADKV_(nkb, C_KS, p.vts) }
        __syncthreads();
        const int lim0 = ((sm[0] >> kb) & 1u) ? tq[0] : -1, lim1 = ((sm[1] >> kb) & 1u) ? tq[1] : -1;
        attn_tile<64, 2, 72, 72>(sK, sVt, qf, o, m, l, c2, lane, [&](int qt, int kl) {
          return (kb * 64 + kl) <= (qt ? lim1 : lim0);
        });
        kb = nkb;
      }
#pragma unroll
      for (int qt = 0; qt < 2; ++qt) {
        float lt = l[qt];
        lt += __shfl_xor(lt, 16);
        lt += __shfl_xor(lt, 32);
        const float sc = lt > 0.f ? gate[qt][1] / lt : 0.f;
#pragma unroll
        for (int dt = 0; dt < 4; ++dt) comb[qt][dt] += o[qt][dt] * sc;
      }
    }
    {
      float m[2] = {-1e30f, -1e30f}, l[2] = {0.f, 0.f};
      f32x4 o[2][4];
#pragma unroll
      for (int qt = 0; qt < 2; ++qt)
#pragma unroll
        for (int dt = 0; dt < 4; ++dt) o[qt][dt] = f32x4{0.f, 0.f, 0.f, 0.f};
      const int kblo = (q0 >= 511) ? ((q0 - 511) >> 6) : 0;
      uint4 rk0, rk1, rv0, rv1;
      const int lr0 = tid >> 3, lch = (tid & 7) << 3;
      int kb = kblo;
      LOADKV_(kb, C_KW, p.vtw)
#pragma unroll 1
      while (kb >= 0) {
        const int nkb = (kb < kbmax) ? kb + 1 : -1;
        __syncthreads();
        STOREKV_()
        if (nkb >= 0) { LOADKV_(nkb, C_KW, p.vtw) }
        __syncthreads();
        attn_tile<64, 2, 72, 72>(sK, sVt, qf, o, m, l, c2, lane, [&](int qt, int kl) {
          return (unsigned)(tq[qt] - (kb * 64 + kl)) < 512u;
        });
        kb = nkb;
      }
#undef LOADKV_
#undef STOREKV_
#pragma unroll
      for (int qt = 0; qt < 2; ++qt) {
        float lt = l[qt];
        lt += __shfl_xor(lt, 16);
        lt += __shfl_xor(lt, 32);
        const float sc = lt > 0.f ? gate[qt][2] / lt : 0.f;
#pragma unroll
        for (int dt = 0; dt < 4; ++dt) comb[qt][dt] += o[qt][dt] * sc;
      }
    }
#pragma unroll
    for (int qt = 0; qt < 2; ++qt) {
      const size_t tok = (size_t)b * T + tq[qt];
#pragma unroll
      for (int dt = 0; dt < 4; ++dt) {
        uint2 pk;
        pk.x = pack2(comb[qt][dt][0], comb[qt][dt][1]);
        pk.y = pack2(comb[qt][dt][2], comb[qt][dt][3]);
        *(uint2*)(p.mix + tok * LDA + 512 + h * 64 + 16 * dt + 4 * quad) = pk;
      }
    }
  }
}

template <bool RESB>
DEVI void phase_resid(const Params& p, unsigned char* smem, const u16* A, const u16* Wt, const float* res, float* ssq) {
  u16* sA = (u16*)smem; u16* sB = sA + 128 * 72;
  XCD_TILE_LOOP(idx, 256, 8) {
    GEMM_LANE_VARS
    const int mt = XCD_TILE_MT(idx, 8), nt_ = XCD_TILE_NT(idx, 8);
    const int m0 = mt * 128, n0 = nt_ * 128;
    f32x4 acc[4][4];
    gemm_mainloop<true>(tid, sA, sB, ARow{A, LDA}, Wt, LDA, m0, n0, 16, acc);
#pragma unroll
    for (int mi = 0; mi < 4; ++mi) {
      const int m = m0 + wm * 64 + 16 * mi + col;
      float ss = 0.f;
#pragma unroll
      for (int ni = 0; ni < 4; ++ni) {
        const int n = n0 + wn * 64 + 16 * ni + 4 * quad;
        const f32x4 v = acc[ni][mi];
        float4 r;
        if (RESB) {
          const uint2 rb = *(const uint2*)(p.hn + (size_t)m * LDA + n);
          r.x = __uint_as_float(rb.x << 16); r.y = __uint_as_float(rb.x & 0xffff0000u);
          r.z = __uint_as_float(rb.y << 16); r.w = __uint_as_float(rb.y & 0xffff0000u);
        } else {
          r = *(const float4*)(res + (size_t)m * D + n);
        }
        float4 hv;
        hv.x = r.x + v[0]; hv.y = r.y + v[1]; hv.z = r.z + v[2]; hv.w = r.w + v[3];
        ss += hv.x * hv.x + hv.y * hv.y + hv.z * hv.z + hv.w * hv.w;
        uint2 pk; pk.x = pack2(hv.x, hv.y); pk.y = pack2(hv.z, hv.w);
        *(uint2*)(p.hn + (size_t)m * LDA + n) = pk;
      }
      ss += __shfl_xor(ss, 16);
      ss += __shfl_xor(ss, 32);
      if (quad == 0) atomicAdd(ssq + m, ss);
    }
  }
}

DEVI void phase_scaled(const Params& p, unsigned char* smem, const u16* A, const u16* Wt, int ntn, const float* ssq, u16* outp, int ldo) {
  u16* sA = (u16*)smem; u16* sB = sA + 128 * 72;
  XCD_TILE_LOOP(idx, 256, ntn) {
    GEMM_LANE_VARS
    const int mt = XCD_TILE_MT(idx, ntn), nt_ = XCD_TILE_NT(idx, ntn);
    const int m0 = mt * 128, n0 = nt_ * 128;
    f32x4 acc[4][4];
    gemm_mainloop<true>(tid, sA, sB, ARow{A, LDA}, Wt, LDA, m0, n0, 16, acc);
#pragma unroll
    for (int mi = 0; mi < 4; ++mi) {
      const int m = m0 + wm * 64 + 16 * mi + col;
      const float rstd = rsqrtf(ssq[m] * (1.f / D) + 1e-6f);
#pragma unroll
      for (int ni = 0; ni < 4; ++ni) {
        const int n = n0 + wn * 64 + 16 * ni + 4 * quad;
        const f32x4 v = acc[ni][mi];
        uint2 pk; pk.x = pack2(v[0] * rstd, v[1] * rstd); pk.y = pack2(v[2] * rstd, v[3] * rstd);
        *(uint2*)(outp + (size_t)m * ldo + n) = pk;
      }
    }
  }
}

DEVI void phase_memattn(const Params& p, unsigned char* smem) {
  u16* sK = (u16*)smem;
  u16* sVt = (u16*)(smem + 33792);
  const float c2 = 0.0625f * 1.4426950408889634f;
#pragma unroll 1
  for (int tile = blockIdx.x; tile < 2048; tile += gridDim.x) {
    const int tid = launder(threadIdx.x), lane = tid & 63, w = tid >> 6, col = lane & 15, quad = lane >> 4;
    const int b = tile >> 7, head = (tile >> 5) & 3, q0 = (tile & 31) * 64;
    const size_t tok = (size_t)b * T + q0 + 16 * w + col;
    bf16x8 qf[1][8];
#pragma unroll
    for (int ks = 0; ks < 8; ++ks) qf[0][ks] = *(const bf16x8*)(p.qm + tok * LDA + head * 256 + 32 * ks + 8 * quad);
    float m[1] = {-1e30f}, l[1] = {0.f};
    f32x4 o[1][16];
#pragma unroll
    for (int dt = 0; dt < 16; ++dt) o[0][dt] = f32x4{0.f, 0.f, 0.f, 0.f};
    uint4 rg0, rg1, rg2, rg3, rg4, rg5, rg6, rg7;
    const int krow = tid >> 5, kch = (tid & 31) << 3;
    const int vrow = tid >> 3, vch = (tid & 7) << 3;
#define LK1_(i, kbx) rg##i = *(const uint4*)(p.memk + ((size_t)b * 256 + (kbx) * 64 + krow + 8 * i) * LDA + head * 256 + kch);
#define SK1_(i) *(uint4*)(sK + (krow + 8 * i) * 264 + kch) = rg##i;
#define LV1_(i, kbx) rg##i = *(const uint4*)(p.memvt + ((size_t)(b * 4 + head) * 256 + vrow + 32 * i) * 256 + (kbx) * 64 + vch);
#define SV1_(i) *(uint4*)(sVt + (vrow + 32 * i) * 72 + vch) = rg##i;
#define LOADK_(kbx) LK1_(0, kbx) LK1_(1, kbx) LK1_(2, kbx) LK1_(3, kbx) LK1_(4, kbx) LK1_(5, kbx) LK1_(6, kbx) LK1_(7, kbx)
#define STOREK_() SK1_(0) SK1_(1) SK1_(2) SK1_(3) SK1_(4) SK1_(5) SK1_(6) SK1_(7)
#define LOADV_(kbx) LV1_(0, kbx) LV1_(1, kbx) LV1_(2, kbx) LV1_(3, kbx) LV1_(4, kbx) LV1_(5, kbx) LV1_(6, kbx) LV1_(7, kbx)
#define STOREV_() SV1_(0) SV1_(1) SV1_(2) SV1_(3) SV1_(4) SV1_(5) SV1_(6) SV1_(7)
    __syncthreads();
    LOADK_(0)
    STOREK_()
    LOADV_(0)
    __syncthreads();
#pragma unroll 1
    for (int kb = 0; kb < 4; ++kb) {
      bf16x8 pb[1][2];
      attn_qk<256, 1, 264>(sK, qf, o, m, l, c2, lane, [&](int, int) { return true; }, pb);
      STOREV_()
      if (kb < 3) { LOADK_(kb + 1) }
      __syncthreads();
      attn_pv<256, 1, 72>(sVt, pb, o, lane);
      if (kb < 3) {
        STOREK_()
        LOADV_(kb + 1)
      }
      __syncthreads();
    }
#undef LOADK_
#undef STOREK_
#undef LOADV_
#undef STOREV_
#undef LK1_
#undef SK1_
#undef LV1_
#undef SV1_
    float lt = l[0];
    lt += __shfl_xor(lt, 16);
    lt += __shfl_xor(lt, 32);
    const float inv = 1.f / lt;
#pragma unroll
    for (int dt = 0; dt < 16; ++dt) {
      uint2 pk;
      pk.x = pack2(o[0][dt][0] * inv, o[0][dt][1] * inv);
      pk.y = pack2(o[0][dt][2] * inv, o[0][dt][3] * inv);
      *(uint2*)(p.mix + tok * LDA + head * 256 + 16 * dt + 4 * quad) = pk;
    }
  }
}

__constant__ unsigned char kCandI[64] = {0,0,0,0,0,0,0,0,0,0,0,0,0,0,0,0, 1,1,1,1,1,1,1,1, 2,2,2,2,2, 3,3,3,3, 4,4,4, 5,5, 6,6, 7,7,
                                          8, 9, 10, 11, 12, 13, 14, 15, 0,0,0,0,0,0,0,0,0,0,0,0,0,0};
__constant__ unsigned char kCandJ[64] = {0,1,2,3,4,5,6,7,8,9,10,11,12,13,14,15, 0,1,2,3,4,5,6,7, 0,1,2,3,4, 0,1,2,3, 0,1,2, 0,1, 0,1, 0,1,
                                          0, 0, 0, 0, 0, 0, 0, 0, 0,0,0,0,0,0,0,0,0,0,0,0,0,0};

DEVI unsigned score_key(float v, int idx) {
  unsigned u = __float_as_uint(v);
  u = (u & 0x80000000u) ? ~u : (u | 0x80000000u);
  return (u & ~127u) | (unsigned)(127 - idx);
}
DEVI float key_score(unsigned k) {
  k &= ~127u;
  const unsigned u = (k & 0x80000000u) ? (k & 0x7fffffffu) : ~k;
  return __uint_as_float(u);
}

DEVI void phase_peer_route(const Params& p, unsigned char* smem) {
  u16* sA = (u16*)smem; u16* sB = sA + 128 * 72;
  unsigned* sScore = (unsigned*)smem;
  unsigned* sTop = (unsigned*)(smem + 36864);
  unsigned* sTmp = (unsigned*)(smem + 53248);
  {
    const int t0_ = launder(threadIdx.x);
    const int gw = (blockIdx.x * 256 + t0_) >> 6, nw = (gridDim.x * 256) >> 6;
    conv_fp8_rows(p.peer_u, p.ub8, p.uscale, 16384, gw, nw, t0_ & 63);
    conv_fp8_rows(p.peer_v, p.vb8, p.vscale, 16384, gw, nw, t0_ & 63);
  }
#pragma unroll 1
  for (int tile = blockIdx.x; tile < 256 * 8; tile += gridDim.x) {
    GEMM_LANE_VARS
    const int mt = tile >> 3, hd = tile & 7;
    const int m0 = mt * 128;
#pragma unroll 1
    for (int ph = 0; ph < 2; ++ph) {
      const int hp = hd * 2 + ph;
      f32x4 acc[4][4];
      __syncthreads();
      gemm_mainloop<false>(tid, sA, sB, ARow{p.pq + hp * 128, LDPQ}, p.subk + (size_t)hp * 128 * 128, 128, m0, 0, 2, acc);
#pragma unroll 1
      for (int hh = 0; hh < 2; ++hh) {
        if (wm == hh) {
#pragma unroll
          for (int mi = 0; mi < 4; ++mi) {
            const int row = 16 * mi + col;
#pragma unroll
            for (int ni = 0; ni < 4; ++ni) {
              const int n = wn * 64 + 16 * ni + 4 * quad;
              const f32x4 v = acc[ni][mi];
              uint4 kk;
              kk.x = score_key(v[0], n); kk.y = score_key(v[1], n + 1);
              kk.z = score_key(v[2], n + 2); kk.w = score_key(v[3], n + 3);
              *(uint4*)(sScore + row * 132 + n) = kk;
            }
          }
        }
        __syncthreads();
#pragma unroll 1
        for (int rg = 0; rg < 4; ++rg) {
          const int rbase = w * 16 + rg * 4;
          unsigned k0[4], k1[4], t0[4], t1[4], thr[4];
#pragma unroll
          for (int r = 0; r < 4; ++r) {
            k0[r] = sScore[(rbase + r) * 132 + lane];
            k1[r] = sScore[(rbase + r) * 132 + 64 + lane];
            t0[r] = ((k0[r] >> 16) << 7) | (k0[r] & 127u);
            t1[r] = ((k1[r] >> 16) << 7) | (k1[r] & 127u);
            thr[r] = 0u;
          }
#pragma unroll
          for (int bit = 22; bit >= 0; --bit) {
#pragma unroll
            for (int r = 0; r < 4; ++r) {
              const unsigned cand = thr[r] | (1u << bit);
              const int cnt = __popcll(__ballot(t0[r] >= cand)) + __popcll(__ballot(t1[r] >= cand));
              thr[r] = (cnt >= 16) ? cand : thr[r];
            }
          }
          unsigned* tmp = sTmp + w * 64;
#pragma unroll
          for (int r = 0; r < 4; ++r) {
            const unsigned long long b0 = __ballot(t0[r] >= thr[r]), b1 = __ballot(t1[r] >= thr[r]);
            const int pos0 = __builtin_amdgcn_mbcnt_hi((unsigned)(b0 >> 32), __builtin_amdgcn_mbcnt_lo((unsigned)b0, 0u));
            const int pos1 = __popcll(b0) + __builtin_amdgcn_mbcnt_hi((unsigned)(b1 >> 32), __builtin_amdgcn_mbcnt_lo((unsigned)b1, 0u));
            if (t0[r] >= thr[r]) tmp[r * 16 + pos0] = k0[r];
            if (t1[r] >= thr[r]) tmp[r * 16 + pos1] = k1[r];
          }
          __builtin_amdgcn_fence(__ATOMIC_RELEASE, "wavefront");
          __builtin_amdgcn_wave_barrier();
          __builtin_amdgcn_fence(__ATOMIC_ACQUIRE, "wavefront");
          {
            const int r = lane >> 4, ix = lane & 15;
            const unsigned mine = tmp[r * 16 + ix];
            const uint4 a = *(const uint4*)(tmp + r * 16), b = *(const uint4*)(tmp + r * 16 + 4), c = *(const uint4*)(tmp + r * 16 + 8),
                        d = *(const uint4*)(tmp + r * 16 + 12);
            const int rk = (a.x > mine) + (a.y > mine) + (a.z > mine) + (a.w > mine) + (b.x > mine) + (b.y > mine) + (b.z > mine) + (b.w > mine) +
                           (c.x > mine) + (c.y > mine) + (c.z > mine) + (c.w > mine) + (d.x > mine) + (d.y > mine) + (d.z > mine) + (d.w > mine);
            sTop[((hh * 64 + rbase + r) * 2 + ph) * 16 + rk] = mine;
          }
          __builtin_amdgcn_fence(__ATOMIC_RELEASE, "wavefront");
          __builtin_amdgcn_wave_barrier();
        }
        __syncthreads();
      }
    }
    const int ci = kCandI[lane], cj = kCandJ[lane];
    const bool act = lane < 50;
#pragma unroll 1
    for (int tg = 0; tg < 8; ++tg) {
      const int tb = w * 32 + tg * 4;
      unsigned k0[4], k1[4], ku[4], thr[4];
      float v[4];
#pragma unroll
      for (int r = 0; r < 4; ++r) {
        k0[r] = sTop[((tb + r) * 2 + 0) * 16 + ci];
        k1[r] = sTop[((tb + r) * 2 + 1) * 16 + cj];
        v[r] = key_score(k0[r]) + key_score(k1[r]);
        unsigned u = __float_as_uint(v[r]);
        u = (u & 0x80000000u) ? ~u : (u | 0x80000000u);
        ku[r] = act ? (((u >> 16) << 6) | (unsigned)(63 - lane)) : 0u;
        thr[r] = 0u;
      }
#pragma unroll
      for (int bit = 21; bit >= 0; --bit) {
#pragma unroll
        for (int r = 0; r < 4; ++r) {
          const unsigned cand = thr[r] | (1u << bit);
          const int cnt = __popcll(__ballot(ku[r] >= cand));
          thr[r] = (cnt >= 16) ? cand : thr[r];
        }
      }
#pragma unroll
      for (int r = 0; r < 4; ++r) {
        const bool sel = act && (ku[r] >= thr[r]);
        const unsigned long long ms = __ballot(sel);
        const int slot = __builtin_amdgcn_mbcnt_hi((unsigned)(ms >> 32), __builtin_amdgcn_mbcnt_lo((unsigned)ms, 0u));
        const float vmax = __int_as_float(__builtin_amdgcn_readlane(__float_as_int(v[r]), 0));
        const float e = sel ? __expf(v[r] - vmax) : 0.f;
        const float tot = wave_sum(e);
        if (sel) {
          const int eid = (127 - (int)(k0[r] & 127u)) * 128 + (127 - (int)(k1[r] & 127u));
          const size_t o = (size_t)(m0 + tb + r) * 128 + hd * 16 + slot;
          p.experts[o] = eid;
          p.gates[o] = e / tot;
        }
      }
    }
  }
}

template <int PART>
DEVI void phase_peer_gather(const Params& p, unsigned char* smem) {
  const int w0_ = threadIdx.x >> 6;
#pragma unroll 1
  for (int tok = blockIdx.x * 4 + w0_; tok < NTOK; tok += gridDim.x * 4) {
    if (NTOK % (gridDim.x * 4) == 0) __syncthreads();
    const int tid = launder(threadIdx.x), lane = tid & 63;
    const uint4* hp4 = (const uint4*)(p.hn + (size_t)tok * LDA + lane * 16);
    float hv[16], xn[16], y[16];
    {
      const uint4 a0 = hp4[0], a1 = hp4[1];
      const unsigned hu[8] = {a0.x, a0.y, a0.z, a0.w, a1.x, a1.y, a1.z, a1.w};
#pragma unroll
      for (int i = 0; i < 8; ++i) { hv[2 * i] = __uint_as_float(hu[i] << 16); hv[2 * i + 1] = __uint_as_float(hu[i] & 0xffff0000u); }
    }
    float ss = 0.f;
#pragma unroll
    for (int i = 0; i < 16; ++i) ss += hv[i] * hv[i];
    ss = wave_sum(ss);
    const float rstd = rsqrtf(ss * (1.f / D) + 1e-6f);
    {
      const float4* g4 = (const float4*)p.peer_g + lane * 4;
      const float4 a0 = g4[0], a1 = g4[1], a2 = g4[2], a3 = g4[3];
      const float gg[16] = {a0.x, a0.y, a0.z, a0.w, a1.x, a1.y, a1.z, a1.w, a2.x, a2.y, a2.z, a2.w, a3.x, a3.y, a3.z, a3.w};
#pragma unroll
      for (int i = 0; i < 16; ++i) { xn[i] = hv[i] * rstd * gg[i]; y[i] = 0.f; }
    }
    int e0 = p.experts[(size_t)tok * 128 + lane], e1 = p.experts[(size_t)tok * 128 + 64 + lane];
    float g0 = p.gates[(size_t)tok * 128 + lane], g1 = p.gates[(size_t)tok * 128 + 64 + lane];
    if (PART == 0) {
      int* sE = (int*)(smem + (tid >> 6) * 1024);
      float* sG = (float*)(sE + 128);
      int pos0 = 0, pos1 = 0, base = 0;
      const int flip_ = (((tok - (blockIdx.x * 4 + w0_)) / (int)(gridDim.x * 4)) & 1) ? 15 : 0;
      const int q0_ = (e0 >> 10) ^ flip_, q1_ = (e1 >> 10) ^ flip_;
#pragma unroll
      for (int q = 0; q < 16; ++q) {
        const unsigned long long m0 = __ballot(q0_ == q), m1 = __ballot(q1_ == q);
        const int c0 = __popcll(m0);
        const int i0 = __builtin_amdgcn_mbcnt_hi((unsigned)(m0 >> 32), __builtin_amdgcn_mbcnt_lo((unsigned)m0, 0u));
        const int i1 = __builtin_amdgcn_mbcnt_hi((unsigned)(m1 >> 32), __builtin_amdgcn_mbcnt_lo((unsigned)m1, 0u));
        if (q0_ == q) pos0 = base + i0;
        if (q1_ == q) pos1 = base + c0 + i1;
        base += c0 + __popcll(m1);
      }
      __builtin_amdgcn_fence(__ATOMIC_RELEASE, "wavefront");
      __builtin_amdgcn_wave_barrier();
      sE[pos0] = e0; sG[pos0] = g0;
      sE[pos1] = e1; sG[pos1] = g1;
      __builtin_amdgcn_fence(__ATOMIC_RELEASE, "wavefront");
      __builtin_amdgcn_wave_barrier();
      __builtin_amdgcn_fence(__ATOMIC_ACQUIRE, "wavefront");
      e0 = sE[lane]; e1 = sE[64 + lane];
      g0 = sG[lane]; g1 = sG[64 + lane];
      p.experts[(size_t)tok * 128 + lane] = e0;
      p.experts[(size_t)tok * 128 + 64 + lane] = e1;
    }
    const float su0 = p.uscale[e0], su1 = p.uscale[e1];
    const float sv0 = p.vscale[e0], sv1 = p.vscale[e1];
    float cf0 = 0.f, cf1 = 0.f, dsum = 0.f;
    uint4 ca[8], cb[8];
#define LOADB_(R, bi)                                                                                   \
    _Pragma("unroll") for (int u = 0; u < 8; ++u) {                                                       \
      const int kk_ = (((bi) & 7) << 3) + u;                                                             \
      const int e_ = __builtin_amdgcn_readlane((((bi) >> 3) & 1) ? e1 : e0, kk_);                        \
      R[u] = ((const uint4*)((((bi) >> 4) ? p.vb8 : p.ub8) + (size_t)e_ * 1024))[lane];                  \
    }
#define COMPU_(R, bi)                                                                                   \
    {                                                                                                    \
      float d8[8];                                                                                       \
      _Pragma("unroll") for (int u = 0; u < 8; ++u) {                                                     \
        const unsigned uu[4] = {R[u].x, R[u].y, R[u].z, R[u].w};                                         \
        f32x2 a2 = {0.f, 0.f};                                                                           \
        _Pragma("unroll") for (int j = 0; j < 4; ++j) {                                                   \
          const f32x2 lo = __builtin_amdgcn_cvt_pk_f32_fp8((int)uu[j], false);                           \
          const f32x2 hi = __builtin_amdgcn_cvt_pk_f32_fp8((int)uu[j], true);                            \
          a2 = xn2[2 * j] * lo + a2;                                                                     \
          a2 = xn2[2 * j + 1] * hi + a2;                                                                 \
        }                                                                                                \
        d8[u] = a2[0] + a2[1];                                                                           \
      }                                                                                                  \
          \
      float v4[4], v2[2];                                                                                \
      _Pragma("unroll") for (int i = 0; i < 4; ++i) {                                                     \
        const float snd = b5 ? d8[i] : d8[4 + i], kp = b5 ? d8[4 + i] : d8[i];                           \
        v4[i] = kp + __shfl_xor(snd, 32);                                                                \
      }                                                                                                  \
      _Pragma("unroll") for (int i = 0; i < 2; ++i) {                                                     \
        const float snd = b4 ? v4[i] : v4[2 + i], kp = b4 ? v4[2 + i] : v4[i];                           \
        v2[i] = kp + __shfl_xor(snd, 16);                                                                \
      }                                                                                                  \
      float v1;                                                                                          \
      { const float snd = b3 ? v2[0] : v2[1], kp = b3 ? v2[1] : v2[0]; v1 = kp + __shfl_xor(snd, 8); }   \
      v1 += __shfl_xor(v1, 4);                                                                           \
      v1 += __shfl_xor(v1, 2);                                                                           \
      v1 += __shfl_xor(v1, 1);                                                                           \
                \
      const float got = __shfl(v1, fsrc);                                                                \
      if ((lane >> 3) == ((bi) & 7)) dsum = got;                                                         \
    }                                                                                                    \
    if (((bi) & 7) == 7) {                                                                               \
      if (((bi) >> 3) & 1) cf1 = gelu_tanh(dsum * su1) * g1 * sv1; else cf0 = gelu_tanh(dsum * su0) * g0 * sv0; \
    }
#define COMPV_(R, bi)                                                                                   \
    _Pragma("unroll") for (int u = 0; u < 8; ++u) {                                                       \
      const int kk_ = (((bi) & 7) << 3) + u;                                                             \
      const float ck_ = __int_as_float(__builtin_amdgcn_readlane(__float_as_int((((bi) >> 3) & 1) ? cf1 : cf0), kk_)); \
      const f32x2 ck2 = {ck_, ck_};                                                                      \
      const unsigned uu[4] = {R[u].x, R[u].y, R[u].z, R[u].w};                                           \
      _Pragma("unroll") for (int j = 0; j < 4; ++j) {                                                     \
        const f32x2 lo = __builtin_amdgcn_cvt_pk_f32_fp8((int)uu[j], false);                             \
        const f32x2 hi = __builtin_amdgcn_cvt_pk_f32_fp8((int)uu[j], true);                              \
        y2[2 * j] = ck2 * lo + y2[2 * j];                                                                \
        y2[2 * j + 1] = ck2 * hi + y2[2 * j + 1];                                                        \
      }                                                                                                  \
    }
    const bool b5 = (lane & 32) != 0, b4 = (lane & 16) != 0, b3 = (lane & 8) != 0;
    const int fsrc = ((lane & 4) << 3) | ((lane & 2) << 3) | ((lane & 1) << 3);
    f32x2 xn2[8], y2[8];
#pragma unroll
    for (int i = 0; i < 8; ++i) { xn2[i] = f32x2{xn[2 * i], xn[2 * i + 1]}; y2[i] = f32x2{0.f, 0.f}; }
    if (PART == 0) {
      LOADB_(ca, 0)
#pragma unroll 1
      for (int bi = 0; bi < 16; bi += 2) {
        LOADB_(cb, bi + 1)
        COMPU_(ca, bi)
        if (bi + 2 < 16) { LOADB_(ca, bi + 2) }
        COMPU_(cb, bi + 1)
      }
      p.gates[(size_t)tok * 128 + lane] = cf0;
      p.gates[(size_t)tok * 128 + 64 + lane] = cf1;
      continue;
    }
    cf0 = g0; cf1 = g1;
    LOADB_(ca, 16)
#pragma unroll 1
    for (int bi = 16; bi < 32; bi += 2) {
      LOADB_(cb, bi + 1)
      COMPV_(ca, bi)
      if (bi + 2 < 32) { LOADB_(ca, bi + 2) }
      COMPV_(cb, bi + 1)
    }
#undef LOADB_
#undef COMPU_
#undef COMPV_
#pragma unroll
    for (int i = 0; i < 8; ++i) { y[2 * i] = y2[i][0]; y[2 * i + 1] = y2[i][1]; }
    float s2 = 0.f;
    {
      const uint4 a0 = hp4[0], a1 = hp4[1];
      const unsigned hu[8] = {a0.x, a0.y, a0.z, a0.w, a1.x, a1.y, a1.z, a1.w};
#pragma unroll
      for (int i = 0; i < 8; ++i) {
        y[2 * i] += __uint_as_float(hu[i] << 16);
        y[2 * i + 1] += __uint_as_float(hu[i] & 0xffff0000u);
        s2 += y[2 * i] * y[2 * i] + y[2 * i + 1] * y[2 * i + 1];
      }
    }
    s2 = wave_sum(s2);
    const float rs2 = rsqrtf(s2 * (1.f / D) + 1e-6f);
    {
      const float4* g4 = (const float4*)p.final_g + lane * 4;
      const float4 a0 = g4[0], a1 = g4[1], a2 = g4[2], a3 = g4[3];
      float4* o4 = (float4*)(p.out + (size_t)tok * D) + lane * 4;
      o4[0] = make_float4(y[0] * rs2 * a0.x, y[1] * rs2 * a0.y, y[2] * rs2 * a0.z, y[3] * rs2 * a0.w);
      o4[1] = make_float4(y[4] * rs2 * a1.x, y[5] * rs2 * a1.y, y[6] * rs2 * a1.z, y[7] * rs2 * a1.w);
      o4[2] = make_float4(y[8] * rs2 * a2.x, y[9] * rs2 * a2.y, y[10] * rs2 * a2.z, y[11] * rs2 * a2.w);
      o4[3] = make_float4(y[12] * rs2 * a3.x, y[13] * rs2 * a3.y, y[14] * rs2 * a3.z, y[15] * rs2 * a3.w);
    }
  }
}

#define XB_TMO      128
#define XB_XCNT(j)  (256  + 64 * (j))
#define XB_XSUB(j)  (1280 + 64 * (j))
#define XB_XGEN(j)  (2304 + 64 * (j))
#define XB_TOP      3328
#define XB_TOPGEN   3392
#define XCD_BAR_WORDS 3456
#define XB_SPIN_CAP (1u << 20)
#define LAS __attribute__((address_space(3)))
DEVI unsigned xb_ld(unsigned* q) { return __hip_atomic_load(q, __ATOMIC_RELAXED, __HIP_MEMORY_SCOPE_AGENT); }
DEVI unsigned xb_add(unsigned* q, unsigned v) { return __hip_atomic_fetch_add(q, v, __ATOMIC_RELAXED, __HIP_MEMORY_SCOPE_AGENT); }
DEVI unsigned xb_xcc_id() { return (unsigned)__builtin_amdgcn_s_getreg((3 << 11) | 20) & 0xFu; }
#define XB_SPIN(cond, bar) do { unsigned _sp = 0; while (cond) { __builtin_amdgcn_s_sleep(1); \
    if ((++_sp & 255u) == 0u) { if (xb_ld(&(bar)[XB_TMO])) break; if (_sp > XB_SPIN_CAP) { atomicAdd(&(bar)[XB_TMO], 1u); break; } } } } while (0)
struct XcdBarrier { unsigned* bar; unsigned x; volatile LAS unsigned* st; };
DEVI XcdBarrier xcd_barrier_post(unsigned* bar, volatile LAS unsigned* st) {
  XcdBarrier b; b.bar = bar; b.x = xb_xcc_id(); b.st = st;
  if (threadIdx.x == 0) (void)xb_add(&bar[XB_XCNT(b.x)], 1u);
  return b;
}
DEVI void xcd_barrier_complete(unsigned* bar, unsigned x, unsigned& nloc, unsigned& nx) {
  const unsigned G = gridDim.x * gridDim.y * gridDim.z;
  unsigned sum, cnt, mine, sp = 0u;
  for (;;) {
    sum = 0u; cnt = 0u; mine = 0u;
#pragma unroll
    for (unsigned j = 0; j < 16; ++j) { const unsigned c = xb_ld(&bar[XB_XCNT(j)]); sum += c; cnt += (c > 0u) ? 1u : 0u; mine = (j == x) ? c : mine; }
    if (sum == G) break;
    __builtin_amdgcn_s_sleep(1);
    if ((++sp & 255u) == 0u) { if (xb_ld(&bar[XB_TMO])) break; if (sp > XB_SPIN_CAP) { atomicAdd(&bar[XB_TMO], 1u); break; } }
  }
  nloc = mine > 0u ? mine : 1u; nx = cnt > 0u ? cnt : 1u;
}
DEVI void xcd_barrier(const XcdBarrier& b) {
  asm volatile("s_waitcnt vmcnt(0)" ::: "memory");
  __syncthreads();
  if (threadIdx.x == 0) {
    unsigned* bar = b.bar;
    __builtin_amdgcn_s_waitcnt(0);
    unsigned nloc = b.st[0], nx = b.st[1];
    if (nloc == 0u) { xcd_barrier_complete(bar, b.x, nloc, nx); b.st[0] = nloc; b.st[1] = nx; }
    const unsigned old = xb_add(&bar[XB_XSUB(b.x)], 1u);
    const unsigned gen = old / nloc;
    if (old + 1u == (gen + 1u) * nloc) {
      __builtin_amdgcn_fence(__ATOMIC_RELEASE, "agent");
      asm volatile("s_waitcnt vmcnt(0)" ::: "memory");
      const unsigned og = xb_add(&bar[XB_TOP], 1u);
      const unsigned tg = og / nx;
      if (og + 1u == (tg + 1u) * nx) xb_add(&bar[XB_TOPGEN], 1u);
      else XB_SPIN(xb_ld(&bar[XB_TOPGEN]) == tg, bar);
      __builtin_amdgcn_fence(__ATOMIC_ACQUIRE, "agent");
      xb_add(&bar[XB_XGEN(b.x)], 1u);
      asm volatile("s_waitcnt vmcnt(0)" ::: "memory");
    } else {
      XB_SPIN(xb_ld(&bar[XB_XGEN(b.x)]) == gen, bar);
      __builtin_amdgcn_fence(__ATOMIC_ACQUIRE, "agent");
      asm volatile("s_waitcnt vmcnt(0)" ::: "memory");
    }
  }
  __syncthreads();
}

template <bool COOP>
__global__ void __launch_bounds__(256, 2) mega(Params p, int ph_lo, int ph_hi) {
  __shared__ __attribute__((aligned(16))) unsigned char smem[SMEM_BYTES];
  __shared__ uint4 xb_words;
  if (threadIdx.x == 0) xb_words = make_uint4(0u, 0u, 0u, 0u);
  __syncthreads();
  XcdBarrier xb = xcd_barrier_post(p.bar, (volatile LAS unsigned*)&xb_words);
  (void)xb;
  if (COOP && ph_hi > 1000) cg::this_grid().sync();
#ifdef REPEAT_MASK
#define RUN_PHASE(i, call)                                                                   \
  if (ph_lo <= (i) && (i) <= ph_hi) {                                                        \
    call;                                                                                    \
    if (COOP && ((REPEAT_MASK >> (i)) & 1)) { xcd_barrier(xb); call; }                       \
    if (COOP && (i) < ph_hi) xcd_barrier(xb);                                                \
  }
#else
#define RUN_PHASE(i, call)                                                                   \
  if (ph_lo <= (i) && (i) <= ph_hi) {                                                        \
    call;                                                                                    \
    if (COOP && (i) < ph_hi) {                                                               \
      xcd_barrier(xb);                                                                       \
    }                                                                                        \
  }
#endif
  RUN_PHASE(0, phase0(p))
  RUN_PHASE(1, phase1(p, smem))
  RUN_PHASE(2, phase2(p, smem))
  RUN_PHASE(4, phase_nsa(p, smem))
  RUN_PHASE(5, phase_resid<false>(p, smem, p.mix, p.woutT, p.x, p.ssq1))
  RUN_PHASE(6, phase_scaled(p, smem, p.hn, p.wmqT, 8, p.ssq1, p.qm, LDA))
  RUN_PHASE(7, phase_memattn(p, smem))
  RUN_PHASE(8, phase_resid<true>(p, smem, p.mix, p.wmoT, nullptr, p.ssq2))
  RUN_PHASE(9, phase_scaled(p, smem, p.hn, p.wpqT, 16, p.ssq2, p.pq, LDPQ))
  RUN_PHASE(10, phase_peer_route(p, smem))
  RUN_PHASE(11, phase_peer_gather<0>(p, smem))
  RUN_PHASE(12, phase_peer_gather<1>(p, smem))
#undef RUN_PHASE
}

extern "C" void kernel_launch(void* const* d_in, const int* in_sizes, int n_in, void* d_out, int out_size, void* d_ws,
                              size_t ws_size, hipStream_t stream) {
  (void)in_sizes; (void)n_in; (void)out_size; (void)ws_size;
  Params p{};
  p.x = (const float*)d_in[0]; p.mem = (const float*)d_in[1]; p.pos = (const int*)d_in[2];
  p.mix_g = (const float*)d_in[3]; p.w_in = (const float*)d_in[4]; p.conv_w = (const float*)d_in[5];
  p.conv_b = (const float*)d_in[6]; p.ln_g = (const float*)d_in[7]; p.ln_b = (const float*)d_in[8];
  p.cmp_pos = (const float*)d_in[9]; p.cmp_w1 = (const float*)d_in[10]; p.cmp_b1 = (const float*)d_in[11];
  p.cmp_w2 = (const float*)d_in[12]; p.cmp_b2 = (const float*)d_in[13]; p.w_out = (const float*)d_in[14];
  p.memq_g = (const float*)d_in[15]; p.memkv_g = (const float*)d_in[16]; p.w_mq = (const float*)d_in[17];
  p.w_mk = (const float*)d_in[18]; p.w_mv = (const float*)d_in[19]; p.w_mo = (const float*)d_in[20];
  p.peer_g = (const float*)d_in[21]; p.peer_wq = (const float*)d_in[22]; p.peer_sk = (const float*)d_in[23];
  p.peer_u = (const float*)d_in[24]; p.peer_v = (const float*)d_in[25]; p.final_g = (const float*)d_in[26];
  p.out = (float*)d_out;
  unsigned char* ws = (unsigned char*)d_ws;
  size_t off = 0;
  auto take = [&](size_t bytes) { unsigned char* r = ws + off; off += (bytes + 255) & ~(size_t)255; return r; };
  unsigned char* regA = take((size_t)NTOK * LDA * 2);
  unsigned char* regB = take((size_t)NTOK * LDP * 2);
  unsigned char* regC = take((size_t)NTOK * LDA * 2);
  p.hn = (u16*)regA;
  p.proj = (u16*)regB; p.qm = (u16*)regB; p.pq = (u16*)regB;
  p.mix = (u16*)regC; p.experts = (int*)regC; p.gates = (float*)(regC + (size_t)NTOK * 128 * 4);
  {
    unsigned char* tb = regC + (size_t)2 * NTOK * 128 * 4;
    p.ub8 = tb; p.vb8 = tb + (size_t)16384 * 1024;
    p.uscale = (float*)(tb + (size_t)2 * 16384 * 1024); p.vscale = p.uscale + 16384;
  }
  p.h = nullptr;
  p.vts = (u16*)take((size_t)Bn * 2 * 64 * LDT * 2);
  p.vtw = (u16*)take((size_t)Bn * 2 * 64 * LDT * 2);
  p.memn = (u16*)take((size_t)Bn * 256 * LDA * 2);
  p.memk = (u16*)take((size_t)Bn * 256 * LDA * 2);
  p.memvt = (u16*)take((size_t)Bn * 256 * D * 2);
  p.winT = (u16*)take((size_t)2432 * LDA * 2);
  p.woutT = (u16*)take((size_t)1024 * LDA * 2);
  p.wmqT = (u16*)take((size_t)1024 * LDA * 2);
  p.wmkT = (u16*)take((size_t)1024 * LDA * 2);
  p.wmvT = (u16*)take((size_t)1024 * LDA * 2);
  p.wmoT = (u16*)take((size_t)1024 * LDA * 2);
  p.wpqT = (u16*)take((size_t)2048 * LDA * 2);
  p.subk = (u16*)take((size_t)16 * 128 * 128 * 2);
  p.w1T = (u16*)take((size_t)2 * 128 * LDW1 * 2);
  p.w2T = (u16*)take((size_t)2 * 128 * 128 * 2);
  p.biasp = (float*)take(256 * 4);
  p.rope = (float*)take((size_t)NTOK * 16 * 4);
  p.hdn = (u16*)take((size_t)2 * 4096 * 128 * 2);
  p.kc = (u16*)take((size_t)Bn * 2 * 128 * 64 * 2);
  p.vcT = (u16*)take((size_t)Bn * 2 * 64 * 128 * 2);
  p.ssq1 = (float*)take((size_t)NTOK * 4);
  p.ssq2 = (float*)take((size_t)NTOK * 4);
  p.bar = (unsigned*)take(16384);
  if (off > ws_size) { fprintf(stderr, "workspace too small: need %zu have %zu\n", off, ws_size); return; }

#if COOP_MODE
  static int grid_blocks = 0;
  if (!grid_blocks) {
    int dev = 0, cus = 0, per_cu = 0;
    hipGetDevice(&dev);
    hipDeviceGetAttribute(&cus, hipDeviceAttributeMultiprocessorCount, dev);
    hipOccupancyMaxActiveBlocksPerMultiprocessor(&per_cu, mega<true>, 256, 0);
    if (per_cu > 2) per_cu = 2;
    if (per_cu < 1) per_cu = 1;
    grid_blocks = cus * per_cu;
  }
  int lo = 0, hi = NPHASE;
  void* args[] = {&p, &lo, &hi};
  (void)hipMemsetAsync(p.bar, 0, 16384, stream);
  hipError_t e = hipLaunchCooperativeKernel((void*)mega<true>, dim3(grid_blocks), dim3(256), args, 0, stream);
  if (e != hipSuccess) fprintf(stderr, "cooperative launch failed: %s (grid %d)\n", hipGetErrorString(e), grid_blocks);
#else
  for (int ph = 0; ph <= NPHASE; ++ph) mega<false><<<dim3(512), dim3(256), 0, stream>>>(p, ph, ph);
#endif
}
```
